# Optimizing an MI355X kernel written in HIP

```python
import math
import jax
import jax.numpy as jnp
from jax import lax
import numpy as np

D_MODEL = 2048
BATCH = 8
SEQ = 2048
DEPTH = 1

MIX_WIDTH = D_MODEL
D_SSD = MIX_WIDTH // 2
D_ATTN = MIX_WIDTH - D_SSD
SSD_HEAD_DIM = 64
N_SSD_HEADS = D_SSD // SSD_HEAD_DIM
SSD_GROUPS = 2
D_STATE = 128
CONV_W = 5
CONV_CH = D_SSD + 2 * SSD_GROUPS * D_STATE
CHUNK = 256
ATTN_HEAD_DIM = 64
N_ATTN_HEADS = D_ATTN // (2 * ATTN_HEAD_DIM)
Q_BLOCK = 128
N_EXPERTS = 64
N_EXPERT_GROUPS = 8
TOPK_GROUPS = 4
TOP_K = 8
D_EXPERT = 512
ROUTED_SCALE = 2.5
BLOCK_ROWS = 256
LN_EPS = 1e-5
RMS_EPS = 1e-5
ALPHA = (2 * DEPTH) ** 0.25
BETA = (8 * DEPTH) ** -0.25
_S0 = D_SSD + CONV_CH + 2 * N_SSD_HEADS
PROJ_SPLITS = (D_SSD, D_SSD + CONV_CH, D_SSD + CONV_CH + N_SSD_HEADS, _S0, _S0 + D_ATTN, _S0 + 2 * D_ATTN)
PROJ_WIDTH = _S0 + 3 * D_ATTN

kernel_name = "hybrid_ssd_diffattn_moe_encoder"


def layer_norm(x, g, b):
    xf = x.astype(jnp.float32)
    mu = jnp.mean(xf, -1, keepdims=True)
    var = jnp.mean(jnp.square(xf - mu), -1, keepdims=True)
    return ((xf - mu) * lax.rsqrt(var + LN_EPS) * g + b).astype(x.dtype)


def rms_norm(x, w):
    xf = x.astype(jnp.float32)
    return xf * lax.rsqrt(jnp.mean(jnp.square(xf), -1, keepdims=True) + RMS_EPS) * w


def centred_depthwise_conv(x, w, b):
    y = lax.conv_general_dilated(x, w[:, None, :].astype(x.dtype), (1,), [(CONV_W // 2, CONV_W // 2)],
                                 dimension_numbers=('NWC', 'WIO', 'NWC'), feature_group_count=x.shape[-1])
    return y + b


def ssd_scan(x, dt, a, b_mat, c_mat):
    f32 = jnp.float32
    bsz, seqlen, nh, hp = x.shape
    ng = b_mat.shape[2]
    r = nh // ng
    nc = -(-seqlen // CHUNK)
    pad = nc * CHUNK - seqlen
    padl = lambda t: jnp.pad(t.astype(f32), [(0, 0), (0, pad)] + [(0, 0)] * (t.ndim - 2))
    x, dt, b_mat, c_mat = padl(x), padl(dt), padl(b_mat), padl(c_mat)
    xc = (x * dt[..., None]).reshape(bsz, nc, CHUNK, ng, r, hp)
    adt = (dt * a.astype(f32)).reshape(bsz, nc, CHUNK, ng, r)
    bc = b_mat.reshape(bsz, nc, CHUNK, ng, D_STATE)
    cc = c_mat.reshape(bsz, nc, CHUNK, ng, D_STATE)
    a_cs = jnp.cumsum(adt, axis=2)
    seg = a_cs[:, :, :, None] - a_cs[:, :, None, :]
    tri = jnp.tril(jnp.ones((CHUNK, CHUNK), bool))
    decay = jnp.exp(jnp.where(tri[:, :, None, None], seg, -jnp.inf))
    cb = jnp.einsum('bclgn,bcsgn->bclsg', cc, bc)
    y_diag = jnp.einsum('bclsgr,bcsgrp->bclgrp', cb[..., None] * decay, xc)
    decay_to_end = jnp.exp(a_cs[:, :, -1:] - a_cs)
    states = jnp.einsum('bcsgn,bcsgr,bcsgrp->bcgrpn', bc, decay_to_end, xc)
    chunk_decay = jnp.exp(a_cs[:, :, -1])

    def step(h, inp):
        s_c, d_c = inp
        return h * d_c[..., None, None] + s_c, h

    h0 = jnp.zeros((bsz, ng, r, hp, D_STATE), f32)
    _, prev = lax.scan(step, h0, (jnp.swapaxes(states, 0, 1), jnp.swapaxes(chunk_decay, 0, 1)))
    prev = jnp.swapaxes(prev, 0, 1)
    y_off = jnp.einsum('bclgn,bcgrpn,bclgr->bclgrp', cc, prev, jnp.exp(a_cs))
    y = (y_diag + y_off).reshape(bsz, nc * CHUNK, nh, hp)
    return y[:, :seqlen]


def alibi_slopes(n):
    return 2.0 ** (-8.0 * jnp.arange(1, n + 1, dtype=jnp.float32) / n)


def diff_attention(q, k, v, lam, norm_w, lambda_init):
    f32 = jnp.float32
    bsz, seqlen = q.shape[:2]
    nb = seqlen // Q_BLOCK
    qb = q.reshape(bsz, nb, Q_BLOCK, N_ATTN_HEADS, 2, ATTN_HEAD_DIM).transpose(1, 0, 3, 4, 2, 5)
    kt = k.transpose(0, 2, 3, 1, 4)
    vt = v.transpose(0, 2, 1, 3)
    slopes = alibi_slopes(N_ATTN_HEADS)
    kpos = jnp.arange(seqlen, dtype=f32)
    scale = ATTN_HEAD_DIM ** -0.5

    def one_block(args):
        q_blk, start = args
        qpos = start + jnp.arange(Q_BLOCK, dtype=f32)
        bias = -slopes[:, None, None] * jnp.abs(qpos[:, None] - kpos[None, :])
        s = jnp.einsum('bhcqd,bhckd->bhcqk', q_blk, kt).astype(f32) * scale + bias[None, :, None]
        p = jax.nn.softmax(s, axis=-1)
        att = p[:, :, 0] - lam * p[:, :, 1]
        return jnp.einsum('bhqk,bhke->bhqe', att.astype(vt.dtype), vt)

    starts = jnp.arange(nb, dtype=f32) * Q_BLOCK
    out = lax.map(one_block, (qb, starts))
    out = out.transpose(1, 0, 3, 2, 4).reshape(bsz, seqlen, N_ATTN_HEADS, 2 * ATTN_HEAD_DIM)
    out = rms_norm(out, norm_w) * (1.0 - lambda_init)
    return out.reshape(bsz, seqlen, D_ATTN)


def mixer(h, w_in, conv_w, conv_b, dt_bias_f, dt_bias_b, a_log_f, a_log_b, d_skip, ssd_norm_w,
          lambda_q1, lambda_k1, lambda_q2, lambda_k2, attn_norm_w, w_out, lambda_init):
    f32 = jnp.float32
    bsz, seqlen, _ = h.shape
    proj = h @ w_in
    z, xbc, dt_f, dt_b, q, k, v = jnp.split(proj, PROJ_SPLITS, axis=-1)
    xbc = jax.nn.silu(centred_depthwise_conv(xbc, conv_w, conv_b))
    xs, bm, cm = jnp.split(xbc, (D_SSD, D_SSD + SSD_GROUPS * D_STATE), axis=-1)
    xs = xs.reshape(bsz, seqlen, N_SSD_HEADS, SSD_HEAD_DIM)
    bm = bm.reshape(bsz, seqlen, SSD_GROUPS, D_STATE)
    cm = cm.reshape(bsz, seqlen, SSD_GROUPS, D_STATE)
    dtf = jax.nn.softplus(dt_f.astype(f32) + dt_bias_f)
    dtb = jax.nn.softplus(dt_b.astype(f32) + dt_bias_b)
    a_f = -jnp.exp(a_log_f.astype(f32))
    a_b = -jnp.exp(a_log_b.astype(f32))
    y_f = ssd_scan(xs, dtf, a_f, bm, cm)
    flip = lambda t: jnp.flip(t, axis=1)
    y_b = flip(ssd_scan(flip(xs), flip(dtb), a_b, flip(bm), flip(cm)))
    y = y_f + y_b + d_skip[:, None] * xs.astype(f32)
    y = y.reshape(bsz, seqlen, D_SSD) * jax.nn.silu(z.astype(f32))
    y = rms_norm(y.reshape(bsz, seqlen, SSD_GROUPS, D_SSD // SSD_GROUPS), 1.0)
    y_ssd = y.reshape(bsz, seqlen, D_SSD) * ssd_norm_w
    q = q.reshape(bsz, seqlen, N_ATTN_HEADS, 2, ATTN_HEAD_DIM)
    k = k.reshape(bsz, seqlen, N_ATTN_HEADS, 2, ATTN_HEAD_DIM)
    v = v.reshape(bsz, seqlen, N_ATTN_HEADS, 2 * ATTN_HEAD_DIM)
    lam = (jnp.exp(jnp.sum(lambda_q1.astype(f32) * lambda_k1.astype(f32)))
           - jnp.exp(jnp.sum(lambda_q2.astype(f32) * lambda_k2.astype(f32))) + lambda_init)
    y_attn = diff_attention(q, k, v, lam, attn_norm_w, lambda_init)
    u = jnp.concatenate([y_ssd.astype(h.dtype), y_attn.astype(h.dtype)], axis=-1)
    return u @ w_out


def moe(h, w_router, router_bias, w_gate_e, w_up_e, w_down_e, w_gate_s, w_up_s, w_down_s):
    f32 = jnp.float32
    bsz, seqlen, d = h.shape
    t = h.reshape(-1, d)
    n_tok = t.shape[0]
    scores = jax.nn.sigmoid((t @ w_router).astype(f32))
    biased = scores + router_bias.astype(f32)
    grp = biased.reshape(n_tok, N_EXPERT_GROUPS, N_EXPERTS // N_EXPERT_GROUPS)
    grp_score = jnp.sum(lax.top_k(grp, 2)[0], axis=-1)
    _, top_g = lax.top_k(grp_score, TOPK_GROUPS)
    gmask = jnp.any(top_g[:, :, None] == jnp.arange(N_EXPERT_GROUPS)[None, None, :], axis=1)
    emask = jnp.repeat(gmask, N_EXPERTS // N_EXPERT_GROUPS, axis=1)
    _, eidx = lax.top_k(jnp.where(emask, biased, -jnp.inf), TOP_K)
    gate = jnp.take_along_axis(scores, eidx, axis=1)
    gate = gate / jnp.sum(gate, -1, keepdims=True) * ROUTED_SCALE
    n_assign = n_tok * TOP_K
    flat_e = eidx.reshape(-1)
    flat_tok = jnp.repeat(jnp.arange(n_tok, dtype=jnp.int32), TOP_K)
    flat_g = gate.reshape(-1)
    order = jnp.argsort(flat_e)
    se, st, sg = flat_e[order], flat_tok[order], flat_g[order]
    counts = jnp.bincount(flat_e, length=N_EXPERTS)
    starts = jnp.cumsum(counts) - counts
    padded = (counts + BLOCK_ROWS - 1) // BLOCK_ROWS * BLOCK_ROWS
    pends = jnp.cumsum(padded)
    pstarts = pends - padded
    dest = pstarts[se] + (jnp.arange(n_assign) - starts[se])
    n_blocks = -(-n_assign // BLOCK_ROWS) + N_EXPERTS
    row_tok = jnp.full((n_blocks * BLOCK_ROWS,), n_tok, jnp.int32).at[dest].set(st)
    row_gate = jnp.zeros((n_blocks * BLOCK_ROWS,), f32).at[dest].set(sg)
    block_exp = jnp.minimum(jnp.searchsorted(pends, jnp.arange(n_blocks) * BLOCK_ROWS, side='right'), N_EXPERTS - 1)
    t_pad = jnp.concatenate([t, jnp.zeros((1, d), t.dtype)], axis=0)

    def body(acc, blk):
        tok, g, e = blk
        xb = t_pad[tok]
        hb = jax.nn.silu(xb @ w_gate_e[e]) * (xb @ w_up_e[e])
        yb = (hb @ w_down_e[e]).astype(f32) * g[:, None]
        return acc.at[tok].add(yb), None

    acc, _ = lax.scan(body, jnp.zeros((n_tok + 1, d), f32),
                      (row_tok.reshape(n_blocks, BLOCK_ROWS), row_gate.reshape(n_blocks, BLOCK_ROWS), block_exp))
    routed = acc[:n_tok]
    shared = ((jax.nn.silu(t @ w_gate_s) * (t @ w_up_s)) @ w_down_s).astype(f32)
    return (routed + shared).astype(h.dtype).reshape(bsz, seqlen, d)


def setup_inputs(seed: int = 0) -> dict:
    key = jax.random.key(seed)
    ks = jax.random.split(key, 32)
    f32 = jnp.float32
    L = DEPTH
    nrm = lambda k, shape, s: jax.random.normal(k, shape, f32) * s

    def dt_bias(k):
        u = jax.random.uniform(k, (L, N_SSD_HEADS), f32)
        dt = jnp.exp(u * (math.log(0.1) - math.log(0.001)) + math.log(0.001))
        return dt + jnp.log(-jnp.expm1(-dt))

    return {
        'x': nrm(ks[0], (BATCH, SEQ, D_MODEL), 1.0),
        'w_in': nrm(ks[1], (L, D_MODEL, PROJ_WIDTH), D_MODEL ** -0.5),
        'conv_w': nrm(ks[2], (L, CONV_W, CONV_CH), CONV_W ** -0.5),
        'conv_b': nrm(ks[3], (L, CONV_CH), 0.01),
        'dt_bias_f': dt_bias(ks[4]),
        'dt_bias_b': dt_bias(ks[5]),
        'a_log_f': jnp.log(jax.random.uniform(ks[6], (L, N_SSD_HEADS), f32, 1.0, 16.0)),
        'a_log_b': jnp.log(jax.random.uniform(ks[7], (L, N_SSD_HEADS), f32, 1.0, 16.0)),
        'd_skip': 1.0 + nrm(ks[8], (L, N_SSD_HEADS), 0.01),
        'ssd_norm_w': 1.0 + nrm(ks[9], (L, D_SSD), 0.01),
        'lambda_q1': nrm(ks[10], (L, ATTN_HEAD_DIM), 0.1),
        'lambda_k1': nrm(ks[11], (L, ATTN_HEAD_DIM), 0.1),
        'lambda_q2': nrm(ks[12], (L, ATTN_HEAD_DIM), 0.1),
        'lambda_k2': nrm(ks[13], (L, ATTN_HEAD_DIM), 0.1),
        'attn_norm_w': 1.0 + nrm(ks[14], (L, 2 * ATTN_HEAD_DIM), 0.01),
        'w_out': nrm(ks[15], (L, MIX_WIDTH, D_MODEL), MIX_WIDTH ** -0.5 * BETA),
        'ln1_g': 1.0 + nrm(ks[16], (L, D_MODEL), 0.01),
        'ln1_b': nrm(ks[17], (L, D_MODEL), 0.01),
        'w_router': nrm(ks[18], (L, D_MODEL, N_EXPERTS), D_MODEL ** -0.5),
        'router_bias': nrm(ks[19], (L, N_EXPERTS), 0.01),
        'w_gate_e': nrm(ks[20], (L, N_EXPERTS, D_MODEL, D_EXPERT), D_MODEL ** -0.5),
        'w_up_e': nrm(ks[21], (L, N_EXPERTS, D_MODEL, D_EXPERT), D_MODEL ** -0.5),
        'w_down_e': nrm(ks[22], (L, N_EXPERTS, D_EXPERT, D_MODEL), D_EXPERT ** -0.5 * BETA),
        'w_gate_s': nrm(ks[23], (L, D_MODEL, D_EXPERT), D_MODEL ** -0.5),
        'w_up_s': nrm(ks[24], (L, D_MODEL, D_EXPERT), D_MODEL ** -0.5),
        'w_down_s': nrm(ks[25], (L, D_EXPERT, D_MODEL), D_EXPERT ** -0.5 * BETA),
        'ln2_g': 1.0 + nrm(ks[26], (L, D_MODEL), 0.01),
        'ln2_b': nrm(ks[27], (L, D_MODEL), 0.01),
    }


def reference(x, w_in, conv_w, conv_b, dt_bias_f, dt_bias_b, a_log_f, a_log_b, d_skip, ssd_norm_w,
              lambda_q1, lambda_k1, lambda_q2, lambda_k2, attn_norm_w, w_out, ln1_g, ln1_b,
              w_router, router_bias, w_gate_e, w_up_e, w_down_e, w_gate_s, w_up_s, w_down_s,
              ln2_g, ln2_b):
    h = x
    for l in range(DEPTH):
        lambda_init = 0.8 - 0.6 * math.exp(-0.3 * l)
        mix = mixer(h, w_in[l], conv_w[l], conv_b[l], dt_bias_f[l], dt_bias_b[l], a_log_f[l], a_log_b[l],
                    d_skip[l], ssd_norm_w[l], lambda_q1[l], lambda_k1[l], lambda_q2[l], lambda_k2[l],
                    attn_norm_w[l], w_out[l], lambda_init)
        h = layer_norm(ALPHA * h + mix, ln1_g[l], ln1_b[l])
        ffn = moe(h, w_router[l], router_bias[l], w_gate_e[l], w_up_e[l], w_down_e[l],
                  w_gate_s[l], w_up_s[l], w_down_s[l])
        h = layer_norm(ALPHA * h + ffn, ln2_g[l], ln2_b[l])
    return h
```

```cpp
#include <hip/hip_runtime.h>
#include <hip/hip_cooperative_groups.h>
#include <cstdio>
#include <cstdint>

namespace {
constexpr int D = 2048, NB = 8, S = 2048, T = NB * S;
constexpr int DSSD = 1024, DATT = 1024, NH = 16, HD = 64, NS = 128, CC = 1536;
constexpr int AH = 8, NE = 64, DE = 512, PW = 5664;
constexpr int O_Z = 0, O_XBC = 1024, O_DTF = 2560, O_DTB = 2576, O_Q = 2592, O_K = 3616, O_V = 4640;
constexpr float ALPHA = 1.189207115002721f;
constexpr float LAMBDA_INIT = 0.2f;
constexpr int NT = 512;

struct Params {
  const float *x, *w_in, *conv_w, *conv_b, *dt_bias_f, *dt_bias_b, *a_log_f, *a_log_b, *d_skip, *ssd_norm_w;
  const float *lq1, *lk1, *lq2, *lk2, *attn_norm_w, *w_out, *ln1_g, *ln1_b, *w_router, *router_bias;
  const float *wg_e, *wu_e, *wd_e, *wg_s, *wu_s, *wd_s, *ln2_g, *ln2_b;
  float* out;
  float *proj, *xc, *dt, *yf, *yb, *u, *h1, *logits, *gate, *hbuf, *acc;
  int *eidx, *cnt, *list;
};

__device__ __forceinline__ float silu_f(float x) { return x / (1.f + __expf(-x)); }
__device__ __forceinline__ float softplus_f(float x) { return x > 20.f ? x : log1pf(__expf(x)); }
__device__ __forceinline__ float wave_sum(float v) { for (int o = 32; o >= 1; o >>= 1) v += __shfl_xor(v, o); return v; }

template <class ARow, class Epi>
__device__ __forceinline__ void gemm_tile(float* smem, int mvalid, int nvalid, int K, ARow arow, const float* Bp, int ldb, Epi epi) {
  float* As = smem;
  float* Bs = smem + 16 * 68;
  const int tid = threadIdx.x, ty = tid >> 5, tx = tid & 31;
  float acc[4][4];
#pragma unroll
  for (int i = 0; i < 4; ++i)
#pragma unroll
    for (int j = 0; j < 4; ++j) acc[i][j] = 0.f;
  const int ak = tid & 15, ar = tid >> 4;
  const float* ap0 = (ar < mvalid) ? arow(ar) : nullptr;
  const float* ap1 = (ar + 32 < mvalid) ? arow(ar + 32) : nullptr;
  const int bn = tid & 127, bk = tid >> 7;
  for (int k0 = 0; k0 < K; k0 += 16) {
    As[ak * 68 + ar] = ap0 ? ap0[k0 + ak] : 0.f;
    As[ak * 68 + ar + 32] = ap1 ? ap1[k0 + ak] : 0.f;
#pragma unroll
    for (int i = 0; i < 4; ++i) { const int kk = bk + 4 * i; Bs[kk * 128 + bn] = (bn < nvalid) ? Bp[(size_t)(k0 + kk) * ldb + bn] : 0.f; }
    __syncthreads();
#pragma unroll
    for (int kk = 0; kk < 16; ++kk) {
      float a[4], b[4];
#pragma unroll
      for (int i = 0; i < 4; ++i) a[i] = As[kk * 68 + ty * 4 + i];
#pragma unroll
      for (int j = 0; j < 4; ++j) b[j] = Bs[kk * 128 + tx * 4 + j];
#pragma unroll
      for (int i = 0; i < 4; ++i)
#pragma unroll
        for (int j = 0; j < 4; ++j) acc[i][j] += a[i] * b[j];
    }
    __syncthreads();
  }
#pragma unroll
  for (int i = 0; i < 4; ++i)
#pragma unroll
    for (int j = 0; j < 4; ++j) { const int r = ty * 4 + i, c = tx * 4 + j; if (r < mvalid && c < nvalid) epi(r, c, acc[i][j]); }
}

__device__ void ph_inproj(const Params& p, float* smem) {
  constexpr int MT = T / 64, NTL = (PW + 127) / 128;
  for (int it = blockIdx.x; it < MT * NTL; it += gridDim.x) {
    const int mt = it / NTL, nt = it % NTL, m0 = mt * 64, n0 = nt * 128;
    const int nvalid = (PW - n0) < 128 ? (PW - n0) : 128;
    gemm_tile(smem, 64, nvalid, D, [&](int r) { return p.x + (size_t)(m0 + r) * D; }, p.w_in + n0, PW,
              [&](int r, int c, float v) { p.proj[(size_t)(m0 + r) * PW + n0 + c] = v; });
  }
}
__device__ void ph_conv(const Params& p) {
  const size_t gtid = (size_t)blockIdx.x * NT + threadIdx.x, gsz = (size_t)gridDim.x * NT;
  for (size_t i = gtid; i < (size_t)T * CC; i += gsz) {
    const int t = (int)(i / CC), c = (int)(i % CC), s = t % S;
    float a = p.conv_b[c];
#pragma unroll
    for (int j = 0; j < 5; ++j) { const int ss = s + j - 2; if (ss >= 0 && ss < S) a += p.conv_w[j * CC + c] * p.proj[(size_t)(t + j - 2) * PW + O_XBC + c]; }
    p.xc[i] = silu_f(a);
  }
  for (size_t i = gtid; i < (size_t)T * 32; i += gsz) {
    const int t = (int)(i / 32), c = (int)(i % 32);
    const float bias = c < 16 ? p.dt_bias_f[c] : p.dt_bias_b[c - 16];
    p.dt[i] = softplus_f(p.proj[(size_t)t * PW + O_DTF + c] + bias);
  }
  if (gtid < NE) p.cnt[gtid] = 0;
}
__device__ void ph_ssd(const Params& p) {
  const int lane = threadIdx.x & 63, wv = threadIdx.x >> 6;
  for (int item = wv * gridDim.x + blockIdx.x; item < NB * NH * 2; item += gridDim.x * 8) {
    const int dir = item & 1, h = (item >> 1) % NH, b = item / (2 * NH), g = h / 8;
    const float a = -__expf(dir ? p.a_log_b[h] : p.a_log_f[h]);
    float st[NS];
#pragma unroll
    for (int n = 0; n < NS; ++n) st[n] = 0.f;
    float* yo = dir ? p.yb : p.yf;
    for (int step = 0; step < S; ++step) {
      const int t = dir ? (S - 1 - step) : step; const size_t tok = (size_t)b * S + t;
      const float dtv = p.dt[tok * 32 + dir * 16 + h];
      const float dA = __expf(a * dtv);
      const float dtx = dtv * p.xc[tok * CC + h * HD + lane];
      const float4* Bp = (const float4*)(p.xc + tok * CC + DSSD + g * NS);
      const float4* Cp = (const float4*)(p.xc + tok * CC + DSSD + 2 * NS + g * NS);
      float y = 0.f;
#pragma unroll
      for (int n4 = 0; n4 < NS / 4; ++n4) {
        const float4 bv = Bp[n4], cv = Cp[n4];
        st[4 * n4 + 0] = st[4 * n4 + 0] * dA + dtx * bv.x; y += st[4 * n4 + 0] * cv.x;
        st[4 * n4 + 1] = st[4 * n4 + 1] * dA + dtx * bv.y; y += st[4 * n4 + 1] * cv.y;
        st[4 * n4 + 2] = st[4 * n4 + 2] * dA + dtx * bv.z; y += st[4 * n4 + 2] * cv.z;
        st[4 * n4 + 3] = st[4 * n4 + 3] * dA + dtx * bv.w; y += st[4 * n4 + 3] * cv.w;
      }
      yo[tok * DSSD + h * HD + lane] = y;
    }
  }
}
__device__ void ph_ssdfin(const Params& p) {
  const int lane = threadIdx.x & 63, wv = threadIdx.x >> 6;
  for (int item = blockIdx.x * 8 + wv; item < T * 2; item += gridDim.x * 8) {
    const int t = item >> 1, g = item & 1;
    float y[8]; float ss = 0.f;
#pragma unroll
    for (int j = 0; j < 8; ++j) {
      const int ch = g * 512 + j * 64 + lane, h = ch / HD;
      const float xs = p.xc[(size_t)t * CC + ch];
      const float z = p.proj[(size_t)t * PW + O_Z + ch];
      const float v = (p.yf[(size_t)t * DSSD + ch] + p.yb[(size_t)t * DSSD + ch] + p.d_skip[h] * xs) * silu_f(z);
      y[j] = v; ss += v * v;
    }
    ss = wave_sum(ss);
    const float rstd = rsqrtf(ss * (1.f / 512.f) + 1e-5f);
#pragma unroll
    for (int j = 0; j < 8; ++j) { const int ch = g * 512 + j * 64 + lane; p.u[(size_t)t * D + ch] = y[j] * rstd * p.ssd_norm_w[ch]; }
  }
}
__device__ void ph_attn(const Params& p, float* smem) {
  float* Ks = smem;
  float* Vs = smem + 64 * 128;
  const int tid = threadIdx.x, r = tid >> 4, c = (tid >> 3) & 1, ds = tid & 7;
  float lam;
  { float s1 = 0.f, s2 = 0.f; for (int i = 0; i < 64; ++i) { s1 += p.lq1[i] * p.lk1[i]; s2 += p.lq2[i] * p.lk2[i]; } lam = __expf(s1) - __expf(s2) + LAMBDA_INIT; }
  for (int item = blockIdx.x; item < NB * AH * (S / 32); item += gridDim.x) {
    const int qt = item % (S / 32), h = (item / (S / 32)) % AH, b = item / ((S / 32) * AH);
    const float slope = exp2f(-(float)(h + 1));
    const int qpos = qt * 32 + r; const size_t qtok = (size_t)b * S + qpos;
    float q[64];
#pragma unroll
    for (int d = 0; d < 64; ++d) q[d] = p.proj[qtok * PW + O_Q + h * 128 + c * 64 + d] * 0.125f;
    float m = -1e30f, l = 0.f, acc[16];
#pragma unroll
    for (int j = 0; j < 16; ++j) acc[j] = 0.f;
    for (int kt = 0; kt < S / 64; ++kt) {
      __syncthreads();
      for (int i = tid; i < 64 * 128; i += NT) { const int key = i >> 7, dd = i & 127; const size_t tok = (size_t)b * S + kt * 64 + key;
        Ks[i] = p.proj[tok * PW + O_K + h * 128 + dd]; Vs[i] = p.proj[tok * PW + O_V + h * 128 + dd]; }
      __syncthreads();
      for (int key = 0; key < 64; ++key) {
        float s = 0.f;
#pragma unroll
        for (int d = 0; d < 64; ++d) s += q[d] * Ks[key * 128 + c * 64 + d];
        const int kpos = kt * 64 + key; const float dist = (float)(qpos > kpos ? qpos - kpos : kpos - qpos);
        s -= slope * dist;
        const float mn = fmaxf(m, s), corr = __expf(m - mn), pe = __expf(s - mn);
        l = l * corr + pe; m = mn;
#pragma unroll
        for (int j = 0; j < 16; ++j) acc[j] = acc[j] * corr + pe * Vs[key * 128 + ds * 16 + j];
      }
    }
    __syncthreads();
    float* X = smem;
    const float il = 1.f / l;
#pragma unroll
    for (int j = 0; j < 16; ++j) X[(r * 2 + c) * 128 + ds * 16 + j] = acc[j] * il;
    __syncthreads();
    float o[16]; float ss = 0.f;
#pragma unroll
    for (int j = 0; j < 16; ++j) { o[j] = X[(r * 2 + 0) * 128 + ds * 16 + j] - lam * X[(r * 2 + 1) * 128 + ds * 16 + j]; ss += o[j] * o[j]; }
    ss += __shfl_xor(ss, 1); ss += __shfl_xor(ss, 2); ss += __shfl_xor(ss, 4);
    const float rstd = rsqrtf(ss * (1.f / 128.f) + 1e-5f);
    if (c == 0) {
#pragma unroll
      for (int j = 0; j < 16; ++j) p.u[qtok * D + DSSD + h * 128 + ds * 16 + j] = o[j] * rstd * p.attn_norm_w[ds * 16 + j] * (1.f - LAMBDA_INIT);
    }
  }
}
__device__ void ph_outproj(const Params& p, float* smem) {
  constexpr int MT = T / 64, NTL = D / 128;
  for (int it = blockIdx.x; it < MT * NTL; it += gridDim.x) {
    const int mt = it / NTL, nt = it % NTL, m0 = mt * 64, n0 = nt * 128;
    gemm_tile(smem, 64, 128, D, [&](int r) { return p.u + (size_t)(m0 + r) * D; }, p.w_out + n0, D,
              [&](int r, int c, float v) { const size_t o = (size_t)(m0 + r) * D + n0 + c; p.h1[o] = ALPHA * p.x[o] + v; });
  }
}
__device__ void ph_ln1(const Params& p) {
  const int lane = threadIdx.x & 63, wv = threadIdx.x >> 6;
  for (int row = blockIdx.x * 8 + wv; row < T; row += gridDim.x * 8) {
    float* hp = p.h1 + (size_t)row * D; float v[32]; float s = 0.f;
#pragma unroll
    for (int j = 0; j < 32; ++j) { v[j] = hp[j * 64 + lane]; s += v[j]; }
    const float mu = wave_sum(s) * (1.f / D); float q = 0.f;
#pragma unroll
    for (int j = 0; j < 32; ++j) { const float d = v[j] - mu; q += d * d; }
    const float rstd = rsqrtf(wave_sum(q) * (1.f / D) + 1e-5f);
#pragma unroll
    for (int j = 0; j < 32; ++j) { const int c = j * 64 + lane; hp[c] = (v[j] - mu) * rstd * p.ln1_g[c] + p.ln1_b[c]; }
  }
  const size_t gtid = (size_t)blockIdx.x * NT + threadIdx.x, gsz = (size_t)gridDim.x * NT;
  for (size_t i = gtid; i < (size_t)T * D; i += gsz) p.acc[i] = 0.f;
}
__device__ void ph_router(const Params& p, float* smem) {
  for (int mt = blockIdx.x; mt < T / 64; mt += gridDim.x) {
    const int m0 = mt * 64;
    gemm_tile(smem, 64, NE, D, [&](int r) { return p.h1 + (size_t)(m0 + r) * D; }, p.w_router, NE,
              [&](int r, int c, float v) { p.logits[(size_t)(m0 + r) * NE + c] = v; });
  }
}
__device__ void ph_route(const Params& p) {
  const int lane = threadIdx.x & 63, wv = threadIdx.x >> 6;
  for (int t = blockIdx.x * 8 + wv; t < T; t += gridDim.x * 8) {
    const float sc = 1.f / (1.f + __expf(-p.logits[(size_t)t * NE + lane]));
    const float bz = sc + p.router_bias[lane];
    int rk = 0;
#pragma unroll
    for (int j = 1; j < 8; ++j) { const float o = __shfl_xor(bz, j); const int oi = lane ^ j; rk += (o > bz || (o == bz && oi < lane)) ? 1 : 0; }
    float gs = rk < 2 ? bz : 0.f;
    gs += __shfl_xor(gs, 1); gs += __shfl_xor(gs, 2); gs += __shfl_xor(gs, 4);
    const int g = lane >> 3; int grk = 0;
#pragma unroll
    for (int j = 1; j < 8; ++j) { const float o = __shfl_xor(gs, j * 8); const int og = g ^ j; grk += (o > gs || (o == gs && og < g)) ? 1 : 0; }
    const bool gsel = grk < 4;
    const float mb = gsel ? bz : -INFINITY;
    int erk = 0;
    for (int j = 1; j < 64; ++j) { const float o = __shfl_xor(mb, j); const int oi = lane ^ j; erk += (o > mb || (o == mb && oi < lane)) ? 1 : 0; }
    const bool sel = gsel && erk < 8;
    const float gsum = wave_sum(sel ? sc : 0.f);
    if (sel) {
      const int slot = t * 8 + erk;
      p.eidx[slot] = lane; p.gate[slot] = sc / gsum * 2.5f;
      const int pos = atomicAdd(&p.cnt[lane], 1);
      p.list[lane * T + pos] = slot;
    }
  }
}
__device__ void ph_gateup(const Params& p, float* smem) {
  constexpr int MTE = T / 64, NTL = DE / 128;
  for (int it = blockIdx.x; it < (NE + 1) * MTE * NTL; it += gridDim.x) {
    const int nt = it % NTL, mt = (it / NTL) % MTE, e = it / (NTL * MTE);
    const int cnt = e < NE ? p.cnt[e] : T, m0 = mt * 64, n0 = nt * 128;
    if (m0 >= cnt) continue;
    const int mvalid = (cnt - m0) < 64 ? (cnt - m0) : 64;
    const int* lst = p.list + (size_t)e * T;
    auto slot_of = [&](int r) { return e < NE ? lst[m0 + r] : T * 8 + m0 + r; };
    auto arow = [&](int r) { const int sl = slot_of(r); const int tok = e < NE ? (sl >> 3) : (m0 + r); return p.h1 + (size_t)tok * D; };
    const float* wg = e < NE ? p.wg_e + (size_t)e * D * DE : p.wg_s;
    const float* wu = e < NE ? p.wu_e + (size_t)e * D * DE : p.wu_s;
    gemm_tile(smem, mvalid, 128, D, arow, wg + n0, DE, [&](int r, int c, float v) { p.hbuf[(size_t)slot_of(r) * DE + n0 + c] = v; });
    gemm_tile(smem, mvalid, 128, D, arow, wu + n0, DE, [&](int r, int c, float v) { float* hp = p.hbuf + (size_t)slot_of(r) * DE + n0 + c; *hp = silu_f(*hp) * v; });
  }
}
__device__ void ph_down(const Params& p, float* smem) {
  constexpr int MTE = T / 64, NTL = D / 128;
  for (int it = blockIdx.x; it < (NE + 1) * MTE * NTL; it += gridDim.x) {
    const int nt = it % NTL, mt = (it / NTL) % MTE, e = it / (NTL * MTE);
    const int cnt = e < NE ? p.cnt[e] : T, m0 = mt * 64, n0 = nt * 128;
    if (m0 >= cnt) continue;
    const int mvalid = (cnt - m0) < 64 ? (cnt - m0) : 64;
    const int* lst = p.list + (size_t)e * T;
    auto slot_of = [&](int r) { return e < NE ? lst[m0 + r] : T * 8 + m0 + r; };
    const float* wd = e < NE ? p.wd_e + (size_t)e * DE * D : p.wd_s;
    gemm_tile(smem, mvalid, 128, DE, [&](int r) { return p.hbuf + (size_t)slot_of(r) * DE; }, wd + n0, D,
              [&](int r, int c, float v) { const int sl = slot_of(r); const int tok = e < NE ? (sl >> 3) : (m0 + r); const float gt = e < NE ? p.gate[sl] : 1.f;
                atomicAdd(&p.acc[(size_t)tok * D + n0 + c], gt * v); });
  }
}
__device__ void ph_ln2(const Params& p) {
  const int lane = threadIdx.x & 63, wv = threadIdx.x >> 6;
  for (int row = blockIdx.x * 8 + wv; row < T; row += gridDim.x * 8) {
    const float* hp = p.h1 + (size_t)row * D; const float* ap = p.acc + (size_t)row * D; float v[32]; float s = 0.f;
#pragma unroll
    for (int j = 0; j < 32; ++j) { v[j] = ALPHA * hp[j * 64 + lane] + ap[j * 64 + lane]; s += v[j]; }
    const float mu = wave_sum(s) * (1.f / D); float q = 0.f;
#pragma unroll
    for (int j = 0; j < 32; ++j) { const float d = v[j] - mu; q += d * d; }
    const float rstd = rsqrtf(wave_sum(q) * (1.f / D) + 1e-5f);
#pragma unroll
    for (int j = 0; j < 32; ++j) { const int c = j * 64 + lane; p.out[(size_t)row * D + c] = (v[j] - mu) * rstd * p.ln2_g[c] + p.ln2_b[c]; }
  }
}

template <int PH>
__global__ void __launch_bounds__(NT) k_phase(Params p) {
  extern __shared__ __attribute__((aligned(16))) float smem[];
  if constexpr (PH == 1) ph_inproj(p, smem);
  if constexpr (PH == 2) ph_conv(p);
  if constexpr (PH == 3) ph_ssd(p);
  if constexpr (PH == 4) ph_ssdfin(p);
  if constexpr (PH == 5) ph_attn(p, smem);
  if constexpr (PH == 6) ph_outproj(p, smem);
  if constexpr (PH == 7) ph_ln1(p);
  if constexpr (PH == 8) ph_router(p, smem);
  if constexpr (PH == 9) ph_route(p);
  if constexpr (PH == 11) ph_gateup(p, smem);
  if constexpr (PH == 12) ph_down(p, smem);
  if constexpr (PH == 13) ph_ln2(p);
}
}

extern "C" void kernel_launch(void* const* d_in, const int* in_sizes, int n_in, void* d_out, int out_size, void* d_ws, size_t ws_size, hipStream_t stream) {
  Params p{};
  const float* const* in = (const float* const*)d_in;
  p.x = in[0]; p.w_in = in[1]; p.conv_w = in[2]; p.conv_b = in[3]; p.dt_bias_f = in[4]; p.dt_bias_b = in[5]; p.a_log_f = in[6]; p.a_log_b = in[7];
  p.d_skip = in[8]; p.ssd_norm_w = in[9]; p.lq1 = in[10]; p.lk1 = in[11]; p.lq2 = in[12]; p.lk2 = in[13]; p.attn_norm_w = in[14]; p.w_out = in[15];
  p.ln1_g = in[16]; p.ln1_b = in[17]; p.w_router = in[18]; p.router_bias = in[19]; p.wg_e = in[20]; p.wu_e = in[21]; p.wd_e = in[22];
  p.wg_s = in[23]; p.wu_s = in[24]; p.wd_s = in[25]; p.ln2_g = in[26]; p.ln2_b = in[27];
  p.out = (float*)d_out;
  float* w = (float*)d_ws; size_t o = 0;
  auto take = [&](size_t n) { float* r = w + o; o += (n + 63) / 64 * 64; return r; };
  p.proj = take((size_t)T * PW); p.xc = take((size_t)T * CC); p.dt = take((size_t)T * 32); p.yf = take((size_t)T * DSSD); p.yb = take((size_t)T * DSSD);
  p.hbuf = p.proj;
  p.acc = p.xc;
  p.u = take((size_t)T * D); p.h1 = take((size_t)T * D); p.logits = take((size_t)T * NE); p.gate = take((size_t)T * 8);
  p.eidx = (int*)take((size_t)T * 8); p.cnt = (int*)take(64); p.list = (int*)take((size_t)NE * T);
  if (o * sizeof(float) > ws_size) { fprintf(stderr, "kernel_launch: ws too small: need %zu have %zu\n", o * sizeof(float), ws_size); return; }
  const size_t SM = 64 * 1024;
  const dim3 blk(NT);
#define LAUNCH(PH, G) hipLaunchKernelGGL(k_phase<PH>, dim3(G), blk, SM, stream, p)
  LAUNCH(1, 2048); LAUNCH(2, 2048); LAUNCH(3, 256); LAUNCH(4, 2048); LAUNCH(5, 4096); LAUNCH(6, 2048); LAUNCH(7, 2048);
  LAUNCH(8, 256); LAUNCH(9, 2048); LAUNCH(11, 4096); LAUNCH(12, 4096); LAUNCH(13, 2048);
#undef LAUNCH
}
```

```cpp
#include <hip/hip_runtime.h>
#include <hip/hip_cooperative_groups.h>
#include <cstdio>
#include <cstdint>

namespace {
constexpr int D = 2048, NB = 8, S = 2048, T = NB * S;
constexpr int DSSD = 1024, DATT = 1024, NH = 16, HD = 64, NS = 128, CC = 1536;
constexpr int AH = 8, NE = 64, DE = 512, PW = 5664;
constexpr int O_Z = 0, O_XBC = 1024, O_DTF = 2560, O_DTB = 2576, O_Q = 2592, O_K = 3616, O_V = 4640;
constexpr float ALPHA = 1.189207115002721f;
constexpr float LAMBDA_INIT = 0.2f;
constexpr int NT = 512;

struct Params {
  const float *x, *w_in, *conv_w, *conv_b, *dt_bias_f, *dt_bias_b, *a_log_f, *a_log_b, *d_skip, *ssd_norm_w;
  const float *lq1, *lk1, *lq2, *lk2, *attn_norm_w, *w_out, *ln1_g, *ln1_b, *w_router, *router_bias;
  const float *wg_e, *wu_e, *wd_e, *wg_s, *wu_s, *wd_s, *ln2_g, *ln2_b;
  float* out;
  float *proj, *xc, *dt, *yf, *yb, *u, *h1, *logits, *gate, *hbuf, *acc;
  int *eidx, *cnt, *list;
};

__device__ __forceinline__ float silu_f(float x) { return x / (1.f + __expf(-x)); }
__device__ __forceinline__ float softplus_f(float x) { return x > 20.f ? x : log1pf(__expf(x)); }
__device__ __forceinline__ float wave_sum(float v) { for (int o = 32; o >= 1; o >>= 1) v += __shfl_xor(v, o); return v; }

template <class ARow, class Epi>
__device__ __forceinline__ void gemm_tile(float* smem, int mvalid, int nvalid, int K, ARow arow, const float* Bp, int ldb, Epi epi) {
  float* As = smem;
  float* Bs = smem + 16 * 68;
  const int tid = threadIdx.x, ty = tid >> 5, tx = tid & 31;
  float acc[4][4];
#pragma unroll
  for (int i = 0; i < 4; ++i)
#pragma unroll
    for (int j = 0; j < 4; ++j) acc[i][j] = 0.f;
  const int ak = tid & 15, ar = tid >> 4;
  const float* ap0 = (ar < mvalid) ? arow(ar) : nullptr;
  const float* ap1 = (ar + 32 < mvalid) ? arow(ar + 32) : nullptr;
  const int bn = tid & 127, bk = tid >> 7;
  for (int k0 = 0; k0 < K; k0 += 16) {
    As[ak * 68 + ar] = ap0 ? ap0[k0 + ak] : 0.f;
    As[ak * 68 + ar + 32] = ap1 ? ap1[k0 + ak] : 0.f;
#pragma unroll
    for (int i = 0; i < 4; ++i) { const int kk = bk + 4 * i; Bs[kk * 128 + bn] = (bn < nvalid) ? Bp[(size_t)(k0 + kk) * ldb + bn] : 0.f; }
    __syncthreads();
#pragma unroll
    for (int kk = 0; kk < 16; ++kk) {
      float a[4], b[4];
#pragma unroll
      for (int i = 0; i < 4; ++i) a[i] = As[kk * 68 + ty * 4 + i];
#pragma unroll
      for (int j = 0; j < 4; ++j) b[j] = Bs[kk * 128 + tx * 4 + j];
#pragma unroll
      for (int i = 0; i < 4; ++i)
#pragma unroll
        for (int j = 0; j < 4; ++j) acc[i][j] += a[i] * b[j];
    }
    __syncthreads();
  }
#pragma unroll
  for (int i = 0; i < 4; ++i)
#pragma unroll
    for (int j = 0; j < 4; ++j) { const int r = ty * 4 + i, c = tx * 4 + j; if (r < mvalid && c < nvalid) epi(r, c, acc[i][j]); }
}

__device__ void ph_inproj(const Params& p, float* smem) {
  constexpr int MT = T / 64, NTL = (PW + 127) / 128;
  for (int it = blockIdx.x; it < MT * NTL; it += gridDim.x) {
    const int mt = it / NTL, nt = it % NTL, m0 = mt * 64, n0 = nt * 128;
    const int nvalid = (PW - n0) < 128 ? (PW - n0) : 128;
    gemm_tile(smem, 64, nvalid, D, [&](int r) { return p.x + (size_t)(m0 + r) * D; }, p.w_in + n0, PW,
              [&](int r, int c, float v) { p.proj[(size_t)(m0 + r) * PW + n0 + c] = v; });
  }
}
__device__ void ph_conv(const Params& p) {
  const size_t gtid = (size_t)blockIdx.x * NT + threadIdx.x, gsz = (size_t)gridDim.x * NT;
  for (size_t i = gtid; i < (size_t)T * CC; i += gsz) {
    const int t = (int)(i / CC), c = (int)(i % CC), s = t % S;
    float a = p.conv_b[c];
#pragma unroll
    for (int j = 0; j < 5; ++j) { const int ss = s + j - 2; if (ss >= 0 && ss < S) a += p.conv_w[j * CC + c] * p.proj[(size_t)(t + j - 2) * PW + O_XBC + c]; }
    p.xc[i] = silu_f(a);
  }
  for (size_t i = gtid; i < (size_t)T * 32; i += gsz) {
    const int t = (int)(i / 32), c = (int)(i % 32);
    const float bias = c < 16 ? p.dt_bias_f[c] : p.dt_bias_b[c - 16];
    p.dt[i] = softplus_f(p.proj[(size_t)t * PW + O_DTF + c] + bias);
  }
  if (gtid < NE) p.cnt[gtid] = 0;
}
__device__ void ph_ssd(const Params& p) {
  const int lane = threadIdx.x & 63, wv = threadIdx.x >> 6;
  for (int item = wv * gridDim.x + blockIdx.x; item < NB * NH * 2; item += gridDim.x * 8) {
    const int dir = item & 1, h = (item >> 1) % NH, b = item / (2 * NH), g = h / 8;
    const float a = -__expf(dir ? p.a_log_b[h] : p.a_log_f[h]);
    float st[NS];
#pragma unroll
    for (int n = 0; n < NS; ++n) st[n] = 0.f;
    float* yo = dir ? p.yb : p.yf;
    for (int step = 0; step < S; ++step) {
      const int t = dir ? (S - 1 - step) : step; const size_t tok = (size_t)b * S + t;
      const float dtv = p.dt[tok * 32 + dir * 16 + h];
      const float dA = __expf(a * dtv);
      const float dtx = dtv * p.xc[tok * CC + h * HD + lane];
      const float4* Bp = (const float4*)(p.xc + tok * CC + DSSD + g * NS);
      const float4* Cp = (const float4*)(p.xc + tok * CC + DSSD + 2 * NS + g * NS);
      float y = 0.f;
#pragma unroll
      for (int n4 = 0; n4 < NS / 4; ++n4) {
        const float4 bv = Bp[n4], cv = Cp[n4];
        st[4 * n4 + 0] = st[4 * n4 + 0] * dA + dtx * bv.x; y += st[4 * n4 + 0] * cv.x;
        st[4 * n4 + 1] = st[4 * n4 + 1] * dA + dtx * bv.y; y += st[4 * n4 + 1] * cv.y;
        st[4 * n4 + 2] = st[4 * n4 + 2] * dA + dtx * bv.z; y += st[4 * n4 + 2] * cv.z;
        st[4 * n4 + 3] = st[4 * n4 + 3] * dA + dtx * bv.w; y += st[4 * n4 + 3] * cv.w;
      }
      yo[tok * DSSD + h * HD + lane] = y;
    }
  }
}
__device__ void ph_ssdfin(const Params& p) {
  const int lane = threadIdx.x & 63, wv = threadIdx.x >> 6;
  for (int item = blockIdx.x * 8 + wv; item < T * 2; item += gridDim.x * 8) {
    const int t = item >> 1, g = item & 1;
    float y[8]; float ss = 0.f;
#pragma unroll
    for (int j = 0; j < 8; ++j) {
      const int ch = g * 512 + j * 64 + lane, h = ch / HD;
      const float xs = p.xc[(size_t)t * CC + ch];
      const float z = p.proj[(size_t)t * PW + O_Z + ch];
      const float v = (p.yf[(size_t)t * DSSD + ch] + p.yb[(size_t)t * DSSD + ch] + p.d_skip[h] * xs) * silu_f(z);
      y[j] = v; ss += v * v;
    }
    ss = wave_sum(ss);
    const float rstd = rsqrtf(ss * (1.f / 512.f) + 1e-5f);
#pragma unroll
    for (int j = 0; j < 8; ++j) { const int ch = g * 512 + j * 64 + lane; p.u[(size_t)t * D + ch] = y[j] * rstd * p.ssd_norm_w[ch]; }
  }
}
__device__ void ph_attn(const Params& p, float* smem) {
  float* Ks = smem;
  float* Vs = smem + 64 * 128;
  const int tid = threadIdx.x, r = tid >> 4, c = (tid >> 3) & 1, ds = tid & 7;
  float lam;
  { float s1 = 0.f, s2 = 0.f; for (int i = 0; i < 64; ++i) { s1 += p.lq1[i] * p.lk1[i]; s2 += p.lq2[i] * p.lk2[i]; } lam = __expf(s1) - __expf(s2) + LAMBDA_INIT; }
  for (int item = blockIdx.x; item < NB * AH * (S / 32); item += gridDim.x) {
    const int qt = item % (S / 32), h = (item / (S / 32)) % AH, b = item / ((S / 32) * AH);
    const float slope = exp2f(-(float)(h + 1));
    const int qpos = qt * 32 + r; const size_t qtok = (size_t)b * S + qpos;
    float q[64];
#pragma unroll
    for (int d = 0; d < 64; ++d) q[d] = p.proj[qtok * PW + O_Q + h * 128 + c * 64 + d] * 0.125f;
    float m = -1e30f, l = 0.f, acc[16];
#pragma unroll
    for (int j = 0; j < 16; ++j) acc[j] = 0.f;
    for (int kt = 0; kt < S / 64; ++kt) {
      __syncthreads();
      for (int i = tid; i < 64 * 128; i += NT) { const int key = i >> 7, dd = i & 127; const size_t tok = (size_t)b * S + kt * 64 + key;
        Ks[i] = p.proj[tok * PW + O_K + h * 128 + dd]; Vs[i] = p.proj[tok * PW + O_V + h * 128 + dd]; }
      __syncthreads();
      for (int key = 0; key < 64; ++key) {
        float s = 0.f;
#pragma unroll
        for (int d = 0; d < 64; ++d) s += q[d] * Ks[key * 128 + c * 64 + d];
        const int kpos = kt * 64 + key; const float dist = (float)(qpos > kpos ? qpos - kpos : kpos - qpos);
        s -= slope * dist;
        const float mn = fmaxf(m, s), corr = __expf(m - mn), pe = __expf(s - mn);
        l = l * corr + pe; m = mn;
#pragma unroll
        for (int j = 0; j < 16; ++j) acc[j] = acc[j] * corr + pe * Vs[key * 128 + ds * 16 + j];
      }
    }
    __syncthreads();
    float* X = smem;
    const float il = 1.f / l;
#pragma unroll
    for (int j = 0; j < 16; ++j) X[(r * 2 + c) * 128 + ds * 16 + j] = acc[j] * il;
    __syncthreads();
    float o[16]; float ss = 0.f;
#pragma unroll
    for (int j = 0; j < 16; ++j) { o[j] = X[(r * 2 + 0) * 128 + ds * 16 + j] - lam * X[(r * 2 + 1) * 128 + ds * 16 + j]; ss += o[j] * o[j]; }
    ss += __shfl_xor(ss, 1); ss += __shfl_xor(ss, 2); ss += __shfl_xor(ss, 4);
    const float rstd = rsqrtf(ss * (1.f / 128.f) + 1e-5f);
    if (c == 0) {
#pragma unroll
      for (int j = 0; j < 16; ++j) p.u[qtok * D + DSSD + h * 128 + ds * 16 + j] = o[j] * rstd * p.attn_norm_w[ds * 16 + j] * (1.f - LAMBDA_INIT);
    }
  }
}
__device__ void ph_outproj(const Params& p, float* smem) {
  constexpr int MT = T / 64, NTL = D / 128;
  for (int it = blockIdx.x; it < MT * NTL; it += gridDim.x) {
    const int mt = it / NTL, nt = it % NTL, m0 = mt * 64, n0 = nt * 128;
    gemm_tile(smem, 64, 128, D, [&](int r) { return p.u + (size_t)(m0 + r) * D; }, p.w_out + n0, D,
              [&](int r, int c, float v) { const size_t o = (size_t)(m0 + r) * D + n0 + c; p.h1[o] = ALPHA * p.x[o] + v; });
  }
}
__device__ void ph_ln1(const Params& p) {
  const int lane = threadIdx.x & 63, wv = threadIdx.x >> 6;
  for (int row = blockIdx.x * 8 + wv; row < T; row += gridDim.x * 8) {
    float* hp = p.h1 + (size_t)row * D; float v[32]; float s = 0.f;
#pragma unroll
    for (int j = 0; j < 32; ++j) { v[j] = hp[j * 64 + lane]; s += v[j]; }
    const float mu = wave_sum(s) * (1.f / D); float q = 0.f;
#pragma unroll
    for (int j = 0; j < 32; ++j) { const float d = v[j] - mu; q += d * d; }
    const float rstd = rsqrtf(wave_sum(q) * (1.f / D) + 1e-5f);
#pragma unroll
    for (int j = 0; j < 32; ++j) { const int c = j * 64 + lane; hp[c] = (v[j] - mu) * rstd * p.ln1_g[c] + p.ln1_b[c]; }
  }
  const size_t gtid = (size_t)blockIdx.x * NT + threadIdx.x, gsz = (size_t)gridDim.x * NT;
  for (size_t i = gtid; i < (size_t)T * D; i += gsz) p.acc[i] = 0.f;
}
__device__ void ph_router(const Params& p, float* smem) {
  for (int mt = blockIdx.x; mt < T / 64; mt += gridDim.x) {
    const int m0 = mt * 64;
    gemm_tile(smem, 64, NE, D, [&](int r) { return p.h1 + (size_t)(m0 + r) * D; }, p.w_router, NE,
              [&](int r, int c, float v) { p.logits[(size_t)(m0 + r) * NE + c] = v; });
  }
}
__device__ void ph_route(const Params& p) {
  const int lane = threadIdx.x & 63, wv = threadIdx.x >> 6;
  for (int t = blockIdx.x * 8 + wv; t < T; t += gridDim.x * 8) {
    const float sc = 1.f / (1.f + __expf(-p.logits[(size_t)t * NE + lane]));
    const float bz = sc + p.router_bias[lane];
    int rk = 0;
#pragma unroll
    for (int j = 1; j < 8; ++j) { const float o = __shfl_xor(bz, j); const int oi = lane ^ j; rk += (o > bz || (o == bz && oi < lane)) ? 1 : 0; }
    float gs = rk < 2 ? bz : 0.f;
    gs += __shfl_xor(gs, 1); gs += __shfl_xor(gs, 2); gs += __shfl_xor(gs, 4);
    const int g = lane >> 3; int grk = 0;
#pragma unroll
    for (int j = 1; j < 8; ++j) { const float o = __shfl_xor(gs, j * 8); const int og = g ^ j; grk += (o > gs || (o == gs && og < g)) ? 1 : 0; }
    const bool gsel = grk < 4;
    const float mb = gsel ? bz : -INFINITY;
    int erk = 0;
    for (int j = 1; j < 64; ++j) { const float o = __shfl_xor(mb, j); const int oi = lane ^ j; erk += (o > mb || (o == mb && oi < lane)) ? 1 : 0; }
    const bool sel = gsel && erk < 8;
    const float gsum = wave_sum(sel ? sc : 0.f);
    if (sel) {
      const int slot = t * 8 + erk;
      p.eidx[slot] = lane; p.gate[slot] = sc / gsum * 2.5f;
      const int pos = atomicAdd(&p.cnt[lane], 1);
      p.list[lane * T + pos] = slot;
    }
  }
}
__device__ void ph_gateup(const Params& p, float* smem) {
  constexpr int MTE = T / 64, NTL = DE / 128;
  for (int it = blockIdx.x; it < (NE + 1) * MTE * NTL; it += gridDim.x) {
    const int nt = it % NTL, mt = (it / NTL) % MTE, e = it / (NTL * MTE);
    const int cnt = e < NE ? p.cnt[e] : T, m0 = mt * 64, n0 = nt * 128;
    if (m0 >= cnt) continue;
    const int mvalid = (cnt - m0) < 64 ? (cnt - m0) : 64;
    const int* lst = p.list + (size_t)e * T;
    auto slot_of = [&](int r) { return e < NE ? lst[m0 + r] : T * 8 + m0 + r; };
    auto arow = [&](int r) { const int sl = slot_of(r); const int tok = e < NE ? (sl >> 3) : (m0 + r); return p.h1 + (size_t)tok * D; };
    const float* wg = e < NE ? p.wg_e + (size_t)e * D * DE : p.wg_s;
    const float* wu = e < NE ? p.wu_e + (size_t)e * D * DE : p.wu_s;
    gemm_tile(smem, mvalid, 128, D, arow, wg + n0, DE, [&](int r, int c, float v) { p.hbuf[(size_t)slot_of(r) * DE + n0 + c] = v; });
    gemm_tile(smem, mvalid, 128, D, arow, wu + n0, DE, [&](int r, int c, float v) { float* hp = p.hbuf + (size_t)slot_of(r) * DE + n0 + c; *hp = silu_f(*hp) * v; });
  }
}
__device__ void ph_down(const Params& p, float* smem) {
  constexpr int MTE = T / 64, NTL = D / 128;
  for (int it = blockIdx.x; it < (NE + 1) * MTE * NTL; it += gridDim.x) {
    const int nt = it % NTL, mt = (it / NTL) % MTE, e = it / (NTL * MTE);
    const int cnt = e < NE ? p.cnt[e] : T, m0 = mt * 64, n0 = nt * 128;
    if (m0 >= cnt) continue;
    const int mvalid = (cnt - m0) < 64 ? (cnt - m0) : 64;
    const int* lst = p.list + (size_t)e * T;
    auto slot_of = [&](int r) { return e < NE ? lst[m0 + r] : T * 8 + m0 + r; };
    const float* wd = e < NE ? p.wd_e + (size_t)e * DE * D : p.wd_s;
    gemm_tile(smem, mvalid, 128, DE, [&](int r) { return p.hbuf + (size_t)slot_of(r) * DE; }, wd + n0, D,
              [&](int r, int c, float v) { const int sl = slot_of(r); const int tok = e < NE ? (sl >> 3) : (m0 + r); const float gt = e < NE ? p.gate[sl] : 1.f;
                atomicAdd(&p.acc[(size_t)tok * D + n0 + c], gt * v); });
  }
}
__device__ void ph_ln2(const Params& p) {
  const int lane = threadIdx.x & 63, wv = threadIdx.x >> 6;
  for (int row = blockIdx.x * 8 + wv; row < T; row += gridDim.x * 8) {
    const float* hp = p.h1 + (size_t)row * D; const float* ap = p.acc + (size_t)row * D; float v[32]; float s = 0.f;
#pragma unroll
    for (int j = 0; j < 32; ++j) { v[j] = ALPHA * hp[j * 64 + lane] + ap[j * 64 + lane]; s += v[j]; }
    const float mu = wave_sum(s) * (1.f / D); float q = 0.f;
#pragma unroll
    for (int j = 0; j < 32; ++j) { const float d = v[j] - mu; q += d * d; }
    const float rstd = rsqrtf(wave_sum(q) * (1.f / D) + 1e-5f);
#pragma unroll
    for (int j = 0; j < 32; ++j) { const int c = j * 64 + lane; p.out[(size_t)row * D + c] = (v[j] - mu) * rstd * p.ln2_g[c] + p.ln2_b[c]; }
  }
}

template <int PH>
__global__ void __launch_bounds__(NT) k_phase(Params p) {
  extern __shared__ __attribute__((aligned(16))) float smem[];
  if constexpr (PH == 1) ph_inproj(p, smem);
  if constexpr (PH == 2) ph_conv(p);
  if constexpr (PH == 3) ph_ssd(p);
  if constexpr (PH == 4) ph_ssdfin(p);
  if constexpr (PH == 5) ph_attn(p, smem);
  if constexpr (PH == 6) ph_outproj(p, smem);
  if constexpr (PH == 7) ph_ln1(p);
  if constexpr (PH == 8) ph_router(p, smem);
  if constexpr (PH == 9) ph_route(p);
  if constexpr (PH == 11) ph_gateup(p, smem);
  if constexpr (PH == 12) ph_down(p, smem);
  if constexpr (PH == 13) ph_ln2(p);
}

__global__ void __launch_bounds__(NT) k_mega(Params p) {
  extern __shared__ __attribute__((aligned(16))) float smem[];
  cooperative_groups::grid_group grid = cooperative_groups::this_grid();
  ph_inproj(p, smem); grid.sync();
  ph_conv(p); grid.sync();
  ph_ssd(p); ph_attn(p, smem); grid.sync();
  ph_ssdfin(p); grid.sync();
  ph_outproj(p, smem); grid.sync();
  ph_ln1(p); grid.sync();
  ph_router(p, smem); grid.sync();
  ph_route(p); grid.sync();
  ph_gateup(p, smem); grid.sync();
  ph_down(p, smem); grid.sync();
  ph_ln2(p);
}
}

extern "C" void kernel_launch(void* const* d_in, const int* in_sizes, int n_in, void* d_out, int out_size, void* d_ws, size_t ws_size, hipStream_t stream) {
  Params p{};
  const float* const* in = (const float* const*)d_in;
  p.x = in[0]; p.w_in = in[1]; p.conv_w = in[2]; p.conv_b = in[3]; p.dt_bias_f = in[4]; p.dt_bias_b = in[5]; p.a_log_f = in[6]; p.a_log_b = in[7];
  p.d_skip = in[8]; p.ssd_norm_w = in[9]; p.lq1 = in[10]; p.lk1 = in[11]; p.lq2 = in[12]; p.lk2 = in[13]; p.attn_norm_w = in[14]; p.w_out = in[15];
  p.ln1_g = in[16]; p.ln1_b = in[17]; p.w_router = in[18]; p.router_bias = in[19]; p.wg_e = in[20]; p.wu_e = in[21]; p.wd_e = in[22];
  p.wg_s = in[23]; p.wu_s = in[24]; p.wd_s = in[25]; p.ln2_g = in[26]; p.ln2_b = in[27];
  p.out = (float*)d_out;
  float* w = (float*)d_ws; size_t o = 0;
  auto take = [&](size_t n) { float* r = w + o; o += (n + 63) / 64 * 64; return r; };
  p.proj = take((size_t)T * PW); p.xc = take((size_t)T * CC); p.dt = take((size_t)T * 32); p.yf = take((size_t)T * DSSD); p.yb = take((size_t)T * DSSD);
  p.hbuf = p.proj;
  p.acc = p.xc;
  p.u = take((size_t)T * D); p.h1 = take((size_t)T * D); p.logits = take((size_t)T * NE); p.gate = take((size_t)T * 8);
  p.eidx = (int*)take((size_t)T * 8); p.cnt = (int*)take(64); p.list = (int*)take((size_t)NE * T);
  if (o * sizeof(float) > ws_size) { fprintf(stderr, "kernel_launch: ws too small: need %zu have %zu\n", o * sizeof(float), ws_size); return; }
  constexpr size_t SM = 64 * 1024;
  static int grid_blocks = 0;
  if (!grid_blocks) {
    int dev = 0, cus = 0, per_cu = 0;
    hipGetDevice(&dev);
    hipDeviceGetAttribute(&cus, hipDeviceAttributeMultiprocessorCount, dev);
    hipOccupancyMaxActiveBlocksPerMultiprocessor(&per_cu, k_mega, NT, SM);
    if (per_cu < 1) { fprintf(stderr, "kernel_launch: occupancy query says 0 blocks/CU\n"); return; }
    grid_blocks = cus;
  }
  void* args[] = {&p};
  hipError_t e = hipLaunchCooperativeKernel((void*)k_mega, dim3(grid_blocks), dim3(NT), args, SM, stream);
  if (e != hipSuccess) fprintf(stderr, "cooperative launch failed: %s (grid %d)\n", hipGetErrorString(e), grid_blocks);
}
```

```cpp
#include <hip/hip_runtime.h>
#include <hip/hip_cooperative_groups.h>
#include <cstdio>
#include <cstdint>

namespace {
constexpr int D = 2048, NB = 8, S = 2048, T = NB * S;
constexpr int DSSD = 1024, DATT = 1024, NH = 16, HD = 64, NS = 128, CC = 1536;
constexpr int AH = 8, NE = 64, DE = 512, PW = 5664;
constexpr int O_DT = 2560, O_Q = 2592;
constexpr int N_Z = 0, N_XBC = 1024, N_Q = 2560, N_K = 3584, N_V = 4608, PLD = 5632, NPROJ = 5888;
constexpr float ALPHA = 1.189207115002721f;
constexpr float LAMBDA_INIT = 0.2f;
constexpr float LOG2E = 1.4426950408889634f;
constexpr float QS = 0.125f * LOG2E;
constexpr int NT = 512;
constexpr int LDS_BYTES = 152 * 1024;

typedef unsigned short bf16_t;

struct Params {
  const float *x, *w_in, *conv_w, *conv_b, *dt_bias_f, *dt_bias_b, *a_log_f, *a_log_b, *d_skip, *ssd_norm_w;
  const float *lq1, *lk1, *lq2, *lk2, *attn_norm_w, *w_out, *ln1_g, *ln1_b, *w_router, *router_bias;
  const float *wg_e, *wu_e, *wd_e, *wg_s, *wu_s, *wd_s, *ln2_g, *ln2_b;
  float* out;
  bf16_t *xb, *WinT, *WoutT, *proj, *u;
  float *xc, *dt, *yf, *yb, *h1, *logits, *gate, *hbuf, *acc;
  int *eidx, *cnt, *list;
};

__device__ __forceinline__ float silu_f(float x) { return x / (1.f + __expf(-x)); }
__device__ __forceinline__ float softplus_f(float x) { return x > 20.f ? x : log1pf(__expf(x)); }
__device__ __forceinline__ float wave_sum(float v) { for (int o = 32; o >= 1; o >>= 1) v += __shfl_xor(v, o); return v; }
__device__ __forceinline__ float bf2f(bf16_t b) { return __uint_as_float(((unsigned)b) << 16); }
__device__ __forceinline__ bf16_t f2bf(float f) { unsigned u = __float_as_uint(f); u += 0x7FFFu + ((u >> 16) & 1u); return (bf16_t)(u >> 16); }
}

namespace pg8 {
#define PG8_LAS __attribute__((address_space(3)))
typedef unsigned short bf16_t;
typedef short bf16x8 __attribute__((ext_vector_type(8)));
typedef float f32x4 __attribute__((ext_vector_type(4)));
typedef unsigned u32x4 __attribute__((ext_vector_type(4)));
constexpr int BM = 256, BK = 64, HALF = 128, HTB = HALF * BK * 2  , STAGE_BYTES = 8 * HTB, NXCD = 8, WGM = 8;

__host__ __device__ __forceinline__ int lds_byte(int r, int c) { const int st = (r >> 4) * 2 + (c >> 5), rr = r & 15, cc = c & 31, ob = rr * 64 + cc * 2; return st * 1024 + (ob ^ (((ob >> 9) & 1) << 5)); }
__host__ __device__ __forceinline__ void stage_rc(int b, int& R, int& C) { const int st = b / 1024, sb = b % 1024, swz = sb ^ (((sb >> 9) & 1) << 5); R = (st >> 1) * 16 + swz / 64; C = (st & 1) * 32 + (swz % 64) / 2; }
__host__ __device__ __forceinline__ int perm32(int rho) { const int n = rho >> 4, i = rho & 15; return 8 * (i >> 2) + 4 * n + (i & 3); }

struct Unit { int pm, pn, bn; };
struct Gemm { const bf16_t* A; const bf16_t* Bt; int K; };


__device__ __forceinline__ unsigned cvt_pk_bf16(float lo, float hi) { unsigned r; asm volatile("v_cvt_pk_bf16_f32 %0, %1, %2" : "=v"(r) : "v"(lo), "v"(hi)); return r; }
struct OrderStatic {
    int nM, nN, nwg, G, c;
    __device__ void init(int M, int N, int G_, int c_) { nM = M / BM; nN = N / BM; nwg = nM * nN; G = G_; c = c_; }
    __device__ bool next(int i, Unit& u) const {
        const long L = (long)i * G + c; if (L >= nwg) return false;
        int wgid = (int)L; { const int q = nwg / NXCD, r = nwg % NXCD, xcd = wgid % NXCD, off = wgid / NXCD; wgid = (xcd < r ? xcd * (q + 1) : r * (q + 1) + (xcd - r) * q) + off; }
        const int nig = WGM * nN, gid = wgid / nig, fm = gid * WGM, gsz = (nM - fm) < WGM ? (nM - fm) : WGM;
        u.pm = fm + ((wgid % nig) % gsz); u.pn = (wgid % nig) / gsz; u.bn = u.pn; return true;
    }
    __device__ __forceinline__ unsigned row_off(int, int) const { return 0u; }
};
template <bool GATHER, class Epi, class Sched>
__device__ __forceinline__ void gemm_phase(PG8_LAS unsigned char* lds, const Gemm g, const Sched& S, const Epi& E) {
    const int tid = threadIdx.x, wid = __builtin_amdgcn_readfirstlane(tid >> 6), lane = tid & 63, wr = wid >> 2, wc = wid & 3, fr = lane & 15, fq = lane >> 4;
    const int K = g.K, nt = K / BK;
#define PG8_STAMP() do {} while (0)
    PG8_STAMP();
    unsigned voffA[2], voffB[2];
#pragma unroll
    for (int i = 0; i < 2; ++i) { int R, C; stage_rc(tid * 16 + i * 8192, R, C); const int Rb = Epi::PERM ? ((R & ~31) + perm32(R & 31)) : R;
        voffA[i] = (unsigned)(R * K + C) * 2u; voffB[i] = (unsigned)(Rb * K + C) * 2u; }
    unsigned voffG[2][2] = {{0u, 0u}, {0u, 0u}};
#define PG8_LOADG(uidx) do { if constexpr (GATHER) { _Pragma("unroll") for (int _h = 0; _h < 2; ++_h) _Pragma("unroll") for (int _i = 0; _i < 2; ++_i) { int R_, C_; stage_rc(tid * 16 + _i * 8192, R_, C_); \
        voffG[_h][_i] = S.row_off((uidx), _h * HALF + R_) + (unsigned)C_ * 2u; } } } while (0)
    const size_t kstep = (size_t)(BK * 2);
    const size_t hstep = (size_t)HALF * K * 2;
    const size_t tstep = 2 * hstep;
    const unsigned ldsw = (unsigned)wid * 1024u;
    const int aoff = lds_byte(wr * 64 + fr, fq * 8), boff = lds_byte(wc * 32 + fr, fq * 8);
#define PG8_SA(b, h) (((b) * 2 + (h)) * HTB)
#define PG8_SB(b, h) ((4 + (b) * 2 + (h)) * HTB)
#define PG8_STAGE(bufoff, gbase, voff) do { _Pragma("unroll") for (int _i = 0; _i < 2; ++_i) \
        __builtin_amdgcn_global_load_lds((const unsigned*)((const char*)(gbase) + (voff)[_i]), (PG8_LAS unsigned*)(lds + (bufoff) + ldsw + _i * 8192), 16, 0, 0); } while (0)
#define PG8_STAGE_A(bufoff, ptr, h) do { if constexpr (GATHER) { PG8_STAGE(bufoff, ptr, voffG[h]); } else { PG8_STAGE(bufoff, (ptr) + (h) * hstep, voffA); } } while (0)
#define PG8_LDA(dst, b, h) do { _Pragma("unroll") for (int m = 0; m < 4; ++m) _Pragma("unroll") for (int k = 0; k < 2; ++k) dst[m][k] = *(const PG8_LAS bf16x8*)(lds + PG8_SA(b, h) + aoff + m * 2048 + k * 1024); } while (0)
#define PG8_LDB(dst, b, h) do { _Pragma("unroll") for (int n = 0; n < 2; ++n) _Pragma("unroll") for (int k = 0; k < 2; ++k) dst[n][k] = *(const PG8_LAS bf16x8*)(lds + PG8_SB(b, h) + boff + n * 2048 + k * 1024); } while (0)
#define PG8_MMA(ai, bj, At, Bt) do { __builtin_amdgcn_s_setprio(1); _Pragma("unroll") for (int m = 0; m < 4; ++m) _Pragma("unroll") for (int n = 0; n < 2; ++n) _Pragma("unroll") for (int k = 0; k < 2; ++k) \
        acc[ai][bj][m][n] = __builtin_amdgcn_mfma_f32_16x16x32_bf16(Bt[n][k], At[m][k], acc[ai][bj][m][n], 0, 0, 0); __builtin_amdgcn_s_setprio(0); } while (0)
#define PG8_WAIT_V(n) asm volatile("s_waitcnt vmcnt(" #n ")" ::: "memory")
#define PG8_WAIT_L(n) asm volatile("s_waitcnt lgkmcnt(" #n ")" ::: "memory")
#define PG8_BAR __builtin_amdgcn_s_barrier()
#define PG8_SCHED __builtin_amdgcn_sched_barrier(0)
    Unit cur, nxt; int ui = 0;
    if (!S.next(0, cur)) return;
    f32x4 acc[2][2][4][2];
#pragma unroll
    for (int a = 0; a < 2; ++a)
#pragma unroll
        for (int b = 0; b < 2; ++b)
#pragma unroll
            for (int m = 0; m < 4; ++m)
#pragma unroll
                for (int n = 0; n < 2; ++n) acc[a][b][m][n] = (f32x4){0.f, 0.f, 0.f, 0.f};
    bf16x8 At[4][2], B0[2][2], B1[2][2];
    const char* cA = GATHER ? (const char*)g.A : (const char*)g.A + (size_t)cur.pm * tstep; const char* cB = (const char*)g.Bt + (size_t)cur.bn * tstep;
    PG8_LOADG(0);
    PG8_STAGE(PG8_SB(0, 0), cB, voffB); PG8_STAGE_A(PG8_SA(0, 0), cA, 0); PG8_STAGE(PG8_SB(0, 1), cB + hstep, voffB); PG8_STAGE_A(PG8_SA(0, 1), cA, 1);
    if (wr == 1) PG8_BAR;
    PG8_WAIT_V(4); PG8_BAR;
    PG8_STAGE(PG8_SB(1, 0), cB + kstep, voffB); PG8_STAGE_A(PG8_SA(1, 0), cA + kstep, 0); PG8_STAGE(PG8_SB(1, 1), cB + hstep + kstep, voffB);
    PG8_WAIT_V(6); PG8_BAR;
    PG8_STAMP();
    for (;;) {
        const bool has_next = S.next(ui + 1, nxt);
        const char* nA = has_next ? (GATHER ? (const char*)g.A : (const char*)g.A + (size_t)nxt.pm * tstep) : cA; const char* nB = has_next ? (const char*)g.Bt + (size_t)nxt.bn * tstep : cB;
        for (int t = 0; t < nt; t += 2) {
            const bool last = (t == nt - 2);
            const char* a1 = cA + (size_t)(t + 1) * kstep;
            const char* a2 = last ? nA : cA + (size_t)(t + 2) * kstep; const char* b2 = last ? nB : cB + (size_t)(t + 2) * kstep;
            const char* a3 = a2 + kstep; const char* b3 = b2 + kstep;
            PG8_LDB(B0, 0, 0); PG8_SCHED; PG8_LDA(At, 0, 0); PG8_STAGE_A(PG8_SA(1, 1), a1, 1);
            PG8_WAIT_L(8); PG8_BAR; PG8_WAIT_L(0); PG8_MMA(0, 0, At, B0); PG8_BAR; PG8_SCHED;
            if (last && has_next) PG8_LOADG(ui + 1);
            PG8_LDB(B1, 0, 1); PG8_STAGE(PG8_SB(0, 0), b2, voffB);
            PG8_BAR; PG8_WAIT_L(0); PG8_MMA(0, 1, At, B1); PG8_BAR;
            PG8_LDA(At, 0, 1); PG8_STAGE_A(PG8_SA(0, 0), a2, 0);
            PG8_BAR; PG8_WAIT_L(0); PG8_MMA(1, 0, At, B0); PG8_BAR; PG8_SCHED;
            PG8_STAGE(PG8_SB(0, 1), b2 + hstep, voffB);
            PG8_WAIT_V(6); PG8_BAR; PG8_MMA(1, 1, At, B1); PG8_BAR;
            PG8_LDB(B0, 1, 0); PG8_SCHED; PG8_LDA(At, 1, 0); PG8_STAGE_A(PG8_SA(0, 1), a2, 1);
            PG8_WAIT_L(8); PG8_BAR; PG8_WAIT_L(0); PG8_MMA(0, 0, At, B0); PG8_BAR; PG8_SCHED;
            PG8_LDB(B1, 1, 1); PG8_STAGE(PG8_SB(1, 0), b3, voffB);
            PG8_BAR; PG8_WAIT_L(0); PG8_MMA(0, 1, At, B1); PG8_BAR;
            PG8_LDA(At, 1, 1); PG8_STAGE_A(PG8_SA(1, 0), a3, 0);
            PG8_BAR; PG8_WAIT_L(0); PG8_MMA(1, 0, At, B0); PG8_BAR; PG8_SCHED;
            PG8_STAGE(PG8_SB(1, 1), b3 + hstep, voffB);
            PG8_WAIT_V(6); PG8_BAR; PG8_MMA(1, 1, At, B1); PG8_BAR;
        }
        PG8_STAMP();
        E(acc, cur, wr, wc, fr, fq);
        PG8_STAMP();
        if (!has_next) break;
#pragma unroll
        for (int a = 0; a < 2; ++a)
#pragma unroll
            for (int b = 0; b < 2; ++b)
#pragma unroll
                for (int m = 0; m < 4; ++m)
#pragma unroll
                    for (int n = 0; n < 2; ++n) acc[a][b][m][n] = (f32x4){0.f, 0.f, 0.f, 0.f};
        cur = nxt; cA = nA; cB = nB; ++ui;
    }
    PG8_WAIT_V(0);
    if (wr == 0) PG8_BAR;
    PG8_BAR;
    PG8_STAMP();
#undef PG8_STAMP
#undef PG8_SA
#undef PG8_SB
#undef PG8_STAGE
#undef PG8_STAGE_A
#undef PG8_LOADG
#undef PG8_LDA
#undef PG8_LDB
#undef PG8_MMA
#undef PG8_WAIT_V
#undef PG8_WAIT_L
#undef PG8_BAR
#undef PG8_SCHED
}
}
namespace {
using pg8::f32x4; using pg8::u32x4; using pg8::cvt_pk_bf16;
#define LAS __attribute__((address_space(3)))

template <class ARow, class Epi>
__device__ __forceinline__ void gemm_tile(float* smem, int mvalid, int nvalid, int K, ARow arow, const float* Bp, int ldb, Epi epi) {
  float* As = smem;
  float* Bs = smem + 16 * 68;
  const int tid = threadIdx.x, ty = tid >> 5, tx = tid & 31;
  float acc[4][4];
#pragma unroll
  for (int i = 0; i < 4; ++i)
#pragma unroll
    for (int j = 0; j < 4; ++j) acc[i][j] = 0.f;
  const int ak = tid & 15, ar = tid >> 4;
  const float* ap0 = (ar < mvalid) ? arow(ar) : nullptr;
  const float* ap1 = (ar + 32 < mvalid) ? arow(ar + 32) : nullptr;
  const int bn = tid & 127, bk = tid >> 7;
  for (int k0 = 0; k0 < K; k0 += 16) {
    As[ak * 68 + ar] = ap0 ? ap0[k0 + ak] : 0.f;
    As[ak * 68 + ar + 32] = ap1 ? ap1[k0 + ak] : 0.f;
#pragma unroll
    for (int i = 0; i < 4; ++i) { const int kk = bk + 4 * i; Bs[kk * 128 + bn] = (bn < nvalid) ? Bp[(size_t)(k0 + kk) * ldb + bn] : 0.f; }
    __syncthreads();
#pragma unroll
    for (int kk = 0; kk < 16; ++kk) {
      float a[4], b[4];
#pragma unroll
      for (int i = 0; i < 4; ++i) a[i] = As[kk * 68 + ty * 4 + i];
#pragma unroll
      for (int j = 0; j < 4; ++j) b[j] = Bs[kk * 128 + tx * 4 + j];
#pragma unroll
      for (int i = 0; i < 4; ++i)
#pragma unroll
        for (int j = 0; j < 4; ++j) acc[i][j] += a[i] * b[j];
    }
    __syncthreads();
  }
#pragma unroll
  for (int i = 0; i < 4; ++i)
#pragma unroll
    for (int j = 0; j < 4; ++j) { const int r = ty * 4 + i, c = tx * 4 + j; if (r < mvalid && c < nvalid) epi(r, c, acc[i][j]); }
}

template <class RowMap>
__device__ __forceinline__ void cvt_tile(const float* __restrict__ src, int N, int K, int k0, int n0, bf16_t* __restrict__ dst, RowMap rm) {
  const int lane = threadIdx.x & 63, w = threadIdx.x >> 6;
  const int n = n0 + (lane & 15) * 4, kk = k0 + (w * 4 + (lane >> 4)) * 8;
  if (n >= N) return;
  float4 v[8];
#pragma unroll
  for (int j = 0; j < 8; ++j) v[j] = *(const float4*)(src + (size_t)(kk + j) * N + n);
  u32x4 o;
  o.x = cvt_pk_bf16(v[0].x, v[1].x); o.y = cvt_pk_bf16(v[2].x, v[3].x); o.z = cvt_pk_bf16(v[4].x, v[5].x); o.w = cvt_pk_bf16(v[6].x, v[7].x);
  *(u32x4*)(dst + (size_t)rm(n + 0) * K + kk) = o;
  o.x = cvt_pk_bf16(v[0].y, v[1].y); o.y = cvt_pk_bf16(v[2].y, v[3].y); o.z = cvt_pk_bf16(v[4].y, v[5].y); o.w = cvt_pk_bf16(v[6].y, v[7].y);
  *(u32x4*)(dst + (size_t)rm(n + 1) * K + kk) = o;
  o.x = cvt_pk_bf16(v[0].z, v[1].z); o.y = cvt_pk_bf16(v[2].z, v[3].z); o.z = cvt_pk_bf16(v[4].z, v[5].z); o.w = cvt_pk_bf16(v[6].z, v[7].z);
  *(u32x4*)(dst + (size_t)rm(n + 2) * K + kk) = o;
  o.x = cvt_pk_bf16(v[0].w, v[1].w); o.y = cvt_pk_bf16(v[2].w, v[3].w); o.z = cvt_pk_bf16(v[4].w, v[5].w); o.w = cvt_pk_bf16(v[6].w, v[7].w);
  *(u32x4*)(dst + (size_t)rm(n + 3) * K + kk) = o;
}
template <class RowMap>
__device__ void cvt_job(const float* src, int nmat, int K, int N, bf16_t* dst, size_t dstride, RowMap rm) {
  const int kt = K / 256, ntl = (N + 63) / 64, per = kt * ntl;
  for (int it = blockIdx.x; it < nmat * per; it += gridDim.x) {
    const int m = it / per, r = it % per, k0 = (r / ntl) * 256, n0 = (r % ntl) * 64;
    cvt_tile(src + (size_t)m * K * N, N, K, k0, n0, dst + (size_t)m * dstride, rm);
  }
}
__device__ void ph_convert(const Params& p) {
  const size_t gtid = (size_t)blockIdx.x * NT + threadIdx.x, gsz = (size_t)gridDim.x * NT;
  for (size_t i = gtid; i < (size_t)T * D / 8; i += gsz) {
    const float4 a = *(const float4*)(p.x + i * 8), b = *(const float4*)(p.x + i * 8 + 4);
    u32x4 o; o.x = cvt_pk_bf16(a.x, a.y); o.y = cvt_pk_bf16(a.z, a.w); o.z = cvt_pk_bf16(b.x, b.y); o.w = cvt_pk_bf16(b.z, b.w);
    *(u32x4*)(p.xb + i * 8) = o;
  }
  cvt_job(p.w_in, 1, D, PW, p.WinT, 0, [](int n) { return n < O_DT ? n : (n < O_Q ? PLD + (n - O_DT) : n - 32); });
  for (size_t i = gtid; i < (size_t)(NPROJ - PW) * D / 8; i += gsz) *(u32x4*)(p.WinT + (size_t)PW * D + i * 8) = (u32x4){0u, 0u, 0u, 0u};
  cvt_job(p.w_out, 1, D, D, p.WoutT, 0, [](int n) { return n; });
}

struct EpiProj {
  static constexpr bool PERM = true;
  bf16_t* proj; float* dt; const float* bias_f; const float* bias_b;
  __device__ __forceinline__ void operator()(const f32x4 (&acc)[2][2][4][2], const pg8::Unit& u, int wr, int wc, int fr, int fq) const {
    const int row0 = u.pm * 256 + wr * 64 + fr;
    if (u.pn < 22) {
      const int col0 = u.pn * 256 + wc * 32 + 8 * fq;
      const float sc = (u.pn >= 10 && u.pn < 14) ? QS : 1.0f;
#pragma unroll
      for (int ai = 0; ai < 2; ++ai)
#pragma unroll
        for (int m = 0; m < 4; ++m) { bf16_t* rowp = proj + (size_t)(row0 + ai * 128 + m * 16) * PLD + col0;
#pragma unroll
          for (int bj = 0; bj < 2; ++bj) { const f32x4 v0 = acc[ai][bj][m][0] * sc, v1 = acc[ai][bj][m][1] * sc;
            u32x4 w; w.x = cvt_pk_bf16(v0[0], v0[1]); w.y = cvt_pk_bf16(v0[2], v0[3]); w.z = cvt_pk_bf16(v1[0], v1[1]); w.w = cvt_pk_bf16(v1[2], v1[3]);
            *(u32x4*)(rowp + bj * 128) = w; } }
    } else if (wc == 0) {
      const int c0 = 8 * fq;
      float bs[8];
#pragma unroll
      for (int j = 0; j < 8; ++j) bs[j] = (c0 + j) < 16 ? bias_f[c0 + j] : bias_b[c0 + j - 16];
#pragma unroll
      for (int ai = 0; ai < 2; ++ai)
#pragma unroll
        for (int m = 0; m < 4; ++m) { float* rowp = dt + (size_t)(row0 + ai * 128 + m * 16) * 32 + c0;
          const f32x4 v0 = acc[ai][0][m][0], v1 = acc[ai][0][m][1];
          f32x4 o0, o1;
#pragma unroll
          for (int j = 0; j < 4; ++j) { o0[j] = softplus_f(v0[j] + bs[j]); o1[j] = softplus_f(v1[j] + bs[4 + j]); }
          *(f32x4*)rowp = o0; *(f32x4*)(rowp + 4) = o1; }
    }
  }
};
struct EpiOut {
  static constexpr bool PERM = false;
  const float* x; float* v;
  __device__ __forceinline__ void operator()(const f32x4 (&acc)[2][2][4][2], const pg8::Unit& u, int wr, int wc, int fr, int fq) const {
    const int row0 = u.pm * 256 + wr * 64 + fr, col0 = u.pn * 256 + wc * 32 + 4 * fq;
#pragma unroll
    for (int ai = 0; ai < 2; ++ai)
#pragma unroll
      for (int m = 0; m < 4; ++m) { const size_t off = (size_t)(row0 + ai * 128 + m * 16) * D + col0;
#pragma unroll
        for (int bj = 0; bj < 2; ++bj)
#pragma unroll
          for (int n = 0; n < 2; ++n) { const f32x4 xv = *(const f32x4*)(x + off + bj * 128 + n * 16); *(f32x4*)(v + off + bj * 128 + n * 16) = xv * ALPHA + acc[ai][bj][m][n]; } }
  }
};

__device__ void ph_inproj(const Params& p, LAS unsigned char* lds) {
  pg8::Gemm g{p.xb, p.WinT, D}; pg8::OrderStatic Sd; Sd.init(T, NPROJ, gridDim.x, blockIdx.x);
  EpiProj E{p.proj, p.dt, p.dt_bias_f, p.dt_bias_b};
  pg8::gemm_phase<false>(lds, g, Sd, E);
}
__device__ void ph_conv(const Params& p) {
  const size_t gtid = (size_t)blockIdx.x * NT + threadIdx.x, gsz = (size_t)gridDim.x * NT;
  for (size_t i = gtid; i < (size_t)T * CC; i += gsz) {
    const int t = (int)(i / CC), c = (int)(i % CC), s = t % S;
    float a = p.conv_b[c];
#pragma unroll
    for (int j = 0; j < 5; ++j) { const int ss = s + j - 2; if (ss >= 0 && ss < S) a += p.conv_w[j * CC + c] * bf2f(p.proj[(size_t)(t + j - 2) * PLD + N_XBC + c]); }
    p.xc[i] = silu_f(a);
  }
  if (gtid < NE) p.cnt[gtid] = 0;
}
__device__ void ph_ssd(const Params& p) {
  const int lane = threadIdx.x & 63, wv = threadIdx.x >> 6;
  for (int item = wv * gridDim.x + blockIdx.x; item < NB * NH * 2; item += gridDim.x * 8) {
    const int dir = item & 1, h = (item >> 1) % NH, b = item / (2 * NH), g = h / 8;
    const float a = -__expf(dir ? p.a_log_b[h] : p.a_log_f[h]);
    float st[NS];
#pragma unroll
    for (int n = 0; n < NS; ++n) st[n] = 0.f;
    float* yo = dir ? p.yb : p.yf;
    for (int step = 0; step < S; ++step) {
      const int t = dir ? (S - 1 - step) : step; const size_t tok = (size_t)b * S + t;
      const float dtv = p.dt[tok * 32 + dir * 16 + h];
      const float dA = __expf(a * dtv);
      const float dtx = dtv * p.xc[tok * CC + h * HD + lane];
      const float4* Bp = (const float4*)(p.xc + tok * CC + DSSD + g * NS);
      const float4* Cp = (const float4*)(p.xc + tok * CC + DSSD + 2 * NS + g * NS);
      float y = 0.f;
#pragma unroll
      for (int n4 = 0; n4 < NS / 4; ++n4) {
        const float4 bv = Bp[n4], cv = Cp[n4];
        st[4 * n4 + 0] = st[4 * n4 + 0] * dA + dtx * bv.x; y += st[4 * n4 + 0] * cv.x;
        st[4 * n4 + 1] = st[4 * n4 + 1] * dA + dtx * bv.y; y += st[4 * n4 + 1] * cv.y;
        st[4 * n4 + 2] = st[4 * n4 + 2] * dA + dtx * bv.z; y += st[4 * n4 + 2] * cv.z;
        st[4 * n4 + 3] = st[4 * n4 + 3] * dA + dtx * bv.w; y += st[4 * n4 + 3] * cv.w;
      }
      yo[tok * DSSD + h * HD + lane] = y;
    }
  }
}
__device__ void ph_ssdfin(const Params& p) {
  const int lane = threadIdx.x & 63, wv = threadIdx.x >> 6;
  for (int item = blockIdx.x * 8 + wv; item < T * 2; item += gridDim.x * 8) {
    const int t = item >> 1, g = item & 1;
    float y[8]; float ss = 0.f;
#pragma unroll
    for (int j = 0; j < 8; ++j) {
      const int ch = g * 512 + j * 64 + lane, h = ch / HD;
      const float xs = p.xc[(size_t)t * CC + ch];
      const float z = bf2f(p.proj[(size_t)t * PLD + N_Z + ch]);
      const float v = (p.yf[(size_t)t * DSSD + ch] + p.yb[(size_t)t * DSSD + ch] + p.d_skip[h] * xs) * silu_f(z);
      y[j] = v; ss += v * v;
    }
    ss = wave_sum(ss);
    const float rstd = rsqrtf(ss * (1.f / 512.f) + 1e-5f);
#pragma unroll
    for (int j = 0; j < 8; ++j) { const int ch = g * 512 + j * 64 + lane; p.u[(size_t)t * D + ch] = f2bf(y[j] * rstd * p.ssd_norm_w[ch]); }
  }
}
__device__ void ph_attn(const Params& p, float* smem) {
  float* Ks = smem;
  float* Vs = smem + 64 * 128;
  const int tid = threadIdx.x, r = tid >> 4, c = (tid >> 3) & 1, ds = tid & 7;
  float lam;
  { float s1 = 0.f, s2 = 0.f; for (int i = 0; i < 64; ++i) { s1 += p.lq1[i] * p.lk1[i]; s2 += p.lq2[i] * p.lk2[i]; } lam = __expf(s1) - __expf(s2) + LAMBDA_INIT; }
  for (int item = blockIdx.x; item < NB * AH * (S / 32); item += gridDim.x) {
    const int qt = item % (S / 32), h = (item / (S / 32)) % AH, b = item / ((S / 32) * AH);
    const float slope = exp2f(-(float)(h + 1)) * LOG2E;
    const int qpos = qt * 32 + r; const size_t qtok = (size_t)b * S + qpos;
    float q[64];
#pragma unroll
    for (int d = 0; d < 64; ++d) q[d] = bf2f(p.proj[qtok * PLD + N_Q + h * 128 + c * 64 + d]);
    float m = -1e30f, l = 0.f, acc[16];
#pragma unroll
    for (int j = 0; j < 16; ++j) acc[j] = 0.f;
    for (int kt = 0; kt < S / 64; ++kt) {
      __syncthreads();
      for (int i = tid; i < 64 * 128; i += NT) { const int key = i >> 7, dd = i & 127; const size_t tok = (size_t)b * S + kt * 64 + key;
        Ks[i] = bf2f(p.proj[tok * PLD + N_K + h * 128 + dd]); Vs[i] = bf2f(p.proj[tok * PLD + N_V + h * 128 + dd]); }
      __syncthreads();
      for (int key = 0; key < 64; ++key) {
        float s = 0.f;
#pragma unroll
        for (int d = 0; d < 64; ++d) s += q[d] * Ks[key * 128 + c * 64 + d];
        const int kpos = kt * 64 + key; const float dist = (float)(qpos > kpos ? qpos - kpos : kpos - qpos);
        s -= slope * dist;
        const float mn = fmaxf(m, s), corr = exp2f(m - mn), pe = exp2f(s - mn);
        l = l * corr + pe; m = mn;
#pragma unroll
        for (int j = 0; j < 16; ++j) acc[j] = acc[j] * corr + pe * Vs[key * 128 + ds * 16 + j];
      }
    }
    __syncthreads();
    float* X = smem;
    const float il = 1.f / l;
#pragma unroll
    for (int j = 0; j < 16; ++j) X[(r * 2 + c) * 128 + ds * 16 + j] = acc[j] * il;
    __syncthreads();
    float o[16]; float ss = 0.f;
#pragma unroll
    for (int j = 0; j < 16; ++j) { o[j] = X[(r * 2 + 0) * 128 + ds * 16 + j] - lam * X[(r * 2 + 1) * 128 + ds * 16 + j]; ss += o[j] * o[j]; }
    ss += __shfl_xor(ss, 1); ss += __shfl_xor(ss, 2); ss += __shfl_xor(ss, 4);
    const float rstd = rsqrtf(ss * (1.f / 128.f) + 1e-5f);
    if (c == 0) {
#pragma unroll
      for (int j = 0; j < 16; ++j) p.u[qtok * D + DSSD + h * 128 + ds * 16 + j] = f2bf(o[j] * rstd * p.attn_norm_w[ds * 16 + j] * (1.f - LAMBDA_INIT));
    }
    __syncthreads();
  }
}
__device__ void ph_outproj(const Params& p, LAS unsigned char* lds) {
  pg8::Gemm g{p.u, p.WoutT, D}; pg8::OrderStatic Sd; Sd.init(T, D, gridDim.x, blockIdx.x);
  EpiOut E{p.x, p.h1};
  pg8::gemm_phase<false>(lds, g, Sd, E);
}
__device__ void ph_ln1(const Params& p) {
  const int lane = threadIdx.x & 63, wv = threadIdx.x >> 6;
  for (int row = blockIdx.x * 8 + wv; row < T; row += gridDim.x * 8) {
    float* hp = p.h1 + (size_t)row * D; float v[32]; float s = 0.f;
#pragma unroll
    for (int j = 0; j < 32; ++j) { v[j] = hp[j * 64 + lane]; s += v[j]; }
    const float mu = wave_sum(s) * (1.f / D); float q = 0.f;
#pragma unroll
    for (int j = 0; j < 32; ++j) { const float d = v[j] - mu; q += d * d; }
    const float rstd = rsqrtf(wave_sum(q) * (1.f / D) + 1e-5f);
#pragma unroll
    for (int j = 0; j < 32; ++j) { const int c = j * 64 + lane; hp[c] = (v[j] - mu) * rstd * p.ln1_g[c] + p.ln1_b[c]; }
  }
  const size_t gtid = (size_t)blockIdx.x * NT + threadIdx.x, gsz = (size_t)gridDim.x * NT;
  for (size_t i = gtid; i < (size_t)T * D; i += gsz) p.acc[i] = 0.f;
}
__device__ void ph_router(const Params& p, float* smem) {
  for (int mt = blockIdx.x; mt < T / 64; mt += gridDim.x) {
    const int m0 = mt * 64;
    gemm_tile(smem, 64, NE, D, [&](int r) { return p.h1 + (size_t)(m0 + r) * D; }, p.w_router, NE,
              [&](int r, int c, float v) { p.logits[(size_t)(m0 + r) * NE + c] = v; });
  }
}
__device__ void ph_route(const Params& p) {
  const int lane = threadIdx.x & 63, wv = threadIdx.x >> 6;
  for (int t = blockIdx.x * 8 + wv; t < T; t += gridDim.x * 8) {
    const float sc = 1.f / (1.f + __expf(-p.logits[(size_t)t * NE + lane]));
    const float bz = sc + p.router_bias[lane];
    int rk = 0;
#pragma unroll
    for (int j = 1; j < 8; ++j) { const float o = __shfl_xor(bz, j); const int oi = lane ^ j; rk += (o > bz || (o == bz && oi < lane)) ? 1 : 0; }
    float gs = rk < 2 ? bz : 0.f;
    gs += __shfl_xor(gs, 1); gs += __shfl_xor(gs, 2); gs += __shfl_xor(gs, 4);
    const int g = lane >> 3; int grk = 0;
#pragma unroll
    for (int j = 1; j < 8; ++j) { const float o = __shfl_xor(gs, j * 8); const int og = g ^ j; grk += (o > gs || (o == gs && og < g)) ? 1 : 0; }
    const bool gsel = grk < 4;
    const float mb = gsel ? bz : -INFINITY;
    int erk = 0;
    for (int j = 1; j < 64; ++j) { const float o = __shfl_xor(mb, j); const int oi = lane ^ j; erk += (o > mb || (o == mb && oi < lane)) ? 1 : 0; }
    const bool sel = gsel && erk < 8;
    const float gsum = wave_sum(sel ? sc : 0.f);
    if (sel) {
      const int slot = t * 8 + erk;
      p.eidx[slot] = lane; p.gate[slot] = sc / gsum * 2.5f;
      const int pos = atomicAdd(&p.cnt[lane], 1);
      p.list[lane * T + pos] = slot;
    }
  }
}
__device__ void ph_gateup(const Params& p, float* smem) {
  constexpr int MTE = T / 64, NTL = DE / 128;
  for (int it = blockIdx.x; it < (NE + 1) * MTE * NTL; it += gridDim.x) {
    const int nt = it % NTL, mt = (it / NTL) % MTE, e = it / (NTL * MTE);
    const int cnt = e < NE ? p.cnt[e] : T, m0 = mt * 64, n0 = nt * 128;
    if (m0 >= cnt) continue;
    const int mvalid = (cnt - m0) < 64 ? (cnt - m0) : 64;
    const int* lst = p.list + (size_t)e * T;
    auto slot_of = [&](int r) { return e < NE ? lst[m0 + r] : T * 8 + m0 + r; };
    auto arow = [&](int r) { const int sl = slot_of(r); const int tok = e < NE ? (sl >> 3) : (m0 + r); return p.h1 + (size_t)tok * D; };
    const float* wg = e < NE ? p.wg_e + (size_t)e * D * DE : p.wg_s;
    const float* wu = e < NE ? p.wu_e + (size_t)e * D * DE : p.wu_s;
    gemm_tile(smem, mvalid, 128, D, arow, wg + n0, DE, [&](int r, int c, float v) { p.hbuf[(size_t)slot_of(r) * DE + n0 + c] = v; });
    gemm_tile(smem, mvalid, 128, D, arow, wu + n0, DE, [&](int r, int c, float v) { float* hp = p.hbuf + (size_t)slot_of(r) * DE + n0 + c; *hp = silu_f(*hp) * v; });
  }
}
__device__ void ph_down(const Params& p, float* smem) {
  constexpr int MTE = T / 64, NTL = D / 128;
  for (int it = blockIdx.x; it < (NE + 1) * MTE * NTL; it += gridDim.x) {
    const int nt = it % NTL, mt = (it / NTL) % MTE, e = it / (NTL * MTE);
    const int cnt = e < NE ? p.cnt[e] : T, m0 = mt * 64, n0 = nt * 128;
    if (m0 >= cnt) continue;
    const int mvalid = (cnt - m0) < 64 ? (cnt - m0) : 64;
    const int* lst = p.list + (size_t)e * T;
    auto slot_of = [&](int r) { return e < NE ? lst[m0 + r] : T * 8 + m0 + r; };
    const float* wd = e < NE ? p.wd_e + (size_t)e * DE * D : p.wd_s;
    gemm_tile(smem, mvalid, 128, DE, [&](int r) { return p.hbuf + (size_t)slot_of(r) * DE; }, wd + n0, D,
              [&](int r, int c, float v) { const int sl = slot_of(r); const int tok = e < NE ? (sl >> 3) : (m0 + r); const float gt = e < NE ? p.gate[sl] : 1.f;
                atomicAdd(&p.acc[(size_t)tok * D + n0 + c], gt * v); });
  }
}
__device__ void ph_ln2(const Params& p) {
  const int lane = threadIdx.x & 63, wv = threadIdx.x >> 6;
  for (int row = blockIdx.x * 8 + wv; row < T; row += gridDim.x * 8) {
    const float* hp = p.h1 + (size_t)row * D; const float* ap = p.acc + (size_t)row * D; float v[32]; float s = 0.f;
#pragma unroll
    for (int j = 0; j < 32; ++j) { v[j] = ALPHA * hp[j * 64 + lane] + ap[j * 64 + lane]; s += v[j]; }
    const float mu = wave_sum(s) * (1.f / D); float q = 0.f;
#pragma unroll
    for (int j = 0; j < 32; ++j) { const float d = v[j] - mu; q += d * d; }
    const float rstd = rsqrtf(wave_sum(q) * (1.f / D) + 1e-5f);
#pragma unroll
    for (int j = 0; j < 32; ++j) { const int c = j * 64 + lane; p.out[(size_t)row * D + c] = (v[j] - mu) * rstd * p.ln2_g[c] + p.ln2_b[c]; }
  }
}

__global__ void __launch_bounds__(NT) k_mega(Params p) {
  extern __shared__ __attribute__((aligned(16))) unsigned char lds_raw[];
  LAS unsigned char* lds = (LAS unsigned char*)lds_raw;
  float* smem = (float*)lds_raw;
  cooperative_groups::grid_group grid = cooperative_groups::this_grid();
  ph_convert(p); grid.sync();
  ph_inproj(p, lds); grid.sync();
  ph_conv(p); grid.sync();
  ph_ssd(p); ph_attn(p, smem); grid.sync();
  ph_ssdfin(p); grid.sync();
  ph_outproj(p, lds); grid.sync();
  ph_ln1(p); grid.sync();
  ph_router(p, smem); grid.sync();
  ph_route(p); grid.sync();
  ph_gateup(p, smem); grid.sync();
  ph_down(p, smem); grid.sync();
  ph_ln2(p);
}
}

extern "C" void kernel_launch(void* const* d_in, const int* in_sizes, int n_in, void* d_out, int out_size, void* d_ws, size_t ws_size, hipStream_t stream) {
  Params p{};
  const float* const* in = (const float* const*)d_in;
  p.x = in[0]; p.w_in = in[1]; p.conv_w = in[2]; p.conv_b = in[3]; p.dt_bias_f = in[4]; p.dt_bias_b = in[5]; p.a_log_f = in[6]; p.a_log_b = in[7];
  p.d_skip = in[8]; p.ssd_norm_w = in[9]; p.lq1 = in[10]; p.lk1 = in[11]; p.lq2 = in[12]; p.lk2 = in[13]; p.attn_norm_w = in[14]; p.w_out = in[15];
  p.ln1_g = in[16]; p.ln1_b = in[17]; p.w_router = in[18]; p.router_bias = in[19]; p.wg_e = in[20]; p.wu_e = in[21]; p.wd_e = in[22];
  p.wg_s = in[23]; p.wu_s = in[24]; p.wd_s = in[25]; p.ln2_g = in[26]; p.ln2_b = in[27];
  p.out = (float*)d_out;
  char* w = (char*)d_ws; size_t o = 0;
  auto take = [&](size_t bytes) { char* r = w + o; o += (bytes + 255) / 256 * 256; return r; };
  p.xb = (bf16_t*)take((size_t)T * D * 2); p.WinT = (bf16_t*)take((size_t)NPROJ * D * 2); p.WoutT = (bf16_t*)take((size_t)D * D * 2);
  char* regA = w + o;
  p.proj = (bf16_t*)take((size_t)T * PLD * 2); p.xc = (float*)take((size_t)T * CC * 4); p.dt = (float*)take((size_t)T * 32 * 4);
  p.yf = (float*)take((size_t)T * DSSD * 4); p.yb = (float*)take((size_t)T * DSSD * 4);
  const size_t regA_bytes = (size_t)((w + o) - regA);
  p.hbuf = (float*)regA;
  if ((size_t)(T * 8 + T) * DE * 4 > regA_bytes) { fprintf(stderr, "kernel_launch: region A too small for hbuf\n"); return; }
  p.u = (bf16_t*)take((size_t)T * D * 2); p.h1 = (float*)take((size_t)T * D * 4); p.acc = (float*)take((size_t)T * D * 4);
  p.logits = (float*)take((size_t)T * NE * 4); p.gate = (float*)take((size_t)T * 8 * 4);
  p.eidx = (int*)take((size_t)T * 8 * 4); p.cnt = (int*)take(256); p.list = (int*)take((size_t)NE * T * 4);
  if (o > ws_size) { fprintf(stderr, "kernel_launch: ws too small: need %zu have %zu\n", o, ws_size); return; }
  static int grid_blocks = 0;
  if (!grid_blocks) {
    int dev = 0, cus = 0, per_cu = 0;
    hipGetDevice(&dev);
    hipDeviceGetAttribute(&cus, hipDeviceAttributeMultiprocessorCount, dev);
    if (hipFuncSetAttribute((const void*)k_mega, hipFuncAttributeMaxDynamicSharedMemorySize, LDS_BYTES) != hipSuccess) { fprintf(stderr, "kernel_launch: hipFuncSetAttribute failed\n"); return; }
    hipOccupancyMaxActiveBlocksPerMultiprocessor(&per_cu, k_mega, NT, LDS_BYTES);
    if (per_cu < 1) { fprintf(stderr, "kernel_launch: occupancy query says 0 blocks/CU\n"); return; }
    grid_blocks = cus;
  }
  void* args[] = {&p};
  hipError_t e = hipLaunchCooperativeKernel((void*)k_mega, dim3(grid_blocks), dim3(NT), args, LDS_BYTES, stream);
  if (e != hipSuccess) fprintf(stderr, "cooperative launch failed: %s (grid %d)\n", hipGetErrorString(e), grid_blocks);
}
```

```cpp
#include <hip/hip_runtime.h>
#include <hip/hip_cooperative_groups.h>
#include <cstdio>
#include <cstdint>

namespace {
constexpr int D = 2048, NB = 8, S = 2048, T = NB * S;
constexpr int DSSD = 1024, DATT = 1024, NH = 16, HD = 64, NS = 128, CC = 1536;
constexpr int AH = 8, NE = 64, DE = 512, PW = 5664;
constexpr int O_DT = 2560, O_Q = 2592;
constexpr int N_Z = 0, N_XBC = 1024, N_Q = 2560, N_K = 3584, N_V = 4608, PLD = 5632, NPROJ = 5888;
constexpr float ALPHA = 1.189207115002721f;
constexpr float LAMBDA_INIT = 0.2f;
constexpr float LOG2E = 1.4426950408889634f;
constexpr float QS = 0.125f * LOG2E;
constexpr int NT = 512;
constexpr int LDS_BYTES = 152 * 1024;
constexpr int LDS_TAB = 128 * 1024;
constexpr int MAXROWS_R = NE * 256 + T * 8;
constexpr int MAXROWS = MAXROWS_R + T;
constexpr int MAXTILES = MAXROWS / 256;

typedef unsigned short bf16_t;

struct Params {
  const float *x, *w_in, *conv_w, *conv_b, *dt_bias_f, *dt_bias_b, *a_log_f, *a_log_b, *d_skip, *ssd_norm_w;
  const float *lq1, *lk1, *lq2, *lk2, *attn_norm_w, *w_out, *ln1_g, *ln1_b, *w_router, *router_bias;
  const float *wg_e, *wu_e, *wd_e, *wg_s, *wu_s, *wd_s, *ln2_g, *ln2_b;
  float* out;
  bf16_t *xb, *WinT, *WoutT, *WguT, *WdT, *proj, *u, *h1b, *H, *Y;
  float *xc, *dt, *yf, *yb, *h1, *logits, *gate, *row_gate;
  int *assign, *blkcnt, *row_tok, *pos, *tile_exp, *meta;
};

__device__ __forceinline__ float silu_f(float x) { return x / (1.f + __expf(-x)); }
__device__ __forceinline__ float softplus_f(float x) { return x > 20.f ? x : log1pf(__expf(x)); }
__device__ __forceinline__ float wave_sum(float v) { for (int o = 32; o >= 1; o >>= 1) v += __shfl_xor(v, o); return v; }
__device__ __forceinline__ float bf2f(bf16_t b) { return __uint_as_float(((unsigned)b) << 16); }
__device__ __forceinline__ bf16_t f2bf(float f) { unsigned u = __float_as_uint(f); u += 0x7FFFu + ((u >> 16) & 1u); return (bf16_t)(u >> 16); }
}

namespace pg8 {
#define PG8_LAS __attribute__((address_space(3)))
typedef unsigned short bf16_t;
typedef short bf16x8 __attribute__((ext_vector_type(8)));
typedef float f32x4 __attribute__((ext_vector_type(4)));
typedef unsigned u32x4 __attribute__((ext_vector_type(4)));
constexpr int BM = 256, BK = 64, HALF = 128, HTB = HALF * BK * 2  , STAGE_BYTES = 8 * HTB, NXCD = 8, WGM = 8;

__host__ __device__ __forceinline__ int lds_byte(int r, int c) { const int st = (r >> 4) * 2 + (c >> 5), rr = r & 15, cc = c & 31, ob = rr * 64 + cc * 2; return st * 1024 + (ob ^ (((ob >> 9) & 1) << 5)); }
__host__ __device__ __forceinline__ void stage_rc(int b, int& R, int& C) { const int st = b / 1024, sb = b % 1024, swz = sb ^ (((sb >> 9) & 1) << 5); R = (st >> 1) * 16 + swz / 64; C = (st & 1) * 32 + (swz % 64) / 2; }
__host__ __device__ __forceinline__ int perm32(int rho) { const int n = rho >> 4, i = rho & 15; return 8 * (i >> 2) + 4 * n + (i & 3); }

struct Unit { int pm, pn, bn, aux; };
struct Gemm { const bf16_t* A; const bf16_t* Bt; int K; };


__device__ __forceinline__ unsigned cvt_pk_bf16(float lo, float hi) { unsigned r; asm volatile("v_cvt_pk_bf16_f32 %0, %1, %2" : "=v"(r) : "v"(lo), "v"(hi)); return r; }
struct OrderStatic {
    int nM, nN, nwg, G, c;
    __device__ void init(int M, int N, int G_, int c_) { nM = M / BM; nN = N / BM; nwg = nM * nN; G = G_; c = c_; }
    __device__ bool next(int i, Unit& u) const {
        const long L = (long)i * G + c; if (L >= nwg) return false;
        int wgid = (int)L; { const int q = nwg / NXCD, r = nwg % NXCD, xcd = wgid % NXCD, off = wgid / NXCD; wgid = (xcd < r ? xcd * (q + 1) : r * (q + 1) + (xcd - r) * q) + off; }
        const int nig = WGM * nN, gid = wgid / nig, fm = gid * WGM, gsz = (nM - fm) < WGM ? (nM - fm) : WGM;
        u.pm = fm + ((wgid % nig) % gsz); u.pn = (wgid % nig) / gsz; u.bn = u.pn; u.aux = i; return true;
    }
    __device__ __forceinline__ unsigned row_off(int, int) const { return 0u; }
};
template <bool GATHER, class Epi, class Sched>
__device__ __forceinline__ void gemm_phase(PG8_LAS unsigned char* lds, const Gemm g, const Sched& S, const Epi& E) {
    const int tid = threadIdx.x, wid = __builtin_amdgcn_readfirstlane(tid >> 6), lane = tid & 63, wr = wid >> 2, wc = wid & 3, fr = lane & 15, fq = lane >> 4;
    const int K = g.K, nt = K / BK;
#define PG8_STAMP() do {} while (0)
    PG8_STAMP();
    unsigned voffA[2], voffB[2];
#pragma unroll
    for (int i = 0; i < 2; ++i) { int R, C; stage_rc(tid * 16 + i * 8192, R, C); const int Rb = Epi::PERM ? ((R & ~31) + perm32(R & 31)) : R;
        voffA[i] = (unsigned)(R * K + C) * 2u; voffB[i] = (unsigned)(Rb * K + C) * 2u; }
    unsigned voffG[2][2] = {{0u, 0u}, {0u, 0u}};
#define PG8_LOADG(uidx) do { if constexpr (GATHER) { _Pragma("unroll") for (int _h = 0; _h < 2; ++_h) _Pragma("unroll") for (int _i = 0; _i < 2; ++_i) { int R_, C_; stage_rc(tid * 16 + _i * 8192, R_, C_); \
        voffG[_h][_i] = S.row_off((uidx), _h * HALF + R_) + (unsigned)C_ * 2u; } } } while (0)
    const size_t kstep = (size_t)(BK * 2);
    const size_t hstep = (size_t)HALF * K * 2;
    const size_t tstep = 2 * hstep;
    const unsigned ldsw = (unsigned)wid * 1024u;
    const int aoff = lds_byte(wr * 64 + fr, fq * 8), boff = lds_byte(wc * 32 + fr, fq * 8);
#define PG8_SA(b, h) (((b) * 2 + (h)) * HTB)
#define PG8_SB(b, h) ((4 + (b) * 2 + (h)) * HTB)
#define PG8_STAGE(bufoff, gbase, voff) do { _Pragma("unroll") for (int _i = 0; _i < 2; ++_i) \
        __builtin_amdgcn_global_load_lds((const unsigned*)((const char*)(gbase) + (voff)[_i]), (PG8_LAS unsigned*)(lds + (bufoff) + ldsw + _i * 8192), 16, 0, 0); } while (0)
#define PG8_STAGE_A(bufoff, ptr, h) do { if constexpr (GATHER) { PG8_STAGE(bufoff, ptr, voffG[h]); } else { PG8_STAGE(bufoff, (ptr) + (h) * hstep, voffA); } } while (0)
#define PG8_LDA(dst, b, h) do { _Pragma("unroll") for (int m = 0; m < 4; ++m) _Pragma("unroll") for (int k = 0; k < 2; ++k) dst[m][k] = *(const PG8_LAS bf16x8*)(lds + PG8_SA(b, h) + aoff + m * 2048 + k * 1024); } while (0)
#define PG8_LDB(dst, b, h) do { _Pragma("unroll") for (int n = 0; n < 2; ++n) _Pragma("unroll") for (int k = 0; k < 2; ++k) dst[n][k] = *(const PG8_LAS bf16x8*)(lds + PG8_SB(b, h) + boff + n * 2048 + k * 1024); } while (0)
#define PG8_MMA(ai, bj, At, Bt) do { __builtin_amdgcn_s_setprio(1); _Pragma("unroll") for (int m = 0; m < 4; ++m) _Pragma("unroll") for (int n = 0; n < 2; ++n) _Pragma("unroll") for (int k = 0; k < 2; ++k) \
        acc[ai][bj][m][n] = __builtin_amdgcn_mfma_f32_16x16x32_bf16(Bt[n][k], At[m][k], acc[ai][bj][m][n], 0, 0, 0); __builtin_amdgcn_s_setprio(0); } while (0)
#define PG8_WAIT_V(n) asm volatile("s_waitcnt vmcnt(" #n ")" ::: "memory")
#define PG8_WAIT_L(n) asm volatile("s_waitcnt lgkmcnt(" #n ")" ::: "memory")
#define PG8_BAR __builtin_amdgcn_s_barrier()
#define PG8_SCHED __builtin_amdgcn_sched_barrier(0)
    Unit cur, nxt; int ui = 0;
    if (!S.next(0, cur)) return;
    f32x4 acc[2][2][4][2];
#pragma unroll
    for (int a = 0; a < 2; ++a)
#pragma unroll
        for (int b = 0; b < 2; ++b)
#pragma unroll
            for (int m = 0; m < 4; ++m)
#pragma unroll
                for (int n = 0; n < 2; ++n) acc[a][b][m][n] = (f32x4){0.f, 0.f, 0.f, 0.f};
    bf16x8 At[4][2], B0[2][2], B1[2][2];
    const char* cA = GATHER ? (const char*)g.A : (const char*)g.A + (size_t)cur.pm * tstep; const char* cB = (const char*)g.Bt + (size_t)cur.bn * tstep;
    PG8_LOADG(0);
    PG8_STAGE(PG8_SB(0, 0), cB, voffB); PG8_STAGE_A(PG8_SA(0, 0), cA, 0); PG8_STAGE(PG8_SB(0, 1), cB + hstep, voffB); PG8_STAGE_A(PG8_SA(0, 1), cA, 1);
    if (wr == 1) PG8_BAR;
    PG8_WAIT_V(4); PG8_BAR;
    PG8_STAGE(PG8_SB(1, 0), cB + kstep, voffB); PG8_STAGE_A(PG8_SA(1, 0), cA + kstep, 0); PG8_STAGE(PG8_SB(1, 1), cB + hstep + kstep, voffB);
    PG8_WAIT_V(6); PG8_BAR;
    PG8_STAMP();
    for (;;) {
        const bool has_next = S.next(ui + 1, nxt);
        const char* nA = has_next ? (GATHER ? (const char*)g.A : (const char*)g.A + (size_t)nxt.pm * tstep) : cA; const char* nB = has_next ? (const char*)g.Bt + (size_t)nxt.bn * tstep : cB;
        for (int t = 0; t < nt; t += 2) {
            const bool last = (t == nt - 2);
            const char* a1 = cA + (size_t)(t + 1) * kstep;
            const char* a2 = last ? nA : cA + (size_t)(t + 2) * kstep; const char* b2 = last ? nB : cB + (size_t)(t + 2) * kstep;
            const char* a3 = a2 + kstep; const char* b3 = b2 + kstep;
            PG8_LDB(B0, 0, 0); PG8_SCHED; PG8_LDA(At, 0, 0); PG8_STAGE_A(PG8_SA(1, 1), a1, 1);
            PG8_WAIT_L(8); PG8_BAR; PG8_WAIT_L(0); PG8_MMA(0, 0, At, B0); PG8_BAR; PG8_SCHED;
            if (last && has_next) PG8_LOADG(ui + 1);
            PG8_LDB(B1, 0, 1); PG8_STAGE(PG8_SB(0, 0), b2, voffB);
            PG8_BAR; PG8_WAIT_L(0); PG8_MMA(0, 1, At, B1); PG8_BAR;
            PG8_LDA(At, 0, 1); PG8_STAGE_A(PG8_SA(0, 0), a2, 0);
            PG8_BAR; PG8_WAIT_L(0); PG8_MMA(1, 0, At, B0); PG8_BAR; PG8_SCHED;
            PG8_STAGE(PG8_SB(0, 1), b2 + hstep, voffB);
            PG8_WAIT_V(6); PG8_BAR; PG8_MMA(1, 1, At, B1); PG8_BAR;
            PG8_LDB(B0, 1, 0); PG8_SCHED; PG8_LDA(At, 1, 0); PG8_STAGE_A(PG8_SA(0, 1), a2, 1);
            PG8_WAIT_L(8); PG8_BAR; PG8_WAIT_L(0); PG8_MMA(0, 0, At, B0); PG8_BAR; PG8_SCHED;
            PG8_LDB(B1, 1, 1); PG8_STAGE(PG8_SB(1, 0), b3, voffB);
            PG8_BAR; PG8_WAIT_L(0); PG8_MMA(0, 1, At, B1); PG8_BAR;
            PG8_LDA(At, 1, 1); PG8_STAGE_A(PG8_SA(1, 0), a3, 0);
            PG8_BAR; PG8_WAIT_L(0); PG8_MMA(1, 0, At, B0); PG8_BAR; PG8_SCHED;
            PG8_STAGE(PG8_SB(1, 1), b3 + hstep, voffB);
            PG8_WAIT_V(6); PG8_BAR; PG8_MMA(1, 1, At, B1); PG8_BAR;
        }
        PG8_STAMP();
        E(acc, cur, wr, wc, fr, fq);
        PG8_STAMP();
        if (!has_next) break;
#pragma unroll
        for (int a = 0; a < 2; ++a)
#pragma unroll
            for (int b = 0; b < 2; ++b)
#pragma unroll
                for (int m = 0; m < 4; ++m)
#pragma unroll
                    for (int n = 0; n < 2; ++n) acc[a][b][m][n] = (f32x4){0.f, 0.f, 0.f, 0.f};
        cur = nxt; cA = nA; cB = nB; ++ui;
    }
    PG8_WAIT_V(0);
    if (wr == 0) PG8_BAR;
    PG8_BAR;
    PG8_STAMP();
#undef PG8_STAMP
#undef PG8_SA
#undef PG8_SB
#undef PG8_STAGE
#undef PG8_STAGE_A
#undef PG8_LOADG
#undef PG8_LDA
#undef PG8_LDB
#undef PG8_MMA
#undef PG8_WAIT_V
#undef PG8_WAIT_L
#undef PG8_BAR
#undef PG8_SCHED
}
}
namespace {
using pg8::f32x4; using pg8::u32x4; using pg8::cvt_pk_bf16;
#define LAS __attribute__((address_space(3)))

template <class ARow, class Epi>
__device__ __forceinline__ void gemm_tile(float* smem, int mvalid, int nvalid, int K, ARow arow, const float* Bp, int ldb, Epi epi) {
  float* As = smem;
  float* Bs = smem + 16 * 68;
  const int tid = threadIdx.x, ty = tid >> 5, tx = tid & 31;
  float acc[4][4];
#pragma unroll
  for (int i = 0; i < 4; ++i)
#pragma unroll
    for (int j = 0; j < 4; ++j) acc[i][j] = 0.f;
  const int ak = tid & 15, ar = tid >> 4;
  const float* ap0 = (ar < mvalid) ? arow(ar) : nullptr;
  const float* ap1 = (ar + 32 < mvalid) ? arow(ar + 32) : nullptr;
  const int bn = tid & 127, bk = tid >> 7;
  for (int k0 = 0; k0 < K; k0 += 16) {
    As[ak * 68 + ar] = ap0 ? ap0[k0 + ak] : 0.f;
    As[ak * 68 + ar + 32] = ap1 ? ap1[k0 + ak] : 0.f;
#pragma unroll
    for (int i = 0; i < 4; ++i) { const int kk = bk + 4 * i; Bs[kk * 128 + bn] = (bn < nvalid) ? Bp[(size_t)(k0 + kk) * ldb + bn] : 0.f; }
    __syncthreads();
#pragma unroll
    for (int kk = 0; kk < 16; ++kk) {
      float a[4], b[4];
#pragma unroll
      for (int i = 0; i < 4; ++i) a[i] = As[kk * 68 + ty * 4 + i];
#pragma unroll
      for (int j = 0; j < 4; ++j) b[j] = Bs[kk * 128 + tx * 4 + j];
#pragma unroll
      for (int i = 0; i < 4; ++i)
#pragma unroll
        for (int j = 0; j < 4; ++j) acc[i][j] += a[i] * b[j];
    }
    __syncthreads();
  }
#pragma unroll
  for (int i = 0; i < 4; ++i)
#pragma unroll
    for (int j = 0; j < 4; ++j) { const int r = ty * 4 + i, c = tx * 4 + j; if (r < mvalid && c < nvalid) epi(r, c, acc[i][j]); }
}

template <class RowMap>
__device__ __forceinline__ void cvt_tile(const float* __restrict__ src, int N, int K, int k0, int n0, bf16_t* __restrict__ dst, RowMap rm) {
  const int lane = threadIdx.x & 63, w = threadIdx.x >> 6;
  const int n = n0 + (lane & 15) * 4, kk = k0 + (w * 4 + (lane >> 4)) * 8;
  if (n >= N) return;
  float4 v[8];
#pragma unroll
  for (int j = 0; j < 8; ++j) v[j] = *(const float4*)(src + (size_t)(kk + j) * N + n);
  u32x4 o;
  o.x = cvt_pk_bf16(v[0].x, v[1].x); o.y = cvt_pk_bf16(v[2].x, v[3].x); o.z = cvt_pk_bf16(v[4].x, v[5].x); o.w = cvt_pk_bf16(v[6].x, v[7].x);
  *(u32x4*)(dst + (size_t)rm(n + 0) * K + kk) = o;
  o.x = cvt_pk_bf16(v[0].y, v[1].y); o.y = cvt_pk_bf16(v[2].y, v[3].y); o.z = cvt_pk_bf16(v[4].y, v[5].y); o.w = cvt_pk_bf16(v[6].y, v[7].y);
  *(u32x4*)(dst + (size_t)rm(n + 1) * K + kk) = o;
  o.x = cvt_pk_bf16(v[0].z, v[1].z); o.y = cvt_pk_bf16(v[2].z, v[3].z); o.z = cvt_pk_bf16(v[4].z, v[5].z); o.w = cvt_pk_bf16(v[6].z, v[7].z);
  *(u32x4*)(dst + (size_t)rm(n + 2) * K + kk) = o;
  o.x = cvt_pk_bf16(v[0].w, v[1].w); o.y = cvt_pk_bf16(v[2].w, v[3].w); o.z = cvt_pk_bf16(v[4].w, v[5].w); o.w = cvt_pk_bf16(v[6].w, v[7].w);
  *(u32x4*)(dst + (size_t)rm(n + 3) * K + kk) = o;
}
template <class RowMap>
__device__ void cvt_job(const float* src, int nmat, int K, int N, bf16_t* dst, size_t dstride, RowMap rm) {
  const int kt = K / 256, ntl = (N + 63) / 64, per = kt * ntl;
  for (int it = blockIdx.x; it < nmat * per; it += gridDim.x) {
    const int m = it / per, r = it % per, k0 = (r / ntl) * 256, n0 = (r % ntl) * 64;
    cvt_tile(src + (size_t)m * K * N, N, K, k0, n0, dst + (size_t)m * dstride, rm);
  }
}
__device__ void ph_convert(const Params& p) {
  const size_t gtid = (size_t)blockIdx.x * NT + threadIdx.x, gsz = (size_t)gridDim.x * NT;
  for (size_t i = gtid; i < (size_t)T * D / 8; i += gsz) {
    const float4 a = *(const float4*)(p.x + i * 8), b = *(const float4*)(p.x + i * 8 + 4);
    u32x4 o; o.x = cvt_pk_bf16(a.x, a.y); o.y = cvt_pk_bf16(a.z, a.w); o.z = cvt_pk_bf16(b.x, b.y); o.w = cvt_pk_bf16(b.z, b.w);
    *(u32x4*)(p.xb + i * 8) = o;
  }
  cvt_job(p.w_in, 1, D, PW, p.WinT, 0, [](int n) { return n < O_DT ? n : (n < O_Q ? PLD + (n - O_DT) : n - 32); });
  for (size_t i = gtid; i < (size_t)(NPROJ - PW) * D / 8; i += gsz) *(u32x4*)(p.WinT + (size_t)PW * D + i * 8) = (u32x4){0u, 0u, 0u, 0u};
  cvt_job(p.w_out, 1, D, D, p.WoutT, 0, [](int n) { return n; });
  cvt_job(p.wg_e, NE, D, DE, p.WguT, (size_t)1024 * D, [](int n) { return (n >> 7) * 256 + (n & 127); });
  cvt_job(p.wu_e, NE, D, DE, p.WguT, (size_t)1024 * D, [](int n) { return (n >> 7) * 256 + 128 + (n & 127); });
  cvt_job(p.wg_s, 1, D, DE, p.WguT + (size_t)NE * 1024 * D, 0, [](int n) { return (n >> 7) * 256 + (n & 127); });
  cvt_job(p.wu_s, 1, D, DE, p.WguT + (size_t)NE * 1024 * D, 0, [](int n) { return (n >> 7) * 256 + 128 + (n & 127); });
  cvt_job(p.wd_e, NE, DE, D, p.WdT, (size_t)D * DE, [](int n) { return n; });
  cvt_job(p.wd_s, 1, DE, D, p.WdT + (size_t)NE * D * DE, 0, [](int n) { return n; });
}

struct EpiProj {
  static constexpr bool PERM = true;
  bf16_t* proj; float* dt; const float* bias_f; const float* bias_b;
  __device__ __forceinline__ void operator()(const f32x4 (&acc)[2][2][4][2], const pg8::Unit& u, int wr, int wc, int fr, int fq) const {
    const int row0 = u.pm * 256 + wr * 64 + fr;
    if (u.pn < 22) {
      const int col0 = u.pn * 256 + wc * 32 + 8 * fq;
      const float sc = (u.pn >= 10 && u.pn < 14) ? QS : 1.0f;
#pragma unroll
      for (int ai = 0; ai < 2; ++ai)
#pragma unroll
        for (int m = 0; m < 4; ++m) { bf16_t* rowp = proj + (size_t)(row0 + ai * 128 + m * 16) * PLD + col0;
#pragma unroll
          for (int bj = 0; bj < 2; ++bj) { const f32x4 v0 = acc[ai][bj][m][0] * sc, v1 = acc[ai][bj][m][1] * sc;
            u32x4 w; w.x = cvt_pk_bf16(v0[0], v0[1]); w.y = cvt_pk_bf16(v0[2], v0[3]); w.z = cvt_pk_bf16(v1[0], v1[1]); w.w = cvt_pk_bf16(v1[2], v1[3]);
            *(u32x4*)(rowp + bj * 128) = w; } }
    } else if (wc == 0) {
      const int c0 = 8 * fq;
      float bs[8];
#pragma unroll
      for (int j = 0; j < 8; ++j) bs[j] = (c0 + j) < 16 ? bias_f[c0 + j] : bias_b[c0 + j - 16];
#pragma unroll
      for (int ai = 0; ai < 2; ++ai)
#pragma unroll
        for (int m = 0; m < 4; ++m) { float* rowp = dt + (size_t)(row0 + ai * 128 + m * 16) * 32 + c0;
          const f32x4 v0 = acc[ai][0][m][0], v1 = acc[ai][0][m][1];
          f32x4 o0, o1;
#pragma unroll
          for (int j = 0; j < 4; ++j) { o0[j] = softplus_f(v0[j] + bs[j]); o1[j] = softplus_f(v1[j] + bs[4 + j]); }
          *(f32x4*)rowp = o0; *(f32x4*)(rowp + 4) = o1; }
    }
  }
};
struct EpiOut {
  static constexpr bool PERM = false;
  const float* x; float* v;
  __device__ __forceinline__ void operator()(const f32x4 (&acc)[2][2][4][2], const pg8::Unit& u, int wr, int wc, int fr, int fq) const {
    const int row0 = u.pm * 256 + wr * 64 + fr, col0 = u.pn * 256 + wc * 32 + 4 * fq;
#pragma unroll
    for (int ai = 0; ai < 2; ++ai)
#pragma unroll
      for (int m = 0; m < 4; ++m) { const size_t off = (size_t)(row0 + ai * 128 + m * 16) * D + col0;
#pragma unroll
        for (int bj = 0; bj < 2; ++bj)
#pragma unroll
          for (int n = 0; n < 2; ++n) { const f32x4 xv = *(const f32x4*)(x + off + bj * 128 + n * 16); *(f32x4*)(v + off + bj * 128 + n * 16) = xv * ALPHA + acc[ai][bj][m][n]; } }
  }
};

__device__ void ph_inproj(const Params& p, LAS unsigned char* lds) {
  pg8::Gemm g{p.xb, p.WinT, D}; pg8::OrderStatic Sd; Sd.init(T, NPROJ, gridDim.x, blockIdx.x);
  EpiProj E{p.proj, p.dt, p.dt_bias_f, p.dt_bias_b};
  pg8::gemm_phase<false>(lds, g, Sd, E);
}
__device__ void ph_conv(const Params& p) {
  const size_t gtid = (size_t)blockIdx.x * NT + threadIdx.x, gsz = (size_t)gridDim.x * NT;
  for (size_t i = gtid; i < (size_t)T * CC; i += gsz) {
    const int t = (int)(i / CC), c = (int)(i % CC), s = t % S;
    float a = p.conv_b[c];
#pragma unroll
    for (int j = 0; j < 5; ++j) { const int ss = s + j - 2; if (ss >= 0 && ss < S) a += p.conv_w[j * CC + c] * bf2f(p.proj[(size_t)(t + j - 2) * PLD + N_XBC + c]); }
    p.xc[i] = silu_f(a);
  }
}
__device__ void ph_ssd(const Params& p) {
  const int lane = threadIdx.x & 63, wv = threadIdx.x >> 6;
  for (int item = wv * gridDim.x + blockIdx.x; item < NB * NH * 2; item += gridDim.x * 8) {
    const int dir = item & 1, h = (item >> 1) % NH, b = item / (2 * NH), g = h / 8;
    const float a = -__expf(dir ? p.a_log_b[h] : p.a_log_f[h]);
    float st[NS];
#pragma unroll
    for (int n = 0; n < NS; ++n) st[n] = 0.f;
    float* yo = dir ? p.yb : p.yf;
    for (int step = 0; step < S; ++step) {
      const int t = dir ? (S - 1 - step) : step; const size_t tok = (size_t)b * S + t;
      const float dtv = p.dt[tok * 32 + dir * 16 + h];
      const float dA = __expf(a * dtv);
      const float dtx = dtv * p.xc[tok * CC + h * HD + lane];
      const float4* Bp = (const float4*)(p.xc + tok * CC + DSSD + g * NS);
      const float4* Cp = (const float4*)(p.xc + tok * CC + DSSD + 2 * NS + g * NS);
      float y = 0.f;
#pragma unroll
      for (int n4 = 0; n4 < NS / 4; ++n4) {
        const float4 bv = Bp[n4], cv = Cp[n4];
        st[4 * n4 + 0] = st[4 * n4 + 0] * dA + dtx * bv.x; y += st[4 * n4 + 0] * cv.x;
        st[4 * n4 + 1] = st[4 * n4 + 1] * dA + dtx * bv.y; y += st[4 * n4 + 1] * cv.y;
        st[4 * n4 + 2] = st[4 * n4 + 2] * dA + dtx * bv.z; y += st[4 * n4 + 2] * cv.z;
        st[4 * n4 + 3] = st[4 * n4 + 3] * dA + dtx * bv.w; y += st[4 * n4 + 3] * cv.w;
      }
      yo[tok * DSSD + h * HD + lane] = y;
    }
  }
}
__device__ void ph_ssdfin(const Params& p) {
  const int lane = threadIdx.x & 63, wv = threadIdx.x >> 6;
  for (int item = blockIdx.x * 8 + wv; item < T * 2; item += gridDim.x * 8) {
    const int t = item >> 1, g = item & 1;
    float y[8]; float ss = 0.f;
#pragma unroll
    for (int j = 0; j < 8; ++j) {
      const int ch = g * 512 + j * 64 + lane, h = ch / HD;
      const float xs = p.xc[(size_t)t * CC + ch];
      const float z = bf2f(p.proj[(size_t)t * PLD + N_Z + ch]);
      const float v = (p.yf[(size_t)t * DSSD + ch] + p.yb[(size_t)t * DSSD + ch] + p.d_skip[h] * xs) * silu_f(z);
      y[j] = v; ss += v * v;
    }
    ss = wave_sum(ss);
    const float rstd = rsqrtf(ss * (1.f / 512.f) + 1e-5f);
#pragma unroll
    for (int j = 0; j < 8; ++j) { const int ch = g * 512 + j * 64 + lane; p.u[(size_t)t * D + ch] = f2bf(y[j] * rstd * p.ssd_norm_w[ch]); }
  }
}
__device__ void ph_attn(const Params& p, float* smem) {
  float* Ks = smem;
  float* Vs = smem + 64 * 128;
  const int tid = threadIdx.x, r = tid >> 4, c = (tid >> 3) & 1, ds = tid & 7;
  float lam;
  { float s1 = 0.f, s2 = 0.f; for (int i = 0; i < 64; ++i) { s1 += p.lq1[i] * p.lk1[i]; s2 += p.lq2[i] * p.lk2[i]; } lam = __expf(s1) - __expf(s2) + LAMBDA_INIT; }
  for (int item = blockIdx.x; item < NB * AH * (S / 32); item += gridDim.x) {
    const int qt = item % (S / 32), h = (item / (S / 32)) % AH, b = item / ((S / 32) * AH);
    const float slope = exp2f(-(float)(h + 1)) * LOG2E;
    const int qpos = qt * 32 + r; const size_t qtok = (size_t)b * S + qpos;
    float q[64];
#pragma unroll
    for (int d = 0; d < 64; ++d) q[d] = bf2f(p.proj[qtok * PLD + N_Q + h * 128 + c * 64 + d]);
    float m = -1e30f, l = 0.f, acc[16];
#pragma unroll
    for (int j = 0; j < 16; ++j) acc[j] = 0.f;
    for (int kt = 0; kt < S / 64; ++kt) {
      __syncthreads();
      for (int i = tid; i < 64 * 128; i += NT) { const int key = i >> 7, dd = i & 127; const size_t tok = (size_t)b * S + kt * 64 + key;
        Ks[i] = bf2f(p.proj[tok * PLD + N_K + h * 128 + dd]); Vs[i] = bf2f(p.proj[tok * PLD + N_V + h * 128 + dd]); }
      __syncthreads();
      for (int key = 0; key < 64; ++key) {
        float s = 0.f;
#pragma unroll
        for (int d = 0; d < 64; ++d) s += q[d] * Ks[key * 128 + c * 64 + d];
        const int kpos = kt * 64 + key; const float dist = (float)(qpos > kpos ? qpos - kpos : kpos - qpos);
        s -= slope * dist;
        const float mn = fmaxf(m, s), corr = exp2f(m - mn), pe = exp2f(s - mn);
        l = l * corr + pe; m = mn;
#pragma unroll
        for (int j = 0; j < 16; ++j) acc[j] = acc[j] * corr + pe * Vs[key * 128 + ds * 16 + j];
      }
    }
    __syncthreads();
    float* X = smem;
    const float il = 1.f / l;
#pragma unroll
    for (int j = 0; j < 16; ++j) X[(r * 2 + c) * 128 + ds * 16 + j] = acc[j] * il;
    __syncthreads();
    float o[16]; float ss = 0.f;
#pragma unroll
    for (int j = 0; j < 16; ++j) { o[j] = X[(r * 2 + 0) * 128 + ds * 16 + j] - lam * X[(r * 2 + 1) * 128 + ds * 16 + j]; ss += o[j] * o[j]; }
    ss += __shfl_xor(ss, 1); ss += __shfl_xor(ss, 2); ss += __shfl_xor(ss, 4);
    const float rstd = rsqrtf(ss * (1.f / 128.f) + 1e-5f);
    if (c == 0) {
#pragma unroll
      for (int j = 0; j < 16; ++j) p.u[qtok * D + DSSD + h * 128 + ds * 16 + j] = f2bf(o[j] * rstd * p.attn_norm_w[ds * 16 + j] * (1.f - LAMBDA_INIT));
    }
    __syncthreads();
  }
}
__device__ void ph_outproj(const Params& p, LAS unsigned char* lds) {
  pg8::Gemm g{p.u, p.WoutT, D}; pg8::OrderStatic Sd; Sd.init(T, D, gridDim.x, blockIdx.x);
  EpiOut E{p.x, p.h1};
  pg8::gemm_phase<false>(lds, g, Sd, E);
}
__device__ void ph_ln1(const Params& p) {
  const int lane = threadIdx.x & 63, wv = threadIdx.x >> 6;
  for (int row = blockIdx.x * 8 + wv; row < T; row += gridDim.x * 8) {
    float* hp = p.h1 + (size_t)row * D; float v[32]; float s = 0.f;
#pragma unroll
    for (int j = 0; j < 32; ++j) { v[j] = hp[j * 64 + lane]; s += v[j]; }
    const float mu = wave_sum(s) * (1.f / D); float q = 0.f;
#pragma unroll
    for (int j = 0; j < 32; ++j) { const float d = v[j] - mu; q += d * d; }
    const float rstd = rsqrtf(wave_sum(q) * (1.f / D) + 1e-5f);
#pragma unroll
    for (int j = 0; j < 32; ++j) { const int c = j * 64 + lane; const float o = (v[j] - mu) * rstd * p.ln1_g[c] + p.ln1_b[c]; hp[c] = o; p.h1b[(size_t)row * D + c] = f2bf(o); }
  }
}
__device__ void ph_router(const Params& p, float* smem) {
  for (int mt = blockIdx.x; mt < T / 64; mt += gridDim.x) {
    const int m0 = mt * 64;
    gemm_tile(smem, 64, NE, D, [&](int r) { return p.h1 + (size_t)(m0 + r) * D; }, p.w_router, NE,
              [&](int r, int c, float v) { p.logits[(size_t)(m0 + r) * NE + c] = v; });
  }
}
__device__ __forceinline__ int ld_agent(const int* p) { return __hip_atomic_load(p, __ATOMIC_RELAXED, __HIP_MEMORY_SCOPE_AGENT); }
__device__ __forceinline__ float ld_agent(const float* p) { return __hip_atomic_load(p, __ATOMIC_RELAXED, __HIP_MEMORY_SCOPE_AGENT); }
__device__ void ph_route(const Params& p, LAS unsigned char* lds) {
  LAS int* cntl = (LAS int*)lds;
  const int lane = threadIdx.x & 63, wv = threadIdx.x >> 6;
  for (int tb = blockIdx.x; tb < T / 64; tb += gridDim.x) {
    __syncthreads();
    if (threadIdx.x < NE) cntl[threadIdx.x] = 0;
    __syncthreads();
    for (int ti = 0; ti < 8; ++ti) {
      const int t = tb * 64 + wv * 8 + ti;
      const float sc = 1.f / (1.f + __expf(-p.logits[(size_t)t * NE + lane]));
      const float bz = sc + p.router_bias[lane];
      int rk = 0;
#pragma unroll
      for (int j = 1; j < 8; ++j) { const float o = __shfl_xor(bz, j); const int oi = lane ^ j; rk += (o > bz || (o == bz && oi < lane)) ? 1 : 0; }
      float gs = rk < 2 ? bz : 0.f;
      gs += __shfl_xor(gs, 1); gs += __shfl_xor(gs, 2); gs += __shfl_xor(gs, 4);
      const int g = lane >> 3; int grk = 0;
#pragma unroll
      for (int j = 1; j < 8; ++j) { const float o = __shfl_xor(gs, j * 8); const int og = g ^ j; grk += (o > gs || (o == gs && og < g)) ? 1 : 0; }
      const bool gsel = grk < 4;
      const float mb = gsel ? bz : -INFINITY;
      int erk = 0;
      for (int j = 1; j < 64; ++j) { const float o = __shfl_xor(mb, j); const int oi = lane ^ j; erk += (o > mb || (o == mb && oi < lane)) ? 1 : 0; }
      const bool sel = gsel && erk < 8;
      const float gsum = wave_sum(sel ? sc : 0.f);
      if (sel) {
        const int lr = __hip_atomic_fetch_add(&cntl[lane], 1, __ATOMIC_RELAXED, __HIP_MEMORY_SCOPE_WORKGROUP);
        p.assign[t * 8 + erk] = lane | (lr << 8); p.gate[t * 8 + erk] = sc / gsum * 2.5f;
      }
    }
    __syncthreads();
    if (threadIdx.x < NE) p.blkcnt[tb * NE + threadIdx.x] = cntl[threadIdx.x];
  }
}
__device__ void ph_place(const Params& p, LAS unsigned char* lds) {
  LAS int* part = (LAS int*)lds;
  LAS int* parta = part + 512;
  LAS int* base = parta + 512;
  LAS int* total = base + 64;
  LAS int* pstart = total + 64;
  const int tid = threadIdx.x, e = tid & 63, pt = tid >> 6;
  for (int tb = blockIdx.x; tb < T / 64; tb += gridDim.x) {
    __syncthreads();
    int slo = 0, sall = 0;
    for (int b = pt * 32; b < pt * 32 + 32; ++b) { const int c = ld_agent(p.blkcnt + b * NE + e); sall += c; slo += (b < tb) ? c : 0; }
    part[pt * 64 + e] = slo; parta[pt * 64 + e] = sall;
    __syncthreads();
    if (tid < 64) {
      int b0 = 0, t0 = 0;
#pragma unroll
      for (int q = 0; q < 8; ++q) { b0 += part[q * 64 + tid]; t0 += parta[q * 64 + tid]; }
      base[tid] = b0; total[tid] = t0;
      const int padded = (t0 + 255) & ~255;
      int incl = padded;
      for (int o = 1; o < 64; o <<= 1) { const int v = __shfl_up(incl, o); if (tid >= o) incl += v; }
      pstart[tid] = incl - padded;
      if (tid == 63) pstart[64] = incl;
    }
    __syncthreads();
    {
      const int t = tb * 64 + (tid >> 3), k = tid & 7;
      const int a = ld_agent(p.assign + t * 8 + k), ee = a & 255, lr = a >> 8;
      const int row = pstart[ee] + base[ee] + lr;
      p.row_tok[row] = t; p.row_gate[row] = ld_agent(p.gate + t * 8 + k); p.pos[t * 8 + k] = row;
      if (tid < 64) { const int srow = pstart[64] + tb * 64 + tid; p.row_tok[srow] = tb * 64 + tid; p.row_gate[srow] = 1.0f; }
    }
    if (tb == blockIdx.x) {
      for (int e2 = blockIdx.x; e2 < NE; e2 += gridDim.x) {
        const int r0 = pstart[e2] + total[e2], r1 = pstart[e2 + 1];
        for (int r = r0 + tid; r < r1; r += NT) { p.row_tok[r] = 0; p.row_gate[r] = 0.f; }
        for (int j = pstart[e2] / 256 + tid; j < r1 / 256; j += NT) p.tile_exp[j] = e2;
      }
      if (blockIdx.x == 0) {
        const int nr = pstart[64] / 256;
        for (int j = tid; j < T / 256; j += NT) p.tile_exp[nr + j] = NE;
        if (tid == 0) { p.meta[0] = nr; p.meta[1] = nr + T / 256; }
      }
    }
  }
}
struct OrderMoE {
  LAS const int* ulist; int n;
  LAS const unsigned* tab;
  __device__ __forceinline__ bool next(int i, pg8::Unit& u) const { if (i >= n) return false; u.pm = ulist[i * 4 + 0]; u.pn = ulist[i * 4 + 1]; u.bn = ulist[i * 4 + 2]; u.aux = i; return true; }
  __device__ __forceinline__ unsigned row_off(int i, int row) const { return tab[i * 512 + row]; }
};
template <bool TABLES>
__device__ __forceinline__ OrderMoE moe_order(const Params& p, LAS unsigned char* lds, int npn, int tile0, int ntiles, int rowbytes) {
  LAS int* ulist = (LAS int*)(lds + LDS_TAB); LAS unsigned* tab = (LAS unsigned*)(lds + LDS_TAB + 1024);
  const int G = gridDim.x, c = blockIdx.x, mpc = 32 / npn; int n = 0;
  __syncthreads();
  for (int i = 0; i < 60; ++i) {
    int U; if (G == 256) U = ((i * 8 + (c & 7)) * 32 + (c >> 3)); else U = i * G + c;
    const int chunk = U >> 5, w = U & 31, j = chunk * mpc + (w % mpc), pn = w / mpc;
    if (j >= ntiles) break;
    const int tile = tile0 + j, e = ld_agent(p.tile_exp + tile);
    if (threadIdx.x == 0) { ulist[i * 4 + 0] = tile; ulist[i * 4 + 1] = pn; ulist[i * 4 + 2] = e * npn + pn; ulist[i * 4 + 3] = e; }
    if (TABLES) { for (int r = threadIdx.x; r < 256; r += NT) { tab[i * 512 + r] = (unsigned)ld_agent(p.row_tok + tile * 256 + r) * (unsigned)rowbytes; tab[i * 512 + 256 + r] = __float_as_uint(ld_agent(p.row_gate + tile * 256 + r)); } }
    n = i + 1;
  }
  __syncthreads();
  return OrderMoE{ulist, n, tab};
}
struct EpiGU {
  static constexpr bool PERM = true;
  bf16_t* H; LAS const unsigned* tab;
  __device__ __forceinline__ void operator()(const f32x4 (&acc)[2][2][4][2], const pg8::Unit& u, int wr, int wc, int fr, int fq) const {
    const int col0 = u.pn * 128 + wc * 32 + 8 * fq;
#pragma unroll
    for (int ai = 0; ai < 2; ++ai)
#pragma unroll
      for (int m = 0; m < 4; ++m) { const int r = ai * 128 + wr * 64 + m * 16 + fr; const float gt = __uint_as_float(tab[u.aux * 512 + 256 + r]);
        f32x4 h0, h1;
#pragma unroll
        for (int j = 0; j < 4; ++j) { const float g0 = acc[ai][0][m][0][j], g1 = acc[ai][0][m][1][j];
          h0[j] = g0 * __builtin_amdgcn_rcpf(1.f + __expf(-g0)) * acc[ai][1][m][0][j] * gt; h1[j] = g1 * __builtin_amdgcn_rcpf(1.f + __expf(-g1)) * acc[ai][1][m][1][j] * gt; }
        u32x4 w; w.x = cvt_pk_bf16(h0[0], h0[1]); w.y = cvt_pk_bf16(h0[2], h0[3]); w.z = cvt_pk_bf16(h1[0], h1[1]); w.w = cvt_pk_bf16(h1[2], h1[3]);
        *(u32x4*)(H + (size_t)(u.pm * 256 + r) * DE + col0) = w; }
  }
};
__device__ void ph_gateup(const Params& p, LAS unsigned char* lds) {
  const int ntot = ld_agent(p.meta + 1);
  const OrderMoE S = moe_order<true>(p, lds, 4, 0, ntot, D * 2);
  pg8::Gemm g{p.h1b, p.WguT, D}; EpiGU E{p.H, S.tab};
  pg8::gemm_phase<true>(lds, g, S, E);
}
struct EpiDown {
  static constexpr bool PERM = true;
  bf16_t* Y; float* out; const bf16_t* h1b; LAS const int* ulist; int srow0;
  __device__ __forceinline__ void operator()(const f32x4 (&acc)[2][2][4][2], const pg8::Unit& u, int wr, int wc, int fr, int fq) const {
    const int col0 = u.pn * 256 + wc * 32 + 8 * fq; const bool shared_e = ulist[u.aux * 4 + 3] == NE;
#pragma unroll
    for (int ai = 0; ai < 2; ++ai)
#pragma unroll
      for (int m = 0; m < 4; ++m) { const int row = u.pm * 256 + ai * 128 + wr * 64 + m * 16 + fr;
#pragma unroll
        for (int bj = 0; bj < 2; ++bj) { const f32x4 v0 = acc[ai][bj][m][0], v1 = acc[ai][bj][m][1];
          if (!shared_e) { u32x4 w; w.x = cvt_pk_bf16(v0[0], v0[1]); w.y = cvt_pk_bf16(v0[2], v0[3]); w.z = cvt_pk_bf16(v1[0], v1[1]); w.w = cvt_pk_bf16(v1[2], v1[3]);
            *(u32x4*)(Y + (size_t)row * D + col0 + bj * 128) = w; }
          else { const size_t o = (size_t)(row - srow0) * D + col0 + bj * 128; const u32x4 hb = *(const u32x4*)(h1b + o); f32x4 a, b;
            a[0] = __uint_as_float(hb.x << 16); a[1] = __uint_as_float(hb.x & 0xffff0000u); a[2] = __uint_as_float(hb.y << 16); a[3] = __uint_as_float(hb.y & 0xffff0000u);
            b[0] = __uint_as_float(hb.z << 16); b[1] = __uint_as_float(hb.z & 0xffff0000u); b[2] = __uint_as_float(hb.w << 16); b[3] = __uint_as_float(hb.w & 0xffff0000u);
            *(f32x4*)(out + o) = a * ALPHA + v0; *(f32x4*)(out + o + 4) = b * ALPHA + v1; } } }
  }
};
__device__ void ph_down(const Params& p, LAS unsigned char* lds) {
  const int nr = ld_agent(p.meta + 0), ntot = ld_agent(p.meta + 1);
  const OrderMoE S = moe_order<false>(p, lds, 8, 0, ntot, 0);
  pg8::Gemm g{p.H, p.WdT, DE}; EpiDown E{p.Y, p.out, p.h1b, S.ulist, nr * 256};
  pg8::gemm_phase<false>(lds, g, S, E);
}
__device__ void ph_combine(const Params& p) {
  const int lane = threadIdx.x & 63, wv = threadIdx.x >> 6;
  for (int row = blockIdx.x * 8 + wv; row < T; row += gridDim.x * 8) {
    float v[32];
    float* op = p.out + (size_t)row * D;
#pragma unroll
    for (int g = 0; g < 4; ++g) { const f32x4 a = *(const f32x4*)(op + g * 512 + lane * 8), b = *(const f32x4*)(op + g * 512 + lane * 8 + 4);
#pragma unroll
      for (int j = 0; j < 4; ++j) { v[g * 8 + j] = a[j]; v[g * 8 + 4 + j] = b[j]; } }
    for (int k = 0; k < 8; ++k) {
      const int yr = ld_agent(p.pos + row * 8 + k); const bf16_t* yp = p.Y + (size_t)yr * D;
#pragma unroll
      for (int g = 0; g < 4; ++g) { const u32x4 hb = *(const u32x4*)(yp + g * 512 + lane * 8);
        v[g * 8 + 0] += __uint_as_float(hb.x << 16); v[g * 8 + 1] += __uint_as_float(hb.x & 0xffff0000u); v[g * 8 + 2] += __uint_as_float(hb.y << 16); v[g * 8 + 3] += __uint_as_float(hb.y & 0xffff0000u);
        v[g * 8 + 4] += __uint_as_float(hb.z << 16); v[g * 8 + 5] += __uint_as_float(hb.z & 0xffff0000u); v[g * 8 + 6] += __uint_as_float(hb.w << 16); v[g * 8 + 7] += __uint_as_float(hb.w & 0xffff0000u); }
    }
    float s = 0.f;
#pragma unroll
    for (int j = 0; j < 32; ++j) s += v[j];
    const float mu = wave_sum(s) * (1.f / D); float q = 0.f;
#pragma unroll
    for (int j = 0; j < 32; ++j) { const float d = v[j] - mu; q += d * d; }
    const float rstd = rsqrtf(wave_sum(q) * (1.f / D) + 1e-5f);
#pragma unroll
    for (int g = 0; g < 4; ++g) { const int c0 = g * 512 + lane * 8; f32x4 a, b;
#pragma unroll
      for (int j = 0; j < 4; ++j) { a[j] = (v[g * 8 + j] - mu) * rstd * p.ln2_g[c0 + j] + p.ln2_b[c0 + j]; b[j] = (v[g * 8 + 4 + j] - mu) * rstd * p.ln2_g[c0 + 4 + j] + p.ln2_b[c0 + 4 + j]; }
      *(f32x4*)(op + c0) = a; *(f32x4*)(op + c0 + 4) = b; }
  }
}

__global__ void __launch_bounds__(NT) k_mega(Params p_arg) {
#if defined(__HIP_DEVICE_COMPILE__)
  extern __shared__ __attribute__((aligned(16))) unsigned char lds_raw[];
  LAS unsigned char* lds = (LAS unsigned char*)lds_raw;
  float* smem = (float*)lds_raw;
  cooperative_groups::grid_group grid = cooperative_groups::this_grid();
#ifndef ONLY
#define ONLY -1
#endif
  typedef const __attribute__((address_space(4))) Params* KP;
  const KP pk = (KP)__builtin_amdgcn_kernarg_segment_ptr();
#define RUN(n, call) do { if (ONLY < 0 || ONLY == n) { KP q_ = pk; asm volatile("" : "+s"(q_)); const Params p = *q_; call; } } while (0)
  RUN(0, ph_convert(p)); grid.sync();
  RUN(1, ph_inproj(p, lds)); grid.sync();
  RUN(2, ph_conv(p)); grid.sync();
  RUN(3, ph_ssd(p)); RUN(4, ph_attn(p, smem)); grid.sync();
  RUN(5, ph_ssdfin(p)); grid.sync();
  RUN(6, ph_outproj(p, lds)); grid.sync();
  RUN(7, ph_ln1(p)); grid.sync();
  RUN(8, ph_router(p, smem)); grid.sync();
  RUN(9, ph_route(p, lds)); grid.sync();
  RUN(10, ph_place(p, lds)); grid.sync();
  RUN(11, ph_gateup(p, lds)); grid.sync();
  RUN(12, ph_down(p, lds)); grid.sync();
  RUN(13, ph_combine(p));
#endif
}
}

extern "C" void kernel_launch(void* const* d_in, const int* in_sizes, int n_in, void* d_out, int out_size, void* d_ws, size_t ws_size, hipStream_t stream) {
  Params p{};
  const float* const* in = (const float* const*)d_in;
  p.x = in[0]; p.w_in = in[1]; p.conv_w = in[2]; p.conv_b = in[3]; p.dt_bias_f = in[4]; p.dt_bias_b = in[5]; p.a_log_f = in[6]; p.a_log_b = in[7];
  p.d_skip = in[8]; p.ssd_norm_w = in[9]; p.lq1 = in[10]; p.lk1 = in[11]; p.lq2 = in[12]; p.lk2 = in[13]; p.attn_norm_w = in[14]; p.w_out = in[15];
  p.ln1_g = in[16]; p.ln1_b = in[17]; p.w_router = in[18]; p.router_bias = in[19]; p.wg_e = in[20]; p.wu_e = in[21]; p.wd_e = in[22];
  p.wg_s = in[23]; p.wu_s = in[24]; p.wd_s = in[25]; p.ln2_g = in[26]; p.ln2_b = in[27];
  p.out = (float*)d_out;
  char* w = (char*)d_ws; size_t o = 0;
  auto take = [&](size_t bytes) { char* r = w + o; o += (bytes + 255) / 256 * 256; return r; };
  char* reg1 = w + o;
  p.xb = (bf16_t*)take((size_t)T * D * 2); p.WinT = (bf16_t*)take((size_t)NPROJ * D * 2); p.WoutT = (bf16_t*)take((size_t)D * D * 2);
  p.WguT = (bf16_t*)take((size_t)(NE + 1) * 1024 * D * 2); p.proj = (bf16_t*)take((size_t)T * PLD * 2); p.u = (bf16_t*)take((size_t)T * D * 2);
  const size_t reg1_bytes = (size_t)((w + o) - reg1);
  p.Y = (bf16_t*)reg1;
  if ((size_t)MAXROWS_R * D * 2 > reg1_bytes) { fprintf(stderr, "kernel_launch: region 1 too small for Y\n"); return; }
  char* reg2 = take((size_t)MAXROWS * DE * 2);
  p.H = (bf16_t*)reg2; p.yf = (float*)reg2; p.yb = (float*)(reg2 + (size_t)T * DSSD * 4);
  p.h1b = (bf16_t*)take((size_t)T * D * 2); p.WdT = (bf16_t*)take((size_t)(NE + 1) * D * DE * 2);
  p.dt = (float*)take((size_t)T * 32 * 4); p.logits = (float*)take((size_t)T * NE * 4); p.gate = (float*)take((size_t)T * 8 * 4);
  p.assign = (int*)take((size_t)T * 8 * 4); p.pos = (int*)take((size_t)T * 8 * 4); p.blkcnt = (int*)take((size_t)(T / 64) * NE * 4);
  p.row_tok = (int*)take((size_t)MAXROWS * 4); p.row_gate = (float*)take((size_t)MAXROWS * 4); p.tile_exp = (int*)take((size_t)MAXTILES * 4); p.meta = (int*)take(256);
  p.xc = (float*)d_out; p.h1 = (float*)d_out;
  if ((size_t)T * CC * 4 > (size_t)T * D * 4) return;
  if (o > ws_size) { fprintf(stderr, "kernel_launch: ws too small: need %zu have %zu\n", o, ws_size); return; }
  static int grid_blocks = 0;
  if (!grid_blocks) {
    int dev = 0, cus = 0, per_cu = 0;
    hipGetDevice(&dev);
    hipDeviceGetAttribute(&cus, hipDeviceAttributeMultiprocessorCount, dev);
    if (hipFuncSetAttribute((const void*)k_mega, hipFuncAttributeMaxDynamicSharedMemorySize, LDS_BYTES) != hipSuccess) { fprintf(stderr, "kernel_launch: hipFuncSetAttribute failed\n"); return; }
    hipOccupancyMaxActiveBlocksPerMultiprocessor(&per_cu, k_mega, NT, LDS_BYTES);
    if (per_cu < 1) { fprintf(stderr, "kernel_launch: occupancy query says 0 blocks/CU\n"); return; }
    grid_blocks = cus;
  }
  void* args[] = {&p};
  hipError_t e = hipLaunchCooperativeKernel((void*)k_mega, dim3(grid_blocks), dim3(NT), args, LDS_BYTES, stream);
  if (e != hipSuccess) fprintf(stderr, "cooperative launch failed: %s (grid %d)\n", hipGetErrorString(e), grid_blocks);
}
```

```cpp
#include <hip/hip_runtime.h>
#include <hip/hip_cooperative_groups.h>
#include <cstdio>
#include <cstdint>

namespace {
constexpr int D = 2048, NB = 8, S = 2048, T = NB * S;
constexpr int DSSD = 1024, DATT = 1024, NH = 16, HD = 64, NS = 128, CC = 1536;
constexpr int AH = 8, NE = 64, DE = 512, PW = 5664;
constexpr int O_DT = 2560, O_Q = 2592;
constexpr int N_Z = 0, N_XBC = 1024, N_Q = 2560, N_K = 3584, N_V = 4608, PLD = 5632, NPROJ = 5888;
constexpr float ALPHA = 1.189207115002721f;
constexpr float LAMBDA_INIT = 0.2f;
constexpr float LOG2E = 1.4426950408889634f;
constexpr float QS = 0.125f * LOG2E;
constexpr int NT = 512;
constexpr int LDS_BYTES = 152 * 1024;
constexpr int LDS_TAB = 128 * 1024;
constexpr int MAXROWS_R = NE * 256 + T * 8;
constexpr int MAXROWS = MAXROWS_R + T;
constexpr int MAXTILES = MAXROWS / 256;

typedef unsigned short bf16_t;

struct Params {
  const float *x, *w_in, *conv_w, *conv_b, *dt_bias_f, *dt_bias_b, *a_log_f, *a_log_b, *d_skip, *ssd_norm_w;
  const float *lq1, *lk1, *lq2, *lk2, *attn_norm_w, *w_out, *ln1_g, *ln1_b, *w_router, *router_bias;
  const float *wg_e, *wu_e, *wd_e, *wg_s, *wu_s, *wd_s, *ln2_g, *ln2_b;
  float* out;
  bf16_t *xb, *WinT, *WoutT, *WguT, *WdT, *proj, *u, *h1b, *H, *Y;
  float *xc, *dt, *yf, *yb, *h1, *logits, *gate, *row_gate;
  int *assign, *blkcnt, *row_tok, *pos, *tile_exp, *meta;
};

__device__ __forceinline__ float silu_f(float x) { return x / (1.f + __expf(-x)); }
__device__ __forceinline__ float softplus_f(float x) { return x > 20.f ? x : log1pf(__expf(x)); }
__device__ __forceinline__ float wave_sum(float v) { for (int o = 32; o >= 1; o >>= 1) v += __shfl_xor(v, o); return v; }
__device__ __forceinline__ float bf2f(bf16_t b) { return __uint_as_float(((unsigned)b) << 16); }
__device__ __forceinline__ bf16_t f2bf(float f) { unsigned u = __float_as_uint(f); u += 0x7FFFu + ((u >> 16) & 1u); return (bf16_t)(u >> 16); }
}

namespace pg8 {
#define PG8_LAS __attribute__((address_space(3)))
typedef unsigned short bf16_t;
typedef short bf16x8 __attribute__((ext_vector_type(8)));
typedef float f32x4 __attribute__((ext_vector_type(4)));
typedef unsigned u32x4 __attribute__((ext_vector_type(4)));
constexpr int BM = 256, BK = 64, HALF = 128, HTB = HALF * BK * 2  , STAGE_BYTES = 8 * HTB, NXCD = 8, WGM = 8;

__host__ __device__ __forceinline__ int lds_byte(int r, int c) { const int st = (r >> 4) * 2 + (c >> 5), rr = r & 15, cc = c & 31, ob = rr * 64 + cc * 2; return st * 1024 + (ob ^ (((ob >> 9) & 1) << 5)); }
__host__ __device__ __forceinline__ void stage_rc(int b, int& R, int& C) { const int st = b / 1024, sb = b % 1024, swz = sb ^ (((sb >> 9) & 1) << 5); R = (st >> 1) * 16 + swz / 64; C = (st & 1) * 32 + (swz % 64) / 2; }
__host__ __device__ __forceinline__ int perm32(int rho) { const int n = rho >> 4, i = rho & 15; return 8 * (i >> 2) + 4 * n + (i & 3); }

struct Unit { int pm, pn, bn, aux; };
struct Gemm { const bf16_t* A; const bf16_t* Bt; int K; };


__device__ __forceinline__ unsigned cvt_pk_bf16(float lo, float hi) { unsigned r; asm volatile("v_cvt_pk_bf16_f32 %0, %1, %2" : "=v"(r) : "v"(lo), "v"(hi)); return r; }
struct OrderStatic {
    int nM, nN, nwg, G, c;
    __device__ void init(int M, int N, int G_, int c_) { nM = M / BM; nN = N / BM; nwg = nM * nN; G = G_; c = c_; }
    __device__ bool next(int i, Unit& u) const {
        const long L = (long)i * G + c; if (L >= nwg) return false;
        int wgid = (int)L; { const int q = nwg / NXCD, r = nwg % NXCD, xcd = wgid % NXCD, off = wgid / NXCD; wgid = (xcd < r ? xcd * (q + 1) : r * (q + 1) + (xcd - r) * q) + off; }
        const int nig = WGM * nN, gid = wgid / nig, fm = gid * WGM, gsz = (nM - fm) < WGM ? (nM - fm) : WGM;
        u.pm = fm + ((wgid % nig) % gsz); u.pn = (wgid % nig) / gsz; u.bn = u.pn; u.aux = i; return true;
    }
    __device__ __forceinline__ unsigned row_off(int, int) const { return 0u; }
};
template <bool GATHER, class Epi, class Sched>
__device__ __forceinline__ void gemm_phase(PG8_LAS unsigned char* lds, const Gemm g, const Sched& S, const Epi& E) {
    int tid = threadIdx.x; asm volatile("" : "+v"(tid));
    const int wid = __builtin_amdgcn_readfirstlane(tid >> 6), lane = tid & 63, wr = wid >> 2, wc = wid & 3, fr = lane & 15, fq = lane >> 4;
    const int K = g.K, nt = K / BK;
#define PG8_STAMP() do {} while (0)
    PG8_STAMP();
    unsigned voffA[2], voffB[2];
#pragma unroll
    for (int i = 0; i < 2; ++i) { int R, C; stage_rc(tid * 16 + i * 8192, R, C); const int Rb = Epi::PERM ? ((R & ~31) + perm32(R & 31)) : R;
        voffA[i] = (unsigned)(R * K + C) * 2u; voffB[i] = (unsigned)(Rb * K + C) * 2u; }
    unsigned voffG[2][2] = {{0u, 0u}, {0u, 0u}};
#define PG8_LOADG(uidx) do { if constexpr (GATHER) { _Pragma("unroll") for (int _h = 0; _h < 2; ++_h) _Pragma("unroll") for (int _i = 0; _i < 2; ++_i) { int R_, C_; stage_rc(tid * 16 + _i * 8192, R_, C_); \
        voffG[_h][_i] = S.row_off((uidx), _h * HALF + R_) + (unsigned)C_ * 2u; } } } while (0)
    const size_t kstep = (size_t)(BK * 2);
    const size_t hstep = (size_t)HALF * K * 2;
    const size_t tstep = 2 * hstep;
    const unsigned ldsw = (unsigned)wid * 1024u;
    const int aoff = lds_byte(wr * 64 + fr, fq * 8), boff = lds_byte(wc * 32 + fr, fq * 8);
#define PG8_SA(b, h) (((b) * 2 + (h)) * HTB)
#define PG8_SB(b, h) ((4 + (b) * 2 + (h)) * HTB)
#define PG8_STAGE(bufoff, gbase, voff) do { _Pragma("unroll") for (int _i = 0; _i < 2; ++_i) \
        __builtin_amdgcn_global_load_lds((const unsigned*)((const char*)(gbase) + (voff)[_i]), (PG8_LAS unsigned*)(lds + (bufoff) + ldsw + _i * 8192), 16, 0, 0); } while (0)
#define PG8_STAGE_A(bufoff, ptr, h) do { if constexpr (GATHER) { PG8_STAGE(bufoff, ptr, voffG[h]); } else { PG8_STAGE(bufoff, (ptr) + (h) * hstep, voffA); } } while (0)
#define PG8_LDA(dst, b, h) do { _Pragma("unroll") for (int m = 0; m < 4; ++m) _Pragma("unroll") for (int k = 0; k < 2; ++k) dst[m][k] = *(const PG8_LAS bf16x8*)(lds + PG8_SA(b, h) + aoff + m * 2048 + k * 1024); } while (0)
#define PG8_LDB(dst, b, h) do { _Pragma("unroll") for (int n = 0; n < 2; ++n) _Pragma("unroll") for (int k = 0; k < 2; ++k) dst[n][k] = *(const PG8_LAS bf16x8*)(lds + PG8_SB(b, h) + boff + n * 2048 + k * 1024); } while (0)
#define PG8_MMA(ai, bj, At, Bt) do { __builtin_amdgcn_s_setprio(1); _Pragma("unroll") for (int m = 0; m < 4; ++m) _Pragma("unroll") for (int n = 0; n < 2; ++n) _Pragma("unroll") for (int k = 0; k < 2; ++k) \
        acc[ai][bj][m][n] = __builtin_amdgcn_mfma_f32_16x16x32_bf16(Bt[n][k], At[m][k], acc[ai][bj][m][n], 0, 0, 0); __builtin_amdgcn_s_setprio(0); } while (0)
#define PG8_WAIT_V(n) asm volatile("s_waitcnt vmcnt(" #n ")" ::: "memory")
#define PG8_WAIT_L(n) asm volatile("s_waitcnt lgkmcnt(" #n ")" ::: "memory")
#define PG8_BAR __builtin_amdgcn_s_barrier()
#define PG8_SCHED __builtin_amdgcn_sched_barrier(0)
    Unit cur, nxt; int ui = 0;
    if (!S.next(0, cur)) return;
    f32x4 acc[2][2][4][2];
#pragma unroll
    for (int a = 0; a < 2; ++a)
#pragma unroll
        for (int b = 0; b < 2; ++b)
#pragma unroll
            for (int m = 0; m < 4; ++m)
#pragma unroll
                for (int n = 0; n < 2; ++n) acc[a][b][m][n] = (f32x4){0.f, 0.f, 0.f, 0.f};
    bf16x8 At[4][2], B0[2][2], B1[2][2];
    const char* cA = GATHER ? (const char*)g.A : (const char*)g.A + (size_t)cur.pm * tstep; const char* cB = (const char*)g.Bt + (size_t)cur.bn * tstep;
    PG8_LOADG(0);
    PG8_STAGE(PG8_SB(0, 0), cB, voffB); PG8_STAGE_A(PG8_SA(0, 0), cA, 0); PG8_STAGE(PG8_SB(0, 1), cB + hstep, voffB); PG8_STAGE_A(PG8_SA(0, 1), cA, 1);
    if (wr == 1) PG8_BAR;
    PG8_WAIT_V(4); PG8_BAR;
    PG8_STAGE(PG8_SB(1, 0), cB + kstep, voffB); PG8_STAGE_A(PG8_SA(1, 0), cA + kstep, 0); PG8_STAGE(PG8_SB(1, 1), cB + hstep + kstep, voffB);
    PG8_WAIT_V(6); PG8_BAR;
    PG8_STAMP();
    for (;;) {
        const bool has_next = S.next(ui + 1, nxt);
        const char* nA = has_next ? (GATHER ? (const char*)g.A : (const char*)g.A + (size_t)nxt.pm * tstep) : cA; const char* nB = has_next ? (const char*)g.Bt + (size_t)nxt.bn * tstep : cB;
        for (int t = 0; t < nt; t += 2) {
            const bool last = (t == nt - 2);
            const char* a1 = cA + (size_t)(t + 1) * kstep;
            const char* a2 = last ? nA : cA + (size_t)(t + 2) * kstep; const char* b2 = last ? nB : cB + (size_t)(t + 2) * kstep;
            const char* a3 = a2 + kstep; const char* b3 = b2 + kstep;
            PG8_LDB(B0, 0, 0); PG8_SCHED; PG8_LDA(At, 0, 0); PG8_STAGE_A(PG8_SA(1, 1), a1, 1);
            PG8_WAIT_L(8); PG8_BAR; PG8_WAIT_L(0); PG8_MMA(0, 0, At, B0); PG8_BAR; PG8_SCHED;
            if (last && has_next) PG8_LOADG(ui + 1);
            PG8_LDB(B1, 0, 1); PG8_STAGE(PG8_SB(0, 0), b2, voffB);
            PG8_BAR; PG8_WAIT_L(0); PG8_MMA(0, 1, At, B1); PG8_BAR;
            PG8_LDA(At, 0, 1); PG8_STAGE_A(PG8_SA(0, 0), a2, 0);
            PG8_BAR; PG8_WAIT_L(0); PG8_MMA(1, 0, At, B0); PG8_BAR; PG8_SCHED;
            PG8_STAGE(PG8_SB(0, 1), b2 + hstep, voffB);
            PG8_WAIT_V(6); PG8_BAR; PG8_MMA(1, 1, At, B1); PG8_BAR;
            PG8_LDB(B0, 1, 0); PG8_SCHED; PG8_LDA(At, 1, 0); PG8_STAGE_A(PG8_SA(0, 1), a2, 1);
            PG8_WAIT_L(8); PG8_BAR; PG8_WAIT_L(0); PG8_MMA(0, 0, At, B0); PG8_BAR; PG8_SCHED;
            PG8_LDB(B1, 1, 1); PG8_STAGE(PG8_SB(1, 0), b3, voffB);
            PG8_BAR; PG8_WAIT_L(0); PG8_MMA(0, 1, At, B1); PG8_BAR;
            PG8_LDA(At, 1, 1); PG8_STAGE_A(PG8_SA(1, 0), a3, 0);
            PG8_BAR; PG8_WAIT_L(0); PG8_MMA(1, 0, At, B0); PG8_BAR; PG8_SCHED;
            PG8_STAGE(PG8_SB(1, 1), b3 + hstep, voffB);
            PG8_WAIT_V(6); PG8_BAR; PG8_MMA(1, 1, At, B1); PG8_BAR;
        }
        PG8_STAMP();
        E(acc, cur, wr, wc, fr, fq);
        PG8_STAMP();
        if (!has_next) break;
#pragma unroll
        for (int a = 0; a < 2; ++a)
#pragma unroll
            for (int b = 0; b < 2; ++b)
#pragma unroll
                for (int m = 0; m < 4; ++m)
#pragma unroll
                    for (int n = 0; n < 2; ++n) acc[a][b][m][n] = (f32x4){0.f, 0.f, 0.f, 0.f};
        cur = nxt; cA = nA; cB = nB; ++ui;
    }
    PG8_WAIT_V(0);
    if (wr == 0) PG8_BAR;
    PG8_BAR;
    PG8_STAMP();
#undef PG8_STAMP
#undef PG8_SA
#undef PG8_SB
#undef PG8_STAGE
#undef PG8_STAGE_A
#undef PG8_LOADG
#undef PG8_LDA
#undef PG8_LDB
#undef PG8_MMA
#undef PG8_WAIT_V
#undef PG8_WAIT_L
#undef PG8_BAR
#undef PG8_SCHED
}
}
namespace {
using pg8::f32x4; using pg8::u32x4; using pg8::cvt_pk_bf16;
#define LAS __attribute__((address_space(3)))

template <class ARow, class Epi>
__device__ __forceinline__ void gemm_tile(float* smem, int mvalid, int nvalid, int K, ARow arow, const float* Bp, int ldb, Epi epi) {
  float* As = smem;
  float* Bs = smem + 16 * 68;
  const int tid = threadIdx.x, ty = tid >> 5, tx = tid & 31;
  float acc[4][4];
#pragma unroll
  for (int i = 0; i < 4; ++i)
#pragma unroll
    for (int j = 0; j < 4; ++j) acc[i][j] = 0.f;
  const int ak = tid & 15, ar = tid >> 4;
  const float* ap0 = (ar < mvalid) ? arow(ar) : nullptr;
  const float* ap1 = (ar + 32 < mvalid) ? arow(ar + 32) : nullptr;
  const int bn = tid & 127, bk = tid >> 7;
  for (int k0 = 0; k0 < K; k0 += 16) {
    As[ak * 68 + ar] = ap0 ? ap0[k0 + ak] : 0.f;
    As[ak * 68 + ar + 32] = ap1 ? ap1[k0 + ak] : 0.f;
#pragma unroll
    for (int i = 0; i < 4; ++i) { const int kk = bk + 4 * i; Bs[kk * 128 + bn] = (bn < nvalid) ? Bp[(size_t)(k0 + kk) * ldb + bn] : 0.f; }
    __syncthreads();
#pragma unroll
    for (int kk = 0; kk < 16; ++kk) {
      float a[4], b[4];
#pragma unroll
      for (int i = 0; i < 4; ++i) a[i] = As[kk * 68 + ty * 4 + i];
#pragma unroll
      for (int j = 0; j < 4; ++j) b[j] = Bs[kk * 128 + tx * 4 + j];
#pragma unroll
      for (int i = 0; i < 4; ++i)
#pragma unroll
        for (int j = 0; j < 4; ++j) acc[i][j] += a[i] * b[j];
    }
    __syncthreads();
  }
#pragma unroll
  for (int i = 0; i < 4; ++i)
#pragma unroll
    for (int j = 0; j < 4; ++j) { const int r = ty * 4 + i, c = tx * 4 + j; if (r < mvalid && c < nvalid) epi(r, c, acc[i][j]); }
}

template <class RowMap>
__device__ __forceinline__ void cvt_tile(const float* __restrict__ src, int N, int K, int k0, int n0, bf16_t* __restrict__ dst, RowMap rm) {
  const int lane = threadIdx.x & 63, w = threadIdx.x >> 6;
  const int n = n0 + (lane & 15) * 4, kk = k0 + (w * 4 + (lane >> 4)) * 8;
  if (n >= N) return;
  float4 v[8];
#pragma unroll
  for (int j = 0; j < 8; ++j) v[j] = *(const float4*)(src + (size_t)(kk + j) * N + n);
  u32x4 o;
  o.x = cvt_pk_bf16(v[0].x, v[1].x); o.y = cvt_pk_bf16(v[2].x, v[3].x); o.z = cvt_pk_bf16(v[4].x, v[5].x); o.w = cvt_pk_bf16(v[6].x, v[7].x);
  *(u32x4*)(dst + (size_t)rm(n + 0) * K + kk) = o;
  o.x = cvt_pk_bf16(v[0].y, v[1].y); o.y = cvt_pk_bf16(v[2].y, v[3].y); o.z = cvt_pk_bf16(v[4].y, v[5].y); o.w = cvt_pk_bf16(v[6].y, v[7].y);
  *(u32x4*)(dst + (size_t)rm(n + 1) * K + kk) = o;
  o.x = cvt_pk_bf16(v[0].z, v[1].z); o.y = cvt_pk_bf16(v[2].z, v[3].z); o.z = cvt_pk_bf16(v[4].z, v[5].z); o.w = cvt_pk_bf16(v[6].z, v[7].z);
  *(u32x4*)(dst + (size_t)rm(n + 2) * K + kk) = o;
  o.x = cvt_pk_bf16(v[0].w, v[1].w); o.y = cvt_pk_bf16(v[2].w, v[3].w); o.z = cvt_pk_bf16(v[4].w, v[5].w); o.w = cvt_pk_bf16(v[6].w, v[7].w);
  *(u32x4*)(dst + (size_t)rm(n + 3) * K + kk) = o;
}
template <class RowMap>
__device__ void cvt_job(const float* src, int nmat, int K, int N, bf16_t* dst, size_t dstride, RowMap rm) {
  const int kt = K / 256, ntl = (N + 63) / 64, per = kt * ntl;
  for (int it = blockIdx.x; it < nmat * per; it += gridDim.x) {
    const int m = it / per, r = it % per, k0 = (r / ntl) * 256, n0 = (r % ntl) * 64;
    cvt_tile(src + (size_t)m * K * N, N, K, k0, n0, dst + (size_t)m * dstride, rm);
  }
}
__device__ void ph_convert(const Params& p) {
  const size_t gtid = (size_t)blockIdx.x * NT + threadIdx.x, gsz = (size_t)gridDim.x * NT;
  for (size_t i = gtid; i < (size_t)T * D / 8; i += gsz) {
    const float4 a = *(const float4*)(p.x + i * 8), b = *(const float4*)(p.x + i * 8 + 4);
    u32x4 o; o.x = cvt_pk_bf16(a.x, a.y); o.y = cvt_pk_bf16(a.z, a.w); o.z = cvt_pk_bf16(b.x, b.y); o.w = cvt_pk_bf16(b.z, b.w);
    *(u32x4*)(p.xb + i * 8) = o;
  }
  cvt_job(p.w_in, 1, D, PW, p.WinT, 0, [](int n) { return n < O_DT ? n : (n < O_Q ? PLD + (n - O_DT) : n - 32); });
  for (size_t i = gtid; i < (size_t)(NPROJ - PW) * D / 8; i += gsz) *(u32x4*)(p.WinT + (size_t)PW * D + i * 8) = (u32x4){0u, 0u, 0u, 0u};
  cvt_job(p.w_out, 1, D, D, p.WoutT, 0, [](int n) { return n; });
  cvt_job(p.wg_e, NE, D, DE, p.WguT, (size_t)1024 * D, [](int n) { return (n >> 7) * 256 + (n & 127); });
  cvt_job(p.wu_e, NE, D, DE, p.WguT, (size_t)1024 * D, [](int n) { return (n >> 7) * 256 + 128 + (n & 127); });
  cvt_job(p.wg_s, 1, D, DE, p.WguT + (size_t)NE * 1024 * D, 0, [](int n) { return (n >> 7) * 256 + (n & 127); });
  cvt_job(p.wu_s, 1, D, DE, p.WguT + (size_t)NE * 1024 * D, 0, [](int n) { return (n >> 7) * 256 + 128 + (n & 127); });
  cvt_job(p.wd_e, NE, DE, D, p.WdT, (size_t)D * DE, [](int n) { return n; });
  cvt_job(p.wd_s, 1, DE, D, p.WdT + (size_t)NE * D * DE, 0, [](int n) { return n; });
}

struct EpiProj {
  static constexpr bool PERM = true;
  bf16_t* proj; float* dt; const float* bias_f; const float* bias_b;
  __device__ __forceinline__ void operator()(const f32x4 (&acc)[2][2][4][2], const pg8::Unit& u, int wr, int wc, int fr, int fq) const {
    const int row0 = u.pm * 256 + wr * 64 + fr;
    if (u.pn < 22) {
      const int col0 = u.pn * 256 + wc * 32 + 8 * fq;
      const float sc = (u.pn >= 10 && u.pn < 14) ? QS : 1.0f;
#pragma unroll
      for (int ai = 0; ai < 2; ++ai)
#pragma unroll
        for (int m = 0; m < 4; ++m) { bf16_t* rowp = proj + (size_t)(row0 + ai * 128 + m * 16) * PLD + col0;
#pragma unroll
          for (int bj = 0; bj < 2; ++bj) { const f32x4 v0 = acc[ai][bj][m][0] * sc, v1 = acc[ai][bj][m][1] * sc;
            u32x4 w; w.x = cvt_pk_bf16(v0[0], v0[1]); w.y = cvt_pk_bf16(v0[2], v0[3]); w.z = cvt_pk_bf16(v1[0], v1[1]); w.w = cvt_pk_bf16(v1[2], v1[3]);
            *(u32x4*)(rowp + bj * 128) = w; } }
    } else if (wc == 0) {
      const int c0 = 8 * fq;
      float bs[8];
#pragma unroll
      for (int j = 0; j < 8; ++j) bs[j] = (c0 + j) < 16 ? bias_f[c0 + j] : bias_b[c0 + j - 16];
#pragma unroll
      for (int ai = 0; ai < 2; ++ai)
#pragma unroll
        for (int m = 0; m < 4; ++m) { float* rowp = dt + (size_t)(row0 + ai * 128 + m * 16) * 32 + c0;
          const f32x4 v0 = acc[ai][0][m][0], v1 = acc[ai][0][m][1];
          f32x4 o0, o1;
#pragma unroll
          for (int j = 0; j < 4; ++j) { o0[j] = softplus_f(v0[j] + bs[j]); o1[j] = softplus_f(v1[j] + bs[4 + j]); }
          *(f32x4*)rowp = o0; *(f32x4*)(rowp + 4) = o1; }
    }
  }
};
struct EpiOut {
  static constexpr bool PERM = false;
  const float* x; float* v;
  __device__ __forceinline__ void operator()(const f32x4 (&acc)[2][2][4][2], const pg8::Unit& u, int wr, int wc, int fr, int fq) const {
    const int row0 = u.pm * 256 + wr * 64 + fr, col0 = u.pn * 256 + wc * 32 + 4 * fq;
#pragma unroll
    for (int ai = 0; ai < 2; ++ai)
#pragma unroll
      for (int m = 0; m < 4; ++m) { const size_t off = (size_t)(row0 + ai * 128 + m * 16) * D + col0;
#pragma unroll
        for (int bj = 0; bj < 2; ++bj)
#pragma unroll
          for (int n = 0; n < 2; ++n) { const f32x4 xv = *(const f32x4*)(x + off + bj * 128 + n * 16); *(f32x4*)(v + off + bj * 128 + n * 16) = xv * ALPHA + acc[ai][bj][m][n]; } }
  }
};

namespace at {
using bf16x8 = __attribute__((ext_vector_type(8))) short;
using s16x4  = __attribute__((ext_vector_type(4))) short;
using f32x16 = __attribute__((ext_vector_type(16))) float;
using u32x4  = __attribute__((ext_vector_type(4))) unsigned;
constexpr int KVBLK = 64;
constexpr size_t SHM_V = KVBLK * 128 * 2, SHM_K = KVBLK * 128 * 2;
constexpr float THR2 = 8.0f;
#define AT_KSWZ(row, colB) ((row) * 256 + ((colB) ^ (((row) & 7) << 4)))
#define AT_SBAR() __builtin_amdgcn_sched_barrier(0)
__device__ __forceinline__ int crow(int r, int hi) { return (r & 3) + 8 * (r >> 2) + 4 * hi; }
__device__ __forceinline__ unsigned cvtpk(float lo, float hi) { unsigned r; asm volatile("v_cvt_pk_bf16_f32 %0, %1, %2" : "=v"(r) : "v"(lo), "v"(hi)); return r; }

__device__ __forceinline__ void partialSM(f32x16& p0, f32x16& p1, float dqh, float nsl2, float& m_reg, float& mn, float& alpha) {
#pragma unroll
  for (int r = 0; r < 16; ++r) { const float c = (float)((r & 3) + 8 * (r >> 2));
    p0[r] = fmaf(nsl2, fabsf(dqh - c), p0[r]); p1[r] = fmaf(nsl2, fabsf(dqh - (c + 32.f)), p1[r]); }
  float pmax = p0[0];
#pragma unroll
  for (int r = 1; r < 16; ++r) pmax = fmaxf(pmax, p0[r]);
#pragma unroll
  for (int r = 0; r < 16; ++r) pmax = fmaxf(pmax, p1[r]);
  { auto rr = __builtin_amdgcn_permlane32_swap(__float_as_uint(pmax), __float_as_uint(pmax), false, false);
    pmax = fmaxf(__uint_as_float(rr[0]), __uint_as_float(rr[1])); }
  if (__builtin_expect(__all(pmax - m_reg <= THR2), 1)) { mn = m_reg; alpha = 1.f; }
  else { mn = fmaxf(m_reg, pmax); alpha = __builtin_amdgcn_exp2f(m_reg - mn); m_reg = mn; }
#pragma unroll
  for (int r = 0; r < 16; ++r) p0[r] = p0[r] - mn;
#pragma unroll
  for (int r = 0; r < 16; ++r) p1[r] = p1[r] - mn;
#pragma unroll
  for (int r = 0; r < 16; ++r) p0[r] = __builtin_amdgcn_exp2f(p0[r]);
}
__device__ __forceinline__ void finishSM(f32x16& p0, f32x16& p1, float alpha, float& l_reg, bf16x8& pa0, bf16x8& pa1, bf16x8& pa2, bf16x8& pa3) {
#pragma unroll
  for (int r = 0; r < 16; ++r) p1[r] = __builtin_amdgcn_exp2f(p1[r]);
  float ps = 0;
#pragma unroll
  for (int r = 0; r < 16; ++r) ps += p0[r];
#pragma unroll
  for (int r = 0; r < 16; ++r) ps += p1[r];
  { auto rr = __builtin_amdgcn_permlane32_swap(__float_as_uint(ps), __float_as_uint(ps), false, false);
    ps = __uint_as_float(rr[0]) + __uint_as_float(rr[1]); }
  l_reg = l_reg * alpha + ps;
#define AT_PK4(P, BASE, OUT) do { unsigned a0 = cvtpk(P[BASE + 0], P[BASE + 1]), a1 = cvtpk(P[BASE + 2], P[BASE + 3]);   \
    unsigned b0 = cvtpk(P[BASE + 4], P[BASE + 5]), b1 = cvtpk(P[BASE + 6], P[BASE + 7]);                              \
    auto r0 = __builtin_amdgcn_permlane32_swap(a0, b0, false, false); auto r1 = __builtin_amdgcn_permlane32_swap(a1, b1, false, false); \
    u32x4 w = {r0[0], r1[0], r0[1], r1[1]}; OUT = *reinterpret_cast<bf16x8*>(&w); } while (0)
  AT_PK4(p0, 0, pa0); AT_PK4(p0, 8, pa1); AT_PK4(p1, 0, pa2); AT_PK4(p1, 8, pa3);
#undef AT_PK4
}
__device__ __forceinline__ void qkt(f32x16& p0, f32x16& p1, const char* Ks, const bf16x8* qr, int r32, int hi, int cm) {
  p0 = f32x16{}; p1 = f32x16{};
#pragma unroll
  for (int d0 = 0; d0 < 4; ++d0) { const int cb = (cm + d0 * 16 + hi * 8) * 2;
    bf16x8 b0 = *reinterpret_cast<const bf16x8*>(Ks + AT_KSWZ(r32, cb));
    bf16x8 b1 = *reinterpret_cast<const bf16x8*>(Ks + AT_KSWZ(32 + r32, cb));
    p0 = __builtin_amdgcn_mfma_f32_32x32x16_bf16(b0, qr[d0], p0, 0, 0, 0);
    p1 = __builtin_amdgcn_mfma_f32_32x32x16_bf16(b1, qr[d0], p1, 0, 0, 0); }
}
__device__ __forceinline__ int v_st(int k, int c) { const int kk = (k & ~0xC) | ((k & 4) << 1) | ((k & 8) >> 1); return ((kk >> 3) * 4 + (c >> 5)) * 512 + ((kk & 7) * 32 + (c & 31)) * 2; }
__device__ __forceinline__ int v_rd_base(int lane) { return ((lane & 3) << 3) | (((lane >> 2) & 3) << 6) | (((lane >> 4) & 1) << 5) | (((lane >> 5) & 1) << 8); }
constexpr int v_rd_off(int d0, int ks, int half) { return d0 * 512 + ks * 4096 + half * 2048; }
template <int OFF> __device__ __forceinline__ s16x4 tr_read(int vb) {
  s16x4 r; asm volatile("ds_read_b64_tr_b16 %0, %1 offset:%2" : "=&v"(r) : "v"(vb), "i"(OFF) : "memory"); return r;
}
template <int D0> __device__ __forceinline__ void pv_one(f32x16& od, int vb, bf16x8 pa0, bf16x8 pa1, bf16x8 pa2, bf16x8 pa3) {
  const s16x4 l0 = tr_read<v_rd_off(D0, 0, 0)>(vb), h0 = tr_read<v_rd_off(D0, 0, 1)>(vb), l1 = tr_read<v_rd_off(D0, 1, 0)>(vb), h1 = tr_read<v_rd_off(D0, 1, 1)>(vb);
  const s16x4 l2 = tr_read<v_rd_off(D0, 2, 0)>(vb), h2 = tr_read<v_rd_off(D0, 2, 1)>(vb), l3 = tr_read<v_rd_off(D0, 3, 0)>(vb), h3 = tr_read<v_rd_off(D0, 3, 1)>(vb);
  asm volatile("s_waitcnt lgkmcnt(0)" ::: "memory"); AT_SBAR();
#define AT_PK(L, H) (bf16x8){L[0], L[1], L[2], L[3], H[0], H[1], H[2], H[3]}
  od = __builtin_amdgcn_mfma_f32_32x32x16_bf16(pa0, AT_PK(l0, h0), od, 0, 0, 0);
  od = __builtin_amdgcn_mfma_f32_32x32x16_bf16(pa1, AT_PK(l1, h1), od, 0, 0, 0);
  od = __builtin_amdgcn_mfma_f32_32x32x16_bf16(pa2, AT_PK(l2, h2), od, 0, 0, 0);
  od = __builtin_amdgcn_mfma_f32_32x32x16_bf16(pa3, AT_PK(l3, h3), od, 0, 0, 0);
#undef AT_PK
}
__device__ __forceinline__ void pv_d0(f32x16* o, int vb, bf16x8 pa0, bf16x8 pa1, bf16x8 pa2, bf16x8 pa3) {
  pv_one<0>(o[0], vb, pa0, pa1, pa2, pa3); pv_one<1>(o[1], vb, pa0, pa1, pa2, pa3); pv_one<2>(o[2], vb, pa0, pa1, pa2, pa3); pv_one<3>(o[3], vb, pa0, pa1, pa2, pa3);
}

__device__ __forceinline__ void attn_item(const bf16_t* __restrict__ Qb, const bf16_t* __restrict__ Kh, const bf16_t* __restrict__ Vh, bf16_t* __restrict__ Ub,
                                          int q0, float nsl2, float lam, const float* __restrict__ normw, char* lds) {
  constexpr int LDK = PLD;
  int tid = threadIdx.x; asm volatile("" : "+v"(tid));
  const int wid = tid >> 6, lane = tid & 63, r32 = lane & 31, hi = lane >> 5, rg = wid >> 1, cmap = wid & 1, cm = cmap * 64;
  char* V_lds = lds; char* K_lds = lds + 2 * SHM_V;
  float* ws = (float*)(lds + 2 * SHM_V + 2 * SHM_K) + wid * 64; float* li_l = ws; float* al_l = ws + 32;
  float m_reg = -1e30f, l_reg = 0; f32x16 o[4] = {}; bf16x8 qr[4];
  const bf16_t* Qw = Qb + (size_t)(rg * 32 + r32) * LDK + cm + hi * 8;
#pragma unroll
  for (int d0 = 0; d0 < 4; ++d0) qr[d0] = *reinterpret_cast<const bf16x8*>(Qw + d0 * 16);
  const int sr = tid >> 4, sc = (tid & 15) * 8, vst0 = v_st(sr, sc), vst1 = v_st(32 + sr, sc);
  const int vb0 = (int)(uintptr_t)V_lds + v_rd_base(lane);
  const float qposh = (float)(q0 + rg * 32 + r32 - 4 * hi);
  struct { bf16x8 vs0, vs1, ks0, ks1; } sr_[2];
#define SLOAD(i, k0) do { sr_[i].vs0 = *reinterpret_cast<const bf16x8*>(&Vh[(size_t)((k0) + sr) * LDK + sc]); sr_[i].vs1 = *reinterpret_cast<const bf16x8*>(&Vh[(size_t)((k0) + 32 + sr) * LDK + sc]); \
    sr_[i].ks0 = *reinterpret_cast<const bf16x8*>(&Kh[(size_t)((k0) + sr) * LDK + sc]); sr_[i].ks1 = *reinterpret_cast<const bf16x8*>(&Kh[(size_t)((k0) + 32 + sr) * LDK + sc]); } while (0)
#define SWRITE(b, i) do { *(bf16x8*)(V_lds + (b) * SHM_V + vst0) = sr_[i].vs0;          \
    *(bf16x8*)(V_lds + (b) * SHM_V + vst1) = sr_[i].vs1; int kc = sc * 2;               \
    *(bf16x8*)(K_lds + (b) * SHM_K + AT_KSWZ(sr, kc)) = sr_[i].ks0;                       \
    *(bf16x8*)(K_lds + (b) * SHM_K + AT_KSWZ(32 + sr, kc)) = sr_[i].ks1; } while (0)
#define SWAIT() asm volatile("s_waitcnt vmcnt(4)" ::: "memory")
#define RESC(a) do { if (__any((a) < 1.f)) { if (hi == 0) al_l[r32] = (a); asm volatile("s_waitcnt lgkmcnt(0)" ::: "memory"); \
    _Pragma("unroll") for (int d = 0; d < 4; ++d) _Pragma("unroll") for (int r = 0; r < 16; ++r) o[d][r] *= al_l[crow(r, hi)]; } } while (0)
  f32x16 pA0, pA1, pB0, pB1; float mnA, mnB, alA, alB; bf16x8 pa0, pa1, pa2, pa3; constexpr int NTL = S / KVBLK;
  constexpr int SE = 0, SO = 1;
  SLOAD(SE, 0); asm volatile("s_waitcnt vmcnt(0)" ::: "memory"); SWRITE(0, SE); __syncthreads();
  qkt(pA0, pA1, K_lds, qr, r32, hi, cm); partialSM(pA0, pA1, qposh, nsl2, m_reg, mnA, alA);
  SLOAD(SO, KVBLK); SLOAD(SE, 2 * KVBLK);
  SWAIT(); SWRITE(1, SO); __syncthreads();
  for (int j = 1; j + 1 < NTL; j += 2) {
    AT_SBAR(); qkt(pB0, pB1, K_lds + SHM_K, qr, r32, hi, cm);
    finishSM(pA0, pA1, alA, l_reg, pa0, pa1, pa2, pa3); AT_SBAR();
    SLOAD(SO, (j + 2) * KVBLK); AT_SBAR();
    pv_d0(o, vb0, pa0, pa1, pa2, pa3); partialSM(pB0, pB1, qposh - (float)(j * KVBLK), nsl2, m_reg, mnB, alB);
    __syncthreads(); SWAIT(); SWRITE(0, SE);
    RESC(alB); __syncthreads();
    AT_SBAR(); qkt(pA0, pA1, K_lds, qr, r32, hi, cm);
    finishSM(pB0, pB1, alB, l_reg, pa0, pa1, pa2, pa3); AT_SBAR();
    if (j + 3 < NTL) SLOAD(SE, (j + 3) * KVBLK); AT_SBAR();
    pv_d0(o, vb0 + (int)SHM_V, pa0, pa1, pa2, pa3); partialSM(pA0, pA1, qposh - (float)((j + 1) * KVBLK), nsl2, m_reg, mnA, alA);
    __syncthreads(); SWAIT(); SWRITE(1, SO);
    RESC(alA); __syncthreads();
  }
  AT_SBAR(); qkt(pB0, pB1, K_lds + SHM_K, qr, r32, hi, cm);
  finishSM(pA0, pA1, alA, l_reg, pa0, pa1, pa2, pa3); AT_SBAR();
  pv_d0(o, vb0, pa0, pa1, pa2, pa3); partialSM(pB0, pB1, qposh - (float)((NTL - 1) * KVBLK), nsl2, m_reg, mnB, alB);
  __syncthreads(); RESC(alB);
  finishSM(pB0, pB1, alB, l_reg, pa0, pa1, pa2, pa3); AT_SBAR();
  pv_d0(o, vb0 + (int)SHM_V, pa0, pa1, pa2, pa3);
  if (hi == 0) li_l[r32] = l_reg; asm volatile("s_waitcnt lgkmcnt(0)" ::: "memory");
  float rli[16];
#pragma unroll
  for (int r = 0; r < 16; ++r) rli[r] = __builtin_amdgcn_rcpf(li_l[crow(r, hi)]);
#pragma unroll
  for (int d = 0; d < 4; ++d)
#pragma unroll
    for (int r = 0; r < 16; ++r) o[d][r] *= rli[r];
  __syncthreads();
  float* X = (float*)lds + rg * (32 * 128);
  if (cmap == 1) {
#pragma unroll
    for (int d = 0; d < 4; ++d)
#pragma unroll
      for (int r = 0; r < 16; ++r) X[crow(r, hi) * 128 + d * 32 + r32] = o[d][r];
  }
  __syncthreads();
  if (cmap == 0) {
    float ss[16];
#pragma unroll
    for (int r = 0; r < 16; ++r) ss[r] = 0.f;
#pragma unroll
    for (int d = 0; d < 4; ++d)
#pragma unroll
      for (int r = 0; r < 16; ++r) { const float v = o[d][r] - lam * X[crow(r, hi) * 128 + d * 32 + r32]; o[d][r] = v; ss[r] += v * v; }
#pragma unroll
    for (int r = 0; r < 16; ++r) { float s = ss[r]; s += __shfl_xor(s, 16); s += __shfl_xor(s, 8); s += __shfl_xor(s, 4); s += __shfl_xor(s, 2); s += __shfl_xor(s, 1);
      ss[r] = rsqrtf(s * (1.f / 128.f) + 1e-5f) * (1.f - LAMBDA_INIT); }
    float nw[4];
#pragma unroll
    for (int d = 0; d < 4; ++d) nw[d] = normw[d * 32 + r32];
#pragma unroll
    for (int r = 0; r < 16; ++r) { bf16_t* up = Ub + (size_t)(rg * 32 + crow(r, hi)) * D + r32;
#pragma unroll
      for (int d = 0; d < 4; ++d) up[d * 32] = f2bf(o[d][r] * ss[r] * nw[d]); }
  }
  __syncthreads();
#undef SLOAD
#undef SWRITE
#undef SWAIT
#undef RESC
}
}

__device__ void ph_attn_mfma(const Params& p, char* lds) {
  float lam;
  { float s1 = 0.f, s2 = 0.f; for (int i = 0; i < 64; ++i) { s1 += p.lq1[i] * p.lk1[i]; s2 += p.lq2[i] * p.lk2[i]; } lam = __expf(s1) - __expf(s2) + LAMBDA_INIT; }
  for (int item = blockIdx.x; item < NB * AH * (S / 128); item += gridDim.x) {
    const int qb = item % (S / 128), h = (item / (S / 128)) % AH, b = item / ((S / 128) * AH);
    const float nsl2 = -exp2f(-(float)(h + 1)) * LOG2E;
    const size_t row0 = (size_t)b * S;
    at::attn_item(p.proj + (row0 + qb * 128) * PLD + N_Q + h * 128, p.proj + row0 * PLD + N_K + h * 128, p.proj + row0 * PLD + N_V + h * 128,
                  p.u + (row0 + qb * 128) * D + DSSD + h * 128, qb * 128, nsl2, lam, p.attn_norm_w, lds);
  }
}
__device__ void ph_inproj(const Params& p, LAS unsigned char* lds) {
  pg8::Gemm g{p.xb, p.WinT, D}; pg8::OrderStatic Sd; Sd.init(T, NPROJ, gridDim.x, blockIdx.x);
  EpiProj E{p.proj, p.dt, p.dt_bias_f, p.dt_bias_b};
  pg8::gemm_phase<false>(lds, g, Sd, E);
}
__device__ void ph_conv(const Params& p) {
  const size_t gtid = (size_t)blockIdx.x * NT + threadIdx.x, gsz = (size_t)gridDim.x * NT;
  for (size_t i = gtid; i < (size_t)T * CC; i += gsz) {
    const int t = (int)(i / CC), c = (int)(i % CC), s = t % S;
    float a = p.conv_b[c];
#pragma unroll
    for (int j = 0; j < 5; ++j) { const int ss = s + j - 2; if (ss >= 0 && ss < S) a += p.conv_w[j * CC + c] * bf2f(p.proj[(size_t)(t + j - 2) * PLD + N_XBC + c]); }
    p.xc[i] = silu_f(a);
  }
}
__device__ void ph_ssd(const Params& p) {
  const int lane = threadIdx.x & 63, wv = threadIdx.x >> 6;
  for (int item = wv * gridDim.x + blockIdx.x; item < NB * NH * 2; item += gridDim.x * 8) {
    const int dir = item & 1, h = (item >> 1) % NH, b = item / (2 * NH), g = h / 8;
    const float a = -__expf(dir ? p.a_log_b[h] : p.a_log_f[h]);
    float st[NS];
#pragma unroll
    for (int n = 0; n < NS; ++n) st[n] = 0.f;
    float* yo = dir ? p.yb : p.yf;
    for (int step = 0; step < S; ++step) {
      const int t = dir ? (S - 1 - step) : step; const size_t tok = (size_t)b * S + t;
      const float dtv = p.dt[tok * 32 + dir * 16 + h];
      const float dA = __expf(a * dtv);
      const float dtx = dtv * p.xc[tok * CC + h * HD + lane];
      const float4* Bp = (const float4*)(p.xc + tok * CC + DSSD + g * NS);
      const float4* Cp = (const float4*)(p.xc + tok * CC + DSSD + 2 * NS + g * NS);
      float y = 0.f;
#pragma unroll
      for (int n4 = 0; n4 < NS / 4; ++n4) {
        const float4 bv = Bp[n4], cv = Cp[n4];
        st[4 * n4 + 0] = st[4 * n4 + 0] * dA + dtx * bv.x; y += st[4 * n4 + 0] * cv.x;
        st[4 * n4 + 1] = st[4 * n4 + 1] * dA + dtx * bv.y; y += st[4 * n4 + 1] * cv.y;
        st[4 * n4 + 2] = st[4 * n4 + 2] * dA + dtx * bv.z; y += st[4 * n4 + 2] * cv.z;
        st[4 * n4 + 3] = st[4 * n4 + 3] * dA + dtx * bv.w; y += st[4 * n4 + 3] * cv.w;
      }
      yo[tok * DSSD + h * HD + lane] = y;
    }
  }
}
__device__ void ph_ssdfin(const Params& p) {
  const int lane = threadIdx.x & 63, wv = threadIdx.x >> 6;
  for (int item = blockIdx.x * 8 + wv; item < T * 2; item += gridDim.x * 8) {
    const int t = item >> 1, g = item & 1;
    float y[8]; float ss = 0.f;
#pragma unroll
    for (int j = 0; j < 8; ++j) {
      const int ch = g * 512 + j * 64 + lane, h = ch / HD;
      const float xs = p.xc[(size_t)t * CC + ch];
      const float z = bf2f(p.proj[(size_t)t * PLD + N_Z + ch]);
      const float v = (p.yf[(size_t)t * DSSD + ch] + p.yb[(size_t)t * DSSD + ch] + p.d_skip[h] * xs) * silu_f(z);
      y[j] = v; ss += v * v;
    }
    ss = wave_sum(ss);
    const float rstd = rsqrtf(ss * (1.f / 512.f) + 1e-5f);
#pragma unroll
    for (int j = 0; j < 8; ++j) { const int ch = g * 512 + j * 64 + lane; p.u[(size_t)t * D + ch] = f2bf(y[j] * rstd * p.ssd_norm_w[ch]); }
  }
}
__device__ void ph_outproj(const Params& p, LAS unsigned char* lds) {
  pg8::Gemm g{p.u, p.WoutT, D}; pg8::OrderStatic Sd; Sd.init(T, D, gridDim.x, blockIdx.x);
  EpiOut E{p.x, p.h1};
  pg8::gemm_phase<false>(lds, g, Sd, E);
}
__device__ void ph_ln1(const Params& p) {
  const int lane = threadIdx.x & 63, wv = threadIdx.x >> 6;
  for (int row = blockIdx.x * 8 + wv; row < T; row += gridDim.x * 8) {
    float* hp = p.h1 + (size_t)row * D; float v[32]; float s = 0.f;
#pragma unroll
    for (int j = 0; j < 32; ++j) { v[j] = hp[j * 64 + lane]; s += v[j]; }
    const float mu = wave_sum(s) * (1.f / D); float q = 0.f;
#pragma unroll
    for (int j = 0; j < 32; ++j) { const float d = v[j] - mu; q += d * d; }
    const float rstd = rsqrtf(wave_sum(q) * (1.f / D) + 1e-5f);
#pragma unroll
    for (int j = 0; j < 32; ++j) { const int c = j * 64 + lane; const float o = (v[j] - mu) * rstd * p.ln1_g[c] + p.ln1_b[c]; hp[c] = o; p.h1b[(size_t)row * D + c] = f2bf(o); }
  }
}
__device__ void ph_router(const Params& p, float* smem) {
  for (int mt = blockIdx.x; mt < T / 64; mt += gridDim.x) {
    const int m0 = mt * 64;
    gemm_tile(smem, 64, NE, D, [&](int r) { return p.h1 + (size_t)(m0 + r) * D; }, p.w_router, NE,
              [&](int r, int c, float v) { p.logits[(size_t)(m0 + r) * NE + c] = v; });
  }
}
__device__ __forceinline__ int ld_agent(const int* p) { return __hip_atomic_load(p, __ATOMIC_RELAXED, __HIP_MEMORY_SCOPE_AGENT); }
__device__ __forceinline__ float ld_agent(const float* p) { return __hip_atomic_load(p, __ATOMIC_RELAXED, __HIP_MEMORY_SCOPE_AGENT); }
__device__ void ph_route(const Params& p, LAS unsigned char* lds) {
  LAS int* cntl = (LAS int*)lds;
  const int lane = threadIdx.x & 63, wv = threadIdx.x >> 6;
  for (int tb = blockIdx.x; tb < T / 64; tb += gridDim.x) {
    __syncthreads();
    if (threadIdx.x < NE) cntl[threadIdx.x] = 0;
    __syncthreads();
    for (int ti = 0; ti < 8; ++ti) {
      const int t = tb * 64 + wv * 8 + ti;
      const float sc = 1.f / (1.f + __expf(-p.logits[(size_t)t * NE + lane]));
      const float bz = sc + p.router_bias[lane];
      int rk = 0;
#pragma unroll
      for (int j = 1; j < 8; ++j) { const float o = __shfl_xor(bz, j); const int oi = lane ^ j; rk += (o > bz || (o == bz && oi < lane)) ? 1 : 0; }
      float gs = rk < 2 ? bz : 0.f;
      gs += __shfl_xor(gs, 1); gs += __shfl_xor(gs, 2); gs += __shfl_xor(gs, 4);
      const int g = lane >> 3; int grk = 0;
#pragma unroll
      for (int j = 1; j < 8; ++j) { const float o = __shfl_xor(gs, j * 8); const int og = g ^ j; grk += (o > gs || (o == gs && og < g)) ? 1 : 0; }
      const bool gsel = grk < 4;
      const float mb = gsel ? bz : -INFINITY;
      int erk = 0;
      for (int j = 1; j < 64; ++j) { const float o = __shfl_xor(mb, j); const int oi = lane ^ j; erk += (o > mb || (o == mb && oi < lane)) ? 1 : 0; }
      const bool sel = gsel && erk < 8;
      const float gsum = wave_sum(sel ? sc : 0.f);
      if (sel) {
        const int lr = __hip_atomic_fetch_add(&cntl[lane], 1, __ATOMIC_RELAXED, __HIP_MEMORY_SCOPE_WORKGROUP);
        p.assign[t * 8 + erk] = lane | (lr << 8); p.gate[t * 8 + erk] = sc / gsum * 2.5f;
      }
    }
    __syncthreads();
    if (threadIdx.x < NE) p.blkcnt[tb * NE + threadIdx.x] = cntl[threadIdx.x];
  }
}
__device__ void ph_place(const Params& p, LAS unsigned char* lds) {
  LAS int* part = (LAS int*)lds;
  LAS int* parta = part + 512;
  LAS int* base = parta + 512;
  LAS int* total = base + 64;
  LAS int* pstart = total + 64;
  const int tid = threadIdx.x, e = tid & 63, pt = tid >> 6;
  for (int tb = blockIdx.x; tb < T / 64; tb += gridDim.x) {
    __syncthreads();
    int slo = 0, sall = 0;
    for (int b = pt * 32; b < pt * 32 + 32; ++b) { const int c = ld_agent(p.blkcnt + b * NE + e); sall += c; slo += (b < tb) ? c : 0; }
    part[pt * 64 + e] = slo; parta[pt * 64 + e] = sall;
    __syncthreads();
    if (tid < 64) {
      int b0 = 0, t0 = 0;
#pragma unroll
      for (int q = 0; q < 8; ++q) { b0 += part[q * 64 + tid]; t0 += parta[q * 64 + tid]; }
      base[tid] = b0; total[tid] = t0;
      const int padded = (t0 + 255) & ~255;
      int incl = padded;
      for (int o = 1; o < 64; o <<= 1) { const int v = __shfl_up(incl, o); if (tid >= o) incl += v; }
      pstart[tid] = incl - padded;
      if (tid == 63) pstart[64] = incl;
    }
    __syncthreads();
    {
      const int t = tb * 64 + (tid >> 3), k = tid & 7;
      const int a = ld_agent(p.assign + t * 8 + k), ee = a & 255, lr = a >> 8;
      const int row = pstart[ee] + base[ee] + lr;
      p.row_tok[row] = t; p.row_gate[row] = ld_agent(p.gate + t * 8 + k); p.pos[t * 8 + k] = row;
      if (tid < 64) { const int srow = pstart[64] + tb * 64 + tid; p.row_tok[srow] = tb * 64 + tid; p.row_gate[srow] = 1.0f; }
    }
    if (tb == blockIdx.x) {
      for (int e2 = blockIdx.x; e2 < NE; e2 += gridDim.x) {
        const int r0 = pstart[e2] + total[e2], r1 = pstart[e2 + 1];
        for (int r = r0 + tid; r < r1; r += NT) { p.row_tok[r] = 0; p.row_gate[r] = 0.f; }
        for (int j = pstart[e2] / 256 + tid; j < r1 / 256; j += NT) p.tile_exp[j] = e2;
      }
      if (blockIdx.x == 0) {
        const int nr = pstart[64] / 256;
        for (int j = tid; j < T / 256; j += NT) p.tile_exp[nr + j] = NE;
        if (tid == 0) { p.meta[0] = nr; p.meta[1] = nr + T / 256; }
      }
    }
  }
}
struct OrderMoE {
  LAS const int* ulist; int n;
  LAS const unsigned* tab;
  __device__ __forceinline__ bool next(int i, pg8::Unit& u) const { if (i >= n) return false; u.pm = ulist[i * 4 + 0]; u.pn = ulist[i * 4 + 1]; u.bn = ulist[i * 4 + 2]; u.aux = i; return true; }
  __device__ __forceinline__ unsigned row_off(int i, int row) const { return tab[i * 512 + row]; }
};
template <bool TABLES>
__device__ __forceinline__ OrderMoE moe_order(const Params& p, LAS unsigned char* lds, int npn, int tile0, int ntiles, int rowbytes) {
  LAS int* ulist = (LAS int*)(lds + LDS_TAB); LAS unsigned* tab = (LAS unsigned*)(lds + LDS_TAB + 1024);
  const int G = gridDim.x, c = blockIdx.x, mpc = 32 / npn; int n = 0;
  __syncthreads();
  for (int i = 0; i < 60; ++i) {
    int U; if (G == 256) U = ((i * 8 + (c & 7)) * 32 + (c >> 3)); else U = i * G + c;
    const int chunk = U >> 5, w = U & 31, j = chunk * mpc + (w % mpc), pn = w / mpc;
    if (j >= ntiles) break;
    const int tile = tile0 + j, e = ld_agent(p.tile_exp + tile);
    if (threadIdx.x == 0) { ulist[i * 4 + 0] = tile; ulist[i * 4 + 1] = pn; ulist[i * 4 + 2] = e * npn + pn; ulist[i * 4 + 3] = e; }
    if (TABLES) { for (int r = threadIdx.x; r < 256; r += NT) { tab[i * 512 + r] = (unsigned)ld_agent(p.row_tok + tile * 256 + r) * (unsigned)rowbytes; tab[i * 512 + 256 + r] = __float_as_uint(ld_agent(p.row_gate + tile * 256 + r)); } }
    n = i + 1;
  }
  __syncthreads();
  return OrderMoE{ulist, n, tab};
}
struct EpiGU {
  static constexpr bool PERM = true;
  bf16_t* H; LAS const unsigned* tab;
  __device__ __forceinline__ void operator()(const f32x4 (&acc)[2][2][4][2], const pg8::Unit& u, int wr, int wc, int fr, int fq) const {
    const int col0 = u.pn * 128 + wc * 32 + 8 * fq;
#pragma unroll
    for (int ai = 0; ai < 2; ++ai)
#pragma unroll
      for (int m = 0; m < 4; ++m) { const int r = ai * 128 + wr * 64 + m * 16 + fr; const float gt = __uint_as_float(tab[u.aux * 512 + 256 + r]);
        f32x4 h0, h1;
#pragma unroll
        for (int j = 0; j < 4; ++j) { const float g0 = acc[ai][0][m][0][j], g1 = acc[ai][0][m][1][j];
          h0[j] = g0 * __builtin_amdgcn_rcpf(1.f + __expf(-g0)) * acc[ai][1][m][0][j] * gt; h1[j] = g1 * __builtin_amdgcn_rcpf(1.f + __expf(-g1)) * acc[ai][1][m][1][j] * gt; }
        u32x4 w; w.x = cvt_pk_bf16(h0[0], h0[1]); w.y = cvt_pk_bf16(h0[2], h0[3]); w.z = cvt_pk_bf16(h1[0], h1[1]); w.w = cvt_pk_bf16(h1[2], h1[3]);
        *(u32x4*)(H + (size_t)(u.pm * 256 + r) * DE + col0) = w; }
  }
};
__device__ void ph_gateup(const Params& p, LAS unsigned char* lds) {
  const int ntot = ld_agent(p.meta + 1);
  const OrderMoE S = moe_order<true>(p, lds, 4, 0, ntot, D * 2);
  pg8::Gemm g{p.h1b, p.WguT, D}; EpiGU E{p.H, S.tab};
  pg8::gemm_phase<true>(lds, g, S, E);
}
struct EpiDown {
  static constexpr bool PERM = true;
  bf16_t* Y; float* out; const bf16_t* h1b; LAS const int* ulist; int srow0;
  __device__ __forceinline__ void operator()(const f32x4 (&acc)[2][2][4][2], const pg8::Unit& u, int wr, int wc, int fr, int fq) const {
    const int col0 = u.pn * 256 + wc * 32 + 8 * fq; const bool shared_e = ulist[u.aux * 4 + 3] == NE;
#pragma unroll
    for (int ai = 0; ai < 2; ++ai)
#pragma unroll
      for (int m = 0; m < 4; ++m) { const int row = u.pm * 256 + ai * 128 + wr * 64 + m * 16 + fr;
#pragma unroll
        for (int bj = 0; bj < 2; ++bj) { const f32x4 v0 = acc[ai][bj][m][0], v1 = acc[ai][bj][m][1];
          if (!shared_e) { u32x4 w; w.x = cvt_pk_bf16(v0[0], v0[1]); w.y = cvt_pk_bf16(v0[2], v0[3]); w.z = cvt_pk_bf16(v1[0], v1[1]); w.w = cvt_pk_bf16(v1[2], v1[3]);
            *(u32x4*)(Y + (size_t)row * D + col0 + bj * 128) = w; }
          else { const size_t o = (size_t)(row - srow0) * D + col0 + bj * 128; const u32x4 hb = *(const u32x4*)(h1b + o); f32x4 a, b;
            a[0] = __uint_as_float(hb.x << 16); a[1] = __uint_as_float(hb.x & 0xffff0000u); a[2] = __uint_as_float(hb.y << 16); a[3] = __uint_as_float(hb.y & 0xffff0000u);
            b[0] = __uint_as_float(hb.z << 16); b[1] = __uint_as_float(hb.z & 0xffff0000u); b[2] = __uint_as_float(hb.w << 16); b[3] = __uint_as_float(hb.w & 0xffff0000u);
            *(f32x4*)(out + o) = a * ALPHA + v0; *(f32x4*)(out + o + 4) = b * ALPHA + v1; } } }
  }
};
__device__ void ph_down(const Params& p, LAS unsigned char* lds) {
  const int nr = ld_agent(p.meta + 0), ntot = ld_agent(p.meta + 1);
  const OrderMoE S = moe_order<false>(p, lds, 8, 0, ntot, 0);
  pg8::Gemm g{p.H, p.WdT, DE}; EpiDown E{p.Y, p.out, p.h1b, S.ulist, nr * 256};
  pg8::gemm_phase<false>(lds, g, S, E);
}
__device__ void ph_combine(const Params& p) {
  const int lane = threadIdx.x & 63, wv = threadIdx.x >> 6;
  for (int row = blockIdx.x * 8 + wv; row < T; row += gridDim.x * 8) {
    float v[32];
    float* op = p.out + (size_t)row * D;
#pragma unroll
    for (int g = 0; g < 4; ++g) { const f32x4 a = *(const f32x4*)(op + g * 512 + lane * 8), b = *(const f32x4*)(op + g * 512 + lane * 8 + 4);
#pragma unroll
      for (int j = 0; j < 4; ++j) { v[g * 8 + j] = a[j]; v[g * 8 + 4 + j] = b[j]; } }
    for (int k = 0; k < 8; ++k) {
      const int yr = ld_agent(p.pos + row * 8 + k); const bf16_t* yp = p.Y + (size_t)yr * D;
#pragma unroll
      for (int g = 0; g < 4; ++g) { const u32x4 hb = *(const u32x4*)(yp + g * 512 + lane * 8);
        v[g * 8 + 0] += __uint_as_float(hb.x << 16); v[g * 8 + 1] += __uint_as_float(hb.x & 0xffff0000u); v[g * 8 + 2] += __uint_as_float(hb.y << 16); v[g * 8 + 3] += __uint_as_float(hb.y & 0xffff0000u);
        v[g * 8 + 4] += __uint_as_float(hb.z << 16); v[g * 8 + 5] += __uint_as_float(hb.z & 0xffff0000u); v[g * 8 + 6] += __uint_as_float(hb.w << 16); v[g * 8 + 7] += __uint_as_float(hb.w & 0xffff0000u); }
    }
    float s = 0.f;
#pragma unroll
    for (int j = 0; j < 32; ++j) s += v[j];
    const float mu = wave_sum(s) * (1.f / D); float q = 0.f;
#pragma unroll
    for (int j = 0; j < 32; ++j) { const float d = v[j] - mu; q += d * d; }
    const float rstd = rsqrtf(wave_sum(q) * (1.f / D) + 1e-5f);
#pragma unroll
    for (int g = 0; g < 4; ++g) { const int c0 = g * 512 + lane * 8; f32x4 a, b;
#pragma unroll
      for (int j = 0; j < 4; ++j) { a[j] = (v[g * 8 + j] - mu) * rstd * p.ln2_g[c0 + j] + p.ln2_b[c0 + j]; b[j] = (v[g * 8 + 4 + j] - mu) * rstd * p.ln2_g[c0 + 4 + j] + p.ln2_b[c0 + 4 + j]; }
      *(f32x4*)(op + c0) = a; *(f32x4*)(op + c0 + 4) = b; }
  }
}

__global__ void __launch_bounds__(NT) k_mega(Params p_arg) {
#if defined(__HIP_DEVICE_COMPILE__)
  extern __shared__ __attribute__((aligned(16))) unsigned char lds_raw[];
  LAS unsigned char* lds = (LAS unsigned char*)lds_raw;
  float* smem = (float*)lds_raw;
  cooperative_groups::grid_group grid = cooperative_groups::this_grid();
#ifndef ONLY
#define ONLY -1
#endif
  typedef const __attribute__((address_space(4))) Params* KP;
  const KP pk = (KP)__builtin_amdgcn_kernarg_segment_ptr();
#define RUN(n, call) do { if (ONLY < 0 || ONLY == n) { KP q_ = pk; asm volatile("" : "+s"(q_)); const Params p = *q_; call; } } while (0)
  RUN(0, ph_convert(p)); grid.sync();
  RUN(1, ph_inproj(p, lds)); grid.sync();
  RUN(2, ph_conv(p)); grid.sync();
  RUN(3, ph_ssd(p)); RUN(4, ph_attn_mfma(p, (char*)lds_raw)); grid.sync();
  RUN(5, ph_ssdfin(p)); grid.sync();
  RUN(6, ph_outproj(p, lds)); grid.sync();
  RUN(7, ph_ln1(p)); grid.sync();
  RUN(8, ph_router(p, smem)); grid.sync();
  RUN(9, ph_route(p, lds)); grid.sync();
  RUN(10, ph_place(p, lds)); grid.sync();
  RUN(11, ph_gateup(p, lds)); grid.sync();
  RUN(12, ph_down(p, lds)); grid.sync();
  RUN(13, ph_combine(p));
#endif
}
}

extern "C" void kernel_launch(void* const* d_in, const int* in_sizes, int n_in, void* d_out, int out_size, void* d_ws, size_t ws_size, hipStream_t stream) {
  Params p{};
  const float* const* in = (const float* const*)d_in;
  p.x = in[0]; p.w_in = in[1]; p.conv_w = in[2]; p.conv_b = in[3]; p.dt_bias_f = in[4]; p.dt_bias_b = in[5]; p.a_log_f = in[6]; p.a_log_b = in[7];
  p.d_skip = in[8]; p.ssd_norm_w = in[9]; p.lq1 = in[10]; p.lk1 = in[11]; p.lq2 = in[12]; p.lk2 = in[13]; p.attn_norm_w = in[14]; p.w_out = in[15];
  p.ln1_g = in[16]; p.ln1_b = in[17]; p.w_router = in[18]; p.router_bias = in[19]; p.wg_e = in[20]; p.wu_e = in[21]; p.wd_e = in[22];
  p.wg_s = in[23]; p.wu_s = in[24]; p.wd_s = in[25]; p.ln2_g = in[26]; p.ln2_b = in[27];
  p.out = (float*)d_out;
  char* w = (char*)d_ws; size_t o = 0;
  auto take = [&](size_t bytes) { char* r = w + o; o += (bytes + 255) / 256 * 256; return r; };
  char* reg1 = w + o;
  p.xb = (bf16_t*)take((size_t)T * D * 2); p.WinT = (bf16_t*)take((size_t)NPROJ * D * 2); p.WoutT = (bf16_t*)take((size_t)D * D * 2);
  p.WguT = (bf16_t*)take((size_t)(NE + 1) * 1024 * D * 2); p.proj = (bf16_t*)take((size_t)T * PLD * 2); p.u = (bf16_t*)take((size_t)T * D * 2);
  const size_t reg1_bytes = (size_t)((w + o) - reg1);
  p.Y = (bf16_t*)reg1;
  if ((size_t)MAXROWS_R * D * 2 > reg1_bytes) { fprintf(stderr, "kernel_launch: region 1 too small for Y\n"); return; }
  char* reg2 = take((size_t)MAXROWS * DE * 2);
  p.H = (bf16_t*)reg2; p.yf = (float*)reg2; p.yb = (float*)(reg2 + (size_t)T * DSSD * 4);
  p.h1b = (bf16_t*)take((size_t)T * D * 2); p.WdT = (bf16_t*)take((size_t)(NE + 1) * D * DE * 2);
  p.dt = (float*)take((size_t)T * 32 * 4); p.logits = (float*)take((size_t)T * NE * 4); p.gate = (float*)take((size_t)T * 8 * 4);
  p.assign = (int*)take((size_t)T * 8 * 4); p.pos = (int*)take((size_t)T * 8 * 4); p.blkcnt = (int*)take((size_t)(T / 64) * NE * 4);
  p.row_tok = (int*)take((size_t)MAXROWS * 4); p.row_gate = (float*)take((size_t)MAXROWS * 4); p.tile_exp = (int*)take((size_t)MAXTILES * 4); p.meta = (int*)take(256);
  p.xc = (float*)d_out; p.h1 = (float*)d_out;
  if ((size_t)T * CC * 4 > (size_t)T * D * 4) return;
  if (o > ws_size) { fprintf(stderr, "kernel_launch: ws too small: need %zu have %zu\n", o, ws_size); return; }
  static int grid_blocks = 0;
  if (!grid_blocks) {
    int dev = 0, cus = 0, per_cu = 0;
    hipGetDevice(&dev);
    hipDeviceGetAttribute(&cus, hipDeviceAttributeMultiprocessorCount, dev);
    if (hipFuncSetAttribute((const void*)k_mega, hipFuncAttributeMaxDynamicSharedMemorySize, LDS_BYTES) != hipSuccess) { fprintf(stderr, "kernel_launch: hipFuncSetAttribute failed\n"); return; }
    hipOccupancyMaxActiveBlocksPerMultiprocessor(&per_cu, k_mega, NT, LDS_BYTES);
    if (per_cu < 1) { fprintf(stderr, "kernel_launch: occupancy query says 0 blocks/CU\n"); return; }
    grid_blocks = cus;
  }
  void* args[] = {&p};
  hipError_t e = hipLaunchCooperativeKernel((void*)k_mega, dim3(grid_blocks), dim3(NT), args, LDS_BYTES, stream);
  if (e != hipSuccess) fprintf(stderr, "cooperative launch failed: %s (grid %d)\n", hipGetErrorString(e), grid_blocks);
}
```

```cpp
#include <hip/hip_runtime.h>
#include <hip/hip_cooperative_groups.h>
#include <cstdio>
#include <cstdint>

namespace {
constexpr int D = 2048, NB = 8, S = 2048, T = NB * S;
constexpr int DSSD = 1024, DATT = 1024, NH = 16, HD = 64, NS = 128, CC = 1536;
constexpr int AH = 8, NE = 64, DE = 512, PW = 5664;
constexpr int O_DT = 2560, O_Q = 2592;
constexpr int N_Z = 0, N_XBC = 1024, N_Q = 2560, N_K = 3584, N_V = 4608, PLD = 5632, NPROJ = 5888;
constexpr float ALPHA = 1.189207115002721f;
constexpr float LAMBDA_INIT = 0.2f;
constexpr float LOG2E = 1.4426950408889634f;
constexpr float QS = 0.125f * LOG2E;
constexpr int NT = 512;
constexpr int LDS_BYTES = 152 * 1024;
constexpr int LDS_TAB = 128 * 1024;
constexpr int MAXROWS_R = NE * 256 + T * 8;
constexpr int MAXROWS = MAXROWS_R + T;
constexpr int MAXTILES = MAXROWS / 256;

typedef unsigned short bf16_t;

struct Params {
  const float *x, *w_in, *conv_w, *conv_b, *dt_bias_f, *dt_bias_b, *a_log_f, *a_log_b, *d_skip, *ssd_norm_w;
  const float *lq1, *lk1, *lq2, *lk2, *attn_norm_w, *w_out, *ln1_g, *ln1_b, *w_router, *router_bias;
  const float *wg_e, *wu_e, *wd_e, *wg_s, *wu_s, *wd_s, *ln2_g, *ln2_b;
  float* out;
  bf16_t *xb, *WinT, *WoutT, *WguT, *WdT, *proj, *u, *h1b, *H, *Y;
  float *xc, *dt, *yf, *yb, *h1, *logits, *gate, *row_gate;
  int *assign, *blkcnt, *row_tok, *pos, *tile_exp, *meta;
};

__device__ __forceinline__ float silu_f(float x) { return x / (1.f + __expf(-x)); }
__device__ __forceinline__ float softplus_f(float x) { return x > 20.f ? x : log1pf(__expf(x)); }
__device__ __forceinline__ float wave_sum(float v) { for (int o = 32; o >= 1; o >>= 1) v += __shfl_xor(v, o); return v; }
__device__ __forceinline__ float bf2f(bf16_t b) { return __uint_as_float(((unsigned)b) << 16); }
__device__ __forceinline__ bf16_t f2bf(float f) { unsigned u = __float_as_uint(f); u += 0x7FFFu + ((u >> 16) & 1u); return (bf16_t)(u >> 16); }
}

namespace pg8 {
#define PG8_LAS __attribute__((address_space(3)))
typedef unsigned short bf16_t;
typedef short bf16x8 __attribute__((ext_vector_type(8)));
typedef float f32x4 __attribute__((ext_vector_type(4)));
typedef unsigned u32x4 __attribute__((ext_vector_type(4)));
constexpr int BM = 256, BK = 64, HALF = 128, HTB = HALF * BK * 2  , STAGE_BYTES = 8 * HTB, NXCD = 8, WGM = 8;

__host__ __device__ __forceinline__ int lds_byte(int r, int c) { const int st = (r >> 4) * 2 + (c >> 5), rr = r & 15, cc = c & 31, ob = rr * 64 + cc * 2; return st * 1024 + (ob ^ (((ob >> 9) & 1) << 5)); }
__host__ __device__ __forceinline__ void stage_rc(int b, int& R, int& C) { const int st = b / 1024, sb = b % 1024, swz = sb ^ (((sb >> 9) & 1) << 5); R = (st >> 1) * 16 + swz / 64; C = (st & 1) * 32 + (swz % 64) / 2; }
__host__ __device__ __forceinline__ int perm32(int rho) { const int n = rho >> 4, i = rho & 15; return 8 * (i >> 2) + 4 * n + (i & 3); }

struct Unit { int pm, pn, bn, aux; };
struct Gemm { const bf16_t* A; const bf16_t* Bt; int K; };


__device__ __forceinline__ unsigned cvt_pk_bf16(float lo, float hi) { unsigned r; asm volatile("v_cvt_pk_bf16_f32 %0, %1, %2" : "=v"(r) : "v"(lo), "v"(hi)); return r; }
struct OrderStatic {
    int nM, nN, nwg, G, c;
    __device__ void init(int M, int N, int G_, int c_) { nM = M / BM; nN = N / BM; nwg = nM * nN; G = G_; c = c_; }
    __device__ bool next(int i, Unit& u) const {
        const long L = (long)i * G + c; if (L >= nwg) return false;
        int wgid = (int)L; { const int q = nwg / NXCD, r = nwg % NXCD, xcd = wgid % NXCD, off = wgid / NXCD; wgid = (xcd < r ? xcd * (q + 1) : r * (q + 1) + (xcd - r) * q) + off; }
        const int nig = WGM * nN, gid = wgid / nig, fm = gid * WGM, gsz = (nM - fm) < WGM ? (nM - fm) : WGM;
        u.pm = fm + ((wgid % nig) % gsz); u.pn = (wgid % nig) / gsz; u.bn = u.pn; u.aux = i; return true;
    }
    __device__ __forceinline__ unsigned row_off(int, int) const { return 0u; }
};
template <bool GATHER, class Epi, class Sched>
__device__ __forceinline__ void gemm_phase(PG8_LAS unsigned char* lds, const Gemm g, const Sched& S, const Epi& E) {
    int tid = threadIdx.x; asm volatile("" : "+v"(tid));
    const int wid = __builtin_amdgcn_readfirstlane(tid >> 6), lane = tid & 63, wr = wid >> 2, wc = wid & 3, fr = lane & 15, fq = lane >> 4;
    const int K = g.K, nt = K / BK;
#define PG8_STAMP() do {} while (0)
    PG8_STAMP();
    unsigned voffA[2], voffB[2];
#pragma unroll
    for (int i = 0; i < 2; ++i) { int R, C; stage_rc(tid * 16 + i * 8192, R, C); const int Rb = Epi::PERM ? ((R & ~31) + perm32(R & 31)) : R;
        voffA[i] = (unsigned)(R * K + C) * 2u; voffB[i] = (unsigned)(Rb * K + C) * 2u; }
    unsigned voffG[2][2] = {{0u, 0u}, {0u, 0u}};
#define PG8_LOADG(uidx) do { if constexpr (GATHER) { _Pragma("unroll") for (int _h = 0; _h < 2; ++_h) _Pragma("unroll") for (int _i = 0; _i < 2; ++_i) { int R_, C_; stage_rc(tid * 16 + _i * 8192, R_, C_); \
        voffG[_h][_i] = S.row_off((uidx), _h * HALF + R_) + (unsigned)C_ * 2u; } } } while (0)
    const size_t kstep = (size_t)(BK * 2);
    const size_t hstep = (size_t)HALF * K * 2;
    const size_t tstep = 2 * hstep;
    const unsigned ldsw = (unsigned)wid * 1024u;
    const int aoff = lds_byte(wr * 64 + fr, fq * 8), boff = lds_byte(wc * 32 + fr, fq * 8);
#define PG8_SA(b, h) (((b) * 2 + (h)) * HTB)
#define PG8_SB(b, h) ((4 + (b) * 2 + (h)) * HTB)
#define PG8_STAGE(bufoff, gbase, voff) do { _Pragma("unroll") for (int _i = 0; _i < 2; ++_i) \
        __builtin_amdgcn_global_load_lds((const unsigned*)((const char*)(gbase) + (voff)[_i]), (PG8_LAS unsigned*)(lds + (bufoff) + ldsw + _i * 8192), 16, 0, 0); } while (0)
#define PG8_STAGE_A(bufoff, ptr, h) do { if constexpr (GATHER) { PG8_STAGE(bufoff, ptr, voffG[h]); } else { PG8_STAGE(bufoff, (ptr) + (h) * hstep, voffA); } } while (0)
#define PG8_LDA(dst, b, h) do { _Pragma("unroll") for (int m = 0; m < 4; ++m) _Pragma("unroll") for (int k = 0; k < 2; ++k) dst[m][k] = *(const PG8_LAS bf16x8*)(lds + PG8_SA(b, h) + aoff + m * 2048 + k * 1024); } while (0)
#define PG8_LDB(dst, b, h) do { _Pragma("unroll") for (int n = 0; n < 2; ++n) _Pragma("unroll") for (int k = 0; k < 2; ++k) dst[n][k] = *(const PG8_LAS bf16x8*)(lds + PG8_SB(b, h) + boff + n * 2048 + k * 1024); } while (0)
#define PG8_MMA(ai, bj, At, Bt) do { __builtin_amdgcn_s_setprio(1); _Pragma("unroll") for (int m = 0; m < 4; ++m) _Pragma("unroll") for (int n = 0; n < 2; ++n) _Pragma("unroll") for (int k = 0; k < 2; ++k) \
        acc[ai][bj][m][n] = __builtin_amdgcn_mfma_f32_16x16x32_bf16(Bt[n][k], At[m][k], acc[ai][bj][m][n], 0, 0, 0); __builtin_amdgcn_s_setprio(0); } while (0)
#define PG8_WAIT_V(n) asm volatile("s_waitcnt vmcnt(" #n ")" ::: "memory")
#define PG8_WAIT_L(n) asm volatile("s_waitcnt lgkmcnt(" #n ")" ::: "memory")
#define PG8_BAR __builtin_amdgcn_s_barrier()
#define PG8_SCHED __builtin_amdgcn_sched_barrier(0)
    Unit cur, nxt; int ui = 0;
    if (!S.next(0, cur)) return;
    f32x4 acc[2][2][4][2];
#pragma unroll
    for (int a = 0; a < 2; ++a)
#pragma unroll
        for (int b = 0; b < 2; ++b)
#pragma unroll
            for (int m = 0; m < 4; ++m)
#pragma unroll
                for (int n = 0; n < 2; ++n) acc[a][b][m][n] = (f32x4){0.f, 0.f, 0.f, 0.f};
    bf16x8 At[4][2], B0[2][2], B1[2][2];
    const char* cA = GATHER ? (const char*)g.A : (const char*)g.A + (size_t)cur.pm * tstep; const char* cB = (const char*)g.Bt + (size_t)cur.bn * tstep;
    PG8_LOADG(0);
    PG8_STAGE(PG8_SB(0, 0), cB, voffB); PG8_STAGE_A(PG8_SA(0, 0), cA, 0); PG8_STAGE(PG8_SB(0, 1), cB + hstep, voffB); PG8_STAGE_A(PG8_SA(0, 1), cA, 1);
    if (wr == 1) PG8_BAR;
    PG8_WAIT_V(4); PG8_BAR;
    PG8_STAGE(PG8_SB(1, 0), cB + kstep, voffB); PG8_STAGE_A(PG8_SA(1, 0), cA + kstep, 0); PG8_STAGE(PG8_SB(1, 1), cB + hstep + kstep, voffB);
    PG8_WAIT_V(6); PG8_BAR;
    PG8_STAMP();
    for (;;) {
        const bool has_next = S.next(ui + 1, nxt);
        const char* nA = has_next ? (GATHER ? (const char*)g.A : (const char*)g.A + (size_t)nxt.pm * tstep) : cA; const char* nB = has_next ? (const char*)g.Bt + (size_t)nxt.bn * tstep : cB;
        for (int t = 0; t < nt; t += 2) {
            const bool last = (t == nt - 2);
            const char* a1 = cA + (size_t)(t + 1) * kstep;
            const char* a2 = last ? nA : cA + (size_t)(t + 2) * kstep; const char* b2 = last ? nB : cB + (size_t)(t + 2) * kstep;
            const char* a3 = a2 + kstep; const char* b3 = b2 + kstep;
            PG8_LDB(B0, 0, 0); PG8_SCHED; PG8_LDA(At, 0, 0); PG8_STAGE_A(PG8_SA(1, 1), a1, 1);
            PG8_WAIT_L(8); PG8_BAR; PG8_WAIT_L(0); PG8_MMA(0, 0, At, B0); PG8_BAR; PG8_SCHED;
            if (last && has_next) PG8_LOADG(ui + 1);
            PG8_LDB(B1, 0, 1); PG8_STAGE(PG8_SB(0, 0), b2, voffB);
            PG8_BAR; PG8_WAIT_L(0); PG8_MMA(0, 1, At, B1); PG8_BAR;
            PG8_LDA(At, 0, 1); PG8_STAGE_A(PG8_SA(0, 0), a2, 0);
            PG8_BAR; PG8_WAIT_L(0); PG8_MMA(1, 0, At, B0); PG8_BAR; PG8_SCHED;
            PG8_STAGE(PG8_SB(0, 1), b2 + hstep, voffB);
            PG8_WAIT_V(6); PG8_BAR; PG8_MMA(1, 1, At, B1); PG8_BAR;
            PG8_LDB(B0, 1, 0); PG8_SCHED; PG8_LDA(At, 1, 0); PG8_STAGE_A(PG8_SA(0, 1), a2, 1);
            PG8_WAIT_L(8); PG8_BAR; PG8_WAIT_L(0); PG8_MMA(0, 0, At, B0); PG8_BAR; PG8_SCHED;
            PG8_LDB(B1, 1, 1); PG8_STAGE(PG8_SB(1, 0), b3, voffB);
            PG8_BAR; PG8_WAIT_L(0); PG8_MMA(0, 1, At, B1); PG8_BAR;
            PG8_LDA(At, 1, 1); PG8_STAGE_A(PG8_SA(1, 0), a3, 0);
            PG8_BAR; PG8_WAIT_L(0); PG8_MMA(1, 0, At, B0); PG8_BAR; PG8_SCHED;
            PG8_STAGE(PG8_SB(1, 1), b3 + hstep, voffB);
            PG8_WAIT_V(6); PG8_BAR; PG8_MMA(1, 1, At, B1); PG8_BAR;
        }
        PG8_STAMP();
        E(acc, cur, wr, wc, fr, fq);
        PG8_STAMP();
        if (!has_next) break;
#pragma unroll
        for (int a = 0; a < 2; ++a)
#pragma unroll
            for (int b = 0; b < 2; ++b)
#pragma unroll
                for (int m = 0; m < 4; ++m)
#pragma unroll
                    for (int n = 0; n < 2; ++n) acc[a][b][m][n] = (f32x4){0.f, 0.f, 0.f, 0.f};
        cur = nxt; cA = nA; cB = nB; ++ui;
    }
    PG8_WAIT_V(0);
    if (wr == 0) PG8_BAR;
    PG8_BAR;
    PG8_STAMP();
#undef PG8_STAMP
#undef PG8_SA
#undef PG8_SB
#undef PG8_STAGE
#undef PG8_STAGE_A
#undef PG8_LOADG
#undef PG8_LDA
#undef PG8_LDB
#undef PG8_MMA
#undef PG8_WAIT_V
#undef PG8_WAIT_L
#undef PG8_BAR
#undef PG8_SCHED
}
}
namespace {
using pg8::f32x4; using pg8::u32x4; using pg8::cvt_pk_bf16;
#define LAS __attribute__((address_space(3)))

template <class ARow, class Epi>
__device__ __forceinline__ void gemm_tile(float* smem, int mvalid, int nvalid, int K, ARow arow, const float* Bp, int ldb, Epi epi) {
  float* As = smem;
  float* Bs = smem + 16 * 68;
  const int tid = threadIdx.x, ty = tid >> 5, tx = tid & 31;
  float acc[4][4];
#pragma unroll
  for (int i = 0; i < 4; ++i)
#pragma unroll
    for (int j = 0; j < 4; ++j) acc[i][j] = 0.f;
  const int ak = tid & 15, ar = tid >> 4;
  const float* ap0 = (ar < mvalid) ? arow(ar) : nullptr;
  const float* ap1 = (ar + 32 < mvalid) ? arow(ar + 32) : nullptr;
  const int bn = tid & 127, bk = tid >> 7;
  for (int k0 = 0; k0 < K; k0 += 16) {
    As[ak * 68 + ar] = ap0 ? ap0[k0 + ak] : 0.f;
    As[ak * 68 + ar + 32] = ap1 ? ap1[k0 + ak] : 0.f;
#pragma unroll
    for (int i = 0; i < 4; ++i) { const int kk = bk + 4 * i; Bs[kk * 128 + bn] = (bn < nvalid) ? Bp[(size_t)(k0 + kk) * ldb + bn] : 0.f; }
    __syncthreads();
#pragma unroll
    for (int kk = 0; kk < 16; ++kk) {
      float a[4], b[4];
#pragma unroll
      for (int i = 0; i < 4; ++i) a[i] = As[kk * 68 + ty * 4 + i];
#pragma unroll
      for (int j = 0; j < 4; ++j) b[j] = Bs[kk * 128 + tx * 4 + j];
#pragma unroll
      for (int i = 0; i < 4; ++i)
#pragma unroll
        for (int j = 0; j < 4; ++j) acc[i][j] += a[i] * b[j];
    }
    __syncthreads();
  }
#pragma unroll
  for (int i = 0; i < 4; ++i)
#pragma unroll
    for (int j = 0; j < 4; ++j) { const int r = ty * 4 + i, c = tx * 4 + j; if (r < mvalid && c < nvalid) epi(r, c, acc[i][j]); }
}

template <class RowMap>
__device__ __forceinline__ void cvt_tile(const float* __restrict__ src, int N, int K, int k0, int n0, bf16_t* __restrict__ dst, RowMap rm) {
  const int lane = threadIdx.x & 63, w = threadIdx.x >> 6;
  const int n = n0 + (lane & 15) * 4, kk = k0 + (w * 4 + (lane >> 4)) * 8;
  if (n >= N) return;
  float4 v[8];
#pragma unroll
  for (int j = 0; j < 8; ++j) v[j] = *(const float4*)(src + (size_t)(kk + j) * N + n);
  u32x4 o;
  o.x = cvt_pk_bf16(v[0].x, v[1].x); o.y = cvt_pk_bf16(v[2].x, v[3].x); o.z = cvt_pk_bf16(v[4].x, v[5].x); o.w = cvt_pk_bf16(v[6].x, v[7].x);
  *(u32x4*)(dst + (size_t)rm(n + 0) * K + kk) = o;
  o.x = cvt_pk_bf16(v[0].y, v[1].y); o.y = cvt_pk_bf16(v[2].y, v[3].y); o.z = cvt_pk_bf16(v[4].y, v[5].y); o.w = cvt_pk_bf16(v[6].y, v[7].y);
  *(u32x4*)(dst + (size_t)rm(n + 1) * K + kk) = o;
  o.x = cvt_pk_bf16(v[0].z, v[1].z); o.y = cvt_pk_bf16(v[2].z, v[3].z); o.z = cvt_pk_bf16(v[4].z, v[5].z); o.w = cvt_pk_bf16(v[6].z, v[7].z);
  *(u32x4*)(dst + (size_t)rm(n + 2) * K + kk) = o;
  o.x = cvt_pk_bf16(v[0].w, v[1].w); o.y = cvt_pk_bf16(v[2].w, v[3].w); o.z = cvt_pk_bf16(v[4].w, v[5].w); o.w = cvt_pk_bf16(v[6].w, v[7].w);
  *(u32x4*)(dst + (size_t)rm(n + 3) * K + kk) = o;
}
template <class RowMap>
__device__ void cvt_job(const float* src, int nmat, int K, int N, bf16_t* dst, size_t dstride, RowMap rm) {
  const int kt = K / 256, ntl = (N + 63) / 64, per = kt * ntl;
  for (int it = blockIdx.x; it < nmat * per; it += gridDim.x) {
    const int m = it / per, r = it % per, k0 = (r / ntl) * 256, n0 = (r % ntl) * 64;
    cvt_tile(src + (size_t)m * K * N, N, K, k0, n0, dst + (size_t)m * dstride, rm);
  }
}
__device__ void ph_convert(const Params& p) {
  const size_t gtid = (size_t)blockIdx.x * NT + threadIdx.x, gsz = (size_t)gridDim.x * NT;
  if (gtid < 64) p.meta[gtid] = 0;
  for (size_t i = gtid; i < (size_t)T * D / 8; i += gsz) {
    const float4 a = *(const float4*)(p.x + i * 8), b = *(const float4*)(p.x + i * 8 + 4);
    u32x4 o; o.x = cvt_pk_bf16(a.x, a.y); o.y = cvt_pk_bf16(a.z, a.w); o.z = cvt_pk_bf16(b.x, b.y); o.w = cvt_pk_bf16(b.z, b.w);
    *(u32x4*)(p.xb + i * 8) = o;
  }
  cvt_job(p.w_in, 1, D, PW, p.WinT, 0, [](int n) { return n < O_DT ? n : (n < O_Q ? PLD + (n - O_DT) : n - 32); });
  for (size_t i = gtid; i < (size_t)(NPROJ - PW) * D / 8; i += gsz) *(u32x4*)(p.WinT + (size_t)PW * D + i * 8) = (u32x4){0u, 0u, 0u, 0u};
  cvt_job(p.w_out, 1, D, D, p.WoutT, 0, [](int n) { return n; });
  cvt_job(p.wg_e, NE, D, DE, p.WguT, (size_t)1024 * D, [](int n) { return (n >> 7) * 256 + (n & 127); });
  cvt_job(p.wu_e, NE, D, DE, p.WguT, (size_t)1024 * D, [](int n) { return (n >> 7) * 256 + 128 + (n & 127); });
  cvt_job(p.wg_s, 1, D, DE, p.WguT + (size_t)NE * 1024 * D, 0, [](int n) { return (n >> 7) * 256 + (n & 127); });
  cvt_job(p.wu_s, 1, D, DE, p.WguT + (size_t)NE * 1024 * D, 0, [](int n) { return (n >> 7) * 256 + 128 + (n & 127); });
  cvt_job(p.wd_e, NE, DE, D, p.WdT, (size_t)D * DE, [](int n) { return n; });
  cvt_job(p.wd_s, 1, DE, D, p.WdT + (size_t)NE * D * DE, 0, [](int n) { return n; });
}

struct EpiProj {
  static constexpr bool PERM = true;
  bf16_t* proj; float* dt; const float* bias_f; const float* bias_b;
  __device__ __forceinline__ void operator()(const f32x4 (&acc)[2][2][4][2], const pg8::Unit& u, int wr, int wc, int fr, int fq) const {
    const int row0 = u.pm * 256 + wr * 64 + fr;
    if (u.pn < 22) {
      const int col0 = u.pn * 256 + wc * 32 + 8 * fq;
      const float sc = (u.pn >= 10 && u.pn < 14) ? QS : 1.0f;
#pragma unroll
      for (int ai = 0; ai < 2; ++ai)
#pragma unroll
        for (int m = 0; m < 4; ++m) { bf16_t* rowp = proj + (size_t)(row0 + ai * 128 + m * 16) * PLD + col0;
#pragma unroll
          for (int bj = 0; bj < 2; ++bj) { const f32x4 v0 = acc[ai][bj][m][0] * sc, v1 = acc[ai][bj][m][1] * sc;
            u32x4 w; w.x = cvt_pk_bf16(v0[0], v0[1]); w.y = cvt_pk_bf16(v0[2], v0[3]); w.z = cvt_pk_bf16(v1[0], v1[1]); w.w = cvt_pk_bf16(v1[2], v1[3]);
            *(u32x4*)(rowp + bj * 128) = w; } }
    } else if (wc == 0) {
      const int c0 = 8 * fq;
      float bs[8];
#pragma unroll
      for (int j = 0; j < 8; ++j) bs[j] = (c0 + j) < 16 ? bias_f[c0 + j] : bias_b[c0 + j - 16];
#pragma unroll
      for (int ai = 0; ai < 2; ++ai)
#pragma unroll
        for (int m = 0; m < 4; ++m) { float* rowp = dt + (size_t)(row0 + ai * 128 + m * 16) * 32 + c0;
          const f32x4 v0 = acc[ai][0][m][0], v1 = acc[ai][0][m][1];
          f32x4 o0, o1;
#pragma unroll
          for (int j = 0; j < 4; ++j) { o0[j] = softplus_f(v0[j] + bs[j]); o1[j] = softplus_f(v1[j] + bs[4 + j]); }
          *(f32x4*)rowp = o0; *(f32x4*)(rowp + 4) = o1; }
    }
  }
};
struct EpiOut {
  static constexpr bool PERM = false;
  const float* x; float* v;
  __device__ __forceinline__ void operator()(const f32x4 (&acc)[2][2][4][2], const pg8::Unit& u, int wr, int wc, int fr, int fq) const {
    const int row0 = u.pm * 256 + wr * 64 + fr, col0 = u.pn * 256 + wc * 32 + 4 * fq;
#pragma unroll
    for (int ai = 0; ai < 2; ++ai)
#pragma unroll
      for (int m = 0; m < 4; ++m) { const size_t off = (size_t)(row0 + ai * 128 + m * 16) * D + col0;
#pragma unroll
        for (int bj = 0; bj < 2; ++bj)
#pragma unroll
          for (int n = 0; n < 2; ++n) { const f32x4 xv = *(const f32x4*)(x + off + bj * 128 + n * 16); *(f32x4*)(v + off + bj * 128 + n * 16) = xv * ALPHA + acc[ai][bj][m][n]; } }
  }
};

namespace at {
using bf16x8 = __attribute__((ext_vector_type(8))) short;
using s16x4  = __attribute__((ext_vector_type(4))) short;
using f32x16 = __attribute__((ext_vector_type(16))) float;
using u32x4  = __attribute__((ext_vector_type(4))) unsigned;
constexpr int KVBLK = 64;
constexpr size_t SHM_V = KVBLK * 128 * 2, SHM_K = KVBLK * 128 * 2;
constexpr float THR2 = 8.0f;
#define AT_KSWZ(row, colB) ((row) * 256 + ((colB) ^ (((row) & 7) << 4)))
#define AT_SBAR() __builtin_amdgcn_sched_barrier(0)
__device__ __forceinline__ int crow(int r, int hi) { return (r & 3) + 8 * (r >> 2) + 4 * hi; }
__device__ __forceinline__ unsigned cvtpk(float lo, float hi) { unsigned r; asm volatile("v_cvt_pk_bf16_f32 %0, %1, %2" : "=v"(r) : "v"(lo), "v"(hi)); return r; }

__device__ __forceinline__ void partialSM(f32x16& p0, f32x16& p1, float dqh, float nsl2, float& m_reg, float& mn, float& alpha) {
#pragma unroll
  for (int r = 0; r < 16; ++r) { const float c = (float)((r & 3) + 8 * (r >> 2));
    p0[r] = fmaf(nsl2, fabsf(dqh - c), p0[r]); p1[r] = fmaf(nsl2, fabsf(dqh - (c + 32.f)), p1[r]); }
  float pmax = p0[0];
#pragma unroll
  for (int r = 1; r < 16; ++r) pmax = fmaxf(pmax, p0[r]);
#pragma unroll
  for (int r = 0; r < 16; ++r) pmax = fmaxf(pmax, p1[r]);
  { auto rr = __builtin_amdgcn_permlane32_swap(__float_as_uint(pmax), __float_as_uint(pmax), false, false);
    pmax = fmaxf(__uint_as_float(rr[0]), __uint_as_float(rr[1])); }
  if (__builtin_expect(__all(pmax - m_reg <= THR2), 1)) { mn = m_reg; alpha = 1.f; }
  else { mn = fmaxf(m_reg, pmax); alpha = __builtin_amdgcn_exp2f(m_reg - mn); m_reg = mn; }
#pragma unroll
  for (int r = 0; r < 16; ++r) p0[r] = p0[r] - mn;
#pragma unroll
  for (int r = 0; r < 16; ++r) p1[r] = p1[r] - mn;
#pragma unroll
  for (int r = 0; r < 16; ++r) p0[r] = __builtin_amdgcn_exp2f(p0[r]);
}
__device__ __forceinline__ void finishSM(f32x16& p0, f32x16& p1, float alpha, float& l_reg, bf16x8& pa0, bf16x8& pa1, bf16x8& pa2, bf16x8& pa3) {
#pragma unroll
  for (int r = 0; r < 16; ++r) p1[r] = __builtin_amdgcn_exp2f(p1[r]);
  float ps = 0;
#pragma unroll
  for (int r = 0; r < 16; ++r) ps += p0[r];
#pragma unroll
  for (int r = 0; r < 16; ++r) ps += p1[r];
  { auto rr = __builtin_amdgcn_permlane32_swap(__float_as_uint(ps), __float_as_uint(ps), false, false);
    ps = __uint_as_float(rr[0]) + __uint_as_float(rr[1]); }
  l_reg = l_reg * alpha + ps;
#define AT_PK4(P, BASE, OUT) do { unsigned a0 = cvtpk(P[BASE + 0], P[BASE + 1]), a1 = cvtpk(P[BASE + 2], P[BASE + 3]);   \
    unsigned b0 = cvtpk(P[BASE + 4], P[BASE + 5]), b1 = cvtpk(P[BASE + 6], P[BASE + 7]);                              \
    auto r0 = __builtin_amdgcn_permlane32_swap(a0, b0, false, false); auto r1 = __builtin_amdgcn_permlane32_swap(a1, b1, false, false); \
    u32x4 w = {r0[0], r1[0], r0[1], r1[1]}; OUT = *reinterpret_cast<bf16x8*>(&w); } while (0)
  AT_PK4(p0, 0, pa0); AT_PK4(p0, 8, pa1); AT_PK4(p1, 0, pa2); AT_PK4(p1, 8, pa3);
#undef AT_PK4
}
__device__ __forceinline__ void qkt(f32x16& p0, f32x16& p1, const char* Ks, const bf16x8* qr, int r32, int hi, int cm) {
  p0 = f32x16{}; p1 = f32x16{};
#pragma unroll
  for (int d0 = 0; d0 < 4; ++d0) { const int cb = (cm + d0 * 16 + hi * 8) * 2;
    bf16x8 b0 = *reinterpret_cast<const bf16x8*>(Ks + AT_KSWZ(r32, cb));
    bf16x8 b1 = *reinterpret_cast<const bf16x8*>(Ks + AT_KSWZ(32 + r32, cb));
    p0 = __builtin_amdgcn_mfma_f32_32x32x16_bf16(b0, qr[d0], p0, 0, 0, 0);
    p1 = __builtin_amdgcn_mfma_f32_32x32x16_bf16(b1, qr[d0], p1, 0, 0, 0); }
}
__device__ __forceinline__ int v_st(int k, int c) { const int kk = (k & ~0xC) | ((k & 4) << 1) | ((k & 8) >> 1); return ((kk >> 3) * 4 + (c >> 5)) * 512 + ((kk & 7) * 32 + (c & 31)) * 2; }
__device__ __forceinline__ int v_rd_base(int lane) { return ((lane & 3) << 3) | (((lane >> 2) & 3) << 6) | (((lane >> 4) & 1) << 5) | (((lane >> 5) & 1) << 8); }
constexpr int v_rd_off(int d0, int ks, int half) { return d0 * 512 + ks * 4096 + half * 2048; }
template <int OFF> __device__ __forceinline__ s16x4 tr_read(int vb) {
  s16x4 r; asm volatile("ds_read_b64_tr_b16 %0, %1 offset:%2" : "=&v"(r) : "v"(vb), "i"(OFF) : "memory"); return r;
}
template <int D0> __device__ __forceinline__ void pv_one(f32x16& od, int vb, bf16x8 pa0, bf16x8 pa1, bf16x8 pa2, bf16x8 pa3) {
  const s16x4 l0 = tr_read<v_rd_off(D0, 0, 0)>(vb), h0 = tr_read<v_rd_off(D0, 0, 1)>(vb), l1 = tr_read<v_rd_off(D0, 1, 0)>(vb), h1 = tr_read<v_rd_off(D0, 1, 1)>(vb);
  const s16x4 l2 = tr_read<v_rd_off(D0, 2, 0)>(vb), h2 = tr_read<v_rd_off(D0, 2, 1)>(vb), l3 = tr_read<v_rd_off(D0, 3, 0)>(vb), h3 = tr_read<v_rd_off(D0, 3, 1)>(vb);
  asm volatile("s_waitcnt lgkmcnt(0)" ::: "memory"); AT_SBAR();
#define AT_PK(L, H) (bf16x8){L[0], L[1], L[2], L[3], H[0], H[1], H[2], H[3]}
  od = __builtin_amdgcn_mfma_f32_32x32x16_bf16(pa0, AT_PK(l0, h0), od, 0, 0, 0);
  od = __builtin_amdgcn_mfma_f32_32x32x16_bf16(pa1, AT_PK(l1, h1), od, 0, 0, 0);
  od = __builtin_amdgcn_mfma_f32_32x32x16_bf16(pa2, AT_PK(l2, h2), od, 0, 0, 0);
  od = __builtin_amdgcn_mfma_f32_32x32x16_bf16(pa3, AT_PK(l3, h3), od, 0, 0, 0);
#undef AT_PK
}
__device__ __forceinline__ void pv_d0(f32x16* o, int vb, bf16x8 pa0, bf16x8 pa1, bf16x8 pa2, bf16x8 pa3) {
  pv_one<0>(o[0], vb, pa0, pa1, pa2, pa3); pv_one<1>(o[1], vb, pa0, pa1, pa2, pa3); pv_one<2>(o[2], vb, pa0, pa1, pa2, pa3); pv_one<3>(o[3], vb, pa0, pa1, pa2, pa3);
}

__device__ __forceinline__ void attn_item(const bf16_t* __restrict__ Qb, const bf16_t* __restrict__ Kh, const bf16_t* __restrict__ Vh, bf16_t* __restrict__ Ub,
                                          int q0, float nsl2, float lam, const float* __restrict__ normw, char* lds) {
  constexpr int LDK = PLD;
  int tid = threadIdx.x; asm volatile("" : "+v"(tid));
  const int wid = tid >> 6, lane = tid & 63, r32 = lane & 31, hi = lane >> 5, rg = wid >> 1, cmap = wid & 1, cm = cmap * 64;
  char* V_lds = lds; char* K_lds = lds + 2 * SHM_V;
  float* ws = (float*)(lds + 2 * SHM_V + 2 * SHM_K) + wid * 64; float* li_l = ws; float* al_l = ws + 32;
  float m_reg = -1e30f, l_reg = 0; f32x16 o[4] = {}; bf16x8 qr[4];
  const bf16_t* Qw = Qb + (size_t)(rg * 32 + r32) * LDK + cm + hi * 8;
#pragma unroll
  for (int d0 = 0; d0 < 4; ++d0) qr[d0] = *reinterpret_cast<const bf16x8*>(Qw + d0 * 16);
  const int sr = tid >> 4, sc = (tid & 15) * 8, vst0 = v_st(sr, sc), vst1 = v_st(32 + sr, sc);
  const int vb0 = (int)(uintptr_t)V_lds + v_rd_base(lane);
  const float qposh = (float)(q0 + rg * 32 + r32 - 4 * hi);
  struct { bf16x8 vs0, vs1, ks0, ks1; } sr_[2];
#define SLOAD(i, k0) do { sr_[i].vs0 = *reinterpret_cast<const bf16x8*>(&Vh[(size_t)((k0) + sr) * LDK + sc]); sr_[i].vs1 = *reinterpret_cast<const bf16x8*>(&Vh[(size_t)((k0) + 32 + sr) * LDK + sc]); \
    sr_[i].ks0 = *reinterpret_cast<const bf16x8*>(&Kh[(size_t)((k0) + sr) * LDK + sc]); sr_[i].ks1 = *reinterpret_cast<const bf16x8*>(&Kh[(size_t)((k0) + 32 + sr) * LDK + sc]); } while (0)
#define SWRITE(b, i) do { *(bf16x8*)(V_lds + (b) * SHM_V + vst0) = sr_[i].vs0;          \
    *(bf16x8*)(V_lds + (b) * SHM_V + vst1) = sr_[i].vs1; int kc = sc * 2;               \
    *(bf16x8*)(K_lds + (b) * SHM_K + AT_KSWZ(sr, kc)) = sr_[i].ks0;                       \
    *(bf16x8*)(K_lds + (b) * SHM_K + AT_KSWZ(32 + sr, kc)) = sr_[i].ks1; } while (0)
#define SWAIT() asm volatile("s_waitcnt vmcnt(4)" ::: "memory")
#define RESC(a) do { if (__any((a) < 1.f)) { if (hi == 0) al_l[r32] = (a); asm volatile("s_waitcnt lgkmcnt(0)" ::: "memory"); \
    _Pragma("unroll") for (int d = 0; d < 4; ++d) _Pragma("unroll") for (int r = 0; r < 16; ++r) o[d][r] *= al_l[crow(r, hi)]; } } while (0)
  f32x16 pA0, pA1, pB0, pB1; float mnA, mnB, alA, alB; bf16x8 pa0, pa1, pa2, pa3; constexpr int NTL = S / KVBLK;
  constexpr int SE = 0, SO = 1;
  SLOAD(SE, 0); asm volatile("s_waitcnt vmcnt(0)" ::: "memory"); SWRITE(0, SE); __syncthreads();
  qkt(pA0, pA1, K_lds, qr, r32, hi, cm); partialSM(pA0, pA1, qposh, nsl2, m_reg, mnA, alA);
  SLOAD(SO, KVBLK); SLOAD(SE, 2 * KVBLK);
  SWAIT(); SWRITE(1, SO); __syncthreads();
  for (int j = 1; j + 1 < NTL; j += 2) {
    AT_SBAR(); qkt(pB0, pB1, K_lds + SHM_K, qr, r32, hi, cm);
    finishSM(pA0, pA1, alA, l_reg, pa0, pa1, pa2, pa3); AT_SBAR();
    SLOAD(SO, (j + 2) * KVBLK); AT_SBAR();
    pv_d0(o, vb0, pa0, pa1, pa2, pa3); partialSM(pB0, pB1, qposh - (float)(j * KVBLK), nsl2, m_reg, mnB, alB);
    __syncthreads(); SWAIT(); SWRITE(0, SE);
    RESC(alB); __syncthreads();
    AT_SBAR(); qkt(pA0, pA1, K_lds, qr, r32, hi, cm);
    finishSM(pB0, pB1, alB, l_reg, pa0, pa1, pa2, pa3); AT_SBAR();
    if (j + 3 < NTL) SLOAD(SE, (j + 3) * KVBLK); AT_SBAR();
    pv_d0(o, vb0 + (int)SHM_V, pa0, pa1, pa2, pa3); partialSM(pA0, pA1, qposh - (float)((j + 1) * KVBLK), nsl2, m_reg, mnA, alA);
    __syncthreads(); SWAIT(); SWRITE(1, SO);
    RESC(alA); __syncthreads();
  }
  AT_SBAR(); qkt(pB0, pB1, K_lds + SHM_K, qr, r32, hi, cm);
  finishSM(pA0, pA1, alA, l_reg, pa0, pa1, pa2, pa3); AT_SBAR();
  pv_d0(o, vb0, pa0, pa1, pa2, pa3); partialSM(pB0, pB1, qposh - (float)((NTL - 1) * KVBLK), nsl2, m_reg, mnB, alB);
  __syncthreads(); RESC(alB);
  finishSM(pB0, pB1, alB, l_reg, pa0, pa1, pa2, pa3); AT_SBAR();
  pv_d0(o, vb0 + (int)SHM_V, pa0, pa1, pa2, pa3);
  if (hi == 0) li_l[r32] = l_reg; asm volatile("s_waitcnt lgkmcnt(0)" ::: "memory");
  float rli[16];
#pragma unroll
  for (int r = 0; r < 16; ++r) rli[r] = __builtin_amdgcn_rcpf(li_l[crow(r, hi)]);
#pragma unroll
  for (int d = 0; d < 4; ++d)
#pragma unroll
    for (int r = 0; r < 16; ++r) o[d][r] *= rli[r];
  __syncthreads();
  float* X = (float*)lds + rg * (32 * 128);
  if (cmap == 1) {
#pragma unroll
    for (int d = 0; d < 4; ++d)
#pragma unroll
      for (int r = 0; r < 16; ++r) X[crow(r, hi) * 128 + d * 32 + r32] = o[d][r];
  }
  __syncthreads();
  if (cmap == 0) {
    float ss[16];
#pragma unroll
    for (int r = 0; r < 16; ++r) ss[r] = 0.f;
#pragma unroll
    for (int d = 0; d < 4; ++d)
#pragma unroll
      for (int r = 0; r < 16; ++r) { const float v = o[d][r] - lam * X[crow(r, hi) * 128 + d * 32 + r32]; o[d][r] = v; ss[r] += v * v; }
#pragma unroll
    for (int r = 0; r < 16; ++r) { float s = ss[r]; s += __shfl_xor(s, 16); s += __shfl_xor(s, 8); s += __shfl_xor(s, 4); s += __shfl_xor(s, 2); s += __shfl_xor(s, 1);
      ss[r] = rsqrtf(s * (1.f / 128.f) + 1e-5f) * (1.f - LAMBDA_INIT); }
    float nw[4];
#pragma unroll
    for (int d = 0; d < 4; ++d) nw[d] = normw[d * 32 + r32];
#pragma unroll
    for (int r = 0; r < 16; ++r) { bf16_t* up = Ub + (size_t)(rg * 32 + crow(r, hi)) * D + r32;
#pragma unroll
      for (int d = 0; d < 4; ++d) up[d * 32] = f2bf(o[d][r] * ss[r] * nw[d]); }
  }
  __syncthreads();
#undef SLOAD
#undef SWRITE
#undef SWAIT
#undef RESC
}
}

__device__ void ph_attn_mfma(const Params& p, char* lds) {
  float lam;
  { float s1 = 0.f, s2 = 0.f; for (int i = 0; i < 64; ++i) { s1 += p.lq1[i] * p.lk1[i]; s2 += p.lq2[i] * p.lk2[i]; } lam = __expf(s1) - __expf(s2) + LAMBDA_INIT; }
  int* qslot = (int*)(lds + 72 * 1024);
  for (;;) {
    __syncthreads();
    if (threadIdx.x == 0) *qslot = atomicAdd(p.meta + 8, 1);
    __syncthreads();
    const int item = *qslot;
    if (item >= NB * AH * (S / 128)) break;
    const int qb = item % (S / 128), h = (item / (S / 128)) % AH, b = item / ((S / 128) * AH);
    const float nsl2 = -exp2f(-(float)(h + 1)) * LOG2E;
    const size_t row0 = (size_t)b * S;
    at::attn_item(p.proj + (row0 + qb * 128) * PLD + N_Q + h * 128, p.proj + row0 * PLD + N_K + h * 128, p.proj + row0 * PLD + N_V + h * 128,
                  p.u + (row0 + qb * 128) * D + DSSD + h * 128, qb * 128, nsl2, lam, p.attn_norm_w, lds);
  }
}
namespace sd {
using at::bf16x8; using at::s16x4; using at::f32x16; using at::u32x4; using at::crow; using at::cvtpk; using at::v_st; using at::v_rd_base; using at::v_rd_off; using at::tr_read;
constexpr int CH = 64, NCH = S / CH;
constexpr int L_BT = 0, L_CT = 16384, L_XV = 32768, L_TAB = 98304, L_SS = 106496;
constexpr int L_CW = 108544, CW_LD = 768;
constexpr size_t SNAP = 16384;
__device__ __forceinline__ size_t snap_off(int dir, int b, int h, int c) { return ((((size_t)dir * NB + b) * NH + h) * NCH + c) * SNAP; }

template <class Wr>
__device__ __forceinline__ void conv8(const Params& p, const float* cw, int b, int chan, int lc, int s0, int n, Wr wr) {
  const bf16_t* base = p.proj + (size_t)b * S * PLD + N_XBC + chan;
  auto ldrow = [&](int s) { u32x4 r = {0u, 0u, 0u, 0u}; if (s >= 0 && s < S) r = *(const u32x4*)(base + (size_t)s * PLD); return r; };
  u32x4 r0 = ldrow(s0 - 2), r1 = ldrow(s0 - 1), r2 = ldrow(s0), r3 = ldrow(s0 + 1);
  for (int i = 0; i < n; ++i) {
    const u32x4 r4 = ldrow(s0 + i + 2);
    float o[8];
    { const float4 a = *(const float4*)(cw + 5 * CW_LD + lc), c = *(const float4*)(cw + 5 * CW_LD + lc + 4);
      o[0] = a.x; o[1] = a.y; o[2] = a.z; o[3] = a.w; o[4] = c.x; o[5] = c.y; o[6] = c.z; o[7] = c.w; }
#pragma unroll
    for (int j = 0; j < 5; ++j) {
      const u32x4 rr = j == 0 ? r0 : (j == 1 ? r1 : (j == 2 ? r2 : (j == 3 ? r3 : r4)));
      const float4 a = *(const float4*)(cw + j * CW_LD + lc), c = *(const float4*)(cw + j * CW_LD + lc + 4);
      o[0] += a.x * __uint_as_float(rr.x << 16); o[1] += a.y * __uint_as_float(rr.x & 0xffff0000u);
      o[2] += a.z * __uint_as_float(rr.y << 16); o[3] += a.w * __uint_as_float(rr.y & 0xffff0000u);
      o[4] += c.x * __uint_as_float(rr.z << 16); o[5] += c.y * __uint_as_float(rr.z & 0xffff0000u);
      o[6] += c.z * __uint_as_float(rr.w << 16); o[7] += c.w * __uint_as_float(rr.w & 0xffff0000u);
      asm volatile("" ::: "memory");
    }
#pragma unroll
    for (int c = 0; c < 8; ++c) o[c] = o[c] * __builtin_amdgcn_rcpf(1.f + __expf(-o[c]));
    u32x4 pk; pk.x = cvtpk(o[0], o[1]); pk.y = cvtpk(o[2], o[3]); pk.z = cvtpk(o[4], o[5]); pk.w = cvtpk(o[6], o[7]);
    wr(i, pk);
    r0 = r1; r1 = r2; r2 = r3; r3 = r4;
  }
}
__device__ __forceinline__ void conv_weights_to_lds(const Params& p, float* cw, int g) {
  int t0_ = threadIdx.x; asm volatile("" : "+v"(t0_));
  for (int i = t0_; i < 6 * 768; i += NT) { const int j = i / 768, lc = i % 768;
    const int chan = lc < 512 ? g * 512 + lc : (lc < 640 ? 1024 + g * 128 + (lc - 512) : 1280 + g * 128 + (lc - 640));
    cw[j * CW_LD + lc] = j < 5 ? p.conv_w[j * CC + chan] : p.conv_b[chan]; }
}
template <bool WITH_C, bool BV>
__device__ __forceinline__ void conv_chunk(const Params& p, char* lds, int b, int g, int c0) {
  constexpr int NCG = WITH_C ? 96 : 80, NSEG = 480 / NCG, SEGL = (CH + NSEG - 1) / NSEG;
  int tid = threadIdx.x; asm volatile("" : "+v"(tid));
  const float* cw = (const float*)(lds + L_CW);
  if (tid < 480) {
    const int cg = tid % NCG, seg = tid / NCG, t0 = seg * SEGL, n = (CH - t0) < SEGL ? (CH - t0) : SEGL;
    if (n > 0) {
      if (cg < 64) { const int hl = cg >> 3, c = (hl & 1) * 64 + (cg & 7) * 8; char* tile = lds + L_XV + (hl >> 1) * 16384;
        conv8(p, cw, b, g * 512 + cg * 8, cg * 8, c0 + t0, n, [&](int i, u32x4 v) { *(u32x4*)(tile + v_st(t0 + i, c)) = v; }); }
      else if (cg < 80) { const int n0 = (cg - 64) * 8;
        conv8(p, cw, b, 1024 + g * 128 + n0, 512 + n0, c0 + t0, n, [&](int i, u32x4 v) { if (BV) *(u32x4*)(lds + L_BT + v_st(t0 + i, n0)) = v; else *(u32x4*)(lds + L_BT + AT_KSWZ(t0 + i, n0 * 2)) = v; }); }
      else { const int n0 = (cg - 80) * 8;
        conv8(p, cw, b, 1280 + g * 128 + n0, 640 + n0, c0 + t0, n, [&](int i, u32x4 v) { *(u32x4*)(lds + L_CT + AT_KSWZ(t0 + i, n0 * 2)) = v; }); }
    }
  }
}
__device__ __forceinline__ float wave_incl_prefix(float v, int lane) {
#pragma unroll
  for (int o = 1; o < 64; o <<= 1) { const float t = __int_as_float(__builtin_amdgcn_ds_bpermute(((lane - o) & 63) << 2, __float_as_int(v))); if (lane >= o) v += t; }
  return v;
}
__device__ __forceinline__ float wave_incl_suffix(float v, int lane) {
#pragma unroll
  for (int o = 1; o < 64; o <<= 1) { const float t = __int_as_float(__builtin_amdgcn_ds_bpermute(((lane + o) & 63) << 2, __float_as_int(v))); if (lane + o < 64) v += t; }
  return v;
}
__device__ __forceinline__ float wave_bcast(float v, int src) { return __int_as_float(__builtin_amdgcn_ds_bpermute(src << 2, __float_as_int(v))); }
__device__ __forceinline__ bf16x8 scale_frag(s16x4 lo, s16x4 hi, const float4 w0, const float4 w1) {
  const unsigned a = ((unsigned)(unsigned short)lo[0]) | ((unsigned)(unsigned short)lo[1] << 16), b = ((unsigned)(unsigned short)lo[2]) | ((unsigned)(unsigned short)lo[3] << 16);
  const unsigned c = ((unsigned)(unsigned short)hi[0]) | ((unsigned)(unsigned short)hi[1] << 16), d = ((unsigned)(unsigned short)hi[2]) | ((unsigned)(unsigned short)hi[3] << 16);
  u32x4 r;
  r.x = cvtpk(__uint_as_float(a << 16) * w0.x, __uint_as_float(a & 0xffff0000u) * w0.y);
  r.y = cvtpk(__uint_as_float(b << 16) * w0.z, __uint_as_float(b & 0xffff0000u) * w0.w);
  r.z = cvtpk(__uint_as_float(c << 16) * w1.x, __uint_as_float(c & 0xffff0000u) * w1.y);
  r.w = cvtpk(__uint_as_float(d << 16) * w1.z, __uint_as_float(d & 0xffff0000u) * w1.w);
  return *reinterpret_cast<bf16x8*>(&r);
}
#define SD_PK(L, H) (bf16x8){L[0], L[1], L[2], L[3], H[0], H[1], H[2], H[3]}

__device__ __forceinline__ void pass_a_item(const Params& p, char* lds, char* snap, int b, int g, int dir) {
  int tid = threadIdx.x; asm volatile("" : "+v"(tid));
  const int hl = tid >> 6, lane = tid & 63, r32 = lane & 31, hi = lane >> 5, h = g * 8 + hl;
  const float a = -__expf(dir ? p.a_log_b[h] : p.a_log_f[h]);
  float* wtab = (float*)(lds + L_TAB) + hl * 64;
  const int vbx = (int)(uintptr_t)(lds + L_XV + (hl >> 1) * 16384) + v_rd_base(lane) + (hl & 1) * 1024;
  const int vbb = (int)(uintptr_t)(lds + L_BT) + v_rd_base(lane);
  f32x16 st[4][2];
#pragma unroll
  for (int nb = 0; nb < 4; ++nb)
#pragma unroll
    for (int pb = 0; pb < 2; ++pb) st[nb][pb] = f32x16{};
  __syncthreads();
  conv_weights_to_lds(p, (float*)(lds + L_CW), g);
  for (int ci = 0; ci < NCH; ++ci) {
    const int c = dir ? (NCH - 1 - ci) : ci, c0 = c * CH;
    __syncthreads();
    conv_chunk<false, true>(p, lds, b, g, c0);
    const float dtv = p.dt[((size_t)b * S + c0 + lane) * 32 + dir * 16 + h];
    const float adt = a * dtv;
    const float cum = dir ? wave_incl_suffix(adt, lane) : wave_incl_prefix(adt, lane);
    const float total = wave_bcast(cum, dir ? 0 : 63);
    wtab[lane] = __expf(total - cum) * dtv;
    const float dec = __expf(total);
    { char* sp = snap + snap_off(dir, b, h, c);
#pragma unroll
      for (int nb = 0; nb < 4; ++nb)
#pragma unroll
        for (int pb = 0; pb < 2; ++pb)
#pragma unroll
          for (int q = 0; q < 4; ++q) { const f32x16& s = st[nb][pb];
            uint2 v; v.x = cvtpk(s[4 * q + 0], s[4 * q + 1]); v.y = cvtpk(s[4 * q + 2], s[4 * q + 3]);
            *(uint2*)(sp + ((((pb * 8 + nb * 2 + (q >> 1)) * 2 + (q & 1)) * 32 + r32) * 16 + hi * 8)) = v; } }
#pragma unroll
    for (int nb = 0; nb < 4; ++nb)
#pragma unroll
      for (int pb = 0; pb < 2; ++pb)
#pragma unroll
        for (int r = 0; r < 16; ++r) st[nb][pb][r] *= dec;
    __syncthreads();
#pragma unroll
    for (int ks = 0; ks < 4; ++ks) {
      const float4 w0 = *(const float4*)(wtab + ks * 16 + hi * 8), w1 = *(const float4*)(wtab + ks * 16 + hi * 8 + 4);
      bf16x8 xf[2];
      { const s16x4 l0 = tr_read<v_rd_off(0, 0, 0)>(vbx + ks * 4096), h0 = tr_read<v_rd_off(0, 0, 1)>(vbx + ks * 4096), l1 = tr_read<v_rd_off(1, 0, 0)>(vbx + ks * 4096), h1 = tr_read<v_rd_off(1, 0, 1)>(vbx + ks * 4096);
        asm volatile("s_waitcnt lgkmcnt(0)" ::: "memory"); AT_SBAR();
        xf[0] = scale_frag(l0, h0, w0, w1); xf[1] = scale_frag(l1, h1, w0, w1); }
#pragma unroll
      for (int nb = 0; nb < 4; ++nb) {
        s16x4 bl, bh;
        asm volatile("ds_read_b64_tr_b16 %0, %1" : "=&v"(bl) : "v"(vbb + nb * 512 + ks * 4096) : "memory");
        asm volatile("ds_read_b64_tr_b16 %0, %1 offset:2048" : "=&v"(bh) : "v"(vbb + nb * 512 + ks * 4096) : "memory");
        asm volatile("s_waitcnt lgkmcnt(0)" ::: "memory"); AT_SBAR();
        const bf16x8 bfr = SD_PK(bl, bh);
        st[nb][0] = __builtin_amdgcn_mfma_f32_32x32x16_bf16(bfr, xf[0], st[nb][0], 0, 0, 0);
        st[nb][1] = __builtin_amdgcn_mfma_f32_32x32x16_bf16(bfr, xf[1], st[nb][1], 0, 0, 0);
      }
    }
  }
  __syncthreads();
}

__device__ __forceinline__ void pass_b_item(const Params& p, char* lds, const char* snap, int b, int g, int c) {
  int tid = threadIdx.x; asm volatile("" : "+v"(tid));
  const int hl = tid >> 6, lane = tid & 63, r32 = lane & 31, hi = lane >> 5, h = g * 8 + hl, c0 = c * CH;
  float4* tab = (float4*)(lds + L_TAB) + hl * 64;
  float* ssp = (float*)(lds + L_SS);
  const int vbx = (int)(uintptr_t)(lds + L_XV + (hl >> 1) * 16384) + v_rd_base(lane) + (hl & 1) * 1024;
  __syncthreads();
  conv_weights_to_lds(p, (float*)(lds + L_CW), g);
  __syncthreads();
  conv_chunk<true, false>(p, lds, b, g, c0);
  { const size_t tok = (size_t)b * S + c0 + lane;
    const float dtf = p.dt[tok * 32 + h], dtb = p.dt[tok * 32 + 16 + h];
    const float af = -__expf(p.a_log_f[h]) * dtf, ab = -__expf(p.a_log_b[h]) * dtb;
    tab[lane] = make_float4(wave_incl_prefix(af, lane) * LOG2E, wave_incl_suffix(ab, lane) * LOG2E, dtf, dtb); }
  __syncthreads();
  const float dsk = p.d_skip[h];
  f32x16 o[2][2];
#pragma unroll
  for (int lb = 0; lb < 2; ++lb) {
    const int l = lb * 32 + r32;
    const float4 tl = tab[l];
    bf16x8 cr[8];
#pragma unroll
    for (int kk = 0; kk < 8; ++kk) cr[kk] = *reinterpret_cast<const bf16x8*>(lds + L_CT + AT_KSWZ(l, (kk * 16 + hi * 8) * 2));
    f32x16 p0 = f32x16{}, p1 = f32x16{};
#pragma unroll
    for (int kk = 0; kk < 8; ++kk) { const int cb = (kk * 16 + hi * 8) * 2;
      const bf16x8 b0 = *reinterpret_cast<const bf16x8*>(lds + L_BT + AT_KSWZ(r32, cb));
      const bf16x8 b1 = *reinterpret_cast<const bf16x8*>(lds + L_BT + AT_KSWZ(32 + r32, cb));
      p0 = __builtin_amdgcn_mfma_f32_32x32x16_bf16(b0, cr[kk], p0, 0, 0, 0);
      p1 = __builtin_amdgcn_mfma_f32_32x32x16_bf16(b1, cr[kk], p1, 0, 0, 0); }
#pragma unroll
    for (int r = 0; r < 16; ++r) {
#pragma unroll
      for (int half = 0; half < 2; ++half) {
        const int s = crow(r, hi) + 32 * half; const float4 ts = tab[s];
        float m = 0.f;
        if (s <= l) m += __builtin_amdgcn_exp2f(tl.x - ts.x) * ts.z;
        if (s >= l) m += __builtin_amdgcn_exp2f(tl.y - ts.y) * ts.w;
        const float add = (s == l) ? dsk : 0.f;
        if (half) p1[r] = p1[r] * m + add; else p0[r] = p0[r] * m + add;
      }
      asm volatile("" ::: "memory");
    }
    bf16x8 pa0, pa1, pa2, pa3;
#define SD_PK4(P, BASE, OUT) do { unsigned a0 = cvtpk(P[BASE + 0], P[BASE + 1]), a1 = cvtpk(P[BASE + 2], P[BASE + 3]);   \
    unsigned b0_ = cvtpk(P[BASE + 4], P[BASE + 5]), b1_ = cvtpk(P[BASE + 6], P[BASE + 7]);                              \
    auto r0 = __builtin_amdgcn_permlane32_swap(a0, b0_, false, false); auto r1 = __builtin_amdgcn_permlane32_swap(a1, b1_, false, false); \
    u32x4 w_ = {r0[0], r1[0], r0[1], r1[1]}; OUT = *reinterpret_cast<bf16x8*>(&w_); } while (0)
    SD_PK4(p0, 0, pa0); SD_PK4(p0, 8, pa1); SD_PK4(p1, 0, pa2); SD_PK4(p1, 8, pa3);
#undef SD_PK4
#pragma unroll
    for (int d = 0; d < 2; ++d) {
      const s16x4 l0 = d ? tr_read<v_rd_off(1, 0, 0)>(vbx) : tr_read<v_rd_off(0, 0, 0)>(vbx), h0 = d ? tr_read<v_rd_off(1, 0, 1)>(vbx) : tr_read<v_rd_off(0, 0, 1)>(vbx);
      const s16x4 l1 = d ? tr_read<v_rd_off(1, 1, 0)>(vbx) : tr_read<v_rd_off(0, 1, 0)>(vbx), h1 = d ? tr_read<v_rd_off(1, 1, 1)>(vbx) : tr_read<v_rd_off(0, 1, 1)>(vbx);
      const s16x4 l2 = d ? tr_read<v_rd_off(1, 2, 0)>(vbx) : tr_read<v_rd_off(0, 2, 0)>(vbx), h2 = d ? tr_read<v_rd_off(1, 2, 1)>(vbx) : tr_read<v_rd_off(0, 2, 1)>(vbx);
      const s16x4 l3 = d ? tr_read<v_rd_off(1, 3, 0)>(vbx) : tr_read<v_rd_off(0, 3, 0)>(vbx), h3 = d ? tr_read<v_rd_off(1, 3, 1)>(vbx) : tr_read<v_rd_off(0, 3, 1)>(vbx);
      asm volatile("s_waitcnt lgkmcnt(0)" ::: "memory"); AT_SBAR();
      f32x16 od = f32x16{};
      od = __builtin_amdgcn_mfma_f32_32x32x16_bf16(pa0, SD_PK(l0, h0), od, 0, 0, 0);
      od = __builtin_amdgcn_mfma_f32_32x32x16_bf16(pa1, SD_PK(l1, h1), od, 0, 0, 0);
      od = __builtin_amdgcn_mfma_f32_32x32x16_bf16(pa2, SD_PK(l2, h2), od, 0, 0, 0);
      od = __builtin_amdgcn_mfma_f32_32x32x16_bf16(pa3, SD_PK(l3, h3), od, 0, 0, 0);
      o[lb][d] = od;
    }
  }
#pragma unroll
  for (int dir = 0; dir < 2; ++dir) {
    if (dir == 0 ? (c == 0) : (c == NCH - 1)) continue;
    const char* sp = snap + snap_off(dir, b, h, c);
#pragma unroll
    for (int d = 0; d < 2; ++d) {
      bf16x8 sf[8];
#pragma unroll
      for (int kk = 0; kk < 8; ++kk) sf[kk] = *reinterpret_cast<const bf16x8*>(sp + ((((d * 8 + kk) * 2 + hi) * 32 + r32) * 16));
#pragma unroll
      for (int lb = 0; lb < 2; ++lb) {
        f32x16 acc = f32x16{};
#pragma unroll
        for (int kk = 0; kk < 8; ++kk) { const bf16x8 cf = *reinterpret_cast<const bf16x8*>(lds + L_CT + AT_KSWZ(lb * 32 + r32, (kk * 16 + hi * 8) * 2));
          acc = __builtin_amdgcn_mfma_f32_32x32x16_bf16(cf, sf[kk], acc, 0, 0, 0); }
#pragma unroll
        for (int r = 0; r < 16; ++r) { const float4 tr = tab[lb * 32 + crow(r, hi)]; o[lb][d][r] += __builtin_amdgcn_exp2f(dir ? tr.y : tr.x) * acc[r]; }
      }
    }
  }
  const bf16_t* zp = p.proj + ((size_t)b * S + c0) * PLD + N_Z + h * HD + r32;
#pragma unroll
  for (int lb = 0; lb < 2; ++lb)
#pragma unroll
    for (int r = 0; r < 16; ++r) { const int l = lb * 32 + crow(r, hi); float ss = 0.f;
#pragma unroll
      for (int d = 0; d < 2; ++d) { const float z = bf2f(zp[(size_t)l * PLD + d * 32]); const float y = o[lb][d][r] * z * __builtin_amdgcn_rcpf(1.f + __expf(-z)); o[lb][d][r] = y; ss += y * y; }
      ss += __shfl_xor(ss, 16); ss += __shfl_xor(ss, 8); ss += __shfl_xor(ss, 4); ss += __shfl_xor(ss, 2); ss += __shfl_xor(ss, 1);
      if (r32 == 0) ssp[hl * 64 + l] = ss; }
  __syncthreads();
  const float nw0 = p.ssd_norm_w[h * HD + r32], nw1 = p.ssd_norm_w[h * HD + 32 + r32];
  bf16_t* up = p.u + ((size_t)b * S + c0) * D + h * HD + r32;
#pragma unroll
  for (int lb = 0; lb < 2; ++lb)
#pragma unroll
    for (int r = 0; r < 16; ++r) { const int l = lb * 32 + crow(r, hi); float ss = 0.f;
#pragma unroll
      for (int q = 0; q < 8; ++q) ss += ssp[q * 64 + l];
      const float rstd = rsqrtf(ss * (1.f / 512.f) + 1e-5f);
      up[(size_t)l * D] = f2bf(o[lb][0][r] * rstd * nw0); up[(size_t)l * D + 32] = f2bf(o[lb][1][r] * rstd * nw1); }
}
}

__device__ void ph_ssd_a(const Params& p, char* lds, char* snap) {
  for (int item = blockIdx.x; item < NB * 2 * 2; item += gridDim.x) { const int dir = item & 1, g = (item >> 1) & 1, b = item >> 2; sd::pass_a_item(p, lds, snap, b, g, dir); }
}
__device__ void ph_ssd_b(const Params& p, char* lds, const char* snap) {
  for (int item = blockIdx.x; item < NB * 2 * sd::NCH; item += gridDim.x) { const int c = item % sd::NCH, g = (item / sd::NCH) & 1, b = item / (2 * sd::NCH); sd::pass_b_item(p, lds, snap, b, g, c); }
}
__device__ void ph_inproj(const Params& p, LAS unsigned char* lds) {
  pg8::Gemm g{p.xb, p.WinT, D}; pg8::OrderStatic Sd; Sd.init(T, NPROJ, gridDim.x, blockIdx.x);
  EpiProj E{p.proj, p.dt, p.dt_bias_f, p.dt_bias_b};
  pg8::gemm_phase<false>(lds, g, Sd, E);
}
__device__ void ph_outproj(const Params& p, LAS unsigned char* lds) {
  pg8::Gemm g{p.u, p.WoutT, D}; pg8::OrderStatic Sd; Sd.init(T, D, gridDim.x, blockIdx.x);
  EpiOut E{p.x, p.h1};
  pg8::gemm_phase<false>(lds, g, Sd, E);
}
__device__ void ph_ln1(const Params& p) {
  const int lane = threadIdx.x & 63, wv = threadIdx.x >> 6;
  for (int row = blockIdx.x * 8 + wv; row < T; row += gridDim.x * 8) {
    float* hp = p.h1 + (size_t)row * D; float v[32]; float s = 0.f;
#pragma unroll
    for (int j = 0; j < 32; ++j) { v[j] = hp[j * 64 + lane]; s += v[j]; }
    const float mu = wave_sum(s) * (1.f / D); float q = 0.f;
#pragma unroll
    for (int j = 0; j < 32; ++j) { const float d = v[j] - mu; q += d * d; }
    const float rstd = rsqrtf(wave_sum(q) * (1.f / D) + 1e-5f);
#pragma unroll
    for (int j = 0; j < 32; ++j) { const int c = j * 64 + lane; const float o = (v[j] - mu) * rstd * p.ln1_g[c] + p.ln1_b[c]; hp[c] = o; p.h1b[(size_t)row * D + c] = f2bf(o); }
  }
}
__device__ void ph_router(const Params& p, float* smem) {
  for (int mt = blockIdx.x; mt < T / 64; mt += gridDim.x) {
    const int m0 = mt * 64;
    gemm_tile(smem, 64, NE, D, [&](int r) { return p.h1 + (size_t)(m0 + r) * D; }, p.w_router, NE,
              [&](int r, int c, float v) { p.logits[(size_t)(m0 + r) * NE + c] = v; });
  }
}
__device__ __forceinline__ int ld_agent(const int* p) { return __hip_atomic_load(p, __ATOMIC_RELAXED, __HIP_MEMORY_SCOPE_AGENT); }
__device__ __forceinline__ float ld_agent(const float* p) { return __hip_atomic_load(p, __ATOMIC_RELAXED, __HIP_MEMORY_SCOPE_AGENT); }
__device__ void ph_route(const Params& p, LAS unsigned char* lds) {
  LAS int* cntl = (LAS int*)lds;
  const int lane = threadIdx.x & 63, wv = threadIdx.x >> 6;
  for (int tb = blockIdx.x; tb < T / 64; tb += gridDim.x) {
    __syncthreads();
    if (threadIdx.x < NE) cntl[threadIdx.x] = 0;
    __syncthreads();
    for (int ti = 0; ti < 8; ++ti) {
      const int t = tb * 64 + wv * 8 + ti;
      const float sc = 1.f / (1.f + __expf(-p.logits[(size_t)t * NE + lane]));
      const float bz = sc + p.router_bias[lane];
      int rk = 0;
#pragma unroll
      for (int j = 1; j < 8; ++j) { const float o = __shfl_xor(bz, j); const int oi = lane ^ j; rk += (o > bz || (o == bz && oi < lane)) ? 1 : 0; }
      float gs = rk < 2 ? bz : 0.f;
      gs += __shfl_xor(gs, 1); gs += __shfl_xor(gs, 2); gs += __shfl_xor(gs, 4);
      const int g = lane >> 3; int grk = 0;
#pragma unroll
      for (int j = 1; j < 8; ++j) { const float o = __shfl_xor(gs, j * 8); const int og = g ^ j; grk += (o > gs || (o == gs && og < g)) ? 1 : 0; }
      const bool gsel = grk < 4;
      const float mb = gsel ? bz : -INFINITY;
      int erk = 0;
      for (int j = 1; j < 64; ++j) { const float o = __shfl_xor(mb, j); const int oi = lane ^ j; erk += (o > mb || (o == mb && oi < lane)) ? 1 : 0; }
      const bool sel = gsel && erk < 8;
      const float gsum = wave_sum(sel ? sc : 0.f);
      if (sel) {
        const int lr = __hip_atomic_fetch_add(&cntl[lane], 1, __ATOMIC_RELAXED, __HIP_MEMORY_SCOPE_WORKGROUP);
        p.assign[t * 8 + erk] = lane | (lr << 8); p.gate[t * 8 + erk] = sc / gsum * 2.5f;
      }
    }
    __syncthreads();
    if (threadIdx.x < NE) p.blkcnt[tb * NE + threadIdx.x] = cntl[threadIdx.x];
  }
}
__device__ void ph_place(const Params& p, LAS unsigned char* lds) {
  LAS int* part = (LAS int*)lds;
  LAS int* parta = part + 512;
  LAS int* base = parta + 512;
  LAS int* total = base + 64;
  LAS int* pstart = total + 64;
  const int tid = threadIdx.x, e = tid & 63, pt = tid >> 6;
  for (int tb = blockIdx.x; tb < T / 64; tb += gridDim.x) {
    __syncthreads();
    int slo = 0, sall = 0;
    for (int b = pt * 32; b < pt * 32 + 32; ++b) { const int c = ld_agent(p.blkcnt + b * NE + e); sall += c; slo += (b < tb) ? c : 0; }
    part[pt * 64 + e] = slo; parta[pt * 64 + e] = sall;
    __syncthreads();
    if (tid < 64) {
      int b0 = 0, t0 = 0;
#pragma unroll
      for (int q = 0; q < 8; ++q) { b0 += part[q * 64 + tid]; t0 += parta[q * 64 + tid]; }
      base[tid] = b0; total[tid] = t0;
      const int padded = (t0 + 255) & ~255;
      int incl = padded;
      for (int o = 1; o < 64; o <<= 1) { const int v = __shfl_up(incl, o); if (tid >= o) incl += v; }
      pstart[tid] = incl - padded;
      if (tid == 63) pstart[64] = incl;
    }
    __syncthreads();
    {
      const int t = tb * 64 + (tid >> 3), k = tid & 7;
      const int a = ld_agent(p.assign + t * 8 + k), ee = a & 255, lr = a >> 8;
      const int row = pstart[ee] + base[ee] + lr;
      p.row_tok[row] = t; p.row_gate[row] = ld_agent(p.gate + t * 8 + k); p.pos[t * 8 + k] = row;
      if (tid < 64) { const int srow = pstart[64] + tb * 64 + tid; p.row_tok[srow] = tb * 64 + tid; p.row_gate[srow] = 1.0f; }
    }
    if (tb == blockIdx.x) {
      for (int e2 = blockIdx.x; e2 < NE; e2 += gridDim.x) {
        const int r0 = pstart[e2] + total[e2], r1 = pstart[e2 + 1];
        for (int r = r0 + tid; r < r1; r += NT) { p.row_tok[r] = 0; p.row_gate[r] = 0.f; }
        for (int j = pstart[e2] / 256 + tid; j < r1 / 256; j += NT) p.tile_exp[j] = e2;
      }
      if (blockIdx.x == 0) {
        const int nr = pstart[64] / 256;
        for (int j = tid; j < T / 256; j += NT) p.tile_exp[nr + j] = NE;
        if (tid == 0) { p.meta[0] = nr; p.meta[1] = nr + T / 256; }
      }
    }
  }
}
struct OrderMoE {
  LAS const int* ulist; int n;
  LAS const unsigned* tab;
  __device__ __forceinline__ bool next(int i, pg8::Unit& u) const { if (i >= n) return false; u.pm = ulist[i * 4 + 0]; u.pn = ulist[i * 4 + 1]; u.bn = ulist[i * 4 + 2]; u.aux = i; return true; }
  __device__ __forceinline__ unsigned row_off(int i, int row) const { return tab[i * 512 + row]; }
};
template <bool TABLES>
__device__ __forceinline__ OrderMoE moe_order(const Params& p, LAS unsigned char* lds, int npn, int tile0, int ntiles, int rowbytes) {
  LAS int* ulist = (LAS int*)(lds + LDS_TAB); LAS unsigned* tab = (LAS unsigned*)(lds + LDS_TAB + 1024);
  const int G = gridDim.x, c = blockIdx.x, mpc = 32 / npn; int n = 0;
  __syncthreads();
  for (int i = 0; i < 60; ++i) {
    int U; if (G == 256) U = ((i * 8 + (c & 7)) * 32 + (c >> 3)); else U = i * G + c;
    const int chunk = U >> 5, w = U & 31, j = chunk * mpc + (w % mpc), pn = w / mpc;
    if (j >= ntiles) break;
    const int tile = tile0 + j, e = ld_agent(p.tile_exp + tile);
    if (threadIdx.x == 0) { ulist[i * 4 + 0] = tile; ulist[i * 4 + 1] = pn; ulist[i * 4 + 2] = e * npn + pn; ulist[i * 4 + 3] = e; }
    if (TABLES) { for (int r = threadIdx.x; r < 256; r += NT) { tab[i * 512 + r] = (unsigned)ld_agent(p.row_tok + tile * 256 + r) * (unsigned)rowbytes; tab[i * 512 + 256 + r] = __float_as_uint(ld_agent(p.row_gate + tile * 256 + r)); } }
    n = i + 1;
  }
  __syncthreads();
  return OrderMoE{ulist, n, tab};
}
struct EpiGU {
  static constexpr bool PERM = true;
  bf16_t* H; LAS const unsigned* tab;
  __device__ __forceinline__ void operator()(const f32x4 (&acc)[2][2][4][2], const pg8::Unit& u, int wr, int wc, int fr, int fq) const {
    const int col0 = u.pn * 128 + wc * 32 + 8 * fq;
#pragma unroll
    for (int ai = 0; ai < 2; ++ai)
#pragma unroll
      for (int m = 0; m < 4; ++m) { const int r = ai * 128 + wr * 64 + m * 16 + fr; const float gt = __uint_as_float(tab[u.aux * 512 + 256 + r]);
        f32x4 h0, h1;
#pragma unroll
        for (int j = 0; j < 4; ++j) { const float g0 = acc[ai][0][m][0][j], g1 = acc[ai][0][m][1][j];
          h0[j] = g0 * __builtin_amdgcn_rcpf(1.f + __expf(-g0)) * acc[ai][1][m][0][j] * gt; h1[j] = g1 * __builtin_amdgcn_rcpf(1.f + __expf(-g1)) * acc[ai][1][m][1][j] * gt; }
        u32x4 w; w.x = cvt_pk_bf16(h0[0], h0[1]); w.y = cvt_pk_bf16(h0[2], h0[3]); w.z = cvt_pk_bf16(h1[0], h1[1]); w.w = cvt_pk_bf16(h1[2], h1[3]);
        *(u32x4*)(H + (size_t)(u.pm * 256 + r) * DE + col0) = w; }
  }
};
__device__ void ph_gateup(const Params& p, LAS unsigned char* lds) {
  const int ntot = ld_agent(p.meta + 1);
  const OrderMoE S = moe_order<true>(p, lds, 4, 0, ntot, D * 2);
  pg8::Gemm g{p.h1b, p.WguT, D}; EpiGU E{p.H, S.tab};
  pg8::gemm_phase<true>(lds, g, S, E);
}
struct EpiDown {
  static constexpr bool PERM = true;
  bf16_t* Y; float* out; const bf16_t* h1b; LAS const int* ulist; int srow0;
  __device__ __forceinline__ void operator()(const f32x4 (&acc)[2][2][4][2], const pg8::Unit& u, int wr, int wc, int fr, int fq) const {
    const int col0 = u.pn * 256 + wc * 32 + 8 * fq; const bool shared_e = ulist[u.aux * 4 + 3] == NE;
#pragma unroll
    for (int ai = 0; ai < 2; ++ai)
#pragma unroll
      for (int m = 0; m < 4; ++m) { const int row = u.pm * 256 + ai * 128 + wr * 64 + m * 16 + fr;
#pragma unroll
        for (int bj = 0; bj < 2; ++bj) { const f32x4 v0 = acc[ai][bj][m][0], v1 = acc[ai][bj][m][1];
          if (!shared_e) { u32x4 w; w.x = cvt_pk_bf16(v0[0], v0[1]); w.y = cvt_pk_bf16(v0[2], v0[3]); w.z = cvt_pk_bf16(v1[0], v1[1]); w.w = cvt_pk_bf16(v1[2], v1[3]);
            *(u32x4*)(Y + (size_t)row * D + col0 + bj * 128) = w; }
          else { const size_t o = (size_t)(row - srow0) * D + col0 + bj * 128; const u32x4 hb = *(const u32x4*)(h1b + o); f32x4 a, b;
            a[0] = __uint_as_float(hb.x << 16); a[1] = __uint_as_float(hb.x & 0xffff0000u); a[2] = __uint_as_float(hb.y << 16); a[3] = __uint_as_float(hb.y & 0xffff0000u);
            b[0] = __uint_as_float(hb.z << 16); b[1] = __uint_as_float(hb.z & 0xffff0000u); b[2] = __uint_as_float(hb.w << 16); b[3] = __uint_as_float(hb.w & 0xffff0000u);
            *(f32x4*)(out + o) = a * ALPHA + v0; *(f32x4*)(out + o + 4) = b * ALPHA + v1; } } }
  }
};
__device__ void ph_down(const Params& p, LAS unsigned char* lds) {
  const int nr = ld_agent(p.meta + 0), ntot = ld_agent(p.meta + 1);
  const OrderMoE S = moe_order<false>(p, lds, 8, 0, ntot, 0);
  pg8::Gemm g{p.H, p.WdT, DE}; EpiDown E{p.Y, p.out, p.h1b, S.ulist, nr * 256};
  pg8::gemm_phase<false>(lds, g, S, E);
}
__device__ void ph_combine(const Params& p) {
  const int lane = threadIdx.x & 63, wv = threadIdx.x >> 6;
  for (int row = blockIdx.x * 8 + wv; row < T; row += gridDim.x * 8) {
    float v[32];
    float* op = p.out + (size_t)row * D;
#pragma unroll
    for (int g = 0; g < 4; ++g) { const f32x4 a = *(const f32x4*)(op + g * 512 + lane * 8), b = *(const f32x4*)(op + g * 512 + lane * 8 + 4);
#pragma unroll
      for (int j = 0; j < 4; ++j) { v[g * 8 + j] = a[j]; v[g * 8 + 4 + j] = b[j]; } }
    for (int k = 0; k < 8; ++k) {
      const int yr = ld_agent(p.pos + row * 8 + k); const bf16_t* yp = p.Y + (size_t)yr * D;
#pragma unroll
      for (int g = 0; g < 4; ++g) { const u32x4 hb = *(const u32x4*)(yp + g * 512 + lane * 8);
        v[g * 8 + 0] += __uint_as_float(hb.x << 16); v[g * 8 + 1] += __uint_as_float(hb.x & 0xffff0000u); v[g * 8 + 2] += __uint_as_float(hb.y << 16); v[g * 8 + 3] += __uint_as_float(hb.y & 0xffff0000u);
        v[g * 8 + 4] += __uint_as_float(hb.z << 16); v[g * 8 + 5] += __uint_as_float(hb.z & 0xffff0000u); v[g * 8 + 6] += __uint_as_float(hb.w << 16); v[g * 8 + 7] += __uint_as_float(hb.w & 0xffff0000u); }
    }
    float s = 0.f;
#pragma unroll
    for (int j = 0; j < 32; ++j) s += v[j];
    const float mu = wave_sum(s) * (1.f / D); float q = 0.f;
#pragma unroll
    for (int j = 0; j < 32; ++j) { const float d = v[j] - mu; q += d * d; }
    const float rstd = rsqrtf(wave_sum(q) * (1.f / D) + 1e-5f);
#pragma unroll
    for (int g = 0; g < 4; ++g) { const int c0 = g * 512 + lane * 8; f32x4 a, b;
#pragma unroll
      for (int j = 0; j < 4; ++j) { a[j] = (v[g * 8 + j] - mu) * rstd * p.ln2_g[c0 + j] + p.ln2_b[c0 + j]; b[j] = (v[g * 8 + 4 + j] - mu) * rstd * p.ln2_g[c0 + 4 + j] + p.ln2_b[c0 + 4 + j]; }
      *(f32x4*)(op + c0) = a; *(f32x4*)(op + c0 + 4) = b; }
  }
}

__global__ void __launch_bounds__(NT) k_mega(Params p_arg) {
#if defined(__HIP_DEVICE_COMPILE__)
  extern __shared__ __attribute__((aligned(16))) unsigned char lds_raw[];
  LAS unsigned char* lds = (LAS unsigned char*)lds_raw;
  float* smem = (float*)lds_raw;
  cooperative_groups::grid_group grid = cooperative_groups::this_grid();
#ifndef ONLY
#define ONLY -1
#endif
  typedef const __attribute__((address_space(4))) Params* KP;
  const KP pk = (KP)__builtin_amdgcn_kernarg_segment_ptr();
#define RUN(n, call) do { if (ONLY < 0 || ONLY == n) { KP q_ = pk; asm volatile("" : "+s"(q_)); const Params p = *q_; call; } } while (0)
  RUN(0, ph_convert(p)); grid.sync();
  RUN(1, ph_inproj(p, lds)); grid.sync();
  RUN(3, ph_ssd_a(p, (char*)lds_raw, (char*)p.out)); RUN(4, ph_attn_mfma(p, (char*)lds_raw)); grid.sync();
  RUN(5, ph_ssd_b(p, (char*)lds_raw, (const char*)p.out)); grid.sync();
  RUN(6, ph_outproj(p, lds)); grid.sync();
  RUN(7, ph_ln1(p)); grid.sync();
  RUN(8, ph_router(p, smem)); grid.sync();
  RUN(9, ph_route(p, lds)); grid.sync();
  RUN(10, ph_place(p, lds)); grid.sync();
  RUN(11, ph_gateup(p, lds)); grid.sync();
  RUN(12, ph_down(p, lds)); grid.sync();
  RUN(13, ph_combine(p));
#endif
}
}

extern "C" void kernel_launch(void* const* d_in, const int* in_sizes, int n_in, void* d_out, int out_size, void* d_ws, size_t ws_size, hipStream_t stream) {
  Params p{};
  const float* const* in = (const float* const*)d_in;
  p.x = in[0]; p.w_in = in[1]; p.conv_w = in[2]; p.conv_b = in[3]; p.dt_bias_f = in[4]; p.dt_bias_b = in[5]; p.a_log_f = in[6]; p.a_log_b = in[7];
  p.d_skip = in[8]; p.ssd_norm_w = in[9]; p.lq1 = in[10]; p.lk1 = in[11]; p.lq2 = in[12]; p.lk2 = in[13]; p.attn_norm_w = in[14]; p.w_out = in[15];
  p.ln1_g = in[16]; p.ln1_b = in[17]; p.w_router = in[18]; p.router_bias = in[19]; p.wg_e = in[20]; p.wu_e = in[21]; p.wd_e = in[22];
  p.wg_s = in[23]; p.wu_s = in[24]; p.wd_s = in[25]; p.ln2_g = in[26]; p.ln2_b = in[27];
  p.out = (float*)d_out;
  char* w = (char*)d_ws; size_t o = 0;
  auto take = [&](size_t bytes) { char* r = w + o; o += (bytes + 255) / 256 * 256; return r; };
  char* reg1 = w + o;
  p.xb = (bf16_t*)take((size_t)T * D * 2); p.WinT = (bf16_t*)take((size_t)NPROJ * D * 2); p.WoutT = (bf16_t*)take((size_t)D * D * 2);
  p.WguT = (bf16_t*)take((size_t)(NE + 1) * 1024 * D * 2); p.proj = (bf16_t*)take((size_t)T * PLD * 2); p.u = (bf16_t*)take((size_t)T * D * 2);
  const size_t reg1_bytes = (size_t)((w + o) - reg1);
  p.Y = (bf16_t*)reg1;
  if ((size_t)MAXROWS_R * D * 2 > reg1_bytes) { fprintf(stderr, "kernel_launch: region 1 too small for Y\n"); return; }
  char* reg2 = take((size_t)MAXROWS * DE * 2);
  p.H = (bf16_t*)reg2; p.yf = (float*)reg2; p.yb = (float*)(reg2 + (size_t)T * DSSD * 4);
  p.h1b = (bf16_t*)take((size_t)T * D * 2); p.WdT = (bf16_t*)take((size_t)(NE + 1) * D * DE * 2);
  p.dt = (float*)take((size_t)T * 32 * 4); p.logits = (float*)take((size_t)T * NE * 4); p.gate = (float*)take((size_t)T * 8 * 4);
  p.assign = (int*)take((size_t)T * 8 * 4); p.pos = (int*)take((size_t)T * 8 * 4); p.blkcnt = (int*)take((size_t)(T / 64) * NE * 4);
  p.row_tok = (int*)take((size_t)MAXROWS * 4); p.row_gate = (float*)take((size_t)MAXROWS * 4); p.tile_exp = (int*)take((size_t)MAXTILES * 4); p.meta = (int*)take(256);
  p.xc = (float*)d_out; p.h1 = (float*)d_out;
  if ((size_t)T * CC * 4 > (size_t)T * D * 4) return;
  if (o > ws_size) { fprintf(stderr, "kernel_launch: ws too small: need %zu have %zu\n", o, ws_size); return; }
  static int grid_blocks = 0;
  if (!grid_blocks) {
    int dev = 0, cus = 0, per_cu = 0;
    hipGetDevice(&dev);
    hipDeviceGetAttribute(&cus, hipDeviceAttributeMultiprocessorCount, dev);
    if (hipFuncSetAttribute((const void*)k_mega, hipFuncAttributeMaxDynamicSharedMemorySize, LDS_BYTES) != hipSuccess) { fprintf(stderr, "kernel_launch: hipFuncSetAttribute failed\n"); return; }
    hipOccupancyMaxActiveBlocksPerMultiprocessor(&per_cu, k_mega, NT, LDS_BYTES);
    if (per_cu < 1) { fprintf(stderr, "kernel_launch: occupancy query says 0 blocks/CU\n"); return; }
    grid_blocks = cus;
  }
  void* args[] = {&p};
  hipError_t e = hipLaunchCooperativeKernel((void*)k_mega, dim3(grid_blocks), dim3(NT), args, LDS_BYTES, stream);
  if (e != hipSuccess) fprintf(stderr, "cooperative launch failed: %s (grid %d)\n", hipGetErrorString(e), grid_blocks);
}
```

```cpp
#include <hip/hip_runtime.h>
#include <hip/hip_cooperative_groups.h>
#include <cstdio>
#include <cstdint>

namespace {
constexpr int D = 2048, NB = 8, S = 2048, T = NB * S;
constexpr int DSSD = 1024, DATT = 1024, NH = 16, HD = 64, NS = 128, CC = 1536;
constexpr int AH = 8, NE = 64, DE = 512, PW = 5664;
constexpr int O_DT = 2560, O_Q = 2592;
constexpr int N_Z = 0, N_XBC = 1024, N_Q = 2560, N_K = 3584, N_V = 4608, PLD = 5632, NPROJ = 5888;
constexpr float ALPHA = 1.189207115002721f;
constexpr float LAMBDA_INIT = 0.2f;
constexpr float LOG2E = 1.4426950408889634f;
constexpr float QS = 0.125f * LOG2E;
constexpr int NT = 512;
constexpr int LDS_BYTES = 152 * 1024;
constexpr int LDS_TAB = 128 * 1024;
constexpr int MAXROWS_R = NE * 256 + T * 8;
constexpr int MAXROWS = MAXROWS_R + T;
constexpr int MAXTILES = MAXROWS / 256;

typedef unsigned short bf16_t;

struct Params {
  const float *x, *w_in, *conv_w, *conv_b, *dt_bias_f, *dt_bias_b, *a_log_f, *a_log_b, *d_skip, *ssd_norm_w;
  const float *lq1, *lk1, *lq2, *lk2, *attn_norm_w, *w_out, *ln1_g, *ln1_b, *w_router, *router_bias;
  const float *wg_e, *wu_e, *wd_e, *wg_s, *wu_s, *wd_s, *ln2_g, *ln2_b;
  float* out;
  bf16_t *xb, *WinT, *WoutT, *WguT, *WdT, *proj, *u, *h1b, *H, *Y, *xc16;
  float *xc, *dt, *yf, *yb, *h1, *logits, *gate, *row_gate;
  int *assign, *blkcnt, *row_tok, *pos, *tile_exp, *meta;
};

__device__ __forceinline__ float silu_f(float x) { return x / (1.f + __expf(-x)); }
__device__ __forceinline__ float softplus_f(float x) { return x > 20.f ? x : log1pf(__expf(x)); }
__device__ __forceinline__ float wave_sum(float v) { for (int o = 32; o >= 1; o >>= 1) v += __shfl_xor(v, o); return v; }
__device__ __forceinline__ float bf2f(bf16_t b) { return __uint_as_float(((unsigned)b) << 16); }
__device__ __forceinline__ bf16_t f2bf(float f) { unsigned u = __float_as_uint(f); u += 0x7FFFu + ((u >> 16) & 1u); return (bf16_t)(u >> 16); }
}

namespace pg8 {
#define PG8_LAS __attribute__((address_space(3)))
typedef unsigned short bf16_t;
typedef short bf16x8 __attribute__((ext_vector_type(8)));
typedef float f32x4 __attribute__((ext_vector_type(4)));
typedef unsigned u32x4 __attribute__((ext_vector_type(4)));
constexpr int BM = 256, BK = 64, HALF = 128, HTB = HALF * BK * 2  , STAGE_BYTES = 8 * HTB, NXCD = 8, WGM = 8;

__host__ __device__ __forceinline__ int lds_byte(int r, int c) { const int st = (r >> 4) * 2 + (c >> 5), rr = r & 15, cc = c & 31, ob = rr * 64 + cc * 2; return st * 1024 + (ob ^ (((ob >> 9) & 1) << 5)); }
__host__ __device__ __forceinline__ void stage_rc(int b, int& R, int& C) { const int st = b / 1024, sb = b % 1024, swz = sb ^ (((sb >> 9) & 1) << 5); R = (st >> 1) * 16 + swz / 64; C = (st & 1) * 32 + (swz % 64) / 2; }
__host__ __device__ __forceinline__ int perm32(int rho) { const int n = rho >> 4, i = rho & 15; return 8 * (i >> 2) + 4 * n + (i & 3); }

struct Unit { int pm, pn, bn, aux; };
struct Gemm { const bf16_t* A; const bf16_t* Bt; int K; };


__device__ __forceinline__ unsigned cvt_pk_bf16(float lo, float hi) { unsigned r; asm volatile("v_cvt_pk_bf16_f32 %0, %1, %2" : "=v"(r) : "v"(lo), "v"(hi)); return r; }
struct OrderStatic {
    int nM, nN, nwg, G, c;
    __device__ void init(int M, int N, int G_, int c_) { nM = M / BM; nN = N / BM; nwg = nM * nN; G = G_; c = c_; }
    __device__ bool next(int i, Unit& u) const {
        const long L = (long)i * G + c; if (L >= nwg) return false;
        int wgid = (int)L; { const int q = nwg / NXCD, r = nwg % NXCD, xcd = wgid % NXCD, off = wgid / NXCD; wgid = (xcd < r ? xcd * (q + 1) : r * (q + 1) + (xcd - r) * q) + off; }
        const int nig = WGM * nN, gid = wgid / nig, fm = gid * WGM, gsz = (nM - fm) < WGM ? (nM - fm) : WGM;
        u.pm = fm + ((wgid % nig) % gsz); u.pn = (wgid % nig) / gsz; u.bn = u.pn; u.aux = i; return true;
    }
    __device__ __forceinline__ unsigned row_off(int, int) const { return 0u; }
};
template <bool GATHER, class Epi, class Sched>
__device__ __forceinline__ void gemm_phase(PG8_LAS unsigned char* lds, const Gemm g, const Sched& S, const Epi& E) {
    int tid = threadIdx.x; asm volatile("" : "+v"(tid));
    const int wid = __builtin_amdgcn_readfirstlane(tid >> 6), lane = tid & 63, wr = wid >> 2, wc = wid & 3, fr = lane & 15, fq = lane >> 4;
    const int K = g.K, nt = K / BK;
#define PG8_STAMP() do {} while (0)
    PG8_STAMP();
    unsigned voffA[2], voffB[2];
#pragma unroll
    for (int i = 0; i < 2; ++i) { int R, C; stage_rc(tid * 16 + i * 8192, R, C); const int Rb = Epi::PERM ? ((R & ~31) + perm32(R & 31)) : R;
        voffA[i] = (unsigned)(R * K + C) * 2u; voffB[i] = (unsigned)(Rb * K + C) * 2u; }
    unsigned voffG[2][2] = {{0u, 0u}, {0u, 0u}};
#define PG8_LOADG(uidx) do { if constexpr (GATHER) { _Pragma("unroll") for (int _h = 0; _h < 2; ++_h) _Pragma("unroll") for (int _i = 0; _i < 2; ++_i) { int R_, C_; stage_rc(tid * 16 + _i * 8192, R_, C_); \
        voffG[_h][_i] = S.row_off((uidx), _h * HALF + R_) + (unsigned)C_ * 2u; } } } while (0)
    const size_t kstep = (size_t)(BK * 2);
    const size_t hstep = (size_t)HALF * K * 2;
    const size_t tstep = 2 * hstep;
    const unsigned ldsw = (unsigned)wid * 1024u;
    const int aoff = lds_byte(wr * 64 + fr, fq * 8), boff = lds_byte(wc * 32 + fr, fq * 8);
#define PG8_SA(b, h) (((b) * 2 + (h)) * HTB)
#define PG8_SB(b, h) ((4 + (b) * 2 + (h)) * HTB)
#define PG8_STAGE(bufoff, gbase, voff) do { _Pragma("unroll") for (int _i = 0; _i < 2; ++_i) \
        __builtin_amdgcn_global_load_lds((const unsigned*)((const char*)(gbase) + (voff)[_i]), (PG8_LAS unsigned*)(lds + (bufoff) + ldsw + _i * 8192), 16, 0, 0); } while (0)
#define PG8_STAGE_A(bufoff, ptr, h) do { if constexpr (GATHER) { PG8_STAGE(bufoff, ptr, voffG[h]); } else { PG8_STAGE(bufoff, (ptr) + (h) * hstep, voffA); } } while (0)
#define PG8_LDA(dst, b, h) do { _Pragma("unroll") for (int m = 0; m < 4; ++m) _Pragma("unroll") for (int k = 0; k < 2; ++k) dst[m][k] = *(const PG8_LAS bf16x8*)(lds + PG8_SA(b, h) + aoff + m * 2048 + k * 1024); } while (0)
#define PG8_LDB(dst, b, h) do { _Pragma("unroll") for (int n = 0; n < 2; ++n) _Pragma("unroll") for (int k = 0; k < 2; ++k) dst[n][k] = *(const PG8_LAS bf16x8*)(lds + PG8_SB(b, h) + boff + n * 2048 + k * 1024); } while (0)
#define PG8_MMA(ai, bj, At, Bt) do { __builtin_amdgcn_s_setprio(1); _Pragma("unroll") for (int m = 0; m < 4; ++m) _Pragma("unroll") for (int n = 0; n < 2; ++n) _Pragma("unroll") for (int k = 0; k < 2; ++k) \
        acc[ai][bj][m][n] = __builtin_amdgcn_mfma_f32_16x16x32_bf16(Bt[n][k], At[m][k], acc[ai][bj][m][n], 0, 0, 0); __builtin_amdgcn_s_setprio(0); } while (0)
#define PG8_WAIT_V(n) asm volatile("s_waitcnt vmcnt(" #n ")" ::: "memory")
#define PG8_WAIT_L(n) asm volatile("s_waitcnt lgkmcnt(" #n ")" ::: "memory")
#define PG8_BAR __builtin_amdgcn_s_barrier()
#define PG8_SCHED __builtin_amdgcn_sched_barrier(0)
    Unit cur, nxt; int ui = 0;
    if (!S.next(0, cur)) return;
    f32x4 acc[2][2][4][2];
#pragma unroll
    for (int a = 0; a < 2; ++a)
#pragma unroll
        for (int b = 0; b < 2; ++b)
#pragma unroll
            for (int m = 0; m < 4; ++m)
#pragma unroll
                for (int n = 0; n < 2; ++n) acc[a][b][m][n] = (f32x4){0.f, 0.f, 0.f, 0.f};
    bf16x8 At[4][2], B0[2][2], B1[2][2];
    const char* cA = GATHER ? (const char*)g.A : (const char*)g.A + (size_t)cur.pm * tstep; const char* cB = (const char*)g.Bt + (size_t)cur.bn * tstep;
    PG8_LOADG(0);
    PG8_STAGE(PG8_SB(0, 0), cB, voffB); PG8_STAGE_A(PG8_SA(0, 0), cA, 0); PG8_STAGE(PG8_SB(0, 1), cB + hstep, voffB); PG8_STAGE_A(PG8_SA(0, 1), cA, 1);
    if (wr == 1) PG8_BAR;
    PG8_WAIT_V(4); PG8_BAR;
    PG8_STAGE(PG8_SB(1, 0), cB + kstep, voffB); PG8_STAGE_A(PG8_SA(1, 0), cA + kstep, 0); PG8_STAGE(PG8_SB(1, 1), cB + hstep + kstep, voffB);
    PG8_WAIT_V(6); PG8_BAR;
    PG8_STAMP();
    for (;;) {
        const bool has_next = S.next(ui + 1, nxt);
        const char* nA = has_next ? (GATHER ? (const char*)g.A : (const char*)g.A + (size_t)nxt.pm * tstep) : cA; const char* nB = has_next ? (const char*)g.Bt + (size_t)nxt.bn * tstep : cB;
        for (int t = 0; t < nt; t += 2) {
            const bool last = (t == nt - 2);
            const char* a1 = cA + (size_t)(t + 1) * kstep;
            const char* a2 = last ? nA : cA + (size_t)(t + 2) * kstep; const char* b2 = last ? nB : cB + (size_t)(t + 2) * kstep;
            const char* a3 = a2 + kstep; const char* b3 = b2 + kstep;
            PG8_LDB(B0, 0, 0); PG8_SCHED; PG8_LDA(At, 0, 0); PG8_STAGE_A(PG8_SA(1, 1), a1, 1);
            PG8_WAIT_L(8); PG8_BAR; PG8_WAIT_L(0); PG8_MMA(0, 0, At, B0); PG8_BAR; PG8_SCHED;
            if (last && has_next) PG8_LOADG(ui + 1);
            PG8_LDB(B1, 0, 1); PG8_STAGE(PG8_SB(0, 0), b2, voffB);
            PG8_BAR; PG8_WAIT_L(0); PG8_MMA(0, 1, At, B1); PG8_BAR;
            PG8_LDA(At, 0, 1); PG8_STAGE_A(PG8_SA(0, 0), a2, 0);
            PG8_BAR; PG8_WAIT_L(0); PG8_MMA(1, 0, At, B0); PG8_BAR; PG8_SCHED;
            PG8_STAGE(PG8_SB(0, 1), b2 + hstep, voffB);
            PG8_WAIT_V(6); PG8_BAR; PG8_MMA(1, 1, At, B1); PG8_BAR;
            PG8_LDB(B0, 1, 0); PG8_SCHED; PG8_LDA(At, 1, 0); PG8_STAGE_A(PG8_SA(0, 1), a2, 1);
            PG8_WAIT_L(8); PG8_BAR; PG8_WAIT_L(0); PG8_MMA(0, 0, At, B0); PG8_BAR; PG8_SCHED;
            PG8_LDB(B1, 1, 1); PG8_STAGE(PG8_SB(1, 0), b3, voffB);
            PG8_BAR; PG8_WAIT_L(0); PG8_MMA(0, 1, At, B1); PG8_BAR;
            PG8_LDA(At, 1, 1); PG8_STAGE_A(PG8_SA(1, 0), a3, 0);
            PG8_BAR; PG8_WAIT_L(0); PG8_MMA(1, 0, At, B0); PG8_BAR; PG8_SCHED;
            PG8_STAGE(PG8_SB(1, 1), b3 + hstep, voffB);
            PG8_WAIT_V(6); PG8_BAR; PG8_MMA(1, 1, At, B1); PG8_BAR;
        }
        PG8_STAMP();
        E(acc, cur, wr, wc, fr, fq);
        PG8_STAMP();
        if (!has_next) break;
#pragma unroll
        for (int a = 0; a < 2; ++a)
#pragma unroll
            for (int b = 0; b < 2; ++b)
#pragma unroll
                for (int m = 0; m < 4; ++m)
#pragma unroll
                    for (int n = 0; n < 2; ++n) acc[a][b][m][n] = (f32x4){0.f, 0.f, 0.f, 0.f};
        cur = nxt; cA = nA; cB = nB; ++ui;
    }
    PG8_WAIT_V(0);
    if (wr == 0) PG8_BAR;
    PG8_BAR;
    PG8_STAMP();
#undef PG8_STAMP
#undef PG8_SA
#undef PG8_SB
#undef PG8_STAGE
#undef PG8_STAGE_A
#undef PG8_LOADG
#undef PG8_LDA
#undef PG8_LDB
#undef PG8_MMA
#undef PG8_WAIT_V
#undef PG8_WAIT_L
#undef PG8_BAR
#undef PG8_SCHED
}
}
namespace {
using pg8::f32x4; using pg8::u32x4; using pg8::cvt_pk_bf16;
#define LAS __attribute__((address_space(3)))

template <class ARow, class Epi>
__device__ __forceinline__ void gemm_tile(float* smem, int mvalid, int nvalid, int K, ARow arow, const float* Bp, int ldb, Epi epi) {
  float* As = smem;
  float* Bs = smem + 16 * 68;
  const int tid = threadIdx.x, ty = tid >> 5, tx = tid & 31;
  float acc[4][4];
#pragma unroll
  for (int i = 0; i < 4; ++i)
#pragma unroll
    for (int j = 0; j < 4; ++j) acc[i][j] = 0.f;
  const int ak = tid & 15, ar = tid >> 4;
  const float* ap0 = (ar < mvalid) ? arow(ar) : nullptr;
  const float* ap1 = (ar + 32 < mvalid) ? arow(ar + 32) : nullptr;
  const int bn = tid & 127, bk = tid >> 7;
  for (int k0 = 0; k0 < K; k0 += 16) {
    As[ak * 68 + ar] = ap0 ? ap0[k0 + ak] : 0.f;
    As[ak * 68 + ar + 32] = ap1 ? ap1[k0 + ak] : 0.f;
#pragma unroll
    for (int i = 0; i < 4; ++i) { const int kk = bk + 4 * i; Bs[kk * 128 + bn] = (bn < nvalid) ? Bp[(size_t)(k0 + kk) * ldb + bn] : 0.f; }
    __syncthreads();
#pragma unroll
    for (int kk = 0; kk < 16; ++kk) {
      float a[4], b[4];
#pragma unroll
      for (int i = 0; i < 4; ++i) a[i] = As[kk * 68 + ty * 4 + i];
#pragma unroll
      for (int j = 0; j < 4; ++j) b[j] = Bs[kk * 128 + tx * 4 + j];
#pragma unroll
      for (int i = 0; i < 4; ++i)
#pragma unroll
        for (int j = 0; j < 4; ++j) acc[i][j] += a[i] * b[j];
    }
    __syncthreads();
  }
#pragma unroll
  for (int i = 0; i < 4; ++i)
#pragma unroll
    for (int j = 0; j < 4; ++j) { const int r = ty * 4 + i, c = tx * 4 + j; if (r < mvalid && c < nvalid) epi(r, c, acc[i][j]); }
}

template <class RowMap>
__device__ __forceinline__ void cvt_tile(const float* __restrict__ src, int N, int K, int k0, int n0, bf16_t* __restrict__ dst, RowMap rm) {
  const int lane = threadIdx.x & 63, w = threadIdx.x >> 6;
  const int n = n0 + (lane & 15) * 4, kk = k0 + (w * 4 + (lane >> 4)) * 8;
  if (n >= N) return;
  float4 v[8];
#pragma unroll
  for (int j = 0; j < 8; ++j) v[j] = *(const float4*)(src + (size_t)(kk + j) * N + n);
  u32x4 o;
  o.x = cvt_pk_bf16(v[0].x, v[1].x); o.y = cvt_pk_bf16(v[2].x, v[3].x); o.z = cvt_pk_bf16(v[4].x, v[5].x); o.w = cvt_pk_bf16(v[6].x, v[7].x);
  *(u32x4*)(dst + (size_t)rm(n + 0) * K + kk) = o;
  o.x = cvt_pk_bf16(v[0].y, v[1].y); o.y = cvt_pk_bf16(v[2].y, v[3].y); o.z = cvt_pk_bf16(v[4].y, v[5].y); o.w = cvt_pk_bf16(v[6].y, v[7].y);
  *(u32x4*)(dst + (size_t)rm(n + 1) * K + kk) = o;
  o.x = cvt_pk_bf16(v[0].z, v[1].z); o.y = cvt_pk_bf16(v[2].z, v[3].z); o.z = cvt_pk_bf16(v[4].z, v[5].z); o.w = cvt_pk_bf16(v[6].z, v[7].z);
  *(u32x4*)(dst + (size_t)rm(n + 2) * K + kk) = o;
  o.x = cvt_pk_bf16(v[0].w, v[1].w); o.y = cvt_pk_bf16(v[2].w, v[3].w); o.z = cvt_pk_bf16(v[4].w, v[5].w); o.w = cvt_pk_bf16(v[6].w, v[7].w);
  *(u32x4*)(dst + (size_t)rm(n + 3) * K + kk) = o;
}
template <class RowMap>
__device__ void cvt_job(const float* src, int nmat, int K, int N, bf16_t* dst, size_t dstride, RowMap rm) {
  const int kt = K / 256, ntl = (N + 63) / 64, per = kt * ntl;
  for (int it = blockIdx.x; it < nmat * per; it += gridDim.x) {
    const int m = it / per, r = it % per, k0 = (r / ntl) * 256, n0 = (r % ntl) * 64;
    cvt_tile(src + (size_t)m * K * N, N, K, k0, n0, dst + (size_t)m * dstride, rm);
  }
}
__device__ void ph_convert(const Params& p) {
  const size_t gtid = (size_t)blockIdx.x * NT + threadIdx.x, gsz = (size_t)gridDim.x * NT;
  if (gtid < 64) p.meta[gtid] = 0;
  for (size_t i = gtid; i < (size_t)T * D / 8; i += gsz) {
    const float4 a = *(const float4*)(p.x + i * 8), b = *(const float4*)(p.x + i * 8 + 4);
    u32x4 o; o.x = cvt_pk_bf16(a.x, a.y); o.y = cvt_pk_bf16(a.z, a.w); o.z = cvt_pk_bf16(b.x, b.y); o.w = cvt_pk_bf16(b.z, b.w);
    *(u32x4*)(p.xb + i * 8) = o;
  }
  cvt_job(p.w_in, 1, D, PW, p.WinT, 0, [](int n) { return n < O_DT ? n : (n < O_Q ? PLD + (n - O_DT) : n - 32); });
  for (size_t i = gtid; i < (size_t)(NPROJ - PW) * D / 8; i += gsz) *(u32x4*)(p.WinT + (size_t)PW * D + i * 8) = (u32x4){0u, 0u, 0u, 0u};
  cvt_job(p.w_out, 1, D, D, p.WoutT, 0, [](int n) { return n; });
  cvt_job(p.wg_e, NE, D, DE, p.WguT, (size_t)1024 * D, [](int n) { return (n >> 7) * 256 + (n & 127); });
  cvt_job(p.wu_e, NE, D, DE, p.WguT, (size_t)1024 * D, [](int n) { return (n >> 7) * 256 + 128 + (n & 127); });
  cvt_job(p.wg_s, 1, D, DE, p.WguT + (size_t)NE * 1024 * D, 0, [](int n) { return (n >> 7) * 256 + (n & 127); });
  cvt_job(p.wu_s, 1, D, DE, p.WguT + (size_t)NE * 1024 * D, 0, [](int n) { return (n >> 7) * 256 + 128 + (n & 127); });
  cvt_job(p.wd_e, NE, DE, D, p.WdT, (size_t)D * DE, [](int n) { return n; });
  cvt_job(p.wd_s, 1, DE, D, p.WdT + (size_t)NE * D * DE, 0, [](int n) { return n; });
}

struct EpiProj {
  static constexpr bool PERM = true;
  bf16_t* proj; float* dt; const float* bias_f; const float* bias_b;
  __device__ __forceinline__ void operator()(const f32x4 (&acc)[2][2][4][2], const pg8::Unit& u, int wr, int wc, int fr, int fq) const {
    const int row0 = u.pm * 256 + wr * 64 + fr;
    if (u.pn < 22) {
      const int col0 = u.pn * 256 + wc * 32 + 8 * fq;
      const float sc = (u.pn >= 10 && u.pn < 14) ? QS : 1.0f;
#pragma unroll
      for (int ai = 0; ai < 2; ++ai)
#pragma unroll
        for (int m = 0; m < 4; ++m) { bf16_t* rowp = proj + (size_t)(row0 + ai * 128 + m * 16) * PLD + col0;
#pragma unroll
          for (int bj = 0; bj < 2; ++bj) { const f32x4 v0 = acc[ai][bj][m][0] * sc, v1 = acc[ai][bj][m][1] * sc;
            u32x4 w; w.x = cvt_pk_bf16(v0[0], v0[1]); w.y = cvt_pk_bf16(v0[2], v0[3]); w.z = cvt_pk_bf16(v1[0], v1[1]); w.w = cvt_pk_bf16(v1[2], v1[3]);
            *(u32x4*)(rowp + bj * 128) = w; } }
    } else if (wc == 0) {
      const int c0 = 8 * fq;
      float bs[8];
#pragma unroll
      for (int j = 0; j < 8; ++j) bs[j] = (c0 + j) < 16 ? bias_f[c0 + j] : bias_b[c0 + j - 16];
#pragma unroll
      for (int ai = 0; ai < 2; ++ai)
#pragma unroll
        for (int m = 0; m < 4; ++m) { float* rowp = dt + (size_t)(row0 + ai * 128 + m * 16) * 32 + c0;
          const f32x4 v0 = acc[ai][0][m][0], v1 = acc[ai][0][m][1];
          f32x4 o0, o1;
#pragma unroll
          for (int j = 0; j < 4; ++j) { o0[j] = softplus_f(v0[j] + bs[j]); o1[j] = softplus_f(v1[j] + bs[4 + j]); }
          *(f32x4*)rowp = o0; *(f32x4*)(rowp + 4) = o1; }
    }
  }
};
struct EpiOut {
  static constexpr bool PERM = false;
  const float* x; float* v;
  __device__ __forceinline__ void operator()(const f32x4 (&acc)[2][2][4][2], const pg8::Unit& u, int wr, int wc, int fr, int fq) const {
    const int row0 = u.pm * 256 + wr * 64 + fr, col0 = u.pn * 256 + wc * 32 + 4 * fq;
#pragma unroll
    for (int ai = 0; ai < 2; ++ai)
#pragma unroll
      for (int m = 0; m < 4; ++m) { const size_t off = (size_t)(row0 + ai * 128 + m * 16) * D + col0;
#pragma unroll
        for (int bj = 0; bj < 2; ++bj)
#pragma unroll
          for (int n = 0; n < 2; ++n) { const f32x4 xv = *(const f32x4*)(x + off + bj * 128 + n * 16); *(f32x4*)(v + off + bj * 128 + n * 16) = xv * ALPHA + acc[ai][bj][m][n]; } }
  }
};

namespace at {
using bf16x8 = __attribute__((ext_vector_type(8))) short;
using s16x4  = __attribute__((ext_vector_type(4))) short;
using f32x16 = __attribute__((ext_vector_type(16))) float;
using u32x4  = __attribute__((ext_vector_type(4))) unsigned;
constexpr int KVBLK = 64;
constexpr size_t SHM_V = KVBLK * 128 * 2, SHM_K = KVBLK * 128 * 2;
constexpr float THR2 = 8.0f;
#define AT_KSWZ(row, colB) ((row) * 256 + ((colB) ^ (((row) & 7) << 4)))
#define AT_SBAR() __builtin_amdgcn_sched_barrier(0)
__device__ __forceinline__ int crow(int r, int hi) { return (r & 3) + 8 * (r >> 2) + 4 * hi; }
__device__ __forceinline__ unsigned cvtpk(float lo, float hi) { unsigned r; asm volatile("v_cvt_pk_bf16_f32 %0, %1, %2" : "=v"(r) : "v"(lo), "v"(hi)); return r; }

__device__ __forceinline__ void partialSM(f32x16& p0, f32x16& p1, float dqh, float nsl2, float& m_reg, float& mn, float& alpha) {
#pragma unroll
  for (int r = 0; r < 16; ++r) { const float c = (float)((r & 3) + 8 * (r >> 2));
    p0[r] = fmaf(nsl2, fabsf(dqh - c), p0[r]); p1[r] = fmaf(nsl2, fabsf(dqh - (c + 32.f)), p1[r]); }
  float pmax = p0[0];
#pragma unroll
  for (int r = 1; r < 16; ++r) pmax = fmaxf(pmax, p0[r]);
#pragma unroll
  for (int r = 0; r < 16; ++r) pmax = fmaxf(pmax, p1[r]);
  { auto rr = __builtin_amdgcn_permlane32_swap(__float_as_uint(pmax), __float_as_uint(pmax), false, false);
    pmax = fmaxf(__uint_as_float(rr[0]), __uint_as_float(rr[1])); }
  if (__builtin_expect(__all(pmax - m_reg <= THR2), 1)) { mn = m_reg; alpha = 1.f; }
  else { mn = fmaxf(m_reg, pmax); alpha = __builtin_amdgcn_exp2f(m_reg - mn); m_reg = mn; }
#pragma unroll
  for (int r = 0; r < 16; ++r) p0[r] = p0[r] - mn;
#pragma unroll
  for (int r = 0; r < 16; ++r) p1[r] = p1[r] - mn;
#pragma unroll
  for (int r = 0; r < 16; ++r) p0[r] = __builtin_amdgcn_exp2f(p0[r]);
}
__device__ __forceinline__ void finishSM(f32x16& p0, f32x16& p1, float alpha, float& l_reg, bf16x8& pa0, bf16x8& pa1, bf16x8& pa2, bf16x8& pa3) {
#pragma unroll
  for (int r = 0; r < 16; ++r) p1[r] = __builtin_amdgcn_exp2f(p1[r]);
  float ps = 0;
#pragma unroll
  for (int r = 0; r < 16; ++r) ps += p0[r];
#pragma unroll
  for (int r = 0; r < 16; ++r) ps += p1[r];
  { auto rr = __builtin_amdgcn_permlane32_swap(__float_as_uint(ps), __float_as_uint(ps), false, false);
    ps = __uint_as_float(rr[0]) + __uint_as_float(rr[1]); }
  l_reg = l_reg * alpha + ps;
#define AT_PK4(P, BASE, OUT) do { unsigned a0 = cvtpk(P[BASE + 0], P[BASE + 1]), a1 = cvtpk(P[BASE + 2], P[BASE + 3]);   \
    unsigned b0 = cvtpk(P[BASE + 4], P[BASE + 5]), b1 = cvtpk(P[BASE + 6], P[BASE + 7]);                              \
    auto r0 = __builtin_amdgcn_permlane32_swap(a0, b0, false, false); auto r1 = __builtin_amdgcn_permlane32_swap(a1, b1, false, false); \
    u32x4 w = {r0[0], r1[0], r0[1], r1[1]}; OUT = *reinterpret_cast<bf16x8*>(&w); } while (0)
  AT_PK4(p0, 0, pa0); AT_PK4(p0, 8, pa1); AT_PK4(p1, 0, pa2); AT_PK4(p1, 8, pa3);
#undef AT_PK4
}
__device__ __forceinline__ void qkt(f32x16& p0, f32x16& p1, const char* Ks, const bf16x8* qr, int r32, int hi, int cm) {
  p0 = f32x16{}; p1 = f32x16{};
#pragma unroll
  for (int d0 = 0; d0 < 4; ++d0) { const int cb = (cm + d0 * 16 + hi * 8) * 2;
    bf16x8 b0 = *reinterpret_cast<const bf16x8*>(Ks + AT_KSWZ(r32, cb));
    bf16x8 b1 = *reinterpret_cast<const bf16x8*>(Ks + AT_KSWZ(32 + r32, cb));
    p0 = __builtin_amdgcn_mfma_f32_32x32x16_bf16(b0, qr[d0], p0, 0, 0, 0);
    p1 = __builtin_amdgcn_mfma_f32_32x32x16_bf16(b1, qr[d0], p1, 0, 0, 0); }
}
__device__ __forceinline__ int v_st(int k, int c) { const int kk = (k & ~0xC) | ((k & 4) << 1) | ((k & 8) >> 1); return ((kk >> 3) * 4 + (c >> 5)) * 512 + ((kk & 7) * 32 + (c & 31)) * 2; }
__device__ __forceinline__ int v_rd_base(int lane) { return ((lane & 3) << 3) | (((lane >> 2) & 3) << 6) | (((lane >> 4) & 1) << 5) | (((lane >> 5) & 1) << 8); }
constexpr int v_rd_off(int d0, int ks, int half) { return d0 * 512 + ks * 4096 + half * 2048; }
template <int OFF> __device__ __forceinline__ s16x4 tr_read(int vb) {
  s16x4 r; asm volatile("ds_read_b64_tr_b16 %0, %1 offset:%2" : "=&v"(r) : "v"(vb), "i"(OFF) : "memory"); return r;
}
template <int D0> __device__ __forceinline__ void pv_one(f32x16& od, int vb, bf16x8 pa0, bf16x8 pa1, bf16x8 pa2, bf16x8 pa3) {
  const s16x4 l0 = tr_read<v_rd_off(D0, 0, 0)>(vb), h0 = tr_read<v_rd_off(D0, 0, 1)>(vb), l1 = tr_read<v_rd_off(D0, 1, 0)>(vb), h1 = tr_read<v_rd_off(D0, 1, 1)>(vb);
  const s16x4 l2 = tr_read<v_rd_off(D0, 2, 0)>(vb), h2 = tr_read<v_rd_off(D0, 2, 1)>(vb), l3 = tr_read<v_rd_off(D0, 3, 0)>(vb), h3 = tr_read<v_rd_off(D0, 3, 1)>(vb);
  asm volatile("s_waitcnt lgkmcnt(0)" ::: "memory"); AT_SBAR();
#define AT_PK(L, H) (bf16x8){L[0], L[1], L[2], L[3], H[0], H[1], H[2], H[3]}
  od = __builtin_amdgcn_mfma_f32_32x32x16_bf16(pa0, AT_PK(l0, h0), od, 0, 0, 0);
  od = __builtin_amdgcn_mfma_f32_32x32x16_bf16(pa1, AT_PK(l1, h1), od, 0, 0, 0);
  od = __builtin_amdgcn_mfma_f32_32x32x16_bf16(pa2, AT_PK(l2, h2), od, 0, 0, 0);
  od = __builtin_amdgcn_mfma_f32_32x32x16_bf16(pa3, AT_PK(l3, h3), od, 0, 0, 0);
#undef AT_PK
}
__device__ __forceinline__ void pv_d0(f32x16* o, int vb, bf16x8 pa0, bf16x8 pa1, bf16x8 pa2, bf16x8 pa3) {
  pv_one<0>(o[0], vb, pa0, pa1, pa2, pa3); pv_one<1>(o[1], vb, pa0, pa1, pa2, pa3); pv_one<2>(o[2], vb, pa0, pa1, pa2, pa3); pv_one<3>(o[3], vb, pa0, pa1, pa2, pa3);
}

__device__ __forceinline__ void attn_item(const bf16_t* __restrict__ Qb, const bf16_t* __restrict__ Kh, const bf16_t* __restrict__ Vh, bf16_t* __restrict__ Ub,
                                          int q0, float nsl2, float lam, const float* __restrict__ normw, char* lds) {
  constexpr int LDK = PLD;
  int tid = threadIdx.x; asm volatile("" : "+v"(tid));
  const int wid = tid >> 6, lane = tid & 63, r32 = lane & 31, hi = lane >> 5, rg = wid >> 1, cmap = wid & 1, cm = cmap * 64;
  char* V_lds = lds; char* K_lds = lds + 2 * SHM_V;
  float* ws = (float*)(lds + 2 * SHM_V + 2 * SHM_K) + wid * 64; float* li_l = ws; float* al_l = ws + 32;
  float m_reg = -1e30f, l_reg = 0; f32x16 o[4] = {}; bf16x8 qr[4];
  const bf16_t* Qw = Qb + (size_t)(rg * 32 + r32) * LDK + cm + hi * 8;
#pragma unroll
  for (int d0 = 0; d0 < 4; ++d0) qr[d0] = *reinterpret_cast<const bf16x8*>(Qw + d0 * 16);
  const int sr = tid >> 4, sc = (tid & 15) * 8, vst0 = v_st(sr, sc), vst1 = v_st(32 + sr, sc);
  const int vb0 = (int)(uintptr_t)V_lds + v_rd_base(lane);
  const float qposh = (float)(q0 + rg * 32 + r32 - 4 * hi);
  struct { bf16x8 vs0, vs1, ks0, ks1; } sr_[2];
#define SLOAD(i, k0) do { sr_[i].vs0 = *reinterpret_cast<const bf16x8*>(&Vh[(size_t)((k0) + sr) * LDK + sc]); sr_[i].vs1 = *reinterpret_cast<const bf16x8*>(&Vh[(size_t)((k0) + 32 + sr) * LDK + sc]); \
    sr_[i].ks0 = *reinterpret_cast<const bf16x8*>(&Kh[(size_t)((k0) + sr) * LDK + sc]); sr_[i].ks1 = *reinterpret_cast<const bf16x8*>(&Kh[(size_t)((k0) + 32 + sr) * LDK + sc]); } while (0)
#define SWRITE(b, i) do { *(bf16x8*)(V_lds + (b) * SHM_V + vst0) = sr_[i].vs0;          \
    *(bf16x8*)(V_lds + (b) * SHM_V + vst1) = sr_[i].vs1; int kc = sc * 2;               \
    *(bf16x8*)(K_lds + (b) * SHM_K + AT_KSWZ(sr, kc)) = sr_[i].ks0;                       \
    *(bf16x8*)(K_lds + (b) * SHM_K + AT_KSWZ(32 + sr, kc)) = sr_[i].ks1; } while (0)
#define SWAIT() asm volatile("s_waitcnt vmcnt(4)" ::: "memory")
#define RESC(a) do { if (__any((a) < 1.f)) { if (hi == 0) al_l[r32] = (a); asm volatile("s_waitcnt lgkmcnt(0)" ::: "memory"); \
    _Pragma("unroll") for (int d = 0; d < 4; ++d) _Pragma("unroll") for (int r = 0; r < 16; ++r) o[d][r] *= al_l[crow(r, hi)]; } } while (0)
  f32x16 pA0, pA1, pB0, pB1; float mnA, mnB, alA, alB; bf16x8 pa0, pa1, pa2, pa3; constexpr int NTL = S / KVBLK;
  constexpr int SE = 0, SO = 1;
  SLOAD(SE, 0); asm volatile("s_waitcnt vmcnt(0)" ::: "memory"); SWRITE(0, SE); __syncthreads();
  qkt(pA0, pA1, K_lds, qr, r32, hi, cm); partialSM(pA0, pA1, qposh, nsl2, m_reg, mnA, alA);
  SLOAD(SO, KVBLK); SLOAD(SE, 2 * KVBLK);
  SWAIT(); SWRITE(1, SO); __syncthreads();
  for (int j = 1; j + 1 < NTL; j += 2) {
    AT_SBAR(); qkt(pB0, pB1, K_lds + SHM_K, qr, r32, hi, cm);
    finishSM(pA0, pA1, alA, l_reg, pa0, pa1, pa2, pa3); AT_SBAR();
    SLOAD(SO, (j + 2) * KVBLK); AT_SBAR();
    pv_d0(o, vb0, pa0, pa1, pa2, pa3); partialSM(pB0, pB1, qposh - (float)(j * KVBLK), nsl2, m_reg, mnB, alB);
    __syncthreads(); SWAIT(); SWRITE(0, SE);
    RESC(alB); __syncthreads();
    AT_SBAR(); qkt(pA0, pA1, K_lds, qr, r32, hi, cm);
    finishSM(pB0, pB1, alB, l_reg, pa0, pa1, pa2, pa3); AT_SBAR();
    if (j + 3 < NTL) SLOAD(SE, (j + 3) * KVBLK); AT_SBAR();
    pv_d0(o, vb0 + (int)SHM_V, pa0, pa1, pa2, pa3); partialSM(pA0, pA1, qposh - (float)((j + 1) * KVBLK), nsl2, m_reg, mnA, alA);
    __syncthreads(); SWAIT(); SWRITE(1, SO);
    RESC(alA); __syncthreads();
  }
  AT_SBAR(); qkt(pB0, pB1, K_lds + SHM_K, qr, r32, hi, cm);
  finishSM(pA0, pA1, alA, l_reg, pa0, pa1, pa2, pa3); AT_SBAR();
  pv_d0(o, vb0, pa0, pa1, pa2, pa3); partialSM(pB0, pB1, qposh - (float)((NTL - 1) * KVBLK), nsl2, m_reg, mnB, alB);
  __syncthreads(); RESC(alB);
  finishSM(pB0, pB1, alB, l_reg, pa0, pa1, pa2, pa3); AT_SBAR();
  pv_d0(o, vb0 + (int)SHM_V, pa0, pa1, pa2, pa3);
  if (hi == 0) li_l[r32] = l_reg; asm volatile("s_waitcnt lgkmcnt(0)" ::: "memory");
  float rli[16];
#pragma unroll
  for (int r = 0; r < 16; ++r) rli[r] = __builtin_amdgcn_rcpf(li_l[crow(r, hi)]);
#pragma unroll
  for (int d = 0; d < 4; ++d)
#pragma unroll
    for (int r = 0; r < 16; ++r) o[d][r] *= rli[r];
  __syncthreads();
  float* X = (float*)lds + rg * (32 * 128);
  if (cmap == 1) {
#pragma unroll
    for (int d = 0; d < 4; ++d)
#pragma unroll
      for (int r = 0; r < 16; ++r) X[crow(r, hi) * 128 + d * 32 + r32] = o[d][r];
  }
  __syncthreads();
  if (cmap == 0) {
    float ss[16];
#pragma unroll
    for (int r = 0; r < 16; ++r) ss[r] = 0.f;
#pragma unroll
    for (int d = 0; d < 4; ++d)
#pragma unroll
      for (int r = 0; r < 16; ++r) { const float v = o[d][r] - lam * X[crow(r, hi) * 128 + d * 32 + r32]; o[d][r] = v; ss[r] += v * v; }
#pragma unroll
    for (int r = 0; r < 16; ++r) { float s = ss[r]; s += __shfl_xor(s, 16); s += __shfl_xor(s, 8); s += __shfl_xor(s, 4); s += __shfl_xor(s, 2); s += __shfl_xor(s, 1);
      ss[r] = rsqrtf(s * (1.f / 128.f) + 1e-5f) * (1.f - LAMBDA_INIT); }
    float nw[4];
#pragma unroll
    for (int d = 0; d < 4; ++d) nw[d] = normw[d * 32 + r32];
#pragma unroll
    for (int r = 0; r < 16; ++r) { bf16_t* up = Ub + (size_t)(rg * 32 + crow(r, hi)) * D + r32;
#pragma unroll
      for (int d = 0; d < 4; ++d) up[d * 32] = f2bf(o[d][r] * ss[r] * nw[d]); }
  }
  __syncthreads();
#undef SLOAD
#undef SWRITE
#undef SWAIT
#undef RESC
}
}

__device__ void ph_attn_mfma(const Params& p, char* lds, int* qhead) {
  float lam;
  { float s1 = 0.f, s2 = 0.f; for (int i = 0; i < 64; ++i) { s1 += p.lq1[i] * p.lk1[i]; s2 += p.lq2[i] * p.lk2[i]; } lam = __expf(s1) - __expf(s2) + LAMBDA_INIT; }
  int* qslot = (int*)(lds + 72 * 1024);
  for (;;) {
    __syncthreads();
    if (threadIdx.x == 0) *qslot = atomicAdd(qhead, 1);
    __syncthreads();
    const int item = *qslot;
    if (item >= NB * AH * (S / 128)) break;
    const int qb = item % (S / 128), h = (item / (S / 128)) % AH, b = item / ((S / 128) * AH);
    const float nsl2 = -exp2f(-(float)(h + 1)) * LOG2E;
    const size_t row0 = (size_t)b * S;
    at::attn_item(p.proj + (row0 + qb * 128) * PLD + N_Q + h * 128, p.proj + row0 * PLD + N_K + h * 128, p.proj + row0 * PLD + N_V + h * 128,
                  p.u + (row0 + qb * 128) * D + DSSD + h * 128, qb * 128, nsl2, lam, p.attn_norm_w, lds);
  }
}
namespace sd {
using at::bf16x8; using at::s16x4; using at::f32x16; using at::u32x4; using at::crow; using at::cvtpk; using at::v_st; using at::v_rd_base; using at::v_rd_off; using at::tr_read;
constexpr int CH = 64, NCH = S / CH;
constexpr int L_BT = 0, L_CT = 16384, L_XV = 32768, L_TAB = 98304, L_SS = 106496;
constexpr size_t SNAP = 16384;
__device__ __forceinline__ size_t snap_off(int dir, int b, int h, int c) { return ((((size_t)dir * NB + b) * NH + h) * NCH + c) * SNAP; }

__device__ void ph_conv16(const Params& p) {
  constexpr int SEG = 16, NCG = CC / 8, NU = NCG * (T / SEG);
  for (int u = blockIdx.x * NT + threadIdx.x; u < NU; u += gridDim.x * NT) {
    const int cg = u % NCG, seg = u / NCG, t0 = seg * SEG, s0 = t0 % S, chan = cg * 8;
    float w[5][8], bias[8];
#pragma unroll
    for (int j = 0; j < 5; ++j) { const float4 a = *(const float4*)(p.conv_w + j * CC + chan), c = *(const float4*)(p.conv_w + j * CC + chan + 4);
      w[j][0] = a.x; w[j][1] = a.y; w[j][2] = a.z; w[j][3] = a.w; w[j][4] = c.x; w[j][5] = c.y; w[j][6] = c.z; w[j][7] = c.w; }
    { const float4 a = *(const float4*)(p.conv_b + chan), c = *(const float4*)(p.conv_b + chan + 4);
      bias[0] = a.x; bias[1] = a.y; bias[2] = a.z; bias[3] = a.w; bias[4] = c.x; bias[5] = c.y; bias[6] = c.z; bias[7] = c.w; }
    const bf16_t* base = p.proj + (size_t)t0 * PLD + N_XBC + chan;
    u32x4 rows[SEG + 4];
#pragma unroll
    for (int i = 0; i < SEG + 4; ++i) { const int s = s0 + i - 2; rows[i] = (u32x4){0u, 0u, 0u, 0u}; if (s >= 0 && s < S) rows[i] = *(const u32x4*)(base + (ptrdiff_t)(i - 2) * PLD); }
#pragma unroll
    for (int i = 0; i < SEG; ++i) {
      float o[8];
#pragma unroll
      for (int c = 0; c < 8; ++c) o[c] = bias[c];
#pragma unroll
      for (int j = 0; j < 5; ++j) { const u32x4 rr = rows[i + j];
        o[0] += w[j][0] * __uint_as_float(rr.x << 16); o[1] += w[j][1] * __uint_as_float(rr.x & 0xffff0000u);
        o[2] += w[j][2] * __uint_as_float(rr.y << 16); o[3] += w[j][3] * __uint_as_float(rr.y & 0xffff0000u);
        o[4] += w[j][4] * __uint_as_float(rr.z << 16); o[5] += w[j][5] * __uint_as_float(rr.z & 0xffff0000u);
        o[6] += w[j][6] * __uint_as_float(rr.w << 16); o[7] += w[j][7] * __uint_as_float(rr.w & 0xffff0000u); }
#pragma unroll
      for (int c = 0; c < 8; ++c) o[c] = o[c] * __builtin_amdgcn_rcpf(1.f + __expf(-o[c]));
      u32x4 pk; pk.x = cvtpk(o[0], o[1]); pk.y = cvtpk(o[2], o[3]); pk.z = cvtpk(o[4], o[5]); pk.w = cvtpk(o[6], o[7]);
      *(u32x4*)(p.xc16 + (size_t)(t0 + i) * CC + chan) = pk;
    }
  }
}
template <bool WITH_C, bool BV>
__device__ __forceinline__ void load_chunk(const Params& p, char* lds, int b, int g, int c0) {
  constexpr int NCG = WITH_C ? 96 : 80, NP = NCG * CH / NT;
  int tid = threadIdx.x; asm volatile("" : "+v"(tid));
  const bf16_t* src = p.xc16 + ((size_t)b * S + c0) * CC;
  u32x4 v[NP];
#pragma unroll
  for (int i = 0; i < NP; ++i) { const int idx = tid + NT * i, tok = idx / NCG, cg = idx % NCG;
    const int chan = cg < 64 ? g * 512 + cg * 8 : (cg < 80 ? 1024 + g * 128 + (cg - 64) * 8 : 1280 + g * 128 + (cg - 80) * 8);
    v[i] = *(const u32x4*)(src + (size_t)tok * CC + chan); }
#pragma unroll
  for (int i = 0; i < NP; ++i) { const int idx = tid + NT * i, tok = idx / NCG, cg = idx % NCG;
    if (cg < 64) { const int hl = cg >> 3, c = (hl & 1) * 64 + (cg & 7) * 8; *(u32x4*)(lds + L_XV + (hl >> 1) * 16384 + v_st(tok, c)) = v[i]; }
    else if (cg < 80) { const int n0 = (cg - 64) * 8; if (BV) *(u32x4*)(lds + L_BT + v_st(tok, n0)) = v[i]; else *(u32x4*)(lds + L_BT + AT_KSWZ(tok, n0 * 2)) = v[i]; }
    else { const int n0 = (cg - 80) * 8; *(u32x4*)(lds + L_CT + AT_KSWZ(tok, n0 * 2)) = v[i]; } }
}
__device__ __forceinline__ float wave_incl_prefix(float v, int lane) {
#pragma unroll
  for (int o = 1; o < 64; o <<= 1) { const float t = __int_as_float(__builtin_amdgcn_ds_bpermute(((lane - o) & 63) << 2, __float_as_int(v))); if (lane >= o) v += t; }
  return v;
}
__device__ __forceinline__ float wave_incl_suffix(float v, int lane) {
#pragma unroll
  for (int o = 1; o < 64; o <<= 1) { const float t = __int_as_float(__builtin_amdgcn_ds_bpermute(((lane + o) & 63) << 2, __float_as_int(v))); if (lane + o < 64) v += t; }
  return v;
}
__device__ __forceinline__ float wave_bcast(float v, int src) { return __int_as_float(__builtin_amdgcn_ds_bpermute(src << 2, __float_as_int(v))); }
__device__ __forceinline__ bf16x8 scale_frag(s16x4 lo, s16x4 hi, const float4 w0, const float4 w1) {
  const unsigned a = ((unsigned)(unsigned short)lo[0]) | ((unsigned)(unsigned short)lo[1] << 16), b = ((unsigned)(unsigned short)lo[2]) | ((unsigned)(unsigned short)lo[3] << 16);
  const unsigned c = ((unsigned)(unsigned short)hi[0]) | ((unsigned)(unsigned short)hi[1] << 16), d = ((unsigned)(unsigned short)hi[2]) | ((unsigned)(unsigned short)hi[3] << 16);
  u32x4 r;
  r.x = cvtpk(__uint_as_float(a << 16) * w0.x, __uint_as_float(a & 0xffff0000u) * w0.y);
  r.y = cvtpk(__uint_as_float(b << 16) * w0.z, __uint_as_float(b & 0xffff0000u) * w0.w);
  r.z = cvtpk(__uint_as_float(c << 16) * w1.x, __uint_as_float(c & 0xffff0000u) * w1.y);
  r.w = cvtpk(__uint_as_float(d << 16) * w1.z, __uint_as_float(d & 0xffff0000u) * w1.w);
  return *reinterpret_cast<bf16x8*>(&r);
}
#define SD_PK(L, H) (bf16x8){L[0], L[1], L[2], L[3], H[0], H[1], H[2], H[3]}

__device__ __forceinline__ void pass_a_item(const Params& p, char* lds, char* snap, int b, int g, int dir) {
  int tid = threadIdx.x; asm volatile("" : "+v"(tid));
  const int hl = tid >> 6, lane = tid & 63, r32 = lane & 31, hi = lane >> 5, h = g * 8 + hl;
  const float a = -__expf(dir ? p.a_log_b[h] : p.a_log_f[h]);
  float* wtab = (float*)(lds + L_TAB) + hl * 64;
  const int vbx = (int)(uintptr_t)(lds + L_XV + (hl >> 1) * 16384) + v_rd_base(lane) + (hl & 1) * 1024;
  const int vbb = (int)(uintptr_t)(lds + L_BT) + v_rd_base(lane);
  f32x16 st[4][2];
#pragma unroll
  for (int nb = 0; nb < 4; ++nb)
#pragma unroll
    for (int pb = 0; pb < 2; ++pb) st[nb][pb] = f32x16{};
  for (int ci = 0; ci < NCH; ++ci) {
    const int c = dir ? (NCH - 1 - ci) : ci, c0 = c * CH;
    __syncthreads();
    load_chunk<false, true>(p, lds, b, g, c0);
    const float dtv = p.dt[((size_t)b * S + c0 + lane) * 32 + dir * 16 + h];
    const float adt = a * dtv;
    const float cum = dir ? wave_incl_suffix(adt, lane) : wave_incl_prefix(adt, lane);
    const float total = wave_bcast(cum, dir ? 0 : 63);
    wtab[lane] = __expf(total - cum) * dtv;
    const float dec = __expf(total);
    { char* sp = snap + snap_off(dir, b, h, c);
#pragma unroll
      for (int nb = 0; nb < 4; ++nb)
#pragma unroll
        for (int pb = 0; pb < 2; ++pb)
#pragma unroll
          for (int q = 0; q < 4; ++q) { const f32x16& s = st[nb][pb];
            uint2 v; v.x = cvtpk(s[4 * q + 0], s[4 * q + 1]); v.y = cvtpk(s[4 * q + 2], s[4 * q + 3]);
            *(uint2*)(sp + ((((pb * 8 + nb * 2 + (q >> 1)) * 2 + (q & 1)) * 32 + r32) * 16 + hi * 8)) = v; } }
#pragma unroll
    for (int nb = 0; nb < 4; ++nb)
#pragma unroll
      for (int pb = 0; pb < 2; ++pb)
#pragma unroll
        for (int r = 0; r < 16; ++r) st[nb][pb][r] *= dec;
    __syncthreads();
#pragma unroll
    for (int ks = 0; ks < 4; ++ks) {
      const float4 w0 = *(const float4*)(wtab + ks * 16 + hi * 8), w1 = *(const float4*)(wtab + ks * 16 + hi * 8 + 4);
      bf16x8 xf[2];
      { const s16x4 l0 = tr_read<v_rd_off(0, 0, 0)>(vbx + ks * 4096), h0 = tr_read<v_rd_off(0, 0, 1)>(vbx + ks * 4096), l1 = tr_read<v_rd_off(1, 0, 0)>(vbx + ks * 4096), h1 = tr_read<v_rd_off(1, 0, 1)>(vbx + ks * 4096);
        asm volatile("s_waitcnt lgkmcnt(0)" ::: "memory"); AT_SBAR();
        xf[0] = scale_frag(l0, h0, w0, w1); xf[1] = scale_frag(l1, h1, w0, w1); }
#pragma unroll
      for (int nb = 0; nb < 4; ++nb) {
        s16x4 bl, bh;
        asm volatile("ds_read_b64_tr_b16 %0, %1" : "=&v"(bl) : "v"(vbb + nb * 512 + ks * 4096) : "memory");
        asm volatile("ds_read_b64_tr_b16 %0, %1 offset:2048" : "=&v"(bh) : "v"(vbb + nb * 512 + ks * 4096) : "memory");
        asm volatile("s_waitcnt lgkmcnt(0)" ::: "memory"); AT_SBAR();
        const bf16x8 bfr = SD_PK(bl, bh);
        st[nb][0] = __builtin_amdgcn_mfma_f32_32x32x16_bf16(bfr, xf[0], st[nb][0], 0, 0, 0);
        st[nb][1] = __builtin_amdgcn_mfma_f32_32x32x16_bf16(bfr, xf[1], st[nb][1], 0, 0, 0);
      }
    }
  }
  __syncthreads();
}

__device__ __forceinline__ void pass_b_item(const Params& p, char* lds, const char* snap, int b, int g, int c) {
  int tid = threadIdx.x; asm volatile("" : "+v"(tid));
  const int hl = tid >> 6, lane = tid & 63, r32 = lane & 31, hi = lane >> 5, h = g * 8 + hl, c0 = c * CH;
  float4* tab = (float4*)(lds + L_TAB) + hl * 64;
  float* ssp = (float*)(lds + L_SS);
  const int vbx = (int)(uintptr_t)(lds + L_XV + (hl >> 1) * 16384) + v_rd_base(lane) + (hl & 1) * 1024;
  __syncthreads();
  load_chunk<true, false>(p, lds, b, g, c0);
  { const size_t tok = (size_t)b * S + c0 + lane;
    const float dtf = p.dt[tok * 32 + h], dtb = p.dt[tok * 32 + 16 + h];
    const float af = -__expf(p.a_log_f[h]) * dtf, ab = -__expf(p.a_log_b[h]) * dtb;
    tab[lane] = make_float4(wave_incl_prefix(af, lane) * LOG2E, wave_incl_suffix(ab, lane) * LOG2E, dtf, dtb); }
  __syncthreads();
  const float dsk = p.d_skip[h];
  f32x16 o[2][2];
#pragma unroll
  for (int lb = 0; lb < 2; ++lb) {
    const int l = lb * 32 + r32;
    const float4 tl = tab[l];
    bf16x8 cr[8];
#pragma unroll
    for (int kk = 0; kk < 8; ++kk) cr[kk] = *reinterpret_cast<const bf16x8*>(lds + L_CT + AT_KSWZ(l, (kk * 16 + hi * 8) * 2));
    f32x16 p0 = f32x16{}, p1 = f32x16{};
#pragma unroll
    for (int kk = 0; kk < 8; ++kk) { const int cb = (kk * 16 + hi * 8) * 2;
      const bf16x8 b0 = *reinterpret_cast<const bf16x8*>(lds + L_BT + AT_KSWZ(r32, cb));
      const bf16x8 b1 = *reinterpret_cast<const bf16x8*>(lds + L_BT + AT_KSWZ(32 + r32, cb));
      p0 = __builtin_amdgcn_mfma_f32_32x32x16_bf16(b0, cr[kk], p0, 0, 0, 0);
      p1 = __builtin_amdgcn_mfma_f32_32x32x16_bf16(b1, cr[kk], p1, 0, 0, 0); }
#pragma unroll
    for (int r = 0; r < 16; ++r) {
#pragma unroll
      for (int half = 0; half < 2; ++half) {
        const int s = crow(r, hi) + 32 * half; const float4 ts = tab[s];
        float m = 0.f;
        if (s <= l) m += __builtin_amdgcn_exp2f(tl.x - ts.x) * ts.z;
        if (s >= l) m += __builtin_amdgcn_exp2f(tl.y - ts.y) * ts.w;
        const float add = (s == l) ? dsk : 0.f;
        if (half) p1[r] = p1[r] * m + add; else p0[r] = p0[r] * m + add;
      }
      asm volatile("" ::: "memory");
    }
    bf16x8 pa0, pa1, pa2, pa3;
#define SD_PK4(P, BASE, OUT) do { unsigned a0 = cvtpk(P[BASE + 0], P[BASE + 1]), a1 = cvtpk(P[BASE + 2], P[BASE + 3]);   \
    unsigned b0_ = cvtpk(P[BASE + 4], P[BASE + 5]), b1_ = cvtpk(P[BASE + 6], P[BASE + 7]);                              \
    auto r0 = __builtin_amdgcn_permlane32_swap(a0, b0_, false, false); auto r1 = __builtin_amdgcn_permlane32_swap(a1, b1_, false, false); \
    u32x4 w_ = {r0[0], r1[0], r0[1], r1[1]}; OUT = *reinterpret_cast<bf16x8*>(&w_); } while (0)
    SD_PK4(p0, 0, pa0); SD_PK4(p0, 8, pa1); SD_PK4(p1, 0, pa2); SD_PK4(p1, 8, pa3);
#undef SD_PK4
#pragma unroll
    for (int d = 0; d < 2; ++d) {
      const s16x4 l0 = d ? tr_read<v_rd_off(1, 0, 0)>(vbx) : tr_read<v_rd_off(0, 0, 0)>(vbx), h0 = d ? tr_read<v_rd_off(1, 0, 1)>(vbx) : tr_read<v_rd_off(0, 0, 1)>(vbx);
      const s16x4 l1 = d ? tr_read<v_rd_off(1, 1, 0)>(vbx) : tr_read<v_rd_off(0, 1, 0)>(vbx), h1 = d ? tr_read<v_rd_off(1, 1, 1)>(vbx) : tr_read<v_rd_off(0, 1, 1)>(vbx);
      const s16x4 l2 = d ? tr_read<v_rd_off(1, 2, 0)>(vbx) : tr_read<v_rd_off(0, 2, 0)>(vbx), h2 = d ? tr_read<v_rd_off(1, 2, 1)>(vbx) : tr_read<v_rd_off(0, 2, 1)>(vbx);
      const s16x4 l3 = d ? tr_read<v_rd_off(1, 3, 0)>(vbx) : tr_read<v_rd_off(0, 3, 0)>(vbx), h3 = d ? tr_read<v_rd_off(1, 3, 1)>(vbx) : tr_read<v_rd_off(0, 3, 1)>(vbx);
      asm volatile("s_waitcnt lgkmcnt(0)" ::: "memory"); AT_SBAR();
      f32x16 od = f32x16{};
      od = __builtin_amdgcn_mfma_f32_32x32x16_bf16(pa0, SD_PK(l0, h0), od, 0, 0, 0);
      od = __builtin_amdgcn_mfma_f32_32x32x16_bf16(pa1, SD_PK(l1, h1), od, 0, 0, 0);
      od = __builtin_amdgcn_mfma_f32_32x32x16_bf16(pa2, SD_PK(l2, h2), od, 0, 0, 0);
      od = __builtin_amdgcn_mfma_f32_32x32x16_bf16(pa3, SD_PK(l3, h3), od, 0, 0, 0);
      o[lb][d] = od;
    }
  }
#pragma unroll
  for (int dir = 0; dir < 2; ++dir) {
    if (dir == 0 ? (c == 0) : (c == NCH - 1)) continue;
    const char* sp = snap + snap_off(dir, b, h, c);
#pragma unroll
    for (int d = 0; d < 2; ++d) {
      bf16x8 sf[8];
#pragma unroll
      for (int kk = 0; kk < 8; ++kk) sf[kk] = *reinterpret_cast<const bf16x8*>(sp + ((((d * 8 + kk) * 2 + hi) * 32 + r32) * 16));
#pragma unroll
      for (int lb = 0; lb < 2; ++lb) {
        f32x16 acc = f32x16{};
#pragma unroll
        for (int kk = 0; kk < 8; ++kk) { const bf16x8 cf = *reinterpret_cast<const bf16x8*>(lds + L_CT + AT_KSWZ(lb * 32 + r32, (kk * 16 + hi * 8) * 2));
          acc = __builtin_amdgcn_mfma_f32_32x32x16_bf16(cf, sf[kk], acc, 0, 0, 0); }
#pragma unroll
        for (int r = 0; r < 16; ++r) { const float4 tr = tab[lb * 32 + crow(r, hi)]; o[lb][d][r] += __builtin_amdgcn_exp2f(dir ? tr.y : tr.x) * acc[r]; }
      }
      asm volatile("" ::: "memory");
    }
  }
  asm volatile("" ::: "memory");
  const bf16_t* zp = p.proj + ((size_t)b * S + c0) * PLD + N_Z + h * HD + r32;
#pragma unroll
  for (int lb = 0; lb < 2; ++lb)
#pragma unroll
    for (int r = 0; r < 16; ++r) { const int l = lb * 32 + crow(r, hi); float ss = 0.f;
#pragma unroll
      for (int d = 0; d < 2; ++d) { const float z = bf2f(zp[(size_t)l * PLD + d * 32]); const float y = o[lb][d][r] * z * __builtin_amdgcn_rcpf(1.f + __expf(-z)); o[lb][d][r] = y; ss += y * y; }
      ss += __shfl_xor(ss, 16); ss += __shfl_xor(ss, 8); ss += __shfl_xor(ss, 4); ss += __shfl_xor(ss, 2); ss += __shfl_xor(ss, 1);
      if (r32 == 0) ssp[hl * 64 + l] = ss;
      if ((r & 3) == 3) asm volatile("" ::: "memory"); }
  __syncthreads();
  const float nw0 = p.ssd_norm_w[h * HD + r32], nw1 = p.ssd_norm_w[h * HD + 32 + r32];
  bf16_t* up = p.u + ((size_t)b * S + c0) * D + h * HD + r32;
#pragma unroll
  for (int lb = 0; lb < 2; ++lb)
#pragma unroll
    for (int r = 0; r < 16; ++r) { const int l = lb * 32 + crow(r, hi); float ss = 0.f;
#pragma unroll
      for (int q = 0; q < 8; ++q) ss += ssp[q * 64 + l];
      const float rstd = rsqrtf(ss * (1.f / 512.f) + 1e-5f);
      up[(size_t)l * D] = f2bf(o[lb][0][r] * rstd * nw0); up[(size_t)l * D + 32] = f2bf(o[lb][1][r] * rstd * nw1); }
}
}

__device__ void ph_ssd_a(const Params& p, char* lds, char* snap) {
  for (int item = blockIdx.x; item < NB * 2 * 2; item += gridDim.x) { const int dir = item & 1, g = (item >> 1) & 1, b = item >> 2; sd::pass_a_item(p, lds, snap, b, g, dir); }
}
__device__ void ph_ssd_b(const Params& p, char* lds, const char* snap) {
  for (int item = blockIdx.x; item < NB * 2 * sd::NCH; item += gridDim.x) { const int c = item % sd::NCH, g = (item / sd::NCH) & 1, b = item / (2 * sd::NCH); sd::pass_b_item(p, lds, snap, b, g, c); }
}
__device__ void ph_inproj(const Params& p, LAS unsigned char* lds) {
  pg8::Gemm g{p.xb, p.WinT, D}; pg8::OrderStatic Sd; Sd.init(T, NPROJ, gridDim.x, blockIdx.x);
  EpiProj E{p.proj, p.dt, p.dt_bias_f, p.dt_bias_b};
  pg8::gemm_phase<false>(lds, g, Sd, E);
}
__device__ void ph_outproj(const Params& p, LAS unsigned char* lds) {
  pg8::Gemm g{p.u, p.WoutT, D}; pg8::OrderStatic Sd; Sd.init(T, D, gridDim.x, blockIdx.x);
  EpiOut E{p.x, p.h1};
  pg8::gemm_phase<false>(lds, g, Sd, E);
}
__device__ void ph_ln1(const Params& p) {
  const int lane = threadIdx.x & 63, wv = threadIdx.x >> 6;
  for (int row = blockIdx.x * 8 + wv; row < T; row += gridDim.x * 8) {
    float* hp = p.h1 + (size_t)row * D; float v[32]; float s = 0.f;
#pragma unroll
    for (int j = 0; j < 32; ++j) { v[j] = hp[j * 64 + lane]; s += v[j]; }
    const float mu = wave_sum(s) * (1.f / D); float q = 0.f;
#pragma unroll
    for (int j = 0; j < 32; ++j) { const float d = v[j] - mu; q += d * d; }
    const float rstd = rsqrtf(wave_sum(q) * (1.f / D) + 1e-5f);
#pragma unroll
    for (int j = 0; j < 32; ++j) { const int c = j * 64 + lane; const float o = (v[j] - mu) * rstd * p.ln1_g[c] + p.ln1_b[c]; hp[c] = o; p.h1b[(size_t)row * D + c] = f2bf(o); }
  }
}
__device__ void ph_router(const Params& p, float* smem) {
  for (int mt = blockIdx.x; mt < T / 64; mt += gridDim.x) {
    const int m0 = mt * 64;
    gemm_tile(smem, 64, NE, D, [&](int r) { return p.h1 + (size_t)(m0 + r) * D; }, p.w_router, NE,
              [&](int r, int c, float v) { p.logits[(size_t)(m0 + r) * NE + c] = v; });
  }
}
__device__ __forceinline__ int ld_agent(const int* p) { return __hip_atomic_load(p, __ATOMIC_RELAXED, __HIP_MEMORY_SCOPE_AGENT); }
__device__ __forceinline__ float ld_agent(const float* p) { return __hip_atomic_load(p, __ATOMIC_RELAXED, __HIP_MEMORY_SCOPE_AGENT); }
__device__ void ph_route(const Params& p, LAS unsigned char* lds) {
  LAS int* cntl = (LAS int*)lds;
  const int lane = threadIdx.x & 63, wv = threadIdx.x >> 6;
  for (int tb = blockIdx.x; tb < T / 64; tb += gridDim.x) {
    __syncthreads();
    if (threadIdx.x < NE) cntl[threadIdx.x] = 0;
    __syncthreads();
    for (int ti = 0; ti < 8; ++ti) {
      const int t = tb * 64 + wv * 8 + ti;
      const float sc = 1.f / (1.f + __expf(-p.logits[(size_t)t * NE + lane]));
      const float bz = sc + p.router_bias[lane];
      int rk = 0;
#pragma unroll
      for (int j = 1; j < 8; ++j) { const float o = __shfl_xor(bz, j); const int oi = lane ^ j; rk += (o > bz || (o == bz && oi < lane)) ? 1 : 0; }
      float gs = rk < 2 ? bz : 0.f;
      gs += __shfl_xor(gs, 1); gs += __shfl_xor(gs, 2); gs += __shfl_xor(gs, 4);
      const int g = lane >> 3; int grk = 0;
#pragma unroll
      for (int j = 1; j < 8; ++j) { const float o = __shfl_xor(gs, j * 8); const int og = g ^ j; grk += (o > gs || (o == gs && og < g)) ? 1 : 0; }
      const bool gsel = grk < 4;
      const float mb = gsel ? bz : -INFINITY;
      int erk = 0;
      for (int j = 1; j < 64; ++j) { const float o = __shfl_xor(mb, j); const int oi = lane ^ j; erk += (o > mb || (o == mb && oi < lane)) ? 1 : 0; }
      const bool sel = gsel && erk < 8;
      const float gsum = wave_sum(sel ? sc : 0.f);
      if (sel) {
        const int lr = __hip_atomic_fetch_add(&cntl[lane], 1, __ATOMIC_RELAXED, __HIP_MEMORY_SCOPE_WORKGROUP);
        p.assign[t * 8 + erk] = lane | (lr << 8); p.gate[t * 8 + erk] = sc / gsum * 2.5f;
      }
    }
    __syncthreads();
    if (threadIdx.x < NE) p.blkcnt[tb * NE + threadIdx.x] = cntl[threadIdx.x];
  }
}
__device__ void ph_place(const Params& p, LAS unsigned char* lds) {
  LAS int* part = (LAS int*)lds;
  LAS int* parta = part + 512;
  LAS int* base = parta + 512;
  LAS int* total = base + 64;
  LAS int* pstart = total + 64;
  const int tid = threadIdx.x, e = tid & 63, pt = tid >> 6;
  for (int tb = blockIdx.x; tb < T / 64; tb += gridDim.x) {
    __syncthreads();
    int slo = 0, sall = 0;
    for (int b = pt * 32; b < pt * 32 + 32; ++b) { const int c = ld_agent(p.blkcnt + b * NE + e); sall += c; slo += (b < tb) ? c : 0; }
    part[pt * 64 + e] = slo; parta[pt * 64 + e] = sall;
    __syncthreads();
    if (tid < 64) {
      int b0 = 0, t0 = 0;
#pragma unroll
      for (int q = 0; q < 8; ++q) { b0 += part[q * 64 + tid]; t0 += parta[q * 64 + tid]; }
      base[tid] = b0; total[tid] = t0;
      const int padded = (t0 + 255) & ~255;
      int incl = padded;
      for (int o = 1; o < 64; o <<= 1) { const int v = __shfl_up(incl, o); if (tid >= o) incl += v; }
      pstart[tid] = incl - padded;
      if (tid == 63) pstart[64] = incl;
    }
    __syncthreads();
    {
      const int t = tb * 64 + (tid >> 3), k = tid & 7;
      const int a = ld_agent(p.assign + t * 8 + k), ee = a & 255, lr = a >> 8;
      const int row = pstart[ee] + base[ee] + lr;
      p.row_tok[row] = t; p.row_gate[row] = ld_agent(p.gate + t * 8 + k); p.pos[t * 8 + k] = row;
      if (tid < 64) { const int srow = pstart[64] + tb * 64 + tid; p.row_tok[srow] = tb * 64 + tid; p.row_gate[srow] = 1.0f; }
    }
    if (tb == blockIdx.x) {
      for (int e2 = blockIdx.x; e2 < NE; e2 += gridDim.x) {
        const int r0 = pstart[e2] + total[e2], r1 = pstart[e2 + 1];
        for (int r = r0 + tid; r < r1; r += NT) { p.row_tok[r] = 0; p.row_gate[r] = 0.f; }
        for (int j = pstart[e2] / 256 + tid; j < r1 / 256; j += NT) p.tile_exp[j] = e2;
      }
      if (blockIdx.x == 0) {
        const int nr = pstart[64] / 256;
        for (int j = tid; j < T / 256; j += NT) p.tile_exp[nr + j] = NE;
        if (tid == 0) { p.meta[0] = nr; p.meta[1] = nr + T / 256; }
      }
    }
  }
}
struct OrderMoE {
  LAS const int* ulist; int n;
  LAS const unsigned* tab;
  __device__ __forceinline__ bool next(int i, pg8::Unit& u) const { if (i >= n) return false; u.pm = ulist[i * 4 + 0]; u.pn = ulist[i * 4 + 1]; u.bn = ulist[i * 4 + 2]; u.aux = i; return true; }
  __device__ __forceinline__ unsigned row_off(int i, int row) const { return tab[i * 512 + row]; }
};
template <bool TABLES>
__device__ __forceinline__ OrderMoE moe_order(const Params& p, LAS unsigned char* lds, int npn, int tile0, int ntiles, int rowbytes) {
  LAS int* ulist = (LAS int*)(lds + LDS_TAB); LAS unsigned* tab = (LAS unsigned*)(lds + LDS_TAB + 1024);
  const int G = gridDim.x, c = blockIdx.x, mpc = 32 / npn; int n = 0;
  __syncthreads();
  for (int i = 0; i < 60; ++i) {
    int U; if (G == 256) U = ((i * 8 + (c & 7)) * 32 + (c >> 3)); else U = i * G + c;
    const int chunk = U >> 5, w = U & 31, j = chunk * mpc + (w % mpc), pn = w / mpc;
    if (j >= ntiles) break;
    const int tile = tile0 + j, e = ld_agent(p.tile_exp + tile);
    if (threadIdx.x == 0) { ulist[i * 4 + 0] = tile; ulist[i * 4 + 1] = pn; ulist[i * 4 + 2] = e * npn + pn; ulist[i * 4 + 3] = e; }
    if (TABLES) { for (int r = threadIdx.x; r < 256; r += NT) { tab[i * 512 + r] = (unsigned)ld_agent(p.row_tok + tile * 256 + r) * (unsigned)rowbytes; tab[i * 512 + 256 + r] = __float_as_uint(ld_agent(p.row_gate + tile * 256 + r)); } }
    n = i + 1;
  }
  __syncthreads();
  return OrderMoE{ulist, n, tab};
}
struct EpiGU {
  static constexpr bool PERM = true;
  bf16_t* H; LAS const unsigned* tab;
  __device__ __forceinline__ void operator()(const f32x4 (&acc)[2][2][4][2], const pg8::Unit& u, int wr, int wc, int fr, int fq) const {
    const int col0 = u.pn * 128 + wc * 32 + 8 * fq;
#pragma unroll
    for (int ai = 0; ai < 2; ++ai)
#pragma unroll
      for (int m = 0; m < 4; ++m) { const int r = ai * 128 + wr * 64 + m * 16 + fr; const float gt = __uint_as_float(tab[u.aux * 512 + 256 + r]);
        f32x4 h0, h1;
#pragma unroll
        for (int j = 0; j < 4; ++j) { const float g0 = acc[ai][0][m][0][j], g1 = acc[ai][0][m][1][j];
          h0[j] = g0 * __builtin_amdgcn_rcpf(1.f + __expf(-g0)) * acc[ai][1][m][0][j] * gt; h1[j] = g1 * __builtin_amdgcn_rcpf(1.f + __expf(-g1)) * acc[ai][1][m][1][j] * gt; }
        u32x4 w; w.x = cvt_pk_bf16(h0[0], h0[1]); w.y = cvt_pk_bf16(h0[2], h0[3]); w.z = cvt_pk_bf16(h1[0], h1[1]); w.w = cvt_pk_bf16(h1[2], h1[3]);
        *(u32x4*)(H + (size_t)(u.pm * 256 + r) * DE + col0) = w; }
  }
};
__device__ void ph_gateup(const Params& p, LAS unsigned char* lds) {
  const int ntot = ld_agent(p.meta + 1);
  const OrderMoE S = moe_order<true>(p, lds, 4, 0, ntot, D * 2);
  pg8::Gemm g{p.h1b, p.WguT, D}; EpiGU E{p.H, S.tab};
  pg8::gemm_phase<true>(lds, g, S, E);
}
struct EpiDown {
  static constexpr bool PERM = true;
  bf16_t* Y; float* out; const bf16_t* h1b; LAS const int* ulist; int srow0;
  __device__ __forceinline__ void operator()(const f32x4 (&acc)[2][2][4][2], const pg8::Unit& u, int wr, int wc, int fr, int fq) const {
    const int col0 = u.pn * 256 + wc * 32 + 8 * fq; const bool shared_e = ulist[u.aux * 4 + 3] == NE;
#pragma unroll
    for (int ai = 0; ai < 2; ++ai)
#pragma unroll
      for (int m = 0; m < 4; ++m) { const int row = u.pm * 256 + ai * 128 + wr * 64 + m * 16 + fr;
#pragma unroll
        for (int bj = 0; bj < 2; ++bj) { const f32x4 v0 = acc[ai][bj][m][0], v1 = acc[ai][bj][m][1];
          if (!shared_e) { u32x4 w; w.x = cvt_pk_bf16(v0[0], v0[1]); w.y = cvt_pk_bf16(v0[2], v0[3]); w.z = cvt_pk_bf16(v1[0], v1[1]); w.w = cvt_pk_bf16(v1[2], v1[3]);
            *(u32x4*)(Y + (size_t)row * D + col0 + bj * 128) = w; }
          else { const size_t o = (size_t)(row - srow0) * D + col0 + bj * 128; const u32x4 hb = *(const u32x4*)(h1b + o); f32x4 a, b;
            a[0] = __uint_as_float(hb.x << 16); a[1] = __uint_as_float(hb.x & 0xffff0000u); a[2] = __uint_as_float(hb.y << 16); a[3] = __uint_as_float(hb.y & 0xffff0000u);
            b[0] = __uint_as_float(hb.z << 16); b[1] = __uint_as_float(hb.z & 0xffff0000u); b[2] = __uint_as_float(hb.w << 16); b[3] = __uint_as_float(hb.w & 0xffff0000u);
            *(f32x4*)(out + o) = a * ALPHA + v0; *(f32x4*)(out + o + 4) = b * ALPHA + v1; } } }
  }
};
__device__ void ph_down(const Params& p, LAS unsigned char* lds) {
  const int nr = ld_agent(p.meta + 0), ntot = ld_agent(p.meta + 1);
  const OrderMoE S = moe_order<false>(p, lds, 8, 0, ntot, 0);
  pg8::Gemm g{p.H, p.WdT, DE}; EpiDown E{p.Y, p.out, p.h1b, S.ulist, nr * 256};
  pg8::gemm_phase<false>(lds, g, S, E);
}
__device__ void ph_combine(const Params& p) {
  const int lane = threadIdx.x & 63, wv = threadIdx.x >> 6;
  for (int row = blockIdx.x * 8 + wv; row < T; row += gridDim.x * 8) {
    float v[32];
    float* op = p.out + (size_t)row * D;
#pragma unroll
    for (int g = 0; g < 4; ++g) { const f32x4 a = *(const f32x4*)(op + g * 512 + lane * 8), b = *(const f32x4*)(op + g * 512 + lane * 8 + 4);
#pragma unroll
      for (int j = 0; j < 4; ++j) { v[g * 8 + j] = a[j]; v[g * 8 + 4 + j] = b[j]; } }
    for (int k = 0; k < 8; ++k) {
      const int yr = ld_agent(p.pos + row * 8 + k); const bf16_t* yp = p.Y + (size_t)yr * D;
#pragma unroll
      for (int g = 0; g < 4; ++g) { const u32x4 hb = *(const u32x4*)(yp + g * 512 + lane * 8);
        v[g * 8 + 0] += __uint_as_float(hb.x << 16); v[g * 8 + 1] += __uint_as_float(hb.x & 0xffff0000u); v[g * 8 + 2] += __uint_as_float(hb.y << 16); v[g * 8 + 3] += __uint_as_float(hb.y & 0xffff0000u);
        v[g * 8 + 4] += __uint_as_float(hb.z << 16); v[g * 8 + 5] += __uint_as_float(hb.z & 0xffff0000u); v[g * 8 + 6] += __uint_as_float(hb.w << 16); v[g * 8 + 7] += __uint_as_float(hb.w & 0xffff0000u); }
    }
    float s = 0.f;
#pragma unroll
    for (int j = 0; j < 32; ++j) s += v[j];
    const float mu = wave_sum(s) * (1.f / D); float q = 0.f;
#pragma unroll
    for (int j = 0; j < 32; ++j) { const float d = v[j] - mu; q += d * d; }
    const float rstd = rsqrtf(wave_sum(q) * (1.f / D) + 1e-5f);
#pragma unroll
    for (int g = 0; g < 4; ++g) { const int c0 = g * 512 + lane * 8; f32x4 a, b;
#pragma unroll
      for (int j = 0; j < 4; ++j) { a[j] = (v[g * 8 + j] - mu) * rstd * p.ln2_g[c0 + j] + p.ln2_b[c0 + j]; b[j] = (v[g * 8 + 4 + j] - mu) * rstd * p.ln2_g[c0 + 4 + j] + p.ln2_b[c0 + 4 + j]; }
      *(f32x4*)(op + c0) = a; *(f32x4*)(op + c0 + 4) = b; }
  }
}

__global__ void __launch_bounds__(NT) k_mega(Params p_arg) {
#if defined(__HIP_DEVICE_COMPILE__)
  extern __shared__ __attribute__((aligned(16))) unsigned char lds_raw[];
  LAS unsigned char* lds = (LAS unsigned char*)lds_raw;
  float* smem = (float*)lds_raw;
  cooperative_groups::grid_group grid = cooperative_groups::this_grid();
#ifndef ONLY
#define ONLY -1
#endif
  typedef const __attribute__((address_space(4))) Params* KP;
  const KP pk = (KP)__builtin_amdgcn_kernarg_segment_ptr();
#ifndef DUP
#define DUP -1
#endif
#define RUN1(n, pass, call) do { if (ONLY < 0 || ONLY == n) { KP q_ = pk; asm volatile("" : "+s"(q_)); const Params p = *q_; const int dup_pass = pass; (void)dup_pass; call; } } while (0)
#define RUN(n, call) do { RUN1(n, 0, call); if (DUP == n) { grid.sync(); RUN1(n, 1, call); } } while (0)
  RUN(0, ph_convert(p)); grid.sync();
  RUN(1, ph_inproj(p, lds)); grid.sync();
  RUN(2, sd::ph_conv16(p)); grid.sync();
  RUN(3, ph_ssd_a(p, (char*)lds_raw, (char*)p.out)); RUN(4, ph_attn_mfma(p, (char*)lds_raw, p.meta + 8 + dup_pass)); grid.sync();
  RUN(5, ph_ssd_b(p, (char*)lds_raw, (const char*)p.out)); grid.sync();
  RUN(6, ph_outproj(p, lds)); grid.sync();
  RUN(7, ph_ln1(p)); grid.sync();
  RUN(8, ph_router(p, smem)); grid.sync();
  RUN(9, ph_route(p, lds)); grid.sync();
  RUN(10, ph_place(p, lds)); grid.sync();
  RUN(11, ph_gateup(p, lds)); grid.sync();
  RUN(12, ph_down(p, lds)); grid.sync();
  RUN(13, ph_combine(p));
#endif
}
}

extern "C" void kernel_launch(void* const* d_in, const int* in_sizes, int n_in, void* d_out, int out_size, void* d_ws, size_t ws_size, hipStream_t stream) {
  Params p{};
  const float* const* in = (const float* const*)d_in;
  p.x = in[0]; p.w_in = in[1]; p.conv_w = in[2]; p.conv_b = in[3]; p.dt_bias_f = in[4]; p.dt_bias_b = in[5]; p.a_log_f = in[6]; p.a_log_b = in[7];
  p.d_skip = in[8]; p.ssd_norm_w = in[9]; p.lq1 = in[10]; p.lk1 = in[11]; p.lq2 = in[12]; p.lk2 = in[13]; p.attn_norm_w = in[14]; p.w_out = in[15];
  p.ln1_g = in[16]; p.ln1_b = in[17]; p.w_router = in[18]; p.router_bias = in[19]; p.wg_e = in[20]; p.wu_e = in[21]; p.wd_e = in[22];
  p.wg_s = in[23]; p.wu_s = in[24]; p.wd_s = in[25]; p.ln2_g = in[26]; p.ln2_b = in[27];
  p.out = (float*)d_out;
  char* w = (char*)d_ws; size_t o = 0;
  auto take = [&](size_t bytes) { char* r = w + o; o += (bytes + 255) / 256 * 256; return r; };
  char* reg1 = w + o;
  p.xb = (bf16_t*)take((size_t)T * D * 2); p.WinT = (bf16_t*)take((size_t)NPROJ * D * 2); p.WoutT = (bf16_t*)take((size_t)D * D * 2);
  p.WguT = (bf16_t*)take((size_t)(NE + 1) * 1024 * D * 2); p.proj = (bf16_t*)take((size_t)T * PLD * 2); p.u = (bf16_t*)take((size_t)T * D * 2);
  const size_t reg1_bytes = (size_t)((w + o) - reg1);
  p.Y = (bf16_t*)reg1;
  if ((size_t)MAXROWS_R * D * 2 > reg1_bytes) { fprintf(stderr, "kernel_launch: region 1 too small for Y\n"); return; }
  char* reg2 = take((size_t)MAXROWS * DE * 2);
  p.H = (bf16_t*)reg2; p.xc16 = (bf16_t*)reg2;
  p.h1b = (bf16_t*)take((size_t)T * D * 2); p.WdT = (bf16_t*)take((size_t)(NE + 1) * D * DE * 2);
  p.dt = (float*)take((size_t)T * 32 * 4); p.logits = (float*)take((size_t)T * NE * 4); p.gate = (float*)take((size_t)T * 8 * 4);
  p.assign = (int*)take((size_t)T * 8 * 4); p.pos = (int*)take((size_t)T * 8 * 4); p.blkcnt = (int*)take((size_t)(T / 64) * NE * 4);
  p.row_tok = (int*)take((size_t)MAXROWS * 4); p.row_gate = (float*)take((size_t)MAXROWS * 4); p.tile_exp = (int*)take((size_t)MAXTILES * 4); p.meta = (int*)take(256);
  p.h1 = (float*)d_out;
  if (o > ws_size) { fprintf(stderr, "kernel_launch: ws too small: need %zu have %zu\n", o, ws_size); return; }
  static int grid_blocks = 0;
  if (!grid_blocks) {
    int dev = 0, cus = 0, per_cu = 0;
    hipGetDevice(&dev);
    hipDeviceGetAttribute(&cus, hipDeviceAttributeMultiprocessorCount, dev);
    if (hipFuncSetAttribute((const void*)k_mega, hipFuncAttributeMaxDynamicSharedMemorySize, LDS_BYTES) != hipSuccess) { fprintf(stderr, "kernel_launch: hipFuncSetAttribute failed\n"); return; }
    hipOccupancyMaxActiveBlocksPerMultiprocessor(&per_cu, k_mega, NT, LDS_BYTES);
    if (per_cu < 1) { fprintf(stderr, "kernel_launch: occupancy query says 0 blocks/CU\n"); return; }
    grid_blocks = cus;
  }
  void* args[] = {&p};
  hipError_t e = hipLaunchCooperativeKernel((void*)k_mega, dim3(grid_blocks), dim3(NT), args, LDS_BYTES, stream);
  if (e != hipSuccess) fprintf(stderr, "cooperative launch failed: %s (grid %d)\n", hipGetErrorString(e), grid_blocks);
}
```

```cpp
#include <hip/hip_runtime.h>
#include <hip/hip_cooperative_groups.h>
#include <cstdio>
#include <cstdint>

namespace {
constexpr int D = 2048, NB = 8, S = 2048, T = NB * S;
constexpr int DSSD = 1024, DATT = 1024, NH = 16, HD = 64, NS = 128, CC = 1536;
constexpr int AH = 8, NE = 64, DE = 512, PW = 5664;
constexpr int O_DT = 2560, O_Q = 2592;
constexpr int N_Z = 0, N_XBC = 1024, N_Q = 2560, N_K = 3584, N_V = 4608, PLD = 5632, NPROJ = 5888;
constexpr float ALPHA = 1.189207115002721f;
constexpr float LAMBDA_INIT = 0.2f;
constexpr float LOG2E = 1.4426950408889634f;
constexpr float QS = 0.125f * LOG2E;
constexpr int NT = 512;
constexpr int LDS_BYTES = 152 * 1024;
constexpr int LDS_TAB = 128 * 1024;
constexpr int MAXROWS_R = NE * 256 + T * 8;
constexpr int MAXROWS = MAXROWS_R + T;
constexpr int MAXTILES = MAXROWS / 256;

typedef unsigned short bf16_t;

struct Params {
  const float *x, *w_in, *conv_w, *conv_b, *dt_bias_f, *dt_bias_b, *a_log_f, *a_log_b, *d_skip, *ssd_norm_w;
  const float *lq1, *lk1, *lq2, *lk2, *attn_norm_w, *w_out, *ln1_g, *ln1_b, *w_router, *router_bias;
  const float *wg_e, *wu_e, *wd_e, *wg_s, *wu_s, *wd_s, *ln2_g, *ln2_b;
  float* out;
  bf16_t *xb, *WinT, *WoutT, *WguT, *WdT, *proj, *u, *h1b, *H, *Y, *xc16, *WrT;
  float *dt, *h1, *gate, *row_gate;
  int *assign, *blkcnt, *row_tok, *pos, *tile_exp, *meta;
};

__device__ __forceinline__ float silu_f(float x) { return x / (1.f + __expf(-x)); }
__device__ __forceinline__ float softplus_f(float x) { return x > 20.f ? x : log1pf(__expf(x)); }
__device__ __forceinline__ float wave_sum(float v) { for (int o = 32; o >= 1; o >>= 1) v += __shfl_xor(v, o); return v; }
__device__ __forceinline__ float bf2f(bf16_t b) { return __uint_as_float(((unsigned)b) << 16); }
__device__ __forceinline__ bf16_t f2bf(float f) { unsigned u = __float_as_uint(f); u += 0x7FFFu + ((u >> 16) & 1u); return (bf16_t)(u >> 16); }
}

namespace pg8 {
#define PG8_LAS __attribute__((address_space(3)))
typedef unsigned short bf16_t;
typedef short bf16x8 __attribute__((ext_vector_type(8)));
typedef float f32x4 __attribute__((ext_vector_type(4)));
typedef unsigned u32x4 __attribute__((ext_vector_type(4)));
constexpr int BM = 256, BK = 64, HALF = 128, HTB = HALF * BK * 2  , STAGE_BYTES = 8 * HTB, NXCD = 8, WGM = 8;

__host__ __device__ __forceinline__ int lds_byte(int r, int c) { const int st = (r >> 4) * 2 + (c >> 5), rr = r & 15, cc = c & 31, ob = rr * 64 + cc * 2; return st * 1024 + (ob ^ (((ob >> 9) & 1) << 5)); }
__host__ __device__ __forceinline__ void stage_rc(int b, int& R, int& C) { const int st = b / 1024, sb = b % 1024, swz = sb ^ (((sb >> 9) & 1) << 5); R = (st >> 1) * 16 + swz / 64; C = (st & 1) * 32 + (swz % 64) / 2; }
__host__ __device__ __forceinline__ int perm32(int rho) { const int n = rho >> 4, i = rho & 15; return 8 * (i >> 2) + 4 * n + (i & 3); }

struct Unit { int pm, pn, bn, aux; };
struct Gemm { const bf16_t* A; const bf16_t* Bt; int K; };


__device__ __forceinline__ unsigned cvt_pk_bf16(float lo, float hi) { unsigned r; asm volatile("v_cvt_pk_bf16_f32 %0, %1, %2" : "=v"(r) : "v"(lo), "v"(hi)); return r; }
struct OrderStatic {
    int nM, nN, nwg, G, c;
    __device__ void init(int M, int N, int G_, int c_) { nM = M / BM; nN = N / BM; nwg = nM * nN; G = G_; c = c_; }
    __device__ bool next(int i, Unit& u) const {
        const long L = (long)i * G + c; if (L >= nwg) return false;
        int wgid = (int)L; { const int q = nwg / NXCD, r = nwg % NXCD, xcd = wgid % NXCD, off = wgid / NXCD; wgid = (xcd < r ? xcd * (q + 1) : r * (q + 1) + (xcd - r) * q) + off; }
        const int nig = WGM * nN, gid = wgid / nig, fm = gid * WGM, gsz = (nM - fm) < WGM ? (nM - fm) : WGM;
        u.pm = fm + ((wgid % nig) % gsz); u.pn = (wgid % nig) / gsz; u.bn = u.pn; u.aux = i; return true;
    }
    __device__ __forceinline__ unsigned row_off(int, int) const { return 0u; }
};
template <bool GATHER, class Epi, class Sched>
__device__ __forceinline__ void gemm_phase(PG8_LAS unsigned char* lds, const Gemm g, const Sched& S, const Epi& E) {
    int tid = threadIdx.x; asm volatile("" : "+v"(tid));
    const int wid = __builtin_amdgcn_readfirstlane(tid >> 6), lane = tid & 63, wr = wid >> 2, wc = wid & 3, fr = lane & 15, fq = lane >> 4;
    const int K = g.K, nt = K / BK;
#define PG8_STAMP() do {} while (0)
    PG8_STAMP();
    unsigned voffA[2], voffB[2];
#pragma unroll
    for (int i = 0; i < 2; ++i) { int R, C; stage_rc(tid * 16 + i * 8192, R, C); const int Rb = Epi::PERM ? ((R & ~31) + perm32(R & 31)) : R;
        voffA[i] = (unsigned)(R * K + C) * 2u; voffB[i] = (unsigned)(Rb * K + C) * 2u; }
    unsigned voffG[2][2] = {{0u, 0u}, {0u, 0u}};
#define PG8_LOADG(uidx) do { if constexpr (GATHER) { _Pragma("unroll") for (int _h = 0; _h < 2; ++_h) _Pragma("unroll") for (int _i = 0; _i < 2; ++_i) { int R_, C_; stage_rc(tid * 16 + _i * 8192, R_, C_); \
        voffG[_h][_i] = S.row_off((uidx), _h * HALF + R_) + (unsigned)C_ * 2u; } } } while (0)
    const size_t kstep = (size_t)(BK * 2);
    const size_t hstep = (size_t)HALF * K * 2;
    const size_t tstep = 2 * hstep;
    const unsigned ldsw = (unsigned)wid * 1024u;
    const int aoff = lds_byte(wr * 64 + fr, fq * 8), boff = lds_byte(wc * 32 + fr, fq * 8);
#define PG8_SA(b, h) (((b) * 2 + (h)) * HTB)
#define PG8_SB(b, h) ((4 + (b) * 2 + (h)) * HTB)
#define PG8_STAGE(bufoff, gbase, voff) do { _Pragma("unroll") for (int _i = 0; _i < 2; ++_i) \
        __builtin_amdgcn_global_load_lds((const unsigned*)((const char*)(gbase) + (voff)[_i]), (PG8_LAS unsigned*)(lds + (bufoff) + ldsw + _i * 8192), 16, 0, 0); } while (0)
#define PG8_STAGE_A(bufoff, ptr, h) do { if constexpr (GATHER) { PG8_STAGE(bufoff, ptr, voffG[h]); } else { PG8_STAGE(bufoff, (ptr) + (h) * hstep, voffA); } } while (0)
#define PG8_LDA(dst, b, h) do { _Pragma("unroll") for (int m = 0; m < 4; ++m) _Pragma("unroll") for (int k = 0; k < 2; ++k) dst[m][k] = *(const PG8_LAS bf16x8*)(lds + PG8_SA(b, h) + aoff + m * 2048 + k * 1024); } while (0)
#define PG8_LDB(dst, b, h) do { _Pragma("unroll") for (int n = 0; n < 2; ++n) _Pragma("unroll") for (int k = 0; k < 2; ++k) dst[n][k] = *(const PG8_LAS bf16x8*)(lds + PG8_SB(b, h) + boff + n * 2048 + k * 1024); } while (0)
#define PG8_MMA(ai, bj, At, Bt) do { __builtin_amdgcn_s_setprio(1); _Pragma("unroll") for (int m = 0; m < 4; ++m) _Pragma("unroll") for (int n = 0; n < 2; ++n) _Pragma("unroll") for (int k = 0; k < 2; ++k) \
        acc[ai][bj][m][n] = __builtin_amdgcn_mfma_f32_16x16x32_bf16(Bt[n][k], At[m][k], acc[ai][bj][m][n], 0, 0, 0); __builtin_amdgcn_s_setprio(0); } while (0)
#define PG8_WAIT_V(n) asm volatile("s_waitcnt vmcnt(" #n ")" ::: "memory")
#define PG8_WAIT_L(n) asm volatile("s_waitcnt lgkmcnt(" #n ")" ::: "memory")
#define PG8_BAR __builtin_amdgcn_s_barrier()
#define PG8_SCHED __builtin_amdgcn_sched_barrier(0)
    Unit cur, nxt; int ui = 0;
    if (!S.next(0, cur)) return;
    f32x4 acc[2][2][4][2];
#pragma unroll
    for (int a = 0; a < 2; ++a)
#pragma unroll
        for (int b = 0; b < 2; ++b)
#pragma unroll
            for (int m = 0; m < 4; ++m)
#pragma unroll
                for (int n = 0; n < 2; ++n) acc[a][b][m][n] = (f32x4){0.f, 0.f, 0.f, 0.f};
    bf16x8 At[4][2], B0[2][2], B1[2][2];
    const char* cA = GATHER ? (const char*)g.A : (const char*)g.A + (size_t)cur.pm * tstep; const char* cB = (const char*)g.Bt + (size_t)cur.bn * tstep;
    PG8_LOADG(0);
    PG8_STAGE(PG8_SB(0, 0), cB, voffB); PG8_STAGE_A(PG8_SA(0, 0), cA, 0); PG8_STAGE(PG8_SB(0, 1), cB + hstep, voffB); PG8_STAGE_A(PG8_SA(0, 1), cA, 1);
    if (wr == 1) PG8_BAR;
    PG8_WAIT_V(4); PG8_BAR;
    PG8_STAGE(PG8_SB(1, 0), cB + kstep, voffB); PG8_STAGE_A(PG8_SA(1, 0), cA + kstep, 0); PG8_STAGE(PG8_SB(1, 1), cB + hstep + kstep, voffB);
    PG8_WAIT_V(6); PG8_BAR;
    PG8_STAMP();
    for (;;) {
        const bool has_next = S.next(ui + 1, nxt);
        const char* nA = has_next ? (GATHER ? (const char*)g.A : (const char*)g.A + (size_t)nxt.pm * tstep) : cA; const char* nB = has_next ? (const char*)g.Bt + (size_t)nxt.bn * tstep : cB;
        for (int t = 0; t < nt; t += 2) {
            const bool last = (t == nt - 2);
            const char* a1 = cA + (size_t)(t + 1) * kstep;
            const char* a2 = last ? nA : cA + (size_t)(t + 2) * kstep; const char* b2 = last ? nB : cB + (size_t)(t + 2) * kstep;
            const char* a3 = a2 + kstep; const char* b3 = b2 + kstep;
            PG8_LDB(B0, 0, 0); PG8_SCHED; PG8_LDA(At, 0, 0); PG8_STAGE_A(PG8_SA(1, 1), a1, 1);
            PG8_WAIT_L(8); PG8_BAR; PG8_WAIT_L(0); PG8_MMA(0, 0, At, B0); PG8_BAR; PG8_SCHED;
            if (last && has_next) PG8_LOADG(ui + 1);
            PG8_LDB(B1, 0, 1); PG8_STAGE(PG8_SB(0, 0), b2, voffB);
            PG8_BAR; PG8_WAIT_L(0); PG8_MMA(0, 1, At, B1); PG8_BAR;
            PG8_LDA(At, 0, 1); PG8_STAGE_A(PG8_SA(0, 0), a2, 0);
            PG8_BAR; PG8_WAIT_L(0); PG8_MMA(1, 0, At, B0); PG8_BAR; PG8_SCHED;
            PG8_STAGE(PG8_SB(0, 1), b2 + hstep, voffB);
            PG8_WAIT_V(6); PG8_BAR; PG8_MMA(1, 1, At, B1); PG8_BAR;
            PG8_LDB(B0, 1, 0); PG8_SCHED; PG8_LDA(At, 1, 0); PG8_STAGE_A(PG8_SA(0, 1), a2, 1);
            PG8_WAIT_L(8); PG8_BAR; PG8_WAIT_L(0); PG8_MMA(0, 0, At, B0); PG8_BAR; PG8_SCHED;
            PG8_LDB(B1, 1, 1); PG8_STAGE(PG8_SB(1, 0), b3, voffB);
            PG8_BAR; PG8_WAIT_L(0); PG8_MMA(0, 1, At, B1); PG8_BAR;
            PG8_LDA(At, 1, 1); PG8_STAGE_A(PG8_SA(1, 0), a3, 0);
            PG8_BAR; PG8_WAIT_L(0); PG8_MMA(1, 0, At, B0); PG8_BAR; PG8_SCHED;
            PG8_STAGE(PG8_SB(1, 1), b3 + hstep, voffB);
            PG8_WAIT_V(6); PG8_BAR; PG8_MMA(1, 1, At, B1); PG8_BAR;
        }
        PG8_STAMP();
        E(acc, cur, wr, wc, fr, fq);
        PG8_STAMP();
        if (!has_next) break;
#pragma unroll
        for (int a = 0; a < 2; ++a)
#pragma unroll
            for (int b = 0; b < 2; ++b)
#pragma unroll
                for (int m = 0; m < 4; ++m)
#pragma unroll
                    for (int n = 0; n < 2; ++n) acc[a][b][m][n] = (f32x4){0.f, 0.f, 0.f, 0.f};
        cur = nxt; cA = nA; cB = nB; ++ui;
    }
    PG8_WAIT_V(0);
    if (wr == 0) PG8_BAR;
    PG8_BAR;
    PG8_STAMP();
#undef PG8_STAMP
#undef PG8_SA
#undef PG8_SB
#undef PG8_STAGE
#undef PG8_STAGE_A
#undef PG8_LOADG
#undef PG8_LDA
#undef PG8_LDB
#undef PG8_MMA
#undef PG8_WAIT_V
#undef PG8_WAIT_L
#undef PG8_BAR
#undef PG8_SCHED
}
}
namespace {
using pg8::f32x4; using pg8::u32x4; using pg8::cvt_pk_bf16;
#define LAS __attribute__((address_space(3)))

template <class ARow, class Epi>
__device__ __forceinline__ void gemm_tile(float* smem, int mvalid, int nvalid, int K, ARow arow, const float* Bp, int ldb, Epi epi) {
  float* As = smem;
  float* Bs = smem + 16 * 68;
  const int tid = threadIdx.x, ty = tid >> 5, tx = tid & 31;
  float acc[4][4];
#pragma unroll
  for (int i = 0; i < 4; ++i)
#pragma unroll
    for (int j = 0; j < 4; ++j) acc[i][j] = 0.f;
  const int ak = tid & 15, ar = tid >> 4;
  const float* ap0 = (ar < mvalid) ? arow(ar) : nullptr;
  const float* ap1 = (ar + 32 < mvalid) ? arow(ar + 32) : nullptr;
  const int bn = tid & 127, bk = tid >> 7;
  for (int k0 = 0; k0 < K; k0 += 16) {
    As[ak * 68 + ar] = ap0 ? ap0[k0 + ak] : 0.f;
    As[ak * 68 + ar + 32] = ap1 ? ap1[k0 + ak] : 0.f;
#pragma unroll
    for (int i = 0; i < 4; ++i) { const int kk = bk + 4 * i; Bs[kk * 128 + bn] = (bn < nvalid) ? Bp[(size_t)(k0 + kk) * ldb + bn] : 0.f; }
    __syncthreads();
#pragma unroll
    for (int kk = 0; kk < 16; ++kk) {
      float a[4], b[4];
#pragma unroll
      for (int i = 0; i < 4; ++i) a[i] = As[kk * 68 + ty * 4 + i];
#pragma unroll
      for (int j = 0; j < 4; ++j) b[j] = Bs[kk * 128 + tx * 4 + j];
#pragma unroll
      for (int i = 0; i < 4; ++i)
#pragma unroll
        for (int j = 0; j < 4; ++j) acc[i][j] += a[i] * b[j];
    }
    __syncthreads();
  }
#pragma unroll
  for (int i = 0; i < 4; ++i)
#pragma unroll
    for (int j = 0; j < 4; ++j) { const int r = ty * 4 + i, c = tx * 4 + j; if (r < mvalid && c < nvalid) epi(r, c, acc[i][j]); }
}

template <class RowMap>
__device__ __forceinline__ void cvt_tile(const float* __restrict__ src, int N, int K, int k0, int n0, bf16_t* __restrict__ dst, RowMap rm) {
  const int lane = threadIdx.x & 63, w = threadIdx.x >> 6;
  const int n = n0 + (lane & 15) * 4, kk = k0 + (w * 4 + (lane >> 4)) * 8;
  if (n >= N) return;
  float4 v[8];
#pragma unroll
  for (int j = 0; j < 8; ++j) v[j] = *(const float4*)(src + (size_t)(kk + j) * N + n);
  u32x4 o;
  o.x = cvt_pk_bf16(v[0].x, v[1].x); o.y = cvt_pk_bf16(v[2].x, v[3].x); o.z = cvt_pk_bf16(v[4].x, v[5].x); o.w = cvt_pk_bf16(v[6].x, v[7].x);
  *(u32x4*)(dst + (size_t)rm(n + 0) * K + kk) = o;
  o.x = cvt_pk_bf16(v[0].y, v[1].y); o.y = cvt_pk_bf16(v[2].y, v[3].y); o.z = cvt_pk_bf16(v[4].y, v[5].y); o.w = cvt_pk_bf16(v[6].y, v[7].y);
  *(u32x4*)(dst + (size_t)rm(n + 1) * K + kk) = o;
  o.x = cvt_pk_bf16(v[0].z, v[1].z); o.y = cvt_pk_bf16(v[2].z, v[3].z); o.z = cvt_pk_bf16(v[4].z, v[5].z); o.w = cvt_pk_bf16(v[6].z, v[7].z);
  *(u32x4*)(dst + (size_t)rm(n + 2) * K + kk) = o;
  o.x = cvt_pk_bf16(v[0].w, v[1].w); o.y = cvt_pk_bf16(v[2].w, v[3].w); o.z = cvt_pk_bf16(v[4].w, v[5].w); o.w = cvt_pk_bf16(v[6].w, v[7].w);
  *(u32x4*)(dst + (size_t)rm(n + 3) * K + kk) = o;
}
template <class RowMap>
__device__ void cvt_job(const float* src, int nmat, int K, int N, bf16_t* dst, size_t dstride, RowMap rm) {
  const int kt = K / 256, ntl = (N + 63) / 64, per = kt * ntl;
  for (int it = blockIdx.x; it < nmat * per; it += gridDim.x) {
    const int m = it / per, r = it % per, k0 = (r / ntl) * 256, n0 = (r % ntl) * 64;
    cvt_tile(src + (size_t)m * K * N, N, K, k0, n0, dst + (size_t)m * dstride, rm);
  }
}
__device__ void ph_convert(const Params& p) {
  const size_t gtid = (size_t)blockIdx.x * NT + threadIdx.x, gsz = (size_t)gridDim.x * NT;
  if (gtid < 64) p.meta[gtid] = 0;
  for (size_t i = gtid; i < (size_t)T * D / 8; i += gsz) {
    const float4 a = *(const float4*)(p.x + i * 8), b = *(const float4*)(p.x + i * 8 + 4);
    u32x4 o; o.x = cvt_pk_bf16(a.x, a.y); o.y = cvt_pk_bf16(a.z, a.w); o.z = cvt_pk_bf16(b.x, b.y); o.w = cvt_pk_bf16(b.z, b.w);
    *(u32x4*)(p.xb + i * 8) = o;
  }
  cvt_job(p.w_in, 1, D, PW, p.WinT, 0, [](int n) { return n < O_DT ? n : (n < O_Q ? PLD + (n - O_DT) : n - 32); });
  for (size_t i = gtid; i < (size_t)(NPROJ - PW) * D / 8; i += gsz) *(u32x4*)(p.WinT + (size_t)PW * D + i * 8) = (u32x4){0u, 0u, 0u, 0u};
  cvt_job(p.w_out, 1, D, D, p.WoutT, 0, [](int n) { return n; });
  cvt_job(p.wg_e, NE, D, DE, p.WguT, (size_t)1024 * D, [](int n) { return (n >> 7) * 256 + (n & 127); });
  cvt_job(p.wu_e, NE, D, DE, p.WguT, (size_t)1024 * D, [](int n) { return (n >> 7) * 256 + 128 + (n & 127); });
  cvt_job(p.wg_s, 1, D, DE, p.WguT + (size_t)NE * 1024 * D, 0, [](int n) { return (n >> 7) * 256 + (n & 127); });
  cvt_job(p.wu_s, 1, D, DE, p.WguT + (size_t)NE * 1024 * D, 0, [](int n) { return (n >> 7) * 256 + 128 + (n & 127); });
  cvt_job(p.w_router, 1, D, NE, p.WrT, 0, [](int n) { return n; });
  cvt_job(p.wd_e, NE, DE, D, p.WdT, (size_t)D * DE, [](int n) { return n; });
  cvt_job(p.wd_s, 1, DE, D, p.WdT + (size_t)NE * D * DE, 0, [](int n) { return n; });
}

struct EpiProj {
  static constexpr bool PERM = true;
  bf16_t* proj; float* dt; const float* bias_f; const float* bias_b;
  __device__ __forceinline__ void operator()(const f32x4 (&acc)[2][2][4][2], const pg8::Unit& u, int wr, int wc, int fr, int fq) const {
    const int row0 = u.pm * 256 + wr * 64 + fr;
    if (u.pn < 22) {
      const int col0 = u.pn * 256 + wc * 32 + 8 * fq;
      const float sc = (u.pn >= 10 && u.pn < 14) ? QS : 1.0f;
#pragma unroll
      for (int ai = 0; ai < 2; ++ai)
#pragma unroll
        for (int m = 0; m < 4; ++m) { bf16_t* rowp = proj + (size_t)(row0 + ai * 128 + m * 16) * PLD + col0;
#pragma unroll
          for (int bj = 0; bj < 2; ++bj) { const f32x4 v0 = acc[ai][bj][m][0] * sc, v1 = acc[ai][bj][m][1] * sc;
            u32x4 w; w.x = cvt_pk_bf16(v0[0], v0[1]); w.y = cvt_pk_bf16(v0[2], v0[3]); w.z = cvt_pk_bf16(v1[0], v1[1]); w.w = cvt_pk_bf16(v1[2], v1[3]);
            *(u32x4*)(rowp + bj * 128) = w; } }
    } else if (wc == 0) {
      const int c0 = 8 * fq;
      float bs[8];
#pragma unroll
      for (int j = 0; j < 8; ++j) bs[j] = (c0 + j) < 16 ? bias_f[c0 + j] : bias_b[c0 + j - 16];
#pragma unroll
      for (int ai = 0; ai < 2; ++ai)
#pragma unroll
        for (int m = 0; m < 4; ++m) { float* rowp = dt + (size_t)(row0 + ai * 128 + m * 16) * 32 + c0;
          const f32x4 v0 = acc[ai][0][m][0], v1 = acc[ai][0][m][1];
          f32x4 o0, o1;
#pragma unroll
          for (int j = 0; j < 4; ++j) { o0[j] = softplus_f(v0[j] + bs[j]); o1[j] = softplus_f(v1[j] + bs[4 + j]); }
          *(f32x4*)rowp = o0; *(f32x4*)(rowp + 4) = o1; }
    }
  }
};
struct EpiOut {
  static constexpr bool PERM = false;
  const float* x; float* v;
  __device__ __forceinline__ void operator()(const f32x4 (&acc)[2][2][4][2], const pg8::Unit& u, int wr, int wc, int fr, int fq) const {
    const int row0 = u.pm * 256 + wr * 64 + fr, col0 = u.pn * 256 + wc * 32 + 4 * fq;
#pragma unroll
    for (int ai = 0; ai < 2; ++ai)
#pragma unroll
      for (int m = 0; m < 4; ++m) { const size_t off = (size_t)(row0 + ai * 128 + m * 16) * D + col0;
#pragma unroll
        for (int bj = 0; bj < 2; ++bj)
#pragma unroll
          for (int n = 0; n < 2; ++n) { const f32x4 xv = *(const f32x4*)(x + off + bj * 128 + n * 16); *(f32x4*)(v + off + bj * 128 + n * 16) = xv * ALPHA + acc[ai][bj][m][n]; } }
  }
};

namespace at {
using bf16x8 = __attribute__((ext_vector_type(8))) short;
using s16x4  = __attribute__((ext_vector_type(4))) short;
using f32x16 = __attribute__((ext_vector_type(16))) float;
using u32x4  = __attribute__((ext_vector_type(4))) unsigned;
constexpr int KVBLK = 64;
constexpr size_t SHM_V = KVBLK * 128 * 2, SHM_K = KVBLK * 128 * 2;
constexpr float THR2 = 8.0f;
#define AT_KSWZ(row, colB) ((row) * 256 + ((colB) ^ (((row) & 7) << 4)))
#define AT_SBAR() __builtin_amdgcn_sched_barrier(0)
__device__ __forceinline__ int crow(int r, int hi) { return (r & 3) + 8 * (r >> 2) + 4 * hi; }
__device__ __forceinline__ unsigned cvtpk(float lo, float hi) { unsigned r; asm volatile("v_cvt_pk_bf16_f32 %0, %1, %2" : "=v"(r) : "v"(lo), "v"(hi)); return r; }

__device__ __forceinline__ void partialSM(f32x16& p0, f32x16& p1, float dqh, float nsl2, float& m_reg, float& mn, float& alpha) {
#pragma unroll
  for (int r = 0; r < 16; ++r) { const float c = (float)((r & 3) + 8 * (r >> 2));
    p0[r] = fmaf(nsl2, fabsf(dqh - c), p0[r]); p1[r] = fmaf(nsl2, fabsf(dqh - (c + 32.f)), p1[r]); }
  float pmax = p0[0];
#pragma unroll
  for (int r = 1; r < 16; ++r) pmax = fmaxf(pmax, p0[r]);
#pragma unroll
  for (int r = 0; r < 16; ++r) pmax = fmaxf(pmax, p1[r]);
  { auto rr = __builtin_amdgcn_permlane32_swap(__float_as_uint(pmax), __float_as_uint(pmax), false, false);
    pmax = fmaxf(__uint_as_float(rr[0]), __uint_as_float(rr[1])); }
  if (__builtin_expect(__all(pmax - m_reg <= THR2), 1)) { mn = m_reg; alpha = 1.f; }
  else { mn = fmaxf(m_reg, pmax); alpha = __builtin_amdgcn_exp2f(m_reg - mn); m_reg = mn; }
#pragma unroll
  for (int r = 0; r < 16; ++r) p0[r] = p0[r] - mn;
#pragma unroll
  for (int r = 0; r < 16; ++r) p1[r] = p1[r] - mn;
#pragma unroll
  for (int r = 0; r < 16; ++r) p0[r] = __builtin_amdgcn_exp2f(p0[r]);
}
__device__ __forceinline__ void finishSM(f32x16& p0, f32x16& p1, float alpha, float& l_reg, bf16x8& pa0, bf16x8& pa1, bf16x8& pa2, bf16x8& pa3) {
#pragma unroll
  for (int r = 0; r < 16; ++r) p1[r] = __builtin_amdgcn_exp2f(p1[r]);
  float ps = 0;
#pragma unroll
  for (int r = 0; r < 16; ++r) ps += p0[r];
#pragma unroll
  for (int r = 0; r < 16; ++r) ps += p1[r];
  { auto rr = __builtin_amdgcn_permlane32_swap(__float_as_uint(ps), __float_as_uint(ps), false, false);
    ps = __uint_as_float(rr[0]) + __uint_as_float(rr[1]); }
  l_reg = l_reg * alpha + ps;
#define AT_PK4(P, BASE, OUT) do { unsigned a0 = cvtpk(P[BASE + 0], P[BASE + 1]), a1 = cvtpk(P[BASE + 2], P[BASE + 3]);   \
    unsigned b0 = cvtpk(P[BASE + 4], P[BASE + 5]), b1 = cvtpk(P[BASE + 6], P[BASE + 7]);                              \
    auto r0 = __builtin_amdgcn_permlane32_swap(a0, b0, false, false); auto r1 = __builtin_amdgcn_permlane32_swap(a1, b1, false, false); \
    u32x4 w = {r0[0], r1[0], r0[1], r1[1]}; OUT = *reinterpret_cast<bf16x8*>(&w); } while (0)
  AT_PK4(p0, 0, pa0); AT_PK4(p0, 8, pa1); AT_PK4(p1, 0, pa2); AT_PK4(p1, 8, pa3);
#undef AT_PK4
}
__device__ __forceinline__ void qkt(f32x16& p0, f32x16& p1, const char* Ks, const bf16x8* qr, int r32, int hi, int cm) {
  p0 = f32x16{}; p1 = f32x16{};
#pragma unroll
  for (int d0 = 0; d0 < 4; ++d0) { const int cb = (cm + d0 * 16 + hi * 8) * 2;
    bf16x8 b0 = *reinterpret_cast<const bf16x8*>(Ks + AT_KSWZ(r32, cb));
    bf16x8 b1 = *reinterpret_cast<const bf16x8*>(Ks + AT_KSWZ(32 + r32, cb));
    p0 = __builtin_amdgcn_mfma_f32_32x32x16_bf16(b0, qr[d0], p0, 0, 0, 0);
    p1 = __builtin_amdgcn_mfma_f32_32x32x16_bf16(b1, qr[d0], p1, 0, 0, 0); }
}
__device__ __forceinline__ int v_st(int k, int c) { const int kk = (k & ~0xC) | ((k & 4) << 1) | ((k & 8) >> 1); return ((kk >> 3) * 4 + (c >> 5)) * 512 + ((kk & 7) * 32 + (c & 31)) * 2; }
__device__ __forceinline__ int v_rd_base(int lane) { return ((lane & 3) << 3) | (((lane >> 2) & 3) << 6) | (((lane >> 4) & 1) << 5) | (((lane >> 5) & 1) << 8); }
constexpr int v_rd_off(int d0, int ks, int half) { return d0 * 512 + ks * 4096 + half * 2048; }
template <int OFF> __device__ __forceinline__ s16x4 tr_read(int vb) {
  s16x4 r; asm volatile("ds_read_b64_tr_b16 %0, %1 offset:%2" : "=&v"(r) : "v"(vb), "i"(OFF) : "memory"); return r;
}
template <int D0> __device__ __forceinline__ void pv_one(f32x16& od, int vb, bf16x8 pa0, bf16x8 pa1, bf16x8 pa2, bf16x8 pa3) {
  const s16x4 l0 = tr_read<v_rd_off(D0, 0, 0)>(vb), h0 = tr_read<v_rd_off(D0, 0, 1)>(vb), l1 = tr_read<v_rd_off(D0, 1, 0)>(vb), h1 = tr_read<v_rd_off(D0, 1, 1)>(vb);
  const s16x4 l2 = tr_read<v_rd_off(D0, 2, 0)>(vb), h2 = tr_read<v_rd_off(D0, 2, 1)>(vb), l3 = tr_read<v_rd_off(D0, 3, 0)>(vb), h3 = tr_read<v_rd_off(D0, 3, 1)>(vb);
  asm volatile("s_waitcnt lgkmcnt(0)" ::: "memory"); AT_SBAR();
#define AT_PK(L, H) (bf16x8){L[0], L[1], L[2], L[3], H[0], H[1], H[2], H[3]}
  od = __builtin_amdgcn_mfma_f32_32x32x16_bf16(pa0, AT_PK(l0, h0), od, 0, 0, 0);
  od = __builtin_amdgcn_mfma_f32_32x32x16_bf16(pa1, AT_PK(l1, h1), od, 0, 0, 0);
  od = __builtin_amdgcn_mfma_f32_32x32x16_bf16(pa2, AT_PK(l2, h2), od, 0, 0, 0);
  od = __builtin_amdgcn_mfma_f32_32x32x16_bf16(pa3, AT_PK(l3, h3), od, 0, 0, 0);
#undef AT_PK
}
__device__ __forceinline__ void pv_d0(f32x16* o, int vb, bf16x8 pa0, bf16x8 pa1, bf16x8 pa2, bf16x8 pa3) {
  pv_one<0>(o[0], vb, pa0, pa1, pa2, pa3); pv_one<1>(o[1], vb, pa0, pa1, pa2, pa3); pv_one<2>(o[2], vb, pa0, pa1, pa2, pa3); pv_one<3>(o[3], vb, pa0, pa1, pa2, pa3);
}

__device__ __forceinline__ void attn_item(const bf16_t* __restrict__ Qb, const bf16_t* __restrict__ Kh, const bf16_t* __restrict__ Vh, bf16_t* __restrict__ Ub,
                                          int q0, float nsl2, float lam, const float* __restrict__ normw, char* lds) {
  constexpr int LDK = PLD;
  int tid = threadIdx.x; asm volatile("" : "+v"(tid));
  const int wid = tid >> 6, lane = tid & 63, r32 = lane & 31, hi = lane >> 5, rg = wid >> 1, cmap = wid & 1, cm = cmap * 64;
  char* V_lds = lds; char* K_lds = lds + 2 * SHM_V;
  float* ws = (float*)(lds + 2 * SHM_V + 2 * SHM_K) + wid * 64; float* li_l = ws; float* al_l = ws + 32;
  float m_reg = -1e30f, l_reg = 0; f32x16 o[4] = {}; bf16x8 qr[4];
  const bf16_t* Qw = Qb + (size_t)(rg * 32 + r32) * LDK + cm + hi * 8;
#pragma unroll
  for (int d0 = 0; d0 < 4; ++d0) qr[d0] = *reinterpret_cast<const bf16x8*>(Qw + d0 * 16);
  const int sr = tid >> 4, sc = (tid & 15) * 8, vst0 = v_st(sr, sc), vst1 = v_st(32 + sr, sc);
  const int vb0 = (int)(uintptr_t)V_lds + v_rd_base(lane);
  const float qposh = (float)(q0 + rg * 32 + r32 - 4 * hi);
  struct { bf16x8 vs0, vs1, ks0, ks1; } sr_[2];
#define SLOAD(i, k0) do { sr_[i].vs0 = *reinterpret_cast<const bf16x8*>(&Vh[(size_t)((k0) + sr) * LDK + sc]); sr_[i].vs1 = *reinterpret_cast<const bf16x8*>(&Vh[(size_t)((k0) + 32 + sr) * LDK + sc]); \
    sr_[i].ks0 = *reinterpret_cast<const bf16x8*>(&Kh[(size_t)((k0) + sr) * LDK + sc]); sr_[i].ks1 = *reinterpret_cast<const bf16x8*>(&Kh[(size_t)((k0) + 32 + sr) * LDK + sc]); } while (0)
#define SWRITE(b, i) do { *(bf16x8*)(V_lds + (b) * SHM_V + vst0) = sr_[i].vs0;          \
    *(bf16x8*)(V_lds + (b) * SHM_V + vst1) = sr_[i].vs1; int kc = sc * 2;               \
    *(bf16x8*)(K_lds + (b) * SHM_K + AT_KSWZ(sr, kc)) = sr_[i].ks0;                       \
    *(bf16x8*)(K_lds + (b) * SHM_K + AT_KSWZ(32 + sr, kc)) = sr_[i].ks1; } while (0)
#define SWAIT() asm volatile("s_waitcnt vmcnt(4)" ::: "memory")
#define RESC(a) do { if (__any((a) < 1.f)) { if (hi == 0) al_l[r32] = (a); asm volatile("s_waitcnt lgkmcnt(0)" ::: "memory"); \
    _Pragma("unroll") for (int d = 0; d < 4; ++d) _Pragma("unroll") for (int r = 0; r < 16; ++r) o[d][r] *= al_l[crow(r, hi)]; } } while (0)
  f32x16 pA0, pA1, pB0, pB1; float mnA, mnB, alA, alB; bf16x8 pa0, pa1, pa2, pa3; constexpr int NTL = S / KVBLK;
  constexpr int SE = 0, SO = 1;
  SLOAD(SE, 0); asm volatile("s_waitcnt vmcnt(0)" ::: "memory"); SWRITE(0, SE); __syncthreads();
  qkt(pA0, pA1, K_lds, qr, r32, hi, cm); partialSM(pA0, pA1, qposh, nsl2, m_reg, mnA, alA);
  SLOAD(SO, KVBLK); SLOAD(SE, 2 * KVBLK);
  SWAIT(); SWRITE(1, SO); __syncthreads();
  for (int j = 1; j + 1 < NTL; j += 2) {
    AT_SBAR(); qkt(pB0, pB1, K_lds + SHM_K, qr, r32, hi, cm);
    finishSM(pA0, pA1, alA, l_reg, pa0, pa1, pa2, pa3); AT_SBAR();
    SLOAD(SO, (j + 2) * KVBLK); AT_SBAR();
    pv_d0(o, vb0, pa0, pa1, pa2, pa3); partialSM(pB0, pB1, qposh - (float)(j * KVBLK), nsl2, m_reg, mnB, alB);
    __syncthreads(); SWAIT(); SWRITE(0, SE);
    RESC(alB); __syncthreads();
    AT_SBAR(); qkt(pA0, pA1, K_lds, qr, r32, hi, cm);
    finishSM(pB0, pB1, alB, l_reg, pa0, pa1, pa2, pa3); AT_SBAR();
    if (j + 3 < NTL) SLOAD(SE, (j + 3) * KVBLK); AT_SBAR();
    pv_d0(o, vb0 + (int)SHM_V, pa0, pa1, pa2, pa3); partialSM(pA0, pA1, qposh - (float)((j + 1) * KVBLK), nsl2, m_reg, mnA, alA);
    __syncthreads(); SWAIT(); SWRITE(1, SO);
    RESC(alA); __syncthreads();
  }
  AT_SBAR(); qkt(pB0, pB1, K_lds + SHM_K, qr, r32, hi, cm);
  finishSM(pA0, pA1, alA, l_reg, pa0, pa1, pa2, pa3); AT_SBAR();
  pv_d0(o, vb0, pa0, pa1, pa2, pa3); partialSM(pB0, pB1, qposh - (float)((NTL - 1) * KVBLK), nsl2, m_reg, mnB, alB);
  __syncthreads(); RESC(alB);
  finishSM(pB0, pB1, alB, l_reg, pa0, pa1, pa2, pa3); AT_SBAR();
  pv_d0(o, vb0 + (int)SHM_V, pa0, pa1, pa2, pa3);
  if (hi == 0) li_l[r32] = l_reg; asm volatile("s_waitcnt lgkmcnt(0)" ::: "memory");
  float rli[16];
#pragma unroll
  for (int r = 0; r < 16; ++r) rli[r] = __builtin_amdgcn_rcpf(li_l[crow(r, hi)]);
#pragma unroll
  for (int d = 0; d < 4; ++d)
#pragma unroll
    for (int r = 0; r < 16; ++r) o[d][r] *= rli[r];
  __syncthreads();
  float* X = (float*)lds + rg * (32 * 128);
  if (cmap == 1) {
#pragma unroll
    for (int d = 0; d < 4; ++d)
#pragma unroll
      for (int r = 0; r < 16; ++r) X[crow(r, hi) * 128 + d * 32 + r32] = o[d][r];
  }
  __syncthreads();
  if (cmap == 0) {
    float ss[16];
#pragma unroll
    for (int r = 0; r < 16; ++r) ss[r] = 0.f;
#pragma unroll
    for (int d = 0; d < 4; ++d)
#pragma unroll
      for (int r = 0; r < 16; ++r) { const float v = o[d][r] - lam * X[crow(r, hi) * 128 + d * 32 + r32]; o[d][r] = v; ss[r] += v * v; }
#pragma unroll
    for (int r = 0; r < 16; ++r) { float s = ss[r]; s += __shfl_xor(s, 16); s += __shfl_xor(s, 8); s += __shfl_xor(s, 4); s += __shfl_xor(s, 2); s += __shfl_xor(s, 1);
      ss[r] = rsqrtf(s * (1.f / 128.f) + 1e-5f) * (1.f - LAMBDA_INIT); }
    float nw[4];
#pragma unroll
    for (int d = 0; d < 4; ++d) nw[d] = normw[d * 32 + r32];
#pragma unroll
    for (int r = 0; r < 16; ++r) { bf16_t* up = Ub + (size_t)(rg * 32 + crow(r, hi)) * D + r32;
#pragma unroll
      for (int d = 0; d < 4; ++d) up[d * 32] = f2bf(o[d][r] * ss[r] * nw[d]); }
  }
  __syncthreads();
#undef SLOAD
#undef SWRITE
#undef SWAIT
#undef RESC
}
}

__device__ void ph_attn_mfma(const Params& p, char* lds, int* qhead) {
  float lam;
  { float s1 = 0.f, s2 = 0.f; for (int i = 0; i < 64; ++i) { s1 += p.lq1[i] * p.lk1[i]; s2 += p.lq2[i] * p.lk2[i]; } lam = __expf(s1) - __expf(s2) + LAMBDA_INIT; }
  int* qslot = (int*)(lds + 72 * 1024);
  for (;;) {
    __syncthreads();
    if (threadIdx.x == 0) *qslot = atomicAdd(qhead, 1);
    __syncthreads();
    const int item = *qslot;
    if (item >= NB * AH * (S / 128)) break;
    const int qb = item % (S / 128), h = (item / (S / 128)) % AH, b = item / ((S / 128) * AH);
    const float nsl2 = -exp2f(-(float)(h + 1)) * LOG2E;
    const size_t row0 = (size_t)b * S;
    at::attn_item(p.proj + (row0 + qb * 128) * PLD + N_Q + h * 128, p.proj + row0 * PLD + N_K + h * 128, p.proj + row0 * PLD + N_V + h * 128,
                  p.u + (row0 + qb * 128) * D + DSSD + h * 128, qb * 128, nsl2, lam, p.attn_norm_w, lds);
  }
}
namespace sd {
using at::bf16x8; using at::s16x4; using at::f32x16; using at::u32x4; using at::crow; using at::cvtpk; using at::v_st; using at::v_rd_base; using at::v_rd_off; using at::tr_read;
constexpr int CH = 64, NCH = S / CH;
constexpr int L_BT = 0, L_CT = 16384, L_XV = 32768, L_TAB = 98304, L_SS = 106496;
constexpr size_t SNAP = 16384;
__device__ __forceinline__ size_t snap_off(int dir, int b, int h, int c) { return ((((size_t)dir * NB + b) * NH + h) * NCH + c) * SNAP; }

__device__ void ph_conv16(const Params& p) {
  constexpr int SEG = 16, NCG = CC / 8, NU = NCG * (T / SEG);
  for (int u = blockIdx.x * NT + threadIdx.x; u < NU; u += gridDim.x * NT) {
    const int cg = u % NCG, seg = u / NCG, t0 = seg * SEG, s0 = t0 % S, chan = cg * 8;
    float w[5][8], bias[8];
#pragma unroll
    for (int j = 0; j < 5; ++j) { const float4 a = *(const float4*)(p.conv_w + j * CC + chan), c = *(const float4*)(p.conv_w + j * CC + chan + 4);
      w[j][0] = a.x; w[j][1] = a.y; w[j][2] = a.z; w[j][3] = a.w; w[j][4] = c.x; w[j][5] = c.y; w[j][6] = c.z; w[j][7] = c.w; }
    { const float4 a = *(const float4*)(p.conv_b + chan), c = *(const float4*)(p.conv_b + chan + 4);
      bias[0] = a.x; bias[1] = a.y; bias[2] = a.z; bias[3] = a.w; bias[4] = c.x; bias[5] = c.y; bias[6] = c.z; bias[7] = c.w; }
    const bf16_t* base = p.proj + (size_t)t0 * PLD + N_XBC + chan;
    u32x4 rows[SEG + 4];
#pragma unroll
    for (int i = 0; i < SEG + 4; ++i) { const int s = s0 + i - 2; rows[i] = (u32x4){0u, 0u, 0u, 0u}; if (s >= 0 && s < S) rows[i] = *(const u32x4*)(base + (ptrdiff_t)(i - 2) * PLD); }
#pragma unroll
    for (int i = 0; i < SEG; ++i) {
      float o[8];
#pragma unroll
      for (int c = 0; c < 8; ++c) o[c] = bias[c];
#pragma unroll
      for (int j = 0; j < 5; ++j) { const u32x4 rr = rows[i + j];
        o[0] += w[j][0] * __uint_as_float(rr.x << 16); o[1] += w[j][1] * __uint_as_float(rr.x & 0xffff0000u);
        o[2] += w[j][2] * __uint_as_float(rr.y << 16); o[3] += w[j][3] * __uint_as_float(rr.y & 0xffff0000u);
        o[4] += w[j][4] * __uint_as_float(rr.z << 16); o[5] += w[j][5] * __uint_as_float(rr.z & 0xffff0000u);
        o[6] += w[j][6] * __uint_as_float(rr.w << 16); o[7] += w[j][7] * __uint_as_float(rr.w & 0xffff0000u); }
#pragma unroll
      for (int c = 0; c < 8; ++c) o[c] = o[c] * __builtin_amdgcn_rcpf(1.f + __expf(-o[c]));
      u32x4 pk; pk.x = cvtpk(o[0], o[1]); pk.y = cvtpk(o[2], o[3]); pk.z = cvtpk(o[4], o[5]); pk.w = cvtpk(o[6], o[7]);
      *(u32x4*)(p.xc16 + (size_t)(t0 + i) * CC + chan) = pk;
    }
  }
}
template <bool WITH_C, bool BV>
__device__ __forceinline__ void load_chunk(const Params& p, char* lds, int b, int g, int c0) {
  constexpr int NCG = WITH_C ? 96 : 80, NP = NCG * CH / NT;
  int tid = threadIdx.x; asm volatile("" : "+v"(tid));
  const bf16_t* src = p.xc16 + ((size_t)b * S + c0) * CC;
  u32x4 v[NP];
#pragma unroll
  for (int i = 0; i < NP; ++i) { const int idx = tid + NT * i, tok = idx / NCG, cg = idx % NCG;
    const int chan = cg < 64 ? g * 512 + cg * 8 : (cg < 80 ? 1024 + g * 128 + (cg - 64) * 8 : 1280 + g * 128 + (cg - 80) * 8);
    v[i] = *(const u32x4*)(src + (size_t)tok * CC + chan); }
#pragma unroll
  for (int i = 0; i < NP; ++i) { const int idx = tid + NT * i, tok = idx / NCG, cg = idx % NCG;
    if (cg < 64) { const int hl = cg >> 3, c = (hl & 1) * 64 + (cg & 7) * 8; *(u32x4*)(lds + L_XV + (hl >> 1) * 16384 + v_st(tok, c)) = v[i]; }
    else if (cg < 80) { const int n0 = (cg - 64) * 8; if (BV) *(u32x4*)(lds + L_BT + v_st(tok, n0)) = v[i]; else *(u32x4*)(lds + L_BT + AT_KSWZ(tok, n0 * 2)) = v[i]; }
    else { const int n0 = (cg - 80) * 8; *(u32x4*)(lds + L_CT + AT_KSWZ(tok, n0 * 2)) = v[i]; } }
}
__device__ __forceinline__ float wave_incl_prefix(float v, int lane) {
#pragma unroll
  for (int o = 1; o < 64; o <<= 1) { const float t = __int_as_float(__builtin_amdgcn_ds_bpermute(((lane - o) & 63) << 2, __float_as_int(v))); if (lane >= o) v += t; }
  return v;
}
__device__ __forceinline__ float wave_incl_suffix(float v, int lane) {
#pragma unroll
  for (int o = 1; o < 64; o <<= 1) { const float t = __int_as_float(__builtin_amdgcn_ds_bpermute(((lane + o) & 63) << 2, __float_as_int(v))); if (lane + o < 64) v += t; }
  return v;
}
__device__ __forceinline__ float wave_bcast(float v, int src) { return __int_as_float(__builtin_amdgcn_ds_bpermute(src << 2, __float_as_int(v))); }
__device__ __forceinline__ bf16x8 scale_frag(s16x4 lo, s16x4 hi, const float4 w0, const float4 w1) {
  const unsigned a = ((unsigned)(unsigned short)lo[0]) | ((unsigned)(unsigned short)lo[1] << 16), b = ((unsigned)(unsigned short)lo[2]) | ((unsigned)(unsigned short)lo[3] << 16);
  const unsigned c = ((unsigned)(unsigned short)hi[0]) | ((unsigned)(unsigned short)hi[1] << 16), d = ((unsigned)(unsigned short)hi[2]) | ((unsigned)(unsigned short)hi[3] << 16);
  u32x4 r;
  r.x = cvtpk(__uint_as_float(a << 16) * w0.x, __uint_as_float(a & 0xffff0000u) * w0.y);
  r.y = cvtpk(__uint_as_float(b << 16) * w0.z, __uint_as_float(b & 0xffff0000u) * w0.w);
  r.z = cvtpk(__uint_as_float(c << 16) * w1.x, __uint_as_float(c & 0xffff0000u) * w1.y);
  r.w = cvtpk(__uint_as_float(d << 16) * w1.z, __uint_as_float(d & 0xffff0000u) * w1.w);
  return *reinterpret_cast<bf16x8*>(&r);
}
#define SD_PK(L, H) (bf16x8){L[0], L[1], L[2], L[3], H[0], H[1], H[2], H[3]}

__device__ __forceinline__ void pass_a_item(const Params& p, char* lds, char* snap, int b, int g, int dir) {
  int tid = threadIdx.x; asm volatile("" : "+v"(tid));
  const int hl = tid >> 6, lane = tid & 63, r32 = lane & 31, hi = lane >> 5, h = g * 8 + hl;
  const float a = -__expf(dir ? p.a_log_b[h] : p.a_log_f[h]);
  float* wtab = (float*)(lds + L_TAB) + hl * 64;
  const int vbx = (int)(uintptr_t)(lds + L_XV + (hl >> 1) * 16384) + v_rd_base(lane) + (hl & 1) * 1024;
  const int vbb = (int)(uintptr_t)(lds + L_BT) + v_rd_base(lane);
  f32x16 st[4][2];
#pragma unroll
  for (int nb = 0; nb < 4; ++nb)
#pragma unroll
    for (int pb = 0; pb < 2; ++pb) st[nb][pb] = f32x16{};
  for (int ci = 0; ci < NCH; ++ci) {
    const int c = dir ? (NCH - 1 - ci) : ci, c0 = c * CH;
    __syncthreads();
    load_chunk<false, true>(p, lds, b, g, c0);
    const float dtv = p.dt[((size_t)b * S + c0 + lane) * 32 + dir * 16 + h];
    const float adt = a * dtv;
    const float cum = dir ? wave_incl_suffix(adt, lane) : wave_incl_prefix(adt, lane);
    const float total = wave_bcast(cum, dir ? 0 : 63);
    wtab[lane] = __expf(total - cum) * dtv;
    const float dec = __expf(total);
    { char* sp = snap + snap_off(dir, b, h, c);
#pragma unroll
      for (int nb = 0; nb < 4; ++nb)
#pragma unroll
        for (int pb = 0; pb < 2; ++pb)
#pragma unroll
          for (int q = 0; q < 4; ++q) { const f32x16& s = st[nb][pb];
            uint2 v; v.x = cvtpk(s[4 * q + 0], s[4 * q + 1]); v.y = cvtpk(s[4 * q + 2], s[4 * q + 3]);
            *(uint2*)(sp + ((((pb * 8 + nb * 2 + (q >> 1)) * 2 + (q & 1)) * 32 + r32) * 16 + hi * 8)) = v; } }
#pragma unroll
    for (int nb = 0; nb < 4; ++nb)
#pragma unroll
      for (int pb = 0; pb < 2; ++pb)
#pragma unroll
        for (int r = 0; r < 16; ++r) st[nb][pb][r] *= dec;
    __syncthreads();
#pragma unroll
    for (int ks = 0; ks < 4; ++ks) {
      const float4 w0 = *(const float4*)(wtab + ks * 16 + hi * 8), w1 = *(const float4*)(wtab + ks * 16 + hi * 8 + 4);
      bf16x8 xf[2];
      { const s16x4 l0 = tr_read<v_rd_off(0, 0, 0)>(vbx + ks * 4096), h0 = tr_read<v_rd_off(0, 0, 1)>(vbx + ks * 4096), l1 = tr_read<v_rd_off(1, 0, 0)>(vbx + ks * 4096), h1 = tr_read<v_rd_off(1, 0, 1)>(vbx + ks * 4096);
        asm volatile("s_waitcnt lgkmcnt(0)" ::: "memory"); AT_SBAR();
        xf[0] = scale_frag(l0, h0, w0, w1); xf[1] = scale_frag(l1, h1, w0, w1); }
#pragma unroll
      for (int nb = 0; nb < 4; ++nb) {
        s16x4 bl, bh;
        asm volatile("ds_read_b64_tr_b16 %0, %1" : "=&v"(bl) : "v"(vbb + nb * 512 + ks * 4096) : "memory");
        asm volatile("ds_read_b64_tr_b16 %0, %1 offset:2048" : "=&v"(bh) : "v"(vbb + nb * 512 + ks * 4096) : "memory");
        asm volatile("s_waitcnt lgkmcnt(0)" ::: "memory"); AT_SBAR();
        const bf16x8 bfr = SD_PK(bl, bh);
        st[nb][0] = __builtin_amdgcn_mfma_f32_32x32x16_bf16(bfr, xf[0], st[nb][0], 0, 0, 0);
        st[nb][1] = __builtin_amdgcn_mfma_f32_32x32x16_bf16(bfr, xf[1], st[nb][1], 0, 0, 0);
      }
    }
  }
  __syncthreads();
}

__device__ __forceinline__ void pass_b_item(const Params& p, char* lds, const char* snap, int b, int g, int c) {
  int tid = threadIdx.x; asm volatile("" : "+v"(tid));
  const int hl = tid >> 6, lane = tid & 63, r32 = lane & 31, hi = lane >> 5, h = g * 8 + hl, c0 = c * CH;
  float4* tab = (float4*)(lds + L_TAB) + hl * 64;
  float* ssp = (float*)(lds + L_SS);
  const int vbx = (int)(uintptr_t)(lds + L_XV + (hl >> 1) * 16384) + v_rd_base(lane) + (hl & 1) * 1024;
  __syncthreads();
  load_chunk<true, false>(p, lds, b, g, c0);
  { const size_t tok = (size_t)b * S + c0 + lane;
    const float dtf = p.dt[tok * 32 + h], dtb = p.dt[tok * 32 + 16 + h];
    const float af = -__expf(p.a_log_f[h]) * dtf, ab = -__expf(p.a_log_b[h]) * dtb;
    tab[lane] = make_float4(wave_incl_prefix(af, lane) * LOG2E, wave_incl_suffix(ab, lane) * LOG2E, dtf, dtb); }
  __syncthreads();
  const float dsk = p.d_skip[h];
  f32x16 o[2][2];
#pragma unroll
  for (int lb = 0; lb < 2; ++lb) {
    const int l = lb * 32 + r32;
    const float4 tl = tab[l];
    bf16x8 cr[8];
#pragma unroll
    for (int kk = 0; kk < 8; ++kk) cr[kk] = *reinterpret_cast<const bf16x8*>(lds + L_CT + AT_KSWZ(l, (kk * 16 + hi * 8) * 2));
    f32x16 p0 = f32x16{}, p1 = f32x16{};
#pragma unroll
    for (int kk = 0; kk < 8; ++kk) { const int cb = (kk * 16 + hi * 8) * 2;
      const bf16x8 b0 = *reinterpret_cast<const bf16x8*>(lds + L_BT + AT_KSWZ(r32, cb));
      const bf16x8 b1 = *reinterpret_cast<const bf16x8*>(lds + L_BT + AT_KSWZ(32 + r32, cb));
      p0 = __builtin_amdgcn_mfma_f32_32x32x16_bf16(b0, cr[kk], p0, 0, 0, 0);
      p1 = __builtin_amdgcn_mfma_f32_32x32x16_bf16(b1, cr[kk], p1, 0, 0, 0); }
#pragma unroll
    for (int r = 0; r < 16; ++r) {
#pragma unroll
      for (int half = 0; half < 2; ++half) {
        const int s = crow(r, hi) + 32 * half; const float4 ts = tab[s];
        float m = 0.f;
        if (s <= l) m += __builtin_amdgcn_exp2f(tl.x - ts.x) * ts.z;
        if (s >= l) m += __builtin_amdgcn_exp2f(tl.y - ts.y) * ts.w;
        const float add = (s == l) ? dsk : 0.f;
        if (half) p1[r] = p1[r] * m + add; else p0[r] = p0[r] * m + add;
      }
      asm volatile("" ::: "memory");
    }
    bf16x8 pa0, pa1, pa2, pa3;
#define SD_PK4(P, BASE, OUT) do { unsigned a0 = cvtpk(P[BASE + 0], P[BASE + 1]), a1 = cvtpk(P[BASE + 2], P[BASE + 3]);   \
    unsigned b0_ = cvtpk(P[BASE + 4], P[BASE + 5]), b1_ = cvtpk(P[BASE + 6], P[BASE + 7]);                              \
    auto r0 = __builtin_amdgcn_permlane32_swap(a0, b0_, false, false); auto r1 = __builtin_amdgcn_permlane32_swap(a1, b1_, false, false); \
    u32x4 w_ = {r0[0], r1[0], r0[1], r1[1]}; OUT = *reinterpret_cast<bf16x8*>(&w_); } while (0)
    SD_PK4(p0, 0, pa0); SD_PK4(p0, 8, pa1); SD_PK4(p1, 0, pa2); SD_PK4(p1, 8, pa3);
#undef SD_PK4
#pragma unroll
    for (int d = 0; d < 2; ++d) {
      const s16x4 l0 = d ? tr_read<v_rd_off(1, 0, 0)>(vbx) : tr_read<v_rd_off(0, 0, 0)>(vbx), h0 = d ? tr_read<v_rd_off(1, 0, 1)>(vbx) : tr_read<v_rd_off(0, 0, 1)>(vbx);
      const s16x4 l1 = d ? tr_read<v_rd_off(1, 1, 0)>(vbx) : tr_read<v_rd_off(0, 1, 0)>(vbx), h1 = d ? tr_read<v_rd_off(1, 1, 1)>(vbx) : tr_read<v_rd_off(0, 1, 1)>(vbx);
      const s16x4 l2 = d ? tr_read<v_rd_off(1, 2, 0)>(vbx) : tr_read<v_rd_off(0, 2, 0)>(vbx), h2 = d ? tr_read<v_rd_off(1, 2, 1)>(vbx) : tr_read<v_rd_off(0, 2, 1)>(vbx);
      const s16x4 l3 = d ? tr_read<v_rd_off(1, 3, 0)>(vbx) : tr_read<v_rd_off(0, 3, 0)>(vbx), h3 = d ? tr_read<v_rd_off(1, 3, 1)>(vbx) : tr_read<v_rd_off(0, 3, 1)>(vbx);
      asm volatile("s_waitcnt lgkmcnt(0)" ::: "memory"); AT_SBAR();
      f32x16 od = f32x16{};
      od = __builtin_amdgcn_mfma_f32_32x32x16_bf16(pa0, SD_PK(l0, h0), od, 0, 0, 0);
      od = __builtin_amdgcn_mfma_f32_32x32x16_bf16(pa1, SD_PK(l1, h1), od, 0, 0, 0);
      od = __builtin_amdgcn_mfma_f32_32x32x16_bf16(pa2, SD_PK(l2, h2), od, 0, 0, 0);
      od = __builtin_amdgcn_mfma_f32_32x32x16_bf16(pa3, SD_PK(l3, h3), od, 0, 0, 0);
      o[lb][d] = od;
    }
  }
#pragma unroll
  for (int dir = 0; dir < 2; ++dir) {
    if (dir == 0 ? (c == 0) : (c == NCH - 1)) continue;
    const char* sp = snap + snap_off(dir, b, h, c);
#pragma unroll
    for (int d = 0; d < 2; ++d) {
      bf16x8 sf[8];
#pragma unroll
      for (int kk = 0; kk < 8; ++kk) sf[kk] = *reinterpret_cast<const bf16x8*>(sp + ((((d * 8 + kk) * 2 + hi) * 32 + r32) * 16));
#pragma unroll
      for (int lb = 0; lb < 2; ++lb) {
        f32x16 acc = f32x16{};
#pragma unroll
        for (int kk = 0; kk < 8; ++kk) { const bf16x8 cf = *reinterpret_cast<const bf16x8*>(lds + L_CT + AT_KSWZ(lb * 32 + r32, (kk * 16 + hi * 8) * 2));
          acc = __builtin_amdgcn_mfma_f32_32x32x16_bf16(cf, sf[kk], acc, 0, 0, 0); }
#pragma unroll
        for (int r = 0; r < 16; ++r) { const float4 tr = tab[lb * 32 + crow(r, hi)]; o[lb][d][r] += __builtin_amdgcn_exp2f(dir ? tr.y : tr.x) * acc[r]; }
      }
      asm volatile("" ::: "memory");
    }
  }
  asm volatile("" ::: "memory");
  const bf16_t* zp = p.proj + ((size_t)b * S + c0) * PLD + N_Z + h * HD + r32;
#pragma unroll
  for (int lb = 0; lb < 2; ++lb)
#pragma unroll
    for (int r = 0; r < 16; ++r) { const int l = lb * 32 + crow(r, hi); float ss = 0.f;
#pragma unroll
      for (int d = 0; d < 2; ++d) { const float z = bf2f(zp[(size_t)l * PLD + d * 32]); const float y = o[lb][d][r] * z * __builtin_amdgcn_rcpf(1.f + __expf(-z)); o[lb][d][r] = y; ss += y * y; }
      ss += __shfl_xor(ss, 16); ss += __shfl_xor(ss, 8); ss += __shfl_xor(ss, 4); ss += __shfl_xor(ss, 2); ss += __shfl_xor(ss, 1);
      if (r32 == 0) ssp[hl * 64 + l] = ss;
      if ((r & 3) == 3) asm volatile("" ::: "memory"); }
  __syncthreads();
  const float nw0 = p.ssd_norm_w[h * HD + r32], nw1 = p.ssd_norm_w[h * HD + 32 + r32];
  bf16_t* up = p.u + ((size_t)b * S + c0) * D + h * HD + r32;
#pragma unroll
  for (int lb = 0; lb < 2; ++lb)
#pragma unroll
    for (int r = 0; r < 16; ++r) { const int l = lb * 32 + crow(r, hi); float ss = 0.f;
#pragma unroll
      for (int q = 0; q < 8; ++q) ss += ssp[q * 64 + l];
      const float rstd = rsqrtf(ss * (1.f / 512.f) + 1e-5f);
      up[(size_t)l * D] = f2bf(o[lb][0][r] * rstd * nw0); up[(size_t)l * D + 32] = f2bf(o[lb][1][r] * rstd * nw1); }
}
}

__device__ void ph_ssd_a(const Params& p, char* lds, char* snap) {
  for (int item = blockIdx.x; item < NB * 2 * 2; item += gridDim.x) { const int dir = item & 1, g = (item >> 1) & 1, b = item >> 2; sd::pass_a_item(p, lds, snap, b, g, dir); }
}
__device__ void ph_ssd_b(const Params& p, char* lds, const char* snap) {
  for (int item = blockIdx.x; item < NB * 2 * sd::NCH; item += gridDim.x) { const int c = item % sd::NCH, g = (item / sd::NCH) & 1, b = item / (2 * sd::NCH); sd::pass_b_item(p, lds, snap, b, g, c); }
}
__device__ void ph_inproj(const Params& p, LAS unsigned char* lds) {
  pg8::Gemm g{p.xb, p.WinT, D}; pg8::OrderStatic Sd; Sd.init(T, NPROJ, gridDim.x, blockIdx.x);
  EpiProj E{p.proj, p.dt, p.dt_bias_f, p.dt_bias_b};
  pg8::gemm_phase<false>(lds, g, Sd, E);
}
__device__ void ph_outproj(const Params& p, LAS unsigned char* lds) {
  pg8::Gemm g{p.u, p.WoutT, D}; pg8::OrderStatic Sd; Sd.init(T, D, gridDim.x, blockIdx.x);
  EpiOut E{p.x, p.h1};
  pg8::gemm_phase<false>(lds, g, Sd, E);
}
__device__ __forceinline__ int ld_agent(const int* p) { return __hip_atomic_load(p, __ATOMIC_RELAXED, __HIP_MEMORY_SCOPE_AGENT); }
__device__ __forceinline__ float ld_agent(const float* p) { return __hip_atomic_load(p, __ATOMIC_RELAXED, __HIP_MEMORY_SCOPE_AGENT); }
__device__ void ph_ln_route(const Params& p, char* ldsg, LAS unsigned char* lds) {
  typedef short bf16x8 __attribute__((ext_vector_type(8)));
  LAS int* cntl = (LAS int*)lds;
  int tid = threadIdx.x; asm volatile("" : "+v"(tid));
  const int lane = tid & 63, wv = tid >> 6;
  float* lg = (float*)(ldsg + 1024) + wv * 512;
  float gm[32], bt[32];
#pragma unroll
  for (int g = 0; g < 4; ++g) { const f32x4 a = *(const f32x4*)(p.ln1_g + g * 512 + lane * 8), b = *(const f32x4*)(p.ln1_g + g * 512 + lane * 8 + 4);
    const f32x4 c = *(const f32x4*)(p.ln1_b + g * 512 + lane * 8), d = *(const f32x4*)(p.ln1_b + g * 512 + lane * 8 + 4);
#pragma unroll
    for (int j = 0; j < 4; ++j) { gm[g * 8 + j] = a[j]; gm[g * 8 + 4 + j] = b[j]; bt[g * 8 + j] = c[j]; bt[g * 8 + 4 + j] = d[j]; } }
  const float rbias = p.router_bias[lane];
  for (int tb = blockIdx.x; tb < T / 64; tb += gridDim.x) {
    __syncthreads();
    if (tid < NE) cntl[tid] = 0;
    const int t0 = tb * 64 + wv * 8;
    for (int i = 0; i < 8; ++i) {
      const float* vp = p.h1 + (size_t)(t0 + i) * D; float v[32]; float s = 0.f;
#pragma unroll
      for (int g = 0; g < 4; ++g) { const f32x4 a = *(const f32x4*)(vp + g * 512 + lane * 8), b = *(const f32x4*)(vp + g * 512 + lane * 8 + 4);
#pragma unroll
        for (int j = 0; j < 4; ++j) { v[g * 8 + j] = a[j]; v[g * 8 + 4 + j] = b[j]; s += a[j] + b[j]; } }
      const float mu = wave_sum(s) * (1.f / D); float q = 0.f;
#pragma unroll
      for (int j = 0; j < 32; ++j) { const float d = v[j] - mu; q += d * d; }
      const float rstd = rsqrtf(wave_sum(q) * (1.f / D) + 1e-5f);
#pragma unroll
      for (int g = 0; g < 4; ++g) { float o[8];
#pragma unroll
        for (int j = 0; j < 8; ++j) o[j] = (v[g * 8 + j] - mu) * rstd * gm[g * 8 + j] + bt[g * 8 + j];
        u32x4 w; w.x = cvt_pk_bf16(o[0], o[1]); w.y = cvt_pk_bf16(o[2], o[3]); w.z = cvt_pk_bf16(o[4], o[5]); w.w = cvt_pk_bf16(o[6], o[7]);
        *(u32x4*)(p.h1b + (size_t)(t0 + i) * D + g * 512 + lane * 8) = w; }
    }
    __threadfence_block(); asm volatile("s_waitcnt vmcnt(0)" ::: "memory");
    f32x4 acc[4];
#pragma unroll
    for (int nb = 0; nb < 4; ++nb) acc[nb] = (f32x4){0.f, 0.f, 0.f, 0.f};
    const bf16_t* ap = p.h1b + (size_t)(t0 + (lane & 7)) * D + 8 * (lane >> 4);
    const bf16_t* bp = p.WrT + (size_t)(lane & 15) * D + 8 * (lane >> 4);
#pragma unroll 4
    for (int kk = 0; kk < D / 32; ++kk) {
      const bf16x8 a = *(const bf16x8*)(ap + kk * 32);
#pragma unroll
      for (int nb = 0; nb < 4; ++nb) { const bf16x8 b = *(const bf16x8*)(bp + (size_t)nb * 16 * D + kk * 32); acc[nb] = __builtin_amdgcn_mfma_f32_16x16x32_bf16(a, b, acc[nb], 0, 0, 0); }
    }
    if ((lane >> 4) < 2) {
#pragma unroll
      for (int nb = 0; nb < 4; ++nb)
#pragma unroll
        for (int i = 0; i < 4; ++i) lg[(4 * (lane >> 4) + i) * 64 + nb * 16 + (lane & 15)] = acc[nb][i];
    }
    __syncthreads();
    for (int ti = 0; ti < 8; ++ti) {
      const int t = t0 + ti;
      const float sc = 1.f / (1.f + __expf(-lg[ti * 64 + lane]));
      const float bz = sc + rbias;
      int rk = 0;
#pragma unroll
      for (int j = 1; j < 8; ++j) { const float o = __shfl_xor(bz, j); const int oi = lane ^ j; rk += (o > bz || (o == bz && oi < lane)) ? 1 : 0; }
      float gs = rk < 2 ? bz : 0.f;
      gs += __shfl_xor(gs, 1); gs += __shfl_xor(gs, 2); gs += __shfl_xor(gs, 4);
      const int g = lane >> 3; int grk = 0;
#pragma unroll
      for (int j = 1; j < 8; ++j) { const float o = __shfl_xor(gs, j * 8); const int og = g ^ j; grk += (o > gs || (o == gs && og < g)) ? 1 : 0; }
      const bool gsel = grk < 4;
      const float mb = gsel ? bz : -INFINITY;
      int erk = 0;
      for (int j = 1; j < 64; ++j) { const float o = __shfl_xor(mb, j); const int oi = lane ^ j; erk += (o > mb || (o == mb && oi < lane)) ? 1 : 0; }
      const bool sel = gsel && erk < 8;
      const float gsum = wave_sum(sel ? sc : 0.f);
      if (sel) {
        const int lr = __hip_atomic_fetch_add(&cntl[lane], 1, __ATOMIC_RELAXED, __HIP_MEMORY_SCOPE_WORKGROUP);
        p.assign[t * 8 + erk] = lane | (lr << 8); p.gate[t * 8 + erk] = sc / gsum * 2.5f;
      }
    }
    __syncthreads();
    if (tid < NE) p.blkcnt[tb * NE + tid] = cntl[tid];
  }
}
__device__ void ph_place(const Params& p, LAS unsigned char* lds) {
  LAS int* part = (LAS int*)lds;
  LAS int* parta = part + 512;
  LAS int* base = parta + 512;
  LAS int* total = base + 64;
  LAS int* pstart = total + 64;
  const int tid = threadIdx.x, e = tid & 63, pt = tid >> 6;
  for (int tb = blockIdx.x; tb < T / 64; tb += gridDim.x) {
    __syncthreads();
    int slo = 0, sall = 0;
    for (int b = pt * 32; b < pt * 32 + 32; ++b) { const int c = ld_agent(p.blkcnt + b * NE + e); sall += c; slo += (b < tb) ? c : 0; }
    part[pt * 64 + e] = slo; parta[pt * 64 + e] = sall;
    __syncthreads();
    if (tid < 64) {
      int b0 = 0, t0 = 0;
#pragma unroll
      for (int q = 0; q < 8; ++q) { b0 += part[q * 64 + tid]; t0 += parta[q * 64 + tid]; }
      base[tid] = b0; total[tid] = t0;
      const int padded = (t0 + 255) & ~255;
      int incl = padded;
      for (int o = 1; o < 64; o <<= 1) { const int v = __shfl_up(incl, o); if (tid >= o) incl += v; }
      pstart[tid] = incl - padded;
      if (tid == 63) pstart[64] = incl;
    }
    __syncthreads();
    {
      const int t = tb * 64 + (tid >> 3), k = tid & 7;
      const int a = ld_agent(p.assign + t * 8 + k), ee = a & 255, lr = a >> 8;
      const int row = pstart[ee] + base[ee] + lr;
      p.row_tok[row] = t; p.row_gate[row] = ld_agent(p.gate + t * 8 + k); p.pos[t * 8 + k] = row;
      if (tid < 64) { const int srow = pstart[64] + tb * 64 + tid; p.row_tok[srow] = tb * 64 + tid; p.row_gate[srow] = 1.0f; }
    }
    if (tb == blockIdx.x) {
      for (int e2 = blockIdx.x; e2 < NE; e2 += gridDim.x) {
        const int r0 = pstart[e2] + total[e2], r1 = pstart[e2 + 1];
        for (int r = r0 + tid; r < r1; r += NT) { p.row_tok[r] = 0; p.row_gate[r] = 0.f; }
        for (int j = pstart[e2] / 256 + tid; j < r1 / 256; j += NT) p.tile_exp[j] = e2;
      }
      if (blockIdx.x == 0) {
        const int nr = pstart[64] / 256;
        for (int j = tid; j < T / 256; j += NT) p.tile_exp[nr + j] = NE;
        if (tid == 0) { p.meta[0] = nr; p.meta[1] = nr + T / 256; }
      }
    }
  }
}
struct OrderMoE {
  LAS const int* ulist; int n;
  LAS const unsigned* tab;
  __device__ __forceinline__ bool next(int i, pg8::Unit& u) const { if (i >= n) return false; u.pm = ulist[i * 4 + 0]; u.pn = ulist[i * 4 + 1]; u.bn = ulist[i * 4 + 2]; u.aux = i; return true; }
  __device__ __forceinline__ unsigned row_off(int i, int row) const { return tab[i * 512 + row]; }
};
template <bool TABLES>
__device__ __forceinline__ OrderMoE moe_order(const Params& p, LAS unsigned char* lds, int npn, int tile0, int ntiles, int rowbytes) {
  LAS int* ulist = (LAS int*)(lds + LDS_TAB); LAS unsigned* tab = (LAS unsigned*)(lds + LDS_TAB + 1024);
  const int G = gridDim.x, c = blockIdx.x, mpc = 32 / npn; int n = 0;
  __syncthreads();
  for (int i = 0; i < 60; ++i) {
    int U; if (G == 256) U = ((i * 8 + (c & 7)) * 32 + (c >> 3)); else U = i * G + c;
    const int chunk = U >> 5, w = U & 31, j = chunk * mpc + (w % mpc), pn = w / mpc;
    if (j >= ntiles) break;
    const int tile = tile0 + j, e = ld_agent(p.tile_exp + tile);
    if (threadIdx.x == 0) { ulist[i * 4 + 0] = tile; ulist[i * 4 + 1] = pn; ulist[i * 4 + 2] = e * npn + pn; ulist[i * 4 + 3] = e; }
    if (TABLES) { for (int r = threadIdx.x; r < 256; r += NT) { tab[i * 512 + r] = (unsigned)ld_agent(p.row_tok + tile * 256 + r) * (unsigned)rowbytes; tab[i * 512 + 256 + r] = __float_as_uint(ld_agent(p.row_gate + tile * 256 + r)); } }
    n = i + 1;
  }
  __syncthreads();
  return OrderMoE{ulist, n, tab};
}
struct EpiGU {
  static constexpr bool PERM = true;
  bf16_t* H; LAS const unsigned* tab;
  __device__ __forceinline__ void operator()(const f32x4 (&acc)[2][2][4][2], const pg8::Unit& u, int wr, int wc, int fr, int fq) const {
    const int col0 = u.pn * 128 + wc * 32 + 8 * fq;
#pragma unroll
    for (int ai = 0; ai < 2; ++ai)
#pragma unroll
      for (int m = 0; m < 4; ++m) { const int r = ai * 128 + wr * 64 + m * 16 + fr; const float gt = __uint_as_float(tab[u.aux * 512 + 256 + r]);
        f32x4 h0, h1;
#pragma unroll
        for (int j = 0; j < 4; ++j) { const float g0 = acc[ai][0][m][0][j], g1 = acc[ai][0][m][1][j];
          h0[j] = g0 * __builtin_amdgcn_rcpf(1.f + __expf(-g0)) * acc[ai][1][m][0][j] * gt; h1[j] = g1 * __builtin_amdgcn_rcpf(1.f + __expf(-g1)) * acc[ai][1][m][1][j] * gt; }
        u32x4 w; w.x = cvt_pk_bf16(h0[0], h0[1]); w.y = cvt_pk_bf16(h0[2], h0[3]); w.z = cvt_pk_bf16(h1[0], h1[1]); w.w = cvt_pk_bf16(h1[2], h1[3]);
        *(u32x4*)(H + (size_t)(u.pm * 256 + r) * DE + col0) = w; }
  }
};
__device__ void ph_gateup(const Params& p, LAS unsigned char* lds) {
  const int ntot = ld_agent(p.meta + 1);
  const OrderMoE S = moe_order<true>(p, lds, 4, 0, ntot, D * 2);
  pg8::Gemm g{p.h1b, p.WguT, D}; EpiGU E{p.H, S.tab};
  pg8::gemm_phase<true>(lds, g, S, E);
}
struct EpiDown {
  static constexpr bool PERM = true;
  bf16_t* Y; float* out; const bf16_t* h1b; LAS const int* ulist; int srow0;
  __device__ __forceinline__ void operator()(const f32x4 (&acc)[2][2][4][2], const pg8::Unit& u, int wr, int wc, int fr, int fq) const {
    const int col0 = u.pn * 256 + wc * 32 + 8 * fq; const bool shared_e = ulist[u.aux * 4 + 3] == NE;
#pragma unroll
    for (int ai = 0; ai < 2; ++ai)
#pragma unroll
      for (int m = 0; m < 4; ++m) { const int row = u.pm * 256 + ai * 128 + wr * 64 + m * 16 + fr;
#pragma unroll
        for (int bj = 0; bj < 2; ++bj) { const f32x4 v0 = acc[ai][bj][m][0], v1 = acc[ai][bj][m][1];
          if (!shared_e) { u32x4 w; w.x = cvt_pk_bf16(v0[0], v0[1]); w.y = cvt_pk_bf16(v0[2], v0[3]); w.z = cvt_pk_bf16(v1[0], v1[1]); w.w = cvt_pk_bf16(v1[2], v1[3]);
            *(u32x4*)(Y + (size_t)row * D + col0 + bj * 128) = w; }
          else { const size_t o = (size_t)(row - srow0) * D + col0 + bj * 128; const u32x4 hb = *(const u32x4*)(h1b + o); f32x4 a, b;
            a[0] = __uint_as_float(hb.x << 16); a[1] = __uint_as_float(hb.x & 0xffff0000u); a[2] = __uint_as_float(hb.y << 16); a[3] = __uint_as_float(hb.y & 0xffff0000u);
            b[0] = __uint_as_float(hb.z << 16); b[1] = __uint_as_float(hb.z & 0xffff0000u); b[2] = __uint_as_float(hb.w << 16); b[3] = __uint_as_float(hb.w & 0xffff0000u);
            *(f32x4*)(out + o) = a * ALPHA + v0; *(f32x4*)(out + o + 4) = b * ALPHA + v1; } } }
  }
};
__device__ void ph_down(const Params& p, LAS unsigned char* lds) {
  const int nr = ld_agent(p.meta + 0), ntot = ld_agent(p.meta + 1);
  const OrderMoE S = moe_order<false>(p, lds, 8, 0, ntot, 0);
  pg8::Gemm g{p.H, p.WdT, DE}; EpiDown E{p.Y, p.out, p.h1b, S.ulist, nr * 256};
  pg8::gemm_phase<false>(lds, g, S, E);
}
__device__ void ph_combine(const Params& p) {
  const int lane = threadIdx.x & 63, wv = threadIdx.x >> 6;
  for (int row = blockIdx.x * 8 + wv; row < T; row += gridDim.x * 8) {
    float v[32];
    float* op = p.out + (size_t)row * D;
#pragma unroll
    for (int g = 0; g < 4; ++g) { const f32x4 a = *(const f32x4*)(op + g * 512 + lane * 8), b = *(const f32x4*)(op + g * 512 + lane * 8 + 4);
#pragma unroll
      for (int j = 0; j < 4; ++j) { v[g * 8 + j] = a[j]; v[g * 8 + 4 + j] = b[j]; } }
    for (int k = 0; k < 8; ++k) {
      const int yr = ld_agent(p.pos + row * 8 + k); const bf16_t* yp = p.Y + (size_t)yr * D;
#pragma unroll
      for (int g = 0; g < 4; ++g) { const u32x4 hb = *(const u32x4*)(yp + g * 512 + lane * 8);
        v[g * 8 + 0] += __uint_as_float(hb.x << 16); v[g * 8 + 1] += __uint_as_float(hb.x & 0xffff0000u); v[g * 8 + 2] += __uint_as_float(hb.y << 16); v[g * 8 + 3] += __uint_as_float(hb.y & 0xffff0000u);
        v[g * 8 + 4] += __uint_as_float(hb.z << 16); v[g * 8 + 5] += __uint_as_float(hb.z & 0xffff0000u); v[g * 8 + 6] += __uint_as_float(hb.w << 16); v[g * 8 + 7] += __uint_as_float(hb.w & 0xffff0000u); }
    }
    float s = 0.f;
#pragma unroll
    for (int j = 0; j < 32; ++j) s += v[j];
    const float mu = wave_sum(s) * (1.f / D); float q = 0.f;
#pragma unroll
    for (int j = 0; j < 32; ++j) { const float d = v[j] - mu; q += d * d; }
    const float rstd = rsqrtf(wave_sum(q) * (1.f / D) + 1e-5f);
#pragma unroll
    for (int g = 0; g < 4; ++g) { const int c0 = g * 512 + lane * 8; f32x4 a, b;
#pragma unroll
      for (int j = 0; j < 4; ++j) { a[j] = (v[g * 8 + j] - mu) * rstd * p.ln2_g[c0 + j] + p.ln2_b[c0 + j]; b[j] = (v[g * 8 + 4 + j] - mu) * rstd * p.ln2_g[c0 + 4 + j] + p.ln2_b[c0 + 4 + j]; }
      *(f32x4*)(op + c0) = a; *(f32x4*)(op + c0 + 4) = b; }
  }
}

__global__ void __launch_bounds__(NT) k_mega(Params p_arg) {
#if defined(__HIP_DEVICE_COMPILE__)
  extern __shared__ __attribute__((aligned(16))) unsigned char lds_raw[];
  LAS unsigned char* lds = (LAS unsigned char*)lds_raw;
  float* smem = (float*)lds_raw;
  cooperative_groups::grid_group grid = cooperative_groups::this_grid();
#ifndef ONLY
#define ONLY -1
#endif
  typedef const __attribute__((address_space(4))) Params* KP;
  const KP pk = (KP)__builtin_amdgcn_kernarg_segment_ptr();
#ifndef DUP
#define DUP -1
#endif
#define RUN1(n, pass, call) do { if (ONLY < 0 || ONLY == n) { KP q_ = pk; asm volatile("" : "+s"(q_)); const Params p = *q_; const int dup_pass = pass; (void)dup_pass; call; } } while (0)
#define RUN(n, call) do { RUN1(n, 0, call); if (DUP == n) { grid.sync(); RUN1(n, 1, call); } } while (0)
  RUN(0, ph_convert(p)); grid.sync();
  RUN(1, ph_inproj(p, lds)); grid.sync();
  RUN(2, sd::ph_conv16(p)); grid.sync();
  RUN(3, ph_ssd_a(p, (char*)lds_raw, (char*)p.out)); RUN(4, ph_attn_mfma(p, (char*)lds_raw, p.meta + 8 + dup_pass)); grid.sync();
  RUN(5, ph_ssd_b(p, (char*)lds_raw, (const char*)p.out)); grid.sync();
  RUN(6, ph_outproj(p, lds)); grid.sync();
  RUN(7, ph_ln_route(p, (char*)lds_raw, lds)); grid.sync();
  RUN(10, ph_place(p, lds)); grid.sync();
  RUN(11, ph_gateup(p, lds)); grid.sync();
  RUN(12, ph_down(p, lds)); grid.sync();
  RUN(13, ph_combine(p));
#endif
}
}

extern "C" void kernel_launch(void* const* d_in, const int* in_sizes, int n_in, void* d_out, int out_size, void* d_ws, size_t ws_size, hipStream_t stream) {
  Params p{};
  const float* const* in = (const float* const*)d_in;
  p.x = in[0]; p.w_in = in[1]; p.conv_w = in[2]; p.conv_b = in[3]; p.dt_bias_f = in[4]; p.dt_bias_b = in[5]; p.a_log_f = in[6]; p.a_log_b = in[7];
  p.d_skip = in[8]; p.ssd_norm_w = in[9]; p.lq1 = in[10]; p.lk1 = in[11]; p.lq2 = in[12]; p.lk2 = in[13]; p.attn_norm_w = in[14]; p.w_out = in[15];
  p.ln1_g = in[16]; p.ln1_b = in[17]; p.w_router = in[18]; p.router_bias = in[19]; p.wg_e = in[20]; p.wu_e = in[21]; p.wd_e = in[22];
  p.wg_s = in[23]; p.wu_s = in[24]; p.wd_s = in[25]; p.ln2_g = in[26]; p.ln2_b = in[27];
  p.out = (float*)d_out;
  char* w = (char*)d_ws; size_t o = 0;
  auto take = [&](size_t bytes) { char* r = w + o; o += (bytes + 255) / 256 * 256; return r; };
  char* reg1 = w + o;
  p.xb = (bf16_t*)take((size_t)T * D * 2); p.WinT = (bf16_t*)take((size_t)NPROJ * D * 2); p.WoutT = (bf16_t*)take((size_t)D * D * 2);
  p.WguT = (bf16_t*)take((size_t)(NE + 1) * 1024 * D * 2); p.proj = (bf16_t*)take((size_t)T * PLD * 2); p.u = (bf16_t*)take((size_t)T * D * 2);
  const size_t reg1_bytes = (size_t)((w + o) - reg1);
  p.Y = (bf16_t*)reg1;
  if ((size_t)MAXROWS_R * D * 2 > reg1_bytes) { fprintf(stderr, "kernel_launch: region 1 too small for Y\n"); return; }
  char* reg2 = take((size_t)MAXROWS * DE * 2);
  p.H = (bf16_t*)reg2; p.xc16 = (bf16_t*)reg2;
  p.h1b = (bf16_t*)take((size_t)T * D * 2); p.WdT = (bf16_t*)take((size_t)(NE + 1) * D * DE * 2);
  p.dt = (float*)take((size_t)T * 32 * 4); p.WrT = (bf16_t*)take((size_t)NE * D * 2); p.gate = (float*)take((size_t)T * 8 * 4);
  p.assign = (int*)take((size_t)T * 8 * 4); p.pos = (int*)take((size_t)T * 8 * 4); p.blkcnt = (int*)take((size_t)(T / 64) * NE * 4);
  p.row_tok = (int*)take((size_t)MAXROWS * 4); p.row_gate = (float*)take((size_t)MAXROWS * 4); p.tile_exp = (int*)take((size_t)MAXTILES * 4); p.meta = (int*)take(256);
  p.h1 = (float*)d_out;
  if (o > ws_size) { fprintf(stderr, "kernel_launch: ws too small: need %zu have %zu\n", o, ws_size); return; }
  static int grid_blocks = 0;
  if (!grid_blocks) {
    int dev = 0, cus = 0, per_cu = 0;
    hipGetDevice(&dev);
    hipDeviceGetAttribute(&cus, hipDeviceAttributeMultiprocessorCount, dev);
    if (hipFuncSetAttribute((const void*)k_mega, hipFuncAttributeMaxDynamicSharedMemorySize, LDS_BYTES) != hipSuccess) { fprintf(stderr, "kernel_launch: hipFuncSetAttribute failed\n"); return; }
    hipOccupancyMaxActiveBlocksPerMultiprocessor(&per_cu, k_mega, NT, LDS_BYTES);
    if (per_cu < 1) { fprintf(stderr, "kernel_launch: occupancy query says 0 blocks/CU\n"); return; }
    grid_blocks = cus;
  }
  void* args[] = {&p};
  hipError_t e = hipLaunchCooperativeKernel((void*)k_mega, dim3(grid_blocks), dim3(NT), args, LDS_BYTES, stream);
  if (e != hipSuccess) fprintf(stderr, "cooperative launch failed: %s (grid %d)\n", hipGetErrorString(e), grid_blocks);
}
```

```cpp
#include <hip/hip_runtime.h>
#include <cstdio>
#include <cstdint>

namespace {
constexpr int D = 2048, NB = 8, S = 2048, T = NB * S;
constexpr int DSSD = 1024, DATT = 1024, NH = 16, HD = 64, NS = 128, CC = 1536;
constexpr int AH = 8, NE = 64, DE = 512, PW = 5664;
constexpr int O_DT = 2560, O_Q = 2592;
constexpr int N_Z = 0, N_XBC = 1024, N_Q = 2560, N_K = 3584, N_V = 4608, PLD = 5632, NPROJ = 5888;
constexpr float ALPHA = 1.189207115002721f;
constexpr float LAMBDA_INIT = 0.2f;
constexpr float LOG2E = 1.4426950408889634f;
constexpr float QS = 0.125f * LOG2E;
constexpr int NT = 512;
constexpr int LDS_BYTES = 152 * 1024;
constexpr int LDS_TAB = 128 * 1024;
constexpr int MAXROWS_R = NE * 256 + T * 8;
constexpr int MAXROWS = MAXROWS_R + T;
constexpr int MAXTILES = MAXROWS / 256;

typedef unsigned short bf16_t;
#define LAS __attribute__((address_space(3)))

struct Params {
  const float *x, *w_in, *conv_w, *conv_b, *dt_bias_f, *dt_bias_b, *a_log_f, *a_log_b, *d_skip, *ssd_norm_w;
  const float *lq1, *lk1, *lq2, *lk2, *attn_norm_w, *w_out, *ln1_g, *ln1_b, *w_router, *router_bias;
  const float *wg_e, *wu_e, *wd_e, *wg_s, *wu_s, *wd_s, *ln2_g, *ln2_b;
  float* out;
  bf16_t *xb, *WinT, *WoutT, *WguT, *WdT, *proj, *u, *h1b, *H, *Y, *xc16, *WrT;
  float *dt, *h1, *gate, *row_gate;
  int *assign, *blkcnt, *row_tok, *pos, *tile_exp, *meta;
  unsigned* bar;
};

__device__ __forceinline__ float silu_f(float x) { return x / (1.f + __expf(-x)); }
__device__ __forceinline__ float softplus_f(float x) { return x > 20.f ? x : log1pf(__expf(x)); }
__device__ __forceinline__ float wave_sum(float v) { for (int o = 32; o >= 1; o >>= 1) v += __shfl_xor(v, o); return v; }
__device__ __forceinline__ float bf2f(bf16_t b) { return __uint_as_float(((unsigned)b) << 16); }
__device__ __forceinline__ bf16_t f2bf(float f) { unsigned u = __float_as_uint(f); u += 0x7FFFu + ((u >> 16) & 1u); return (bf16_t)(u >> 16); }
}

namespace pg8 {
#define PG8_LAS __attribute__((address_space(3)))
typedef unsigned short bf16_t;
typedef short bf16x8 __attribute__((ext_vector_type(8)));
typedef float f32x4 __attribute__((ext_vector_type(4)));
typedef unsigned u32x4 __attribute__((ext_vector_type(4)));
constexpr int BM = 256, BK = 64, HALF = 128, HTB = HALF * BK * 2  , STAGE_BYTES = 8 * HTB, NXCD = 8, WGM = 8;

__host__ __device__ __forceinline__ int lds_byte(int r, int c) { const int st = (r >> 4) * 2 + (c >> 5), rr = r & 15, cc = c & 31, ob = rr * 64 + cc * 2; return st * 1024 + (ob ^ (((ob >> 9) & 1) << 5)); }
__host__ __device__ __forceinline__ void stage_rc(int b, int& R, int& C) { const int st = b / 1024, sb = b % 1024, swz = sb ^ (((sb >> 9) & 1) << 5); R = (st >> 1) * 16 + swz / 64; C = (st & 1) * 32 + (swz % 64) / 2; }
__host__ __device__ __forceinline__ int perm32(int rho) { const int n = rho >> 4, i = rho & 15; return 8 * (i >> 2) + 4 * n + (i & 3); }

struct Unit { int pm, pn, bn, aux; };
struct Gemm { const bf16_t* A; const bf16_t* Bt; int K; };


__device__ __forceinline__ unsigned cvt_pk_bf16(float lo, float hi) { unsigned r; asm volatile("v_cvt_pk_bf16_f32 %0, %1, %2" : "=v"(r) : "v"(lo), "v"(hi)); return r; }
struct OrderStatic {
    int nM, nN, nwg, G, c;
    __device__ void init(int M, int N, int G_, int c_) { nM = M / BM; nN = N / BM; nwg = nM * nN; G = G_; c = c_; }
    __device__ bool next(int i, Unit& u) const {
        const long L = (long)i * G + c; if (L >= nwg) return false;
        int wgid = (int)L; { const int q = nwg / NXCD, r = nwg % NXCD, xcd = wgid % NXCD, off = wgid / NXCD; wgid = (xcd < r ? xcd * (q + 1) : r * (q + 1) + (xcd - r) * q) + off; }
        const int nig = WGM * nN, gid = wgid / nig, fm = gid * WGM, gsz = (nM - fm) < WGM ? (nM - fm) : WGM;
        u.pm = fm + ((wgid % nig) % gsz); u.pn = (wgid % nig) / gsz; u.bn = u.pn; u.aux = i; return true;
    }
    __device__ __forceinline__ unsigned row_off(int, int) const { return 0u; }
};
template <bool GATHER, class Epi, class Sched>
__device__ __forceinline__ void gemm_phase(PG8_LAS unsigned char* lds, const Gemm g, const Sched& S, const Epi& E) {
    int tid = threadIdx.x; asm volatile("" : "+v"(tid));
    const int wid = __builtin_amdgcn_readfirstlane(tid >> 6), lane = tid & 63, wr = wid >> 2, wc = wid & 3, fr = lane & 15, fq = lane >> 4;
    const int K = g.K, nt = K / BK;
#define PG8_STAMP() do {} while (0)
    PG8_STAMP();
    unsigned voffA[2], voffB[2];
#pragma unroll
    for (int i = 0; i < 2; ++i) { int R, C; stage_rc(tid * 16 + i * 8192, R, C); const int Rb = Epi::PERM ? ((R & ~31) + perm32(R & 31)) : R;
        voffA[i] = (unsigned)(R * K + C) * 2u; voffB[i] = (unsigned)(Rb * K + C) * 2u; }
    unsigned voffG[2][2] = {{0u, 0u}, {0u, 0u}};
#define PG8_LOADG(uidx) do { if constexpr (GATHER) { _Pragma("unroll") for (int _h = 0; _h < 2; ++_h) _Pragma("unroll") for (int _i = 0; _i < 2; ++_i) { int R_, C_; stage_rc(tid * 16 + _i * 8192, R_, C_); \
        voffG[_h][_i] = S.row_off((uidx), _h * HALF + R_) + (unsigned)C_ * 2u; } } } while (0)
    const size_t kstep = (size_t)(BK * 2);
    const size_t hstep = (size_t)HALF * K * 2;
    const size_t tstep = 2 * hstep;
    const unsigned ldsw = (unsigned)wid * 1024u;
    const int aoff = lds_byte(wr * 64 + fr, fq * 8), boff = lds_byte(wc * 32 + fr, fq * 8);
#define PG8_SA(b, h) (((b) * 2 + (h)) * HTB)
#define PG8_SB(b, h) ((4 + (b) * 2 + (h)) * HTB)
#define PG8_STAGE(bufoff, gbase, voff) do { _Pragma("unroll") for (int _i = 0; _i < 2; ++_i) \
        __builtin_amdgcn_global_load_lds((const unsigned*)((const char*)(gbase) + (voff)[_i]), (PG8_LAS unsigned*)(lds + (bufoff) + ldsw + _i * 8192), 16, 0, 0); } while (0)
#define PG8_STAGE_A(bufoff, ptr, h) do { if constexpr (GATHER) { PG8_STAGE(bufoff, ptr, voffG[h]); } else { PG8_STAGE(bufoff, (ptr) + (h) * hstep, voffA); } } while (0)
#define PG8_LDA(dst, b, h) do { _Pragma("unroll") for (int m = 0; m < 4; ++m) _Pragma("unroll") for (int k = 0; k < 2; ++k) dst[m][k] = *(const PG8_LAS bf16x8*)(lds + PG8_SA(b, h) + aoff + m * 2048 + k * 1024); } while (0)
#define PG8_LDB(dst, b, h) do { _Pragma("unroll") for (int n = 0; n < 2; ++n) _Pragma("unroll") for (int k = 0; k < 2; ++k) dst[n][k] = *(const PG8_LAS bf16x8*)(lds + PG8_SB(b, h) + boff + n * 2048 + k * 1024); } while (0)
#define PG8_MMA(ai, bj, At, Bt) do { __builtin_amdgcn_s_setprio(1); _Pragma("unroll") for (int m = 0; m < 4; ++m) _Pragma("unroll") for (int n = 0; n < 2; ++n) _Pragma("unroll") for (int k = 0; k < 2; ++k) \
        acc[ai][bj][m][n] = __builtin_amdgcn_mfma_f32_16x16x32_bf16(Bt[n][k], At[m][k], acc[ai][bj][m][n], 0, 0, 0); __builtin_amdgcn_s_setprio(0); } while (0)
#define PG8_WAIT_V(n) asm volatile("s_waitcnt vmcnt(" #n ")" ::: "memory")
#define PG8_WAIT_L(n) asm volatile("s_waitcnt lgkmcnt(" #n ")" ::: "memory")
#define PG8_BAR __builtin_amdgcn_s_barrier()
#define PG8_SCHED __builtin_amdgcn_sched_barrier(0)
    Unit cur, nxt; int ui = 0;
    if (!S.next(0, cur)) return;
    f32x4 acc[2][2][4][2];
#pragma unroll
    for (int a = 0; a < 2; ++a)
#pragma unroll
        for (int b = 0; b < 2; ++b)
#pragma unroll
            for (int m = 0; m < 4; ++m)
#pragma unroll
                for (int n = 0; n < 2; ++n) acc[a][b][m][n] = (f32x4){0.f, 0.f, 0.f, 0.f};
    bf16x8 At[4][2], B0[2][2], B1[2][2];
    const char* cA = GATHER ? (const char*)g.A : (const char*)g.A + (size_t)cur.pm * tstep; const char* cB = (const char*)g.Bt + (size_t)cur.bn * tstep;
    PG8_LOADG(0);
    PG8_STAGE(PG8_SB(0, 0), cB, voffB); PG8_STAGE_A(PG8_SA(0, 0), cA, 0); PG8_STAGE(PG8_SB(0, 1), cB + hstep, voffB); PG8_STAGE_A(PG8_SA(0, 1), cA, 1);
    if (wr == 1) PG8_BAR;
    PG8_WAIT_V(4); PG8_BAR;
    PG8_STAGE(PG8_SB(1, 0), cB + kstep, voffB); PG8_STAGE_A(PG8_SA(1, 0), cA + kstep, 0); PG8_STAGE(PG8_SB(1, 1), cB + hstep + kstep, voffB);
    PG8_WAIT_V(6); PG8_BAR;
    PG8_STAMP();
    for (;;) {
        const bool has_next = S.next(ui + 1, nxt);
        const char* nA = has_next ? (GATHER ? (const char*)g.A : (const char*)g.A + (size_t)nxt.pm * tstep) : cA; const char* nB = has_next ? (const char*)g.Bt + (size_t)nxt.bn * tstep : cB;
        for (int t = 0; t < nt; t += 2) {
            const bool last = (t == nt - 2);
            const char* a1 = cA + (size_t)(t + 1) * kstep;
            const char* a2 = last ? nA : cA + (size_t)(t + 2) * kstep; const char* b2 = last ? nB : cB + (size_t)(t + 2) * kstep;
            const char* a3 = a2 + kstep; const char* b3 = b2 + kstep;
            PG8_LDB(B0, 0, 0); PG8_SCHED; PG8_LDA(At, 0, 0); PG8_STAGE_A(PG8_SA(1, 1), a1, 1);
            PG8_WAIT_L(8); PG8_BAR; PG8_WAIT_L(0); PG8_MMA(0, 0, At, B0); PG8_BAR; PG8_SCHED;
            if (last && has_next) PG8_LOADG(ui + 1);
            PG8_LDB(B1, 0, 1); PG8_STAGE(PG8_SB(0, 0), b2, voffB);
            PG8_BAR; PG8_WAIT_L(0); PG8_MMA(0, 1, At, B1); PG8_BAR;
            PG8_LDA(At, 0, 1); PG8_STAGE_A(PG8_SA(0, 0), a2, 0);
            PG8_BAR; PG8_WAIT_L(0); PG8_MMA(1, 0, At, B0); PG8_BAR; PG8_SCHED;
            PG8_STAGE(PG8_SB(0, 1), b2 + hstep, voffB);
            PG8_WAIT_V(6); PG8_BAR; PG8_MMA(1, 1, At, B1); PG8_BAR;
            PG8_LDB(B0, 1, 0); PG8_SCHED; PG8_LDA(At, 1, 0); PG8_STAGE_A(PG8_SA(0, 1), a2, 1);
            PG8_WAIT_L(8); PG8_BAR; PG8_WAIT_L(0); PG8_MMA(0, 0, At, B0); PG8_BAR; PG8_SCHED;
            PG8_LDB(B1, 1, 1); PG8_STAGE(PG8_SB(1, 0), b3, voffB);
            PG8_BAR; PG8_WAIT_L(0); PG8_MMA(0, 1, At, B1); PG8_BAR;
            PG8_LDA(At, 1, 1); PG8_STAGE_A(PG8_SA(1, 0), a3, 0);
            PG8_BAR; PG8_WAIT_L(0); PG8_MMA(1, 0, At, B0); PG8_BAR; PG8_SCHED;
            PG8_STAGE(PG8_SB(1, 1), b3 + hstep, voffB);
            PG8_WAIT_V(6); PG8_BAR; PG8_MMA(1, 1, At, B1); PG8_BAR;
        }
        PG8_STAMP();
        E(acc, cur, wr, wc, fr, fq);
        PG8_STAMP();
        if (!has_next) break;
#pragma unroll
        for (int a = 0; a < 2; ++a)
#pragma unroll
            for (int b = 0; b < 2; ++b)
#pragma unroll
                for (int m = 0; m < 4; ++m)
#pragma unroll
                    for (int n = 0; n < 2; ++n) acc[a][b][m][n] = (f32x4){0.f, 0.f, 0.f, 0.f};
        cur = nxt; cA = nA; cB = nB; ++ui;
    }
    PG8_WAIT_V(0);
    if (wr == 0) PG8_BAR;
    PG8_BAR;
    PG8_STAMP();
#undef PG8_STAMP
#undef PG8_SA
#undef PG8_SB
#undef PG8_STAGE
#undef PG8_STAGE_A
#undef PG8_LOADG
#undef PG8_LDA
#undef PG8_LDB
#undef PG8_MMA
#undef PG8_WAIT_V
#undef PG8_WAIT_L
#undef PG8_BAR
#undef PG8_SCHED
}
}
namespace {
#define XB_TMO      128
#define XB_XCNT(j)  (256  + 64 * (j))
#define XB_XSUB(j)  (1280 + 64 * (j))
#define XB_XGEN(j)  (2304 + 64 * (j))
#define XB_TOP      3328
#define XB_TOPGEN   3392
#define XCD_BAR_WORDS 3456
#define XB_SPIN_CAP (1u << 18)

__device__ __forceinline__ unsigned xb_ld(unsigned* p)              { return __hip_atomic_load(p, __ATOMIC_RELAXED, __HIP_MEMORY_SCOPE_AGENT); }
__device__ __forceinline__ unsigned xb_add(unsigned* p, unsigned v) { return __hip_atomic_fetch_add(p, v, __ATOMIC_RELAXED, __HIP_MEMORY_SCOPE_AGENT); }
__device__ __forceinline__ unsigned xb_xcc_id() { return (unsigned)__builtin_amdgcn_s_getreg((3 << 11) | 20) & 0xFu; }
#define XB_SPIN(cond, bar) do { unsigned _sp = 0; while (cond) { __builtin_amdgcn_s_sleep(1); \
    if ((++_sp & 255u) == 0u) { if (xb_ld(&(bar)[XB_TMO])) break; if (_sp > XB_SPIN_CAP) { atomicAdd(&(bar)[XB_TMO], 1u); break; } } } } while (0)

struct XcdBarrier {
    unsigned* bar; unsigned x;
    volatile LAS unsigned* st;
};

__device__ __forceinline__ XcdBarrier xcd_barrier_post(unsigned* bar, volatile LAS unsigned* st) {
    XcdBarrier b; b.bar = bar; b.x = xb_xcc_id(); b.st = st;
    if (threadIdx.x == 0) (void)xb_add(&bar[XB_XCNT(b.x)], 1u);
    return b;
}
__device__ __forceinline__ void xcd_barrier_complete(unsigned* bar, unsigned x, unsigned& nloc, unsigned& nx) {
    const unsigned G = gridDim.x * gridDim.y * gridDim.z;
    unsigned sum, cnt, mine, sp = 0u;
    for (;;) {
        sum = 0u; cnt = 0u; mine = 0u;
#pragma unroll
        for (unsigned j = 0; j < 16; ++j) { const unsigned c = xb_ld(&bar[XB_XCNT(j)]); sum += c; cnt += (c > 0u) ? 1u : 0u; mine = (j == x) ? c : mine; }
        if (sum == G) break;
        __builtin_amdgcn_s_sleep(1);
        if ((++sp & 255u) == 0u) { if (xb_ld(&bar[XB_TMO])) break; if (sp > XB_SPIN_CAP) { atomicAdd(&bar[XB_TMO], 1u); break; } }
    }
    nloc = mine > 0u ? mine : 1u; nx = cnt > 0u ? cnt : 1u;
}

__device__ __forceinline__ void xcd_barrier(const XcdBarrier& b) {
    asm volatile("s_waitcnt vmcnt(0)" ::: "memory");
    __syncthreads();
    if (threadIdx.x == 0) {
        unsigned* bar = b.bar;
        __builtin_amdgcn_s_waitcnt(0);
        unsigned nloc = b.st[0], nx = b.st[1];
        if (nloc == 0u) { xcd_barrier_complete(bar, b.x, nloc, nx); b.st[0] = nloc; b.st[1] = nx; }
        const unsigned old = xb_add(&bar[XB_XSUB(b.x)], 1u);
        const unsigned gen = old / nloc;
        if (old + 1u == (gen + 1u) * nloc) {
            __builtin_amdgcn_fence(__ATOMIC_RELEASE, "agent");
            asm volatile("s_waitcnt vmcnt(0)" ::: "memory");
            const unsigned og = xb_add(&bar[XB_TOP], 1u);
            const unsigned tg = og / nx;
            if (og + 1u == (tg + 1u) * nx) xb_add(&bar[XB_TOPGEN], 1u);
            else XB_SPIN(xb_ld(&bar[XB_TOPGEN]) == tg, bar);
            __builtin_amdgcn_fence(__ATOMIC_ACQUIRE, "agent");
            xb_add(&bar[XB_XGEN(b.x)], 1u);
            asm volatile("s_waitcnt vmcnt(0)" ::: "memory");
        } else {
            XB_SPIN(xb_ld(&bar[XB_XGEN(b.x)]) == gen, bar);
            __builtin_amdgcn_fence(__ATOMIC_ACQUIRE, "agent");
            asm volatile("s_waitcnt vmcnt(0)" ::: "memory");
        }
    }
    __syncthreads();
}

}
namespace {
using pg8::f32x4; using pg8::u32x4; using pg8::cvt_pk_bf16;

template <class ARow, class Epi>
__device__ __forceinline__ void gemm_tile(float* smem, int mvalid, int nvalid, int K, ARow arow, const float* Bp, int ldb, Epi epi) {
  float* As = smem;
  float* Bs = smem + 16 * 68;
  const int tid = threadIdx.x, ty = tid >> 5, tx = tid & 31;
  float acc[4][4];
#pragma unroll
  for (int i = 0; i < 4; ++i)
#pragma unroll
    for (int j = 0; j < 4; ++j) acc[i][j] = 0.f;
  const int ak = tid & 15, ar = tid >> 4;
  const float* ap0 = (ar < mvalid) ? arow(ar) : nullptr;
  const float* ap1 = (ar + 32 < mvalid) ? arow(ar + 32) : nullptr;
  const int bn = tid & 127, bk = tid >> 7;
  for (int k0 = 0; k0 < K; k0 += 16) {
    As[ak * 68 + ar] = ap0 ? ap0[k0 + ak] : 0.f;
    As[ak * 68 + ar + 32] = ap1 ? ap1[k0 + ak] : 0.f;
#pragma unroll
    for (int i = 0; i < 4; ++i) { const int kk = bk + 4 * i; Bs[kk * 128 + bn] = (bn < nvalid) ? Bp[(size_t)(k0 + kk) * ldb + bn] : 0.f; }
    __syncthreads();
#pragma unroll
    for (int kk = 0; kk < 16; ++kk) {
      float a[4], b[4];
#pragma unroll
      for (int i = 0; i < 4; ++i) a[i] = As[kk * 68 + ty * 4 + i];
#pragma unroll
      for (int j = 0; j < 4; ++j) b[j] = Bs[kk * 128 + tx * 4 + j];
#pragma unroll
      for (int i = 0; i < 4; ++i)
#pragma unroll
        for (int j = 0; j < 4; ++j) acc[i][j] += a[i] * b[j];
    }
    __syncthreads();
  }
#pragma unroll
  for (int i = 0; i < 4; ++i)
#pragma unroll
    for (int j = 0; j < 4; ++j) { const int r = ty * 4 + i, c = tx * 4 + j; if (r < mvalid && c < nvalid) epi(r, c, acc[i][j]); }
}

template <class RowMap>
__device__ __forceinline__ void cvt_tile(const float* __restrict__ src, int N, int K, int k0, int n0, bf16_t* __restrict__ dst, RowMap rm) {
  const int lane = threadIdx.x & 63, w = threadIdx.x >> 6;
  const int n = n0 + (lane & 15) * 4, kk = k0 + (w * 4 + (lane >> 4)) * 8;
  if (n >= N) return;
  float4 v[8];
#pragma unroll
  for (int j = 0; j < 8; ++j) v[j] = *(const float4*)(src + (size_t)(kk + j) * N + n);
  u32x4 o;
  o.x = cvt_pk_bf16(v[0].x, v[1].x); o.y = cvt_pk_bf16(v[2].x, v[3].x); o.z = cvt_pk_bf16(v[4].x, v[5].x); o.w = cvt_pk_bf16(v[6].x, v[7].x);
  *(u32x4*)(dst + (size_t)rm(n + 0) * K + kk) = o;
  o.x = cvt_pk_bf16(v[0].y, v[1].y); o.y = cvt_pk_bf16(v[2].y, v[3].y); o.z = cvt_pk_bf16(v[4].y, v[5].y); o.w = cvt_pk_bf16(v[6].y, v[7].y);
  *(u32x4*)(dst + (size_t)rm(n + 1) * K + kk) = o;
  o.x = cvt_pk_bf16(v[0].z, v[1].z); o.y = cvt_pk_bf16(v[2].z, v[3].z); o.z = cvt_pk_bf16(v[4].z, v[5].z); o.w = cvt_pk_bf16(v[6].z, v[7].z);
  *(u32x4*)(dst + (size_t)rm(n + 2) * K + kk) = o;
  o.x = cvt_pk_bf16(v[0].w, v[1].w); o.y = cvt_pk_bf16(v[2].w, v[3].w); o.z = cvt_pk_bf16(v[4].w, v[5].w); o.w = cvt_pk_bf16(v[6].w, v[7].w);
  *(u32x4*)(dst + (size_t)rm(n + 3) * K + kk) = o;
}
template <class RowMap>
__device__ void cvt_job(const float* src, int nmat, int K, int N, bf16_t* dst, size_t dstride, RowMap rm) {
  const int kt = K / 256, ntl = (N + 63) / 64, per = kt * ntl;
  for (int it = blockIdx.x; it < nmat * per; it += gridDim.x) {
    const int m = it / per, r = it % per, k0 = (r / ntl) * 256, n0 = (r % ntl) * 64;
    cvt_tile(src + (size_t)m * K * N, N, K, k0, n0, dst + (size_t)m * dstride, rm);
  }
}
__device__ void ph_convert(const Params& p) {
  const size_t gtid = (size_t)blockIdx.x * NT + threadIdx.x, gsz = (size_t)gridDim.x * NT;
  for (size_t i = gtid; i < (size_t)T * D / 8; i += gsz) {
    const float4 a = *(const float4*)(p.x + i * 8), b = *(const float4*)(p.x + i * 8 + 4);
    u32x4 o; o.x = cvt_pk_bf16(a.x, a.y); o.y = cvt_pk_bf16(a.z, a.w); o.z = cvt_pk_bf16(b.x, b.y); o.w = cvt_pk_bf16(b.z, b.w);
    *(u32x4*)(p.xb + i * 8) = o;
  }
  cvt_job(p.w_in, 1, D, PW, p.WinT, 0, [](int n) { return n < O_DT ? n : (n < O_Q ? PLD + (n - O_DT) : n - 32); });
  for (size_t i = gtid; i < (size_t)(NPROJ - PW) * D / 8; i += gsz) *(u32x4*)(p.WinT + (size_t)PW * D + i * 8) = (u32x4){0u, 0u, 0u, 0u};
  cvt_job(p.w_out, 1, D, D, p.WoutT, 0, [](int n) { return n; });
  cvt_job(p.wg_e, NE, D, DE, p.WguT, (size_t)1024 * D, [](int n) { return (n >> 7) * 256 + (n & 127); });
  cvt_job(p.wu_e, NE, D, DE, p.WguT, (size_t)1024 * D, [](int n) { return (n >> 7) * 256 + 128 + (n & 127); });
  cvt_job(p.wg_s, 1, D, DE, p.WguT + (size_t)NE * 1024 * D, 0, [](int n) { return (n >> 7) * 256 + (n & 127); });
  cvt_job(p.wu_s, 1, D, DE, p.WguT + (size_t)NE * 1024 * D, 0, [](int n) { return (n >> 7) * 256 + 128 + (n & 127); });
  cvt_job(p.w_router, 1, D, NE, p.WrT, 0, [](int n) { return n; });
  cvt_job(p.wd_e, NE, DE, D, p.WdT, (size_t)D * DE, [](int n) { return n; });
  cvt_job(p.wd_s, 1, DE, D, p.WdT + (size_t)NE * D * DE, 0, [](int n) { return n; });
}

struct EpiProj {
  static constexpr bool PERM = true;
  bf16_t* proj; float* dt; const float* bias_f; const float* bias_b;
  __device__ __forceinline__ void operator()(const f32x4 (&acc)[2][2][4][2], const pg8::Unit& u, int wr, int wc, int fr, int fq) const {
    const int row0 = u.pm * 256 + wr * 64 + fr;
    if (u.pn < 22) {
      const int col0 = u.pn * 256 + wc * 32 + 8 * fq;
      const float sc = (u.pn >= 10 && u.pn < 14) ? QS : 1.0f;
#pragma unroll
      for (int ai = 0; ai < 2; ++ai)
#pragma unroll
        for (int m = 0; m < 4; ++m) { bf16_t* rowp = proj + (size_t)(row0 + ai * 128 + m * 16) * PLD + col0;
#pragma unroll
          for (int bj = 0; bj < 2; ++bj) { const f32x4 v0 = acc[ai][bj][m][0] * sc, v1 = acc[ai][bj][m][1] * sc;
            u32x4 w; w.x = cvt_pk_bf16(v0[0], v0[1]); w.y = cvt_pk_bf16(v0[2], v0[3]); w.z = cvt_pk_bf16(v1[0], v1[1]); w.w = cvt_pk_bf16(v1[2], v1[3]);
            *(u32x4*)(rowp + bj * 128) = w; } }
    } else if (wc == 0) {
      const int c0 = 8 * fq;
      float bs[8];
#pragma unroll
      for (int j = 0; j < 8; ++j) bs[j] = (c0 + j) < 16 ? bias_f[c0 + j] : bias_b[c0 + j - 16];
#pragma unroll
      for (int ai = 0; ai < 2; ++ai)
#pragma unroll
        for (int m = 0; m < 4; ++m) { float* rowp = dt + (size_t)(row0 + ai * 128 + m * 16) * 32 + c0;
          const f32x4 v0 = acc[ai][0][m][0], v1 = acc[ai][0][m][1];
          f32x4 o0, o1;
#pragma unroll
          for (int j = 0; j < 4; ++j) { o0[j] = softplus_f(v0[j] + bs[j]); o1[j] = softplus_f(v1[j] + bs[4 + j]); }
          *(f32x4*)rowp = o0; *(f32x4*)(rowp + 4) = o1; }
    }
  }
};
struct EpiOut {
  static constexpr bool PERM = false;
  const float* x; float* v;
  __device__ __forceinline__ void operator()(const f32x4 (&acc)[2][2][4][2], const pg8::Unit& u, int wr, int wc, int fr, int fq) const {
    const int row0 = u.pm * 256 + wr * 64 + fr, col0 = u.pn * 256 + wc * 32 + 4 * fq;
#pragma unroll
    for (int ai = 0; ai < 2; ++ai)
#pragma unroll
      for (int m = 0; m < 4; ++m) { const size_t off = (size_t)(row0 + ai * 128 + m * 16) * D + col0;
#pragma unroll
        for (int bj = 0; bj < 2; ++bj)
#pragma unroll
          for (int n = 0; n < 2; ++n) { const f32x4 xv = *(const f32x4*)(x + off + bj * 128 + n * 16); *(f32x4*)(v + off + bj * 128 + n * 16) = xv * ALPHA + acc[ai][bj][m][n]; } }
  }
};

namespace at {
using bf16x8 = __attribute__((ext_vector_type(8))) short;
using s16x4  = __attribute__((ext_vector_type(4))) short;
using f32x16 = __attribute__((ext_vector_type(16))) float;
using u32x4  = __attribute__((ext_vector_type(4))) unsigned;
constexpr int KVBLK = 64;
constexpr size_t SHM_V = KVBLK * 128 * 2, SHM_K = KVBLK * 128 * 2;
constexpr float THR2 = 8.0f;
#define AT_KSWZ(row, colB) ((row) * 256 + ((colB) ^ (((row) & 7) << 4)))
#define AT_SBAR() __builtin_amdgcn_sched_barrier(0)
__device__ __forceinline__ int crow(int r, int hi) { return (r & 3) + 8 * (r >> 2) + 4 * hi; }
__device__ __forceinline__ unsigned cvtpk(float lo, float hi) { unsigned r; asm volatile("v_cvt_pk_bf16_f32 %0, %1, %2" : "=v"(r) : "v"(lo), "v"(hi)); return r; }

__device__ __forceinline__ void partialSM(f32x16& p0, f32x16& p1, float dqh, float nsl2, float& m_reg, float& mn, float& alpha) {
#pragma unroll
  for (int r = 0; r < 16; ++r) { const float c = (float)((r & 3) + 8 * (r >> 2));
    p0[r] = fmaf(nsl2, fabsf(dqh - c), p0[r]); p1[r] = fmaf(nsl2, fabsf(dqh - (c + 32.f)), p1[r]); }
  float pmax = p0[0];
#pragma unroll
  for (int r = 1; r < 16; ++r) pmax = fmaxf(pmax, p0[r]);
#pragma unroll
  for (int r = 0; r < 16; ++r) pmax = fmaxf(pmax, p1[r]);
  { auto rr = __builtin_amdgcn_permlane32_swap(__float_as_uint(pmax), __float_as_uint(pmax), false, false);
    pmax = fmaxf(__uint_as_float(rr[0]), __uint_as_float(rr[1])); }
  if (__builtin_expect(__all(pmax - m_reg <= THR2), 1)) { mn = m_reg; alpha = 1.f; }
  else { mn = fmaxf(m_reg, pmax); alpha = __builtin_amdgcn_exp2f(m_reg - mn); m_reg = mn; }
#pragma unroll
  for (int r = 0; r < 16; ++r) p0[r] = p0[r] - mn;
#pragma unroll
  for (int r = 0; r < 16; ++r) p1[r] = p1[r] - mn;
#pragma unroll
  for (int r = 0; r < 16; ++r) p0[r] = __builtin_amdgcn_exp2f(p0[r]);
}
__device__ __forceinline__ void finishSM(f32x16& p0, f32x16& p1, float alpha, float& l_reg, bf16x8& pa0, bf16x8& pa1, bf16x8& pa2, bf16x8& pa3) {
#pragma unroll
  for (int r = 0; r < 16; ++r) p1[r] = __builtin_amdgcn_exp2f(p1[r]);
  float ps = 0;
#pragma unroll
  for (int r = 0; r < 16; ++r) ps += p0[r];
#pragma unroll
  for (int r = 0; r < 16; ++r) ps += p1[r];
  { auto rr = __builtin_amdgcn_permlane32_swap(__float_as_uint(ps), __float_as_uint(ps), false, false);
    ps = __uint_as_float(rr[0]) + __uint_as_float(rr[1]); }
  l_reg = l_reg * alpha + ps;
#define AT_PK4(P, BASE, OUT) do { unsigned a0 = cvtpk(P[BASE + 0], P[BASE + 1]), a1 = cvtpk(P[BASE + 2], P[BASE + 3]);   \
    unsigned b0 = cvtpk(P[BASE + 4], P[BASE + 5]), b1 = cvtpk(P[BASE + 6], P[BASE + 7]);                              \
    auto r0 = __builtin_amdgcn_permlane32_swap(a0, b0, false, false); auto r1 = __builtin_amdgcn_permlane32_swap(a1, b1, false, false); \
    u32x4 w = {r0[0], r1[0], r0[1], r1[1]}; OUT = *reinterpret_cast<bf16x8*>(&w); } while (0)
  AT_PK4(p0, 0, pa0); AT_PK4(p0, 8, pa1); AT_PK4(p1, 0, pa2); AT_PK4(p1, 8, pa3);
#undef AT_PK4
}
__device__ __forceinline__ void qkt(f32x16& p0, f32x16& p1, const char* Ks, const bf16x8* qr, int r32, int hi, int cm) {
  p0 = f32x16{}; p1 = f32x16{};
#pragma unroll
  for (int d0 = 0; d0 < 4; ++d0) { const int cb = (cm + d0 * 16 + hi * 8) * 2;
    bf16x8 b0 = *reinterpret_cast<const bf16x8*>(Ks + AT_KSWZ(r32, cb));
    bf16x8 b1 = *reinterpret_cast<const bf16x8*>(Ks + AT_KSWZ(32 + r32, cb));
    p0 = __builtin_amdgcn_mfma_f32_32x32x16_bf16(b0, qr[d0], p0, 0, 0, 0);
    p1 = __builtin_amdgcn_mfma_f32_32x32x16_bf16(b1, qr[d0], p1, 0, 0, 0); }
}
__device__ __forceinline__ int v_st(int k, int c) { const int kk = (k & ~0xC) | ((k & 4) << 1) | ((k & 8) >> 1); return ((kk >> 3) * 4 + (c >> 5)) * 512 + ((kk & 7) * 32 + (c & 31)) * 2; }
__device__ __forceinline__ int v_rd_base(int lane) { return ((lane & 3) << 3) | (((lane >> 2) & 3) << 6) | (((lane >> 4) & 1) << 5) | (((lane >> 5) & 1) << 8); }
constexpr int v_rd_off(int d0, int ks, int half) { return d0 * 512 + ks * 4096 + half * 2048; }
template <int OFF> __device__ __forceinline__ s16x4 tr_read(int vb) {
  s16x4 r; asm volatile("ds_read_b64_tr_b16 %0, %1 offset:%2" : "=&v"(r) : "v"(vb), "i"(OFF) : "memory"); return r;
}
template <int D0> __device__ __forceinline__ void pv_one(f32x16& od, int vb, bf16x8 pa0, bf16x8 pa1, bf16x8 pa2, bf16x8 pa3) {
  const s16x4 l0 = tr_read<v_rd_off(D0, 0, 0)>(vb), h0 = tr_read<v_rd_off(D0, 0, 1)>(vb), l1 = tr_read<v_rd_off(D0, 1, 0)>(vb), h1 = tr_read<v_rd_off(D0, 1, 1)>(vb);
  const s16x4 l2 = tr_read<v_rd_off(D0, 2, 0)>(vb), h2 = tr_read<v_rd_off(D0, 2, 1)>(vb), l3 = tr_read<v_rd_off(D0, 3, 0)>(vb), h3 = tr_read<v_rd_off(D0, 3, 1)>(vb);
  asm volatile("s_waitcnt lgkmcnt(0)" ::: "memory"); AT_SBAR();
#define AT_PK(L, H) (bf16x8){L[0], L[1], L[2], L[3], H[0], H[1], H[2], H[3]}
  od = __builtin_amdgcn_mfma_f32_32x32x16_bf16(pa0, AT_PK(l0, h0), od, 0, 0, 0);
  od = __builtin_amdgcn_mfma_f32_32x32x16_bf16(pa1, AT_PK(l1, h1), od, 0, 0, 0);
  od = __builtin_amdgcn_mfma_f32_32x32x16_bf16(pa2, AT_PK(l2, h2), od, 0, 0, 0);
  od = __builtin_amdgcn_mfma_f32_32x32x16_bf16(pa3, AT_PK(l3, h3), od, 0, 0, 0);
#undef AT_PK
}
__device__ __forceinline__ void pv_d0(f32x16* o, int vb, bf16x8 pa0, bf16x8 pa1, bf16x8 pa2, bf16x8 pa3) {
  pv_one<0>(o[0], vb, pa0, pa1, pa2, pa3); pv_one<1>(o[1], vb, pa0, pa1, pa2, pa3); pv_one<2>(o[2], vb, pa0, pa1, pa2, pa3); pv_one<3>(o[3], vb, pa0, pa1, pa2, pa3);
}

__device__ __forceinline__ void attn_item(const bf16_t* __restrict__ Qb, const bf16_t* __restrict__ Kh, const bf16_t* __restrict__ Vh, bf16_t* __restrict__ Ub,
                                          int q0, float nsl2, float lam, const float* __restrict__ normw, char* lds) {
  constexpr int LDK = PLD;
  int tid = threadIdx.x; asm volatile("" : "+v"(tid));
  const int wid = tid >> 6, lane = tid & 63, r32 = lane & 31, hi = lane >> 5, rg = wid >> 1, cmap = wid & 1, cm = cmap * 64;
  char* V_lds = lds; char* K_lds = lds + 2 * SHM_V;
  float* ws = (float*)(lds + 2 * SHM_V + 2 * SHM_K) + wid * 64; float* li_l = ws; float* al_l = ws + 32;
  float m_reg = -1e30f, l_reg = 0; f32x16 o[4] = {}; bf16x8 qr[4];
  const bf16_t* Qw = Qb + (size_t)(rg * 32 + r32) * LDK + cm + hi * 8;
#pragma unroll
  for (int d0 = 0; d0 < 4; ++d0) qr[d0] = *reinterpret_cast<const bf16x8*>(Qw + d0 * 16);
  const int sr = tid >> 4, sc = (tid & 15) * 8, vst0 = v_st(sr, sc), vst1 = v_st(32 + sr, sc);
  const int vb0 = (int)(uintptr_t)V_lds + v_rd_base(lane);
  const float qposh = (float)(q0 + rg * 32 + r32 - 4 * hi);
  struct { bf16x8 vs0, vs1, ks0, ks1; } sr_[2];
#define SLOAD(i, k0) do { sr_[i].vs0 = *reinterpret_cast<const bf16x8*>(&Vh[(size_t)((k0) + sr) * LDK + sc]); sr_[i].vs1 = *reinterpret_cast<const bf16x8*>(&Vh[(size_t)((k0) + 32 + sr) * LDK + sc]); \
    sr_[i].ks0 = *reinterpret_cast<const bf16x8*>(&Kh[(size_t)((k0) + sr) * LDK + sc]); sr_[i].ks1 = *reinterpret_cast<const bf16x8*>(&Kh[(size_t)((k0) + 32 + sr) * LDK + sc]); } while (0)
#define SWRITE(b, i) do { *(bf16x8*)(V_lds + (b) * SHM_V + vst0) = sr_[i].vs0;          \
    *(bf16x8*)(V_lds + (b) * SHM_V + vst1) = sr_[i].vs1; int kc = sc * 2;               \
    *(bf16x8*)(K_lds + (b) * SHM_K + AT_KSWZ(sr, kc)) = sr_[i].ks0;                       \
    *(bf16x8*)(K_lds + (b) * SHM_K + AT_KSWZ(32 + sr, kc)) = sr_[i].ks1; } while (0)
#define SWAIT() asm volatile("s_waitcnt vmcnt(4)" ::: "memory")
#define RESC(a) do { if (__any((a) < 1.f)) { if (hi == 0) al_l[r32] = (a); asm volatile("s_waitcnt lgkmcnt(0)" ::: "memory"); \
    _Pragma("unroll") for (int d = 0; d < 4; ++d) _Pragma("unroll") for (int r = 0; r < 16; ++r) o[d][r] *= al_l[crow(r, hi)]; } } while (0)
  f32x16 pA0, pA1, pB0, pB1; float mnA, mnB, alA, alB; bf16x8 pa0, pa1, pa2, pa3; constexpr int NTL = S / KVBLK;
  constexpr int SE = 0, SO = 1;
  SLOAD(SE, 0); asm volatile("s_waitcnt vmcnt(0)" ::: "memory"); SWRITE(0, SE); __syncthreads();
  qkt(pA0, pA1, K_lds, qr, r32, hi, cm); partialSM(pA0, pA1, qposh, nsl2, m_reg, mnA, alA);
  SLOAD(SO, KVBLK); SLOAD(SE, 2 * KVBLK);
  SWAIT(); SWRITE(1, SO); __syncthreads();
  for (int j = 1; j + 1 < NTL; j += 2) {
    AT_SBAR(); qkt(pB0, pB1, K_lds + SHM_K, qr, r32, hi, cm);
    finishSM(pA0, pA1, alA, l_reg, pa0, pa1, pa2, pa3); AT_SBAR();
    SLOAD(SO, (j + 2) * KVBLK); AT_SBAR();
    pv_d0(o, vb0, pa0, pa1, pa2, pa3); partialSM(pB0, pB1, qposh - (float)(j * KVBLK), nsl2, m_reg, mnB, alB);
    __syncthreads(); SWAIT(); SWRITE(0, SE);
    RESC(alB); __syncthreads();
    AT_SBAR(); qkt(pA0, pA1, K_lds, qr, r32, hi, cm);
    finishSM(pB0, pB1, alB, l_reg, pa0, pa1, pa2, pa3); AT_SBAR();
    if (j + 3 < NTL) SLOAD(SE, (j + 3) * KVBLK); AT_SBAR();
    pv_d0(o, vb0 + (int)SHM_V, pa0, pa1, pa2, pa3); partialSM(pA0, pA1, qposh - (float)((j + 1) * KVBLK), nsl2, m_reg, mnA, alA);
    __syncthreads(); SWAIT(); SWRITE(1, SO);
    RESC(alA); __syncthreads();
  }
  AT_SBAR(); qkt(pB0, pB1, K_lds + SHM_K, qr, r32, hi, cm);
  finishSM(pA0, pA1, alA, l_reg, pa0, pa1, pa2, pa3); AT_SBAR();
  pv_d0(o, vb0, pa0, pa1, pa2, pa3); partialSM(pB0, pB1, qposh - (float)((NTL - 1) * KVBLK), nsl2, m_reg, mnB, alB);
  __syncthreads(); RESC(alB);
  finishSM(pB0, pB1, alB, l_reg, pa0, pa1, pa2, pa3); AT_SBAR();
  pv_d0(o, vb0 + (int)SHM_V, pa0, pa1, pa2, pa3);
  if (hi == 0) li_l[r32] = l_reg; asm volatile("s_waitcnt lgkmcnt(0)" ::: "memory");
  float rli[16];
#pragma unroll
  for (int r = 0; r < 16; ++r) rli[r] = __builtin_amdgcn_rcpf(li_l[crow(r, hi)]);
#pragma unroll
  for (int d = 0; d < 4; ++d)
#pragma unroll
    for (int r = 0; r < 16; ++r) o[d][r] *= rli[r];
  __syncthreads();
  float* X = (float*)lds + rg * (32 * 128);
  if (cmap == 1) {
#pragma unroll
    for (int d = 0; d < 4; ++d)
#pragma unroll
      for (int r = 0; r < 16; ++r) X[crow(r, hi) * 128 + d * 32 + r32] = o[d][r];
  }
  __syncthreads();
  if (cmap == 0) {
    float ss[16];
#pragma unroll
    for (int r = 0; r < 16; ++r) ss[r] = 0.f;
#pragma unroll
    for (int d = 0; d < 4; ++d)
#pragma unroll
      for (int r = 0; r < 16; ++r) { const float v = o[d][r] - lam * X[crow(r, hi) * 128 + d * 32 + r32]; o[d][r] = v; ss[r] += v * v; }
#pragma unroll
    for (int r = 0; r < 16; ++r) { float s = ss[r]; s += __shfl_xor(s, 16); s += __shfl_xor(s, 8); s += __shfl_xor(s, 4); s += __shfl_xor(s, 2); s += __shfl_xor(s, 1);
      ss[r] = rsqrtf(s * (1.f / 128.f) + 1e-5f) * (1.f - LAMBDA_INIT); }
    float nw[4];
#pragma unroll
    for (int d = 0; d < 4; ++d) nw[d] = normw[d * 32 + r32];
#pragma unroll
    for (int r = 0; r < 16; ++r) { bf16_t* up = Ub + (size_t)(rg * 32 + crow(r, hi)) * D + r32;
#pragma unroll
      for (int d = 0; d < 4; ++d) up[d * 32] = f2bf(o[d][r] * ss[r] * nw[d]); }
  }
  __syncthreads();
#undef SLOAD
#undef SWRITE
#undef SWAIT
#undef RESC
}
}

__device__ void ph_attn_mfma(const Params& p, char* lds, int* qhead) {
  float lam;
  { float s1 = 0.f, s2 = 0.f; for (int i = 0; i < 64; ++i) { s1 += p.lq1[i] * p.lk1[i]; s2 += p.lq2[i] * p.lk2[i]; } lam = __expf(s1) - __expf(s2) + LAMBDA_INIT; }
  int* qslot = (int*)(lds + 72 * 1024);
  for (;;) {
    __syncthreads();
    if (threadIdx.x == 0) *qslot = atomicAdd(qhead, 1);
    __syncthreads();
    const int item = *qslot;
    if (item >= NB * AH * (S / 128)) break;
    const int qb = item % (S / 128), h = (item / (S / 128)) % AH, b = item / ((S / 128) * AH);
    const float nsl2 = -exp2f(-(float)(h + 1)) * LOG2E;
    const size_t row0 = (size_t)b * S;
    at::attn_item(p.proj + (row0 + qb * 128) * PLD + N_Q + h * 128, p.proj + row0 * PLD + N_K + h * 128, p.proj + row0 * PLD + N_V + h * 128,
                  p.u + (row0 + qb * 128) * D + DSSD + h * 128, qb * 128, nsl2, lam, p.attn_norm_w, lds);
  }
}
namespace sd {
using at::bf16x8; using at::s16x4; using at::f32x16; using at::u32x4; using at::crow; using at::cvtpk; using at::v_st; using at::v_rd_base; using at::v_rd_off; using at::tr_read;
constexpr int CH = 64, NCH = S / CH;
constexpr int L_BT = 0, L_CT = 16384, L_XV = 32768, L_TAB = 98304, L_SS = 106496;
constexpr size_t SNAP = 16384;
__device__ __forceinline__ size_t snap_off(int dir, int b, int h, int c) { return ((((size_t)dir * NB + b) * NH + h) * NCH + c) * SNAP; }

__device__ void ph_conv16(const Params& p) {
  constexpr int SEG = 16, NCG = CC / 8, NU = NCG * (T / SEG);
  for (int u = blockIdx.x * NT + threadIdx.x; u < NU; u += gridDim.x * NT) {
    const int cg = u % NCG, seg = u / NCG, t0 = seg * SEG, s0 = t0 % S, chan = cg * 8;
    float w[5][8], bias[8];
#pragma unroll
    for (int j = 0; j < 5; ++j) { const float4 a = *(const float4*)(p.conv_w + j * CC + chan), c = *(const float4*)(p.conv_w + j * CC + chan + 4);
      w[j][0] = a.x; w[j][1] = a.y; w[j][2] = a.z; w[j][3] = a.w; w[j][4] = c.x; w[j][5] = c.y; w[j][6] = c.z; w[j][7] = c.w; }
    { const float4 a = *(const float4*)(p.conv_b + chan), c = *(const float4*)(p.conv_b + chan + 4);
      bias[0] = a.x; bias[1] = a.y; bias[2] = a.z; bias[3] = a.w; bias[4] = c.x; bias[5] = c.y; bias[6] = c.z; bias[7] = c.w; }
    const bf16_t* base = p.proj + (size_t)t0 * PLD + N_XBC + chan;
    u32x4 rows[SEG + 4];
#pragma unroll
    for (int i = 0; i < SEG + 4; ++i) { const int s = s0 + i - 2; rows[i] = (u32x4){0u, 0u, 0u, 0u}; if (s >= 0 && s < S) rows[i] = *(const u32x4*)(base + (ptrdiff_t)(i - 2) * PLD); }
#pragma unroll
    for (int i = 0; i < SEG; ++i) {
      float o[8];
#pragma unroll
      for (int c = 0; c < 8; ++c) o[c] = bias[c];
#pragma unroll
      for (int j = 0; j < 5; ++j) { const u32x4 rr = rows[i + j];
        o[0] += w[j][0] * __uint_as_float(rr.x << 16); o[1] += w[j][1] * __uint_as_float(rr.x & 0xffff0000u);
        o[2] += w[j][2] * __uint_as_float(rr.y << 16); o[3] += w[j][3] * __uint_as_float(rr.y & 0xffff0000u);
        o[4] += w[j][4] * __uint_as_float(rr.z << 16); o[5] += w[j][5] * __uint_as_float(rr.z & 0xffff0000u);
        o[6] += w[j][6] * __uint_as_float(rr.w << 16); o[7] += w[j][7] * __uint_as_float(rr.w & 0xffff0000u); }
#pragma unroll
      for (int c = 0; c < 8; ++c) o[c] = o[c] * __builtin_amdgcn_rcpf(1.f + __expf(-o[c]));
      u32x4 pk; pk.x = cvtpk(o[0], o[1]); pk.y = cvtpk(o[2], o[3]); pk.z = cvtpk(o[4], o[5]); pk.w = cvtpk(o[6], o[7]);
      *(u32x4*)(p.xc16 + (size_t)(t0 + i) * CC + chan) = pk;
    }
  }
}
template <bool WITH_C, bool BV>
__device__ __forceinline__ void load_chunk(const Params& p, char* lds, int b, int g, int c0) {
  constexpr int NCG = WITH_C ? 96 : 80, NP = NCG * CH / NT;
  int tid = threadIdx.x; asm volatile("" : "+v"(tid));
  const bf16_t* src = p.xc16 + ((size_t)b * S + c0) * CC;
  u32x4 v[NP];
#pragma unroll
  for (int i = 0; i < NP; ++i) { const int idx = tid + NT * i, tok = idx / NCG, cg = idx % NCG;
    const int chan = cg < 64 ? g * 512 + cg * 8 : (cg < 80 ? 1024 + g * 128 + (cg - 64) * 8 : 1280 + g * 128 + (cg - 80) * 8);
    v[i] = *(const u32x4*)(src + (size_t)tok * CC + chan); }
#pragma unroll
  for (int i = 0; i < NP; ++i) { const int idx = tid + NT * i, tok = idx / NCG, cg = idx % NCG;
    if (cg < 64) { const int hl = cg >> 3, c = (hl & 1) * 64 + (cg & 7) * 8; *(u32x4*)(lds + L_XV + (hl >> 1) * 16384 + v_st(tok, c)) = v[i]; }
    else if (cg < 80) { const int n0 = (cg - 64) * 8; if (BV) *(u32x4*)(lds + L_BT + v_st(tok, n0)) = v[i]; else *(u32x4*)(lds + L_BT + AT_KSWZ(tok, n0 * 2)) = v[i]; }
    else { const int n0 = (cg - 80) * 8; *(u32x4*)(lds + L_CT + AT_KSWZ(tok, n0 * 2)) = v[i]; } }
}
__device__ __forceinline__ float wave_incl_prefix(float v, int lane) {
#pragma unroll
  for (int o = 1; o < 64; o <<= 1) { const float t = __int_as_float(__builtin_amdgcn_ds_bpermute(((lane - o) & 63) << 2, __float_as_int(v))); if (lane >= o) v += t; }
  return v;
}
__device__ __forceinline__ float wave_incl_suffix(float v, int lane) {
#pragma unroll
  for (int o = 1; o < 64; o <<= 1) { const float t = __int_as_float(__builtin_amdgcn_ds_bpermute(((lane + o) & 63) << 2, __float_as_int(v))); if (lane + o < 64) v += t; }
  return v;
}
__device__ __forceinline__ float wave_bcast(float v, int src) { return __int_as_float(__builtin_amdgcn_ds_bpermute(src << 2, __float_as_int(v))); }
__device__ __forceinline__ bf16x8 scale_frag(s16x4 lo, s16x4 hi, const float4 w0, const float4 w1) {
  const unsigned a = ((unsigned)(unsigned short)lo[0]) | ((unsigned)(unsigned short)lo[1] << 16), b = ((unsigned)(unsigned short)lo[2]) | ((unsigned)(unsigned short)lo[3] << 16);
  const unsigned c = ((unsigned)(unsigned short)hi[0]) | ((unsigned)(unsigned short)hi[1] << 16), d = ((unsigned)(unsigned short)hi[2]) | ((unsigned)(unsigned short)hi[3] << 16);
  u32x4 r;
  r.x = cvtpk(__uint_as_float(a << 16) * w0.x, __uint_as_float(a & 0xffff0000u) * w0.y);
  r.y = cvtpk(__uint_as_float(b << 16) * w0.z, __uint_as_float(b & 0xffff0000u) * w0.w);
  r.z = cvtpk(__uint_as_float(c << 16) * w1.x, __uint_as_float(c & 0xffff0000u) * w1.y);
  r.w = cvtpk(__uint_as_float(d << 16) * w1.z, __uint_as_float(d & 0xffff0000u) * w1.w);
  return *reinterpret_cast<bf16x8*>(&r);
}
#define SD_PK(L, H) (bf16x8){L[0], L[1], L[2], L[3], H[0], H[1], H[2], H[3]}

__device__ __forceinline__ void pass_a_item(const Params& p, char* lds, char* snap, int b, int g, int dir) {
  int tid = threadIdx.x; asm volatile("" : "+v"(tid));
  const int hl = tid >> 6, lane = tid & 63, r32 = lane & 31, hi = lane >> 5, h = g * 8 + hl;
  const float a = -__expf(dir ? p.a_log_b[h] : p.a_log_f[h]);
  float* wtab = (float*)(lds + L_TAB) + hl * 64;
  const int vbx = (int)(uintptr_t)(lds + L_XV + (hl >> 1) * 16384) + v_rd_base(lane) + (hl & 1) * 1024;
  const int vbb = (int)(uintptr_t)(lds + L_BT) + v_rd_base(lane);
  f32x16 st[4][2];
#pragma unroll
  for (int nb = 0; nb < 4; ++nb)
#pragma unroll
    for (int pb = 0; pb < 2; ++pb) st[nb][pb] = f32x16{};
  for (int ci = 0; ci < NCH; ++ci) {
    const int c = dir ? (NCH - 1 - ci) : ci, c0 = c * CH;
    __syncthreads();
    load_chunk<false, true>(p, lds, b, g, c0);
    const float dtv = p.dt[((size_t)b * S + c0 + lane) * 32 + dir * 16 + h];
    const float adt = a * dtv;
    const float cum = dir ? wave_incl_suffix(adt, lane) : wave_incl_prefix(adt, lane);
    const float total = wave_bcast(cum, dir ? 0 : 63);
    wtab[lane] = __expf(total - cum) * dtv;
    const float dec = __expf(total);
    { char* sp = snap + snap_off(dir, b, h, c);
#pragma unroll
      for (int nb = 0; nb < 4; ++nb)
#pragma unroll
        for (int pb = 0; pb < 2; ++pb)
#pragma unroll
          for (int q = 0; q < 4; ++q) { const f32x16& s = st[nb][pb];
            uint2 v; v.x = cvtpk(s[4 * q + 0], s[4 * q + 1]); v.y = cvtpk(s[4 * q + 2], s[4 * q + 3]);
            *(uint2*)(sp + ((((pb * 8 + nb * 2 + (q >> 1)) * 2 + (q & 1)) * 32 + r32) * 16 + hi * 8)) = v; } }
#pragma unroll
    for (int nb = 0; nb < 4; ++nb)
#pragma unroll
      for (int pb = 0; pb < 2; ++pb)
#pragma unroll
        for (int r = 0; r < 16; ++r) st[nb][pb][r] *= dec;
    __syncthreads();
#pragma unroll
    for (int ks = 0; ks < 4; ++ks) {
      const float4 w0 = *(const float4*)(wtab + ks * 16 + hi * 8), w1 = *(const float4*)(wtab + ks * 16 + hi * 8 + 4);
      bf16x8 xf[2];
      { const s16x4 l0 = tr_read<v_rd_off(0, 0, 0)>(vbx + ks * 4096), h0 = tr_read<v_rd_off(0, 0, 1)>(vbx + ks * 4096), l1 = tr_read<v_rd_off(1, 0, 0)>(vbx + ks * 4096), h1 = tr_read<v_rd_off(1, 0, 1)>(vbx + ks * 4096);
        asm volatile("s_waitcnt lgkmcnt(0)" ::: "memory"); AT_SBAR();
        xf[0] = scale_frag(l0, h0, w0, w1); xf[1] = scale_frag(l1, h1, w0, w1); }
#pragma unroll
      for (int nb = 0; nb < 4; ++nb) {
        s16x4 bl, bh;
        asm volatile("ds_read_b64_tr_b16 %0, %1" : "=&v"(bl) : "v"(vbb + nb * 512 + ks * 4096) : "memory");
        asm volatile("ds_read_b64_tr_b16 %0, %1 offset:2048" : "=&v"(bh) : "v"(vbb + nb * 512 + ks * 4096) : "memory");
        asm volatile("s_waitcnt lgkmcnt(0)" ::: "memory"); AT_SBAR();
        const bf16x8 bfr = SD_PK(bl, bh);
        st[nb][0] = __builtin_amdgcn_mfma_f32_32x32x16_bf16(bfr, xf[0], st[nb][0], 0, 0, 0);
        st[nb][1] = __builtin_amdgcn_mfma_f32_32x32x16_bf16(bfr, xf[1], st[nb][1], 0, 0, 0);
      }
    }
  }
  __syncthreads();
}

__device__ __forceinline__ void pass_b_item(const Params& p, char* lds, const char* snap, int b, int g, int c) {
  int tid = threadIdx.x; asm volatile("" : "+v"(tid));
  const int hl = tid >> 6, lane = tid & 63, r32 = lane & 31, hi = lane >> 5, h = g * 8 + hl, c0 = c * CH;
  float4* tab = (float4*)(lds + L_TAB) + hl * 64;
  float* ssp = (float*)(lds + L_SS);
  const int vbx = (int)(uintptr_t)(lds + L_XV + (hl >> 1) * 16384) + v_rd_base(lane) + (hl & 1) * 1024;
  __syncthreads();
  load_chunk<true, false>(p, lds, b, g, c0);
  { const size_t tok = (size_t)b * S + c0 + lane;
    const float dtf = p.dt[tok * 32 + h], dtb = p.dt[tok * 32 + 16 + h];
    const float af = -__expf(p.a_log_f[h]) * dtf, ab = -__expf(p.a_log_b[h]) * dtb;
    tab[lane] = make_float4(wave_incl_prefix(af, lane) * LOG2E, wave_incl_suffix(ab, lane) * LOG2E, dtf, dtb); }
  __syncthreads();
  const float dsk = p.d_skip[h];
  f32x16 o[2][2];
#pragma unroll
  for (int lb = 0; lb < 2; ++lb) {
    const int l = lb * 32 + r32;
    const float4 tl = tab[l];
    bf16x8 cr[8];
#pragma unroll
    for (int kk = 0; kk < 8; ++kk) cr[kk] = *reinterpret_cast<const bf16x8*>(lds + L_CT + AT_KSWZ(l, (kk * 16 + hi * 8) * 2));
    f32x16 p0 = f32x16{}, p1 = f32x16{};
#pragma unroll
    for (int kk = 0; kk < 8; ++kk) { const int cb = (kk * 16 + hi * 8) * 2;
      const bf16x8 b0 = *reinterpret_cast<const bf16x8*>(lds + L_BT + AT_KSWZ(r32, cb));
      const bf16x8 b1 = *reinterpret_cast<const bf16x8*>(lds + L_BT + AT_KSWZ(32 + r32, cb));
      p0 = __builtin_amdgcn_mfma_f32_32x32x16_bf16(b0, cr[kk], p0, 0, 0, 0);
      p1 = __builtin_amdgcn_mfma_f32_32x32x16_bf16(b1, cr[kk], p1, 0, 0, 0); }
#pragma unroll
    for (int r = 0; r < 16; ++r) {
#pragma unroll
      for (int half = 0; half < 2; ++half) {
        const int s = crow(r, hi) + 32 * half; const float4 ts = tab[s];
        float m = 0.f;
        if (s <= l) m += __builtin_amdgcn_exp2f(tl.x - ts.x) * ts.z;
        if (s >= l) m += __builtin_amdgcn_exp2f(tl.y - ts.y) * ts.w;
        const float add = (s == l) ? dsk : 0.f;
        if (half) p1[r] = p1[r] * m + add; else p0[r] = p0[r] * m + add;
      }
      asm volatile("" ::: "memory");
    }
    bf16x8 pa0, pa1, pa2, pa3;
#define SD_PK4(P, BASE, OUT) do { unsigned a0 = cvtpk(P[BASE + 0], P[BASE + 1]), a1 = cvtpk(P[BASE + 2], P[BASE + 3]);   \
    unsigned b0_ = cvtpk(P[BASE + 4], P[BASE + 5]), b1_ = cvtpk(P[BASE + 6], P[BASE + 7]);                              \
    auto r0 = __builtin_amdgcn_permlane32_swap(a0, b0_, false, false); auto r1 = __builtin_amdgcn_permlane32_swap(a1, b1_, false, false); \
    u32x4 w_ = {r0[0], r1[0], r0[1], r1[1]}; OUT = *reinterpret_cast<bf16x8*>(&w_); } while (0)
    SD_PK4(p0, 0, pa0); SD_PK4(p0, 8, pa1); SD_PK4(p1, 0, pa2); SD_PK4(p1, 8, pa3);
#undef SD_PK4
#pragma unroll
    for (int d = 0; d < 2; ++d) {
      const s16x4 l0 = d ? tr_read<v_rd_off(1, 0, 0)>(vbx) : tr_read<v_rd_off(0, 0, 0)>(vbx), h0 = d ? tr_read<v_rd_off(1, 0, 1)>(vbx) : tr_read<v_rd_off(0, 0, 1)>(vbx);
      const s16x4 l1 = d ? tr_read<v_rd_off(1, 1, 0)>(vbx) : tr_read<v_rd_off(0, 1, 0)>(vbx), h1 = d ? tr_read<v_rd_off(1, 1, 1)>(vbx) : tr_read<v_rd_off(0, 1, 1)>(vbx);
      const s16x4 l2 = d ? tr_read<v_rd_off(1, 2, 0)>(vbx) : tr_read<v_rd_off(0, 2, 0)>(vbx), h2 = d ? tr_read<v_rd_off(1, 2, 1)>(vbx) : tr_read<v_rd_off(0, 2, 1)>(vbx);
      const s16x4 l3 = d ? tr_read<v_rd_off(1, 3, 0)>(vbx) : tr_read<v_rd_off(0, 3, 0)>(vbx), h3 = d ? tr_read<v_rd_off(1, 3, 1)>(vbx) : tr_read<v_rd_off(0, 3, 1)>(vbx);
      asm volatile("s_waitcnt lgkmcnt(0)" ::: "memory"); AT_SBAR();
      f32x16 od = f32x16{};
      od = __builtin_amdgcn_mfma_f32_32x32x16_bf16(pa0, SD_PK(l0, h0), od, 0, 0, 0);
      od = __builtin_amdgcn_mfma_f32_32x32x16_bf16(pa1, SD_PK(l1, h1), od, 0, 0, 0);
      od = __builtin_amdgcn_mfma_f32_32x32x16_bf16(pa2, SD_PK(l2, h2), od, 0, 0, 0);
      od = __builtin_amdgcn_mfma_f32_32x32x16_bf16(pa3, SD_PK(l3, h3), od, 0, 0, 0);
      o[lb][d] = od;
    }
  }
#pragma unroll
  for (int dir = 0; dir < 2; ++dir) {
    if (dir == 0 ? (c == 0) : (c == NCH - 1)) continue;
    const char* sp = snap + snap_off(dir, b, h, c);
#pragma unroll
    for (int d = 0; d < 2; ++d) {
      bf16x8 sf[8];
#pragma unroll
      for (int kk = 0; kk < 8; ++kk) sf[kk] = *reinterpret_cast<const bf16x8*>(sp + ((((d * 8 + kk) * 2 + hi) * 32 + r32) * 16));
#pragma unroll
      for (int lb = 0; lb < 2; ++lb) {
        f32x16 acc = f32x16{};
#pragma unroll
        for (int kk = 0; kk < 8; ++kk) { const bf16x8 cf = *reinterpret_cast<const bf16x8*>(lds + L_CT + AT_KSWZ(lb * 32 + r32, (kk * 16 + hi * 8) * 2));
          acc = __builtin_amdgcn_mfma_f32_32x32x16_bf16(cf, sf[kk], acc, 0, 0, 0); }
#pragma unroll
        for (int r = 0; r < 16; ++r) { const float4 tr = tab[lb * 32 + crow(r, hi)]; o[lb][d][r] += __builtin_amdgcn_exp2f(dir ? tr.y : tr.x) * acc[r]; }
      }
      asm volatile("" ::: "memory");
    }
  }
  asm volatile("" ::: "memory");
  const bf16_t* zp = p.proj + ((size_t)b * S + c0) * PLD + N_Z + h * HD + r32;
#pragma unroll
  for (int lb = 0; lb < 2; ++lb)
#pragma unroll
    for (int r = 0; r < 16; ++r) { const int l = lb * 32 + crow(r, hi); float ss = 0.f;
#pragma unroll
      for (int d = 0; d < 2; ++d) { const float z = bf2f(zp[(size_t)l * PLD + d * 32]); const float y = o[lb][d][r] * z * __builtin_amdgcn_rcpf(1.f + __expf(-z)); o[lb][d][r] = y; ss += y * y; }
      ss += __shfl_xor(ss, 16); ss += __shfl_xor(ss, 8); ss += __shfl_xor(ss, 4); ss += __shfl_xor(ss, 2); ss += __shfl_xor(ss, 1);
      if (r32 == 0) ssp[hl * 64 + l] = ss;
      if ((r & 3) == 3) asm volatile("" ::: "memory"); }
  __syncthreads();
  const float nw0 = p.ssd_norm_w[h * HD + r32], nw1 = p.ssd_norm_w[h * HD + 32 + r32];
  bf16_t* up = p.u + ((size_t)b * S + c0) * D + h * HD + r32;
#pragma unroll
  for (int lb = 0; lb < 2; ++lb)
#pragma unroll
    for (int r = 0; r < 16; ++r) { const int l = lb * 32 + crow(r, hi); float ss = 0.f;
#pragma unroll
      for (int q = 0; q < 8; ++q) ss += ssp[q * 64 + l];
      const float rstd = rsqrtf(ss * (1.f / 512.f) + 1e-5f);
      up[(size_t)l * D] = f2bf(o[lb][0][r] * rstd * nw0); up[(size_t)l * D + 32] = f2bf(o[lb][1][r] * rstd * nw1); }
}
}

__device__ void ph_ssd_a(const Params& p, char* lds, char* snap) {
  for (int item = blockIdx.x; item < NB * 2 * 2; item += gridDim.x) { const int dir = item & 1, g = (item >> 1) & 1, b = item >> 2; sd::pass_a_item(p, lds, snap, b, g, dir); }
}
__device__ void ph_ssd_b(const Params& p, char* lds, const char* snap) {
  for (int item = blockIdx.x; item < NB * 2 * sd::NCH; item += gridDim.x) { const int c = item % sd::NCH, g = (item / sd::NCH) & 1, b = item / (2 * sd::NCH); sd::pass_b_item(p, lds, snap, b, g, c); }
}
__device__ void ph_inproj(const Params& p, LAS unsigned char* lds) {
  pg8::Gemm g{p.xb, p.WinT, D}; pg8::OrderStatic Sd; Sd.init(T, NPROJ, gridDim.x, blockIdx.x);
  EpiProj E{p.proj, p.dt, p.dt_bias_f, p.dt_bias_b};
  pg8::gemm_phase<false>(lds, g, Sd, E);
}
__device__ void ph_outproj(const Params& p, LAS unsigned char* lds) {
  pg8::Gemm g{p.u, p.WoutT, D}; pg8::OrderStatic Sd; Sd.init(T, D, gridDim.x, blockIdx.x);
  EpiOut E{p.x, p.h1};
  pg8::gemm_phase<false>(lds, g, Sd, E);
}
__device__ __forceinline__ int ld_agent(const int* p) { return __hip_atomic_load(p, __ATOMIC_RELAXED, __HIP_MEMORY_SCOPE_AGENT); }
__device__ __forceinline__ float ld_agent(const float* p) { return __hip_atomic_load(p, __ATOMIC_RELAXED, __HIP_MEMORY_SCOPE_AGENT); }
__device__ void ph_ln_route(const Params& p, char* ldsg, LAS unsigned char* lds) {
  typedef short bf16x8 __attribute__((ext_vector_type(8)));
  LAS int* cntl = (LAS int*)lds;
  int tid = threadIdx.x; asm volatile("" : "+v"(tid));
  const int lane = tid & 63, wv = tid >> 6;
  float* lg = (float*)(ldsg + 1024) + wv * 512;
  float gm[32], bt[32];
#pragma unroll
  for (int g = 0; g < 4; ++g) { const f32x4 a = *(const f32x4*)(p.ln1_g + g * 512 + lane * 8), b = *(const f32x4*)(p.ln1_g + g * 512 + lane * 8 + 4);
    const f32x4 c = *(const f32x4*)(p.ln1_b + g * 512 + lane * 8), d = *(const f32x4*)(p.ln1_b + g * 512 + lane * 8 + 4);
#pragma unroll
    for (int j = 0; j < 4; ++j) { gm[g * 8 + j] = a[j]; gm[g * 8 + 4 + j] = b[j]; bt[g * 8 + j] = c[j]; bt[g * 8 + 4 + j] = d[j]; } }
  const float rbias = p.router_bias[lane];
  for (int tb = blockIdx.x; tb < T / 64; tb += gridDim.x) {
    __syncthreads();
    if (tid < NE) cntl[tid] = 0;
    const int t0 = tb * 64 + wv * 8;
    for (int i = 0; i < 8; ++i) {
      const float* vp = p.h1 + (size_t)(t0 + i) * D; float v[32]; float s = 0.f;
#pragma unroll
      for (int g = 0; g < 4; ++g) { const f32x4 a = *(const f32x4*)(vp + g * 512 + lane * 8), b = *(const f32x4*)(vp + g * 512 + lane * 8 + 4);
#pragma unroll
        for (int j = 0; j < 4; ++j) { v[g * 8 + j] = a[j]; v[g * 8 + 4 + j] = b[j]; s += a[j] + b[j]; } }
      const float mu = wave_sum(s) * (1.f / D); float q = 0.f;
#pragma unroll
      for (int j = 0; j < 32; ++j) { const float d = v[j] - mu; q += d * d; }
      const float rstd = rsqrtf(wave_sum(q) * (1.f / D) + 1e-5f);
#pragma unroll
      for (int g = 0; g < 4; ++g) { float o[8];
#pragma unroll
        for (int j = 0; j < 8; ++j) o[j] = (v[g * 8 + j] - mu) * rstd * gm[g * 8 + j] + bt[g * 8 + j];
        u32x4 w; w.x = cvt_pk_bf16(o[0], o[1]); w.y = cvt_pk_bf16(o[2], o[3]); w.z = cvt_pk_bf16(o[4], o[5]); w.w = cvt_pk_bf16(o[6], o[7]);
        *(u32x4*)(p.h1b + (size_t)(t0 + i) * D + g * 512 + lane * 8) = w; }
    }
    __threadfence_block(); asm volatile("s_waitcnt vmcnt(0)" ::: "memory");
    f32x4 acc[4];
#pragma unroll
    for (int nb = 0; nb < 4; ++nb) acc[nb] = (f32x4){0.f, 0.f, 0.f, 0.f};
    const bf16_t* ap = p.h1b + (size_t)(t0 + (lane & 7)) * D + 8 * (lane >> 4);
    const bf16_t* bp = p.WrT + (size_t)(lane & 15) * D + 8 * (lane >> 4);
#pragma unroll 4
    for (int kk = 0; kk < D / 32; ++kk) {
      const bf16x8 a = *(const bf16x8*)(ap + kk * 32);
#pragma unroll
      for (int nb = 0; nb < 4; ++nb) { const bf16x8 b = *(const bf16x8*)(bp + (size_t)nb * 16 * D + kk * 32); acc[nb] = __builtin_amdgcn_mfma_f32_16x16x32_bf16(a, b, acc[nb], 0, 0, 0); }
    }
    if ((lane >> 4) < 2) {
#pragma unroll
      for (int nb = 0; nb < 4; ++nb)
#pragma unroll
        for (int i = 0; i < 4; ++i) lg[(4 * (lane >> 4) + i) * 64 + nb * 16 + (lane & 15)] = acc[nb][i];
    }
    __syncthreads();
    for (int ti = 0; ti < 8; ++ti) {
      const int t = t0 + ti;
      const float sc = 1.f / (1.f + __expf(-lg[ti * 64 + lane]));
      const float bz = sc + rbias;
      int rk = 0;
#pragma unroll
      for (int j = 1; j < 8; ++j) { const float o = __shfl_xor(bz, j); const int oi = lane ^ j; rk += (o > bz || (o == bz && oi < lane)) ? 1 : 0; }
      float gs = rk < 2 ? bz : 0.f;
      gs += __shfl_xor(gs, 1); gs += __shfl_xor(gs, 2); gs += __shfl_xor(gs, 4);
      const int g = lane >> 3; int grk = 0;
#pragma unroll
      for (int j = 1; j < 8; ++j) { const float o = __shfl_xor(gs, j * 8); const int og = g ^ j; grk += (o > gs || (o == gs && og < g)) ? 1 : 0; }
      const bool gsel = grk < 4;
      const float mb = gsel ? bz : -INFINITY;
      int erk = 0;
      for (int j = 1; j < 64; ++j) { const float o = __shfl_xor(mb, j); const int oi = lane ^ j; erk += (o > mb || (o == mb && oi < lane)) ? 1 : 0; }
      const bool sel = gsel && erk < 8;
      const float gsum = wave_sum(sel ? sc : 0.f);
      if (sel) {
        const int lr = __hip_atomic_fetch_add(&cntl[lane], 1, __ATOMIC_RELAXED, __HIP_MEMORY_SCOPE_WORKGROUP);
        p.assign[t * 8 + erk] = lane | (lr << 8); p.gate[t * 8 + erk] = sc / gsum * 2.5f;
      }
    }
    __syncthreads();
    if (tid < NE) p.blkcnt[tb * NE + tid] = cntl[tid];
  }
}
__device__ void ph_place(const Params& p, LAS unsigned char* lds) {
  LAS int* part = (LAS int*)lds;
  LAS int* parta = part + 512;
  LAS int* base = parta + 512;
  LAS int* total = base + 64;
  LAS int* pstart = total + 64;
  const int tid = threadIdx.x, e = tid & 63, pt = tid >> 6;
  for (int tb = blockIdx.x; tb < T / 64; tb += gridDim.x) {
    __syncthreads();
    int slo = 0, sall = 0;
    for (int b = pt * 32; b < pt * 32 + 32; ++b) { const int c = ld_agent(p.blkcnt + b * NE + e); sall += c; slo += (b < tb) ? c : 0; }
    part[pt * 64 + e] = slo; parta[pt * 64 + e] = sall;
    __syncthreads();
    if (tid < 64) {
      int b0 = 0, t0 = 0;
#pragma unroll
      for (int q = 0; q < 8; ++q) { b0 += part[q * 64 + tid]; t0 += parta[q * 64 + tid]; }
      base[tid] = b0; total[tid] = t0;
      const int padded = (t0 + 255) & ~255;
      int incl = padded;
      for (int o = 1; o < 64; o <<= 1) { const int v = __shfl_up(incl, o); if (tid >= o) incl += v; }
      pstart[tid] = incl - padded;
      if (tid == 63) pstart[64] = incl;
    }
    __syncthreads();
    {
      const int t = tb * 64 + (tid >> 3), k = tid & 7;
      const int a = ld_agent(p.assign + t * 8 + k), ee = a & 255, lr = a >> 8;
      const int row = pstart[ee] + base[ee] + lr;
      p.row_tok[row] = t; p.row_gate[row] = ld_agent(p.gate + t * 8 + k); p.pos[t * 8 + k] = row;
      if (tid < 64) { const int srow = pstart[64] + tb * 64 + tid; p.row_tok[srow] = tb * 64 + tid; p.row_gate[srow] = 1.0f; }
    }
    if (tb == blockIdx.x) {
      for (int e2 = blockIdx.x; e2 < NE; e2 += gridDim.x) {
        const int r0 = pstart[e2] + total[e2], r1 = pstart[e2 + 1];
        for (int r = r0 + tid; r < r1; r += NT) { p.row_tok[r] = 0; p.row_gate[r] = 0.f; }
        for (int j = pstart[e2] / 256 + tid; j < r1 / 256; j += NT) p.tile_exp[j] = e2;
      }
      if (blockIdx.x == 0) {
        const int nr = pstart[64] / 256;
        for (int j = tid; j < T / 256; j += NT) p.tile_exp[nr + j] = NE;
        if (tid == 0) { p.meta[0] = nr; p.meta[1] = nr + T / 256; }
      }
    }
  }
}
struct OrderMoE {
  LAS const int* ulist; int n;
  LAS const unsigned* tab;
  __device__ __forceinline__ bool next(int i, pg8::Unit& u) const { if (i >= n) return false; u.pm = ulist[i * 4 + 0]; u.pn = ulist[i * 4 + 1]; u.bn = ulist[i * 4 + 2]; u.aux = i; return true; }
  __device__ __forceinline__ unsigned row_off(int i, int row) const { return tab[i * 512 + row]; }
};
template <bool TABLES>
__device__ __forceinline__ OrderMoE moe_order(const Params& p, LAS unsigned char* lds, int npn, int tile0, int ntiles, int rowbytes) {
  LAS int* ulist = (LAS int*)(lds + LDS_TAB); LAS unsigned* tab = (LAS unsigned*)(lds + LDS_TAB + 1024);
  const int G = gridDim.x, c = blockIdx.x, mpc = 32 / npn; int n = 0;
  __syncthreads();
  for (int i = 0; i < 60; ++i) {
    int U; if (G == 256) U = ((i * 8 + (c & 7)) * 32 + (c >> 3)); else U = i * G + c;
    const int chunk = U >> 5, w = U & 31, j = chunk * mpc + (w % mpc), pn = w / mpc;
    if (j >= ntiles) break;
    const int tile = tile0 + j, e = ld_agent(p.tile_exp + tile);
    if (threadIdx.x == 0) { ulist[i * 4 + 0] = tile; ulist[i * 4 + 1] = pn; ulist[i * 4 + 2] = e * npn + pn; ulist[i * 4 + 3] = e; }
    if (TABLES) { for (int r = threadIdx.x; r < 256; r += NT) { tab[i * 512 + r] = (unsigned)ld_agent(p.row_tok + tile * 256 + r) * (unsigned)rowbytes; tab[i * 512 + 256 + r] = __float_as_uint(ld_agent(p.row_gate + tile * 256 + r)); } }
    n = i + 1;
  }
  __syncthreads();
  return OrderMoE{ulist, n, tab};
}
struct EpiGU {
  static constexpr bool PERM = true;
  bf16_t* H; LAS const unsigned* tab;
  __device__ __forceinline__ void operator()(const f32x4 (&acc)[2][2][4][2], const pg8::Unit& u, int wr, int wc, int fr, int fq) const {
    const int col0 = u.pn * 128 + wc * 32 + 8 * fq;
#pragma unroll
    for (int ai = 0; ai < 2; ++ai)
#pragma unroll
      for (int m = 0; m < 4; ++m) { const int r = ai * 128 + wr * 64 + m * 16 + fr; const float gt = __uint_as_float(tab[u.aux * 512 + 256 + r]);
        f32x4 h0, h1;
#pragma unroll
        for (int j = 0; j < 4; ++j) { const float g0 = acc[ai][0][m][0][j], g1 = acc[ai][0][m][1][j];
          h0[j] = g0 * __builtin_amdgcn_rcpf(1.f + __expf(-g0)) * acc[ai][1][m][0][j] * gt; h1[j] = g1 * __builtin_amdgcn_rcpf(1.f + __expf(-g1)) * acc[ai][1][m][1][j] * gt; }
        u32x4 w; w.x = cvt_pk_bf16(h0[0], h0[1]); w.y = cvt_pk_bf16(h0[2], h0[3]); w.z = cvt_pk_bf16(h1[0], h1[1]); w.w = cvt_pk_bf16(h1[2], h1[3]);
        *(u32x4*)(H + (size_t)(u.pm * 256 + r) * DE + col0) = w; }
  }
};
__device__ void ph_gateup(const Params& p, LAS unsigned char* lds) {
  const int ntot = ld_agent(p.meta + 1);
  const OrderMoE S = moe_order<true>(p, lds, 4, 0, ntot, D * 2);
  pg8::Gemm g{p.h1b, p.WguT, D}; EpiGU E{p.H, S.tab};
  pg8::gemm_phase<true>(lds, g, S, E);
}
struct EpiDown {
  static constexpr bool PERM = true;
  bf16_t* Y; float* out; const bf16_t* h1b; LAS const int* ulist; int srow0;
  __device__ __forceinline__ void operator()(const f32x4 (&acc)[2][2][4][2], const pg8::Unit& u, int wr, int wc, int fr, int fq) const {
    const int col0 = u.pn * 256 + wc * 32 + 8 * fq; const bool shared_e = ulist[u.aux * 4 + 3] == NE;
#pragma unroll
    for (int ai = 0; ai < 2; ++ai)
#pragma unroll
      for (int m = 0; m < 4; ++m) { const int row = u.pm * 256 + ai * 128 + wr * 64 + m * 16 + fr;
#pragma unroll
        for (int bj = 0; bj < 2; ++bj) { const f32x4 v0 = acc[ai][bj][m][0], v1 = acc[ai][bj][m][1];
          if (!shared_e) { u32x4 w; w.x = cvt_pk_bf16(v0[0], v0[1]); w.y = cvt_pk_bf16(v0[2], v0[3]); w.z = cvt_pk_bf16(v1[0], v1[1]); w.w = cvt_pk_bf16(v1[2], v1[3]);
            *(u32x4*)(Y + (size_t)row * D + col0 + bj * 128) = w; }
          else { const size_t o = (size_t)(row - srow0) * D + col0 + bj * 128; const u32x4 hb = *(const u32x4*)(h1b + o); f32x4 a, b;
            a[0] = __uint_as_float(hb.x << 16); a[1] = __uint_as_float(hb.x & 0xffff0000u); a[2] = __uint_as_float(hb.y << 16); a[3] = __uint_as_float(hb.y & 0xffff0000u);
            b[0] = __uint_as_float(hb.z << 16); b[1] = __uint_as_float(hb.z & 0xffff0000u); b[2] = __uint_as_float(hb.w << 16); b[3] = __uint_as_float(hb.w & 0xffff0000u);
            *(f32x4*)(out + o) = a * ALPHA + v0; *(f32x4*)(out + o + 4) = b * ALPHA + v1; } } }
  }
};
__device__ void ph_down(const Params& p, LAS unsigned char* lds) {
  const int nr = ld_agent(p.meta + 0), ntot = ld_agent(p.meta + 1);
  const OrderMoE S = moe_order<false>(p, lds, 8, 0, ntot, 0);
  pg8::Gemm g{p.H, p.WdT, DE}; EpiDown E{p.Y, p.out, p.h1b, S.ulist, nr * 256};
  pg8::gemm_phase<false>(lds, g, S, E);
}
__device__ void ph_combine(const Params& p) {
  const int lane = threadIdx.x & 63, wv = threadIdx.x >> 6;
  for (int row = blockIdx.x * 8 + wv; row < T; row += gridDim.x * 8) {
    float v[32];
    float* op = p.out + (size_t)row * D;
#pragma unroll
    for (int g = 0; g < 4; ++g) { const f32x4 a = *(const f32x4*)(op + g * 512 + lane * 8), b = *(const f32x4*)(op + g * 512 + lane * 8 + 4);
#pragma unroll
      for (int j = 0; j < 4; ++j) { v[g * 8 + j] = a[j]; v[g * 8 + 4 + j] = b[j]; } }
    for (int k = 0; k < 8; ++k) {
      const int yr = ld_agent(p.pos + row * 8 + k); const bf16_t* yp = p.Y + (size_t)yr * D;
#pragma unroll
      for (int g = 0; g < 4; ++g) { const u32x4 hb = *(const u32x4*)(yp + g * 512 + lane * 8);
        v[g * 8 + 0] += __uint_as_float(hb.x << 16); v[g * 8 + 1] += __uint_as_float(hb.x & 0xffff0000u); v[g * 8 + 2] += __uint_as_float(hb.y << 16); v[g * 8 + 3] += __uint_as_float(hb.y & 0xffff0000u);
        v[g * 8 + 4] += __uint_as_float(hb.z << 16); v[g * 8 + 5] += __uint_as_float(hb.z & 0xffff0000u); v[g * 8 + 6] += __uint_as_float(hb.w << 16); v[g * 8 + 7] += __uint_as_float(hb.w & 0xffff0000u); }
    }
    float s = 0.f;
#pragma unroll
    for (int j = 0; j < 32; ++j) s += v[j];
    const float mu = wave_sum(s) * (1.f / D); float q = 0.f;
#pragma unroll
    for (int j = 0; j < 32; ++j) { const float d = v[j] - mu; q += d * d; }
    const float rstd = rsqrtf(wave_sum(q) * (1.f / D) + 1e-5f);
#pragma unroll
    for (int g = 0; g < 4; ++g) { const int c0 = g * 512 + lane * 8; f32x4 a, b;
#pragma unroll
      for (int j = 0; j < 4; ++j) { a[j] = (v[g * 8 + j] - mu) * rstd * p.ln2_g[c0 + j] + p.ln2_b[c0 + j]; b[j] = (v[g * 8 + 4 + j] - mu) * rstd * p.ln2_g[c0 + 4 + j] + p.ln2_b[c0 + 4 + j]; }
      *(f32x4*)(op + c0) = a; *(f32x4*)(op + c0 + 4) = b; }
  }
}

__global__ void __launch_bounds__(NT) k_mega(Params p_arg) {
#if defined(__HIP_DEVICE_COMPILE__)
  extern __shared__ __attribute__((aligned(16))) unsigned char lds_raw[];
  LAS unsigned char* lds = (LAS unsigned char*)lds_raw;
  float* smem = (float*)lds_raw;
#ifndef ONLY
#define ONLY -1
#endif
  typedef const __attribute__((address_space(4))) Params* KP;
  const KP pk = (KP)__builtin_amdgcn_kernarg_segment_ptr();
  volatile LAS unsigned* bst = (volatile LAS unsigned*)(lds + LDS_BYTES - 16);
  if (threadIdx.x == 0) { bst[0] = 0u; bst[1] = 0u; }
  __syncthreads();
  XcdBarrier gbar;
  { KP q_ = pk; asm volatile("" : "+s"(q_)); gbar = xcd_barrier_post(q_->bar, bst); }
#define GSYNC() xcd_barrier(gbar)
#ifndef DUP
#define DUP -1
#endif
#define RUN1(n, pass, call) do { if (ONLY < 0 || ONLY == n) { KP q_ = pk; asm volatile("" : "+s"(q_)); const Params p = *q_; const int dup_pass = pass; (void)dup_pass; call; } } while (0)
#define RUN(n, call) do { RUN1(n, 0, call); if (DUP == n) { GSYNC(); RUN1(n, 1, call); } } while (0)
  RUN(0, ph_convert(p)); GSYNC();
  RUN(1, ph_inproj(p, lds)); GSYNC();
  RUN(2, sd::ph_conv16(p)); GSYNC();
  RUN(3, ph_ssd_a(p, (char*)lds_raw, (char*)p.out)); RUN(4, ph_attn_mfma(p, (char*)lds_raw, p.meta + 8 + dup_pass)); GSYNC();
  RUN(5, ph_ssd_b(p, (char*)lds_raw, (const char*)p.out)); GSYNC();
  RUN(6, ph_outproj(p, lds)); GSYNC();
  RUN(7, ph_ln_route(p, (char*)lds_raw, lds)); GSYNC();
  RUN(10, ph_place(p, lds)); GSYNC();
  RUN(11, ph_gateup(p, lds)); GSYNC();
  RUN(12, ph_down(p, lds)); GSYNC();
  RUN(13, ph_combine(p));
#endif
}
}

extern "C" void kernel_launch(void* const* d_in, const int* in_sizes, int n_in, void* d_out, int out_size, void* d_ws, size_t ws_size, hipStream_t stream) {
  Params p{};
  const float* const* in = (const float* const*)d_in;
  p.x = in[0]; p.w_in = in[1]; p.conv_w = in[2]; p.conv_b = in[3]; p.dt_bias_f = in[4]; p.dt_bias_b = in[5]; p.a_log_f = in[6]; p.a_log_b = in[7];
  p.d_skip = in[8]; p.ssd_norm_w = in[9]; p.lq1 = in[10]; p.lk1 = in[11]; p.lq2 = in[12]; p.lk2 = in[13]; p.attn_norm_w = in[14]; p.w_out = in[15];
  p.ln1_g = in[16]; p.ln1_b = in[17]; p.w_router = in[18]; p.router_bias = in[19]; p.wg_e = in[20]; p.wu_e = in[21]; p.wd_e = in[22];
  p.wg_s = in[23]; p.wu_s = in[24]; p.wd_s = in[25]; p.ln2_g = in[26]; p.ln2_b = in[27];
  p.out = (float*)d_out;
  char* w = (char*)d_ws; size_t o = 0;
  auto take = [&](size_t bytes) { char* r = w + o; o += (bytes + 255) / 256 * 256; return r; };
  char* reg1 = w + o;
  p.xb = (bf16_t*)take((size_t)T * D * 2); p.WinT = (bf16_t*)take((size_t)NPROJ * D * 2); p.WoutT = (bf16_t*)take((size_t)D * D * 2);
  p.WguT = (bf16_t*)take((size_t)(NE + 1) * 1024 * D * 2); p.proj = (bf16_t*)take((size_t)T * PLD * 2); p.u = (bf16_t*)take((size_t)T * D * 2);
  const size_t reg1_bytes = (size_t)((w + o) - reg1);
  p.Y = (bf16_t*)reg1;
  if ((size_t)MAXROWS_R * D * 2 > reg1_bytes) { fprintf(stderr, "kernel_launch: region 1 too small for Y\n"); return; }
  char* reg2 = take((size_t)MAXROWS * DE * 2);
  p.H = (bf16_t*)reg2; p.xc16 = (bf16_t*)reg2;
  p.h1b = (bf16_t*)take((size_t)T * D * 2); p.WdT = (bf16_t*)take((size_t)(NE + 1) * D * DE * 2);
  p.dt = (float*)take((size_t)T * 32 * 4); p.WrT = (bf16_t*)take((size_t)NE * D * 2); p.gate = (float*)take((size_t)T * 8 * 4);
  p.assign = (int*)take((size_t)T * 8 * 4); p.pos = (int*)take((size_t)T * 8 * 4); p.blkcnt = (int*)take((size_t)(T / 64) * NE * 4);
  p.row_tok = (int*)take((size_t)MAXROWS * 4); p.row_gate = (float*)take((size_t)MAXROWS * 4); p.tile_exp = (int*)take((size_t)MAXTILES * 4);
  p.bar = (unsigned*)take((size_t)XCD_BAR_WORDS * 4 + 256); p.meta = (int*)(p.bar + XCD_BAR_WORDS);
  p.h1 = (float*)d_out;
  if (o > ws_size) { fprintf(stderr, "kernel_launch: ws too small: need %zu have %zu\n", o, ws_size); return; }
  static int grid_blocks = 0;
  if (!grid_blocks) {
    int dev = 0, cus = 0, per_cu = 0;
    hipGetDevice(&dev);
    hipDeviceGetAttribute(&cus, hipDeviceAttributeMultiprocessorCount, dev);
    if (hipFuncSetAttribute((const void*)k_mega, hipFuncAttributeMaxDynamicSharedMemorySize, LDS_BYTES) != hipSuccess) { fprintf(stderr, "kernel_launch: hipFuncSetAttribute failed\n"); return; }
    hipOccupancyMaxActiveBlocksPerMultiprocessor(&per_cu, k_mega, NT, LDS_BYTES);
    if (per_cu < 1) { fprintf(stderr, "kernel_launch: occupancy query says 0 blocks/CU\n"); return; }
    grid_blocks = cus;
  }
  if (hipMemsetAsync(p.bar, 0, (size_t)XCD_BAR_WORDS * 4 + 256, stream) != hipSuccess) { fprintf(stderr, "kernel_launch: memset failed\n"); return; }
  hipLaunchKernelGGL(k_mega, dim3(grid_blocks), dim3(NT), LDS_BYTES, stream, p);
  const hipError_t le = hipPeekAtLastError();
  if (le != hipSuccess) fprintf(stderr, "kernel_launch: launch failed: %s (grid %d)\n", hipGetErrorString(le), grid_blocks);
}
```

```cpp
#include <hip/hip_runtime.h>
#include <cstdio>
#include <cstdint>

namespace {
constexpr int D = 2048, NB = 8, S = 2048, T = NB * S;
constexpr int DSSD = 1024, DATT = 1024, NH = 16, HD = 64, NS = 128, CC = 1536;
constexpr int AH = 8, NE = 64, DE = 512, PW = 5664;
constexpr int O_DT = 2560, O_Q = 2592;
constexpr int N_Z = 0, N_XBC = 1024, N_Q = 2560, N_K = 3584, N_V = 4608, PLD = 5632, NPROJ = 5888;
constexpr float ALPHA = 1.189207115002721f;
constexpr float LAMBDA_INIT = 0.2f;
constexpr float LOG2E = 1.4426950408889634f;
constexpr float QS = 0.125f * LOG2E;
constexpr int NT = 512;
constexpr int LDS_BYTES = 152 * 1024;
constexpr int LDS_TAB = 128 * 1024;
constexpr int MAXROWS_R = NE * 256 + T * 8;
constexpr int MAXROWS = MAXROWS_R + T;
constexpr int MAXTILES = MAXROWS / 256;

typedef unsigned short bf16_t;
#define LAS __attribute__((address_space(3)))

struct Params {
  const float *x, *w_in, *conv_w, *conv_b, *dt_bias_f, *dt_bias_b, *a_log_f, *a_log_b, *d_skip, *ssd_norm_w;
  const float *lq1, *lk1, *lq2, *lk2, *attn_norm_w, *w_out, *ln1_g, *ln1_b, *w_router, *router_bias;
  const float *wg_e, *wu_e, *wd_e, *wg_s, *wu_s, *wd_s, *ln2_g, *ln2_b;
  float* out;
  bf16_t *xb, *WinT, *WoutT, *WguT, *WdT, *proj, *u, *h1b, *H, *Y, *xc16, *WrT;
  float *dt, *h1, *gate, *row_gate;
  int *assign, *blkcnt, *row_tok, *pos, *tile_exp, *meta;
  unsigned* bar;
};

__device__ __forceinline__ float silu_f(float x) { return x / (1.f + __expf(-x)); }
__device__ __forceinline__ float softplus_f(float x) { return x > 20.f ? x : log1pf(__expf(x)); }
__device__ __forceinline__ float wave_sum(float v) { for (int o = 32; o >= 1; o >>= 1) v += __shfl_xor(v, o); return v; }
__device__ __forceinline__ float bf2f(bf16_t b) { return __uint_as_float(((unsigned)b) << 16); }
__device__ __forceinline__ bf16_t f2bf(float f) { unsigned u = __float_as_uint(f); u += 0x7FFFu + ((u >> 16) & 1u); return (bf16_t)(u >> 16); }
}

namespace pg8 {
#define PG8_LAS __attribute__((address_space(3)))
typedef unsigned short bf16_t;
typedef short bf16x8 __attribute__((ext_vector_type(8)));
typedef float f32x4 __attribute__((ext_vector_type(4)));
typedef unsigned u32x4 __attribute__((ext_vector_type(4)));
constexpr int BM = 256, BK = 64, HALF = 128, HTB = HALF * BK * 2  , STAGE_BYTES = 8 * HTB, NXCD = 8, WGM = 8;

__host__ __device__ __forceinline__ int lds_byte(int r, int c) { const int st = (r >> 4) * 2 + (c >> 5), rr = r & 15, cc = c & 31, ob = rr * 64 + cc * 2; return st * 1024 + (ob ^ (((ob >> 9) & 1) << 5)); }
__host__ __device__ __forceinline__ void stage_rc(int b, int& R, int& C) { const int st = b / 1024, sb = b % 1024, swz = sb ^ (((sb >> 9) & 1) << 5); R = (st >> 1) * 16 + swz / 64; C = (st & 1) * 32 + (swz % 64) / 2; }
__host__ __device__ __forceinline__ int perm32(int rho) { const int n = rho >> 4, i = rho & 15; return 8 * (i >> 2) + 4 * n + (i & 3); }

struct Unit { int pm, pn, bn, aux; };
struct Gemm { const bf16_t* A; const bf16_t* Bt; int K; };


__device__ __forceinline__ unsigned cvt_pk_bf16(float lo, float hi) { unsigned r; asm volatile("v_cvt_pk_bf16_f32 %0, %1, %2" : "=v"(r) : "v"(lo), "v"(hi)); return r; }
struct OrderStatic {
    int nM, nN, nwg, G, c;
    __device__ void init(int M, int N, int G_, int c_) { nM = M / BM; nN = N / BM; nwg = nM * nN; G = G_; c = c_; }
    __device__ bool next(int i, Unit& u) const {
        const long L = (long)i * G + c; if (L >= nwg) return false;
        int wgid = (int)L; { const int q = nwg / NXCD, r = nwg % NXCD, xcd = wgid % NXCD, off = wgid / NXCD; wgid = (xcd < r ? xcd * (q + 1) : r * (q + 1) + (xcd - r) * q) + off; }
        const int nig = WGM * nN, gid = wgid / nig, fm = gid * WGM, gsz = (nM - fm) < WGM ? (nM - fm) : WGM;
        u.pm = fm + ((wgid % nig) % gsz); u.pn = (wgid % nig) / gsz; u.bn = u.pn; u.aux = i; return true;
    }
    __device__ __forceinline__ unsigned row_off(int, int) const { return 0u; }
};
template <bool GATHER, class Epi, class Sched>
__device__ __forceinline__ void gemm_phase(PG8_LAS unsigned char* lds, const Gemm g, const Sched& S, const Epi& E) {
    int tid = threadIdx.x; asm volatile("" : "+v"(tid));
    const int wid = __builtin_amdgcn_readfirstlane(tid >> 6), lane = tid & 63, wr = wid >> 2, wc = wid & 3, fr = lane & 15, fq = lane >> 4;
    const int K = g.K, nt = K / BK;
#define PG8_STAMP() do {} while (0)
    PG8_STAMP();
    unsigned voffA[2], voffB[2];
#pragma unroll
    for (int i = 0; i < 2; ++i) { int R, C; stage_rc(tid * 16 + i * 8192, R, C); const int Rb = Epi::PERM ? ((R & ~31) + perm32(R & 31)) : R;
        voffA[i] = (unsigned)(R * K + C) * 2u; voffB[i] = (unsigned)(Rb * K + C) * 2u; }
    unsigned voffG[2][2] = {{0u, 0u}, {0u, 0u}};
#define PG8_LOADG(uidx) do { if constexpr (GATHER) { _Pragma("unroll") for (int _h = 0; _h < 2; ++_h) _Pragma("unroll") for (int _i = 0; _i < 2; ++_i) { int R_, C_; stage_rc(tid * 16 + _i * 8192, R_, C_); \
        voffG[_h][_i] = S.row_off((uidx), _h * HALF + R_) + (unsigned)C_ * 2u; } } } while (0)
    const size_t kstep = (size_t)(BK * 2);
    const size_t hstep = (size_t)HALF * K * 2;
    const size_t tstep = 2 * hstep;
    const unsigned ldsw = (unsigned)wid * 1024u;
    const int aoff = lds_byte(wr * 64 + fr, fq * 8), boff = lds_byte(wc * 32 + fr, fq * 8);
#define PG8_SA(b, h) (((b) * 2 + (h)) * HTB)
#define PG8_SB(b, h) ((4 + (b) * 2 + (h)) * HTB)
#define PG8_STAGE(bufoff, gbase, voff) do { _Pragma("unroll") for (int _i = 0; _i < 2; ++_i) \
        __builtin_amdgcn_global_load_lds((const unsigned*)((const char*)(gbase) + (voff)[_i]), (PG8_LAS unsigned*)(lds + (bufoff) + ldsw + _i * 8192), 16, 0, 0); } while (0)
#define PG8_STAGE_A(bufoff, ptr, h) do { if constexpr (GATHER) { PG8_STAGE(bufoff, ptr, voffG[h]); } else { PG8_STAGE(bufoff, (ptr) + (h) * hstep, voffA); } } while (0)
#define PG8_LDA(dst, b, h) do { _Pragma("unroll") for (int m = 0; m < 4; ++m) _Pragma("unroll") for (int k = 0; k < 2; ++k) dst[m][k] = *(const PG8_LAS bf16x8*)(lds + PG8_SA(b, h) + aoff + m * 2048 + k * 1024); } while (0)
#define PG8_LDB(dst, b, h) do { _Pragma("unroll") for (int n = 0; n < 2; ++n) _Pragma("unroll") for (int k = 0; k < 2; ++k) dst[n][k] = *(const PG8_LAS bf16x8*)(lds + PG8_SB(b, h) + boff + n * 2048 + k * 1024); } while (0)
#define PG8_MMA(ai, bj, At, Bt) do { __builtin_amdgcn_s_setprio(1); _Pragma("unroll") for (int m = 0; m < 4; ++m) _Pragma("unroll") for (int n = 0; n < 2; ++n) _Pragma("unroll") for (int k = 0; k < 2; ++k) \
        acc[ai][bj][m][n] = __builtin_amdgcn_mfma_f32_16x16x32_bf16(Bt[n][k], At[m][k], acc[ai][bj][m][n], 0, 0, 0); __builtin_amdgcn_s_setprio(0); } while (0)
#define PG8_WAIT_V(n) asm volatile("s_waitcnt vmcnt(" #n ")" ::: "memory")
#define PG8_WAIT_L(n) asm volatile("s_waitcnt lgkmcnt(" #n ")" ::: "memory")
#define PG8_BAR __builtin_amdgcn_s_barrier()
#define PG8_SCHED __builtin_amdgcn_sched_barrier(0)
    Unit cur, nxt; int ui = 0;
    if (!S.next(0, cur)) return;
    f32x4 acc[2][2][4][2];
#pragma unroll
    for (int a = 0; a < 2; ++a)
#pragma unroll
        for (int b = 0; b < 2; ++b)
#pragma unroll
            for (int m = 0; m < 4; ++m)
#pragma unroll
                for (int n = 0; n < 2; ++n) acc[a][b][m][n] = (f32x4){0.f, 0.f, 0.f, 0.f};
    bf16x8 At[4][2], B0[2][2], B1[2][2];
    const char* cA = GATHER ? (const char*)g.A : (const char*)g.A + (size_t)cur.pm * tstep; const char* cB = (const char*)g.Bt + (size_t)cur.bn * tstep;
    PG8_LOADG(0);
    PG8_STAGE(PG8_SB(0, 0), cB, voffB); PG8_STAGE_A(PG8_SA(0, 0), cA, 0); PG8_STAGE(PG8_SB(0, 1), cB + hstep, voffB); PG8_STAGE_A(PG8_SA(0, 1), cA, 1);
    if (wr == 1) PG8_BAR;
    PG8_WAIT_V(4); PG8_BAR;
    PG8_STAGE(PG8_SB(1, 0), cB + kstep, voffB); PG8_STAGE_A(PG8_SA(1, 0), cA + kstep, 0); PG8_STAGE(PG8_SB(1, 1), cB + hstep + kstep, voffB);
    PG8_WAIT_V(6); PG8_BAR;
    PG8_STAMP();
    for (;;) {
        const bool has_next = S.next(ui + 1, nxt);
        const char* nA = has_next ? (GATHER ? (const char*)g.A : (const char*)g.A + (size_t)nxt.pm * tstep) : cA; const char* nB = has_next ? (const char*)g.Bt + (size_t)nxt.bn * tstep : cB;
        for (int t = 0; t < nt; t += 2) {
            const bool last = (t == nt - 2);
            const char* a1 = cA + (size_t)(t + 1) * kstep;
            const char* a2 = last ? nA : cA + (size_t)(t + 2) * kstep; const char* b2 = last ? nB : cB + (size_t)(t + 2) * kstep;
            const char* a3 = a2 + kstep; const char* b3 = b2 + kstep;
            PG8_LDB(B0, 0, 0); PG8_SCHED; PG8_LDA(At, 0, 0); PG8_STAGE_A(PG8_SA(1, 1), a1, 1);
            PG8_WAIT_L(8); PG8_BAR; PG8_WAIT_L(0); PG8_MMA(0, 0, At, B0); PG8_BAR; PG8_SCHED;
            if (last && has_next) PG8_LOADG(ui + 1);
            PG8_LDB(B1, 0, 1); PG8_STAGE(PG8_SB(0, 0), b2, voffB);
            PG8_BAR; PG8_WAIT_L(0); PG8_MMA(0, 1, At, B1); PG8_BAR;
            PG8_LDA(At, 0, 1); PG8_STAGE_A(PG8_SA(0, 0), a2, 0);
            PG8_BAR; PG8_WAIT_L(0); PG8_MMA(1, 0, At, B0); PG8_BAR; PG8_SCHED;
            PG8_STAGE(PG8_SB(0, 1), b2 + hstep, voffB);
            PG8_WAIT_V(6); PG8_BAR; PG8_MMA(1, 1, At, B1); PG8_BAR;
            PG8_LDB(B0, 1, 0); PG8_SCHED; PG8_LDA(At, 1, 0); PG8_STAGE_A(PG8_SA(0, 1), a2, 1);
            PG8_WAIT_L(8); PG8_BAR; PG8_WAIT_L(0); PG8_MMA(0, 0, At, B0); PG8_BAR; PG8_SCHED;
            PG8_LDB(B1, 1, 1); PG8_STAGE(PG8_SB(1, 0), b3, voffB);
            PG8_BAR; PG8_WAIT_L(0); PG8_MMA(0, 1, At, B1); PG8_BAR;
            PG8_LDA(At, 1, 1); PG8_STAGE_A(PG8_SA(1, 0), a3, 0);
            PG8_BAR; PG8_WAIT_L(0); PG8_MMA(1, 0, At, B0); PG8_BAR; PG8_SCHED;
            PG8_STAGE(PG8_SB(1, 1), b3 + hstep, voffB);
            PG8_WAIT_V(6); PG8_BAR; PG8_MMA(1, 1, At, B1); PG8_BAR;
        }
        PG8_STAMP();
        E(acc, cur, wr, wc, fr, fq);
        PG8_STAMP();
        if (!has_next) break;
#pragma unroll
        for (int a = 0; a < 2; ++a)
#pragma unroll
            for (int b = 0; b < 2; ++b)
#pragma unroll
                for (int m = 0; m < 4; ++m)
#pragma unroll
                    for (int n = 0; n < 2; ++n) acc[a][b][m][n] = (f32x4){0.f, 0.f, 0.f, 0.f};
        cur = nxt; cA = nA; cB = nB; ++ui;
    }
    PG8_WAIT_V(0);
    if (wr == 0) PG8_BAR;
    PG8_BAR;
    PG8_STAMP();
#undef PG8_STAMP
#undef PG8_SA
#undef PG8_SB
#undef PG8_STAGE
#undef PG8_STAGE_A
#undef PG8_LOADG
#undef PG8_LDA
#undef PG8_LDB
#undef PG8_MMA
#undef PG8_WAIT_V
#undef PG8_WAIT_L
#undef PG8_BAR
#undef PG8_SCHED
}
}
namespace {
#define XB_TMO      128
#define XB_XCNT(j)  (256  + 64 * (j))
#define XB_XSUB(j)  (1280 + 64 * (j))
#define XB_XGEN(j)  (2304 + 64 * (j))
#define XB_TOP      3328
#define XB_TOPGEN   3392
#define XCD_BAR_WORDS 3456
#define XB_SPIN_CAP (1u << 18)

__device__ __forceinline__ unsigned xb_ld(unsigned* p)              { return __hip_atomic_load(p, __ATOMIC_RELAXED, __HIP_MEMORY_SCOPE_AGENT); }
__device__ __forceinline__ unsigned xb_add(unsigned* p, unsigned v) { return __hip_atomic_fetch_add(p, v, __ATOMIC_RELAXED, __HIP_MEMORY_SCOPE_AGENT); }
__device__ __forceinline__ unsigned xb_xcc_id() { return (unsigned)__builtin_amdgcn_s_getreg((3 << 11) | 20) & 0xFu; }
#define XB_SPIN(cond, bar) do { unsigned _sp = 0; while (cond) { __builtin_amdgcn_s_sleep(1); \
    if ((++_sp & 255u) == 0u) { if (xb_ld(&(bar)[XB_TMO])) break; if (_sp > XB_SPIN_CAP) { atomicAdd(&(bar)[XB_TMO], 1u); break; } } } } while (0)

struct XcdBarrier {
    unsigned* bar; unsigned x;
    volatile LAS unsigned* st;
};

__device__ __forceinline__ XcdBarrier xcd_barrier_post(unsigned* bar, volatile LAS unsigned* st) {
    XcdBarrier b; b.bar = bar; b.x = xb_xcc_id(); b.st = st;
    if (threadIdx.x == 0) (void)xb_add(&bar[XB_XCNT(b.x)], 1u);
    return b;
}
__device__ __forceinline__ void xcd_barrier_complete(unsigned* bar, unsigned x, unsigned& nloc, unsigned& nx) {
    const unsigned G = gridDim.x * gridDim.y * gridDim.z;
    unsigned sum, cnt, mine, sp = 0u;
    for (;;) {
        sum = 0u; cnt = 0u; mine = 0u;
#pragma unroll
        for (unsigned j = 0; j < 16; ++j) { const unsigned c = xb_ld(&bar[XB_XCNT(j)]); sum += c; cnt += (c > 0u) ? 1u : 0u; mine = (j == x) ? c : mine; }
        if (sum == G) break;
        __builtin_amdgcn_s_sleep(1);
        if ((++sp & 255u) == 0u) { if (xb_ld(&bar[XB_TMO])) break; if (sp > XB_SPIN_CAP) { atomicAdd(&bar[XB_TMO], 1u); break; } }
    }
    nloc = mine > 0u ? mine : 1u; nx = cnt > 0u ? cnt : 1u;
}

__device__ __forceinline__ void xcd_barrier(const XcdBarrier& b) {
    asm volatile("s_waitcnt vmcnt(0)" ::: "memory");
    __syncthreads();
    if (threadIdx.x == 0) {
        unsigned* bar = b.bar;
        __builtin_amdgcn_s_waitcnt(0);
        unsigned nloc = b.st[0], nx = b.st[1];
        if (nloc == 0u) { xcd_barrier_complete(bar, b.x, nloc, nx); b.st[0] = nloc; b.st[1] = nx; }
        const unsigned old = xb_add(&bar[XB_XSUB(b.x)], 1u);
        const unsigned gen = old / nloc;
        if (old + 1u == (gen + 1u) * nloc) {
            __builtin_amdgcn_fence(__ATOMIC_RELEASE, "agent");
            asm volatile("s_waitcnt vmcnt(0)" ::: "memory");
            const unsigned og = xb_add(&bar[XB_TOP], 1u);
            const unsigned tg = og / nx;
            if (og + 1u == (tg + 1u) * nx) xb_add(&bar[XB_TOPGEN], 1u);
            else XB_SPIN(xb_ld(&bar[XB_TOPGEN]) == tg, bar);
            __builtin_amdgcn_fence(__ATOMIC_ACQUIRE, "agent");
            xb_add(&bar[XB_XGEN(b.x)], 1u);
            asm volatile("s_waitcnt vmcnt(0)" ::: "memory");
        } else {
            XB_SPIN(xb_ld(&bar[XB_XGEN(b.x)]) == gen, bar);
            __builtin_amdgcn_fence(__ATOMIC_ACQUIRE, "agent");
            asm volatile("s_waitcnt vmcnt(0)" ::: "memory");
        }
    }
    __syncthreads();
}

}
namespace {
using pg8::f32x4; using pg8::u32x4; using pg8::cvt_pk_bf16;

template <class ARow, class Epi>
__device__ __forceinline__ void gemm_tile(float* smem, int mvalid, int nvalid, int K, ARow arow, const float* Bp, int ldb, Epi epi) {
  float* As = smem;
  float* Bs = smem + 16 * 68;
  const int tid = threadIdx.x, ty = tid >> 5, tx = tid & 31;
  float acc[4][4];
#pragma unroll
  for (int i = 0; i < 4; ++i)
#pragma unroll
    for (int j = 0; j < 4; ++j) acc[i][j] = 0.f;
  const int ak = tid & 15, ar = tid >> 4;
  const float* ap0 = (ar < mvalid) ? arow(ar) : nullptr;
  const float* ap1 = (ar + 32 < mvalid) ? arow(ar + 32) : nullptr;
  const int bn = tid & 127, bk = tid >> 7;
  for (int k0 = 0; k0 < K; k0 += 16) {
    As[ak * 68 + ar] = ap0 ? ap0[k0 + ak] : 0.f;
    As[ak * 68 + ar + 32] = ap1 ? ap1[k0 + ak] : 0.f;
#pragma unroll
    for (int i = 0; i < 4; ++i) { const int kk = bk + 4 * i; Bs[kk * 128 + bn] = (bn < nvalid) ? Bp[(size_t)(k0 + kk) * ldb + bn] : 0.f; }
    __syncthreads();
#pragma unroll
    for (int kk = 0; kk < 16; ++kk) {
      float a[4], b[4];
#pragma unroll
      for (int i = 0; i < 4; ++i) a[i] = As[kk * 68 + ty * 4 + i];
#pragma unroll
      for (int j = 0; j < 4; ++j) b[j] = Bs[kk * 128 + tx * 4 + j];
#pragma unroll
      for (int i = 0; i < 4; ++i)
#pragma unroll
        for (int j = 0; j < 4; ++j) acc[i][j] += a[i] * b[j];
    }
    __syncthreads();
  }
#pragma unroll
  for (int i = 0; i < 4; ++i)
#pragma unroll
    for (int j = 0; j < 4; ++j) { const int r = ty * 4 + i, c = tx * 4 + j; if (r < mvalid && c < nvalid) epi(r, c, acc[i][j]); }
}

template <class RowMap>
__device__ __forceinline__ void cvt_tile(const float* __restrict__ src, int N, int K, int k0, int n0, bf16_t* __restrict__ dst, RowMap rm) {
  const int lane = threadIdx.x & 63, w = threadIdx.x >> 6;
  const int n = n0 + (lane & 15) * 4, kk = k0 + (w * 4 + (lane >> 4)) * 8;
  if (n >= N) return;
  float4 v[8];
#pragma unroll
  for (int j = 0; j < 8; ++j) v[j] = *(const float4*)(src + (size_t)(kk + j) * N + n);
  u32x4 o;
  o.x = cvt_pk_bf16(v[0].x, v[1].x); o.y = cvt_pk_bf16(v[2].x, v[3].x); o.z = cvt_pk_bf16(v[4].x, v[5].x); o.w = cvt_pk_bf16(v[6].x, v[7].x);
  *(u32x4*)(dst + (size_t)rm(n + 0) * K + kk) = o;
  o.x = cvt_pk_bf16(v[0].y, v[1].y); o.y = cvt_pk_bf16(v[2].y, v[3].y); o.z = cvt_pk_bf16(v[4].y, v[5].y); o.w = cvt_pk_bf16(v[6].y, v[7].y);
  *(u32x4*)(dst + (size_t)rm(n + 1) * K + kk) = o;
  o.x = cvt_pk_bf16(v[0].z, v[1].z); o.y = cvt_pk_bf16(v[2].z, v[3].z); o.z = cvt_pk_bf16(v[4].z, v[5].z); o.w = cvt_pk_bf16(v[6].z, v[7].z);
  *(u32x4*)(dst + (size_t)rm(n + 2) * K + kk) = o;
  o.x = cvt_pk_bf16(v[0].w, v[1].w); o.y = cvt_pk_bf16(v[2].w, v[3].w); o.z = cvt_pk_bf16(v[4].w, v[5].w); o.w = cvt_pk_bf16(v[6].w, v[7].w);
  *(u32x4*)(dst + (size_t)rm(n + 3) * K + kk) = o;
}
template <class RowMap>
__device__ void cvt_job(const float* src, int nmat, int K, int N, bf16_t* dst, size_t dstride, RowMap rm) {
  const int kt = K / 256, ntl = (N + 63) / 64, per = kt * ntl;
  for (int it = blockIdx.x; it < nmat * per; it += gridDim.x) {
    const int m = it / per, r = it % per, k0 = (r / ntl) * 256, n0 = (r % ntl) * 64;
    cvt_tile(src + (size_t)m * K * N, N, K, k0, n0, dst + (size_t)m * dstride, rm);
  }
}
__device__ void ph_convert(const Params& p) {
  const size_t gtid = (size_t)blockIdx.x * NT + threadIdx.x, gsz = (size_t)gridDim.x * NT;
  for (size_t i = gtid; i < (size_t)T * D / 8; i += gsz) {
    const float4 a = *(const float4*)(p.x + i * 8), b = *(const float4*)(p.x + i * 8 + 4);
    u32x4 o; o.x = cvt_pk_bf16(a.x, a.y); o.y = cvt_pk_bf16(a.z, a.w); o.z = cvt_pk_bf16(b.x, b.y); o.w = cvt_pk_bf16(b.z, b.w);
    *(u32x4*)(p.xb + i * 8) = o;
  }
  cvt_job(p.w_in, 1, D, PW, p.WinT, 0, [](int n) { return n < O_DT ? n : (n < O_Q ? PLD + (n - O_DT) : n - 32); });
  for (size_t i = gtid; i < (size_t)(NPROJ - PW) * D / 8; i += gsz) *(u32x4*)(p.WinT + (size_t)PW * D + i * 8) = (u32x4){0u, 0u, 0u, 0u};
  cvt_job(p.w_out, 1, D, D, p.WoutT, 0, [](int n) { return n; });
  cvt_job(p.w_router, 1, D, NE, p.WrT, 0, [](int n) { return n; });
}
template <class RowMap>
__device__ __forceinline__ void cvt_range(const float* src, int K, int N, bf16_t* dst, size_t dstride, RowMap rm, int it0, int it1) {
  const int kt = K / 256, ntl = (N + 63) / 64, per = kt * ntl;
  for (int it = it0; it < it1; ++it) {
    const int m = it / per, r = it % per, k0 = (r / ntl) * 256, n0 = (r % ntl) * 64;
    cvt_tile(src + (size_t)m * K * N, N, K, k0, n0, dst + (size_t)m * dstride, rm);
  }
}
constexpr int CVT_PER_ITEM = 16, CVT_ITEMS = 3 * 256 + 3 * 4;
__device__ __forceinline__ void cvt_moe_item(const Params& p, int item) {
  if (item < 256) cvt_range(p.wg_e, D, DE, p.WguT, (size_t)1024 * D, [](int n) { return (n >> 7) * 256 + (n & 127); }, item * 16, item * 16 + 16);
  else if (item < 512) cvt_range(p.wu_e, D, DE, p.WguT, (size_t)1024 * D, [](int n) { return (n >> 7) * 256 + 128 + (n & 127); }, (item - 256) * 16, (item - 256) * 16 + 16);
  else if (item < 768) cvt_range(p.wd_e, DE, D, p.WdT, (size_t)D * DE, [](int n) { return n; }, (item - 512) * 16, (item - 512) * 16 + 16);
  else if (item < 772) cvt_range(p.wg_s, D, DE, p.WguT + (size_t)NE * 1024 * D, 0, [](int n) { return (n >> 7) * 256 + (n & 127); }, (item - 768) * 16, (item - 768) * 16 + 16);
  else if (item < 776) cvt_range(p.wu_s, D, DE, p.WguT + (size_t)NE * 1024 * D, 0, [](int n) { return (n >> 7) * 256 + 128 + (n & 127); }, (item - 772) * 16, (item - 772) * 16 + 16);
  else cvt_range(p.wd_s, DE, D, p.WdT + (size_t)NE * D * DE, 0, [](int n) { return n; }, (item - 776) * 16, (item - 776) * 16 + 16);
}

struct EpiProj {
  static constexpr bool PERM = true;
  bf16_t* proj; float* dt; const float* bias_f; const float* bias_b;
  __device__ __forceinline__ void operator()(const f32x4 (&acc)[2][2][4][2], const pg8::Unit& u, int wr, int wc, int fr, int fq) const {
    const int row0 = u.pm * 256 + wr * 64 + fr;
    if (u.pn < 22) {
      const int col0 = u.pn * 256 + wc * 32 + 8 * fq;
      const float sc = (u.pn >= 10 && u.pn < 14) ? QS : 1.0f;
#pragma unroll
      for (int ai = 0; ai < 2; ++ai)
#pragma unroll
        for (int m = 0; m < 4; ++m) { bf16_t* rowp = proj + (size_t)(row0 + ai * 128 + m * 16) * PLD + col0;
#pragma unroll
          for (int bj = 0; bj < 2; ++bj) { const f32x4 v0 = acc[ai][bj][m][0] * sc, v1 = acc[ai][bj][m][1] * sc;
            u32x4 w; w.x = cvt_pk_bf16(v0[0], v0[1]); w.y = cvt_pk_bf16(v0[2], v0[3]); w.z = cvt_pk_bf16(v1[0], v1[1]); w.w = cvt_pk_bf16(v1[2], v1[3]);
            *(u32x4*)(rowp + bj * 128) = w; } }
    } else if (wc == 0) {
      const int c0 = 8 * fq;
      float bs[8];
#pragma unroll
      for (int j = 0; j < 8; ++j) bs[j] = (c0 + j) < 16 ? bias_f[c0 + j] : bias_b[c0 + j - 16];
#pragma unroll
      for (int ai = 0; ai < 2; ++ai)
#pragma unroll
        for (int m = 0; m < 4; ++m) { float* rowp = dt + (size_t)(row0 + ai * 128 + m * 16) * 32 + c0;
          const f32x4 v0 = acc[ai][0][m][0], v1 = acc[ai][0][m][1];
          f32x4 o0, o1;
#pragma unroll
          for (int j = 0; j < 4; ++j) { o0[j] = softplus_f(v0[j] + bs[j]); o1[j] = softplus_f(v1[j] + bs[4 + j]); }
          *(f32x4*)rowp = o0; *(f32x4*)(rowp + 4) = o1; }
    }
  }
};
struct EpiOut {
  static constexpr bool PERM = false;
  const float* x; float* v;
  __device__ __forceinline__ void operator()(const f32x4 (&acc)[2][2][4][2], const pg8::Unit& u, int wr, int wc, int fr, int fq) const {
    const int row0 = u.pm * 256 + wr * 64 + fr, col0 = u.pn * 256 + wc * 32 + 4 * fq;
#pragma unroll
    for (int ai = 0; ai < 2; ++ai)
#pragma unroll
      for (int m = 0; m < 4; ++m) { const size_t off = (size_t)(row0 + ai * 128 + m * 16) * D + col0;
#pragma unroll
        for (int bj = 0; bj < 2; ++bj)
#pragma unroll
          for (int n = 0; n < 2; ++n) { const f32x4 xv = *(const f32x4*)(x + off + bj * 128 + n * 16); *(f32x4*)(v + off + bj * 128 + n * 16) = xv * ALPHA + acc[ai][bj][m][n]; } }
  }
};

namespace at {
using bf16x8 = __attribute__((ext_vector_type(8))) short;
using s16x4  = __attribute__((ext_vector_type(4))) short;
using f32x16 = __attribute__((ext_vector_type(16))) float;
using u32x4  = __attribute__((ext_vector_type(4))) unsigned;
constexpr int KVBLK = 64;
constexpr size_t SHM_V = KVBLK * 128 * 2, SHM_K = KVBLK * 128 * 2;
constexpr float THR2 = 8.0f;
#define AT_KSWZ(row, colB) ((row) * 256 + ((colB) ^ (((row) & 7) << 4)))
#define AT_SBAR() __builtin_amdgcn_sched_barrier(0)
__device__ __forceinline__ int crow(int r, int hi) { return (r & 3) + 8 * (r >> 2) + 4 * hi; }
__device__ __forceinline__ unsigned cvtpk(float lo, float hi) { unsigned r; asm volatile("v_cvt_pk_bf16_f32 %0, %1, %2" : "=v"(r) : "v"(lo), "v"(hi)); return r; }

__device__ __forceinline__ void partialSM(f32x16& p0, f32x16& p1, float dqh, float nsl2, float& m_reg, float& mn, float& alpha) {
#pragma unroll
  for (int r = 0; r < 16; ++r) { const float c = (float)((r & 3) + 8 * (r >> 2));
    p0[r] = fmaf(nsl2, fabsf(dqh - c), p0[r]); p1[r] = fmaf(nsl2, fabsf(dqh - (c + 32.f)), p1[r]); }
  float pmax = p0[0];
#pragma unroll
  for (int r = 1; r < 16; ++r) pmax = fmaxf(pmax, p0[r]);
#pragma unroll
  for (int r = 0; r < 16; ++r) pmax = fmaxf(pmax, p1[r]);
  { auto rr = __builtin_amdgcn_permlane32_swap(__float_as_uint(pmax), __float_as_uint(pmax), false, false);
    pmax = fmaxf(__uint_as_float(rr[0]), __uint_as_float(rr[1])); }
  if (__builtin_expect(__all(pmax - m_reg <= THR2), 1)) { mn = m_reg; alpha = 1.f; }
  else { mn = fmaxf(m_reg, pmax); alpha = __builtin_amdgcn_exp2f(m_reg - mn); m_reg = mn; }
#pragma unroll
  for (int r = 0; r < 16; ++r) p0[r] = p0[r] - mn;
#pragma unroll
  for (int r = 0; r < 16; ++r) p1[r] = p1[r] - mn;
#pragma unroll
  for (int r = 0; r < 16; ++r) p0[r] = __builtin_amdgcn_exp2f(p0[r]);
}
__device__ __forceinline__ void finishSM(f32x16& p0, f32x16& p1, float alpha, float& l_reg, bf16x8& pa0, bf16x8& pa1, bf16x8& pa2, bf16x8& pa3) {
#pragma unroll
  for (int r = 0; r < 16; ++r) p1[r] = __builtin_amdgcn_exp2f(p1[r]);
  float ps = 0;
#pragma unroll
  for (int r = 0; r < 16; ++r) ps += p0[r];
#pragma unroll
  for (int r = 0; r < 16; ++r) ps += p1[r];
  { auto rr = __builtin_amdgcn_permlane32_swap(__float_as_uint(ps), __float_as_uint(ps), false, false);
    ps = __uint_as_float(rr[0]) + __uint_as_float(rr[1]); }
  l_reg = l_reg * alpha + ps;
#define AT_PK4(P, BASE, OUT) do { unsigned a0 = cvtpk(P[BASE + 0], P[BASE + 1]), a1 = cvtpk(P[BASE + 2], P[BASE + 3]);   \
    unsigned b0 = cvtpk(P[BASE + 4], P[BASE + 5]), b1 = cvtpk(P[BASE + 6], P[BASE + 7]);                              \
    auto r0 = __builtin_amdgcn_permlane32_swap(a0, b0, false, false); auto r1 = __builtin_amdgcn_permlane32_swap(a1, b1, false, false); \
    u32x4 w = {r0[0], r1[0], r0[1], r1[1]}; OUT = *reinterpret_cast<bf16x8*>(&w); } while (0)
  AT_PK4(p0, 0, pa0); AT_PK4(p0, 8, pa1); AT_PK4(p1, 0, pa2); AT_PK4(p1, 8, pa3);
#undef AT_PK4
}
__device__ __forceinline__ void qkt(f32x16& p0, f32x16& p1, const char* Ks, const bf16x8* qr, int r32, int hi, int cm) {
  p0 = f32x16{}; p1 = f32x16{};
#pragma unroll
  for (int d0 = 0; d0 < 4; ++d0) { const int cb = (cm + d0 * 16 + hi * 8) * 2;
    bf16x8 b0 = *reinterpret_cast<const bf16x8*>(Ks + AT_KSWZ(r32, cb));
    bf16x8 b1 = *reinterpret_cast<const bf16x8*>(Ks + AT_KSWZ(32 + r32, cb));
    p0 = __builtin_amdgcn_mfma_f32_32x32x16_bf16(b0, qr[d0], p0, 0, 0, 0);
    p1 = __builtin_amdgcn_mfma_f32_32x32x16_bf16(b1, qr[d0], p1, 0, 0, 0); }
}
__device__ __forceinline__ int v_st(int k, int c) { const int kk = (k & ~0xC) | ((k & 4) << 1) | ((k & 8) >> 1); return ((kk >> 3) * 4 + (c >> 5)) * 512 + ((kk & 7) * 32 + (c & 31)) * 2; }
__device__ __forceinline__ int v_rd_base(int lane) { return ((lane & 3) << 3) | (((lane >> 2) & 3) << 6) | (((lane >> 4) & 1) << 5) | (((lane >> 5) & 1) << 8); }
constexpr int v_rd_off(int d0, int ks, int half) { return d0 * 512 + ks * 4096 + half * 2048; }
template <int OFF> __device__ __forceinline__ s16x4 tr_read(int vb) {
  s16x4 r; asm volatile("ds_read_b64_tr_b16 %0, %1 offset:%2" : "=&v"(r) : "v"(vb), "i"(OFF) : "memory"); return r;
}
template <int D0> __device__ __forceinline__ void pv_one(f32x16& od, int vb, bf16x8 pa0, bf16x8 pa1, bf16x8 pa2, bf16x8 pa3) {
  const s16x4 l0 = tr_read<v_rd_off(D0, 0, 0)>(vb), h0 = tr_read<v_rd_off(D0, 0, 1)>(vb), l1 = tr_read<v_rd_off(D0, 1, 0)>(vb), h1 = tr_read<v_rd_off(D0, 1, 1)>(vb);
  const s16x4 l2 = tr_read<v_rd_off(D0, 2, 0)>(vb), h2 = tr_read<v_rd_off(D0, 2, 1)>(vb), l3 = tr_read<v_rd_off(D0, 3, 0)>(vb), h3 = tr_read<v_rd_off(D0, 3, 1)>(vb);
  asm volatile("s_waitcnt lgkmcnt(0)" ::: "memory"); AT_SBAR();
#define AT_PK(L, H) (bf16x8){L[0], L[1], L[2], L[3], H[0], H[1], H[2], H[3]}
  od = __builtin_amdgcn_mfma_f32_32x32x16_bf16(pa0, AT_PK(l0, h0), od, 0, 0, 0);
  od = __builtin_amdgcn_mfma_f32_32x32x16_bf16(pa1, AT_PK(l1, h1), od, 0, 0, 0);
  od = __builtin_amdgcn_mfma_f32_32x32x16_bf16(pa2, AT_PK(l2, h2), od, 0, 0, 0);
  od = __builtin_amdgcn_mfma_f32_32x32x16_bf16(pa3, AT_PK(l3, h3), od, 0, 0, 0);
#undef AT_PK
}
__device__ __forceinline__ void pv_d0(f32x16* o, int vb, bf16x8 pa0, bf16x8 pa1, bf16x8 pa2, bf16x8 pa3) {
  pv_one<0>(o[0], vb, pa0, pa1, pa2, pa3); pv_one<1>(o[1], vb, pa0, pa1, pa2, pa3); pv_one<2>(o[2], vb, pa0, pa1, pa2, pa3); pv_one<3>(o[3], vb, pa0, pa1, pa2, pa3);
}

__device__ __forceinline__ void attn_item(const bf16_t* __restrict__ Qb, const bf16_t* __restrict__ Kh, const bf16_t* __restrict__ Vh, bf16_t* __restrict__ Ub,
                                          int q0, float nsl2, float lam, const float* __restrict__ normw, char* lds) {
  constexpr int LDK = PLD;
  int tid = threadIdx.x; asm volatile("" : "+v"(tid));
  const int wid = tid >> 6, lane = tid & 63, r32 = lane & 31, hi = lane >> 5, rg = wid >> 1, cmap = wid & 1, cm = cmap * 64;
  char* V_lds = lds; char* K_lds = lds + 2 * SHM_V;
  float* ws = (float*)(lds + 2 * SHM_V + 2 * SHM_K) + wid * 64; float* li_l = ws; float* al_l = ws + 32;
  float m_reg = -1e30f, l_reg = 0; f32x16 o[4] = {}; bf16x8 qr[4];
  const bf16_t* Qw = Qb + (size_t)(rg * 32 + r32) * LDK + cm + hi * 8;
#pragma unroll
  for (int d0 = 0; d0 < 4; ++d0) qr[d0] = *reinterpret_cast<const bf16x8*>(Qw + d0 * 16);
  const int sr = tid >> 4, sc = (tid & 15) * 8, vst0 = v_st(sr, sc), vst1 = v_st(32 + sr, sc);
  const int vb0 = (int)(uintptr_t)V_lds + v_rd_base(lane);
  const float qposh = (float)(q0 + rg * 32 + r32 - 4 * hi);
  struct { bf16x8 vs0, vs1, ks0, ks1; } sr_[2];
#define SLOAD(i, k0) do { sr_[i].vs0 = *reinterpret_cast<const bf16x8*>(&Vh[(size_t)((k0) + sr) * LDK + sc]); sr_[i].vs1 = *reinterpret_cast<const bf16x8*>(&Vh[(size_t)((k0) + 32 + sr) * LDK + sc]); \
    sr_[i].ks0 = *reinterpret_cast<const bf16x8*>(&Kh[(size_t)((k0) + sr) * LDK + sc]); sr_[i].ks1 = *reinterpret_cast<const bf16x8*>(&Kh[(size_t)((k0) + 32 + sr) * LDK + sc]); } while (0)
#define SWRITE(b, i) do { *(bf16x8*)(V_lds + (b) * SHM_V + vst0) = sr_[i].vs0;          \
    *(bf16x8*)(V_lds + (b) * SHM_V + vst1) = sr_[i].vs1; int kc = sc * 2;               \
    *(bf16x8*)(K_lds + (b) * SHM_K + AT_KSWZ(sr, kc)) = sr_[i].ks0;                       \
    *(bf16x8*)(K_lds + (b) * SHM_K + AT_KSWZ(32 + sr, kc)) = sr_[i].ks1; } while (0)
#define SWAIT() asm volatile("s_waitcnt vmcnt(4)" ::: "memory")
#define RESC(a) do { if (__any((a) < 1.f)) { if (hi == 0) al_l[r32] = (a); asm volatile("s_waitcnt lgkmcnt(0)" ::: "memory"); \
    _Pragma("unroll") for (int d = 0; d < 4; ++d) _Pragma("unroll") for (int r = 0; r < 16; ++r) o[d][r] *= al_l[crow(r, hi)]; } } while (0)
  f32x16 pA0, pA1, pB0, pB1; float mnA, mnB, alA, alB; bf16x8 pa0, pa1, pa2, pa3; constexpr int NTL = S / KVBLK;
  constexpr int SE = 0, SO = 1;
  SLOAD(SE, 0); asm volatile("s_waitcnt vmcnt(0)" ::: "memory"); SWRITE(0, SE); __syncthreads();
  qkt(pA0, pA1, K_lds, qr, r32, hi, cm); partialSM(pA0, pA1, qposh, nsl2, m_reg, mnA, alA);
  SLOAD(SO, KVBLK); SLOAD(SE, 2 * KVBLK);
  SWAIT(); SWRITE(1, SO); __syncthreads();
  for (int j = 1; j + 1 < NTL; j += 2) {
    AT_SBAR(); qkt(pB0, pB1, K_lds + SHM_K, qr, r32, hi, cm);
    finishSM(pA0, pA1, alA, l_reg, pa0, pa1, pa2, pa3); AT_SBAR();
    SLOAD(SO, (j + 2) * KVBLK); AT_SBAR();
    pv_d0(o, vb0, pa0, pa1, pa2, pa3); partialSM(pB0, pB1, qposh - (float)(j * KVBLK), nsl2, m_reg, mnB, alB);
    __syncthreads(); SWAIT(); SWRITE(0, SE);
    RESC(alB); __syncthreads();
    AT_SBAR(); qkt(pA0, pA1, K_lds, qr, r32, hi, cm);
    finishSM(pB0, pB1, alB, l_reg, pa0, pa1, pa2, pa3); AT_SBAR();
    if (j + 3 < NTL) SLOAD(SE, (j + 3) * KVBLK); AT_SBAR();
    pv_d0(o, vb0 + (int)SHM_V, pa0, pa1, pa2, pa3); partialSM(pA0, pA1, qposh - (float)((j + 1) * KVBLK), nsl2, m_reg, mnA, alA);
    __syncthreads(); SWAIT(); SWRITE(1, SO);
    RESC(alA); __syncthreads();
  }
  AT_SBAR(); qkt(pB0, pB1, K_lds + SHM_K, qr, r32, hi, cm);
  finishSM(pA0, pA1, alA, l_reg, pa0, pa1, pa2, pa3); AT_SBAR();
  pv_d0(o, vb0, pa0, pa1, pa2, pa3); partialSM(pB0, pB1, qposh - (float)((NTL - 1) * KVBLK), nsl2, m_reg, mnB, alB);
  __syncthreads(); RESC(alB);
  finishSM(pB0, pB1, alB, l_reg, pa0, pa1, pa2, pa3); AT_SBAR();
  pv_d0(o, vb0 + (int)SHM_V, pa0, pa1, pa2, pa3);
  if (hi == 0) li_l[r32] = l_reg; asm volatile("s_waitcnt lgkmcnt(0)" ::: "memory");
  float rli[16];
#pragma unroll
  for (int r = 0; r < 16; ++r) rli[r] = __builtin_amdgcn_rcpf(li_l[crow(r, hi)]);
#pragma unroll
  for (int d = 0; d < 4; ++d)
#pragma unroll
    for (int r = 0; r < 16; ++r) o[d][r] *= rli[r];
  __syncthreads();
  float* X = (float*)lds + rg * (32 * 128);
  if (cmap == 1) {
#pragma unroll
    for (int d = 0; d < 4; ++d)
#pragma unroll
      for (int r = 0; r < 16; ++r) X[crow(r, hi) * 128 + d * 32 + r32] = o[d][r];
  }
  __syncthreads();
  if (cmap == 0) {
    float ss[16];
#pragma unroll
    for (int r = 0; r < 16; ++r) ss[r] = 0.f;
#pragma unroll
    for (int d = 0; d < 4; ++d)
#pragma unroll
      for (int r = 0; r < 16; ++r) { const float v = o[d][r] - lam * X[crow(r, hi) * 128 + d * 32 + r32]; o[d][r] = v; ss[r] += v * v; }
#pragma unroll
    for (int r = 0; r < 16; ++r) { float s = ss[r]; s += __shfl_xor(s, 16); s += __shfl_xor(s, 8); s += __shfl_xor(s, 4); s += __shfl_xor(s, 2); s += __shfl_xor(s, 1);
      ss[r] = rsqrtf(s * (1.f / 128.f) + 1e-5f) * (1.f - LAMBDA_INIT); }
    float nw[4];
#pragma unroll
    for (int d = 0; d < 4; ++d) nw[d] = normw[d * 32 + r32];
#pragma unroll
    for (int r = 0; r < 16; ++r) { bf16_t* up = Ub + (size_t)(rg * 32 + crow(r, hi)) * D + r32;
#pragma unroll
      for (int d = 0; d < 4; ++d) up[d * 32] = f2bf(o[d][r] * ss[r] * nw[d]); }
  }
  __syncthreads();
#undef SLOAD
#undef SWRITE
#undef SWAIT
#undef RESC
}
}

__device__ void ph_attn_mfma(const Params& p, char* lds, int* qhead) {
  float lam;
  { float s1 = 0.f, s2 = 0.f; for (int i = 0; i < 64; ++i) { s1 += p.lq1[i] * p.lk1[i]; s2 += p.lq2[i] * p.lk2[i]; } lam = __expf(s1) - __expf(s2) + LAMBDA_INIT; }
  int* qslot = (int*)(lds + 72 * 1024);
  bool more_a = true, more_c = true;
  for (int turn = 0; more_a || more_c; ++turn) {
    const bool do_attn = more_a && (!more_c || (turn & 1) == 0);
    __syncthreads();
    if (threadIdx.x == 0) *qslot = atomicAdd(do_attn ? qhead : qhead + 4, 1);
    __syncthreads();
    const int item = *qslot;
    if (do_attn) {
      if (item >= NB * AH * (S / 128)) { more_a = false; continue; }
      const int qb = item % (S / 128), h = (item / (S / 128)) % AH, b = item / ((S / 128) * AH);
      const float nsl2 = -exp2f(-(float)(h + 1)) * LOG2E;
      const size_t row0 = (size_t)b * S;
      at::attn_item(p.proj + (row0 + qb * 128) * PLD + N_Q + h * 128, p.proj + row0 * PLD + N_K + h * 128, p.proj + row0 * PLD + N_V + h * 128,
                    p.u + (row0 + qb * 128) * D + DSSD + h * 128, qb * 128, nsl2, lam, p.attn_norm_w, lds);
    } else {
      if (item >= CVT_ITEMS) { more_c = false; continue; }
      cvt_moe_item(p, item);
    }
  }
}
namespace sd {
using at::bf16x8; using at::s16x4; using at::f32x16; using at::u32x4; using at::crow; using at::cvtpk; using at::v_st; using at::v_rd_base; using at::v_rd_off; using at::tr_read;
constexpr int CH = 64, NCH = S / CH;
constexpr int L_BT = 0, L_CT = 16384, L_XV = 32768, L_TAB = 98304, L_SS = 106496;
constexpr size_t SNAP = 16384;
__device__ __forceinline__ size_t snap_off(int dir, int b, int h, int c) { return ((((size_t)dir * NB + b) * NH + h) * NCH + c) * SNAP; }

__device__ void ph_conv16(const Params& p) {
  constexpr int SEG = 16, NCG = CC / 8, NU = NCG * (T / SEG);
  for (int u = blockIdx.x * NT + threadIdx.x; u < NU; u += gridDim.x * NT) {
    const int cg = u % NCG, seg = u / NCG, t0 = seg * SEG, s0 = t0 % S, chan = cg * 8;
    float w[5][8], bias[8];
#pragma unroll
    for (int j = 0; j < 5; ++j) { const float4 a = *(const float4*)(p.conv_w + j * CC + chan), c = *(const float4*)(p.conv_w + j * CC + chan + 4);
      w[j][0] = a.x; w[j][1] = a.y; w[j][2] = a.z; w[j][3] = a.w; w[j][4] = c.x; w[j][5] = c.y; w[j][6] = c.z; w[j][7] = c.w; }
    { const float4 a = *(const float4*)(p.conv_b + chan), c = *(const float4*)(p.conv_b + chan + 4);
      bias[0] = a.x; bias[1] = a.y; bias[2] = a.z; bias[3] = a.w; bias[4] = c.x; bias[5] = c.y; bias[6] = c.z; bias[7] = c.w; }
    const bf16_t* base = p.proj + (size_t)t0 * PLD + N_XBC + chan;
    u32x4 rows[SEG + 4];
#pragma unroll
    for (int i = 0; i < SEG + 4; ++i) { const int s = s0 + i - 2; rows[i] = (u32x4){0u, 0u, 0u, 0u}; if (s >= 0 && s < S) rows[i] = *(const u32x4*)(base + (ptrdiff_t)(i - 2) * PLD); }
#pragma unroll
    for (int i = 0; i < SEG; ++i) {
      float o[8];
#pragma unroll
      for (int c = 0; c < 8; ++c) o[c] = bias[c];
#pragma unroll
      for (int j = 0; j < 5; ++j) { const u32x4 rr = rows[i + j];
        o[0] += w[j][0] * __uint_as_float(rr.x << 16); o[1] += w[j][1] * __uint_as_float(rr.x & 0xffff0000u);
        o[2] += w[j][2] * __uint_as_float(rr.y << 16); o[3] += w[j][3] * __uint_as_float(rr.y & 0xffff0000u);
        o[4] += w[j][4] * __uint_as_float(rr.z << 16); o[5] += w[j][5] * __uint_as_float(rr.z & 0xffff0000u);
        o[6] += w[j][6] * __uint_as_float(rr.w << 16); o[7] += w[j][7] * __uint_as_float(rr.w & 0xffff0000u); }
#pragma unroll
      for (int c = 0; c < 8; ++c) o[c] = o[c] * __builtin_amdgcn_rcpf(1.f + __expf(-o[c]));
      u32x4 pk; pk.x = cvtpk(o[0], o[1]); pk.y = cvtpk(o[2], o[3]); pk.z = cvtpk(o[4], o[5]); pk.w = cvtpk(o[6], o[7]);
      *(u32x4*)(p.xc16 + (size_t)(t0 + i) * CC + chan) = pk;
    }
  }
}
template <bool WITH_C, bool BV>
__device__ __forceinline__ void load_chunk(const Params& p, char* lds, int b, int g, int c0) {
  constexpr int NCG = WITH_C ? 96 : 80, NP = NCG * CH / NT;
  int tid = threadIdx.x; asm volatile("" : "+v"(tid));
  const bf16_t* src = p.xc16 + ((size_t)b * S + c0) * CC;
  u32x4 v[NP];
#pragma unroll
  for (int i = 0; i < NP; ++i) { const int idx = tid + NT * i, tok = idx / NCG, cg = idx % NCG;
    const int chan = cg < 64 ? g * 512 + cg * 8 : (cg < 80 ? 1024 + g * 128 + (cg - 64) * 8 : 1280 + g * 128 + (cg - 80) * 8);
    v[i] = *(const u32x4*)(src + (size_t)tok * CC + chan); }
#pragma unroll
  for (int i = 0; i < NP; ++i) { const int idx = tid + NT * i, tok = idx / NCG, cg = idx % NCG;
    if (cg < 64) { const int hl = cg >> 3, c = (hl & 1) * 64 + (cg & 7) * 8; *(u32x4*)(lds + L_XV + (hl >> 1) * 16384 + v_st(tok, c)) = v[i]; }
    else if (cg < 80) { const int n0 = (cg - 64) * 8; if (BV) *(u32x4*)(lds + L_BT + v_st(tok, n0)) = v[i]; else *(u32x4*)(lds + L_BT + AT_KSWZ(tok, n0 * 2)) = v[i]; }
    else { const int n0 = (cg - 80) * 8; *(u32x4*)(lds + L_CT + AT_KSWZ(tok, n0 * 2)) = v[i]; } }
}
__device__ __forceinline__ float wave_incl_prefix(float v, int lane) {
#pragma unroll
  for (int o = 1; o < 64; o <<= 1) { const float t = __int_as_float(__builtin_amdgcn_ds_bpermute(((lane - o) & 63) << 2, __float_as_int(v))); if (lane >= o) v += t; }
  return v;
}
__device__ __forceinline__ float wave_incl_suffix(float v, int lane) {
#pragma unroll
  for (int o = 1; o < 64; o <<= 1) { const float t = __int_as_float(__builtin_amdgcn_ds_bpermute(((lane + o) & 63) << 2, __float_as_int(v))); if (lane + o < 64) v += t; }
  return v;
}
__device__ __forceinline__ float wave_bcast(float v, int src) { return __int_as_float(__builtin_amdgcn_ds_bpermute(src << 2, __float_as_int(v))); }
__device__ __forceinline__ bf16x8 scale_frag(s16x4 lo, s16x4 hi, const float4 w0, const float4 w1) {
  const unsigned a = ((unsigned)(unsigned short)lo[0]) | ((unsigned)(unsigned short)lo[1] << 16), b = ((unsigned)(unsigned short)lo[2]) | ((unsigned)(unsigned short)lo[3] << 16);
  const unsigned c = ((unsigned)(unsigned short)hi[0]) | ((unsigned)(unsigned short)hi[1] << 16), d = ((unsigned)(unsigned short)hi[2]) | ((unsigned)(unsigned short)hi[3] << 16);
  u32x4 r;
  r.x = cvtpk(__uint_as_float(a << 16) * w0.x, __uint_as_float(a & 0xffff0000u) * w0.y);
  r.y = cvtpk(__uint_as_float(b << 16) * w0.z, __uint_as_float(b & 0xffff0000u) * w0.w);
  r.z = cvtpk(__uint_as_float(c << 16) * w1.x, __uint_as_float(c & 0xffff0000u) * w1.y);
  r.w = cvtpk(__uint_as_float(d << 16) * w1.z, __uint_as_float(d & 0xffff0000u) * w1.w);
  return *reinterpret_cast<bf16x8*>(&r);
}
#define SD_PK(L, H) (bf16x8){L[0], L[1], L[2], L[3], H[0], H[1], H[2], H[3]}

__device__ __forceinline__ void pass_a_item(const Params& p, char* lds, char* snap, int b, int g, int dir) {
  int tid = threadIdx.x; asm volatile("" : "+v"(tid));
  const int hl = tid >> 6, lane = tid & 63, r32 = lane & 31, hi = lane >> 5, h = g * 8 + hl;
  const float a = -__expf(dir ? p.a_log_b[h] : p.a_log_f[h]);
  float* wtab = (float*)(lds + L_TAB) + hl * 64;
  const int vbx = (int)(uintptr_t)(lds + L_XV + (hl >> 1) * 16384) + v_rd_base(lane) + (hl & 1) * 1024;
  const int vbb = (int)(uintptr_t)(lds + L_BT) + v_rd_base(lane);
  f32x16 st[4][2];
#pragma unroll
  for (int nb = 0; nb < 4; ++nb)
#pragma unroll
    for (int pb = 0; pb < 2; ++pb) st[nb][pb] = f32x16{};
  for (int ci = 0; ci < NCH; ++ci) {
    const int c = dir ? (NCH - 1 - ci) : ci, c0 = c * CH;
    __syncthreads();
    load_chunk<false, true>(p, lds, b, g, c0);
    const float dtv = p.dt[((size_t)b * S + c0 + lane) * 32 + dir * 16 + h];
    const float adt = a * dtv;
    const float cum = dir ? wave_incl_suffix(adt, lane) : wave_incl_prefix(adt, lane);
    const float total = wave_bcast(cum, dir ? 0 : 63);
    wtab[lane] = __expf(total - cum) * dtv;
    const float dec = __expf(total);
    { char* sp = snap + snap_off(dir, b, h, c);
#pragma unroll
      for (int nb = 0; nb < 4; ++nb)
#pragma unroll
        for (int pb = 0; pb < 2; ++pb)
#pragma unroll
          for (int q = 0; q < 4; ++q) { const f32x16& s = st[nb][pb];
            uint2 v; v.x = cvtpk(s[4 * q + 0], s[4 * q + 1]); v.y = cvtpk(s[4 * q + 2], s[4 * q + 3]);
            *(uint2*)(sp + ((((pb * 8 + nb * 2 + (q >> 1)) * 2 + (q & 1)) * 32 + r32) * 16 + hi * 8)) = v; } }
#pragma unroll
    for (int nb = 0; nb < 4; ++nb)
#pragma unroll
      for (int pb = 0; pb < 2; ++pb)
#pragma unroll
        for (int r = 0; r < 16; ++r) st[nb][pb][r] *= dec;
    __syncthreads();
#pragma unroll
    for (int ks = 0; ks < 4; ++ks) {
      const float4 w0 = *(const float4*)(wtab + ks * 16 + hi * 8), w1 = *(const float4*)(wtab + ks * 16 + hi * 8 + 4);
      bf16x8 xf[2];
      { const s16x4 l0 = tr_read<v_rd_off(0, 0, 0)>(vbx + ks * 4096), h0 = tr_read<v_rd_off(0, 0, 1)>(vbx + ks * 4096), l1 = tr_read<v_rd_off(1, 0, 0)>(vbx + ks * 4096), h1 = tr_read<v_rd_off(1, 0, 1)>(vbx + ks * 4096);
        asm volatile("s_waitcnt lgkmcnt(0)" ::: "memory"); AT_SBAR();
        xf[0] = scale_frag(l0, h0, w0, w1); xf[1] = scale_frag(l1, h1, w0, w1); }
#pragma unroll
      for (int nb = 0; nb < 4; ++nb) {
        s16x4 bl, bh;
        asm volatile("ds_read_b64_tr_b16 %0, %1" : "=&v"(bl) : "v"(vbb + nb * 512 + ks * 4096) : "memory");
        asm volatile("ds_read_b64_tr_b16 %0, %1 offset:2048" : "=&v"(bh) : "v"(vbb + nb * 512 + ks * 4096) : "memory");
        asm volatile("s_waitcnt lgkmcnt(0)" ::: "memory"); AT_SBAR();
        const bf16x8 bfr = SD_PK(bl, bh);
        st[nb][0] = __builtin_amdgcn_mfma_f32_32x32x16_bf16(bfr, xf[0], st[nb][0], 0, 0, 0);
        st[nb][1] = __builtin_amdgcn_mfma_f32_32x32x16_bf16(bfr, xf[1], st[nb][1], 0, 0, 0);
      }
    }
  }
  __syncthreads();
}

__device__ __forceinline__ void pass_b_item(const Params& p, char* lds, const char* snap, int b, int g, int c) {
  int tid = threadIdx.x; asm volatile("" : "+v"(tid));
  const int hl = tid >> 6, lane = tid & 63, r32 = lane & 31, hi = lane >> 5, h = g * 8 + hl, c0 = c * CH;
  float4* tab = (float4*)(lds + L_TAB) + hl * 64;
  float* ssp = (float*)(lds + L_SS);
  const int vbx = (int)(uintptr_t)(lds + L_XV + (hl >> 1) * 16384) + v_rd_base(lane) + (hl & 1) * 1024;
  __syncthreads();
  load_chunk<true, false>(p, lds, b, g, c0);
  { const size_t tok = (size_t)b * S + c0 + lane;
    const float dtf = p.dt[tok * 32 + h], dtb = p.dt[tok * 32 + 16 + h];
    const float af = -__expf(p.a_log_f[h]) * dtf, ab = -__expf(p.a_log_b[h]) * dtb;
    tab[lane] = make_float4(wave_incl_prefix(af, lane) * LOG2E, wave_incl_suffix(ab, lane) * LOG2E, dtf, dtb); }
  __syncthreads();
  const float dsk = p.d_skip[h];
  f32x16 o[2][2];
#pragma unroll
  for (int lb = 0; lb < 2; ++lb) {
    const int l = lb * 32 + r32;
    const float4 tl = tab[l];
    bf16x8 cr[8];
#pragma unroll
    for (int kk = 0; kk < 8; ++kk) cr[kk] = *reinterpret_cast<const bf16x8*>(lds + L_CT + AT_KSWZ(l, (kk * 16 + hi * 8) * 2));
    f32x16 p0 = f32x16{}, p1 = f32x16{};
#pragma unroll
    for (int kk = 0; kk < 8; ++kk) { const int cb = (kk * 16 + hi * 8) * 2;
      const bf16x8 b0 = *reinterpret_cast<const bf16x8*>(lds + L_BT + AT_KSWZ(r32, cb));
      const bf16x8 b1 = *reinterpret_cast<const bf16x8*>(lds + L_BT + AT_KSWZ(32 + r32, cb));
      p0 = __builtin_amdgcn_mfma_f32_32x32x16_bf16(b0, cr[kk], p0, 0, 0, 0);
      p1 = __builtin_amdgcn_mfma_f32_32x32x16_bf16(b1, cr[kk], p1, 0, 0, 0); }
#pragma unroll
    for (int r = 0; r < 16; ++r) {
#pragma unroll
      for (int half = 0; half < 2; ++half) {
        const int s = crow(r, hi) + 32 * half; const float4 ts = tab[s];
        float m = 0.f;
        if (s <= l) m += __builtin_amdgcn_exp2f(tl.x - ts.x) * ts.z;
        if (s >= l) m += __builtin_amdgcn_exp2f(tl.y - ts.y) * ts.w;
        const float add = (s == l) ? dsk : 0.f;
        if (half) p1[r] = p1[r] * m + add; else p0[r] = p0[r] * m + add;
      }
      asm volatile("" ::: "memory");
    }
    bf16x8 pa0, pa1, pa2, pa3;
#define SD_PK4(P, BASE, OUT) do { unsigned a0 = cvtpk(P[BASE + 0], P[BASE + 1]), a1 = cvtpk(P[BASE + 2], P[BASE + 3]);   \
    unsigned b0_ = cvtpk(P[BASE + 4], P[BASE + 5]), b1_ = cvtpk(P[BASE + 6], P[BASE + 7]);                              \
    auto r0 = __builtin_amdgcn_permlane32_swap(a0, b0_, false, false); auto r1 = __builtin_amdgcn_permlane32_swap(a1, b1_, false, false); \
    u32x4 w_ = {r0[0], r1[0], r0[1], r1[1]}; OUT = *reinterpret_cast<bf16x8*>(&w_); } while (0)
    SD_PK4(p0, 0, pa0); SD_PK4(p0, 8, pa1); SD_PK4(p1, 0, pa2); SD_PK4(p1, 8, pa3);
#undef SD_PK4
#pragma unroll
    for (int d = 0; d < 2; ++d) {
      const s16x4 l0 = d ? tr_read<v_rd_off(1, 0, 0)>(vbx) : tr_read<v_rd_off(0, 0, 0)>(vbx), h0 = d ? tr_read<v_rd_off(1, 0, 1)>(vbx) : tr_read<v_rd_off(0, 0, 1)>(vbx);
      const s16x4 l1 = d ? tr_read<v_rd_off(1, 1, 0)>(vbx) : tr_read<v_rd_off(0, 1, 0)>(vbx), h1 = d ? tr_read<v_rd_off(1, 1, 1)>(vbx) : tr_read<v_rd_off(0, 1, 1)>(vbx);
      const s16x4 l2 = d ? tr_read<v_rd_off(1, 2, 0)>(vbx) : tr_read<v_rd_off(0, 2, 0)>(vbx), h2 = d ? tr_read<v_rd_off(1, 2, 1)>(vbx) : tr_read<v_rd_off(0, 2, 1)>(vbx);
      const s16x4 l3 = d ? tr_read<v_rd_off(1, 3, 0)>(vbx) : tr_read<v_rd_off(0, 3, 0)>(vbx), h3 = d ? tr_read<v_rd_off(1, 3, 1)>(vbx) : tr_read<v_rd_off(0, 3, 1)>(vbx);
      asm volatile("s_waitcnt lgkmcnt(0)" ::: "memory"); AT_SBAR();
      f32x16 od = f32x16{};
      od = __builtin_amdgcn_mfma_f32_32x32x16_bf16(pa0, SD_PK(l0, h0), od, 0, 0, 0);
      od = __builtin_amdgcn_mfma_f32_32x32x16_bf16(pa1, SD_PK(l1, h1), od, 0, 0, 0);
      od = __builtin_amdgcn_mfma_f32_32x32x16_bf16(pa2, SD_PK(l2, h2), od, 0, 0, 0);
      od = __builtin_amdgcn_mfma_f32_32x32x16_bf16(pa3, SD_PK(l3, h3), od, 0, 0, 0);
      o[lb][d] = od;
    }
  }
#pragma unroll
  for (int dir = 0; dir < 2; ++dir) {
    if (dir == 0 ? (c == 0) : (c == NCH - 1)) continue;
    const char* sp = snap + snap_off(dir, b, h, c);
#pragma unroll
    for (int d = 0; d < 2; ++d) {
      bf16x8 sf[8];
#pragma unroll
      for (int kk = 0; kk < 8; ++kk) sf[kk] = *reinterpret_cast<const bf16x8*>(sp + ((((d * 8 + kk) * 2 + hi) * 32 + r32) * 16));
#pragma unroll
      for (int lb = 0; lb < 2; ++lb) {
        f32x16 acc = f32x16{};
#pragma unroll
        for (int kk = 0; kk < 8; ++kk) { const bf16x8 cf = *reinterpret_cast<const bf16x8*>(lds + L_CT + AT_KSWZ(lb * 32 + r32, (kk * 16 + hi * 8) * 2));
          acc = __builtin_amdgcn_mfma_f32_32x32x16_bf16(cf, sf[kk], acc, 0, 0, 0); }
#pragma unroll
        for (int r = 0; r < 16; ++r) { const float4 tr = tab[lb * 32 + crow(r, hi)]; o[lb][d][r] += __builtin_amdgcn_exp2f(dir ? tr.y : tr.x) * acc[r]; }
      }
      asm volatile("" ::: "memory");
    }
  }
  asm volatile("" ::: "memory");
  const bf16_t* zp = p.proj + ((size_t)b * S + c0) * PLD + N_Z + h * HD + r32;
#pragma unroll
  for (int lb = 0; lb < 2; ++lb)
#pragma unroll
    for (int r = 0; r < 16; ++r) { const int l = lb * 32 + crow(r, hi); float ss = 0.f;
#pragma unroll
      for (int d = 0; d < 2; ++d) { const float z = bf2f(zp[(size_t)l * PLD + d * 32]); const float y = o[lb][d][r] * z * __builtin_amdgcn_rcpf(1.f + __expf(-z)); o[lb][d][r] = y; ss += y * y; }
      ss += __shfl_xor(ss, 16); ss += __shfl_xor(ss, 8); ss += __shfl_xor(ss, 4); ss += __shfl_xor(ss, 2); ss += __shfl_xor(ss, 1);
      if (r32 == 0) ssp[hl * 64 + l] = ss;
      if ((r & 3) == 3) asm volatile("" ::: "memory"); }
  __syncthreads();
  const float nw0 = p.ssd_norm_w[h * HD + r32], nw1 = p.ssd_norm_w[h * HD + 32 + r32];
  bf16_t* up = p.u + ((size_t)b * S + c0) * D + h * HD + r32;
#pragma unroll
  for (int lb = 0; lb < 2; ++lb)
#pragma unroll
    for (int r = 0; r < 16; ++r) { const int l = lb * 32 + crow(r, hi); float ss = 0.f;
#pragma unroll
      for (int q = 0; q < 8; ++q) ss += ssp[q * 64 + l];
      const float rstd = rsqrtf(ss * (1.f / 512.f) + 1e-5f);
      up[(size_t)l * D] = f2bf(o[lb][0][r] * rstd * nw0); up[(size_t)l * D + 32] = f2bf(o[lb][1][r] * rstd * nw1); }
}
}

__device__ void ph_ssd_a(const Params& p, char* lds, char* snap) {
  for (int item = blockIdx.x; item < NB * 2 * 2; item += gridDim.x) { const int dir = item & 1, g = (item >> 1) & 1, b = item >> 2; sd::pass_a_item(p, lds, snap, b, g, dir); }
}
__device__ void ph_ssd_b(const Params& p, char* lds, const char* snap) {
  for (int item = blockIdx.x; item < NB * 2 * sd::NCH; item += gridDim.x) { const int c = item % sd::NCH, g = (item / sd::NCH) & 1, b = item / (2 * sd::NCH); sd::pass_b_item(p, lds, snap, b, g, c); }
}
__device__ void ph_inproj(const Params& p, LAS unsigned char* lds) {
  pg8::Gemm g{p.xb, p.WinT, D}; pg8::OrderStatic Sd; Sd.init(T, NPROJ, gridDim.x, blockIdx.x);
  EpiProj E{p.proj, p.dt, p.dt_bias_f, p.dt_bias_b};
  pg8::gemm_phase<false>(lds, g, Sd, E);
}
__device__ void ph_outproj(const Params& p, LAS unsigned char* lds) {
  pg8::Gemm g{p.u, p.WoutT, D}; pg8::OrderStatic Sd; Sd.init(T, D, gridDim.x, blockIdx.x);
  EpiOut E{p.x, p.h1};
  pg8::gemm_phase<false>(lds, g, Sd, E);
}
__device__ __forceinline__ int ld_agent(const int* p) { return __hip_atomic_load(p, __ATOMIC_RELAXED, __HIP_MEMORY_SCOPE_AGENT); }
__device__ __forceinline__ float ld_agent(const float* p) { return __hip_atomic_load(p, __ATOMIC_RELAXED, __HIP_MEMORY_SCOPE_AGENT); }
__device__ void ph_ln_route(const Params& p, char* ldsg, LAS unsigned char* lds) {
  typedef short bf16x8 __attribute__((ext_vector_type(8)));
  LAS int* cntl = (LAS int*)lds;
  int tid = threadIdx.x; asm volatile("" : "+v"(tid));
  const int lane = tid & 63, wv = tid >> 6;
  float* lg = (float*)(ldsg + 1024) + wv * 512;
  float gm[32], bt[32];
#pragma unroll
  for (int g = 0; g < 4; ++g) { const f32x4 a = *(const f32x4*)(p.ln1_g + g * 512 + lane * 8), b = *(const f32x4*)(p.ln1_g + g * 512 + lane * 8 + 4);
    const f32x4 c = *(const f32x4*)(p.ln1_b + g * 512 + lane * 8), d = *(const f32x4*)(p.ln1_b + g * 512 + lane * 8 + 4);
#pragma unroll
    for (int j = 0; j < 4; ++j) { gm[g * 8 + j] = a[j]; gm[g * 8 + 4 + j] = b[j]; bt[g * 8 + j] = c[j]; bt[g * 8 + 4 + j] = d[j]; } }
  const float rbias = p.router_bias[lane];
  for (int tb = blockIdx.x; tb < T / 64; tb += gridDim.x) {
    __syncthreads();
    if (tid < NE) cntl[tid] = 0;
    const int t0 = tb * 64 + wv * 8;
    for (int i = 0; i < 8; ++i) {
      const float* vp = p.h1 + (size_t)(t0 + i) * D; float v[32]; float s = 0.f;
#pragma unroll
      for (int g = 0; g < 4; ++g) { const f32x4 a = *(const f32x4*)(vp + g * 512 + lane * 8), b = *(const f32x4*)(vp + g * 512 + lane * 8 + 4);
#pragma unroll
        for (int j = 0; j < 4; ++j) { v[g * 8 + j] = a[j]; v[g * 8 + 4 + j] = b[j]; s += a[j] + b[j]; } }
      const float mu = wave_sum(s) * (1.f / D); float q = 0.f;
#pragma unroll
      for (int j = 0; j < 32; ++j) { const float d = v[j] - mu; q += d * d; }
      const float rstd = rsqrtf(wave_sum(q) * (1.f / D) + 1e-5f);
#pragma unroll
      for (int g = 0; g < 4; ++g) { float o[8];
#pragma unroll
        for (int j = 0; j < 8; ++j) o[j] = (v[g * 8 + j] - mu) * rstd * gm[g * 8 + j] + bt[g * 8 + j];
        u32x4 w; w.x = cvt_pk_bf16(o[0], o[1]); w.y = cvt_pk_bf16(o[2], o[3]); w.z = cvt_pk_bf16(o[4], o[5]); w.w = cvt_pk_bf16(o[6], o[7]);
        *(u32x4*)(p.h1b + (size_t)(t0 + i) * D + g * 512 + lane * 8) = w; }
    }
    __threadfence_block(); asm volatile("s_waitcnt vmcnt(0)" ::: "memory");
    f32x4 acc[4];
#pragma unroll
    for (int nb = 0; nb < 4; ++nb) acc[nb] = (f32x4){0.f, 0.f, 0.f, 0.f};
    const bf16_t* ap = p.h1b + (size_t)(t0 + (lane & 7)) * D + 8 * (lane >> 4);
    const bf16_t* bp = p.WrT + (size_t)(lane & 15) * D + 8 * (lane >> 4);
#pragma unroll 4
    for (int kk = 0; kk < D / 32; ++kk) {
      const bf16x8 a = *(const bf16x8*)(ap + kk * 32);
#pragma unroll
      for (int nb = 0; nb < 4; ++nb) { const bf16x8 b = *(const bf16x8*)(bp + (size_t)nb * 16 * D + kk * 32); acc[nb] = __builtin_amdgcn_mfma_f32_16x16x32_bf16(a, b, acc[nb], 0, 0, 0); }
    }
    if ((lane >> 4) < 2) {
#pragma unroll
      for (int nb = 0; nb < 4; ++nb)
#pragma unroll
        for (int i = 0; i < 4; ++i) lg[(4 * (lane >> 4) + i) * 64 + nb * 16 + (lane & 15)] = acc[nb][i];
    }
    __syncthreads();
    for (int ti = 0; ti < 8; ++ti) {
      const int t = t0 + ti;
      const float sc = 1.f / (1.f + __expf(-lg[ti * 64 + lane]));
      const float bz = sc + rbias;
      int rk = 0;
#pragma unroll
      for (int j = 1; j < 8; ++j) { const float o = __shfl_xor(bz, j); const int oi = lane ^ j; rk += (o > bz || (o == bz && oi < lane)) ? 1 : 0; }
      float gs = rk < 2 ? bz : 0.f;
      gs += __shfl_xor(gs, 1); gs += __shfl_xor(gs, 2); gs += __shfl_xor(gs, 4);
      const int g = lane >> 3; int grk = 0;
#pragma unroll
      for (int j = 1; j < 8; ++j) { const float o = __shfl_xor(gs, j * 8); const int og = g ^ j; grk += (o > gs || (o == gs && og < g)) ? 1 : 0; }
      const bool gsel = grk < 4;
      const float mb = gsel ? bz : -INFINITY;
      int erk = 0;
      for (int j = 1; j < 64; ++j) { const float o = __shfl_xor(mb, j); const int oi = lane ^ j; erk += (o > mb || (o == mb && oi < lane)) ? 1 : 0; }
      const bool sel = gsel && erk < 8;
      const float gsum = wave_sum(sel ? sc : 0.f);
      if (sel) {
        const int lr = __hip_atomic_fetch_add(&cntl[lane], 1, __ATOMIC_RELAXED, __HIP_MEMORY_SCOPE_WORKGROUP);
        p.assign[t * 8 + erk] = lane | (lr << 8); p.gate[t * 8 + erk] = sc / gsum * 2.5f;
      }
    }
    __syncthreads();
    if (tid < NE) p.blkcnt[tb * NE + tid] = cntl[tid];
  }
}
__device__ void ph_place(const Params& p, LAS unsigned char* lds) {
  LAS int* part = (LAS int*)lds;
  LAS int* parta = part + 512;
  LAS int* base = parta + 512;
  LAS int* total = base + 64;
  LAS int* pstart = total + 64;
  const int tid = threadIdx.x, e = tid & 63, pt = tid >> 6;
  for (int tb = blockIdx.x; tb < T / 64; tb += gridDim.x) {
    __syncthreads();
    int slo = 0, sall = 0;
    for (int b = pt * 32; b < pt * 32 + 32; ++b) { const int c = ld_agent(p.blkcnt + b * NE + e); sall += c; slo += (b < tb) ? c : 0; }
    part[pt * 64 + e] = slo; parta[pt * 64 + e] = sall;
    __syncthreads();
    if (tid < 64) {
      int b0 = 0, t0 = 0;
#pragma unroll
      for (int q = 0; q < 8; ++q) { b0 += part[q * 64 + tid]; t0 += parta[q * 64 + tid]; }
      base[tid] = b0; total[tid] = t0;
      const int padded = (t0 + 255) & ~255;
      int incl = padded;
      for (int o = 1; o < 64; o <<= 1) { const int v = __shfl_up(incl, o); if (tid >= o) incl += v; }
      pstart[tid] = incl - padded;
      if (tid == 63) pstart[64] = incl;
    }
    __syncthreads();
    {
      const int t = tb * 64 + (tid >> 3), k = tid & 7;
      const int a = ld_agent(p.assign + t * 8 + k), ee = a & 255, lr = a >> 8;
      const int row = pstart[ee] + base[ee] + lr;
      p.row_tok[row] = t; p.row_gate[row] = ld_agent(p.gate + t * 8 + k); p.pos[t * 8 + k] = row;
      if (tid < 64) { const int srow = pstart[64] + tb * 64 + tid; p.row_tok[srow] = tb * 64 + tid; p.row_gate[srow] = 1.0f; }
    }
    if (tb == blockIdx.x) {
      for (int e2 = blockIdx.x; e2 < NE; e2 += gridDim.x) {
        const int r0 = pstart[e2] + total[e2], r1 = pstart[e2 + 1];
        for (int r = r0 + tid; r < r1; r += NT) { p.row_tok[r] = 0; p.row_gate[r] = 0.f; }
        for (int j = pstart[e2] / 256 + tid; j < r1 / 256; j += NT) p.tile_exp[j] = e2;
      }
      if (blockIdx.x == 0) {
        const int nr = pstart[64] / 256;
        for (int j = tid; j < T / 256; j += NT) p.tile_exp[nr + j] = NE;
        if (tid == 0) { p.meta[0] = nr; p.meta[1] = nr + T / 256; }
      }
    }
  }
}
struct OrderMoE {
  LAS const int* ulist; int n;
  LAS const unsigned* tab;
  __device__ __forceinline__ bool next(int i, pg8::Unit& u) const { if (i >= n) return false; u.pm = ulist[i * 4 + 0]; u.pn = ulist[i * 4 + 1]; u.bn = ulist[i * 4 + 2]; u.aux = i; return true; }
  __device__ __forceinline__ unsigned row_off(int i, int row) const { return tab[i * 512 + row]; }
};
template <bool TABLES>
__device__ __forceinline__ OrderMoE moe_order(const Params& p, LAS unsigned char* lds, int npn, int tile0, int ntiles, int rowbytes) {
  LAS int* ulist = (LAS int*)(lds + LDS_TAB); LAS unsigned* tab = (LAS unsigned*)(lds + LDS_TAB + 1024);
  const int G = gridDim.x, c = blockIdx.x, mpc = 32 / npn; int n = 0;
  __syncthreads();
  for (int i = 0; i < 60; ++i) {
    int U; if (G == 256) U = ((i * 8 + (c & 7)) * 32 + (c >> 3)); else U = i * G + c;
    const int chunk = U >> 5, w = U & 31, j = chunk * mpc + (w % mpc), pn = w / mpc;
    if (j >= ntiles) break;
    const int tile = tile0 + j, e = ld_agent(p.tile_exp + tile);
    if (threadIdx.x == 0) { ulist[i * 4 + 0] = tile; ulist[i * 4 + 1] = pn; ulist[i * 4 + 2] = e * npn + pn; ulist[i * 4 + 3] = e; }
    if (TABLES) { for (int r = threadIdx.x; r < 256; r += NT) { tab[i * 512 + r] = (unsigned)ld_agent(p.row_tok + tile * 256 + r) * (unsigned)rowbytes; tab[i * 512 + 256 + r] = __float_as_uint(ld_agent(p.row_gate + tile * 256 + r)); } }
    n = i + 1;
  }
  __syncthreads();
  return OrderMoE{ulist, n, tab};
}
struct EpiGU {
  static constexpr bool PERM = true;
  bf16_t* H; LAS const unsigned* tab;
  __device__ __forceinline__ void operator()(const f32x4 (&acc)[2][2][4][2], const pg8::Unit& u, int wr, int wc, int fr, int fq) const {
    const int col0 = u.pn * 128 + wc * 32 + 8 * fq;
#pragma unroll
    for (int ai = 0; ai < 2; ++ai)
#pragma unroll
      for (int m = 0; m < 4; ++m) { const int r = ai * 128 + wr * 64 + m * 16 + fr; const float gt = __uint_as_float(tab[u.aux * 512 + 256 + r]);
        f32x4 h0, h1;
#pragma unroll
        for (int j = 0; j < 4; ++j) { const float g0 = acc[ai][0][m][0][j], g1 = acc[ai][0][m][1][j];
          h0[j] = g0 * __builtin_amdgcn_rcpf(1.f + __expf(-g0)) * acc[ai][1][m][0][j] * gt; h1[j] = g1 * __builtin_amdgcn_rcpf(1.f + __expf(-g1)) * acc[ai][1][m][1][j] * gt; }
        u32x4 w; w.x = cvt_pk_bf16(h0[0], h0[1]); w.y = cvt_pk_bf16(h0[2], h0[3]); w.z = cvt_pk_bf16(h1[0], h1[1]); w.w = cvt_pk_bf16(h1[2], h1[3]);
        *(u32x4*)(H + (size_t)(u.pm * 256 + r) * DE + col0) = w; }
  }
};
__device__ void ph_gateup(const Params& p, LAS unsigned char* lds) {
  const int ntot = ld_agent(p.meta + 1);
  const OrderMoE S = moe_order<true>(p, lds, 4, 0, ntot, D * 2);
  pg8::Gemm g{p.h1b, p.WguT, D}; EpiGU E{p.H, S.tab};
  pg8::gemm_phase<true>(lds, g, S, E);
}
struct EpiDown {
  static constexpr bool PERM = true;
  bf16_t* Y; float* out; const bf16_t* h1b; LAS const int* ulist; int srow0;
  __device__ __forceinline__ void operator()(const f32x4 (&acc)[2][2][4][2], const pg8::Unit& u, int wr, int wc, int fr, int fq) const {
    const int col0 = u.pn * 256 + wc * 32 + 8 * fq; const bool shared_e = ulist[u.aux * 4 + 3] == NE;
#pragma unroll
    for (int ai = 0; ai < 2; ++ai)
#pragma unroll
      for (int m = 0; m < 4; ++m) { const int row = u.pm * 256 + ai * 128 + wr * 64 + m * 16 + fr;
#pragma unroll
        for (int bj = 0; bj < 2; ++bj) { const f32x4 v0 = acc[ai][bj][m][0], v1 = acc[ai][bj][m][1];
          if (!shared_e) { u32x4 w; w.x = cvt_pk_bf16(v0[0], v0[1]); w.y = cvt_pk_bf16(v0[2], v0[3]); w.z = cvt_pk_bf16(v1[0], v1[1]); w.w = cvt_pk_bf16(v1[2], v1[3]);
            *(u32x4*)(Y + (size_t)row * D + col0 + bj * 128) = w; }
          else { const size_t o = (size_t)(row - srow0) * D + col0 + bj * 128; const u32x4 hb = *(const u32x4*)(h1b + o); f32x4 a, b;
            a[0] = __uint_as_float(hb.x << 16); a[1] = __uint_as_float(hb.x & 0xffff0000u); a[2] = __uint_as_float(hb.y << 16); a[3] = __uint_as_float(hb.y & 0xffff0000u);
            b[0] = __uint_as_float(hb.z << 16); b[1] = __uint_as_float(hb.z & 0xffff0000u); b[2] = __uint_as_float(hb.w << 16); b[3] = __uint_as_float(hb.w & 0xffff0000u);
            *(f32x4*)(out + o) = a * ALPHA + v0; *(f32x4*)(out + o + 4) = b * ALPHA + v1; } } }
  }
};
__device__ void ph_down(const Params& p, LAS unsigned char* lds) {
  const int nr = ld_agent(p.meta + 0), ntot = ld_agent(p.meta + 1);
  const OrderMoE S = moe_order<false>(p, lds, 8, 0, ntot, 0);
  pg8::Gemm g{p.H, p.WdT, DE}; EpiDown E{p.Y, p.out, p.h1b, S.ulist, nr * 256};
  pg8::gemm_phase<false>(lds, g, S, E);
}
__device__ void ph_combine(const Params& p) {
  const int lane = threadIdx.x & 63, wv = threadIdx.x >> 6;
  for (int row = blockIdx.x * 8 + wv; row < T; row += gridDim.x * 8) {
    float v[32];
    float* op = p.out + (size_t)row * D;
#pragma unroll
    for (int g = 0; g < 4; ++g) { const f32x4 a = *(const f32x4*)(op + g * 512 + lane * 8), b = *(const f32x4*)(op + g * 512 + lane * 8 + 4);
#pragma unroll
      for (int j = 0; j < 4; ++j) { v[g * 8 + j] = a[j]; v[g * 8 + 4 + j] = b[j]; } }
    for (int k = 0; k < 8; ++k) {
      const int yr = ld_agent(p.pos + row * 8 + k); const bf16_t* yp = p.Y + (size_t)yr * D;
#pragma unroll
      for (int g = 0; g < 4; ++g) { const u32x4 hb = *(const u32x4*)(yp + g * 512 + lane * 8);
        v[g * 8 + 0] += __uint_as_float(hb.x << 16); v[g * 8 + 1] += __uint_as_float(hb.x & 0xffff0000u); v[g * 8 + 2] += __uint_as_float(hb.y << 16); v[g * 8 + 3] += __uint_as_float(hb.y & 0xffff0000u);
        v[g * 8 + 4] += __uint_as_float(hb.z << 16); v[g * 8 + 5] += __uint_as_float(hb.z & 0xffff0000u); v[g * 8 + 6] += __uint_as_float(hb.w << 16); v[g * 8 + 7] += __uint_as_float(hb.w & 0xffff0000u); }
    }
    float s = 0.f;
#pragma unroll
    for (int j = 0; j < 32; ++j) s += v[j];
    const float mu = wave_sum(s) * (1.f / D); float q = 0.f;
#pragma unroll
    for (int j = 0; j < 32; ++j) { const float d = v[j] - mu; q += d * d; }
    const float rstd = rsqrtf(wave_sum(q) * (1.f / D) + 1e-5f);
#pragma unroll
    for (int g = 0; g < 4; ++g) { const int c0 = g * 512 + lane * 8; f32x4 a, b;
#pragma unroll
      for (int j = 0; j < 4; ++j) { a[j] = (v[g * 8 + j] - mu) * rstd * p.ln2_g[c0 + j] + p.ln2_b[c0 + j]; b[j] = (v[g * 8 + 4 + j] - mu) * rstd * p.ln2_g[c0 + 4 + j] + p.ln2_b[c0 + 4 + j]; }
      *(f32x4*)(op + c0) = a; *(f32x4*)(op + c0 + 4) = b; }
  }
}

__global__ void __launch_bounds__(NT) k_mega(Params p_arg) {
#if defined(__HIP_DEVICE_COMPILE__)
  extern __shared__ __attribute__((aligned(16))) unsigned char lds_raw[];
  LAS unsigned char* lds = (LAS unsigned char*)lds_raw;
  float* smem = (float*)lds_raw;
#ifndef ONLY
#define ONLY -1
#endif
  typedef const __attribute__((address_space(4))) Params* KP;
  const KP pk = (KP)__builtin_amdgcn_kernarg_segment_ptr();
  volatile LAS unsigned* bst = (volatile LAS unsigned*)(lds + LDS_BYTES - 16);
  if (threadIdx.x == 0) { bst[0] = 0u; bst[1] = 0u; }
  __syncthreads();
  XcdBarrier gbar;
  { KP q_ = pk; asm volatile("" : "+s"(q_)); gbar = xcd_barrier_post(q_->bar, bst); }
#define GSYNC() xcd_barrier(gbar)
#ifndef DUP
#define DUP -1
#endif
#define RUN1(n, pass, call) do { if (ONLY < 0 || ONLY == n) { KP q_ = pk; asm volatile("" : "+s"(q_)); const Params p = *q_; const int dup_pass = pass; (void)dup_pass; call; } } while (0)
#define RUN(n, call) do { RUN1(n, 0, call); if (DUP == n) { GSYNC(); RUN1(n, 1, call); } } while (0)
  RUN(0, ph_convert(p)); GSYNC();
  RUN(1, ph_inproj(p, lds)); GSYNC();
  RUN(2, sd::ph_conv16(p)); GSYNC();
  RUN(3, ph_ssd_a(p, (char*)lds_raw, (char*)p.out)); RUN(4, ph_attn_mfma(p, (char*)lds_raw, p.meta + 8 + dup_pass)); GSYNC();
  RUN(5, ph_ssd_b(p, (char*)lds_raw, (const char*)p.out)); GSYNC();
  RUN(6, ph_outproj(p, lds)); GSYNC();
  RUN(7, ph_ln_route(p, (char*)lds_raw, lds)); GSYNC();
  RUN(10, ph_place(p, lds)); GSYNC();
  RUN(11, ph_gateup(p, lds)); GSYNC();
  RUN(12, ph_down(p, lds)); GSYNC();
  RUN(13, ph_combine(p));
#endif
}
}

extern "C" void kernel_launch(void* const* d_in, const int* in_sizes, int n_in, void* d_out, int out_size, void* d_ws, size_t ws_size, hipStream_t stream) {
  Params p{};
  const float* const* in = (const float* const*)d_in;
  p.x = in[0]; p.w_in = in[1]; p.conv_w = in[2]; p.conv_b = in[3]; p.dt_bias_f = in[4]; p.dt_bias_b = in[5]; p.a_log_f = in[6]; p.a_log_b = in[7];
  p.d_skip = in[8]; p.ssd_norm_w = in[9]; p.lq1 = in[10]; p.lk1 = in[11]; p.lq2 = in[12]; p.lk2 = in[13]; p.attn_norm_w = in[14]; p.w_out = in[15];
  p.ln1_g = in[16]; p.ln1_b = in[17]; p.w_router = in[18]; p.router_bias = in[19]; p.wg_e = in[20]; p.wu_e = in[21]; p.wd_e = in[22];
  p.wg_s = in[23]; p.wu_s = in[24]; p.wd_s = in[25]; p.ln2_g = in[26]; p.ln2_b = in[27];
  p.out = (float*)d_out;
  char* w = (char*)d_ws; size_t o = 0;
  auto take = [&](size_t bytes) { char* r = w + o; o += (bytes + 255) / 256 * 256; return r; };
  char* reg1 = w + o;
  p.xb = (bf16_t*)take((size_t)T * D * 2); p.WinT = (bf16_t*)take((size_t)NPROJ * D * 2); p.WoutT = (bf16_t*)take((size_t)D * D * 2);
  p.WguT = (bf16_t*)take((size_t)(NE + 1) * 1024 * D * 2); p.proj = (bf16_t*)take((size_t)T * PLD * 2); p.u = (bf16_t*)take((size_t)T * D * 2);
  const size_t reg1_bytes = (size_t)((w + o) - reg1);
  p.Y = (bf16_t*)reg1;
  if ((size_t)MAXROWS_R * D * 2 > reg1_bytes) { fprintf(stderr, "kernel_launch: region 1 too small for Y\n"); return; }
  char* reg2 = take((size_t)MAXROWS * DE * 2);
  p.H = (bf16_t*)reg2; p.xc16 = (bf16_t*)reg2;
  p.h1b = (bf16_t*)take((size_t)T * D * 2); p.WdT = (bf16_t*)take((size_t)(NE + 1) * D * DE * 2);
  p.dt = (float*)take((size_t)T * 32 * 4); p.WrT = (bf16_t*)take((size_t)NE * D * 2); p.gate = (float*)take((size_t)T * 8 * 4);
  p.assign = (int*)take((size_t)T * 8 * 4); p.pos = (int*)take((size_t)T * 8 * 4); p.blkcnt = (int*)take((size_t)(T / 64) * NE * 4);
  p.row_tok = (int*)take((size_t)MAXROWS * 4); p.row_gate = (float*)take((size_t)MAXROWS * 4); p.tile_exp = (int*)take((size_t)MAXTILES * 4);
  p.bar = (unsigned*)take((size_t)XCD_BAR_WORDS * 4 + 256); p.meta = (int*)(p.bar + XCD_BAR_WORDS);
  p.h1 = (float*)d_out;
  if (o > ws_size) { fprintf(stderr, "kernel_launch: ws too small: need %zu have %zu\n", o, ws_size); return; }
  static int grid_blocks = 0;
  if (!grid_blocks) {
    int dev = 0, cus = 0, per_cu = 0;
    hipGetDevice(&dev);
    hipDeviceGetAttribute(&cus, hipDeviceAttributeMultiprocessorCount, dev);
    if (hipFuncSetAttribute((const void*)k_mega, hipFuncAttributeMaxDynamicSharedMemorySize, LDS_BYTES) != hipSuccess) { fprintf(stderr, "kernel_launch: hipFuncSetAttribute failed\n"); return; }
    hipOccupancyMaxActiveBlocksPerMultiprocessor(&per_cu, k_mega, NT, LDS_BYTES);
    if (per_cu < 1) { fprintf(stderr, "kernel_launch: occupancy query says 0 blocks/CU\n"); return; }
    grid_blocks = cus;
  }
  if (hipMemsetAsync(p.bar, 0, (size_t)XCD_BAR_WORDS * 4 + 256, stream) != hipSuccess) { fprintf(stderr, "kernel_launch: memset failed\n"); return; }
  hipLaunchKernelGGL(k_mega, dim3(grid_blocks), dim3(NT), LDS_BYTES, stream, p);
  const hipError_t le = hipPeekAtLastError();
  if (le != hipSuccess) fprintf(stderr, "kernel_launch: launch failed: %s (grid %d)\n", hipGetErrorString(le), grid_blocks);
}
```

```cpp
#include <hip/hip_runtime.h>
#include <cstdio>
#include <cstdint>

namespace {
constexpr int D = 2048, NB = 8, S = 2048, T = NB * S;
constexpr int DSSD = 1024, DATT = 1024, NH = 16, HD = 64, NS = 128, CC = 1536;
constexpr int AH = 8, NE = 64, DE = 512, PW = 5664;
constexpr int O_DT = 2560, O_Q = 2592;
constexpr int N_Z = 0, N_XBC = 1024, N_Q = 2560, N_K = 3584, N_V = 4608, PLD = 5632, NPROJ = 5888;
constexpr float ALPHA = 1.189207115002721f;
constexpr float LAMBDA_INIT = 0.2f;
constexpr float LOG2E = 1.4426950408889634f;
constexpr float QS = 0.125f * LOG2E;
constexpr float W8S = 32.f, H8S = 8.f;
constexpr int NT = 512;
constexpr int LDS_BYTES = 152 * 1024;
constexpr int LDS_TAB = 128 * 1024;
constexpr int MAXROWS_R = NE * 256 + T * 8;
constexpr int MAXROWS = MAXROWS_R + T;
constexpr int MAXTILES = MAXROWS / 256;

typedef unsigned short bf16_t;
#define LAS __attribute__((address_space(3)))

struct Params {
  const float *x, *w_in, *conv_w, *conv_b, *dt_bias_f, *dt_bias_b, *a_log_f, *a_log_b, *d_skip, *ssd_norm_w;
  const float *lq1, *lk1, *lq2, *lk2, *attn_norm_w, *w_out, *ln1_g, *ln1_b, *w_router, *router_bias;
  const float *wg_e, *wu_e, *wd_e, *wg_s, *wu_s, *wd_s, *ln2_g, *ln2_b;
  float* out;
  bf16_t *xb, *WinT, *WoutT, *WguT, *WdT, *proj, *u, *h1b, *H, *Y, *xc16, *WrT;
  float *dt, *h1, *gate, *row_gate;
  int *assign, *blkcnt, *row_tok, *pos, *tile_exp, *meta;
  unsigned* bar;
  unsigned char* h1q;
};

__device__ __forceinline__ float silu_f(float x) { return x / (1.f + __expf(-x)); }
__device__ __forceinline__ float softplus_f(float x) { return x > 20.f ? x : log1pf(__expf(x)); }
__device__ __forceinline__ float wave_sum(float v) { for (int o = 32; o >= 1; o >>= 1) v += __shfl_xor(v, o); return v; }
__device__ __forceinline__ float bf2f(bf16_t b) { return __uint_as_float(((unsigned)b) << 16); }
__device__ __forceinline__ bf16_t f2bf(float f) { unsigned u = __float_as_uint(f); u += 0x7FFFu + ((u >> 16) & 1u); return (bf16_t)(u >> 16); }
}

namespace pg8 {
#define PG8_LAS __attribute__((address_space(3)))
typedef unsigned short bf16_t;
typedef short bf16x8 __attribute__((ext_vector_type(8)));
typedef float f32x4 __attribute__((ext_vector_type(4)));
typedef unsigned u32x4 __attribute__((ext_vector_type(4)));
typedef int v8i __attribute__((ext_vector_type(8)));
constexpr int BM = 256, BK = 64, HALF = 128, HTB = HALF * BK * 2  , STAGE_BYTES = 8 * HTB, NXCD = 8, WGM = 8;

__host__ __device__ __forceinline__ int lds_byte(int r, int c) { const int st = (r >> 4) * 2 + (c >> 5), rr = r & 15, cc = c & 31, ob = rr * 64 + cc * 2; return st * 1024 + (ob ^ (((ob >> 9) & 1) << 5)); }
__host__ __device__ __forceinline__ void stage_rc(int b, int& R, int& C) { const int st = b / 1024, sb = b % 1024, swz = sb ^ (((sb >> 9) & 1) << 5); R = (st >> 1) * 16 + swz / 64; C = (st & 1) * 32 + (swz % 64) / 2; }
__host__ __device__ __forceinline__ int perm32(int rho) { const int n = rho >> 4, i = rho & 15; return 8 * (i >> 2) + 4 * n + (i & 3); }

struct Unit { int pm, pn, bn, aux; };
struct Gemm { const bf16_t* A; const bf16_t* Bt; int K; int sc_w, sc_a; };


__device__ __forceinline__ unsigned cvt_pk_bf16(float lo, float hi) { unsigned r; asm volatile("v_cvt_pk_bf16_f32 %0, %1, %2" : "=v"(r) : "v"(lo), "v"(hi)); return r; }
struct OrderStatic {
    int nM, nN, nwg, G, c;
    __device__ void init(int M, int N, int G_, int c_) { nM = M / BM; nN = N / BM; nwg = nM * nN; G = G_; c = c_; }
    __device__ bool next(int i, Unit& u) const {
        const long L = (long)i * G + c; if (L >= nwg) return false;
        int wgid = (int)L; { const int q = nwg / NXCD, r = nwg % NXCD, xcd = wgid % NXCD, off = wgid / NXCD; wgid = (xcd < r ? xcd * (q + 1) : r * (q + 1) + (xcd - r) * q) + off; }
        const int nig = WGM * nN, gid = wgid / nig, fm = gid * WGM, gsz = (nM - fm) < WGM ? (nM - fm) : WGM;
        u.pm = fm + ((wgid % nig) % gsz); u.pn = (wgid % nig) / gsz; u.bn = u.pn; u.aux = i; return true;
    }
    __device__ __forceinline__ unsigned row_off(int, int) const { return 0u; }
};
template <bool GATHER, bool FP8, class Epi, class Sched>
__device__ __forceinline__ void gemm_phase(PG8_LAS unsigned char* lds, const Gemm g, const Sched& S, const Epi& E) {
    int tid = threadIdx.x; asm volatile("" : "+v"(tid));
    const int wid = __builtin_amdgcn_readfirstlane(tid >> 6), lane = tid & 63, wr = wid >> 2, wc = wid & 3, fr = lane & 15, fq = lane >> 4;
    const int K = g.K; int nt = K / BK; asm volatile("" : "+s"(nt));
#define PG8_STAMP() do {} while (0)
    PG8_STAMP();
    unsigned voffA[2], voffB[2];
#pragma unroll
    for (int i = 0; i < 2; ++i) { int R, C; stage_rc(tid * 16 + i * 8192, R, C); const int Rb = Epi::PERM ? ((R & ~31) + perm32(R & 31)) : R;
        voffA[i] = (unsigned)(R * K + C) * 2u; voffB[i] = (unsigned)(Rb * K + C) * 2u; }
    unsigned voffG[2][2] = {{0u, 0u}, {0u, 0u}};
#define PG8_LOADG(uidx) do { if constexpr (GATHER) { _Pragma("unroll") for (int _h = 0; _h < 2; ++_h) _Pragma("unroll") for (int _i = 0; _i < 2; ++_i) { int R_, C_; stage_rc(tid * 16 + _i * 8192, R_, C_); \
        voffG[_h][_i] = S.row_off((uidx), _h * HALF + R_) + (unsigned)C_ * 2u; } } } while (0)
    const size_t kstep = (size_t)(BK * 2);
    const size_t hstep = (size_t)HALF * K * 2;
    const size_t tstep = 2 * hstep;
    const unsigned ldsw = (unsigned)wid * 1024u;
    const int aoff = lds_byte(wr * 64 + fr, fq * 8), boff = lds_byte(wc * 32 + fr, fq * 8);
    const int c8 = (fq >> 1) * 32 + (fq & 1) * 16;
    const int aoff8a = lds_byte(wr * 64 + fr, c8), aoff8b = lds_byte(wr * 64 + fr, c8 + 8), boff8a = lds_byte(wc * 32 + fr, c8), boff8b = lds_byte(wc * 32 + fr, c8 + 8);
#define PG8_SA(b, h) (((b) * 2 + (h)) * HTB)
#define PG8_SB(b, h) ((4 + (b) * 2 + (h)) * HTB)
#define PG8_STAGE(bufoff, gbase, voff) do { _Pragma("unroll") for (int _i = 0; _i < 2; ++_i) \
        __builtin_amdgcn_global_load_lds((const unsigned*)((const char*)(gbase) + (voff)[_i]), (PG8_LAS unsigned*)(lds + (bufoff) + ldsw + _i * 8192), 16, 0, 0); } while (0)
#define PG8_STAGE_A(bufoff, ptr, h) do { if constexpr (GATHER) { PG8_STAGE(bufoff, ptr, voffG[h]); } else { PG8_STAGE(bufoff, (ptr) + (h) * hstep, voffA); } } while (0)
#define PG8_LDA(dst, b, h) do { if constexpr (FP8) { _Pragma("unroll") for (int m = 0; m < 4; ++m) { const u32x4 lo_ = *(const PG8_LAS u32x4*)(lds + PG8_SA(b, h) + aoff8a + m * 2048), hi_ = *(const PG8_LAS u32x4*)(lds + PG8_SA(b, h) + aoff8b + m * 2048); \
        dst##8[m] = (v8i){(int)lo_.x, (int)lo_.y, (int)lo_.z, (int)lo_.w, (int)hi_.x, (int)hi_.y, (int)hi_.z, (int)hi_.w}; } } else { \
        _Pragma("unroll") for (int m = 0; m < 4; ++m) _Pragma("unroll") for (int k = 0; k < 2; ++k) dst[m][k] = *(const PG8_LAS bf16x8*)(lds + PG8_SA(b, h) + aoff + m * 2048 + k * 1024); } } while (0)
#define PG8_LDB(dst, b, h) do { if constexpr (FP8) { _Pragma("unroll") for (int n = 0; n < 2; ++n) { const u32x4 lo_ = *(const PG8_LAS u32x4*)(lds + PG8_SB(b, h) + boff8a + n * 2048), hi_ = *(const PG8_LAS u32x4*)(lds + PG8_SB(b, h) + boff8b + n * 2048); \
        dst##8[n] = (v8i){(int)lo_.x, (int)lo_.y, (int)lo_.z, (int)lo_.w, (int)hi_.x, (int)hi_.y, (int)hi_.z, (int)hi_.w}; } } else { \
        _Pragma("unroll") for (int n = 0; n < 2; ++n) _Pragma("unroll") for (int k = 0; k < 2; ++k) dst[n][k] = *(const PG8_LAS bf16x8*)(lds + PG8_SB(b, h) + boff + n * 2048 + k * 1024); } } while (0)
#define PG8_MMA(ai, bj, At, Bt) do { __builtin_amdgcn_s_setprio(1); if constexpr (FP8) { _Pragma("unroll") for (int m = 0; m < 4; ++m) _Pragma("unroll") for (int n = 0; n < 2; ++n) \
        acc[ai][bj][m][n] = __builtin_amdgcn_mfma_scale_f32_16x16x128_f8f6f4(Bt##8[n], At##8[m], acc[ai][bj][m][n], 0, 0, 0, g.sc_w, 0, g.sc_a); } else { \
        _Pragma("unroll") for (int m = 0; m < 4; ++m) _Pragma("unroll") for (int n = 0; n < 2; ++n) _Pragma("unroll") for (int k = 0; k < 2; ++k) \
        acc[ai][bj][m][n] = __builtin_amdgcn_mfma_f32_16x16x32_bf16(Bt[n][k], At[m][k], acc[ai][bj][m][n], 0, 0, 0); } __builtin_amdgcn_s_setprio(0); } while (0)
#define PG8_WAIT_V(n) asm volatile("s_waitcnt vmcnt(" #n ")" ::: "memory")
#define PG8_WAIT_L(n) asm volatile("s_waitcnt lgkmcnt(" #n ")" ::: "memory")
#define PG8_BAR __builtin_amdgcn_s_barrier()
#define PG8_SCHED __builtin_amdgcn_sched_barrier(0)
    Unit cur, nxt; int ui = 0;
    if (!S.next(0, cur)) return;
    f32x4 acc[2][2][4][2];
#pragma unroll
    for (int a = 0; a < 2; ++a)
#pragma unroll
        for (int b = 0; b < 2; ++b)
#pragma unroll
            for (int m = 0; m < 4; ++m)
#pragma unroll
                for (int n = 0; n < 2; ++n) acc[a][b][m][n] = (f32x4){0.f, 0.f, 0.f, 0.f};
    bf16x8 At[4][2], B0[2][2], B1[2][2]; v8i At8[4], B08[2], B18[2];
    const char* cA = GATHER ? (const char*)g.A : (const char*)g.A + (size_t)cur.pm * tstep; const char* cB = (const char*)g.Bt + (size_t)cur.bn * tstep;
    PG8_LOADG(0);
    PG8_STAGE(PG8_SB(0, 0), cB, voffB); PG8_STAGE_A(PG8_SA(0, 0), cA, 0); PG8_STAGE(PG8_SB(0, 1), cB + hstep, voffB); PG8_STAGE_A(PG8_SA(0, 1), cA, 1);
    if (wr == 1) PG8_BAR;
    PG8_WAIT_V(4); PG8_BAR;
    PG8_STAGE(PG8_SB(1, 0), cB + kstep, voffB); PG8_STAGE_A(PG8_SA(1, 0), cA + kstep, 0); PG8_STAGE(PG8_SB(1, 1), cB + hstep + kstep, voffB);
    PG8_WAIT_V(6); PG8_BAR;
    PG8_STAMP();
    for (;;) {
        const bool has_next = S.next(ui + 1, nxt);
        const char* nA = has_next ? (GATHER ? (const char*)g.A : (const char*)g.A + (size_t)nxt.pm * tstep) : cA; const char* nB = has_next ? (const char*)g.Bt + (size_t)nxt.bn * tstep : cB;
#pragma unroll 1
        for (int t = 0; t < nt; t += 2) {
            const bool last = (t == nt - 2);
            const char* a1 = cA + (size_t)(t + 1) * kstep;
            const char* a2 = last ? nA : cA + (size_t)(t + 2) * kstep; const char* b2 = last ? nB : cB + (size_t)(t + 2) * kstep;
            const char* a3 = a2 + kstep; const char* b3 = b2 + kstep;
            PG8_LDB(B0, 0, 0); PG8_SCHED; PG8_LDA(At, 0, 0); PG8_STAGE_A(PG8_SA(1, 1), a1, 1);
            PG8_WAIT_L(8); PG8_BAR; PG8_WAIT_L(0); PG8_MMA(0, 0, At, B0); PG8_BAR; PG8_SCHED;
            if (last && has_next) PG8_LOADG(ui + 1);
            PG8_LDB(B1, 0, 1); PG8_STAGE(PG8_SB(0, 0), b2, voffB);
            PG8_BAR; PG8_WAIT_L(0); PG8_MMA(0, 1, At, B1); PG8_BAR;
            PG8_LDA(At, 0, 1); PG8_STAGE_A(PG8_SA(0, 0), a2, 0);
            PG8_BAR; PG8_WAIT_L(0); PG8_MMA(1, 0, At, B0); PG8_BAR; PG8_SCHED;
            PG8_STAGE(PG8_SB(0, 1), b2 + hstep, voffB);
            PG8_WAIT_V(6); PG8_BAR; PG8_MMA(1, 1, At, B1); PG8_BAR;
            PG8_LDB(B0, 1, 0); PG8_SCHED; PG8_LDA(At, 1, 0); PG8_STAGE_A(PG8_SA(0, 1), a2, 1);
            PG8_WAIT_L(8); PG8_BAR; PG8_WAIT_L(0); PG8_MMA(0, 0, At, B0); PG8_BAR; PG8_SCHED;
            PG8_LDB(B1, 1, 1); PG8_STAGE(PG8_SB(1, 0), b3, voffB);
            PG8_BAR; PG8_WAIT_L(0); PG8_MMA(0, 1, At, B1); PG8_BAR;
            PG8_LDA(At, 1, 1); PG8_STAGE_A(PG8_SA(1, 0), a3, 0);
            PG8_BAR; PG8_WAIT_L(0); PG8_MMA(1, 0, At, B0); PG8_BAR; PG8_SCHED;
            PG8_STAGE(PG8_SB(1, 1), b3 + hstep, voffB);
            PG8_WAIT_V(6); PG8_BAR; PG8_MMA(1, 1, At, B1); PG8_BAR;
        }
        PG8_STAMP();
        E(acc, cur, wr, wc, fr, fq);
        PG8_STAMP();
        if (!has_next) break;
#pragma unroll
        for (int a = 0; a < 2; ++a)
#pragma unroll
            for (int b = 0; b < 2; ++b)
#pragma unroll
                for (int m = 0; m < 4; ++m)
#pragma unroll
                    for (int n = 0; n < 2; ++n) acc[a][b][m][n] = (f32x4){0.f, 0.f, 0.f, 0.f};
        cur = nxt; cA = nA; cB = nB; ++ui;
    }
    PG8_WAIT_V(0);
    if (wr == 0) PG8_BAR;
    PG8_BAR;
    PG8_STAMP();
#undef PG8_STAMP
#undef PG8_SA
#undef PG8_SB
#undef PG8_STAGE
#undef PG8_STAGE_A
#undef PG8_LOADG
#undef PG8_LDA
#undef PG8_LDB
#undef PG8_MMA
#undef PG8_WAIT_V
#undef PG8_WAIT_L
#undef PG8_BAR
#undef PG8_SCHED
}
}
namespace {
#define XB_TMO      128
#define XB_XCNT(j)  (256  + 64 * (j))
#define XB_XSUB(j)  (1280 + 64 * (j))
#define XB_XGEN(j)  (2304 + 64 * (j))
#define XB_TOP      3328
#define XB_TOPGEN   3392
#define XCD_BAR_WORDS 3456
#define XB_SPIN_CAP (1u << 18)

__device__ __forceinline__ unsigned xb_ld(unsigned* p)              { return __hip_atomic_load(p, __ATOMIC_RELAXED, __HIP_MEMORY_SCOPE_AGENT); }
__device__ __forceinline__ unsigned xb_add(unsigned* p, unsigned v) { return __hip_atomic_fetch_add(p, v, __ATOMIC_RELAXED, __HIP_MEMORY_SCOPE_AGENT); }
__device__ __forceinline__ unsigned xb_xcc_id() { return (unsigned)__builtin_amdgcn_s_getreg((3 << 11) | 20) & 0xFu; }
#define XB_SPIN(cond, bar) do { unsigned _sp = 0; while (cond) { __builtin_amdgcn_s_sleep(1); \
    if ((++_sp & 255u) == 0u) { if (xb_ld(&(bar)[XB_TMO])) break; if (_sp > XB_SPIN_CAP) { atomicAdd(&(bar)[XB_TMO], 1u); break; } } } } while (0)

struct XcdBarrier {
    unsigned* bar; unsigned x;
    volatile LAS unsigned* st;
};

__device__ __forceinline__ XcdBarrier xcd_barrier_post(unsigned* bar, volatile LAS unsigned* st) {
    XcdBarrier b; b.bar = bar; b.x = xb_xcc_id(); b.st = st;
    if (threadIdx.x == 0) (void)xb_add(&bar[XB_XCNT(b.x)], 1u);
    return b;
}
__device__ __forceinline__ void xcd_barrier_complete(unsigned* bar, unsigned x, unsigned& nloc, unsigned& nx) {
    const unsigned G = gridDim.x * gridDim.y * gridDim.z;
    unsigned sum, cnt, mine, sp = 0u;
    for (;;) {
        sum = 0u; cnt = 0u; mine = 0u;
#pragma unroll
        for (unsigned j = 0; j < 16; ++j) { const unsigned c = xb_ld(&bar[XB_XCNT(j)]); sum += c; cnt += (c > 0u) ? 1u : 0u; mine = (j == x) ? c : mine; }
        if (sum == G) break;
        __builtin_amdgcn_s_sleep(1);
        if ((++sp & 255u) == 0u) { if (xb_ld(&bar[XB_TMO])) break; if (sp > XB_SPIN_CAP) { atomicAdd(&bar[XB_TMO], 1u); break; } }
    }
    nloc = mine > 0u ? mine : 1u; nx = cnt > 0u ? cnt : 1u;
}

__device__ __forceinline__ void xcd_barrier(const XcdBarrier& b) {
    asm volatile("s_waitcnt vmcnt(0)" ::: "memory");
    __syncthreads();
    if (threadIdx.x == 0) {
        unsigned* bar = b.bar;
        __builtin_amdgcn_s_waitcnt(0);
        unsigned nloc = b.st[0], nx = b.st[1];
        if (nloc == 0u) { xcd_barrier_complete(bar, b.x, nloc, nx); b.st[0] = nloc; b.st[1] = nx; }
        const unsigned old = xb_add(&bar[XB_XSUB(b.x)], 1u);
        const unsigned gen = old / nloc;
        if (old + 1u == (gen + 1u) * nloc) {
            __builtin_amdgcn_fence(__ATOMIC_RELEASE, "agent");
            asm volatile("s_waitcnt vmcnt(0)" ::: "memory");
            const unsigned og = xb_add(&bar[XB_TOP], 1u);
            const unsigned tg = og / nx;
            if (og + 1u == (tg + 1u) * nx) xb_add(&bar[XB_TOPGEN], 1u);
            else XB_SPIN(xb_ld(&bar[XB_TOPGEN]) == tg, bar);
            __builtin_amdgcn_fence(__ATOMIC_ACQUIRE, "agent");
            xb_add(&bar[XB_XGEN(b.x)], 1u);
            asm volatile("s_waitcnt vmcnt(0)" ::: "memory");
        } else {
            XB_SPIN(xb_ld(&bar[XB_XGEN(b.x)]) == gen, bar);
            __builtin_amdgcn_fence(__ATOMIC_ACQUIRE, "agent");
            asm volatile("s_waitcnt vmcnt(0)" ::: "memory");
        }
    }
    __syncthreads();
}

}
namespace {
using pg8::f32x4; using pg8::u32x4; using pg8::cvt_pk_bf16;

template <class ARow, class Epi>
__device__ __forceinline__ void gemm_tile(float* smem, int mvalid, int nvalid, int K, ARow arow, const float* Bp, int ldb, Epi epi) {
  float* As = smem;
  float* Bs = smem + 16 * 68;
  const int tid = threadIdx.x, ty = tid >> 5, tx = tid & 31;
  float acc[4][4];
#pragma unroll
  for (int i = 0; i < 4; ++i)
#pragma unroll
    for (int j = 0; j < 4; ++j) acc[i][j] = 0.f;
  const int ak = tid & 15, ar = tid >> 4;
  const float* ap0 = (ar < mvalid) ? arow(ar) : nullptr;
  const float* ap1 = (ar + 32 < mvalid) ? arow(ar + 32) : nullptr;
  const int bn = tid & 127, bk = tid >> 7;
  for (int k0 = 0; k0 < K; k0 += 16) {
    As[ak * 68 + ar] = ap0 ? ap0[k0 + ak] : 0.f;
    As[ak * 68 + ar + 32] = ap1 ? ap1[k0 + ak] : 0.f;
#pragma unroll
    for (int i = 0; i < 4; ++i) { const int kk = bk + 4 * i; Bs[kk * 128 + bn] = (bn < nvalid) ? Bp[(size_t)(k0 + kk) * ldb + bn] : 0.f; }
    __syncthreads();
#pragma unroll
    for (int kk = 0; kk < 16; ++kk) {
      float a[4], b[4];
#pragma unroll
      for (int i = 0; i < 4; ++i) a[i] = As[kk * 68 + ty * 4 + i];
#pragma unroll
      for (int j = 0; j < 4; ++j) b[j] = Bs[kk * 128 + tx * 4 + j];
#pragma unroll
      for (int i = 0; i < 4; ++i)
#pragma unroll
        for (int j = 0; j < 4; ++j) acc[i][j] += a[i] * b[j];
    }
    __syncthreads();
  }
#pragma unroll
  for (int i = 0; i < 4; ++i)
#pragma unroll
    for (int j = 0; j < 4; ++j) { const int r = ty * 4 + i, c = tx * 4 + j; if (r < mvalid && c < nvalid) epi(r, c, acc[i][j]); }
}

template <class RowMap>
__device__ __forceinline__ void cvt_tile(const float* __restrict__ src, int N, int K, int k0, int n0, bf16_t* __restrict__ dst, RowMap rm) {
  const int lane = threadIdx.x & 63, w = threadIdx.x >> 6;
  const int n = n0 + (lane & 15) * 4, kk = k0 + (w * 4 + (lane >> 4)) * 8;
  if (n >= N) return;
  float4 v[8];
#pragma unroll
  for (int j = 0; j < 8; ++j) v[j] = *(const float4*)(src + (size_t)(kk + j) * N + n);
  u32x4 o;
  o.x = cvt_pk_bf16(v[0].x, v[1].x); o.y = cvt_pk_bf16(v[2].x, v[3].x); o.z = cvt_pk_bf16(v[4].x, v[5].x); o.w = cvt_pk_bf16(v[6].x, v[7].x);
  *(u32x4*)(dst + (size_t)rm(n + 0) * K + kk) = o;
  o.x = cvt_pk_bf16(v[0].y, v[1].y); o.y = cvt_pk_bf16(v[2].y, v[3].y); o.z = cvt_pk_bf16(v[4].y, v[5].y); o.w = cvt_pk_bf16(v[6].y, v[7].y);
  *(u32x4*)(dst + (size_t)rm(n + 1) * K + kk) = o;
  o.x = cvt_pk_bf16(v[0].z, v[1].z); o.y = cvt_pk_bf16(v[2].z, v[3].z); o.z = cvt_pk_bf16(v[4].z, v[5].z); o.w = cvt_pk_bf16(v[6].z, v[7].z);
  *(u32x4*)(dst + (size_t)rm(n + 2) * K + kk) = o;
  o.x = cvt_pk_bf16(v[0].w, v[1].w); o.y = cvt_pk_bf16(v[2].w, v[3].w); o.z = cvt_pk_bf16(v[4].w, v[5].w); o.w = cvt_pk_bf16(v[6].w, v[7].w);
  *(u32x4*)(dst + (size_t)rm(n + 3) * K + kk) = o;
}
template <class RowMap>
__device__ void cvt_job(const float* src, int nmat, int K, int N, bf16_t* dst, size_t dstride, RowMap rm) {
  const int kt = K / 256, ntl = (N + 63) / 64, per = kt * ntl;
  for (int it = blockIdx.x; it < nmat * per; it += gridDim.x) {
    const int m = it / per, r = it % per, k0 = (r / ntl) * 256, n0 = (r % ntl) * 64;
    cvt_tile(src + (size_t)m * K * N, N, K, k0, n0, dst + (size_t)m * dstride, rm);
  }
}
__device__ void ph_convert(const Params& p) {
  const size_t gtid = (size_t)blockIdx.x * NT + threadIdx.x, gsz = (size_t)gridDim.x * NT;
  for (size_t i = gtid; i < (size_t)T * D / 8; i += gsz) {
    const float4 a = *(const float4*)(p.x + i * 8), b = *(const float4*)(p.x + i * 8 + 4);
    u32x4 o; o.x = cvt_pk_bf16(a.x, a.y); o.y = cvt_pk_bf16(a.z, a.w); o.z = cvt_pk_bf16(b.x, b.y); o.w = cvt_pk_bf16(b.z, b.w);
    *(u32x4*)(p.xb + i * 8) = o;
  }
  cvt_job(p.w_in, 1, D, PW, p.WinT, 0, [](int n) { return n < O_DT ? n : (n < O_Q ? PLD + (n - O_DT) : n - 32); });
  for (size_t i = gtid; i < (size_t)(NPROJ - PW) * D / 8; i += gsz) *(u32x4*)(p.WinT + (size_t)PW * D + i * 8) = (u32x4){0u, 0u, 0u, 0u};
  cvt_job(p.w_out, 1, D, D, p.WoutT, 0, [](int n) { return n; });
  cvt_job(p.w_router, 1, D, NE, p.WrT, 0, [](int n) { return n; });
}
__device__ __forceinline__ unsigned pk4_fp8(float a, float b, float c, float d) { int w = 0; w = __builtin_amdgcn_cvt_pk_fp8_f32(a * W8S, b * W8S, w, false); w = __builtin_amdgcn_cvt_pk_fp8_f32(c * W8S, d * W8S, w, true); return (unsigned)w; }
template <class RowMap>
__device__ __forceinline__ void cvt_range8(const float* __restrict__ src, int K, int N, unsigned char* __restrict__ dst, size_t dstride, RowMap rm, int it0, int it1) {
  constexpr int NT2 = 2;
  const int kt = K / 512, ntl = N / 64, per = kt * ntl;
  int tid = threadIdx.x; asm volatile("" : "+v"(tid));
  const int lane = tid & 63, w = tid >> 6, nl = (lane & 15) * 4, kl = (w * 4 + (lane >> 4)) * 16;
  for (int it = it0; it < it1; it += NT2) {
    float4 v[NT2][16];
#pragma unroll
    for (int q = 0; q < NT2; ++q) { const int m = (it + q) / per, r = (it + q) % per, kk = (r / ntl) * 512 + kl, n = (r % ntl) * 64 + nl;
      const float* sp = src + (size_t)m * K * N + (size_t)kk * N + n;
#pragma unroll
      for (int j = 0; j < 16; ++j) v[q][j] = *(const float4*)(sp + (size_t)j * N); }
#pragma unroll
    for (int q = 0; q < NT2; ++q) { const int m = (it + q) / per, r = (it + q) % per, kk = (r / ntl) * 512 + kl, n = (r % ntl) * 64 + nl;
      unsigned char* dp = dst + (size_t)m * dstride + kk; u32x4 o;
      o.x = pk4_fp8(v[q][0].x, v[q][1].x, v[q][2].x, v[q][3].x); o.y = pk4_fp8(v[q][4].x, v[q][5].x, v[q][6].x, v[q][7].x); o.z = pk4_fp8(v[q][8].x, v[q][9].x, v[q][10].x, v[q][11].x); o.w = pk4_fp8(v[q][12].x, v[q][13].x, v[q][14].x, v[q][15].x);
      *(u32x4*)(dp + (size_t)rm(n + 0) * K) = o;
      o.x = pk4_fp8(v[q][0].y, v[q][1].y, v[q][2].y, v[q][3].y); o.y = pk4_fp8(v[q][4].y, v[q][5].y, v[q][6].y, v[q][7].y); o.z = pk4_fp8(v[q][8].y, v[q][9].y, v[q][10].y, v[q][11].y); o.w = pk4_fp8(v[q][12].y, v[q][13].y, v[q][14].y, v[q][15].y);
      *(u32x4*)(dp + (size_t)rm(n + 1) * K) = o;
      o.x = pk4_fp8(v[q][0].z, v[q][1].z, v[q][2].z, v[q][3].z); o.y = pk4_fp8(v[q][4].z, v[q][5].z, v[q][6].z, v[q][7].z); o.z = pk4_fp8(v[q][8].z, v[q][9].z, v[q][10].z, v[q][11].z); o.w = pk4_fp8(v[q][12].z, v[q][13].z, v[q][14].z, v[q][15].z);
      *(u32x4*)(dp + (size_t)rm(n + 2) * K) = o;
      o.x = pk4_fp8(v[q][0].w, v[q][1].w, v[q][2].w, v[q][3].w); o.y = pk4_fp8(v[q][4].w, v[q][5].w, v[q][6].w, v[q][7].w); o.z = pk4_fp8(v[q][8].w, v[q][9].w, v[q][10].w, v[q][11].w); o.w = pk4_fp8(v[q][12].w, v[q][13].w, v[q][14].w, v[q][15].w);
      *(u32x4*)(dp + (size_t)rm(n + 3) * K) = o; }
  }
}
constexpr int CVT_ITEMS = 3 * 256 + 3 * 4;
__device__ __forceinline__ void cvt_moe_item(const Params& p, int item) {
  unsigned char* gu = (unsigned char*)p.WguT; unsigned char* dn = (unsigned char*)p.WdT;
  if (item < 256) cvt_range8(p.wg_e, D, DE, gu, (size_t)1024 * D, [](int n) { return (n >> 7) * 256 + (n & 127); }, item * 8, item * 8 + 8);
  else if (item < 512) cvt_range8(p.wu_e, D, DE, gu, (size_t)1024 * D, [](int n) { return (n >> 7) * 256 + 128 + (n & 127); }, (item - 256) * 8, (item - 256) * 8 + 8);
  else if (item < 768) cvt_range8(p.wd_e, DE, D, dn, (size_t)D * DE, [](int n) { return n; }, (item - 512) * 8, (item - 512) * 8 + 8);
  else if (item < 772) cvt_range8(p.wg_s, D, DE, gu + (size_t)NE * 1024 * D, 0, [](int n) { return (n >> 7) * 256 + (n & 127); }, (item - 768) * 8, (item - 768) * 8 + 8);
  else if (item < 776) cvt_range8(p.wu_s, D, DE, gu + (size_t)NE * 1024 * D, 0, [](int n) { return (n >> 7) * 256 + 128 + (n & 127); }, (item - 772) * 8, (item - 772) * 8 + 8);
  else cvt_range8(p.wd_s, DE, D, dn + (size_t)NE * D * DE, 0, [](int n) { return n; }, (item - 776) * 8, (item - 776) * 8 + 8);
}

struct EpiProj {
  static constexpr bool PERM = true;
  bf16_t* proj; float* dt; const float* bias_f; const float* bias_b;
  __device__ __forceinline__ void operator()(const f32x4 (&acc)[2][2][4][2], const pg8::Unit& u, int wr, int wc, int fr, int fq) const {
    asm volatile("" : "+v"(fr), "+v"(fq));
    const int row0 = u.pm * 256 + wr * 64 + fr;
    if (u.pn < 22) {
      const int col0 = u.pn * 256 + wc * 32 + 8 * fq;
      const float sc = (u.pn >= 10 && u.pn < 14) ? QS : 1.0f;
#pragma unroll
      for (int ai = 0; ai < 2; ++ai)
#pragma unroll
        for (int m = 0; m < 4; ++m) { bf16_t* rowp = proj + (size_t)(row0 + ai * 128 + m * 16) * PLD + col0;
#pragma unroll
          for (int bj = 0; bj < 2; ++bj) { const f32x4 v0 = acc[ai][bj][m][0] * sc, v1 = acc[ai][bj][m][1] * sc;
            u32x4 w; w.x = cvt_pk_bf16(v0[0], v0[1]); w.y = cvt_pk_bf16(v0[2], v0[3]); w.z = cvt_pk_bf16(v1[0], v1[1]); w.w = cvt_pk_bf16(v1[2], v1[3]);
            *(u32x4*)(rowp + bj * 128) = w; } }
    } else if (wc == 0) {
      const int c0 = 8 * fq;
      float bs[8];
#pragma unroll
      for (int j = 0; j < 8; ++j) bs[j] = (c0 + j) < 16 ? bias_f[c0 + j] : bias_b[c0 + j - 16];
#pragma unroll
      for (int ai = 0; ai < 2; ++ai)
#pragma unroll
        for (int m = 0; m < 4; ++m) { float* rowp = dt + (size_t)(row0 + ai * 128 + m * 16) * 32 + c0;
          const f32x4 v0 = acc[ai][0][m][0], v1 = acc[ai][0][m][1];
          f32x4 o0, o1;
#pragma unroll
          for (int j = 0; j < 4; ++j) { o0[j] = softplus_f(v0[j] + bs[j]); o1[j] = softplus_f(v1[j] + bs[4 + j]); }
          *(f32x4*)rowp = o0; *(f32x4*)(rowp + 4) = o1; }
    }
  }
};
struct EpiOut {
  static constexpr bool PERM = false;
  const float* x; float* v;
  __device__ __forceinline__ void operator()(const f32x4 (&acc)[2][2][4][2], const pg8::Unit& u, int wr, int wc, int fr, int fq) const {
    asm volatile("" : "+v"(fr), "+v"(fq));
    const int row0 = u.pm * 256 + wr * 64 + fr, col0 = u.pn * 256 + wc * 32 + 4 * fq;
#pragma unroll
    for (int ai = 0; ai < 2; ++ai)
#pragma unroll
      for (int m = 0; m < 4; ++m) { const size_t off = (size_t)(row0 + ai * 128 + m * 16) * D + col0;
#pragma unroll
        for (int bj = 0; bj < 2; ++bj)
#pragma unroll
          for (int n = 0; n < 2; ++n) { const f32x4 xv = *(const f32x4*)(x + off + bj * 128 + n * 16); *(f32x4*)(v + off + bj * 128 + n * 16) = xv * ALPHA + acc[ai][bj][m][n]; } }
  }
};

namespace at {
using bf16x8 = __attribute__((ext_vector_type(8))) short;
using s16x4  = __attribute__((ext_vector_type(4))) short;
using f32x16 = __attribute__((ext_vector_type(16))) float;
using u32x4  = __attribute__((ext_vector_type(4))) unsigned;
constexpr int KVBLK = 64;
constexpr size_t SHM_V = KVBLK * 128 * 2, SHM_K = KVBLK * 128 * 2;
constexpr float THR2 = 8.0f;
#define AT_KSWZ(row, colB) ((row) * 256 + ((colB) ^ (((row) & 7) << 4)))
#define AT_SBAR() __builtin_amdgcn_sched_barrier(0)
__device__ __forceinline__ int crow(int r, int hi) { return (r & 3) + 8 * (r >> 2) + 4 * hi; }
__device__ __forceinline__ unsigned cvtpk(float lo, float hi) { unsigned r; asm volatile("v_cvt_pk_bf16_f32 %0, %1, %2" : "=v"(r) : "v"(lo), "v"(hi)); return r; }

__device__ __forceinline__ void partialSM(f32x16& p0, f32x16& p1, float dqh, float nsl2, float& m_reg, float& mn, float& alpha) {
#pragma unroll
  for (int r = 0; r < 16; ++r) { const float c = (float)((r & 3) + 8 * (r >> 2));
    p0[r] = fmaf(nsl2, fabsf(dqh - c), p0[r]); p1[r] = fmaf(nsl2, fabsf(dqh - (c + 32.f)), p1[r]); }
  float pmax = p0[0];
#pragma unroll
  for (int r = 1; r < 16; ++r) pmax = fmaxf(pmax, p0[r]);
#pragma unroll
  for (int r = 0; r < 16; ++r) pmax = fmaxf(pmax, p1[r]);
  { auto rr = __builtin_amdgcn_permlane32_swap(__float_as_uint(pmax), __float_as_uint(pmax), false, false);
    pmax = fmaxf(__uint_as_float(rr[0]), __uint_as_float(rr[1])); }
  if (__builtin_expect(__all(pmax - m_reg <= THR2), 1)) { mn = m_reg; alpha = 1.f; }
  else { mn = fmaxf(m_reg, pmax); alpha = __builtin_amdgcn_exp2f(m_reg - mn); m_reg = mn; }
#pragma unroll
  for (int r = 0; r < 16; ++r) p0[r] = p0[r] - mn;
#pragma unroll
  for (int r = 0; r < 16; ++r) p1[r] = p1[r] - mn;
#pragma unroll
  for (int r = 0; r < 16; ++r) p0[r] = __builtin_amdgcn_exp2f(p0[r]);
}
__device__ __forceinline__ void finishSM(f32x16& p0, f32x16& p1, float alpha, float& l_reg, bf16x8& pa0, bf16x8& pa1, bf16x8& pa2, bf16x8& pa3) {
#pragma unroll
  for (int r = 0; r < 16; ++r) p1[r] = __builtin_amdgcn_exp2f(p1[r]);
  float ps = 0;
#pragma unroll
  for (int r = 0; r < 16; ++r) ps += p0[r];
#pragma unroll
  for (int r = 0; r < 16; ++r) ps += p1[r];
  { auto rr = __builtin_amdgcn_permlane32_swap(__float_as_uint(ps), __float_as_uint(ps), false, false);
    ps = __uint_as_float(rr[0]) + __uint_as_float(rr[1]); }
  l_reg = l_reg * alpha + ps;
#define AT_PK4(P, BASE, OUT) do { unsigned a0 = cvtpk(P[BASE + 0], P[BASE + 1]), a1 = cvtpk(P[BASE + 2], P[BASE + 3]);   \
    unsigned b0 = cvtpk(P[BASE + 4], P[BASE + 5]), b1 = cvtpk(P[BASE + 6], P[BASE + 7]);                              \
    auto r0 = __builtin_amdgcn_permlane32_swap(a0, b0, false, false); auto r1 = __builtin_amdgcn_permlane32_swap(a1, b1, false, false); \
    u32x4 w = {r0[0], r1[0], r0[1], r1[1]}; OUT = *reinterpret_cast<bf16x8*>(&w); } while (0)
  AT_PK4(p0, 0, pa0); AT_PK4(p0, 8, pa1); AT_PK4(p1, 0, pa2); AT_PK4(p1, 8, pa3);
#undef AT_PK4
}
__device__ __forceinline__ void qkt(f32x16& p0, f32x16& p1, const char* Ks, const bf16x8* qr, int r32, int hi, int cm) {
  p0 = f32x16{}; p1 = f32x16{};
#pragma unroll
  for (int d0 = 0; d0 < 4; ++d0) { const int cb = (cm + d0 * 16 + hi * 8) * 2;
    bf16x8 b0 = *reinterpret_cast<const bf16x8*>(Ks + AT_KSWZ(r32, cb));
    bf16x8 b1 = *reinterpret_cast<const bf16x8*>(Ks + AT_KSWZ(32 + r32, cb));
    p0 = __builtin_amdgcn_mfma_f32_32x32x16_bf16(b0, qr[d0], p0, 0, 0, 0);
    p1 = __builtin_amdgcn_mfma_f32_32x32x16_bf16(b1, qr[d0], p1, 0, 0, 0); }
}
__device__ __forceinline__ int v_st(int k, int c) { const int kk = (k & ~0xC) | ((k & 4) << 1) | ((k & 8) >> 1); return ((kk >> 3) * 4 + (c >> 5)) * 512 + ((kk & 7) * 32 + (c & 31)) * 2; }
__device__ __forceinline__ int v_rd_base(int lane) { return ((lane & 3) << 3) | (((lane >> 2) & 3) << 6) | (((lane >> 4) & 1) << 5) | (((lane >> 5) & 1) << 8); }
constexpr int v_rd_off(int d0, int ks, int half) { return d0 * 512 + ks * 4096 + half * 2048; }
template <int OFF> __device__ __forceinline__ s16x4 tr_read(int vb) {
  s16x4 r; asm volatile("ds_read_b64_tr_b16 %0, %1 offset:%2" : "=&v"(r) : "v"(vb), "i"(OFF) : "memory"); return r;
}
template <int D0> __device__ __forceinline__ void pv_one(f32x16& od, int vb, bf16x8 pa0, bf16x8 pa1, bf16x8 pa2, bf16x8 pa3) {
  const s16x4 l0 = tr_read<v_rd_off(D0, 0, 0)>(vb), h0 = tr_read<v_rd_off(D0, 0, 1)>(vb), l1 = tr_read<v_rd_off(D0, 1, 0)>(vb), h1 = tr_read<v_rd_off(D0, 1, 1)>(vb);
  const s16x4 l2 = tr_read<v_rd_off(D0, 2, 0)>(vb), h2 = tr_read<v_rd_off(D0, 2, 1)>(vb), l3 = tr_read<v_rd_off(D0, 3, 0)>(vb), h3 = tr_read<v_rd_off(D0, 3, 1)>(vb);
  asm volatile("s_waitcnt lgkmcnt(0)" ::: "memory"); AT_SBAR();
#define AT_PK(L, H) (bf16x8){L[0], L[1], L[2], L[3], H[0], H[1], H[2], H[3]}
  od = __builtin_amdgcn_mfma_f32_32x32x16_bf16(pa0, AT_PK(l0, h0), od, 0, 0, 0);
  od = __builtin_amdgcn_mfma_f32_32x32x16_bf16(pa1, AT_PK(l1, h1), od, 0, 0, 0);
  od = __builtin_amdgcn_mfma_f32_32x32x16_bf16(pa2, AT_PK(l2, h2), od, 0, 0, 0);
  od = __builtin_amdgcn_mfma_f32_32x32x16_bf16(pa3, AT_PK(l3, h3), od, 0, 0, 0);
#undef AT_PK
}
__device__ __forceinline__ void pv_d0(f32x16* o, int vb, bf16x8 pa0, bf16x8 pa1, bf16x8 pa2, bf16x8 pa3) {
  pv_one<0>(o[0], vb, pa0, pa1, pa2, pa3); pv_one<1>(o[1], vb, pa0, pa1, pa2, pa3); pv_one<2>(o[2], vb, pa0, pa1, pa2, pa3); pv_one<3>(o[3], vb, pa0, pa1, pa2, pa3);
}

__device__ __forceinline__ void attn_item(const bf16_t* __restrict__ Qb, const bf16_t* __restrict__ Kh, const bf16_t* __restrict__ Vh, bf16_t* __restrict__ Ub,
                                          int q0, float nsl2, float lam, const float* __restrict__ normw, char* lds) {
  constexpr int LDK = PLD;
  int tid = threadIdx.x; asm volatile("" : "+v"(tid));
  const int wid = tid >> 6, lane = tid & 63, r32 = lane & 31, hi = lane >> 5, rg = wid >> 1, cmap = wid & 1, cm = cmap * 64;
  char* V_lds = lds; char* K_lds = lds + 2 * SHM_V;
  float* ws = (float*)(lds + 2 * SHM_V + 2 * SHM_K) + wid * 64; float* li_l = ws; float* al_l = ws + 32;
  float m_reg = -1e30f, l_reg = 0; f32x16 o[4] = {}; bf16x8 qr[4];
  const bf16_t* Qw = Qb + (size_t)(rg * 32 + r32) * LDK + cm + hi * 8;
#pragma unroll
  for (int d0 = 0; d0 < 4; ++d0) qr[d0] = *reinterpret_cast<const bf16x8*>(Qw + d0 * 16);
  const int sr = tid >> 4, sc = (tid & 15) * 8, vst0 = v_st(sr, sc), vst1 = v_st(32 + sr, sc);
  const int vb0 = (int)(uintptr_t)V_lds + v_rd_base(lane);
  const float qposh = (float)(q0 + rg * 32 + r32 - 4 * hi);
  struct { bf16x8 vs0, vs1, ks0, ks1; } sr_[2];
#define SLOAD(i, k0) do { sr_[i].vs0 = *reinterpret_cast<const bf16x8*>(&Vh[(size_t)((k0) + sr) * LDK + sc]); sr_[i].vs1 = *reinterpret_cast<const bf16x8*>(&Vh[(size_t)((k0) + 32 + sr) * LDK + sc]); \
    sr_[i].ks0 = *reinterpret_cast<const bf16x8*>(&Kh[(size_t)((k0) + sr) * LDK + sc]); sr_[i].ks1 = *reinterpret_cast<const bf16x8*>(&Kh[(size_t)((k0) + 32 + sr) * LDK + sc]); } while (0)
#define SWRITE(b, i) do { *(bf16x8*)(V_lds + (b) * SHM_V + vst0) = sr_[i].vs0;          \
    *(bf16x8*)(V_lds + (b) * SHM_V + vst1) = sr_[i].vs1; int kc = sc * 2;               \
    *(bf16x8*)(K_lds + (b) * SHM_K + AT_KSWZ(sr, kc)) = sr_[i].ks0;                       \
    *(bf16x8*)(K_lds + (b) * SHM_K + AT_KSWZ(32 + sr, kc)) = sr_[i].ks1; } while (0)
#define SWAIT() asm volatile("s_waitcnt vmcnt(4)" ::: "memory")
#define RESC(a) do { if (__any((a) < 1.f)) { if (hi == 0) al_l[r32] = (a); asm volatile("s_waitcnt lgkmcnt(0)" ::: "memory"); \
    _Pragma("unroll") for (int d = 0; d < 4; ++d) _Pragma("unroll") for (int r = 0; r < 16; ++r) o[d][r] *= al_l[crow(r, hi)]; } } while (0)
  f32x16 pA0, pA1, pB0, pB1; float mnA, mnB, alA, alB; bf16x8 pa0, pa1, pa2, pa3; constexpr int NTL = S / KVBLK;
  constexpr int SE = 0, SO = 1;
  SLOAD(SE, 0); asm volatile("s_waitcnt vmcnt(0)" ::: "memory"); SWRITE(0, SE); __syncthreads();
  qkt(pA0, pA1, K_lds, qr, r32, hi, cm); partialSM(pA0, pA1, qposh, nsl2, m_reg, mnA, alA);
  SLOAD(SO, KVBLK); SLOAD(SE, 2 * KVBLK);
  SWAIT(); SWRITE(1, SO); __syncthreads();
  for (int j = 1; j + 1 < NTL; j += 2) {
    AT_SBAR(); qkt(pB0, pB1, K_lds + SHM_K, qr, r32, hi, cm);
    finishSM(pA0, pA1, alA, l_reg, pa0, pa1, pa2, pa3); AT_SBAR();
    SLOAD(SO, (j + 2) * KVBLK); AT_SBAR();
    pv_d0(o, vb0, pa0, pa1, pa2, pa3); partialSM(pB0, pB1, qposh - (float)(j * KVBLK), nsl2, m_reg, mnB, alB);
    __syncthreads(); SWAIT(); SWRITE(0, SE);
    RESC(alB); __syncthreads();
    AT_SBAR(); qkt(pA0, pA1, K_lds, qr, r32, hi, cm);
    finishSM(pB0, pB1, alB, l_reg, pa0, pa1, pa2, pa3); AT_SBAR();
    if (j + 3 < NTL) SLOAD(SE, (j + 3) * KVBLK); AT_SBAR();
    pv_d0(o, vb0 + (int)SHM_V, pa0, pa1, pa2, pa3); partialSM(pA0, pA1, qposh - (float)((j + 1) * KVBLK), nsl2, m_reg, mnA, alA);
    __syncthreads(); SWAIT(); SWRITE(1, SO);
    RESC(alA); __syncthreads();
  }
  AT_SBAR(); qkt(pB0, pB1, K_lds + SHM_K, qr, r32, hi, cm);
  finishSM(pA0, pA1, alA, l_reg, pa0, pa1, pa2, pa3); AT_SBAR();
  pv_d0(o, vb0, pa0, pa1, pa2, pa3); partialSM(pB0, pB1, qposh - (float)((NTL - 1) * KVBLK), nsl2, m_reg, mnB, alB);
  __syncthreads(); RESC(alB);
  finishSM(pB0, pB1, alB, l_reg, pa0, pa1, pa2, pa3); AT_SBAR();
  pv_d0(o, vb0 + (int)SHM_V, pa0, pa1, pa2, pa3);
  if (hi == 0) li_l[r32] = l_reg; asm volatile("s_waitcnt lgkmcnt(0)" ::: "memory");
  float rli[16];
#pragma unroll
  for (int r = 0; r < 16; ++r) rli[r] = __builtin_amdgcn_rcpf(li_l[crow(r, hi)]);
#pragma unroll
  for (int d = 0; d < 4; ++d)
#pragma unroll
    for (int r = 0; r < 16; ++r) o[d][r] *= rli[r];
  __syncthreads();
  float* X = (float*)lds + rg * (32 * 128);
  if (cmap == 1) {
#pragma unroll
    for (int d = 0; d < 4; ++d)
#pragma unroll
      for (int r = 0; r < 16; ++r) X[crow(r, hi) * 128 + d * 32 + r32] = o[d][r];
  }
  __syncthreads();
  if (cmap == 0) {
    float ss[16];
#pragma unroll
    for (int r = 0; r < 16; ++r) ss[r] = 0.f;
#pragma unroll
    for (int d = 0; d < 4; ++d)
#pragma unroll
      for (int r = 0; r < 16; ++r) { const float v = o[d][r] - lam * X[crow(r, hi) * 128 + d * 32 + r32]; o[d][r] = v; ss[r] += v * v; }
#pragma unroll
    for (int r = 0; r < 16; ++r) { float s = ss[r]; s += __shfl_xor(s, 16); s += __shfl_xor(s, 8); s += __shfl_xor(s, 4); s += __shfl_xor(s, 2); s += __shfl_xor(s, 1);
      ss[r] = rsqrtf(s * (1.f / 128.f) + 1e-5f) * (1.f - LAMBDA_INIT); }
    float nw[4];
#pragma unroll
    for (int d = 0; d < 4; ++d) nw[d] = normw[d * 32 + r32];
#pragma unroll
    for (int r = 0; r < 16; ++r) { bf16_t* up = Ub + (size_t)(rg * 32 + crow(r, hi)) * D + r32;
#pragma unroll
      for (int d = 0; d < 4; ++d) up[d * 32] = f2bf(o[d][r] * ss[r] * nw[d]); }
  }
  __syncthreads();
#undef SLOAD
#undef SWRITE
#undef SWAIT
#undef RESC
}
}

__device__ void ph_attn_mfma(const Params& p, char* lds, int* qhead) {
  float lam;
  { float s1 = 0.f, s2 = 0.f; for (int i = 0; i < 64; ++i) { s1 += p.lq1[i] * p.lk1[i]; s2 += p.lq2[i] * p.lk2[i]; } lam = __expf(s1) - __expf(s2) + LAMBDA_INIT; }
  int* qslot = (int*)(lds + 72 * 1024);
  bool more_a = true, more_c = true;
  for (int turn = 0; more_a || more_c; ++turn) {
    const bool do_attn = more_a && (!more_c || (turn & 1) == 0);
    __syncthreads();
    if (threadIdx.x == 0) *qslot = atomicAdd(do_attn ? qhead : qhead + 4, 1);
    __syncthreads();
    const int item = *qslot;
    if (do_attn) {
      if (item >= NB * AH * (S / 128)) { more_a = false; continue; }
      const int qb = item % (S / 128), h = (item / (S / 128)) % AH, b = item / ((S / 128) * AH);
      const float nsl2 = -exp2f(-(float)(h + 1)) * LOG2E;
      const size_t row0 = (size_t)b * S;
      at::attn_item(p.proj + (row0 + qb * 128) * PLD + N_Q + h * 128, p.proj + row0 * PLD + N_K + h * 128, p.proj + row0 * PLD + N_V + h * 128,
                    p.u + (row0 + qb * 128) * D + DSSD + h * 128, qb * 128, nsl2, lam, p.attn_norm_w, lds);
    } else {
      if (item >= CVT_ITEMS) { more_c = false; continue; }
      cvt_moe_item(p, item);
    }
  }
}
namespace sd {
using at::bf16x8; using at::s16x4; using at::f32x16; using at::u32x4; using at::crow; using at::cvtpk; using at::v_st; using at::v_rd_base; using at::v_rd_off; using at::tr_read;
constexpr int CH = 64, NCH = S / CH;
constexpr int L_BT = 0, L_CT = 16384, L_XV = 32768, L_TAB = 98304, L_SS = 106496;
constexpr size_t SNAP = 16384;
__device__ __forceinline__ size_t snap_off(int dir, int b, int h, int c) { return ((((size_t)dir * NB + b) * NH + h) * NCH + c) * SNAP; }

__device__ void ph_conv16(const Params& p) {
  constexpr int SEG = 16, NCG = CC / 8, NU = NCG * (T / SEG);
  for (int u = blockIdx.x * NT + threadIdx.x; u < NU; u += gridDim.x * NT) {
    const int cg = u % NCG, seg = u / NCG, t0 = seg * SEG, s0 = t0 % S, chan = cg * 8;
    float w[5][8], bias[8];
#pragma unroll
    for (int j = 0; j < 5; ++j) { const float4 a = *(const float4*)(p.conv_w + j * CC + chan), c = *(const float4*)(p.conv_w + j * CC + chan + 4);
      w[j][0] = a.x; w[j][1] = a.y; w[j][2] = a.z; w[j][3] = a.w; w[j][4] = c.x; w[j][5] = c.y; w[j][6] = c.z; w[j][7] = c.w; }
    { const float4 a = *(const float4*)(p.conv_b + chan), c = *(const float4*)(p.conv_b + chan + 4);
      bias[0] = a.x; bias[1] = a.y; bias[2] = a.z; bias[3] = a.w; bias[4] = c.x; bias[5] = c.y; bias[6] = c.z; bias[7] = c.w; }
    const bf16_t* base = p.proj + (size_t)t0 * PLD + N_XBC + chan;
    u32x4 rows[SEG + 4];
#pragma unroll
    for (int i = 0; i < SEG + 4; ++i) { const int s = s0 + i - 2; rows[i] = (u32x4){0u, 0u, 0u, 0u}; if (s >= 0 && s < S) rows[i] = *(const u32x4*)(base + (ptrdiff_t)(i - 2) * PLD); }
#pragma unroll
    for (int i = 0; i < SEG; ++i) {
      float o[8];
#pragma unroll
      for (int c = 0; c < 8; ++c) o[c] = bias[c];
#pragma unroll
      for (int j = 0; j < 5; ++j) { const u32x4 rr = rows[i + j];
        o[0] += w[j][0] * __uint_as_float(rr.x << 16); o[1] += w[j][1] * __uint_as_float(rr.x & 0xffff0000u);
        o[2] += w[j][2] * __uint_as_float(rr.y << 16); o[3] += w[j][3] * __uint_as_float(rr.y & 0xffff0000u);
        o[4] += w[j][4] * __uint_as_float(rr.z << 16); o[5] += w[j][5] * __uint_as_float(rr.z & 0xffff0000u);
        o[6] += w[j][6] * __uint_as_float(rr.w << 16); o[7] += w[j][7] * __uint_as_float(rr.w & 0xffff0000u); }
#pragma unroll
      for (int c = 0; c < 8; ++c) o[c] = o[c] * __builtin_amdgcn_rcpf(1.f + __expf(-o[c]));
      u32x4 pk; pk.x = cvtpk(o[0], o[1]); pk.y = cvtpk(o[2], o[3]); pk.z = cvtpk(o[4], o[5]); pk.w = cvtpk(o[6], o[7]);
      *(u32x4*)(p.xc16 + (size_t)(t0 + i) * CC + chan) = pk;
    }
  }
}
template <bool WITH_C, bool BV>
__device__ __forceinline__ void load_chunk(const Params& p, char* lds, int b, int g, int c0) {
  constexpr int NCG = WITH_C ? 96 : 80, NP = NCG * CH / NT;
  int tid = threadIdx.x; asm volatile("" : "+v"(tid));
  const bf16_t* src = p.xc16 + ((size_t)b * S + c0) * CC;
  u32x4 v[NP];
#pragma unroll
  for (int i = 0; i < NP; ++i) { const int idx = tid + NT * i, tok = idx / NCG, cg = idx % NCG;
    const int chan = cg < 64 ? g * 512 + cg * 8 : (cg < 80 ? 1024 + g * 128 + (cg - 64) * 8 : 1280 + g * 128 + (cg - 80) * 8);
    v[i] = *(const u32x4*)(src + (size_t)tok * CC + chan); }
#pragma unroll
  for (int i = 0; i < NP; ++i) { const int idx = tid + NT * i, tok = idx / NCG, cg = idx % NCG;
    if (cg < 64) { const int hl = cg >> 3, c = (hl & 1) * 64 + (cg & 7) * 8; *(u32x4*)(lds + L_XV + (hl >> 1) * 16384 + v_st(tok, c)) = v[i]; }
    else if (cg < 80) { const int n0 = (cg - 64) * 8; if (BV) *(u32x4*)(lds + L_BT + v_st(tok, n0)) = v[i]; else *(u32x4*)(lds + L_BT + AT_KSWZ(tok, n0 * 2)) = v[i]; }
    else { const int n0 = (cg - 80) * 8; *(u32x4*)(lds + L_CT + AT_KSWZ(tok, n0 * 2)) = v[i]; } }
}
__device__ __forceinline__ float wave_incl_prefix(float v, int lane) {
#pragma unroll
  for (int o = 1; o < 64; o <<= 1) { const float t = __int_as_float(__builtin_amdgcn_ds_bpermute(((lane - o) & 63) << 2, __float_as_int(v))); if (lane >= o) v += t; }
  return v;
}
__device__ __forceinline__ float wave_incl_suffix(float v, int lane) {
#pragma unroll
  for (int o = 1; o < 64; o <<= 1) { const float t = __int_as_float(__builtin_amdgcn_ds_bpermute(((lane + o) & 63) << 2, __float_as_int(v))); if (lane + o < 64) v += t; }
  return v;
}
__device__ __forceinline__ float wave_bcast(float v, int src) { return __int_as_float(__builtin_amdgcn_ds_bpermute(src << 2, __float_as_int(v))); }
__device__ __forceinline__ bf16x8 scale_frag(s16x4 lo, s16x4 hi, const float4 w0, const float4 w1) {
  const unsigned a = ((unsigned)(unsigned short)lo[0]) | ((unsigned)(unsigned short)lo[1] << 16), b = ((unsigned)(unsigned short)lo[2]) | ((unsigned)(unsigned short)lo[3] << 16);
  const unsigned c = ((unsigned)(unsigned short)hi[0]) | ((unsigned)(unsigned short)hi[1] << 16), d = ((unsigned)(unsigned short)hi[2]) | ((unsigned)(unsigned short)hi[3] << 16);
  u32x4 r;
  r.x = cvtpk(__uint_as_float(a << 16) * w0.x, __uint_as_float(a & 0xffff0000u) * w0.y);
  r.y = cvtpk(__uint_as_float(b << 16) * w0.z, __uint_as_float(b & 0xffff0000u) * w0.w);
  r.z = cvtpk(__uint_as_float(c << 16) * w1.x, __uint_as_float(c & 0xffff0000u) * w1.y);
  r.w = cvtpk(__uint_as_float(d << 16) * w1.z, __uint_as_float(d & 0xffff0000u) * w1.w);
  return *reinterpret_cast<bf16x8*>(&r);
}
#define SD_PK(L, H) (bf16x8){L[0], L[1], L[2], L[3], H[0], H[1], H[2], H[3]}

__device__ __forceinline__ void pass_a_item(const Params& p, char* lds, char* snap, int b, int g, int dir) {
  int tid = threadIdx.x; asm volatile("" : "+v"(tid));
  const int hl = tid >> 6, lane = tid & 63, r32 = lane & 31, hi = lane >> 5, h = g * 8 + hl;
  const float a = -__expf(dir ? p.a_log_b[h] : p.a_log_f[h]);
  float* wtab = (float*)(lds + L_TAB) + hl * 64;
  const int vbx = (int)(uintptr_t)(lds + L_XV + (hl >> 1) * 16384) + v_rd_base(lane) + (hl & 1) * 1024;
  const int vbb = (int)(uintptr_t)(lds + L_BT) + v_rd_base(lane);
  f32x16 st[4][2];
#pragma unroll
  for (int nb = 0; nb < 4; ++nb)
#pragma unroll
    for (int pb = 0; pb < 2; ++pb) st[nb][pb] = f32x16{};
  for (int ci = 0; ci < NCH; ++ci) {
    const int c = dir ? (NCH - 1 - ci) : ci, c0 = c * CH;
    __syncthreads();
    load_chunk<false, true>(p, lds, b, g, c0);
    const float dtv = p.dt[((size_t)b * S + c0 + lane) * 32 + dir * 16 + h];
    const float adt = a * dtv;
    const float cum = dir ? wave_incl_suffix(adt, lane) : wave_incl_prefix(adt, lane);
    const float total = wave_bcast(cum, dir ? 0 : 63);
    wtab[lane] = __expf(total - cum) * dtv;
    const float dec = __expf(total);
    { char* sp = snap + snap_off(dir, b, h, c);
#pragma unroll
      for (int nb = 0; nb < 4; ++nb)
#pragma unroll
        for (int pb = 0; pb < 2; ++pb)
#pragma unroll
          for (int q = 0; q < 4; ++q) { const f32x16& s = st[nb][pb];
            uint2 v; v.x = cvtpk(s[4 * q + 0], s[4 * q + 1]); v.y = cvtpk(s[4 * q + 2], s[4 * q + 3]);
            *(uint2*)(sp + ((((pb * 8 + nb * 2 + (q >> 1)) * 2 + (q & 1)) * 32 + r32) * 16 + hi * 8)) = v; } }
#pragma unroll
    for (int nb = 0; nb < 4; ++nb)
#pragma unroll
      for (int pb = 0; pb < 2; ++pb)
#pragma unroll
        for (int r = 0; r < 16; ++r) st[nb][pb][r] *= dec;
    __syncthreads();
#pragma unroll
    for (int ks = 0; ks < 4; ++ks) {
      const float4 w0 = *(const float4*)(wtab + ks * 16 + hi * 8), w1 = *(const float4*)(wtab + ks * 16 + hi * 8 + 4);
      bf16x8 xf[2];
      { const s16x4 l0 = tr_read<v_rd_off(0, 0, 0)>(vbx + ks * 4096), h0 = tr_read<v_rd_off(0, 0, 1)>(vbx + ks * 4096), l1 = tr_read<v_rd_off(1, 0, 0)>(vbx + ks * 4096), h1 = tr_read<v_rd_off(1, 0, 1)>(vbx + ks * 4096);
        asm volatile("s_waitcnt lgkmcnt(0)" ::: "memory"); AT_SBAR();
        xf[0] = scale_frag(l0, h0, w0, w1); xf[1] = scale_frag(l1, h1, w0, w1); }
#pragma unroll
      for (int nb = 0; nb < 4; ++nb) {
        s16x4 bl, bh;
        asm volatile("ds_read_b64_tr_b16 %0, %1" : "=&v"(bl) : "v"(vbb + nb * 512 + ks * 4096) : "memory");
        asm volatile("ds_read_b64_tr_b16 %0, %1 offset:2048" : "=&v"(bh) : "v"(vbb + nb * 512 + ks * 4096) : "memory");
        asm volatile("s_waitcnt lgkmcnt(0)" ::: "memory"); AT_SBAR();
        const bf16x8 bfr = SD_PK(bl, bh);
        st[nb][0] = __builtin_amdgcn_mfma_f32_32x32x16_bf16(bfr, xf[0], st[nb][0], 0, 0, 0);
        st[nb][1] = __builtin_amdgcn_mfma_f32_32x32x16_bf16(bfr, xf[1], st[nb][1], 0, 0, 0);
      }
    }
  }
  __syncthreads();
}

__device__ __forceinline__ void pass_b_item(const Params& p, char* lds, const char* snap, int b, int g, int c) {
  int tid = threadIdx.x; asm volatile("" : "+v"(tid));
  const int hl = tid >> 6, lane = tid & 63, r32 = lane & 31, hi = lane >> 5, h = g * 8 + hl, c0 = c * CH;
  float4* tab = (float4*)(lds + L_TAB) + hl * 64;
  float* ssp = (float*)(lds + L_SS);
  const int vbx = (int)(uintptr_t)(lds + L_XV + (hl >> 1) * 16384) + v_rd_base(lane) + (hl & 1) * 1024;
  __syncthreads();
  load_chunk<true, false>(p, lds, b, g, c0);
  { const size_t tok = (size_t)b * S + c0 + lane;
    const float dtf = p.dt[tok * 32 + h], dtb = p.dt[tok * 32 + 16 + h];
    const float af = -__expf(p.a_log_f[h]) * dtf, ab = -__expf(p.a_log_b[h]) * dtb;
    tab[lane] = make_float4(wave_incl_prefix(af, lane) * LOG2E, wave_incl_suffix(ab, lane) * LOG2E, dtf, dtb); }
  __syncthreads();
  const float dsk = p.d_skip[h];
  f32x16 o[2][2];
#pragma unroll
  for (int lb = 0; lb < 2; ++lb) {
    const int l = lb * 32 + r32;
    const float4 tl = tab[l];
    bf16x8 cr[8];
#pragma unroll
    for (int kk = 0; kk < 8; ++kk) cr[kk] = *reinterpret_cast<const bf16x8*>(lds + L_CT + AT_KSWZ(l, (kk * 16 + hi * 8) * 2));
    f32x16 p0 = f32x16{}, p1 = f32x16{};
#pragma unroll
    for (int kk = 0; kk < 8; ++kk) { const int cb = (kk * 16 + hi * 8) * 2;
      const bf16x8 b0 = *reinterpret_cast<const bf16x8*>(lds + L_BT + AT_KSWZ(r32, cb));
      const bf16x8 b1 = *reinterpret_cast<const bf16x8*>(lds + L_BT + AT_KSWZ(32 + r32, cb));
      p0 = __builtin_amdgcn_mfma_f32_32x32x16_bf16(b0, cr[kk], p0, 0, 0, 0);
      p1 = __builtin_amdgcn_mfma_f32_32x32x16_bf16(b1, cr[kk], p1, 0, 0, 0); }
#pragma unroll
    for (int r = 0; r < 16; ++r) {
#pragma unroll
      for (int half = 0; half < 2; ++half) {
        const int s = crow(r, hi) + 32 * half; const float4 ts = tab[s];
        float m = 0.f;
        if (s <= l) m += __builtin_amdgcn_exp2f(tl.x - ts.x) * ts.z;
        if (s >= l) m += __builtin_amdgcn_exp2f(tl.y - ts.y) * ts.w;
        const float add = (s == l) ? dsk : 0.f;
        if (half) p1[r] = p1[r] * m + add; else p0[r] = p0[r] * m + add;
      }
      asm volatile("" ::: "memory");
    }
    bf16x8 pa0, pa1, pa2, pa3;
#define SD_PK4(P, BASE, OUT) do { unsigned a0 = cvtpk(P[BASE + 0], P[BASE + 1]), a1 = cvtpk(P[BASE + 2], P[BASE + 3]);   \
    unsigned b0_ = cvtpk(P[BASE + 4], P[BASE + 5]), b1_ = cvtpk(P[BASE + 6], P[BASE + 7]);                              \
    auto r0 = __builtin_amdgcn_permlane32_swap(a0, b0_, false, false); auto r1 = __builtin_amdgcn_permlane32_swap(a1, b1_, false, false); \
    u32x4 w_ = {r0[0], r1[0], r0[1], r1[1]}; OUT = *reinterpret_cast<bf16x8*>(&w_); } while (0)
    SD_PK4(p0, 0, pa0); SD_PK4(p0, 8, pa1); SD_PK4(p1, 0, pa2); SD_PK4(p1, 8, pa3);
#undef SD_PK4
#pragma unroll
    for (int d = 0; d < 2; ++d) {
      const s16x4 l0 = d ? tr_read<v_rd_off(1, 0, 0)>(vbx) : tr_read<v_rd_off(0, 0, 0)>(vbx), h0 = d ? tr_read<v_rd_off(1, 0, 1)>(vbx) : tr_read<v_rd_off(0, 0, 1)>(vbx);
      const s16x4 l1 = d ? tr_read<v_rd_off(1, 1, 0)>(vbx) : tr_read<v_rd_off(0, 1, 0)>(vbx), h1 = d ? tr_read<v_rd_off(1, 1, 1)>(vbx) : tr_read<v_rd_off(0, 1, 1)>(vbx);
      const s16x4 l2 = d ? tr_read<v_rd_off(1, 2, 0)>(vbx) : tr_read<v_rd_off(0, 2, 0)>(vbx), h2 = d ? tr_read<v_rd_off(1, 2, 1)>(vbx) : tr_read<v_rd_off(0, 2, 1)>(vbx);
      const s16x4 l3 = d ? tr_read<v_rd_off(1, 3, 0)>(vbx) : tr_read<v_rd_off(0, 3, 0)>(vbx), h3 = d ? tr_read<v_rd_off(1, 3, 1)>(vbx) : tr_read<v_rd_off(0, 3, 1)>(vbx);
      asm volatile("s_waitcnt lgkmcnt(0)" ::: "memory"); AT_SBAR();
      f32x16 od = f32x16{};
      od = __builtin_amdgcn_mfma_f32_32x32x16_bf16(pa0, SD_PK(l0, h0), od, 0, 0, 0);
      od = __builtin_amdgcn_mfma_f32_32x32x16_bf16(pa1, SD_PK(l1, h1), od, 0, 0, 0);
      od = __builtin_amdgcn_mfma_f32_32x32x16_bf16(pa2, SD_PK(l2, h2), od, 0, 0, 0);
      od = __builtin_amdgcn_mfma_f32_32x32x16_bf16(pa3, SD_PK(l3, h3), od, 0, 0, 0);
      o[lb][d] = od;
    }
  }
#pragma unroll
  for (int dir = 0; dir < 2; ++dir) {
    if (dir == 0 ? (c == 0) : (c == NCH - 1)) continue;
    const char* sp = snap + snap_off(dir, b, h, c);
#pragma unroll
    for (int d = 0; d < 2; ++d) {
      bf16x8 sf[8];
#pragma unroll
      for (int kk = 0; kk < 8; ++kk) sf[kk] = *reinterpret_cast<const bf16x8*>(sp + ((((d * 8 + kk) * 2 + hi) * 32 + r32) * 16));
#pragma unroll
      for (int lb = 0; lb < 2; ++lb) {
        f32x16 acc = f32x16{};
#pragma unroll
        for (int kk = 0; kk < 8; ++kk) { const bf16x8 cf = *reinterpret_cast<const bf16x8*>(lds + L_CT + AT_KSWZ(lb * 32 + r32, (kk * 16 + hi * 8) * 2));
          acc = __builtin_amdgcn_mfma_f32_32x32x16_bf16(cf, sf[kk], acc, 0, 0, 0); }
#pragma unroll
        for (int r = 0; r < 16; ++r) { const float4 tr = tab[lb * 32 + crow(r, hi)]; o[lb][d][r] += __builtin_amdgcn_exp2f(dir ? tr.y : tr.x) * acc[r]; }
      }
      asm volatile("" ::: "memory");
    }
  }
  asm volatile("" ::: "memory");
  const bf16_t* zp = p.proj + ((size_t)b * S + c0) * PLD + N_Z + h * HD + r32;
#pragma unroll
  for (int lb = 0; lb < 2; ++lb)
#pragma unroll
    for (int r = 0; r < 16; ++r) { const int l = lb * 32 + crow(r, hi); float ss = 0.f;
#pragma unroll
      for (int d = 0; d < 2; ++d) { const float z = bf2f(zp[(size_t)l * PLD + d * 32]); const float y = o[lb][d][r] * z * __builtin_amdgcn_rcpf(1.f + __expf(-z)); o[lb][d][r] = y; ss += y * y; }
      ss += __shfl_xor(ss, 16); ss += __shfl_xor(ss, 8); ss += __shfl_xor(ss, 4); ss += __shfl_xor(ss, 2); ss += __shfl_xor(ss, 1);
      if (r32 == 0) ssp[hl * 64 + l] = ss;
      if ((r & 3) == 3) asm volatile("" ::: "memory"); }
  __syncthreads();
  const float nw0 = p.ssd_norm_w[h * HD + r32], nw1 = p.ssd_norm_w[h * HD + 32 + r32];
  bf16_t* up = p.u + ((size_t)b * S + c0) * D + h * HD + r32;
#pragma unroll
  for (int lb = 0; lb < 2; ++lb)
#pragma unroll
    for (int r = 0; r < 16; ++r) { const int l = lb * 32 + crow(r, hi); float ss = 0.f;
#pragma unroll
      for (int q = 0; q < 8; ++q) ss += ssp[q * 64 + l];
      const float rstd = rsqrtf(ss * (1.f / 512.f) + 1e-5f);
      up[(size_t)l * D] = f2bf(o[lb][0][r] * rstd * nw0); up[(size_t)l * D + 32] = f2bf(o[lb][1][r] * rstd * nw1); }
}
}

__device__ void ph_ssd_a(const Params& p, char* lds, char* snap) {
  for (int item = blockIdx.x; item < NB * 2 * 2; item += gridDim.x) { const int dir = item & 1, g = (item >> 1) & 1, b = item >> 2; sd::pass_a_item(p, lds, snap, b, g, dir); }
}
__device__ void ph_ssd_b(const Params& p, char* lds, const char* snap) {
  for (int item = blockIdx.x; item < NB * 2 * sd::NCH; item += gridDim.x) { const int c = item % sd::NCH, g = (item / sd::NCH) & 1, b = item / (2 * sd::NCH); sd::pass_b_item(p, lds, snap, b, g, c); }
}
__device__ void ph_inproj(const Params& p, LAS unsigned char* lds) {
  pg8::Gemm g{p.xb, p.WinT, D, 0, 0}; pg8::OrderStatic Sd; Sd.init(T, NPROJ, gridDim.x, blockIdx.x);
  EpiProj E{p.proj, p.dt, p.dt_bias_f, p.dt_bias_b};
  pg8::gemm_phase<false, false>(lds, g, Sd, E);
}
__device__ void ph_outproj(const Params& p, LAS unsigned char* lds) {
  pg8::Gemm g{p.u, p.WoutT, D, 0, 0}; pg8::OrderStatic Sd; Sd.init(T, D, gridDim.x, blockIdx.x);
  EpiOut E{p.x, p.h1};
  pg8::gemm_phase<false, false>(lds, g, Sd, E);
}
__device__ __forceinline__ int ld_agent(const int* p) { return __hip_atomic_load(p, __ATOMIC_RELAXED, __HIP_MEMORY_SCOPE_AGENT); }
__device__ __forceinline__ float ld_agent(const float* p) { return __hip_atomic_load(p, __ATOMIC_RELAXED, __HIP_MEMORY_SCOPE_AGENT); }
__device__ void ph_ln_route(const Params& p, char* ldsg, LAS unsigned char* lds) {
  typedef short bf16x8 __attribute__((ext_vector_type(8)));
  LAS int* cntl = (LAS int*)lds;
  int tid = threadIdx.x; asm volatile("" : "+v"(tid));
  const int lane = tid & 63, wv = tid >> 6;
  float* lg = (float*)(ldsg + 1024) + wv * 512;
  float gm[32], bt[32];
#pragma unroll
  for (int g = 0; g < 4; ++g) { const f32x4 a = *(const f32x4*)(p.ln1_g + g * 512 + lane * 8), b = *(const f32x4*)(p.ln1_g + g * 512 + lane * 8 + 4);
    const f32x4 c = *(const f32x4*)(p.ln1_b + g * 512 + lane * 8), d = *(const f32x4*)(p.ln1_b + g * 512 + lane * 8 + 4);
#pragma unroll
    for (int j = 0; j < 4; ++j) { gm[g * 8 + j] = a[j]; gm[g * 8 + 4 + j] = b[j]; bt[g * 8 + j] = c[j]; bt[g * 8 + 4 + j] = d[j]; } }
  const float rbias = p.router_bias[lane];
  for (int tb = blockIdx.x; tb < T / 64; tb += gridDim.x) {
    __syncthreads();
    if (tid < NE) cntl[tid] = 0;
    const int t0 = tb * 64 + wv * 8;
    for (int i = 0; i < 8; ++i) {
      const float* vp = p.h1 + (size_t)(t0 + i) * D; float v[32]; float s = 0.f;
#pragma unroll
      for (int g = 0; g < 4; ++g) { const f32x4 a = *(const f32x4*)(vp + g * 512 + lane * 8), b = *(const f32x4*)(vp + g * 512 + lane * 8 + 4);
#pragma unroll
        for (int j = 0; j < 4; ++j) { v[g * 8 + j] = a[j]; v[g * 8 + 4 + j] = b[j]; s += a[j] + b[j]; } }
      const float mu = wave_sum(s) * (1.f / D); float q = 0.f;
#pragma unroll
      for (int j = 0; j < 32; ++j) { const float d = v[j] - mu; q += d * d; }
      const float rstd = rsqrtf(wave_sum(q) * (1.f / D) + 1e-5f);
#pragma unroll
      for (int g = 0; g < 4; ++g) { float o[8];
#pragma unroll
        for (int j = 0; j < 8; ++j) o[j] = (v[g * 8 + j] - mu) * rstd * gm[g * 8 + j] + bt[g * 8 + j];
        u32x4 w; w.x = cvt_pk_bf16(o[0], o[1]); w.y = cvt_pk_bf16(o[2], o[3]); w.z = cvt_pk_bf16(o[4], o[5]); w.w = cvt_pk_bf16(o[6], o[7]);
        *(u32x4*)(p.h1b + (size_t)(t0 + i) * D + g * 512 + lane * 8) = w;
        uint2 w8; { int a = 0, b = 0; a = __builtin_amdgcn_cvt_pk_fp8_f32(o[0], o[1], a, false); a = __builtin_amdgcn_cvt_pk_fp8_f32(o[2], o[3], a, true); b = __builtin_amdgcn_cvt_pk_fp8_f32(o[4], o[5], b, false); b = __builtin_amdgcn_cvt_pk_fp8_f32(o[6], o[7], b, true); w8.x = (unsigned)a; w8.y = (unsigned)b; }
        *(uint2*)(p.h1q + (size_t)(t0 + i) * D + g * 512 + lane * 8) = w8; }
    }
    __threadfence_block(); asm volatile("s_waitcnt vmcnt(0)" ::: "memory");
    f32x4 acc[4];
#pragma unroll
    for (int nb = 0; nb < 4; ++nb) acc[nb] = (f32x4){0.f, 0.f, 0.f, 0.f};
    const bf16_t* ap = p.h1b + (size_t)(t0 + (lane & 7)) * D + 8 * (lane >> 4);
    const bf16_t* bp = p.WrT + (size_t)(lane & 15) * D + 8 * (lane >> 4);
#pragma unroll 4
    for (int kk = 0; kk < D / 32; ++kk) {
      const bf16x8 a = *(const bf16x8*)(ap + kk * 32);
#pragma unroll
      for (int nb = 0; nb < 4; ++nb) { const bf16x8 b = *(const bf16x8*)(bp + (size_t)nb * 16 * D + kk * 32); acc[nb] = __builtin_amdgcn_mfma_f32_16x16x32_bf16(a, b, acc[nb], 0, 0, 0); }
    }
    if ((lane >> 4) < 2) {
#pragma unroll
      for (int nb = 0; nb < 4; ++nb)
#pragma unroll
        for (int i = 0; i < 4; ++i) lg[(4 * (lane >> 4) + i) * 64 + nb * 16 + (lane & 15)] = acc[nb][i];
    }
    __syncthreads();
    for (int ti = 0; ti < 8; ++ti) {
      const int t = t0 + ti;
      const float sc = 1.f / (1.f + __expf(-lg[ti * 64 + lane]));
      const float bz = sc + rbias;
      int rk = 0;
#pragma unroll
      for (int j = 1; j < 8; ++j) { const float o = __shfl_xor(bz, j); const int oi = lane ^ j; rk += (o > bz || (o == bz && oi < lane)) ? 1 : 0; }
      float gs = rk < 2 ? bz : 0.f;
      gs += __shfl_xor(gs, 1); gs += __shfl_xor(gs, 2); gs += __shfl_xor(gs, 4);
      const int g = lane >> 3; int grk = 0;
#pragma unroll
      for (int j = 1; j < 8; ++j) { const float o = __shfl_xor(gs, j * 8); const int og = g ^ j; grk += (o > gs || (o == gs && og < g)) ? 1 : 0; }
      const bool gsel = grk < 4;
      const float mb = gsel ? bz : -INFINITY;
      int erk = 0;
      for (int j = 1; j < 64; ++j) { const float o = __shfl_xor(mb, j); const int oi = lane ^ j; erk += (o > mb || (o == mb && oi < lane)) ? 1 : 0; }
      const bool sel = gsel && erk < 8;
      const float gsum = wave_sum(sel ? sc : 0.f);
      if (sel) {
        const int lr = __hip_atomic_fetch_add(&cntl[lane], 1, __ATOMIC_RELAXED, __HIP_MEMORY_SCOPE_WORKGROUP);
        p.assign[t * 8 + erk] = lane | (lr << 8); p.gate[t * 8 + erk] = sc / gsum * 2.5f;
      }
    }
    __syncthreads();
    if (tid < NE) p.blkcnt[tb * NE + tid] = cntl[tid];
  }
}
__device__ void ph_place(const Params& p, LAS unsigned char* lds) {
  LAS int* part = (LAS int*)lds;
  LAS int* parta = part + 512;
  LAS int* base = parta + 512;
  LAS int* total = base + 64;
  LAS int* pstart = total + 64;
  const int tid = threadIdx.x, e = tid & 63, pt = tid >> 6;
  for (int tb = blockIdx.x; tb < T / 64; tb += gridDim.x) {
    __syncthreads();
    int slo = 0, sall = 0;
    for (int b = pt * 32; b < pt * 32 + 32; ++b) { const int c = ld_agent(p.blkcnt + b * NE + e); sall += c; slo += (b < tb) ? c : 0; }
    part[pt * 64 + e] = slo; parta[pt * 64 + e] = sall;
    __syncthreads();
    if (tid < 64) {
      int b0 = 0, t0 = 0;
#pragma unroll
      for (int q = 0; q < 8; ++q) { b0 += part[q * 64 + tid]; t0 += parta[q * 64 + tid]; }
      base[tid] = b0; total[tid] = t0;
      const int padded = (t0 + 255) & ~255;
      int incl = padded;
      for (int o = 1; o < 64; o <<= 1) { const int v = __shfl_up(incl, o); if (tid >= o) incl += v; }
      pstart[tid] = incl - padded;
      if (tid == 63) pstart[64] = incl;
    }
    __syncthreads();
    {
      const int t = tb * 64 + (tid >> 3), k = tid & 7;
      const int a = ld_agent(p.assign + t * 8 + k), ee = a & 255, lr = a >> 8;
      const int row = pstart[ee] + base[ee] + lr;
      p.row_tok[row] = t; p.row_gate[row] = ld_agent(p.gate + t * 8 + k); p.pos[t * 8 + k] = row;
      if (tid < 64) { const int srow = pstart[64] + tb * 64 + tid; p.row_tok[srow] = tb * 64 + tid; p.row_gate[srow] = 1.0f; }
    }
    if (tb == blockIdx.x) {
      for (int e2 = blockIdx.x; e2 < NE; e2 += gridDim.x) {
        const int r0 = pstart[e2] + total[e2], r1 = pstart[e2 + 1];
        for (int r = r0 + tid; r < r1; r += NT) { p.row_tok[r] = 0; p.row_gate[r] = 0.f; }
        for (int j = pstart[e2] / 256 + tid; j < r1 / 256; j += NT) p.tile_exp[j] = e2;
      }
      if (blockIdx.x == 0) {
        const int nr = pstart[64] / 256;
        for (int j = tid; j < T / 256; j += NT) p.tile_exp[nr + j] = NE;
        if (tid == 0) { p.meta[0] = nr; p.meta[1] = nr + T / 256; }
      }
    }
  }
}
struct OrderMoE {
  LAS const int* ulist; int n;
  LAS const unsigned* tab; int tstride;
  __device__ __forceinline__ bool next(int i, pg8::Unit& u) const { if (i >= n) return false; u.pm = ulist[i * 4 + 0]; u.pn = ulist[i * 4 + 1]; u.bn = ulist[i * 4 + 2]; u.aux = i; return true; }
  __device__ __forceinline__ unsigned row_off(int i, int row) const { return tab[i * tstride + row]; }
};
template <int TABLES>
__device__ __forceinline__ OrderMoE moe_order(const Params& p, LAS unsigned char* lds, int npn, int tile0, int ntiles, int rowbytes) {
  LAS int* ulist = (LAS int*)(lds + LDS_TAB); LAS unsigned* tab = (LAS unsigned*)(lds + LDS_TAB + 1024);
  const int G = gridDim.x, c = blockIdx.x, mpc = 32 / npn; int n = 0;
  __syncthreads();
  for (int i = 0; i < 60; ++i) {
    int U; if (G == 256) U = ((i * 8 + (c & 7)) * 32 + (c >> 3)); else U = i * G + c;
    const int chunk = U >> 5, w = U & 31, j = chunk * mpc + (w % mpc), pn = w / mpc;
    if (j >= ntiles) break;
    const int tile = tile0 + j, e = ld_agent(p.tile_exp + tile);
    if (threadIdx.x == 0) { ulist[i * 4 + 0] = tile; ulist[i * 4 + 1] = pn; ulist[i * 4 + 2] = e * npn + pn; ulist[i * 4 + 3] = e; }
    if (TABLES == 2) { for (int r = threadIdx.x; r < 256; r += NT) tab[i * 256 + r] = (unsigned)(tile * 256 + r) * (unsigned)rowbytes; }
    if (TABLES == 1) { for (int r = threadIdx.x; r < 256; r += NT) { tab[i * 512 + r] = (unsigned)ld_agent(p.row_tok + tile * 256 + r) * (unsigned)rowbytes; tab[i * 512 + 256 + r] = __float_as_uint(ld_agent(p.row_gate + tile * 256 + r)); } }
    n = i + 1;
  }
  __syncthreads();
  return OrderMoE{ulist, n, tab, TABLES == 2 ? 256 : 512};
}
struct EpiGU {
  static constexpr bool PERM = true;
  unsigned char* H; LAS const unsigned* tab;
  __device__ __forceinline__ void operator()(const f32x4 (&acc)[2][2][4][2], const pg8::Unit& u, int wr, int wc, int fr, int fq) const {
    asm volatile("" : "+v"(fr), "+v"(fq));
    const int col0 = u.pn * 128 + wc * 32 + 8 * fq;
#pragma unroll
    for (int ai = 0; ai < 2; ++ai)
#pragma unroll
      for (int m = 0; m < 4; ++m) { const int r = ai * 128 + wr * 64 + m * 16 + fr; const float gt = __uint_as_float(tab[u.aux * 512 + 256 + r]) * H8S;
        float h[8];
#pragma unroll
        for (int j = 0; j < 4; ++j) { const float g0 = acc[ai][0][m][0][j], g1 = acc[ai][0][m][1][j];
          h[j] = g0 * __builtin_amdgcn_rcpf(1.f + __expf(-g0)) * acc[ai][1][m][0][j] * gt; h[4 + j] = g1 * __builtin_amdgcn_rcpf(1.f + __expf(-g1)) * acc[ai][1][m][1][j] * gt; }
#pragma unroll
        for (int j = 0; j < 8; ++j) h[j] = fminf(fmaxf(h[j], -448.f), 448.f);
        uint2 w; { int a = 0, b = 0; a = __builtin_amdgcn_cvt_pk_fp8_f32(h[0], h[1], a, false); a = __builtin_amdgcn_cvt_pk_fp8_f32(h[2], h[3], a, true); b = __builtin_amdgcn_cvt_pk_fp8_f32(h[4], h[5], b, false); b = __builtin_amdgcn_cvt_pk_fp8_f32(h[6], h[7], b, true); w.x = (unsigned)a; w.y = (unsigned)b; }
        *(uint2*)(H + (size_t)(u.pm * 256 + r) * DE + col0) = w; }
  }
};
__device__ void ph_gateup(const Params& p, LAS unsigned char* lds) {
  const int ntot = ld_agent(p.meta + 1);
  const OrderMoE S = moe_order<1>(p, lds, 4, 0, ntot, D);
  pg8::Gemm g{(const bf16_t*)p.h1q, p.WguT, D / 2, 0x7a7a7a7a  , 0x7f7f7f7f}; EpiGU E{(unsigned char*)p.H, S.tab};
  pg8::gemm_phase<true, true>(lds, g, S, E);
}
struct EpiDown {
  static constexpr bool PERM = true;
  bf16_t* Y;
  __device__ __forceinline__ void operator()(const f32x4 (&acc)[2][2][4][2], const pg8::Unit& u, int wr, int wc, int fr, int fq) const {
    asm volatile("" : "+v"(fr), "+v"(fq));
    const int col0 = u.pn * 256 + wc * 32 + 8 * fq;
#pragma unroll
    for (int ai = 0; ai < 2; ++ai)
#pragma unroll
      for (int m = 0; m < 4; ++m) { bf16_t* rowp = Y + (size_t)(u.pm * 256 + ai * 128 + wr * 64 + m * 16 + fr) * D + col0;
#pragma unroll
        for (int bj = 0; bj < 2; ++bj) { const f32x4 v0 = acc[ai][bj][m][0], v1 = acc[ai][bj][m][1];
          u32x4 w; w.x = cvt_pk_bf16(v0[0], v0[1]); w.y = cvt_pk_bf16(v0[2], v0[3]); w.z = cvt_pk_bf16(v1[0], v1[1]); w.w = cvt_pk_bf16(v1[2], v1[3]);
          *(u32x4*)(rowp + bj * 128) = w; } }
  }
};
__device__ void ph_down(const Params& p, LAS unsigned char* lds) {
  const int ntot = ld_agent(p.meta + 1);
  const OrderMoE S = moe_order<2>(p, lds, 8, 0, ntot, DE);
  pg8::Gemm g{p.H, p.WdT, DE / 2, 0x7a7a7a7a  , 0x7c7c7c7c  }; EpiDown E{p.Y};
  pg8::gemm_phase<true, true>(lds, g, S, E);
}
__device__ void ph_combine(const Params& p) {
  const int lane = threadIdx.x & 63, wv = threadIdx.x >> 6;
  const int srow0 = ld_agent(p.meta + 0) * 256;
  for (int row = blockIdx.x * 8 + wv; row < T; row += gridDim.x * 8) {
    float v[32];
    float* op = p.out + (size_t)row * D;
    { const bf16_t* hp = p.h1b + (size_t)row * D; const bf16_t* sp = p.Y + (size_t)(srow0 + row) * D;
#pragma unroll
      for (int g = 0; g < 4; ++g) { const u32x4 hb = *(const u32x4*)(hp + g * 512 + lane * 8), sb = *(const u32x4*)(sp + g * 512 + lane * 8);
        v[g * 8 + 0] = ALPHA * __uint_as_float(hb.x << 16) + __uint_as_float(sb.x << 16); v[g * 8 + 1] = ALPHA * __uint_as_float(hb.x & 0xffff0000u) + __uint_as_float(sb.x & 0xffff0000u);
        v[g * 8 + 2] = ALPHA * __uint_as_float(hb.y << 16) + __uint_as_float(sb.y << 16); v[g * 8 + 3] = ALPHA * __uint_as_float(hb.y & 0xffff0000u) + __uint_as_float(sb.y & 0xffff0000u);
        v[g * 8 + 4] = ALPHA * __uint_as_float(hb.z << 16) + __uint_as_float(sb.z << 16); v[g * 8 + 5] = ALPHA * __uint_as_float(hb.z & 0xffff0000u) + __uint_as_float(sb.z & 0xffff0000u);
        v[g * 8 + 6] = ALPHA * __uint_as_float(hb.w << 16) + __uint_as_float(sb.w << 16); v[g * 8 + 7] = ALPHA * __uint_as_float(hb.w & 0xffff0000u) + __uint_as_float(sb.w & 0xffff0000u); } }
    for (int k = 0; k < 8; ++k) {
      const int yr = ld_agent(p.pos + row * 8 + k); const bf16_t* yp = p.Y + (size_t)yr * D;
#pragma unroll
      for (int g = 0; g < 4; ++g) { const u32x4 hb = *(const u32x4*)(yp + g * 512 + lane * 8);
        v[g * 8 + 0] += __uint_as_float(hb.x << 16); v[g * 8 + 1] += __uint_as_float(hb.x & 0xffff0000u); v[g * 8 + 2] += __uint_as_float(hb.y << 16); v[g * 8 + 3] += __uint_as_float(hb.y & 0xffff0000u);
        v[g * 8 + 4] += __uint_as_float(hb.z << 16); v[g * 8 + 5] += __uint_as_float(hb.z & 0xffff0000u); v[g * 8 + 6] += __uint_as_float(hb.w << 16); v[g * 8 + 7] += __uint_as_float(hb.w & 0xffff0000u); }
    }
    float s = 0.f;
#pragma unroll
    for (int j = 0; j < 32; ++j) s += v[j];
    const float mu = wave_sum(s) * (1.f / D); float q = 0.f;
#pragma unroll
    for (int j = 0; j < 32; ++j) { const float d = v[j] - mu; q += d * d; }
    const float rstd = rsqrtf(wave_sum(q) * (1.f / D) + 1e-5f);
#pragma unroll
    for (int g = 0; g < 4; ++g) { const int c0 = g * 512 + lane * 8; f32x4 a, b;
#pragma unroll
      for (int j = 0; j < 4; ++j) { a[j] = (v[g * 8 + j] - mu) * rstd * p.ln2_g[c0 + j] + p.ln2_b[c0 + j]; b[j] = (v[g * 8 + 4 + j] - mu) * rstd * p.ln2_g[c0 + 4 + j] + p.ln2_b[c0 + 4 + j]; }
      *(f32x4*)(op + c0) = a; *(f32x4*)(op + c0 + 4) = b; }
  }
}

__global__ void __launch_bounds__(NT) k_mega(Params p_arg) {
#if defined(__HIP_DEVICE_COMPILE__)
  extern __shared__ __attribute__((aligned(16))) unsigned char lds_raw[];
  LAS unsigned char* lds = (LAS unsigned char*)lds_raw;
  float* smem = (float*)lds_raw;
#ifndef ONLY
#define ONLY -1
#endif
  typedef const __attribute__((address_space(4))) Params* KP;
  const KP pk = (KP)__builtin_amdgcn_kernarg_segment_ptr();
  volatile LAS unsigned* bst = (volatile LAS unsigned*)(lds + LDS_BYTES - 16);
  if (threadIdx.x == 0) { bst[0] = 0u; bst[1] = 0u; }
  __syncthreads();
  XcdBarrier gbar;
  { KP q_ = pk; asm volatile("" : "+s"(q_)); gbar = xcd_barrier_post(q_->bar, bst); }
#define GSYNC() xcd_barrier(gbar)
#ifndef DUP
#define DUP -1
#endif
#define RUN1(n, pass, call) do { if (ONLY < 0 || ONLY == n) { KP q_ = pk; asm volatile("" : "+s"(q_)); const Params p = *q_; const int dup_pass = pass; (void)dup_pass; call; } } while (0)
#define RUN(n, call) do { RUN1(n, 0, call); if (DUP == n) { GSYNC(); RUN1(n, 1, call); } } while (0)
  RUN(0, ph_convert(p)); GSYNC();
  RUN(1, ph_inproj(p, lds)); GSYNC();
  RUN(2, sd::ph_conv16(p)); GSYNC();
  RUN(3, ph_ssd_a(p, (char*)lds_raw, (char*)p.out)); RUN(4, ph_attn_mfma(p, (char*)lds_raw, p.meta + 8 + dup_pass)); GSYNC();
  RUN(5, ph_ssd_b(p, (char*)lds_raw, (const char*)p.out)); GSYNC();
  RUN(6, ph_outproj(p, lds)); GSYNC();
  RUN(7, ph_ln_route(p, (char*)lds_raw, lds)); GSYNC();
  RUN(10, ph_place(p, lds)); GSYNC();
  RUN(11, ph_gateup(p, lds)); GSYNC();
  RUN(12, ph_down(p, lds)); GSYNC();
  RUN(13, ph_combine(p));
#endif
}
}

extern "C" void kernel_launch(void* const* d_in, const int* in_sizes, int n_in, void* d_out, int out_size, void* d_ws, size_t ws_size, hipStream_t stream) {
  Params p{};
  const float* const* in = (const float* const*)d_in;
  p.x = in[0]; p.w_in = in[1]; p.conv_w = in[2]; p.conv_b = in[3]; p.dt_bias_f = in[4]; p.dt_bias_b = in[5]; p.a_log_f = in[6]; p.a_log_b = in[7];
  p.d_skip = in[8]; p.ssd_norm_w = in[9]; p.lq1 = in[10]; p.lk1 = in[11]; p.lq2 = in[12]; p.lk2 = in[13]; p.attn_norm_w = in[14]; p.w_out = in[15];
  p.ln1_g = in[16]; p.ln1_b = in[17]; p.w_router = in[18]; p.router_bias = in[19]; p.wg_e = in[20]; p.wu_e = in[21]; p.wd_e = in[22];
  p.wg_s = in[23]; p.wu_s = in[24]; p.wd_s = in[25]; p.ln2_g = in[26]; p.ln2_b = in[27];
  p.out = (float*)d_out;
  char* w = (char*)d_ws; size_t o = 0;
  auto take = [&](size_t bytes) { char* r = w + o; o += (bytes + 255) / 256 * 256; return r; };
  char* reg1 = w + o;
  p.xb = (bf16_t*)take((size_t)T * D * 2); p.WinT = (bf16_t*)take((size_t)NPROJ * D * 2); p.WoutT = (bf16_t*)take((size_t)D * D * 2);
  p.WguT = (bf16_t*)take((size_t)(NE + 1) * 1024 * D); p.proj = (bf16_t*)take((size_t)T * PLD * 2); p.u = (bf16_t*)take((size_t)T * D * 2);
  if ((size_t)((w + o) - reg1) < (size_t)MAXROWS * D * 2) take((size_t)MAXROWS * D * 2 - (size_t)((w + o) - reg1));
  const size_t reg1_bytes = (size_t)((w + o) - reg1);
  p.Y = (bf16_t*)reg1;
  if ((size_t)MAXROWS * D * 2 > reg1_bytes) { fprintf(stderr, "kernel_launch: region 1 too small for Y\n"); return; }
  char* reg2 = take((size_t)MAXROWS * DE);
  p.H = (bf16_t*)reg2; p.xc16 = (bf16_t*)reg2;
  p.h1b = (bf16_t*)take((size_t)T * D * 2); p.WdT = (bf16_t*)take((size_t)(NE + 1) * D * DE); p.h1q = (unsigned char*)take((size_t)T * D);
  p.dt = (float*)take((size_t)T * 32 * 4); p.WrT = (bf16_t*)take((size_t)NE * D * 2); p.gate = (float*)take((size_t)T * 8 * 4);
  p.assign = (int*)take((size_t)T * 8 * 4); p.pos = (int*)take((size_t)T * 8 * 4); p.blkcnt = (int*)take((size_t)(T / 64) * NE * 4);
  p.row_tok = (int*)take((size_t)MAXROWS * 4); p.row_gate = (float*)take((size_t)MAXROWS * 4); p.tile_exp = (int*)take((size_t)MAXTILES * 4);
  p.bar = (unsigned*)take((size_t)XCD_BAR_WORDS * 4 + 256); p.meta = (int*)(p.bar + XCD_BAR_WORDS);
  p.h1 = (float*)d_out;
  if (o > ws_size) { fprintf(stderr, "kernel_launch: ws too small: need %zu have %zu\n", o, ws_size); return; }
  static int grid_blocks = 0;
  if (!grid_blocks) {
    int dev = 0, cus = 0, per_cu = 0;
    hipGetDevice(&dev);
    hipDeviceGetAttribute(&cus, hipDeviceAttributeMultiprocessorCount, dev);
    if (hipFuncSetAttribute((const void*)k_mega, hipFuncAttributeMaxDynamicSharedMemorySize, LDS_BYTES) != hipSuccess) { fprintf(stderr, "kernel_launch: hipFuncSetAttribute failed\n"); return; }
    hipOccupancyMaxActiveBlocksPerMultiprocessor(&per_cu, k_mega, NT, LDS_BYTES);
    if (per_cu < 1) { fprintf(stderr, "kernel_launch: occupancy query says 0 blocks/CU\n"); return; }
    grid_blocks = cus;
  }
  if (hipMemsetAsync(p.bar, 0, (size_t)XCD_BAR_WORDS * 4 + 256, stream) != hipSuccess) { fprintf(stderr, "kernel_launch: memset failed\n"); return; }
  hipLaunchKernelGGL(k_mega, dim3(grid_blocks), dim3(NT), LDS_BYTES, stream, p);
  const hipError_t le = hipPeekAtLastError();
  if (le != hipSuccess) fprintf(stderr, "kernel_launch: launch failed: %s (grid %d)\n", hipGetErrorString(le), grid_blocks);
}
```

```cpp
#include <hip/hip_runtime.h>
#include <cstdio>
#include <cstdint>

namespace {
constexpr int D = 2048, NB = 8, S = 2048, T = NB * S;
constexpr int DSSD = 1024, DATT = 1024, NH = 16, HD = 64, NS = 128, CC = 1536;
constexpr int AH = 8, NE = 64, DE = 512, PW = 5664;
constexpr int O_DT = 2560, O_Q = 2592;
constexpr int N_Z = 0, N_XBC = 1024, N_Q = 2560, N_K = 3584, N_V = 4608, PLD = 5632, NPROJ = 5888;
constexpr float ALPHA = 1.189207115002721f;
constexpr float LAMBDA_INIT = 0.2f;
constexpr float LOG2E = 1.4426950408889634f;
constexpr float QS = 0.125f * LOG2E;
constexpr float W8S = 32.f, H8S = 8.f, Y8S = 32.f, Y8I = 1.f / 32.f;
constexpr int NT = 512;
constexpr int LDS_BYTES = 152 * 1024;
constexpr int LDS_TAB = 128 * 1024;
constexpr int MAXROWS_R = NE * 256 + T * 8;
constexpr int MAXROWS = MAXROWS_R + T;
constexpr int MAXTILES = MAXROWS / 256;

typedef unsigned short bf16_t;
#define LAS __attribute__((address_space(3)))

struct Params {
  const float *x, *w_in, *conv_w, *conv_b, *dt_bias_f, *dt_bias_b, *a_log_f, *a_log_b, *d_skip, *ssd_norm_w;
  const float *lq1, *lk1, *lq2, *lk2, *attn_norm_w, *w_out, *ln1_g, *ln1_b, *w_router, *router_bias;
  const float *wg_e, *wu_e, *wd_e, *wg_s, *wu_s, *wd_s, *ln2_g, *ln2_b;
  float* out;
  bf16_t *xb, *WinT, *WoutT, *WguT, *WdT, *proj, *u, *h1b, *H, *Y, *xc16, *WrT;
  float *dt, *h1, *gate, *row_gate;
  int *assign, *blkcnt, *row_tok, *pos, *tile_exp, *meta;
  unsigned* bar;
  unsigned char* h1q;
};

__device__ __forceinline__ float silu_f(float x) { return x / (1.f + __expf(-x)); }
__device__ __forceinline__ float softplus_f(float x) { return x > 20.f ? x : log1pf(__expf(x)); }
__device__ __forceinline__ float wave_sum(float v) { for (int o = 32; o >= 1; o >>= 1) v += __shfl_xor(v, o); return v; }
__device__ __forceinline__ float bf2f(bf16_t b) { return __uint_as_float(((unsigned)b) << 16); }
__device__ __forceinline__ bf16_t f2bf(float f) { unsigned u = __float_as_uint(f); u += 0x7FFFu + ((u >> 16) & 1u); return (bf16_t)(u >> 16); }
}

namespace pg8 {
#define PG8_LAS __attribute__((address_space(3)))
typedef unsigned short bf16_t;
typedef short bf16x8 __attribute__((ext_vector_type(8)));
typedef float f32x4 __attribute__((ext_vector_type(4)));
typedef unsigned u32x4 __attribute__((ext_vector_type(4)));
typedef int v8i __attribute__((ext_vector_type(8)));
constexpr int BM = 256, BK = 64, HALF = 128, HTB = HALF * BK * 2  , STAGE_BYTES = 8 * HTB, NXCD = 8, WGM = 8;

__host__ __device__ __forceinline__ int lds_byte(int r, int c) { const int st = (r >> 4) * 2 + (c >> 5), rr = r & 15, cc = c & 31, ob = rr * 64 + cc * 2; return st * 1024 + (ob ^ (((ob >> 9) & 1) << 5)); }
__host__ __device__ __forceinline__ void stage_rc(int b, int& R, int& C) { const int st = b / 1024, sb = b % 1024, swz = sb ^ (((sb >> 9) & 1) << 5); R = (st >> 1) * 16 + swz / 64; C = (st & 1) * 32 + (swz % 64) / 2; }
__host__ __device__ __forceinline__ int perm32(int rho) { const int n = rho >> 4, i = rho & 15; return 8 * (i >> 2) + 4 * n + (i & 3); }

struct Unit { int pm, pn, bn, aux; };
struct Gemm { const bf16_t* A; const bf16_t* Bt; int K; int sc_w, sc_a; };


__device__ __forceinline__ unsigned cvt_pk_bf16(float lo, float hi) { unsigned r; asm volatile("v_cvt_pk_bf16_f32 %0, %1, %2" : "=v"(r) : "v"(lo), "v"(hi)); return r; }
struct OrderStatic {
    int nM, nN, nwg, G, c;
    __device__ void init(int M, int N, int G_, int c_) { nM = M / BM; nN = N / BM; nwg = nM * nN; G = G_; c = c_; }
    __device__ bool next(int i, Unit& u) const {
        const long L = (long)i * G + c; if (L >= nwg) return false;
        int wgid = (int)L; { const int q = nwg / NXCD, r = nwg % NXCD, xcd = wgid % NXCD, off = wgid / NXCD; wgid = (xcd < r ? xcd * (q + 1) : r * (q + 1) + (xcd - r) * q) + off; }
        const int nig = WGM * nN, gid = wgid / nig, fm = gid * WGM, gsz = (nM - fm) < WGM ? (nM - fm) : WGM;
        u.pm = fm + ((wgid % nig) % gsz); u.pn = (wgid % nig) / gsz; u.bn = u.pn; u.aux = i; return true;
    }
    __device__ __forceinline__ unsigned row_off(int, int) const { return 0u; }
};
template <bool GATHER, bool FP8, class Epi, class Sched>
__device__ __forceinline__ void gemm_phase(PG8_LAS unsigned char* lds, const Gemm g, const Sched& S, const Epi& E) {
    int tid = threadIdx.x; asm volatile("" : "+v"(tid));
    const int wid = __builtin_amdgcn_readfirstlane(tid >> 6), lane = tid & 63, wr = wid >> 2, wc = wid & 3, fr = lane & 15, fq = lane >> 4;
    const int K = g.K; int nt = K / BK; asm volatile("" : "+s"(nt));
#define PG8_STAMP() do {} while (0)
    PG8_STAMP();
    unsigned voffA[2], voffB[2];
#pragma unroll
    for (int i = 0; i < 2; ++i) { int R, C; stage_rc(tid * 16 + i * 8192, R, C); const int Rb = Epi::PERM ? ((R & ~31) + perm32(R & 31)) : R;
        voffA[i] = (unsigned)(R * K + C) * 2u; voffB[i] = (unsigned)(Rb * K + C) * 2u; }
    unsigned voffG[2][2] = {{0u, 0u}, {0u, 0u}};
#define PG8_LOADG(uidx) do { if constexpr (GATHER) { _Pragma("unroll") for (int _h = 0; _h < 2; ++_h) _Pragma("unroll") for (int _i = 0; _i < 2; ++_i) { int R_, C_; stage_rc(tid * 16 + _i * 8192, R_, C_); \
        voffG[_h][_i] = S.row_off((uidx), _h * HALF + R_) + (unsigned)C_ * 2u; } } } while (0)
    const size_t kstep = (size_t)(BK * 2);
    const size_t hstep = (size_t)HALF * K * 2;
    const size_t tstep = 2 * hstep;
    const unsigned ldsw = (unsigned)wid * 1024u;
    const int aoff = lds_byte(wr * 64 + fr, fq * 8), boff = lds_byte(wc * 32 + fr, fq * 8);
    const int c8 = (fq >> 1) * 32 + (fq & 1) * 16;
    const int aoff8a = lds_byte(wr * 64 + fr, c8), aoff8b = lds_byte(wr * 64 + fr, c8 + 8), boff8a = lds_byte(wc * 32 + fr, c8), boff8b = lds_byte(wc * 32 + fr, c8 + 8);
#define PG8_SA(b, h) (((b) * 2 + (h)) * HTB)
#define PG8_SB(b, h) ((4 + (b) * 2 + (h)) * HTB)
#define PG8_STAGE(bufoff, gbase, voff) do { _Pragma("unroll") for (int _i = 0; _i < 2; ++_i) \
        __builtin_amdgcn_global_load_lds((const unsigned*)((const char*)(gbase) + (voff)[_i]), (PG8_LAS unsigned*)(lds + (bufoff) + ldsw + _i * 8192), 16, 0, 0); } while (0)
#define PG8_STAGE_A(bufoff, ptr, h) do { if constexpr (GATHER) { PG8_STAGE(bufoff, ptr, voffG[h]); } else { PG8_STAGE(bufoff, (ptr) + (h) * hstep, voffA); } } while (0)
#define PG8_LDA(dst, b, h) do { if constexpr (FP8) { _Pragma("unroll") for (int m = 0; m < 4; ++m) { const u32x4 lo_ = *(const PG8_LAS u32x4*)(lds + PG8_SA(b, h) + aoff8a + m * 2048), hi_ = *(const PG8_LAS u32x4*)(lds + PG8_SA(b, h) + aoff8b + m * 2048); \
        dst##8[m] = (v8i){(int)lo_.x, (int)lo_.y, (int)lo_.z, (int)lo_.w, (int)hi_.x, (int)hi_.y, (int)hi_.z, (int)hi_.w}; } } else { \
        _Pragma("unroll") for (int m = 0; m < 4; ++m) _Pragma("unroll") for (int k = 0; k < 2; ++k) dst[m][k] = *(const PG8_LAS bf16x8*)(lds + PG8_SA(b, h) + aoff + m * 2048 + k * 1024); } } while (0)
#define PG8_LDB(dst, b, h) do { if constexpr (FP8) { _Pragma("unroll") for (int n = 0; n < 2; ++n) { const u32x4 lo_ = *(const PG8_LAS u32x4*)(lds + PG8_SB(b, h) + boff8a + n * 2048), hi_ = *(const PG8_LAS u32x4*)(lds + PG8_SB(b, h) + boff8b + n * 2048); \
        dst##8[n] = (v8i){(int)lo_.x, (int)lo_.y, (int)lo_.z, (int)lo_.w, (int)hi_.x, (int)hi_.y, (int)hi_.z, (int)hi_.w}; } } else { \
        _Pragma("unroll") for (int n = 0; n < 2; ++n) _Pragma("unroll") for (int k = 0; k < 2; ++k) dst[n][k] = *(const PG8_LAS bf16x8*)(lds + PG8_SB(b, h) + boff + n * 2048 + k * 1024); } } while (0)
#define PG8_MMA(ai, bj, At, Bt) do { __builtin_amdgcn_s_setprio(1); if constexpr (FP8) { _Pragma("unroll") for (int m = 0; m < 4; ++m) _Pragma("unroll") for (int n = 0; n < 2; ++n) \
        acc[ai][bj][m][n] = __builtin_amdgcn_mfma_scale_f32_16x16x128_f8f6f4(Bt##8[n], At##8[m], acc[ai][bj][m][n], 0, 0, 0, g.sc_w, 0, g.sc_a); } else { \
        _Pragma("unroll") for (int m = 0; m < 4; ++m) _Pragma("unroll") for (int n = 0; n < 2; ++n) _Pragma("unroll") for (int k = 0; k < 2; ++k) \
        acc[ai][bj][m][n] = __builtin_amdgcn_mfma_f32_16x16x32_bf16(Bt[n][k], At[m][k], acc[ai][bj][m][n], 0, 0, 0); } __builtin_amdgcn_s_setprio(0); } while (0)
#define PG8_WAIT_V(n) asm volatile("s_waitcnt vmcnt(" #n ")" ::: "memory")
#define PG8_WAIT_L(n) asm volatile("s_waitcnt lgkmcnt(" #n ")" ::: "memory")
#define PG8_BAR __builtin_amdgcn_s_barrier()
#define PG8_SCHED __builtin_amdgcn_sched_barrier(0)
    Unit cur, nxt; int ui = 0;
    if (!S.next(0, cur)) return;
    f32x4 acc[2][2][4][2];
#pragma unroll
    for (int a = 0; a < 2; ++a)
#pragma unroll
        for (int b = 0; b < 2; ++b)
#pragma unroll
            for (int m = 0; m < 4; ++m)
#pragma unroll
                for (int n = 0; n < 2; ++n) acc[a][b][m][n] = (f32x4){0.f, 0.f, 0.f, 0.f};
    bf16x8 At[4][2], B0[2][2], B1[2][2]; v8i At8[4], B08[2], B18[2];
    const char* cA = GATHER ? (const char*)g.A : (const char*)g.A + (size_t)cur.pm * tstep; const char* cB = (const char*)g.Bt + (size_t)cur.bn * tstep;
    PG8_LOADG(0);
    PG8_STAGE(PG8_SB(0, 0), cB, voffB); PG8_STAGE_A(PG8_SA(0, 0), cA, 0); PG8_STAGE(PG8_SB(0, 1), cB + hstep, voffB); PG8_STAGE_A(PG8_SA(0, 1), cA, 1);
    if (wr == 1) PG8_BAR;
    PG8_WAIT_V(4); PG8_BAR;
    PG8_STAGE(PG8_SB(1, 0), cB + kstep, voffB); PG8_STAGE_A(PG8_SA(1, 0), cA + kstep, 0); PG8_STAGE(PG8_SB(1, 1), cB + hstep + kstep, voffB);
    PG8_WAIT_V(6); PG8_BAR;
    PG8_STAMP();
    for (;;) {
        const bool has_next = S.next(ui + 1, nxt);
        const char* nA = has_next ? (GATHER ? (const char*)g.A : (const char*)g.A + (size_t)nxt.pm * tstep) : cA; const char* nB = has_next ? (const char*)g.Bt + (size_t)nxt.bn * tstep : cB;
#pragma unroll 1
        for (int t = 0; t < nt; t += 2) {
            const bool last = (t == nt - 2);
            const char* a1 = cA + (size_t)(t + 1) * kstep;
            const char* a2 = last ? nA : cA + (size_t)(t + 2) * kstep; const char* b2 = last ? nB : cB + (size_t)(t + 2) * kstep;
            const char* a3 = a2 + kstep; const char* b3 = b2 + kstep;
            PG8_LDB(B0, 0, 0); PG8_SCHED; PG8_LDA(At, 0, 0); PG8_STAGE_A(PG8_SA(1, 1), a1, 1);
            PG8_WAIT_L(8); PG8_BAR; PG8_WAIT_L(0); PG8_MMA(0, 0, At, B0); PG8_BAR; PG8_SCHED;
            if (last && has_next) PG8_LOADG(ui + 1);
            PG8_LDB(B1, 0, 1); PG8_STAGE(PG8_SB(0, 0), b2, voffB);
            PG8_BAR; PG8_WAIT_L(0); PG8_MMA(0, 1, At, B1); PG8_BAR;
            PG8_LDA(At, 0, 1); PG8_STAGE_A(PG8_SA(0, 0), a2, 0);
            PG8_BAR; PG8_WAIT_L(0); PG8_MMA(1, 0, At, B0); PG8_BAR; PG8_SCHED;
            PG8_STAGE(PG8_SB(0, 1), b2 + hstep, voffB);
            PG8_WAIT_V(6); PG8_BAR; PG8_MMA(1, 1, At, B1); PG8_BAR;
            PG8_LDB(B0, 1, 0); PG8_SCHED; PG8_LDA(At, 1, 0); PG8_STAGE_A(PG8_SA(0, 1), a2, 1);
            PG8_WAIT_L(8); PG8_BAR; PG8_WAIT_L(0); PG8_MMA(0, 0, At, B0); PG8_BAR; PG8_SCHED;
            PG8_LDB(B1, 1, 1); PG8_STAGE(PG8_SB(1, 0), b3, voffB);
            PG8_BAR; PG8_WAIT_L(0); PG8_MMA(0, 1, At, B1); PG8_BAR;
            PG8_LDA(At, 1, 1); PG8_STAGE_A(PG8_SA(1, 0), a3, 0);
            PG8_BAR; PG8_WAIT_L(0); PG8_MMA(1, 0, At, B0); PG8_BAR; PG8_SCHED;
            PG8_STAGE(PG8_SB(1, 1), b3 + hstep, voffB);
            PG8_WAIT_V(6); PG8_BAR; PG8_MMA(1, 1, At, B1); PG8_BAR;
        }
        PG8_STAMP();
        E(acc, cur, wr, wc, fr, fq);
        PG8_STAMP();
        if (!has_next) break;
#pragma unroll
        for (int a = 0; a < 2; ++a)
#pragma unroll
            for (int b = 0; b < 2; ++b)
#pragma unroll
                for (int m = 0; m < 4; ++m)
#pragma unroll
                    for (int n = 0; n < 2; ++n) acc[a][b][m][n] = (f32x4){0.f, 0.f, 0.f, 0.f};
        cur = nxt; cA = nA; cB = nB; ++ui;
    }
    PG8_WAIT_V(0);
    if (wr == 0) PG8_BAR;
    PG8_BAR;
    PG8_STAMP();
#undef PG8_STAMP
#undef PG8_SA
#undef PG8_SB
#undef PG8_STAGE
#undef PG8_STAGE_A
#undef PG8_LOADG
#undef PG8_LDA
#undef PG8_LDB
#undef PG8_MMA
#undef PG8_WAIT_V
#undef PG8_WAIT_L
#undef PG8_BAR
#undef PG8_SCHED
}
}
namespace {
#define XB_TMO      128
#define XB_XCNT(j)  (256  + 64 * (j))
#define XB_XSUB(j)  (1280 + 64 * (j))
#define XB_XGEN(j)  (2304 + 64 * (j))
#define XB_TOP      3328
#define XB_TOPGEN   3392
#define XCD_BAR_WORDS 3456
#define XB_SPIN_CAP (1u << 18)

__device__ __forceinline__ unsigned xb_ld(unsigned* p)              { return __hip_atomic_load(p, __ATOMIC_RELAXED, __HIP_MEMORY_SCOPE_AGENT); }
__device__ __forceinline__ unsigned xb_add(unsigned* p, unsigned v) { return __hip_atomic_fetch_add(p, v, __ATOMIC_RELAXED, __HIP_MEMORY_SCOPE_AGENT); }
__device__ __forceinline__ unsigned xb_xcc_id() { return (unsigned)__builtin_amdgcn_s_getreg((3 << 11) | 20) & 0xFu; }
#define XB_SPIN(cond, bar) do { unsigned _sp = 0; while (cond) { __builtin_amdgcn_s_sleep(1); \
    if ((++_sp & 255u) == 0u) { if (xb_ld(&(bar)[XB_TMO])) break; if (_sp > XB_SPIN_CAP) { atomicAdd(&(bar)[XB_TMO], 1u); break; } } } } while (0)

struct XcdBarrier {
    unsigned* bar; unsigned x;
    volatile LAS unsigned* st;
};

__device__ __forceinline__ XcdBarrier xcd_barrier_post(unsigned* bar, volatile LAS unsigned* st) {
    XcdBarrier b; b.bar = bar; b.x = xb_xcc_id(); b.st = st;
    if (threadIdx.x == 0) (void)xb_add(&bar[XB_XCNT(b.x)], 1u);
    return b;
}
__device__ __forceinline__ void xcd_barrier_complete(unsigned* bar, unsigned x, unsigned& nloc, unsigned& nx) {
    const unsigned G = gridDim.x * gridDim.y * gridDim.z;
    unsigned sum, cnt, mine, sp = 0u;
    for (;;) {
        sum = 0u; cnt = 0u; mine = 0u;
#pragma unroll
        for (unsigned j = 0; j < 16; ++j) { const unsigned c = xb_ld(&bar[XB_XCNT(j)]); sum += c; cnt += (c > 0u) ? 1u : 0u; mine = (j == x) ? c : mine; }
        if (sum == G) break;
        __builtin_amdgcn_s_sleep(1);
        if ((++sp & 255u) == 0u) { if (xb_ld(&bar[XB_TMO])) break; if (sp > XB_SPIN_CAP) { atomicAdd(&bar[XB_TMO], 1u); break; } }
    }
    nloc = mine > 0u ? mine : 1u; nx = cnt > 0u ? cnt : 1u;
}

__device__ __forceinline__ void xcd_barrier(const XcdBarrier& b) {
    asm volatile("s_waitcnt vmcnt(0)" ::: "memory");
    __syncthreads();
    if (threadIdx.x == 0) {
        unsigned* bar = b.bar;
        __builtin_amdgcn_s_waitcnt(0);
        unsigned nloc = b.st[0], nx = b.st[1];
        if (nloc == 0u) { xcd_barrier_complete(bar, b.x, nloc, nx); b.st[0] = nloc; b.st[1] = nx; }
        const unsigned old = xb_add(&bar[XB_XSUB(b.x)], 1u);
        const unsigned gen = old / nloc;
        if (old + 1u == (gen + 1u) * nloc) {
            __builtin_amdgcn_fence(__ATOMIC_RELEASE, "agent");
            asm volatile("s_waitcnt vmcnt(0)" ::: "memory");
            const unsigned og = xb_add(&bar[XB_TOP], 1u);
            const unsigned tg = og / nx;
            if (og + 1u == (tg + 1u) * nx) xb_add(&bar[XB_TOPGEN], 1u);
            else XB_SPIN(xb_ld(&bar[XB_TOPGEN]) == tg, bar);
            __builtin_amdgcn_fence(__ATOMIC_ACQUIRE, "agent");
            xb_add(&bar[XB_XGEN(b.x)], 1u);
            asm volatile("s_waitcnt vmcnt(0)" ::: "memory");
        } else {
            XB_SPIN(xb_ld(&bar[XB_XGEN(b.x)]) == gen, bar);
            __builtin_amdgcn_fence(__ATOMIC_ACQUIRE, "agent");
            asm volatile("s_waitcnt vmcnt(0)" ::: "memory");
        }
    }
    __syncthreads();
}

}
namespace {
using pg8::f32x4; using pg8::u32x4; using pg8::cvt_pk_bf16;

template <class ARow, class Epi>
__device__ __forceinline__ void gemm_tile(float* smem, int mvalid, int nvalid, int K, ARow arow, const float* Bp, int ldb, Epi epi) {
  float* As = smem;
  float* Bs = smem + 16 * 68;
  const int tid = threadIdx.x, ty = tid >> 5, tx = tid & 31;
  float acc[4][4];
#pragma unroll
  for (int i = 0; i < 4; ++i)
#pragma unroll
    for (int j = 0; j < 4; ++j) acc[i][j] = 0.f;
  const int ak = tid & 15, ar = tid >> 4;
  const float* ap0 = (ar < mvalid) ? arow(ar) : nullptr;
  const float* ap1 = (ar + 32 < mvalid) ? arow(ar + 32) : nullptr;
  const int bn = tid & 127, bk = tid >> 7;
  for (int k0 = 0; k0 < K; k0 += 16) {
    As[ak * 68 + ar] = ap0 ? ap0[k0 + ak] : 0.f;
    As[ak * 68 + ar + 32] = ap1 ? ap1[k0 + ak] : 0.f;
#pragma unroll
    for (int i = 0; i < 4; ++i) { const int kk = bk + 4 * i; Bs[kk * 128 + bn] = (bn < nvalid) ? Bp[(size_t)(k0 + kk) * ldb + bn] : 0.f; }
    __syncthreads();
#pragma unroll
    for (int kk = 0; kk < 16; ++kk) {
      float a[4], b[4];
#pragma unroll
      for (int i = 0; i < 4; ++i) a[i] = As[kk * 68 + ty * 4 + i];
#pragma unroll
      for (int j = 0; j < 4; ++j) b[j] = Bs[kk * 128 + tx * 4 + j];
#pragma unroll
      for (int i = 0; i < 4; ++i)
#pragma unroll
        for (int j = 0; j < 4; ++j) acc[i][j] += a[i] * b[j];
    }
    __syncthreads();
  }
#pragma unroll
  for (int i = 0; i < 4; ++i)
#pragma unroll
    for (int j = 0; j < 4; ++j) { const int r = ty * 4 + i, c = tx * 4 + j; if (r < mvalid && c < nvalid) epi(r, c, acc[i][j]); }
}

template <class RowMap>
__device__ __forceinline__ void cvt_tile(const float* __restrict__ src, int N, int K, int k0, int n0, bf16_t* __restrict__ dst, RowMap rm) {
  const int lane = threadIdx.x & 63, w = threadIdx.x >> 6;
  const int n = n0 + (lane & 15) * 4, kk = k0 + (w * 4 + (lane >> 4)) * 8;
  if (n >= N) return;
  float4 v[8];
#pragma unroll
  for (int j = 0; j < 8; ++j) v[j] = *(const float4*)(src + (size_t)(kk + j) * N + n);
  u32x4 o;
  o.x = cvt_pk_bf16(v[0].x, v[1].x); o.y = cvt_pk_bf16(v[2].x, v[3].x); o.z = cvt_pk_bf16(v[4].x, v[5].x); o.w = cvt_pk_bf16(v[6].x, v[7].x);
  *(u32x4*)(dst + (size_t)rm(n + 0) * K + kk) = o;
  o.x = cvt_pk_bf16(v[0].y, v[1].y); o.y = cvt_pk_bf16(v[2].y, v[3].y); o.z = cvt_pk_bf16(v[4].y, v[5].y); o.w = cvt_pk_bf16(v[6].y, v[7].y);
  *(u32x4*)(dst + (size_t)rm(n + 1) * K + kk) = o;
  o.x = cvt_pk_bf16(v[0].z, v[1].z); o.y = cvt_pk_bf16(v[2].z, v[3].z); o.z = cvt_pk_bf16(v[4].z, v[5].z); o.w = cvt_pk_bf16(v[6].z, v[7].z);
  *(u32x4*)(dst + (size_t)rm(n + 2) * K + kk) = o;
  o.x = cvt_pk_bf16(v[0].w, v[1].w); o.y = cvt_pk_bf16(v[2].w, v[3].w); o.z = cvt_pk_bf16(v[4].w, v[5].w); o.w = cvt_pk_bf16(v[6].w, v[7].w);
  *(u32x4*)(dst + (size_t)rm(n + 3) * K + kk) = o;
}
template <class RowMap>
__device__ void cvt_job(const float* src, int nmat, int K, int N, bf16_t* dst, size_t dstride, RowMap rm) {
  const int kt = K / 256, ntl = (N + 63) / 64, per = kt * ntl;
  for (int it = blockIdx.x; it < nmat * per; it += gridDim.x) {
    const int m = it / per, r = it % per, k0 = (r / ntl) * 256, n0 = (r % ntl) * 64;
    cvt_tile(src + (size_t)m * K * N, N, K, k0, n0, dst + (size_t)m * dstride, rm);
  }
}
__device__ void ph_convert(const Params& p) {
  const size_t gtid = (size_t)blockIdx.x * NT + threadIdx.x, gsz = (size_t)gridDim.x * NT;
  for (size_t i = gtid; i < (size_t)T * D / 8; i += gsz) {
    const float4 a = *(const float4*)(p.x + i * 8), b = *(const float4*)(p.x + i * 8 + 4);
    u32x4 o; o.x = cvt_pk_bf16(a.x, a.y); o.y = cvt_pk_bf16(a.z, a.w); o.z = cvt_pk_bf16(b.x, b.y); o.w = cvt_pk_bf16(b.z, b.w);
    *(u32x4*)(p.xb + i * 8) = o;
  }
  cvt_job(p.w_in, 1, D, PW, p.WinT, 0, [](int n) { return n < O_DT ? n : (n < O_Q ? PLD + (n - O_DT) : n - 32); });
  for (size_t i = gtid; i < (size_t)(NPROJ - PW) * D / 8; i += gsz) *(u32x4*)(p.WinT + (size_t)PW * D + i * 8) = (u32x4){0u, 0u, 0u, 0u};
  cvt_job(p.w_out, 1, D, D, p.WoutT, 0, [](int n) { return n; });
  cvt_job(p.w_router, 1, D, NE, p.WrT, 0, [](int n) { return n; });
}
__device__ __forceinline__ unsigned pk4_fp8(float a, float b, float c, float d) { int w = 0; w = __builtin_amdgcn_cvt_pk_fp8_f32(a * W8S, b * W8S, w, false); w = __builtin_amdgcn_cvt_pk_fp8_f32(c * W8S, d * W8S, w, true); return (unsigned)w; }
template <class RowMap>
__device__ __forceinline__ void cvt_range8(const float* __restrict__ src, int K, int N, unsigned char* __restrict__ dst, size_t dstride, RowMap rm, int it0, int it1) {
  constexpr int NT2 = 2;
  const int kt = K / 512, ntl = N / 64, per = kt * ntl;
  int tid = threadIdx.x; asm volatile("" : "+v"(tid));
  const int lane = tid & 63, w = tid >> 6, nl = (lane & 15) * 4, kl = (w * 4 + (lane >> 4)) * 16;
  for (int it = it0; it < it1; it += NT2) {
    float4 v[NT2][16];
#pragma unroll
    for (int q = 0; q < NT2; ++q) { const int m = (it + q) / per, r = (it + q) % per, kk = (r / ntl) * 512 + kl, n = (r % ntl) * 64 + nl;
      const float* sp = src + (size_t)m * K * N + (size_t)kk * N + n;
#pragma unroll
      for (int j = 0; j < 16; ++j) v[q][j] = *(const float4*)(sp + (size_t)j * N); }
#pragma unroll
    for (int q = 0; q < NT2; ++q) { const int m = (it + q) / per, r = (it + q) % per, kk = (r / ntl) * 512 + kl, n = (r % ntl) * 64 + nl;
      unsigned char* dp = dst + (size_t)m * dstride + kk; u32x4 o;
      o.x = pk4_fp8(v[q][0].x, v[q][1].x, v[q][2].x, v[q][3].x); o.y = pk4_fp8(v[q][4].x, v[q][5].x, v[q][6].x, v[q][7].x); o.z = pk4_fp8(v[q][8].x, v[q][9].x, v[q][10].x, v[q][11].x); o.w = pk4_fp8(v[q][12].x, v[q][13].x, v[q][14].x, v[q][15].x);
      *(u32x4*)(dp + (size_t)rm(n + 0) * K) = o;
      o.x = pk4_fp8(v[q][0].y, v[q][1].y, v[q][2].y, v[q][3].y); o.y = pk4_fp8(v[q][4].y, v[q][5].y, v[q][6].y, v[q][7].y); o.z = pk4_fp8(v[q][8].y, v[q][9].y, v[q][10].y, v[q][11].y); o.w = pk4_fp8(v[q][12].y, v[q][13].y, v[q][14].y, v[q][15].y);
      *(u32x4*)(dp + (size_t)rm(n + 1) * K) = o;
      o.x = pk4_fp8(v[q][0].z, v[q][1].z, v[q][2].z, v[q][3].z); o.y = pk4_fp8(v[q][4].z, v[q][5].z, v[q][6].z, v[q][7].z); o.z = pk4_fp8(v[q][8].z, v[q][9].z, v[q][10].z, v[q][11].z); o.w = pk4_fp8(v[q][12].z, v[q][13].z, v[q][14].z, v[q][15].z);
      *(u32x4*)(dp + (size_t)rm(n + 2) * K) = o;
      o.x = pk4_fp8(v[q][0].w, v[q][1].w, v[q][2].w, v[q][3].w); o.y = pk4_fp8(v[q][4].w, v[q][5].w, v[q][6].w, v[q][7].w); o.z = pk4_fp8(v[q][8].w, v[q][9].w, v[q][10].w, v[q][11].w); o.w = pk4_fp8(v[q][12].w, v[q][13].w, v[q][14].w, v[q][15].w);
      *(u32x4*)(dp + (size_t)rm(n + 3) * K) = o; }
  }
}
constexpr int CVT_ITEMS = 3 * 256 + 3 * 4;
__device__ __forceinline__ void cvt_moe_item(const Params& p, int item) {
  unsigned char* gu = (unsigned char*)p.WguT; unsigned char* dn = (unsigned char*)p.WdT;
  if (item < 256) cvt_range8(p.wg_e, D, DE, gu, (size_t)1024 * D, [](int n) { return (n >> 7) * 256 + (n & 127); }, item * 8, item * 8 + 8);
  else if (item < 512) cvt_range8(p.wu_e, D, DE, gu, (size_t)1024 * D, [](int n) { return (n >> 7) * 256 + 128 + (n & 127); }, (item - 256) * 8, (item - 256) * 8 + 8);
  else if (item < 768) cvt_range8(p.wd_e, DE, D, dn, (size_t)D * DE, [](int n) { return n; }, (item - 512) * 8, (item - 512) * 8 + 8);
  else if (item < 772) cvt_range8(p.wg_s, D, DE, gu + (size_t)NE * 1024 * D, 0, [](int n) { return (n >> 7) * 256 + (n & 127); }, (item - 768) * 8, (item - 768) * 8 + 8);
  else if (item < 776) cvt_range8(p.wu_s, D, DE, gu + (size_t)NE * 1024 * D, 0, [](int n) { return (n >> 7) * 256 + 128 + (n & 127); }, (item - 772) * 8, (item - 772) * 8 + 8);
  else cvt_range8(p.wd_s, DE, D, dn + (size_t)NE * D * DE, 0, [](int n) { return n; }, (item - 776) * 8, (item - 776) * 8 + 8);
}

struct EpiProj {
  static constexpr bool PERM = true;
  bf16_t* proj; float* dt; const float* bias_f; const float* bias_b;
  __device__ __forceinline__ void operator()(const f32x4 (&acc)[2][2][4][2], const pg8::Unit& u, int wr, int wc, int fr, int fq) const {
    asm volatile("" : "+v"(fr), "+v"(fq));
    const int row0 = u.pm * 256 + wr * 64 + fr;
    if (u.pn < 22) {
      const int col0 = u.pn * 256 + wc * 32 + 8 * fq;
      const float sc = (u.pn >= 10 && u.pn < 14) ? QS : 1.0f;
#pragma unroll
      for (int ai = 0; ai < 2; ++ai)
#pragma unroll
        for (int m = 0; m < 4; ++m) { bf16_t* rowp = proj + (size_t)(row0 + ai * 128 + m * 16) * PLD + col0;
#pragma unroll
          for (int bj = 0; bj < 2; ++bj) { const f32x4 v0 = acc[ai][bj][m][0] * sc, v1 = acc[ai][bj][m][1] * sc;
            u32x4 w; w.x = cvt_pk_bf16(v0[0], v0[1]); w.y = cvt_pk_bf16(v0[2], v0[3]); w.z = cvt_pk_bf16(v1[0], v1[1]); w.w = cvt_pk_bf16(v1[2], v1[3]);
            *(u32x4*)(rowp + bj * 128) = w; } }
    } else if (wc == 0) {
      const int c0 = 8 * fq;
      float bs[8];
#pragma unroll
      for (int j = 0; j < 8; ++j) bs[j] = (c0 + j) < 16 ? bias_f[c0 + j] : bias_b[c0 + j - 16];
#pragma unroll
      for (int ai = 0; ai < 2; ++ai)
#pragma unroll
        for (int m = 0; m < 4; ++m) { float* rowp = dt + (size_t)(row0 + ai * 128 + m * 16) * 32 + c0;
          const f32x4 v0 = acc[ai][0][m][0], v1 = acc[ai][0][m][1];
          f32x4 o0, o1;
#pragma unroll
          for (int j = 0; j < 4; ++j) { o0[j] = softplus_f(v0[j] + bs[j]); o1[j] = softplus_f(v1[j] + bs[4 + j]); }
          *(f32x4*)rowp = o0; *(f32x4*)(rowp + 4) = o1; }
    }
  }
};
struct EpiOut {
  static constexpr bool PERM = false;
  const float* x; float* v;
  __device__ __forceinline__ void operator()(const f32x4 (&acc)[2][2][4][2], const pg8::Unit& u, int wr, int wc, int fr, int fq) const {
    asm volatile("" : "+v"(fr), "+v"(fq));
    const int row0 = u.pm * 256 + wr * 64 + fr, col0 = u.pn * 256 + wc * 32 + 4 * fq;
#pragma unroll
    for (int ai = 0; ai < 2; ++ai)
#pragma unroll
      for (int m = 0; m < 4; ++m) { const size_t off = (size_t)(row0 + ai * 128 + m * 16) * D + col0;
#pragma unroll
        for (int bj = 0; bj < 2; ++bj)
#pragma unroll
          for (int n = 0; n < 2; ++n) { const f32x4 xv = *(const f32x4*)(x + off + bj * 128 + n * 16); *(f32x4*)(v + off + bj * 128 + n * 16) = xv * ALPHA + acc[ai][bj][m][n]; } }
  }
};

namespace at {
using bf16x8 = __attribute__((ext_vector_type(8))) short;
using s16x4  = __attribute__((ext_vector_type(4))) short;
using f32x16 = __attribute__((ext_vector_type(16))) float;
using u32x4  = __attribute__((ext_vector_type(4))) unsigned;
constexpr int KVBLK = 64;
constexpr size_t SHM_V = KVBLK * 128 * 2, SHM_K = KVBLK * 128 * 2;
constexpr float THR2 = 8.0f;
#define AT_KSWZ(row, colB) ((row) * 256 + ((colB) ^ (((row) & 7) << 4)))
#define AT_SBAR() __builtin_amdgcn_sched_barrier(0)
__device__ __forceinline__ int crow(int r, int hi) { return (r & 3) + 8 * (r >> 2) + 4 * hi; }
__device__ __forceinline__ unsigned cvtpk(float lo, float hi) { unsigned r; asm volatile("v_cvt_pk_bf16_f32 %0, %1, %2" : "=v"(r) : "v"(lo), "v"(hi)); return r; }

__device__ __forceinline__ void partialSM(f32x16& p0, f32x16& p1, float dqh, float nsl2, float& m_reg, float& mn, float& alpha) {
#pragma unroll
  for (int r = 0; r < 16; ++r) { const float c = (float)((r & 3) + 8 * (r >> 2));
    p0[r] = fmaf(nsl2, fabsf(dqh - c), p0[r]); p1[r] = fmaf(nsl2, fabsf(dqh - (c + 32.f)), p1[r]); }
  float pmax = p0[0];
#pragma unroll
  for (int r = 1; r < 16; ++r) pmax = fmaxf(pmax, p0[r]);
#pragma unroll
  for (int r = 0; r < 16; ++r) pmax = fmaxf(pmax, p1[r]);
  { auto rr = __builtin_amdgcn_permlane32_swap(__float_as_uint(pmax), __float_as_uint(pmax), false, false);
    pmax = fmaxf(__uint_as_float(rr[0]), __uint_as_float(rr[1])); }
  if (__builtin_expect(__all(pmax - m_reg <= THR2), 1)) { mn = m_reg; alpha = 1.f; }
  else { mn = fmaxf(m_reg, pmax); alpha = __builtin_amdgcn_exp2f(m_reg - mn); m_reg = mn; }
#pragma unroll
  for (int r = 0; r < 16; ++r) p0[r] = p0[r] - mn;
#pragma unroll
  for (int r = 0; r < 16; ++r) p1[r] = p1[r] - mn;
#pragma unroll
  for (int r = 0; r < 16; ++r) p0[r] = __builtin_amdgcn_exp2f(p0[r]);
}
__device__ __forceinline__ void finishSM(f32x16& p0, f32x16& p1, float alpha, float& l_reg, bf16x8& pa0, bf16x8& pa1, bf16x8& pa2, bf16x8& pa3) {
#pragma unroll
  for (int r = 0; r < 16; ++r) p1[r] = __builtin_amdgcn_exp2f(p1[r]);
  float ps = 0;
#pragma unroll
  for (int r = 0; r < 16; ++r) ps += p0[r];
#pragma unroll
  for (int r = 0; r < 16; ++r) ps += p1[r];
  { auto rr = __builtin_amdgcn_permlane32_swap(__float_as_uint(ps), __float_as_uint(ps), false, false);
    ps = __uint_as_float(rr[0]) + __uint_as_float(rr[1]); }
  l_reg = l_reg * alpha + ps;
#define AT_PK4(P, BASE, OUT) do { unsigned a0 = cvtpk(P[BASE + 0], P[BASE + 1]), a1 = cvtpk(P[BASE + 2], P[BASE + 3]);   \
    unsigned b0 = cvtpk(P[BASE + 4], P[BASE + 5]), b1 = cvtpk(P[BASE + 6], P[BASE + 7]);                              \
    auto r0 = __builtin_amdgcn_permlane32_swap(a0, b0, false, false); auto r1 = __builtin_amdgcn_permlane32_swap(a1, b1, false, false); \
    u32x4 w = {r0[0], r1[0], r0[1], r1[1]}; OUT = *reinterpret_cast<bf16x8*>(&w); } while (0)
  AT_PK4(p0, 0, pa0); AT_PK4(p0, 8, pa1); AT_PK4(p1, 0, pa2); AT_PK4(p1, 8, pa3);
#undef AT_PK4
}
__device__ __forceinline__ void qkt(f32x16& p0, f32x16& p1, const char* Ks, const bf16x8* qr, int r32, int hi, int cm) {
  p0 = f32x16{}; p1 = f32x16{};
#pragma unroll
  for (int d0 = 0; d0 < 4; ++d0) { const int cb = (cm + d0 * 16 + hi * 8) * 2;
    bf16x8 b0 = *reinterpret_cast<const bf16x8*>(Ks + AT_KSWZ(r32, cb));
    bf16x8 b1 = *reinterpret_cast<const bf16x8*>(Ks + AT_KSWZ(32 + r32, cb));
    p0 = __builtin_amdgcn_mfma_f32_32x32x16_bf16(b0, qr[d0], p0, 0, 0, 0);
    p1 = __builtin_amdgcn_mfma_f32_32x32x16_bf16(b1, qr[d0], p1, 0, 0, 0); }
}
__device__ __forceinline__ int v_st(int k, int c) { const int kk = (k & ~0xC) | ((k & 4) << 1) | ((k & 8) >> 1); return ((kk >> 3) * 4 + (c >> 5)) * 512 + ((kk & 7) * 32 + (c & 31)) * 2; }
__device__ __forceinline__ int v_rd_base(int lane) { return ((lane & 3) << 3) | (((lane >> 2) & 3) << 6) | (((lane >> 4) & 1) << 5) | (((lane >> 5) & 1) << 8); }
constexpr int v_rd_off(int d0, int ks, int half) { return d0 * 512 + ks * 4096 + half * 2048; }
template <int OFF> __device__ __forceinline__ s16x4 tr_read(int vb) {
  s16x4 r; asm volatile("ds_read_b64_tr_b16 %0, %1 offset:%2" : "=&v"(r) : "v"(vb), "i"(OFF) : "memory"); return r;
}
template <int D0> __device__ __forceinline__ void pv_one(f32x16& od, int vb, bf16x8 pa0, bf16x8 pa1, bf16x8 pa2, bf16x8 pa3) {
  const s16x4 l0 = tr_read<v_rd_off(D0, 0, 0)>(vb), h0 = tr_read<v_rd_off(D0, 0, 1)>(vb), l1 = tr_read<v_rd_off(D0, 1, 0)>(vb), h1 = tr_read<v_rd_off(D0, 1, 1)>(vb);
  const s16x4 l2 = tr_read<v_rd_off(D0, 2, 0)>(vb), h2 = tr_read<v_rd_off(D0, 2, 1)>(vb), l3 = tr_read<v_rd_off(D0, 3, 0)>(vb), h3 = tr_read<v_rd_off(D0, 3, 1)>(vb);
  asm volatile("s_waitcnt lgkmcnt(0)" ::: "memory"); AT_SBAR();
#define AT_PK(L, H) (bf16x8){L[0], L[1], L[2], L[3], H[0], H[1], H[2], H[3]}
  od = __builtin_amdgcn_mfma_f32_32x32x16_bf16(pa0, AT_PK(l0, h0), od, 0, 0, 0);
  od = __builtin_amdgcn_mfma_f32_32x32x16_bf16(pa1, AT_PK(l1, h1), od, 0, 0, 0);
  od = __builtin_amdgcn_mfma_f32_32x32x16_bf16(pa2, AT_PK(l2, h2), od, 0, 0, 0);
  od = __builtin_amdgcn_mfma_f32_32x32x16_bf16(pa3, AT_PK(l3, h3), od, 0, 0, 0);
#undef AT_PK
}
__device__ __forceinline__ void pv_d0(f32x16* o, int vb, bf16x8 pa0, bf16x8 pa1, bf16x8 pa2, bf16x8 pa3) {
  pv_one<0>(o[0], vb, pa0, pa1, pa2, pa3); pv_one<1>(o[1], vb, pa0, pa1, pa2, pa3); pv_one<2>(o[2], vb, pa0, pa1, pa2, pa3); pv_one<3>(o[3], vb, pa0, pa1, pa2, pa3);
}

__device__ __forceinline__ void attn_item(const bf16_t* __restrict__ Qb, const bf16_t* __restrict__ Kh, const bf16_t* __restrict__ Vh, bf16_t* __restrict__ Ub,
                                          int q0, float nsl2, float lam, const float* __restrict__ normw, char* lds) {
  constexpr int LDK = PLD;
  int tid = threadIdx.x; asm volatile("" : "+v"(tid));
  const int wid = tid >> 6, lane = tid & 63, r32 = lane & 31, hi = lane >> 5, rg = wid >> 1, cmap = wid & 1, cm = cmap * 64;
  char* V_lds = lds; char* K_lds = lds + 2 * SHM_V;
  float* ws = (float*)(lds + 2 * SHM_V + 2 * SHM_K) + wid * 64; float* li_l = ws; float* al_l = ws + 32;
  float m_reg = -1e30f, l_reg = 0; f32x16 o[4] = {}; bf16x8 qr[4];
  const bf16_t* Qw = Qb + (size_t)(rg * 32 + r32) * LDK + cm + hi * 8;
#pragma unroll
  for (int d0 = 0; d0 < 4; ++d0) qr[d0] = *reinterpret_cast<const bf16x8*>(Qw + d0 * 16);
  const int sr = tid >> 4, sc = (tid & 15) * 8, vst0 = v_st(sr, sc), vst1 = v_st(32 + sr, sc);
  const int vb0 = (int)(uintptr_t)V_lds + v_rd_base(lane);
  const float qposh = (float)(q0 + rg * 32 + r32 - 4 * hi);
  struct { bf16x8 vs0, vs1, ks0, ks1; } sr_[2];
#define SLOAD(i, k0) do { sr_[i].vs0 = *reinterpret_cast<const bf16x8*>(&Vh[(size_t)((k0) + sr) * LDK + sc]); sr_[i].vs1 = *reinterpret_cast<const bf16x8*>(&Vh[(size_t)((k0) + 32 + sr) * LDK + sc]); \
    sr_[i].ks0 = *reinterpret_cast<const bf16x8*>(&Kh[(size_t)((k0) + sr) * LDK + sc]); sr_[i].ks1 = *reinterpret_cast<const bf16x8*>(&Kh[(size_t)((k0) + 32 + sr) * LDK + sc]); } while (0)
#define SWRITE(b, i) do { *(bf16x8*)(V_lds + (b) * SHM_V + vst0) = sr_[i].vs0;          \
    *(bf16x8*)(V_lds + (b) * SHM_V + vst1) = sr_[i].vs1; int kc = sc * 2;               \
    *(bf16x8*)(K_lds + (b) * SHM_K + AT_KSWZ(sr, kc)) = sr_[i].ks0;                       \
    *(bf16x8*)(K_lds + (b) * SHM_K + AT_KSWZ(32 + sr, kc)) = sr_[i].ks1; } while (0)
#define SWAIT() asm volatile("s_waitcnt vmcnt(4)" ::: "memory")
#define RESC(a) do { if (__any((a) < 1.f)) { if (hi == 0) al_l[r32] = (a); asm volatile("s_waitcnt lgkmcnt(0)" ::: "memory"); \
    _Pragma("unroll") for (int d = 0; d < 4; ++d) _Pragma("unroll") for (int r = 0; r < 16; ++r) o[d][r] *= al_l[crow(r, hi)]; } } while (0)
  f32x16 pA0, pA1, pB0, pB1; float mnA, mnB, alA, alB; bf16x8 pa0, pa1, pa2, pa3; constexpr int NTL = S / KVBLK;
  constexpr int SE = 0, SO = 1;
  SLOAD(SE, 0); asm volatile("s_waitcnt vmcnt(0)" ::: "memory"); SWRITE(0, SE); __syncthreads();
  qkt(pA0, pA1, K_lds, qr, r32, hi, cm); partialSM(pA0, pA1, qposh, nsl2, m_reg, mnA, alA);
  SLOAD(SO, KVBLK); SLOAD(SE, 2 * KVBLK);
  SWAIT(); SWRITE(1, SO); __syncthreads();
  for (int j = 1; j + 1 < NTL; j += 2) {
    AT_SBAR(); qkt(pB0, pB1, K_lds + SHM_K, qr, r32, hi, cm);
    finishSM(pA0, pA1, alA, l_reg, pa0, pa1, pa2, pa3); AT_SBAR();
    SLOAD(SO, (j + 2) * KVBLK); AT_SBAR();
    pv_d0(o, vb0, pa0, pa1, pa2, pa3); partialSM(pB0, pB1, qposh - (float)(j * KVBLK), nsl2, m_reg, mnB, alB);
    __syncthreads(); SWAIT(); SWRITE(0, SE);
    RESC(alB); __syncthreads();
    AT_SBAR(); qkt(pA0, pA1, K_lds, qr, r32, hi, cm);
    finishSM(pB0, pB1, alB, l_reg, pa0, pa1, pa2, pa3); AT_SBAR();
    if (j + 3 < NTL) SLOAD(SE, (j + 3) * KVBLK); AT_SBAR();
    pv_d0(o, vb0 + (int)SHM_V, pa0, pa1, pa2, pa3); partialSM(pA0, pA1, qposh - (float)((j + 1) * KVBLK), nsl2, m_reg, mnA, alA);
    __syncthreads(); SWAIT(); SWRITE(1, SO);
    RESC(alA); __syncthreads();
  }
  AT_SBAR(); qkt(pB0, pB1, K_lds + SHM_K, qr, r32, hi, cm);
  finishSM(pA0, pA1, alA, l_reg, pa0, pa1, pa2, pa3); AT_SBAR();
  pv_d0(o, vb0, pa0, pa1, pa2, pa3); partialSM(pB0, pB1, qposh - (float)((NTL - 1) * KVBLK), nsl2, m_reg, mnB, alB);
  __syncthreads(); RESC(alB);
  finishSM(pB0, pB1, alB, l_reg, pa0, pa1, pa2, pa3); AT_SBAR();
  pv_d0(o, vb0 + (int)SHM_V, pa0, pa1, pa2, pa3);
  if (hi == 0) li_l[r32] = l_reg; asm volatile("s_waitcnt lgkmcnt(0)" ::: "memory");
  float rli[16];
#pragma unroll
  for (int r = 0; r < 16; ++r) rli[r] = __builtin_amdgcn_rcpf(li_l[crow(r, hi)]);
#pragma unroll
  for (int d = 0; d < 4; ++d)
#pragma unroll
    for (int r = 0; r < 16; ++r) o[d][r] *= rli[r];
  __syncthreads();
  float* X = (float*)lds + rg * (32 * 128);
  if (cmap == 1) {
#pragma unroll
    for (int d = 0; d < 4; ++d)
#pragma unroll
      for (int r = 0; r < 16; ++r) X[crow(r, hi) * 128 + d * 32 + r32] = o[d][r];
  }
  __syncthreads();
  if (cmap == 0) {
    float ss[16];
#pragma unroll
    for (int r = 0; r < 16; ++r) ss[r] = 0.f;
#pragma unroll
    for (int d = 0; d < 4; ++d)
#pragma unroll
      for (int r = 0; r < 16; ++r) { const float v = o[d][r] - lam * X[crow(r, hi) * 128 + d * 32 + r32]; o[d][r] = v; ss[r] += v * v; }
#pragma unroll
    for (int r = 0; r < 16; ++r) { float s = ss[r]; s += __shfl_xor(s, 16); s += __shfl_xor(s, 8); s += __shfl_xor(s, 4); s += __shfl_xor(s, 2); s += __shfl_xor(s, 1);
      ss[r] = rsqrtf(s * (1.f / 128.f) + 1e-5f) * (1.f - LAMBDA_INIT); }
    float nw[4];
#pragma unroll
    for (int d = 0; d < 4; ++d) nw[d] = normw[d * 32 + r32];
#pragma unroll
    for (int r = 0; r < 16; ++r) { bf16_t* up = Ub + (size_t)(rg * 32 + crow(r, hi)) * D + r32;
#pragma unroll
      for (int d = 0; d < 4; ++d) up[d * 32] = f2bf(o[d][r] * ss[r] * nw[d]); }
  }
  __syncthreads();
#undef SLOAD
#undef SWRITE
#undef SWAIT
#undef RESC
}
}

__device__ void ph_attn_mfma(const Params& p, char* lds, int* qhead) {
  float lam;
  { float s1 = 0.f, s2 = 0.f; for (int i = 0; i < 64; ++i) { s1 += p.lq1[i] * p.lk1[i]; s2 += p.lq2[i] * p.lk2[i]; } lam = __expf(s1) - __expf(s2) + LAMBDA_INIT; }
  int* qslot = (int*)(lds + 72 * 1024);
  bool more_a = true, more_c = true;
  for (int turn = 0; more_a || more_c; ++turn) {
    const bool do_attn = more_a && (!more_c || (turn & 1) == 0);
    __syncthreads();
    if (threadIdx.x == 0) *qslot = atomicAdd(do_attn ? qhead : qhead + 4, 1);
    __syncthreads();
    const int item = *qslot;
    if (do_attn) {
      if (item >= NB * AH * (S / 128)) { more_a = false; continue; }
      const int qb = item % (S / 128), h = (item / (S / 128)) % AH, b = item / ((S / 128) * AH);
      const float nsl2 = -exp2f(-(float)(h + 1)) * LOG2E;
      const size_t row0 = (size_t)b * S;
      at::attn_item(p.proj + (row0 + qb * 128) * PLD + N_Q + h * 128, p.proj + row0 * PLD + N_K + h * 128, p.proj + row0 * PLD + N_V + h * 128,
                    p.u + (row0 + qb * 128) * D + DSSD + h * 128, qb * 128, nsl2, lam, p.attn_norm_w, lds);
    } else {
      if (item >= CVT_ITEMS) { more_c = false; continue; }
      cvt_moe_item(p, item);
    }
  }
}
namespace sd {
using at::bf16x8; using at::s16x4; using at::f32x16; using at::u32x4; using at::crow; using at::cvtpk; using at::v_st; using at::v_rd_base; using at::v_rd_off; using at::tr_read;
constexpr int CH = 64, NCH = S / CH;
constexpr int L_BT = 0, L_CT = 16384, L_XV = 32768, L_TAB = 98304, L_SS = 106496;
constexpr size_t SNAP = 16384;
__device__ __forceinline__ size_t snap_off(int dir, int b, int h, int c) { return ((((size_t)dir * NB + b) * NH + h) * NCH + c) * SNAP; }

__device__ void ph_conv16(const Params& p) {
  constexpr int SEG = 16, NCG = CC / 8, NU = NCG * (T / SEG);
  for (int u = blockIdx.x * NT + threadIdx.x; u < NU; u += gridDim.x * NT) {
    const int cg = u % NCG, seg = u / NCG, t0 = seg * SEG, s0 = t0 % S, chan = cg * 8;
    float w[5][8], bias[8];
#pragma unroll
    for (int j = 0; j < 5; ++j) { const float4 a = *(const float4*)(p.conv_w + j * CC + chan), c = *(const float4*)(p.conv_w + j * CC + chan + 4);
      w[j][0] = a.x; w[j][1] = a.y; w[j][2] = a.z; w[j][3] = a.w; w[j][4] = c.x; w[j][5] = c.y; w[j][6] = c.z; w[j][7] = c.w; }
    { const float4 a = *(const float4*)(p.conv_b + chan), c = *(const float4*)(p.conv_b + chan + 4);
      bias[0] = a.x; bias[1] = a.y; bias[2] = a.z; bias[3] = a.w; bias[4] = c.x; bias[5] = c.y; bias[6] = c.z; bias[7] = c.w; }
    const bf16_t* base = p.proj + (size_t)t0 * PLD + N_XBC + chan;
    u32x4 rows[SEG + 4];
#pragma unroll
    for (int i = 0; i < SEG + 4; ++i) { const int s = s0 + i - 2; rows[i] = (u32x4){0u, 0u, 0u, 0u}; if (s >= 0 && s < S) rows[i] = *(const u32x4*)(base + (ptrdiff_t)(i - 2) * PLD); }
#pragma unroll
    for (int i = 0; i < SEG; ++i) {
      float o[8];
#pragma unroll
      for (int c = 0; c < 8; ++c) o[c] = bias[c];
#pragma unroll
      for (int j = 0; j < 5; ++j) { const u32x4 rr = rows[i + j];
        o[0] += w[j][0] * __uint_as_float(rr.x << 16); o[1] += w[j][1] * __uint_as_float(rr.x & 0xffff0000u);
        o[2] += w[j][2] * __uint_as_float(rr.y << 16); o[3] += w[j][3] * __uint_as_float(rr.y & 0xffff0000u);
        o[4] += w[j][4] * __uint_as_float(rr.z << 16); o[5] += w[j][5] * __uint_as_float(rr.z & 0xffff0000u);
        o[6] += w[j][6] * __uint_as_float(rr.w << 16); o[7] += w[j][7] * __uint_as_float(rr.w & 0xffff0000u); }
#pragma unroll
      for (int c = 0; c < 8; ++c) o[c] = o[c] * __builtin_amdgcn_rcpf(1.f + __expf(-o[c]));
      u32x4 pk; pk.x = cvtpk(o[0], o[1]); pk.y = cvtpk(o[2], o[3]); pk.z = cvtpk(o[4], o[5]); pk.w = cvtpk(o[6], o[7]);
      *(u32x4*)(p.xc16 + (size_t)(t0 + i) * CC + chan) = pk;
    }
  }
}
template <bool WITH_C, bool BV>
__device__ __forceinline__ void load_chunk(const Params& p, char* lds, int b, int g, int c0) {
  constexpr int NCG = WITH_C ? 96 : 80, NP = NCG * CH / NT;
  int tid = threadIdx.x; asm volatile("" : "+v"(tid));
  const bf16_t* src = p.xc16 + ((size_t)b * S + c0) * CC;
  u32x4 v[NP];
#pragma unroll
  for (int i = 0; i < NP; ++i) { const int idx = tid + NT * i, tok = idx / NCG, cg = idx % NCG;
    const int chan = cg < 64 ? g * 512 + cg * 8 : (cg < 80 ? 1024 + g * 128 + (cg - 64) * 8 : 1280 + g * 128 + (cg - 80) * 8);
    v[i] = *(const u32x4*)(src + (size_t)tok * CC + chan); }
#pragma unroll
  for (int i = 0; i < NP; ++i) { const int idx = tid + NT * i, tok = idx / NCG, cg = idx % NCG;
    if (cg < 64) { const int hl = cg >> 3, c = (hl & 1) * 64 + (cg & 7) * 8; *(u32x4*)(lds + L_XV + (hl >> 1) * 16384 + v_st(tok, c)) = v[i]; }
    else if (cg < 80) { const int n0 = (cg - 64) * 8; if (BV) *(u32x4*)(lds + L_BT + v_st(tok, n0)) = v[i]; else *(u32x4*)(lds + L_BT + AT_KSWZ(tok, n0 * 2)) = v[i]; }
    else { const int n0 = (cg - 80) * 8; *(u32x4*)(lds + L_CT + AT_KSWZ(tok, n0 * 2)) = v[i]; } }
}
__device__ __forceinline__ float wave_incl_prefix(float v, int lane) {
#pragma unroll
  for (int o = 1; o < 64; o <<= 1) { const float t = __int_as_float(__builtin_amdgcn_ds_bpermute(((lane - o) & 63) << 2, __float_as_int(v))); if (lane >= o) v += t; }
  return v;
}
__device__ __forceinline__ float wave_incl_suffix(float v, int lane) {
#pragma unroll
  for (int o = 1; o < 64; o <<= 1) { const float t = __int_as_float(__builtin_amdgcn_ds_bpermute(((lane + o) & 63) << 2, __float_as_int(v))); if (lane + o < 64) v += t; }
  return v;
}
__device__ __forceinline__ float wave_bcast(float v, int src) { return __int_as_float(__builtin_amdgcn_ds_bpermute(src << 2, __float_as_int(v))); }
__device__ __forceinline__ bf16x8 scale_frag(s16x4 lo, s16x4 hi, const float4 w0, const float4 w1) {
  const unsigned a = ((unsigned)(unsigned short)lo[0]) | ((unsigned)(unsigned short)lo[1] << 16), b = ((unsigned)(unsigned short)lo[2]) | ((unsigned)(unsigned short)lo[3] << 16);
  const unsigned c = ((unsigned)(unsigned short)hi[0]) | ((unsigned)(unsigned short)hi[1] << 16), d = ((unsigned)(unsigned short)hi[2]) | ((unsigned)(unsigned short)hi[3] << 16);
  u32x4 r;
  r.x = cvtpk(__uint_as_float(a << 16) * w0.x, __uint_as_float(a & 0xffff0000u) * w0.y);
  r.y = cvtpk(__uint_as_float(b << 16) * w0.z, __uint_as_float(b & 0xffff0000u) * w0.w);
  r.z = cvtpk(__uint_as_float(c << 16) * w1.x, __uint_as_float(c & 0xffff0000u) * w1.y);
  r.w = cvtpk(__uint_as_float(d << 16) * w1.z, __uint_as_float(d & 0xffff0000u) * w1.w);
  return *reinterpret_cast<bf16x8*>(&r);
}
#define SD_PK(L, H) (bf16x8){L[0], L[1], L[2], L[3], H[0], H[1], H[2], H[3]}

__device__ __forceinline__ void pass_a_item(const Params& p, char* lds, char* snap, int b, int g, int dir) {
  int tid = threadIdx.x; asm volatile("" : "+v"(tid));
  const int hl = tid >> 6, lane = tid & 63, r32 = lane & 31, hi = lane >> 5, h = g * 8 + hl;
  const float a = -__expf(dir ? p.a_log_b[h] : p.a_log_f[h]);
  float* wtab = (float*)(lds + L_TAB) + hl * 64;
  const int vbx = (int)(uintptr_t)(lds + L_XV + (hl >> 1) * 16384) + v_rd_base(lane) + (hl & 1) * 1024;
  const int vbb = (int)(uintptr_t)(lds + L_BT) + v_rd_base(lane);
  f32x16 st[4][2];
#pragma unroll
  for (int nb = 0; nb < 4; ++nb)
#pragma unroll
    for (int pb = 0; pb < 2; ++pb) st[nb][pb] = f32x16{};
  for (int ci = 0; ci < NCH; ++ci) {
    const int c = dir ? (NCH - 1 - ci) : ci, c0 = c * CH;
    __syncthreads();
    load_chunk<false, true>(p, lds, b, g, c0);
    const float dtv = p.dt[((size_t)b * S + c0 + lane) * 32 + dir * 16 + h];
    const float adt = a * dtv;
    const float cum = dir ? wave_incl_suffix(adt, lane) : wave_incl_prefix(adt, lane);
    const float total = wave_bcast(cum, dir ? 0 : 63);
    wtab[lane] = __expf(total - cum) * dtv;
    const float dec = __expf(total);
    { char* sp = snap + snap_off(dir, b, h, c);
#pragma unroll
      for (int nb = 0; nb < 4; ++nb)
#pragma unroll
        for (int pb = 0; pb < 2; ++pb)
#pragma unroll
          for (int q = 0; q < 4; ++q) { const f32x16& s = st[nb][pb];
            uint2 v; v.x = cvtpk(s[4 * q + 0], s[4 * q + 1]); v.y = cvtpk(s[4 * q + 2], s[4 * q + 3]);
            *(uint2*)(sp + ((((pb * 8 + nb * 2 + (q >> 1)) * 2 + (q & 1)) * 32 + r32) * 16 + hi * 8)) = v; } }
#pragma unroll
    for (int nb = 0; nb < 4; ++nb)
#pragma unroll
      for (int pb = 0; pb < 2; ++pb)
#pragma unroll
        for (int r = 0; r < 16; ++r) st[nb][pb][r] *= dec;
    __syncthreads();
#pragma unroll
    for (int ks = 0; ks < 4; ++ks) {
      const float4 w0 = *(const float4*)(wtab + ks * 16 + hi * 8), w1 = *(const float4*)(wtab + ks * 16 + hi * 8 + 4);
      bf16x8 xf[2];
      { const s16x4 l0 = tr_read<v_rd_off(0, 0, 0)>(vbx + ks * 4096), h0 = tr_read<v_rd_off(0, 0, 1)>(vbx + ks * 4096), l1 = tr_read<v_rd_off(1, 0, 0)>(vbx + ks * 4096), h1 = tr_read<v_rd_off(1, 0, 1)>(vbx + ks * 4096);
        asm volatile("s_waitcnt lgkmcnt(0)" ::: "memory"); AT_SBAR();
        xf[0] = scale_frag(l0, h0, w0, w1); xf[1] = scale_frag(l1, h1, w0, w1); }
#pragma unroll
      for (int nb = 0; nb < 4; ++nb) {
        s16x4 bl, bh;
        asm volatile("ds_read_b64_tr_b16 %0, %1" : "=&v"(bl) : "v"(vbb + nb * 512 + ks * 4096) : "memory");
        asm volatile("ds_read_b64_tr_b16 %0, %1 offset:2048" : "=&v"(bh) : "v"(vbb + nb * 512 + ks * 4096) : "memory");
        asm volatile("s_waitcnt lgkmcnt(0)" ::: "memory"); AT_SBAR();
        const bf16x8 bfr = SD_PK(bl, bh);
        st[nb][0] = __builtin_amdgcn_mfma_f32_32x32x16_bf16(bfr, xf[0], st[nb][0], 0, 0, 0);
        st[nb][1] = __builtin_amdgcn_mfma_f32_32x32x16_bf16(bfr, xf[1], st[nb][1], 0, 0, 0);
      }
    }
  }
  __syncthreads();
}

__device__ __forceinline__ void pass_b_item(const Params& p, char* lds, const char* snap, int b, int g, int c) {
  int tid = threadIdx.x; asm volatile("" : "+v"(tid));
  const int hl = tid >> 6, lane = tid & 63, r32 = lane & 31, hi = lane >> 5, h = g * 8 + hl, c0 = c * CH;
  float4* tab = (float4*)(lds + L_TAB) + hl * 64;
  float* ssp = (float*)(lds + L_SS);
  const int vbx = (int)(uintptr_t)(lds + L_XV + (hl >> 1) * 16384) + v_rd_base(lane) + (hl & 1) * 1024;
  __syncthreads();
  load_chunk<true, false>(p, lds, b, g, c0);
  { const size_t tok = (size_t)b * S + c0 + lane;
    const float dtf = p.dt[tok * 32 + h], dtb = p.dt[tok * 32 + 16 + h];
    const float af = -__expf(p.a_log_f[h]) * dtf, ab = -__expf(p.a_log_b[h]) * dtb;
    tab[lane] = make_float4(wave_incl_prefix(af, lane) * LOG2E, wave_incl_suffix(ab, lane) * LOG2E, dtf, dtb); }
  __syncthreads();
  const float dsk = p.d_skip[h];
  f32x16 o[2][2];
#pragma unroll
  for (int lb = 0; lb < 2; ++lb) {
    const int l = lb * 32 + r32;
    const float4 tl = tab[l];
    bf16x8 cr[8];
#pragma unroll
    for (int kk = 0; kk < 8; ++kk) cr[kk] = *reinterpret_cast<const bf16x8*>(lds + L_CT + AT_KSWZ(l, (kk * 16 + hi * 8) * 2));
    f32x16 p0 = f32x16{}, p1 = f32x16{};
#pragma unroll
    for (int kk = 0; kk < 8; ++kk) { const int cb = (kk * 16 + hi * 8) * 2;
      const bf16x8 b0 = *reinterpret_cast<const bf16x8*>(lds + L_BT + AT_KSWZ(r32, cb));
      const bf16x8 b1 = *reinterpret_cast<const bf16x8*>(lds + L_BT + AT_KSWZ(32 + r32, cb));
      p0 = __builtin_amdgcn_mfma_f32_32x32x16_bf16(b0, cr[kk], p0, 0, 0, 0);
      p1 = __builtin_amdgcn_mfma_f32_32x32x16_bf16(b1, cr[kk], p1, 0, 0, 0); }
#pragma unroll
    for (int r = 0; r < 16; ++r) {
#pragma unroll
      for (int half = 0; half < 2; ++half) {
        const int s = crow(r, hi) + 32 * half; const float4 ts = tab[s];
        float m = 0.f;
        if (s <= l) m += __builtin_amdgcn_exp2f(tl.x - ts.x) * ts.z;
        if (s >= l) m += __builtin_amdgcn_exp2f(tl.y - ts.y) * ts.w;
        const float add = (s == l) ? dsk : 0.f;
        if (half) p1[r] = p1[r] * m + add; else p0[r] = p0[r] * m + add;
      }
      asm volatile("" ::: "memory");
    }
    bf16x8 pa0, pa1, pa2, pa3;
#define SD_PK4(P, BASE, OUT) do { unsigned a0 = cvtpk(P[BASE + 0], P[BASE + 1]), a1 = cvtpk(P[BASE + 2], P[BASE + 3]);   \
    unsigned b0_ = cvtpk(P[BASE + 4], P[BASE + 5]), b1_ = cvtpk(P[BASE + 6], P[BASE + 7]);                              \
    auto r0 = __builtin_amdgcn_permlane32_swap(a0, b0_, false, false); auto r1 = __builtin_amdgcn_permlane32_swap(a1, b1_, false, false); \
    u32x4 w_ = {r0[0], r1[0], r0[1], r1[1]}; OUT = *reinterpret_cast<bf16x8*>(&w_); } while (0)
    SD_PK4(p0, 0, pa0); SD_PK4(p0, 8, pa1); SD_PK4(p1, 0, pa2); SD_PK4(p1, 8, pa3);
#undef SD_PK4
#pragma unroll
    for (int d = 0; d < 2; ++d) {
      const s16x4 l0 = d ? tr_read<v_rd_off(1, 0, 0)>(vbx) : tr_read<v_rd_off(0, 0, 0)>(vbx), h0 = d ? tr_read<v_rd_off(1, 0, 1)>(vbx) : tr_read<v_rd_off(0, 0, 1)>(vbx);
      const s16x4 l1 = d ? tr_read<v_rd_off(1, 1, 0)>(vbx) : tr_read<v_rd_off(0, 1, 0)>(vbx), h1 = d ? tr_read<v_rd_off(1, 1, 1)>(vbx) : tr_read<v_rd_off(0, 1, 1)>(vbx);
      const s16x4 l2 = d ? tr_read<v_rd_off(1, 2, 0)>(vbx) : tr_read<v_rd_off(0, 2, 0)>(vbx), h2 = d ? tr_read<v_rd_off(1, 2, 1)>(vbx) : tr_read<v_rd_off(0, 2, 1)>(vbx);
      const s16x4 l3 = d ? tr_read<v_rd_off(1, 3, 0)>(vbx) : tr_read<v_rd_off(0, 3, 0)>(vbx), h3 = d ? tr_read<v_rd_off(1, 3, 1)>(vbx) : tr_read<v_rd_off(0, 3, 1)>(vbx);
      asm volatile("s_waitcnt lgkmcnt(0)" ::: "memory"); AT_SBAR();
      f32x16 od = f32x16{};
      od = __builtin_amdgcn_mfma_f32_32x32x16_bf16(pa0, SD_PK(l0, h0), od, 0, 0, 0);
      od = __builtin_amdgcn_mfma_f32_32x32x16_bf16(pa1, SD_PK(l1, h1), od, 0, 0, 0);
      od = __builtin_amdgcn_mfma_f32_32x32x16_bf16(pa2, SD_PK(l2, h2), od, 0, 0, 0);
      od = __builtin_amdgcn_mfma_f32_32x32x16_bf16(pa3, SD_PK(l3, h3), od, 0, 0, 0);
      o[lb][d] = od;
    }
  }
#pragma unroll
  for (int dir = 0; dir < 2; ++dir) {
    if (dir == 0 ? (c == 0) : (c == NCH - 1)) continue;
    const char* sp = snap + snap_off(dir, b, h, c);
#pragma unroll
    for (int d = 0; d < 2; ++d) {
      bf16x8 sf[8];
#pragma unroll
      for (int kk = 0; kk < 8; ++kk) sf[kk] = *reinterpret_cast<const bf16x8*>(sp + ((((d * 8 + kk) * 2 + hi) * 32 + r32) * 16));
#pragma unroll
      for (int lb = 0; lb < 2; ++lb) {
        f32x16 acc = f32x16{};
#pragma unroll
        for (int kk = 0; kk < 8; ++kk) { const bf16x8 cf = *reinterpret_cast<const bf16x8*>(lds + L_CT + AT_KSWZ(lb * 32 + r32, (kk * 16 + hi * 8) * 2));
          acc = __builtin_amdgcn_mfma_f32_32x32x16_bf16(cf, sf[kk], acc, 0, 0, 0); }
#pragma unroll
        for (int r = 0; r < 16; ++r) { const float4 tr = tab[lb * 32 + crow(r, hi)]; o[lb][d][r] += __builtin_amdgcn_exp2f(dir ? tr.y : tr.x) * acc[r]; }
      }
      asm volatile("" ::: "memory");
    }
  }
  asm volatile("" ::: "memory");
  const bf16_t* zp = p.proj + ((size_t)b * S + c0) * PLD + N_Z + h * HD + r32;
#pragma unroll
  for (int lb = 0; lb < 2; ++lb)
#pragma unroll
    for (int r = 0; r < 16; ++r) { const int l = lb * 32 + crow(r, hi); float ss = 0.f;
#pragma unroll
      for (int d = 0; d < 2; ++d) { const float z = bf2f(zp[(size_t)l * PLD + d * 32]); const float y = o[lb][d][r] * z * __builtin_amdgcn_rcpf(1.f + __expf(-z)); o[lb][d][r] = y; ss += y * y; }
      ss += __shfl_xor(ss, 16); ss += __shfl_xor(ss, 8); ss += __shfl_xor(ss, 4); ss += __shfl_xor(ss, 2); ss += __shfl_xor(ss, 1);
      if (r32 == 0) ssp[hl * 64 + l] = ss;
      if ((r & 3) == 3) asm volatile("" ::: "memory"); }
  __syncthreads();
  const float nw0 = p.ssd_norm_w[h * HD + r32], nw1 = p.ssd_norm_w[h * HD + 32 + r32];
  bf16_t* up = p.u + ((size_t)b * S + c0) * D + h * HD + r32;
#pragma unroll
  for (int lb = 0; lb < 2; ++lb)
#pragma unroll
    for (int r = 0; r < 16; ++r) { const int l = lb * 32 + crow(r, hi); float ss = 0.f;
#pragma unroll
      for (int q = 0; q < 8; ++q) ss += ssp[q * 64 + l];
      const float rstd = rsqrtf(ss * (1.f / 512.f) + 1e-5f);
      up[(size_t)l * D] = f2bf(o[lb][0][r] * rstd * nw0); up[(size_t)l * D + 32] = f2bf(o[lb][1][r] * rstd * nw1); }
}
}

__device__ void ph_ssd_a(const Params& p, char* lds, char* snap) {
  for (int item = blockIdx.x; item < NB * 2 * 2; item += gridDim.x) { const int dir = item & 1, g = (item >> 1) & 1, b = item >> 2; sd::pass_a_item(p, lds, snap, b, g, dir); }
}
__device__ void ph_ssd_b(const Params& p, char* lds, const char* snap) {
  for (int item = blockIdx.x; item < NB * 2 * sd::NCH; item += gridDim.x) { const int c = item % sd::NCH, g = (item / sd::NCH) & 1, b = item / (2 * sd::NCH); sd::pass_b_item(p, lds, snap, b, g, c); }
}
__device__ void ph_inproj(const Params& p, LAS unsigned char* lds) {
  pg8::Gemm g{p.xb, p.WinT, D, 0, 0}; pg8::OrderStatic Sd; Sd.init(T, NPROJ, gridDim.x, blockIdx.x);
  EpiProj E{p.proj, p.dt, p.dt_bias_f, p.dt_bias_b};
  pg8::gemm_phase<false, false>(lds, g, Sd, E);
}
__device__ void ph_outproj(const Params& p, LAS unsigned char* lds) {
  pg8::Gemm g{p.u, p.WoutT, D, 0, 0}; pg8::OrderStatic Sd; Sd.init(T, D, gridDim.x, blockIdx.x);
  EpiOut E{p.x, p.h1};
  pg8::gemm_phase<false, false>(lds, g, Sd, E);
}
__device__ __forceinline__ int ld_agent(const int* p) { return __hip_atomic_load(p, __ATOMIC_RELAXED, __HIP_MEMORY_SCOPE_AGENT); }
__device__ __forceinline__ float ld_agent(const float* p) { return __hip_atomic_load(p, __ATOMIC_RELAXED, __HIP_MEMORY_SCOPE_AGENT); }
__device__ void ph_ln_route(const Params& p, char* ldsg, LAS unsigned char* lds) {
  typedef short bf16x8 __attribute__((ext_vector_type(8)));
  LAS int* cntl = (LAS int*)lds;
  int tid = threadIdx.x; asm volatile("" : "+v"(tid));
  const int lane = tid & 63, wv = tid >> 6;
  float* lg = (float*)(ldsg + 1024) + wv * 512;
  float gm[32], bt[32];
#pragma unroll
  for (int g = 0; g < 4; ++g) { const f32x4 a = *(const f32x4*)(p.ln1_g + g * 512 + lane * 8), b = *(const f32x4*)(p.ln1_g + g * 512 + lane * 8 + 4);
    const f32x4 c = *(const f32x4*)(p.ln1_b + g * 512 + lane * 8), d = *(const f32x4*)(p.ln1_b + g * 512 + lane * 8 + 4);
#pragma unroll
    for (int j = 0; j < 4; ++j) { gm[g * 8 + j] = a[j]; gm[g * 8 + 4 + j] = b[j]; bt[g * 8 + j] = c[j]; bt[g * 8 + 4 + j] = d[j]; } }
  const float rbias = p.router_bias[lane];
  for (int tb = blockIdx.x; tb < T / 64; tb += gridDim.x) {
    __syncthreads();
    if (tid < NE) cntl[tid] = 0;
    const int t0 = tb * 64 + wv * 8;
    for (int i = 0; i < 8; ++i) {
      const float* vp = p.h1 + (size_t)(t0 + i) * D; float v[32]; float s = 0.f;
#pragma unroll
      for (int g = 0; g < 4; ++g) { const f32x4 a = *(const f32x4*)(vp + g * 512 + lane * 8), b = *(const f32x4*)(vp + g * 512 + lane * 8 + 4);
#pragma unroll
        for (int j = 0; j < 4; ++j) { v[g * 8 + j] = a[j]; v[g * 8 + 4 + j] = b[j]; s += a[j] + b[j]; } }
      const float mu = wave_sum(s) * (1.f / D); float q = 0.f;
#pragma unroll
      for (int j = 0; j < 32; ++j) { const float d = v[j] - mu; q += d * d; }
      const float rstd = rsqrtf(wave_sum(q) * (1.f / D) + 1e-5f);
#pragma unroll
      for (int g = 0; g < 4; ++g) { float o[8];
#pragma unroll
        for (int j = 0; j < 8; ++j) o[j] = (v[g * 8 + j] - mu) * rstd * gm[g * 8 + j] + bt[g * 8 + j];
        u32x4 w; w.x = cvt_pk_bf16(o[0], o[1]); w.y = cvt_pk_bf16(o[2], o[3]); w.z = cvt_pk_bf16(o[4], o[5]); w.w = cvt_pk_bf16(o[6], o[7]);
        *(u32x4*)(p.h1b + (size_t)(t0 + i) * D + g * 512 + lane * 8) = w;
        uint2 w8; { int a = 0, b = 0; a = __builtin_amdgcn_cvt_pk_fp8_f32(o[0], o[1], a, false); a = __builtin_amdgcn_cvt_pk_fp8_f32(o[2], o[3], a, true); b = __builtin_amdgcn_cvt_pk_fp8_f32(o[4], o[5], b, false); b = __builtin_amdgcn_cvt_pk_fp8_f32(o[6], o[7], b, true); w8.x = (unsigned)a; w8.y = (unsigned)b; }
        *(uint2*)(p.h1q + (size_t)(t0 + i) * D + g * 512 + lane * 8) = w8; }
    }
    __threadfence_block(); asm volatile("s_waitcnt vmcnt(0)" ::: "memory");
    f32x4 acc[4];
#pragma unroll
    for (int nb = 0; nb < 4; ++nb) acc[nb] = (f32x4){0.f, 0.f, 0.f, 0.f};
    const bf16_t* ap = p.h1b + (size_t)(t0 + (lane & 7)) * D + 8 * (lane >> 4);
    const bf16_t* bp = p.WrT + (size_t)(lane & 15) * D + 8 * (lane >> 4);
#pragma unroll 4
    for (int kk = 0; kk < D / 32; ++kk) {
      const bf16x8 a = *(const bf16x8*)(ap + kk * 32);
#pragma unroll
      for (int nb = 0; nb < 4; ++nb) { const bf16x8 b = *(const bf16x8*)(bp + (size_t)nb * 16 * D + kk * 32); acc[nb] = __builtin_amdgcn_mfma_f32_16x16x32_bf16(a, b, acc[nb], 0, 0, 0); }
    }
    if ((lane >> 4) < 2) {
#pragma unroll
      for (int nb = 0; nb < 4; ++nb)
#pragma unroll
        for (int i = 0; i < 4; ++i) lg[(4 * (lane >> 4) + i) * 64 + nb * 16 + (lane & 15)] = acc[nb][i];
    }
    __syncthreads();
    for (int ti = 0; ti < 8; ++ti) {
      const int t = t0 + ti;
      const float sc = 1.f / (1.f + __expf(-lg[ti * 64 + lane]));
      const float bz = sc + rbias;
      int rk = 0;
#pragma unroll
      for (int j = 1; j < 8; ++j) { const float o = __shfl_xor(bz, j); const int oi = lane ^ j; rk += (o > bz || (o == bz && oi < lane)) ? 1 : 0; }
      float gs = rk < 2 ? bz : 0.f;
      gs += __shfl_xor(gs, 1); gs += __shfl_xor(gs, 2); gs += __shfl_xor(gs, 4);
      const int g = lane >> 3; int grk = 0;
#pragma unroll
      for (int j = 1; j < 8; ++j) { const float o = __shfl_xor(gs, j * 8); const int og = g ^ j; grk += (o > gs || (o == gs && og < g)) ? 1 : 0; }
      const bool gsel = grk < 4;
      const float mb = gsel ? bz : -INFINITY;
      int erk = 0;
      for (int j = 1; j < 64; ++j) { const float o = __shfl_xor(mb, j); const int oi = lane ^ j; erk += (o > mb || (o == mb && oi < lane)) ? 1 : 0; }
      const bool sel = gsel && erk < 8;
      const float gsum = wave_sum(sel ? sc : 0.f);
      if (sel) {
        const int lr = __hip_atomic_fetch_add(&cntl[lane], 1, __ATOMIC_RELAXED, __HIP_MEMORY_SCOPE_WORKGROUP);
        p.assign[t * 8 + erk] = lane | (lr << 8); p.gate[t * 8 + erk] = sc / gsum * 2.5f;
      }
    }
    __syncthreads();
    if (tid < NE) p.blkcnt[tb * NE + tid] = cntl[tid];
  }
}
__device__ void ph_place(const Params& p, LAS unsigned char* lds) {
  LAS int* part = (LAS int*)lds;
  LAS int* parta = part + 512;
  LAS int* base = parta + 512;
  LAS int* total = base + 64;
  LAS int* pstart = total + 64;
  const int tid = threadIdx.x, e = tid & 63, pt = tid >> 6;
  for (int tb = blockIdx.x; tb < T / 64; tb += gridDim.x) {
    __syncthreads();
    int slo = 0, sall = 0;
    for (int b = pt * 32; b < pt * 32 + 32; ++b) { const int c = ld_agent(p.blkcnt + b * NE + e); sall += c; slo += (b < tb) ? c : 0; }
    part[pt * 64 + e] = slo; parta[pt * 64 + e] = sall;
    __syncthreads();
    if (tid < 64) {
      int b0 = 0, t0 = 0;
#pragma unroll
      for (int q = 0; q < 8; ++q) { b0 += part[q * 64 + tid]; t0 += parta[q * 64 + tid]; }
      base[tid] = b0; total[tid] = t0;
      const int padded = (t0 + 255) & ~255;
      int incl = padded;
      for (int o = 1; o < 64; o <<= 1) { const int v = __shfl_up(incl, o); if (tid >= o) incl += v; }
      pstart[tid] = incl - padded;
      if (tid == 63) pstart[64] = incl;
    }
    __syncthreads();
    {
      const int t = tb * 64 + (tid >> 3), k = tid & 7;
      const int a = ld_agent(p.assign + t * 8 + k), ee = a & 255, lr = a >> 8;
      const int row = pstart[ee] + base[ee] + lr;
      p.row_tok[row] = t; p.row_gate[row] = ld_agent(p.gate + t * 8 + k); p.pos[t * 8 + k] = row;
      if (tid < 64) { const int srow = pstart[64] + tb * 64 + tid; p.row_tok[srow] = tb * 64 + tid; p.row_gate[srow] = 1.0f; }
    }
    if (tb == blockIdx.x) {
      for (int e2 = blockIdx.x; e2 < NE; e2 += gridDim.x) {
        const int r0 = pstart[e2] + total[e2], r1 = pstart[e2 + 1];
        for (int r = r0 + tid; r < r1; r += NT) { p.row_tok[r] = 0; p.row_gate[r] = 0.f; }
        for (int j = pstart[e2] / 256 + tid; j < r1 / 256; j += NT) p.tile_exp[j] = e2;
      }
      if (blockIdx.x == 0) {
        const int nr = pstart[64] / 256;
        for (int j = tid; j < T / 256; j += NT) p.tile_exp[nr + j] = NE;
        if (tid == 0) { p.meta[0] = nr; p.meta[1] = nr + T / 256; }
      }
    }
  }
}
struct OrderMoE {
  LAS const int* ulist; int n;
  LAS const unsigned* tab; int tstride;
  __device__ __forceinline__ bool next(int i, pg8::Unit& u) const { if (i >= n) return false; u.pm = ulist[i * 4 + 0]; u.pn = ulist[i * 4 + 1]; u.bn = ulist[i * 4 + 2]; u.aux = i; return true; }
  __device__ __forceinline__ unsigned row_off(int i, int row) const { return tab[i * tstride + row]; }
};
template <int TABLES>
__device__ __forceinline__ OrderMoE moe_order(const Params& p, LAS unsigned char* lds, int npn, int tile0, int ntiles, int rowbytes) {
  LAS int* ulist = (LAS int*)(lds + LDS_TAB); LAS unsigned* tab = (LAS unsigned*)(lds + LDS_TAB + 1024);
  const int G = gridDim.x, c = blockIdx.x, mpc = 32 / npn; int n = 0;
  __syncthreads();
  for (int i = 0; i < 60; ++i) {
    int U; if (G == 256) U = ((i * 8 + (c & 7)) * 32 + (c >> 3)); else U = i * G + c;
    const int chunk = U >> 5, w = U & 31, j = chunk * mpc + (w % mpc), pn = w / mpc;
    if (j >= ntiles) break;
    const int tile = tile0 + j, e = ld_agent(p.tile_exp + tile);
    if (threadIdx.x == 0) { ulist[i * 4 + 0] = tile; ulist[i * 4 + 1] = pn; ulist[i * 4 + 2] = e * npn + pn; ulist[i * 4 + 3] = e; }
    if (TABLES == 2) { for (int r = threadIdx.x; r < 256; r += NT) tab[i * 256 + r] = (unsigned)(tile * 256 + r) * (unsigned)rowbytes; }
    if (TABLES == 1) { for (int r = threadIdx.x; r < 256; r += NT) { tab[i * 512 + r] = (unsigned)ld_agent(p.row_tok + tile * 256 + r) * (unsigned)rowbytes; tab[i * 512 + 256 + r] = __float_as_uint(ld_agent(p.row_gate + tile * 256 + r)); } }
    n = i + 1;
  }
  __syncthreads();
  return OrderMoE{ulist, n, tab, TABLES == 2 ? 256 : 512};
}
struct EpiGU {
  static constexpr bool PERM = true;
  unsigned char* H; LAS const unsigned* tab;
  __device__ __forceinline__ void operator()(const f32x4 (&acc)[2][2][4][2], const pg8::Unit& u, int wr, int wc, int fr, int fq) const {
    asm volatile("" : "+v"(fr), "+v"(fq));
    const int col0 = u.pn * 128 + wc * 32 + 8 * fq;
#pragma unroll
    for (int ai = 0; ai < 2; ++ai)
#pragma unroll
      for (int m = 0; m < 4; ++m) { const int r = ai * 128 + wr * 64 + m * 16 + fr; const float gt = __uint_as_float(tab[u.aux * 512 + 256 + r]) * H8S;
        float h[8];
#pragma unroll
        for (int j = 0; j < 4; ++j) { const float g0 = acc[ai][0][m][0][j], g1 = acc[ai][0][m][1][j];
          h[j] = g0 * __builtin_amdgcn_rcpf(1.f + __expf(-g0)) * acc[ai][1][m][0][j] * gt; h[4 + j] = g1 * __builtin_amdgcn_rcpf(1.f + __expf(-g1)) * acc[ai][1][m][1][j] * gt; }
#pragma unroll
        for (int j = 0; j < 8; ++j) h[j] = fminf(fmaxf(h[j], -448.f), 448.f);
        uint2 w; { int a = 0, b = 0; a = __builtin_amdgcn_cvt_pk_fp8_f32(h[0], h[1], a, false); a = __builtin_amdgcn_cvt_pk_fp8_f32(h[2], h[3], a, true); b = __builtin_amdgcn_cvt_pk_fp8_f32(h[4], h[5], b, false); b = __builtin_amdgcn_cvt_pk_fp8_f32(h[6], h[7], b, true); w.x = (unsigned)a; w.y = (unsigned)b; }
        *(uint2*)(H + (size_t)(u.pm * 256 + r) * DE + col0) = w; }
  }
};
__device__ void ph_gateup(const Params& p, LAS unsigned char* lds) {
  const int ntot = ld_agent(p.meta + 1);
  const OrderMoE S = moe_order<1>(p, lds, 4, 0, ntot, D);
  pg8::Gemm g{(const bf16_t*)p.h1q, p.WguT, D / 2, 0x7a7a7a7a  , 0x7f7f7f7f}; EpiGU E{(unsigned char*)p.H, S.tab};
  pg8::gemm_phase<true, true>(lds, g, S, E);
}
struct EpiDown {
  static constexpr bool PERM = true;
  unsigned char* Y;
  __device__ __forceinline__ void operator()(const f32x4 (&acc)[2][2][4][2], const pg8::Unit& u, int wr, int wc, int fr, int fq) const {
    asm volatile("" : "+v"(fr), "+v"(fq));
    const int col0 = u.pn * 256 + wc * 32 + 8 * fq;
#pragma unroll
    for (int ai = 0; ai < 2; ++ai)
#pragma unroll
      for (int m = 0; m < 4; ++m) { unsigned char* rowp = Y + (size_t)(u.pm * 256 + ai * 128 + wr * 64 + m * 16 + fr) * D + col0;
#pragma unroll
        for (int bj = 0; bj < 2; ++bj) { const f32x4 v0 = acc[ai][bj][m][0], v1 = acc[ai][bj][m][1];
          uint2 w; { int a = 0, b = 0; a = __builtin_amdgcn_cvt_pk_fp8_f32(v0[0], v0[1], a, false); a = __builtin_amdgcn_cvt_pk_fp8_f32(v0[2], v0[3], a, true); b = __builtin_amdgcn_cvt_pk_fp8_f32(v1[0], v1[1], b, false); b = __builtin_amdgcn_cvt_pk_fp8_f32(v1[2], v1[3], b, true); w.x = (unsigned)a; w.y = (unsigned)b; }
          *(uint2*)(rowp + bj * 128) = w; } }
  }
};
__device__ void ph_down(const Params& p, LAS unsigned char* lds) {
  const int ntot = ld_agent(p.meta + 1);
  const OrderMoE S = moe_order<2>(p, lds, 8, 0, ntot, DE);
  pg8::Gemm g{p.H, p.WdT, DE / 2, 0x7a7a7a7a  , (int)0x81818181u  }; EpiDown E{(unsigned char*)p.Y};
  pg8::gemm_phase<true, true>(lds, g, S, E);
}
__device__ __forceinline__ void acc_fp8x8(float* v, uint2 w) {
  const auto a = __builtin_amdgcn_cvt_pk_f32_fp8((int)w.x, false), b = __builtin_amdgcn_cvt_pk_f32_fp8((int)w.x, true), c = __builtin_amdgcn_cvt_pk_f32_fp8((int)w.y, false), d = __builtin_amdgcn_cvt_pk_f32_fp8((int)w.y, true);
  v[0] += a[0]; v[1] += a[1]; v[2] += b[0]; v[3] += b[1]; v[4] += c[0]; v[5] += c[1]; v[6] += d[0]; v[7] += d[1];
}
__device__ void ph_combine(const Params& p) {
  const int lane = threadIdx.x & 63, wv = threadIdx.x >> 6;
  const int srow0 = ld_agent(p.meta + 0) * 256;
  const unsigned char* Yb = (const unsigned char*)p.Y;
  for (int row = blockIdx.x * 8 + wv; row < T; row += gridDim.x * 8) {
    float v[32];
#pragma unroll
    for (int j = 0; j < 32; ++j) v[j] = 0.f;
    int yr[8];
#pragma unroll
    for (int k = 0; k < 8; ++k) yr[k] = ld_agent(p.pos + row * 8 + k);
#pragma unroll
    for (int g = 0; g < 4; ++g) acc_fp8x8(v + g * 8, *(const uint2*)(Yb + (size_t)(srow0 + row) * D + g * 512 + lane * 8));
#pragma unroll
    for (int k = 0; k < 8; ++k) {
#pragma unroll
      for (int g = 0; g < 4; ++g) acc_fp8x8(v + g * 8, *(const uint2*)(Yb + (size_t)yr[k] * D + g * 512 + lane * 8)); }
    { const bf16_t* hp = p.h1b + (size_t)row * D;
#pragma unroll
      for (int g = 0; g < 4; ++g) { const u32x4 hb = *(const u32x4*)(hp + g * 512 + lane * 8);
        v[g * 8 + 0] = v[g * 8 + 0] * Y8I + ALPHA * __uint_as_float(hb.x << 16); v[g * 8 + 1] = v[g * 8 + 1] * Y8I + ALPHA * __uint_as_float(hb.x & 0xffff0000u);
        v[g * 8 + 2] = v[g * 8 + 2] * Y8I + ALPHA * __uint_as_float(hb.y << 16); v[g * 8 + 3] = v[g * 8 + 3] * Y8I + ALPHA * __uint_as_float(hb.y & 0xffff0000u);
        v[g * 8 + 4] = v[g * 8 + 4] * Y8I + ALPHA * __uint_as_float(hb.z << 16); v[g * 8 + 5] = v[g * 8 + 5] * Y8I + ALPHA * __uint_as_float(hb.z & 0xffff0000u);
        v[g * 8 + 6] = v[g * 8 + 6] * Y8I + ALPHA * __uint_as_float(hb.w << 16); v[g * 8 + 7] = v[g * 8 + 7] * Y8I + ALPHA * __uint_as_float(hb.w & 0xffff0000u); } }
    float s = 0.f;
#pragma unroll
    for (int j = 0; j < 32; ++j) s += v[j];
    const float mu = wave_sum(s) * (1.f / D); float q = 0.f;
#pragma unroll
    for (int j = 0; j < 32; ++j) { const float d = v[j] - mu; q += d * d; }
    const float rstd = rsqrtf(wave_sum(q) * (1.f / D) + 1e-5f);
    float* op = p.out + (size_t)row * D;
#pragma unroll
    for (int g = 0; g < 4; ++g) { const int c0 = g * 512 + lane * 8; f32x4 a, b;
#pragma unroll
      for (int j = 0; j < 4; ++j) { a[j] = (v[g * 8 + j] - mu) * rstd * p.ln2_g[c0 + j] + p.ln2_b[c0 + j]; b[j] = (v[g * 8 + 4 + j] - mu) * rstd * p.ln2_g[c0 + 4 + j] + p.ln2_b[c0 + 4 + j]; }
      *(f32x4*)(op + c0) = a; *(f32x4*)(op + c0 + 4) = b; }
  }
}

__global__ void __launch_bounds__(NT) k_mega(Params p_arg) {
#if defined(__HIP_DEVICE_COMPILE__)
  extern __shared__ __attribute__((aligned(16))) unsigned char lds_raw[];
  LAS unsigned char* lds = (LAS unsigned char*)lds_raw;
  float* smem = (float*)lds_raw;
#ifndef ONLY
#define ONLY -1
#endif
  typedef const __attribute__((address_space(4))) Params* KP;
  const KP pk = (KP)__builtin_amdgcn_kernarg_segment_ptr();
  volatile LAS unsigned* bst = (volatile LAS unsigned*)(lds + LDS_BYTES - 16);
  if (threadIdx.x == 0) { bst[0] = 0u; bst[1] = 0u; }
  __syncthreads();
  XcdBarrier gbar;
  { KP q_ = pk; asm volatile("" : "+s"(q_)); gbar = xcd_barrier_post(q_->bar, bst); }
#define GSYNC() xcd_barrier(gbar)
#ifndef DUP
#define DUP -1
#endif
#define RUN1(n, pass, call) do { if (ONLY < 0 || ONLY == n) { KP q_ = pk; asm volatile("" : "+s"(q_)); const Params p = *q_; const int dup_pass = pass; (void)dup_pass; call; } } while (0)
#define RUN(n, call) do { RUN1(n, 0, call); if (DUP == n) { GSYNC(); RUN1(n, 1, call); } } while (0)
  RUN(0, ph_convert(p)); GSYNC();
  RUN(1, ph_inproj(p, lds)); GSYNC();
  RUN(2, sd::ph_conv16(p)); GSYNC();
  RUN(3, ph_ssd_a(p, (char*)lds_raw, (char*)p.out)); RUN(4, ph_attn_mfma(p, (char*)lds_raw, p.meta + 8 + dup_pass)); GSYNC();
  RUN(5, ph_ssd_b(p, (char*)lds_raw, (const char*)p.out)); GSYNC();
  RUN(6, ph_outproj(p, lds)); GSYNC();
  RUN(7, ph_ln_route(p, (char*)lds_raw, lds)); GSYNC();
  RUN(10, ph_place(p, lds)); GSYNC();
  RUN(11, ph_gateup(p, lds)); GSYNC();
  RUN(12, ph_down(p, lds)); GSYNC();
  RUN(13, ph_combine(p));
#endif
}
}

extern "C" void kernel_launch(void* const* d_in, const int* in_sizes, int n_in, void* d_out, int out_size, void* d_ws, size_t ws_size, hipStream_t stream) {
  Params p{};
  const float* const* in = (const float* const*)d_in;
  p.x = in[0]; p.w_in = in[1]; p.conv_w = in[2]; p.conv_b = in[3]; p.dt_bias_f = in[4]; p.dt_bias_b = in[5]; p.a_log_f = in[6]; p.a_log_b = in[7];
  p.d_skip = in[8]; p.ssd_norm_w = in[9]; p.lq1 = in[10]; p.lk1 = in[11]; p.lq2 = in[12]; p.lk2 = in[13]; p.attn_norm_w = in[14]; p.w_out = in[15];
  p.ln1_g = in[16]; p.ln1_b = in[17]; p.w_router = in[18]; p.router_bias = in[19]; p.wg_e = in[20]; p.wu_e = in[21]; p.wd_e = in[22];
  p.wg_s = in[23]; p.wu_s = in[24]; p.wd_s = in[25]; p.ln2_g = in[26]; p.ln2_b = in[27];
  p.out = (float*)d_out;
  char* w = (char*)d_ws; size_t o = 0;
  auto take = [&](size_t bytes) { char* r = w + o; o += (bytes + 255) / 256 * 256; return r; };
  char* reg1 = w + o;
  p.xb = (bf16_t*)take((size_t)T * D * 2); p.WinT = (bf16_t*)take((size_t)NPROJ * D * 2); p.WoutT = (bf16_t*)take((size_t)D * D * 2);
  p.WguT = (bf16_t*)take((size_t)(NE + 1) * 1024 * D); p.proj = (bf16_t*)take((size_t)T * PLD * 2); p.u = (bf16_t*)take((size_t)T * D * 2);
  if ((size_t)((w + o) - reg1) < (size_t)MAXROWS * D * 2) take((size_t)MAXROWS * D * 2 - (size_t)((w + o) - reg1));
  const size_t reg1_bytes = (size_t)((w + o) - reg1);
  p.Y = (bf16_t*)reg1;
  if ((size_t)MAXROWS * D * 2 > reg1_bytes) { fprintf(stderr, "kernel_launch: region 1 too small for Y\n"); return; }
  char* reg2 = take((size_t)MAXROWS * DE);
  p.H = (bf16_t*)reg2; p.xc16 = (bf16_t*)reg2;
  p.h1b = (bf16_t*)take((size_t)T * D * 2); p.WdT = (bf16_t*)take((size_t)(NE + 1) * D * DE); p.h1q = (unsigned char*)take((size_t)T * D);
  p.dt = (float*)take((size_t)T * 32 * 4); p.WrT = (bf16_t*)take((size_t)NE * D * 2); p.gate = (float*)take((size_t)T * 8 * 4);
  p.assign = (int*)take((size_t)T * 8 * 4); p.pos = (int*)take((size_t)T * 8 * 4); p.blkcnt = (int*)take((size_t)(T / 64) * NE * 4);
  p.row_tok = (int*)take((size_t)MAXROWS * 4); p.row_gate = (float*)take((size_t)MAXROWS * 4); p.tile_exp = (int*)take((size_t)MAXTILES * 4);
  p.bar = (unsigned*)take((size_t)XCD_BAR_WORDS * 4 + 256); p.meta = (int*)(p.bar + XCD_BAR_WORDS);
  p.h1 = (float*)d_out;
  if (o > ws_size) { fprintf(stderr, "kernel_launch: ws too small: need %zu have %zu\n", o, ws_size); return; }
  static int grid_blocks = 0;
  if (!grid_blocks) {
    int dev = 0, cus = 0, per_cu = 0;
    hipGetDevice(&dev);
    hipDeviceGetAttribute(&cus, hipDeviceAttributeMultiprocessorCount, dev);
    if (hipFuncSetAttribute((const void*)k_mega, hipFuncAttributeMaxDynamicSharedMemorySize, LDS_BYTES) != hipSuccess) { fprintf(stderr, "kernel_launch: hipFuncSetAttribute failed\n"); return; }
    hipOccupancyMaxActiveBlocksPerMultiprocessor(&per_cu, k_mega, NT, LDS_BYTES);
    if (per_cu < 1) { fprintf(stderr, "kernel_launch: occupancy query says 0 blocks/CU\n"); return; }
    grid_blocks = cus;
  }
  if (hipMemsetAsync(p.bar, 0, (size_t)XCD_BAR_WORDS * 4 + 256, stream) != hipSuccess) { fprintf(stderr, "kernel_launch: memset failed\n"); return; }
  hipLaunchKernelGGL(k_mega, dim3(grid_blocks), dim3(NT), LDS_BYTES, stream, p);
  const hipError_t le = hipPeekAtLastError();
  if (le != hipSuccess) fprintf(stderr, "kernel_launch: launch failed: %s (grid %d)\n", hipGetErrorString(le), grid_blocks);
}
```

```cpp
#include <hip/hip_runtime.h>
#include <cstdio>
#include <cstdint>

namespace {
constexpr int D = 2048, NB = 8, S = 2048, T = NB * S;
constexpr int DSSD = 1024, DATT = 1024, NH = 16, HD = 64, NS = 128, CC = 1536;
constexpr int AH = 8, NE = 64, DE = 512, PW = 5664;
constexpr int O_DT = 2560, O_Q = 2592;
constexpr int N_Z = 0, N_XBC = 1024, N_Q = 2560, N_K = 3584, N_V = 4608, PLD = 5632, NPROJ = 5888;
constexpr float ALPHA = 1.189207115002721f;
constexpr float LAMBDA_INIT = 0.2f;
constexpr float LOG2E = 1.4426950408889634f;
constexpr float QS = 0.125f * LOG2E;
constexpr float W8S = 32.f, H8S = 8.f, Y8S = 32.f, Y8I = 1.f / 32.f;
constexpr int NT = 512;
constexpr int LDS_BYTES = 152 * 1024;
constexpr int LDS_TAB = 128 * 1024;
constexpr int MAXROWS_R = NE * 256 + T * 8;
constexpr int MAXROWS = MAXROWS_R + T;
constexpr int MAXTILES = MAXROWS / 256;

typedef unsigned short bf16_t;
#define LAS __attribute__((address_space(3)))

struct Params {
  const float *x, *w_in, *conv_w, *conv_b, *dt_bias_f, *dt_bias_b, *a_log_f, *a_log_b, *d_skip, *ssd_norm_w;
  const float *lq1, *lk1, *lq2, *lk2, *attn_norm_w, *w_out, *ln1_g, *ln1_b, *w_router, *router_bias;
  const float *wg_e, *wu_e, *wd_e, *wg_s, *wu_s, *wd_s, *ln2_g, *ln2_b;
  float* out;
  bf16_t *xb, *WinT, *WoutT, *WguT, *WdT, *proj, *u, *h1b, *H, *Y, *xc16, *WrT;
  float *dt, *h1, *gate, *row_gate, *kn2;
  int *assign, *blkcnt, *row_tok, *pos, *tile_exp, *meta;
  unsigned* bar;
  unsigned char* h1q;
};

__device__ __forceinline__ float silu_f(float x) { return x / (1.f + __expf(-x)); }
__device__ __forceinline__ float softplus_f(float x) { return x > 20.f ? x : log1pf(__expf(x)); }
__device__ __forceinline__ float wave_sum(float v) { for (int o = 32; o >= 1; o >>= 1) v += __shfl_xor(v, o); return v; }
__device__ __forceinline__ float bf2f(bf16_t b) { return __uint_as_float(((unsigned)b) << 16); }
__device__ __forceinline__ bf16_t f2bf(float f) { unsigned u = __float_as_uint(f); u += 0x7FFFu + ((u >> 16) & 1u); return (bf16_t)(u >> 16); }
}

namespace pg8 {
#define PG8_LAS __attribute__((address_space(3)))
typedef unsigned short bf16_t;
typedef short bf16x8 __attribute__((ext_vector_type(8)));
typedef float f32x4 __attribute__((ext_vector_type(4)));
typedef unsigned u32x4 __attribute__((ext_vector_type(4)));
typedef int v8i __attribute__((ext_vector_type(8)));
constexpr int BM = 256, BK = 64, HALF = 128, HTB = HALF * BK * 2  , STAGE_BYTES = 8 * HTB, NXCD = 8, WGM = 8;

__host__ __device__ __forceinline__ int lds_byte(int r, int c) { const int st = (r >> 4) * 2 + (c >> 5), rr = r & 15, cc = c & 31, ob = rr * 64 + cc * 2; return st * 1024 + (ob ^ (((ob >> 9) & 1) << 5)); }
__host__ __device__ __forceinline__ void stage_rc(int b, int& R, int& C) { const int st = b / 1024, sb = b % 1024, swz = sb ^ (((sb >> 9) & 1) << 5); R = (st >> 1) * 16 + swz / 64; C = (st & 1) * 32 + (swz % 64) / 2; }
__host__ __device__ __forceinline__ int perm32(int rho) { const int n = rho >> 4, i = rho & 15; return 8 * (i >> 2) + 4 * n + (i & 3); }

struct Unit { int pm, pn, bn, aux; };
struct Gemm { const bf16_t* A; const bf16_t* Bt; int K; int sc_w, sc_a; };


__device__ __forceinline__ unsigned cvt_pk_bf16(float lo, float hi) { unsigned r; asm volatile("v_cvt_pk_bf16_f32 %0, %1, %2" : "=v"(r) : "v"(lo), "v"(hi)); return r; }
struct OrderStatic {
    int nM, nN, nwg, G, c;
    __device__ void init(int M, int N, int G_, int c_) { nM = M / BM; nN = N / BM; nwg = nM * nN; G = G_; c = c_; }
    __device__ bool next(int i, Unit& u) const {
        const long L = (long)i * G + c; if (L >= nwg) return false;
        int wgid = (int)L; { const int q = nwg / NXCD, r = nwg % NXCD, xcd = wgid % NXCD, off = wgid / NXCD; wgid = (xcd < r ? xcd * (q + 1) : r * (q + 1) + (xcd - r) * q) + off; }
        const int nig = WGM * nN, gid = wgid / nig, fm = gid * WGM, gsz = (nM - fm) < WGM ? (nM - fm) : WGM;
        u.pm = fm + ((wgid % nig) % gsz); u.pn = (wgid % nig) / gsz; u.bn = u.pn; u.aux = i; return true;
    }
    __device__ __forceinline__ unsigned row_off(int, int) const { return 0u; }
};
template <bool GATHER, bool FP8, class Epi, class Sched>
__device__ __forceinline__ void gemm_phase(PG8_LAS unsigned char* lds, const Gemm g, const Sched& S, const Epi& E) {
    int tid = threadIdx.x; asm volatile("" : "+v"(tid));
    const int wid = __builtin_amdgcn_readfirstlane(tid >> 6), lane = tid & 63, wr = wid >> 2, wc = wid & 3, fr = lane & 15, fq = lane >> 4;
    const int K = g.K; int nt = K / BK; asm volatile("" : "+s"(nt));
#define PG8_STAMP() do {} while (0)
    PG8_STAMP();
    unsigned voffA[2], voffB[2];
#pragma unroll
    for (int i = 0; i < 2; ++i) { int R, C; stage_rc(tid * 16 + i * 8192, R, C); const int Rb = Epi::PERM ? ((R & ~31) + perm32(R & 31)) : R;
        voffA[i] = (unsigned)(R * K + C) * 2u; voffB[i] = (unsigned)(Rb * K + C) * 2u; }
    unsigned voffG[2][2] = {{0u, 0u}, {0u, 0u}};
#define PG8_LOADG(uidx) do { if constexpr (GATHER) { _Pragma("unroll") for (int _h = 0; _h < 2; ++_h) _Pragma("unroll") for (int _i = 0; _i < 2; ++_i) { int R_, C_; stage_rc(tid * 16 + _i * 8192, R_, C_); \
        voffG[_h][_i] = S.row_off((uidx), _h * HALF + R_) + (unsigned)C_ * 2u; } } } while (0)
    const size_t kstep = (size_t)(BK * 2);
    const size_t hstep = (size_t)HALF * K * 2;
    const size_t tstep = 2 * hstep;
    const unsigned ldsw = (unsigned)wid * 1024u;
    const int aoff = lds_byte(wr * 64 + fr, fq * 8), boff = lds_byte(wc * 32 + fr, fq * 8);
    const int c8 = (fq >> 1) * 32 + (fq & 1) * 16;
    const int aoff8a = lds_byte(wr * 64 + fr, c8), aoff8b = lds_byte(wr * 64 + fr, c8 + 8), boff8a = lds_byte(wc * 32 + fr, c8), boff8b = lds_byte(wc * 32 + fr, c8 + 8);
#define PG8_SA(b, h) (((b) * 2 + (h)) * HTB)
#define PG8_SB(b, h) ((4 + (b) * 2 + (h)) * HTB)
#define PG8_STAGE(bufoff, gbase, voff) do { _Pragma("unroll") for (int _i = 0; _i < 2; ++_i) \
        __builtin_amdgcn_global_load_lds((const unsigned*)((const char*)(gbase) + (voff)[_i]), (PG8_LAS unsigned*)(lds + (bufoff) + ldsw + _i * 8192), 16, 0, 0); } while (0)
#define PG8_STAGE_A(bufoff, ptr, h) do { if constexpr (GATHER) { PG8_STAGE(bufoff, ptr, voffG[h]); } else { PG8_STAGE(bufoff, (ptr) + (h) * hstep, voffA); } } while (0)
#define PG8_LDA(dst, b, h) do { if constexpr (FP8) { _Pragma("unroll") for (int m = 0; m < 4; ++m) { const u32x4 lo_ = *(const PG8_LAS u32x4*)(lds + PG8_SA(b, h) + aoff8a + m * 2048), hi_ = *(const PG8_LAS u32x4*)(lds + PG8_SA(b, h) + aoff8b + m * 2048); \
        dst##8[m] = (v8i){(int)lo_.x, (int)lo_.y, (int)lo_.z, (int)lo_.w, (int)hi_.x, (int)hi_.y, (int)hi_.z, (int)hi_.w}; } } else { \
        _Pragma("unroll") for (int m = 0; m < 4; ++m) _Pragma("unroll") for (int k = 0; k < 2; ++k) dst[m][k] = *(const PG8_LAS bf16x8*)(lds + PG8_SA(b, h) + aoff + m * 2048 + k * 1024); } } while (0)
#define PG8_LDB(dst, b, h) do { if constexpr (FP8) { _Pragma("unroll") for (int n = 0; n < 2; ++n) { const u32x4 lo_ = *(const PG8_LAS u32x4*)(lds + PG8_SB(b, h) + boff8a + n * 2048), hi_ = *(const PG8_LAS u32x4*)(lds + PG8_SB(b, h) + boff8b + n * 2048); \
        dst##8[n] = (v8i){(int)lo_.x, (int)lo_.y, (int)lo_.z, (int)lo_.w, (int)hi_.x, (int)hi_.y, (int)hi_.z, (int)hi_.w}; } } else { \
        _Pragma("unroll") for (int n = 0; n < 2; ++n) _Pragma("unroll") for (int k = 0; k < 2; ++k) dst[n][k] = *(const PG8_LAS bf16x8*)(lds + PG8_SB(b, h) + boff + n * 2048 + k * 1024); } } while (0)
#define PG8_MMA(ai, bj, At, Bt) do { __builtin_amdgcn_s_setprio(1); if constexpr (FP8) { _Pragma("unroll") for (int m = 0; m < 4; ++m) _Pragma("unroll") for (int n = 0; n < 2; ++n) \
        acc[ai][bj][m][n] = __builtin_amdgcn_mfma_scale_f32_16x16x128_f8f6f4(Bt##8[n], At##8[m], acc[ai][bj][m][n], 0, 0, 0, g.sc_w, 0, g.sc_a); } else { \
        _Pragma("unroll") for (int m = 0; m < 4; ++m) _Pragma("unroll") for (int n = 0; n < 2; ++n) _Pragma("unroll") for (int k = 0; k < 2; ++k) \
        acc[ai][bj][m][n] = __builtin_amdgcn_mfma_f32_16x16x32_bf16(Bt[n][k], At[m][k], acc[ai][bj][m][n], 0, 0, 0); } __builtin_amdgcn_s_setprio(0); } while (0)
#define PG8_WAIT_V(n) asm volatile("s_waitcnt vmcnt(" #n ")" ::: "memory")
#define PG8_WAIT_L(n) asm volatile("s_waitcnt lgkmcnt(" #n ")" ::: "memory")
#define PG8_BAR __builtin_amdgcn_s_barrier()
#define PG8_SCHED __builtin_amdgcn_sched_barrier(0)
    Unit cur, nxt; int ui = 0;
    if (!S.next(0, cur)) return;
    f32x4 acc[2][2][4][2];
#pragma unroll
    for (int a = 0; a < 2; ++a)
#pragma unroll
        for (int b = 0; b < 2; ++b)
#pragma unroll
            for (int m = 0; m < 4; ++m)
#pragma unroll
                for (int n = 0; n < 2; ++n) acc[a][b][m][n] = (f32x4){0.f, 0.f, 0.f, 0.f};
    bf16x8 At[4][2], B0[2][2], B1[2][2]; v8i At8[4], B08[2], B18[2];
    const char* cA = GATHER ? (const char*)g.A : (const char*)g.A + (size_t)cur.pm * tstep; const char* cB = (const char*)g.Bt + (size_t)cur.bn * tstep;
    PG8_LOADG(0);
    PG8_STAGE(PG8_SB(0, 0), cB, voffB); PG8_STAGE_A(PG8_SA(0, 0), cA, 0); PG8_STAGE(PG8_SB(0, 1), cB + hstep, voffB); PG8_STAGE_A(PG8_SA(0, 1), cA, 1);
    if (wr == 1) PG8_BAR;
    PG8_WAIT_V(4); PG8_BAR;
    PG8_STAGE(PG8_SB(1, 0), cB + kstep, voffB); PG8_STAGE_A(PG8_SA(1, 0), cA + kstep, 0); PG8_STAGE(PG8_SB(1, 1), cB + hstep + kstep, voffB);
    PG8_WAIT_V(6); PG8_BAR;
    PG8_STAMP();
    for (;;) {
        const bool has_next = S.next(ui + 1, nxt);
        const char* nA = has_next ? (GATHER ? (const char*)g.A : (const char*)g.A + (size_t)nxt.pm * tstep) : cA; const char* nB = has_next ? (const char*)g.Bt + (size_t)nxt.bn * tstep : cB;
#pragma unroll 1
        for (int t = 0; t < nt; t += 2) {
            const bool last = (t == nt - 2);
            const char* a1 = cA + (size_t)(t + 1) * kstep;
            const char* a2 = last ? nA : cA + (size_t)(t + 2) * kstep; const char* b2 = last ? nB : cB + (size_t)(t + 2) * kstep;
            const char* a3 = a2 + kstep; const char* b3 = b2 + kstep;
            PG8_LDB(B0, 0, 0); PG8_SCHED; PG8_LDA(At, 0, 0); PG8_STAGE_A(PG8_SA(1, 1), a1, 1);
            PG8_WAIT_L(8); PG8_BAR; PG8_WAIT_L(0); PG8_MMA(0, 0, At, B0); PG8_BAR; PG8_SCHED;
            if (last && has_next) PG8_LOADG(ui + 1);
            PG8_LDB(B1, 0, 1); PG8_STAGE(PG8_SB(0, 0), b2, voffB);
            PG8_BAR; PG8_WAIT_L(0); PG8_MMA(0, 1, At, B1); PG8_BAR;
            PG8_LDA(At, 0, 1); PG8_STAGE_A(PG8_SA(0, 0), a2, 0);
            PG8_BAR; PG8_WAIT_L(0); PG8_MMA(1, 0, At, B0); PG8_BAR; PG8_SCHED;
            PG8_STAGE(PG8_SB(0, 1), b2 + hstep, voffB);
            PG8_WAIT_V(6); PG8_BAR; PG8_MMA(1, 1, At, B1); PG8_BAR;
            PG8_LDB(B0, 1, 0); PG8_SCHED; PG8_LDA(At, 1, 0); PG8_STAGE_A(PG8_SA(0, 1), a2, 1);
            PG8_WAIT_L(8); PG8_BAR; PG8_WAIT_L(0); PG8_MMA(0, 0, At, B0); PG8_BAR; PG8_SCHED;
            PG8_LDB(B1, 1, 1); PG8_STAGE(PG8_SB(1, 0), b3, voffB);
            PG8_BAR; PG8_WAIT_L(0); PG8_MMA(0, 1, At, B1); PG8_BAR;
            PG8_LDA(At, 1, 1); PG8_STAGE_A(PG8_SA(1, 0), a3, 0);
            PG8_BAR; PG8_WAIT_L(0); PG8_MMA(1, 0, At, B0); PG8_BAR; PG8_SCHED;
            PG8_STAGE(PG8_SB(1, 1), b3 + hstep, voffB);
            PG8_WAIT_V(6); PG8_BAR; PG8_MMA(1, 1, At, B1); PG8_BAR;
        }
        PG8_STAMP();
        E(acc, cur, wr, wc, fr, fq);
        PG8_STAMP();
        if (!has_next) break;
#pragma unroll
        for (int a = 0; a < 2; ++a)
#pragma unroll
            for (int b = 0; b < 2; ++b)
#pragma unroll
                for (int m = 0; m < 4; ++m)
#pragma unroll
                    for (int n = 0; n < 2; ++n) acc[a][b][m][n] = (f32x4){0.f, 0.f, 0.f, 0.f};
        cur = nxt; cA = nA; cB = nB; ++ui;
    }
    PG8_WAIT_V(0);
    if (wr == 0) PG8_BAR;
    PG8_BAR;
    PG8_STAMP();
#undef PG8_STAMP
#undef PG8_SA
#undef PG8_SB
#undef PG8_STAGE
#undef PG8_STAGE_A
#undef PG8_LOADG
#undef PG8_LDA
#undef PG8_LDB
#undef PG8_MMA
#undef PG8_WAIT_V
#undef PG8_WAIT_L
#undef PG8_BAR
#undef PG8_SCHED
}
}
namespace {
#define XB_TMO      128
#define XB_XCNT(j)  (256  + 64 * (j))
#define XB_XSUB(j)  (1280 + 64 * (j))
#define XB_XGEN(j)  (2304 + 64 * (j))
#define XB_TOP      3328
#define XB_TOPGEN   3392
#define XCD_BAR_WORDS 3456
#define XB_SPIN_CAP (1u << 18)

__device__ __forceinline__ unsigned xb_ld(unsigned* p)              { return __hip_atomic_load(p, __ATOMIC_RELAXED, __HIP_MEMORY_SCOPE_AGENT); }
__device__ __forceinline__ unsigned xb_add(unsigned* p, unsigned v) { return __hip_atomic_fetch_add(p, v, __ATOMIC_RELAXED, __HIP_MEMORY_SCOPE_AGENT); }
__device__ __forceinline__ unsigned xb_xcc_id() { return (unsigned)__builtin_amdgcn_s_getreg((3 << 11) | 20) & 0xFu; }
#define XB_SPIN(cond, bar) do { unsigned _sp = 0; while (cond) { __builtin_amdgcn_s_sleep(1); \
    if ((++_sp & 255u) == 0u) { if (xb_ld(&(bar)[XB_TMO])) break; if (_sp > XB_SPIN_CAP) { atomicAdd(&(bar)[XB_TMO], 1u); break; } } } } while (0)

struct XcdBarrier {
    unsigned* bar; unsigned x;
    volatile LAS unsigned* st;
};

__device__ __forceinline__ XcdBarrier xcd_barrier_post(unsigned* bar, volatile LAS unsigned* st) {
    XcdBarrier b; b.bar = bar; b.x = xb_xcc_id(); b.st = st;
    if (threadIdx.x == 0) (void)xb_add(&bar[XB_XCNT(b.x)], 1u);
    return b;
}
__device__ __forceinline__ void xcd_barrier_complete(unsigned* bar, unsigned x, unsigned& nloc, unsigned& nx) {
    const unsigned G = gridDim.x * gridDim.y * gridDim.z;
    unsigned sum, cnt, mine, sp = 0u;
    for (;;) {
        sum = 0u; cnt = 0u; mine = 0u;
#pragma unroll
        for (unsigned j = 0; j < 16; ++j) { const unsigned c = xb_ld(&bar[XB_XCNT(j)]); sum += c; cnt += (c > 0u) ? 1u : 0u; mine = (j == x) ? c : mine; }
        if (sum == G) break;
        __builtin_amdgcn_s_sleep(1);
        if ((++sp & 255u) == 0u) { if (xb_ld(&bar[XB_TMO])) break; if (sp > XB_SPIN_CAP) { atomicAdd(&bar[XB_TMO], 1u); break; } }
    }
    nloc = mine > 0u ? mine : 1u; nx = cnt > 0u ? cnt : 1u;
}

__device__ __forceinline__ void xcd_barrier(const XcdBarrier& b) {
    asm volatile("s_waitcnt vmcnt(0)" ::: "memory");
    __syncthreads();
    if (threadIdx.x == 0) {
        unsigned* bar = b.bar;
        __builtin_amdgcn_s_waitcnt(0);
        unsigned nloc = b.st[0], nx = b.st[1];
        if (nloc == 0u) { xcd_barrier_complete(bar, b.x, nloc, nx); b.st[0] = nloc; b.st[1] = nx; }
        const unsigned old = xb_add(&bar[XB_XSUB(b.x)], 1u);
        const unsigned gen = old / nloc;
        if (old + 1u == (gen + 1u) * nloc) {
            __builtin_amdgcn_fence(__ATOMIC_RELEASE, "agent");
            asm volatile("s_waitcnt vmcnt(0)" ::: "memory");
            const unsigned og = xb_add(&bar[XB_TOP], 1u);
            const unsigned tg = og / nx;
            if (og + 1u == (tg + 1u) * nx) xb_add(&bar[XB_TOPGEN], 1u);
            else XB_SPIN(xb_ld(&bar[XB_TOPGEN]) == tg, bar);
            __builtin_amdgcn_fence(__ATOMIC_ACQUIRE, "agent");
            xb_add(&bar[XB_XGEN(b.x)], 1u);
            asm volatile("s_waitcnt vmcnt(0)" ::: "memory");
        } else {
            XB_SPIN(xb_ld(&bar[XB_XGEN(b.x)]) == gen, bar);
            __builtin_amdgcn_fence(__ATOMIC_ACQUIRE, "agent");
            asm volatile("s_waitcnt vmcnt(0)" ::: "memory");
        }
    }
    __syncthreads();
}

}
namespace {
using pg8::f32x4; using pg8::u32x4; using pg8::cvt_pk_bf16;

template <class ARow, class Epi>
__device__ __forceinline__ void gemm_tile(float* smem, int mvalid, int nvalid, int K, ARow arow, const float* Bp, int ldb, Epi epi) {
  float* As = smem;
  float* Bs = smem + 16 * 68;
  const int tid = threadIdx.x, ty = tid >> 5, tx = tid & 31;
  float acc[4][4];
#pragma unroll
  for (int i = 0; i < 4; ++i)
#pragma unroll
    for (int j = 0; j < 4; ++j) acc[i][j] = 0.f;
  const int ak = tid & 15, ar = tid >> 4;
  const float* ap0 = (ar < mvalid) ? arow(ar) : nullptr;
  const float* ap1 = (ar + 32 < mvalid) ? arow(ar + 32) : nullptr;
  const int bn = tid & 127, bk = tid >> 7;
  for (int k0 = 0; k0 < K; k0 += 16) {
    As[ak * 68 + ar] = ap0 ? ap0[k0 + ak] : 0.f;
    As[ak * 68 + ar + 32] = ap1 ? ap1[k0 + ak] : 0.f;
#pragma unroll
    for (int i = 0; i < 4; ++i) { const int kk = bk + 4 * i; Bs[kk * 128 + bn] = (bn < nvalid) ? Bp[(size_t)(k0 + kk) * ldb + bn] : 0.f; }
    __syncthreads();
#pragma unroll
    for (int kk = 0; kk < 16; ++kk) {
      float a[4], b[4];
#pragma unroll
      for (int i = 0; i < 4; ++i) a[i] = As[kk * 68 + ty * 4 + i];
#pragma unroll
      for (int j = 0; j < 4; ++j) b[j] = Bs[kk * 128 + tx * 4 + j];
#pragma unroll
      for (int i = 0; i < 4; ++i)
#pragma unroll
        for (int j = 0; j < 4; ++j) acc[i][j] += a[i] * b[j];
    }
    __syncthreads();
  }
#pragma unroll
  for (int i = 0; i < 4; ++i)
#pragma unroll
    for (int j = 0; j < 4; ++j) { const int r = ty * 4 + i, c = tx * 4 + j; if (r < mvalid && c < nvalid) epi(r, c, acc[i][j]); }
}

template <class RowMap>
__device__ __forceinline__ void cvt_tile(const float* __restrict__ src, int N, int K, int k0, int n0, bf16_t* __restrict__ dst, RowMap rm) {
  const int lane = threadIdx.x & 63, w = threadIdx.x >> 6;
  const int n = n0 + (lane & 15) * 4, kk = k0 + (w * 4 + (lane >> 4)) * 8;
  if (n >= N) return;
  float4 v[8];
#pragma unroll
  for (int j = 0; j < 8; ++j) v[j] = *(const float4*)(src + (size_t)(kk + j) * N + n);
  u32x4 o;
  o.x = cvt_pk_bf16(v[0].x, v[1].x); o.y = cvt_pk_bf16(v[2].x, v[3].x); o.z = cvt_pk_bf16(v[4].x, v[5].x); o.w = cvt_pk_bf16(v[6].x, v[7].x);
  *(u32x4*)(dst + (size_t)rm(n + 0) * K + kk) = o;
  o.x = cvt_pk_bf16(v[0].y, v[1].y); o.y = cvt_pk_bf16(v[2].y, v[3].y); o.z = cvt_pk_bf16(v[4].y, v[5].y); o.w = cvt_pk_bf16(v[6].y, v[7].y);
  *(u32x4*)(dst + (size_t)rm(n + 1) * K + kk) = o;
  o.x = cvt_pk_bf16(v[0].z, v[1].z); o.y = cvt_pk_bf16(v[2].z, v[3].z); o.z = cvt_pk_bf16(v[4].z, v[5].z); o.w = cvt_pk_bf16(v[6].z, v[7].z);
  *(u32x4*)(dst + (size_t)rm(n + 2) * K + kk) = o;
  o.x = cvt_pk_bf16(v[0].w, v[1].w); o.y = cvt_pk_bf16(v[2].w, v[3].w); o.z = cvt_pk_bf16(v[4].w, v[5].w); o.w = cvt_pk_bf16(v[6].w, v[7].w);
  *(u32x4*)(dst + (size_t)rm(n + 3) * K + kk) = o;
}
template <class RowMap>
__device__ void cvt_job(const float* src, int nmat, int K, int N, bf16_t* dst, size_t dstride, RowMap rm) {
  const int kt = K / 256, ntl = (N + 63) / 64, per = kt * ntl;
  for (int it = blockIdx.x; it < nmat * per; it += gridDim.x) {
    const int m = it / per, r = it % per, k0 = (r / ntl) * 256, n0 = (r % ntl) * 64;
    cvt_tile(src + (size_t)m * K * N, N, K, k0, n0, dst + (size_t)m * dstride, rm);
  }
}
__device__ void ph_convert(const Params& p) {
  const size_t gtid = (size_t)blockIdx.x * NT + threadIdx.x, gsz = (size_t)gridDim.x * NT;
  for (size_t i = gtid; i < (size_t)T * D / 8; i += gsz) {
    const float4 a = *(const float4*)(p.x + i * 8), b = *(const float4*)(p.x + i * 8 + 4);
    u32x4 o; o.x = cvt_pk_bf16(a.x, a.y); o.y = cvt_pk_bf16(a.z, a.w); o.z = cvt_pk_bf16(b.x, b.y); o.w = cvt_pk_bf16(b.z, b.w);
    *(u32x4*)(p.xb + i * 8) = o;
  }
  cvt_job(p.w_in, 1, D, PW, p.WinT, 0, [](int n) { return n < O_DT ? n : (n < O_Q ? PLD + (n - O_DT) : n - 32); });
  for (size_t i = gtid; i < (size_t)(NPROJ - PW) * D / 8; i += gsz) *(u32x4*)(p.WinT + (size_t)PW * D + i * 8) = (u32x4){0u, 0u, 0u, 0u};
  cvt_job(p.w_out, 1, D, D, p.WoutT, 0, [](int n) { return n; });
  cvt_job(p.w_router, 1, D, NE, p.WrT, 0, [](int n) { return n; });
}
__device__ __forceinline__ unsigned pk4_fp8(float a, float b, float c, float d) { int w = 0; w = __builtin_amdgcn_cvt_pk_fp8_f32(a * W8S, b * W8S, w, false); w = __builtin_amdgcn_cvt_pk_fp8_f32(c * W8S, d * W8S, w, true); return (unsigned)w; }
template <class RowMap>
__device__ __forceinline__ void cvt_range8(const float* __restrict__ src, int K, int N, unsigned char* __restrict__ dst, size_t dstride, RowMap rm, int it0, int it1) {
  constexpr int NT2 = 2;
  const int kt = K / 512, ntl = N / 64, per = kt * ntl;
  int tid = threadIdx.x; asm volatile("" : "+v"(tid));
  const int lane = tid & 63, w = tid >> 6, nl = (lane & 15) * 4, kl = (w * 4 + (lane >> 4)) * 16;
  for (int it = it0; it < it1; it += NT2) {
    float4 v[NT2][16];
#pragma unroll
    for (int q = 0; q < NT2; ++q) { const int m = (it + q) / per, r = (it + q) % per, kk = (r / ntl) * 512 + kl, n = (r % ntl) * 64 + nl;
      const float* sp = src + (size_t)m * K * N + (size_t)kk * N + n;
#pragma unroll
      for (int j = 0; j < 16; ++j) v[q][j] = *(const float4*)(sp + (size_t)j * N); }
#pragma unroll
    for (int q = 0; q < NT2; ++q) { const int m = (it + q) / per, r = (it + q) % per, kk = (r / ntl) * 512 + kl, n = (r % ntl) * 64 + nl;
      unsigned char* dp = dst + (size_t)m * dstride + kk; u32x4 o;
      o.x = pk4_fp8(v[q][0].x, v[q][1].x, v[q][2].x, v[q][3].x); o.y = pk4_fp8(v[q][4].x, v[q][5].x, v[q][6].x, v[q][7].x); o.z = pk4_fp8(v[q][8].x, v[q][9].x, v[q][10].x, v[q][11].x); o.w = pk4_fp8(v[q][12].x, v[q][13].x, v[q][14].x, v[q][15].x);
      *(u32x4*)(dp + (size_t)rm(n + 0) * K) = o;
      o.x = pk4_fp8(v[q][0].y, v[q][1].y, v[q][2].y, v[q][3].y); o.y = pk4_fp8(v[q][4].y, v[q][5].y, v[q][6].y, v[q][7].y); o.z = pk4_fp8(v[q][8].y, v[q][9].y, v[q][10].y, v[q][11].y); o.w = pk4_fp8(v[q][12].y, v[q][13].y, v[q][14].y, v[q][15].y);
      *(u32x4*)(dp + (size_t)rm(n + 1) * K) = o;
      o.x = pk4_fp8(v[q][0].z, v[q][1].z, v[q][2].z, v[q][3].z); o.y = pk4_fp8(v[q][4].z, v[q][5].z, v[q][6].z, v[q][7].z); o.z = pk4_fp8(v[q][8].z, v[q][9].z, v[q][10].z, v[q][11].z); o.w = pk4_fp8(v[q][12].z, v[q][13].z, v[q][14].z, v[q][15].z);
      *(u32x4*)(dp + (size_t)rm(n + 2) * K) = o;
      o.x = pk4_fp8(v[q][0].w, v[q][1].w, v[q][2].w, v[q][3].w); o.y = pk4_fp8(v[q][4].w, v[q][5].w, v[q][6].w, v[q][7].w); o.z = pk4_fp8(v[q][8].w, v[q][9].w, v[q][10].w, v[q][11].w); o.w = pk4_fp8(v[q][12].w, v[q][13].w, v[q][14].w, v[q][15].w);
      *(u32x4*)(dp + (size_t)rm(n + 3) * K) = o; }
  }
}
constexpr int CVT_ITEMS = 3 * 256 + 3 * 4;
__device__ __forceinline__ void cvt_moe_item(const Params& p, int item) {
  unsigned char* gu = (unsigned char*)p.WguT; unsigned char* dn = (unsigned char*)p.WdT;
  if (item < 256) cvt_range8(p.wg_e, D, DE, gu, (size_t)1024 * D, [](int n) { return (n >> 7) * 256 + (n & 127); }, item * 8, item * 8 + 8);
  else if (item < 512) cvt_range8(p.wu_e, D, DE, gu, (size_t)1024 * D, [](int n) { return (n >> 7) * 256 + 128 + (n & 127); }, (item - 256) * 8, (item - 256) * 8 + 8);
  else if (item < 768) cvt_range8(p.wd_e, DE, D, dn, (size_t)D * DE, [](int n) { return n; }, (item - 512) * 8, (item - 512) * 8 + 8);
  else if (item < 772) cvt_range8(p.wg_s, D, DE, gu + (size_t)NE * 1024 * D, 0, [](int n) { return (n >> 7) * 256 + (n & 127); }, (item - 768) * 8, (item - 768) * 8 + 8);
  else if (item < 776) cvt_range8(p.wu_s, D, DE, gu + (size_t)NE * 1024 * D, 0, [](int n) { return (n >> 7) * 256 + 128 + (n & 127); }, (item - 772) * 8, (item - 772) * 8 + 8);
  else cvt_range8(p.wd_s, DE, D, dn + (size_t)NE * D * DE, 0, [](int n) { return n; }, (item - 776) * 8, (item - 776) * 8 + 8);
}

struct EpiProj {
  static constexpr bool PERM = true;
  bf16_t* proj; float* dt; const float* bias_f; const float* bias_b;
  __device__ __forceinline__ void operator()(const f32x4 (&acc)[2][2][4][2], const pg8::Unit& u, int wr, int wc, int fr, int fq) const {
    asm volatile("" : "+v"(fr), "+v"(fq));
    const int row0 = u.pm * 256 + wr * 64 + fr;
    if (u.pn < 22) {
      const int col0 = u.pn * 256 + wc * 32 + 8 * fq;
      const float sc = (u.pn >= 10 && u.pn < 14) ? QS : 1.0f;
#pragma unroll
      for (int ai = 0; ai < 2; ++ai)
#pragma unroll
        for (int m = 0; m < 4; ++m) { bf16_t* rowp = proj + (size_t)(row0 + ai * 128 + m * 16) * PLD + col0;
#pragma unroll
          for (int bj = 0; bj < 2; ++bj) { const f32x4 v0 = acc[ai][bj][m][0] * sc, v1 = acc[ai][bj][m][1] * sc;
            u32x4 w; w.x = cvt_pk_bf16(v0[0], v0[1]); w.y = cvt_pk_bf16(v0[2], v0[3]); w.z = cvt_pk_bf16(v1[0], v1[1]); w.w = cvt_pk_bf16(v1[2], v1[3]);
            *(u32x4*)(rowp + bj * 128) = w; } }
    } else if (wc == 0) {
      const int c0 = 8 * fq;
      float bs[8];
#pragma unroll
      for (int j = 0; j < 8; ++j) bs[j] = (c0 + j) < 16 ? bias_f[c0 + j] : bias_b[c0 + j - 16];
#pragma unroll
      for (int ai = 0; ai < 2; ++ai)
#pragma unroll
        for (int m = 0; m < 4; ++m) { float* rowp = dt + (size_t)(row0 + ai * 128 + m * 16) * 32 + c0;
          const f32x4 v0 = acc[ai][0][m][0], v1 = acc[ai][0][m][1];
          f32x4 o0, o1;
#pragma unroll
          for (int j = 0; j < 4; ++j) { o0[j] = softplus_f(v0[j] + bs[j]); o1[j] = softplus_f(v1[j] + bs[4 + j]); }
          *(f32x4*)rowp = o0; *(f32x4*)(rowp + 4) = o1; }
    }
  }
};
struct EpiOut {
  static constexpr bool PERM = false;
  const float* x; float* v;
  __device__ __forceinline__ void operator()(const f32x4 (&acc)[2][2][4][2], const pg8::Unit& u, int wr, int wc, int fr, int fq) const {
    asm volatile("" : "+v"(fr), "+v"(fq));
    const int row0 = u.pm * 256 + wr * 64 + fr, col0 = u.pn * 256 + wc * 32 + 4 * fq;
#pragma unroll
    for (int ai = 0; ai < 2; ++ai)
#pragma unroll
      for (int m = 0; m < 4; ++m) { const size_t off = (size_t)(row0 + ai * 128 + m * 16) * D + col0;
#pragma unroll
        for (int bj = 0; bj < 2; ++bj)
#pragma unroll
          for (int n = 0; n < 2; ++n) { const f32x4 xv = *(const f32x4*)(x + off + bj * 128 + n * 16); *(f32x4*)(v + off + bj * 128 + n * 16) = xv * ALPHA + acc[ai][bj][m][n]; } }
  }
};

namespace at {
using bf16x8 = __attribute__((ext_vector_type(8))) short;
using s16x4  = __attribute__((ext_vector_type(4))) short;
using f32x16 = __attribute__((ext_vector_type(16))) float;
using u32x4  = __attribute__((ext_vector_type(4))) unsigned;
constexpr int KVBLK = 64;
constexpr size_t SHM_V = KVBLK * 128 * 2, SHM_K = KVBLK * 128 * 2;
constexpr float THR2 = 8.0f;
#define AT_KSWZ(row, colB) ((row) * 256 + ((colB) ^ (((row) & 7) << 4)))
#define AT_SBAR() __builtin_amdgcn_sched_barrier(0)
__device__ __forceinline__ int crow(int r, int hi) { return (r & 3) + 8 * (r >> 2) + 4 * hi; }
__device__ __forceinline__ unsigned cvtpk(float lo, float hi) { unsigned r; asm volatile("v_cvt_pk_bf16_f32 %0, %1, %2" : "=v"(r) : "v"(lo), "v"(hi)); return r; }

__device__ __forceinline__ void partialSM(f32x16& p0, f32x16& p1, float dqh, float nsl2, float& m_reg, float& mn, float& alpha) {
#pragma unroll
  for (int r = 0; r < 16; ++r) { const float c = (float)((r & 3) + 8 * (r >> 2));
    p0[r] = fmaf(nsl2, fabsf(dqh - c), p0[r]); p1[r] = fmaf(nsl2, fabsf(dqh - (c + 32.f)), p1[r]); }
  float pmax = p0[0];
#pragma unroll
  for (int r = 1; r < 16; ++r) pmax = fmaxf(pmax, p0[r]);
#pragma unroll
  for (int r = 0; r < 16; ++r) pmax = fmaxf(pmax, p1[r]);
  { auto rr = __builtin_amdgcn_permlane32_swap(__float_as_uint(pmax), __float_as_uint(pmax), false, false);
    pmax = fmaxf(__uint_as_float(rr[0]), __uint_as_float(rr[1])); }
  if (__builtin_expect(__all(pmax - m_reg <= THR2), 1)) { mn = m_reg; alpha = 1.f; }
  else { mn = fmaxf(m_reg, pmax); alpha = __builtin_amdgcn_exp2f(m_reg - mn); m_reg = mn; }
#pragma unroll
  for (int r = 0; r < 16; ++r) p0[r] = p0[r] - mn;
#pragma unroll
  for (int r = 0; r < 16; ++r) p1[r] = p1[r] - mn;
#pragma unroll
  for (int r = 0; r < 16; ++r) p0[r] = __builtin_amdgcn_exp2f(p0[r]);
}
__device__ __forceinline__ void finishSM(f32x16& p0, f32x16& p1, float alpha, float& l_reg, bf16x8& pa0, bf16x8& pa1, bf16x8& pa2, bf16x8& pa3) {
#pragma unroll
  for (int r = 0; r < 16; ++r) p1[r] = __builtin_amdgcn_exp2f(p1[r]);
  float ps = 0;
#pragma unroll
  for (int r = 0; r < 16; ++r) ps += p0[r];
#pragma unroll
  for (int r = 0; r < 16; ++r) ps += p1[r];
  { auto rr = __builtin_amdgcn_permlane32_swap(__float_as_uint(ps), __float_as_uint(ps), false, false);
    ps = __uint_as_float(rr[0]) + __uint_as_float(rr[1]); }
  l_reg = l_reg * alpha + ps;
#define AT_PK4(P, BASE, OUT) do { unsigned a0 = cvtpk(P[BASE + 0], P[BASE + 1]), a1 = cvtpk(P[BASE + 2], P[BASE + 3]);   \
    unsigned b0 = cvtpk(P[BASE + 4], P[BASE + 5]), b1 = cvtpk(P[BASE + 6], P[BASE + 7]);                              \
    auto r0 = __builtin_amdgcn_permlane32_swap(a0, b0, false, false); auto r1 = __builtin_amdgcn_permlane32_swap(a1, b1, false, false); \
    u32x4 w = {r0[0], r1[0], r0[1], r1[1]}; OUT = *reinterpret_cast<bf16x8*>(&w); } while (0)
  AT_PK4(p0, 0, pa0); AT_PK4(p0, 8, pa1); AT_PK4(p1, 0, pa2); AT_PK4(p1, 8, pa3);
#undef AT_PK4
}
__device__ __forceinline__ void qkt(f32x16& p0, f32x16& p1, const char* Ks, const bf16x8* qr, int r32, int hi, int cm) {
  p0 = f32x16{}; p1 = f32x16{};
#pragma unroll
  for (int d0 = 0; d0 < 4; ++d0) { const int cb = (cm + d0 * 16 + hi * 8) * 2;
    bf16x8 b0 = *reinterpret_cast<const bf16x8*>(Ks + AT_KSWZ(r32, cb));
    bf16x8 b1 = *reinterpret_cast<const bf16x8*>(Ks + AT_KSWZ(32 + r32, cb));
    p0 = __builtin_amdgcn_mfma_f32_32x32x16_bf16(b0, qr[d0], p0, 0, 0, 0);
    p1 = __builtin_amdgcn_mfma_f32_32x32x16_bf16(b1, qr[d0], p1, 0, 0, 0); }
}
__device__ __forceinline__ int v_st(int k, int c) { const int kk = (k & ~0xC) | ((k & 4) << 1) | ((k & 8) >> 1); return ((kk >> 3) * 4 + (c >> 5)) * 512 + ((kk & 7) * 32 + (c & 31)) * 2; }
__device__ __forceinline__ int v_rd_base(int lane) { return ((lane & 3) << 3) | (((lane >> 2) & 3) << 6) | (((lane >> 4) & 1) << 5) | (((lane >> 5) & 1) << 8); }
constexpr int v_rd_off(int d0, int ks, int half) { return d0 * 512 + ks * 4096 + half * 2048; }
template <int OFF> __device__ __forceinline__ s16x4 tr_read(int vb) {
  s16x4 r; asm volatile("ds_read_b64_tr_b16 %0, %1 offset:%2" : "=&v"(r) : "v"(vb), "i"(OFF) : "memory"); return r;
}
template <int D0> __device__ __forceinline__ void pv_one(f32x16& od, int vb, bf16x8 pa0, bf16x8 pa1, bf16x8 pa2, bf16x8 pa3) {
  const s16x4 l0 = tr_read<v_rd_off(D0, 0, 0)>(vb), h0 = tr_read<v_rd_off(D0, 0, 1)>(vb), l1 = tr_read<v_rd_off(D0, 1, 0)>(vb), h1 = tr_read<v_rd_off(D0, 1, 1)>(vb);
  const s16x4 l2 = tr_read<v_rd_off(D0, 2, 0)>(vb), h2 = tr_read<v_rd_off(D0, 2, 1)>(vb), l3 = tr_read<v_rd_off(D0, 3, 0)>(vb), h3 = tr_read<v_rd_off(D0, 3, 1)>(vb);
  asm volatile("s_waitcnt lgkmcnt(0)" ::: "memory"); AT_SBAR();
#define AT_PK(L, H) (bf16x8){L[0], L[1], L[2], L[3], H[0], H[1], H[2], H[3]}
  od = __builtin_amdgcn_mfma_f32_32x32x16_bf16(pa0, AT_PK(l0, h0), od, 0, 0, 0);
  od = __builtin_amdgcn_mfma_f32_32x32x16_bf16(pa1, AT_PK(l1, h1), od, 0, 0, 0);
  od = __builtin_amdgcn_mfma_f32_32x32x16_bf16(pa2, AT_PK(l2, h2), od, 0, 0, 0);
  od = __builtin_amdgcn_mfma_f32_32x32x16_bf16(pa3, AT_PK(l3, h3), od, 0, 0, 0);
#undef AT_PK
}
__device__ __forceinline__ void pv_d0(f32x16* o, int vb, bf16x8 pa0, bf16x8 pa1, bf16x8 pa2, bf16x8 pa3) {
  pv_one<0>(o[0], vb, pa0, pa1, pa2, pa3); pv_one<1>(o[1], vb, pa0, pa1, pa2, pa3); pv_one<2>(o[2], vb, pa0, pa1, pa2, pa3); pv_one<3>(o[3], vb, pa0, pa1, pa2, pa3);
}

__device__ __forceinline__ void attn_item(const bf16_t* __restrict__ Qb, const bf16_t* Kh, const bf16_t* Vh, bf16_t* __restrict__ Ub,
                                          int q0, float nsl2, float lam, const float* __restrict__ normw, const float* kn2, char* lds) {
  constexpr int LDK = PLD;
  int tid = threadIdx.x; asm volatile("" : "+v"(tid));
  const int wid = tid >> 6, lane = tid & 63, r32 = lane & 31, hi = lane >> 5, rg = wid >> 1, cmap = wid & 1, cm = cmap * 64;
  char* V_lds = lds; char* K_lds = lds + 2 * SHM_V;
  float* ws = (float*)(lds + 2 * SHM_V + 2 * SHM_K) + wid * 64; float* li_l = ws; float* al_l = ws + 32;
  float m_reg = -1e30f, l_reg = 0; f32x16 o[4] = {}; bf16x8 qr[4];
  const bf16_t* Qw = Qb + (size_t)(rg * 32 + r32) * LDK + cm + hi * 8;
#pragma unroll
  for (int d0 = 0; d0 < 4; ++d0) qr[d0] = *reinterpret_cast<const bf16x8*>(Qw + d0 * 16);
  int jlo, ntl;
  { float qs = 0.f;
#pragma unroll
    for (int d0 = 0; d0 < 4; ++d0)
#pragma unroll
      for (int e = 0; e < 8; ++e) { const float x = __uint_as_float(((unsigned)(unsigned short)qr[d0][e]) << 16); qs += x * x; }
    qs += __shfl_xor(qs, 32);
    for (int o = 16; o >= 1; o >>= 1) qs = fmaxf(qs, __shfl_xor(qs, o));
    float* qn = (float*)(lds + 70 * 1024);
    __syncthreads();
    if (lane == 0) qn[wid] = qs;
    __syncthreads();
    float q2 = qn[0];
#pragma unroll
    for (int w = 1; w < 8; ++w) q2 = fmaxf(q2, qn[w]);
    const float qnm = sqrtf(q2) * 1.01f;
    int lo = S / KVBLK, hi_ = -1;
    for (int j = 0; j < S / KVBLK; ++j) {
      const int dl = q0 - (j * KVBLK + KVBLK - 1), dr = j * KVBLK - (q0 + 127); const int dmin = dl > 0 ? dl : (dr > 0 ? dr : 0);
      const float smax = qnm * sqrtf(fmaxf(__hip_atomic_load(kn2 + j, __ATOMIC_RELAXED, __HIP_MEMORY_SCOPE_AGENT), __hip_atomic_load(kn2 + S / KVBLK + j, __ATOMIC_RELAXED, __HIP_MEMORY_SCOPE_AGENT))) * 1.01f;
      const bool keep = -nsl2 * (float)dmin < 2.f * smax + 30.f;
      if (keep) { lo = j < lo ? j : lo; hi_ = j; }
    }
    int cnt = hi_ - lo + 1;
    if (cnt & 1) { if (lo > 0) --lo; else ++hi_; ++cnt; }
    jlo = lo; ntl = cnt; }
  Kh += (size_t)jlo * KVBLK * LDK; Vh += (size_t)jlo * KVBLK * LDK;
  const int sr = tid >> 4, sc = (tid & 15) * 8, vst0 = v_st(sr, sc), vst1 = v_st(32 + sr, sc);
  const int vb0 = (int)(uintptr_t)V_lds + v_rd_base(lane);
  const float qposh = (float)(q0 - jlo * KVBLK + rg * 32 + r32 - 4 * hi);
  struct { bf16x8 vs0, vs1, ks0, ks1; } sr_[2];
#define SLOAD(i, k0) do { sr_[i].vs0 = *reinterpret_cast<const bf16x8*>(&Vh[(size_t)((k0) + sr) * LDK + sc]); sr_[i].vs1 = *reinterpret_cast<const bf16x8*>(&Vh[(size_t)((k0) + 32 + sr) * LDK + sc]); \
    sr_[i].ks0 = *reinterpret_cast<const bf16x8*>(&Kh[(size_t)((k0) + sr) * LDK + sc]); sr_[i].ks1 = *reinterpret_cast<const bf16x8*>(&Kh[(size_t)((k0) + 32 + sr) * LDK + sc]); } while (0)
#define SWRITE(b, i) do { *(bf16x8*)(V_lds + (b) * SHM_V + vst0) = sr_[i].vs0;          \
    *(bf16x8*)(V_lds + (b) * SHM_V + vst1) = sr_[i].vs1; int kc = sc * 2;               \
    *(bf16x8*)(K_lds + (b) * SHM_K + AT_KSWZ(sr, kc)) = sr_[i].ks0;                       \
    *(bf16x8*)(K_lds + (b) * SHM_K + AT_KSWZ(32 + sr, kc)) = sr_[i].ks1; } while (0)
#define SWAIT() asm volatile("s_waitcnt vmcnt(4)" ::: "memory")
#define RESC(a) do { if (__any((a) < 1.f)) { if (hi == 0) al_l[r32] = (a); asm volatile("s_waitcnt lgkmcnt(0)" ::: "memory"); \
    _Pragma("unroll") for (int d = 0; d < 4; ++d) _Pragma("unroll") for (int r = 0; r < 16; ++r) o[d][r] *= al_l[crow(r, hi)]; } } while (0)
  f32x16 pA0, pA1, pB0, pB1; float mnA, mnB, alA, alB; bf16x8 pa0, pa1, pa2, pa3; const int NTL = ntl;
  constexpr int SE = 0, SO = 1;
  SLOAD(SE, 0); asm volatile("s_waitcnt vmcnt(0)" ::: "memory"); SWRITE(0, SE); __syncthreads();
  qkt(pA0, pA1, K_lds, qr, r32, hi, cm); partialSM(pA0, pA1, qposh, nsl2, m_reg, mnA, alA);
  SLOAD(SO, KVBLK); if (2 < NTL) SLOAD(SE, 2 * KVBLK);
  SWAIT(); SWRITE(1, SO); __syncthreads();
  for (int j = 1; j + 1 < NTL; j += 2) {
    AT_SBAR(); qkt(pB0, pB1, K_lds + SHM_K, qr, r32, hi, cm);
    finishSM(pA0, pA1, alA, l_reg, pa0, pa1, pa2, pa3); AT_SBAR();
    SLOAD(SO, (j + 2) * KVBLK); AT_SBAR();
    pv_d0(o, vb0, pa0, pa1, pa2, pa3); partialSM(pB0, pB1, qposh - (float)(j * KVBLK), nsl2, m_reg, mnB, alB);
    __syncthreads(); SWAIT(); SWRITE(0, SE);
    RESC(alB); __syncthreads();
    AT_SBAR(); qkt(pA0, pA1, K_lds, qr, r32, hi, cm);
    finishSM(pB0, pB1, alB, l_reg, pa0, pa1, pa2, pa3); AT_SBAR();
    if (j + 3 < NTL) SLOAD(SE, (j + 3) * KVBLK); AT_SBAR();
    pv_d0(o, vb0 + (int)SHM_V, pa0, pa1, pa2, pa3); partialSM(pA0, pA1, qposh - (float)((j + 1) * KVBLK), nsl2, m_reg, mnA, alA);
    __syncthreads(); SWAIT(); SWRITE(1, SO);
    RESC(alA); __syncthreads();
  }
  AT_SBAR(); qkt(pB0, pB1, K_lds + SHM_K, qr, r32, hi, cm);
  finishSM(pA0, pA1, alA, l_reg, pa0, pa1, pa2, pa3); AT_SBAR();
  pv_d0(o, vb0, pa0, pa1, pa2, pa3); partialSM(pB0, pB1, qposh - (float)((NTL - 1) * KVBLK), nsl2, m_reg, mnB, alB);
  __syncthreads(); RESC(alB);
  finishSM(pB0, pB1, alB, l_reg, pa0, pa1, pa2, pa3); AT_SBAR();
  pv_d0(o, vb0 + (int)SHM_V, pa0, pa1, pa2, pa3);
  if (hi == 0) li_l[r32] = l_reg; asm volatile("s_waitcnt lgkmcnt(0)" ::: "memory");
  float rli[16];
#pragma unroll
  for (int r = 0; r < 16; ++r) rli[r] = __builtin_amdgcn_rcpf(li_l[crow(r, hi)]);
#pragma unroll
  for (int d = 0; d < 4; ++d)
#pragma unroll
    for (int r = 0; r < 16; ++r) o[d][r] *= rli[r];
  __syncthreads();
  float* X = (float*)lds + rg * (32 * 128);
  if (cmap == 1) {
#pragma unroll
    for (int d = 0; d < 4; ++d)
#pragma unroll
      for (int r = 0; r < 16; ++r) X[crow(r, hi) * 128 + d * 32 + r32] = o[d][r];
  }
  __syncthreads();
  if (cmap == 0) {
    float ss[16];
#pragma unroll
    for (int r = 0; r < 16; ++r) ss[r] = 0.f;
#pragma unroll
    for (int d = 0; d < 4; ++d)
#pragma unroll
      for (int r = 0; r < 16; ++r) { const float v = o[d][r] - lam * X[crow(r, hi) * 128 + d * 32 + r32]; o[d][r] = v; ss[r] += v * v; }
#pragma unroll
    for (int r = 0; r < 16; ++r) { float s = ss[r]; s += __shfl_xor(s, 16); s += __shfl_xor(s, 8); s += __shfl_xor(s, 4); s += __shfl_xor(s, 2); s += __shfl_xor(s, 1);
      ss[r] = rsqrtf(s * (1.f / 128.f) + 1e-5f) * (1.f - LAMBDA_INIT); }
    float nw[4];
#pragma unroll
    for (int d = 0; d < 4; ++d) nw[d] = normw[d * 32 + r32];
#pragma unroll
    for (int r = 0; r < 16; ++r) { bf16_t* up = Ub + (size_t)(rg * 32 + crow(r, hi)) * D + r32;
#pragma unroll
      for (int d = 0; d < 4; ++d) up[d * 32] = f2bf(o[d][r] * ss[r] * nw[d]); }
  }
  __syncthreads();
#undef SLOAD
#undef SWRITE
#undef SWAIT
#undef RESC
}
}

__device__ void ph_attn_mfma(const Params& p, char* lds, int* qhead) {
  float lam;
  { float s1 = 0.f, s2 = 0.f; for (int i = 0; i < 64; ++i) { s1 += p.lq1[i] * p.lk1[i]; s2 += p.lq2[i] * p.lk2[i]; } lam = __expf(s1) - __expf(s2) + LAMBDA_INIT; }
  int* qslot = (int*)(lds + 72 * 1024);
  bool more_a = true, more_c = true;
  for (int turn = 0; more_a || more_c; ++turn) {
    const bool do_attn = more_a && (!more_c || (turn & 1) == 0);
    __syncthreads();
    if (threadIdx.x == 0) *qslot = atomicAdd(do_attn ? qhead : qhead + 4, 1);
    __syncthreads();
    const int item = *qslot;
    if (do_attn) {
      if (item >= NB * AH * (S / 128)) { more_a = false; continue; }
      const int qb = item % (S / 128), h = (item / (S / 128)) % AH, b = item / ((S / 128) * AH);
      const float nsl2 = -exp2f(-(float)(h + 1)) * LOG2E;
      const size_t row0 = (size_t)b * S;
      at::attn_item(p.proj + (row0 + qb * 128) * PLD + N_Q + h * 128, p.proj + row0 * PLD + N_K + h * 128, p.proj + row0 * PLD + N_V + h * 128,
                    p.u + (row0 + qb * 128) * D + DSSD + h * 128, qb * 128, nsl2, lam, p.attn_norm_w, p.kn2 + (size_t)(b * AH + h) * 2 * (S / 64), lds);
    } else {
      if (item >= CVT_ITEMS) { more_c = false; continue; }
      cvt_moe_item(p, item);
    }
  }
}
namespace sd {
using at::bf16x8; using at::s16x4; using at::f32x16; using at::u32x4; using at::crow; using at::cvtpk; using at::v_st; using at::v_rd_base; using at::v_rd_off; using at::tr_read;
constexpr int CH = 64, NCH = S / CH;
constexpr int L_BT = 0, L_CT = 16384, L_XV = 32768, L_TAB = 98304, L_SS = 106496;
constexpr size_t SNAP = 16384;
__device__ __forceinline__ size_t snap_off(int dir, int b, int h, int c) { return ((((size_t)dir * NB + b) * NH + h) * NCH + c) * SNAP; }

__device__ void ph_conv16(const Params& p) {
  { const int lane = threadIdx.x & 63, wv = threadIdx.x >> 6;
    for (int it = blockIdx.x * 8 + wv; it < NB * AH * 2 * (S / 64); it += gridDim.x * 8) {
      const int j = it % (S / 64), c = (it / (S / 64)) & 1, h = (it / (2 * (S / 64))) % AH, b = it / (2 * (S / 64) * AH);
      const bf16_t* kp = p.proj + ((size_t)b * S + j * 64 + lane) * PLD + N_K + h * 128 + c * 64; float ss = 0.f;
#pragma unroll
      for (int q = 0; q < 8; ++q) { const u32x4 w = *(const u32x4*)(kp + q * 8);
        const float x0 = __uint_as_float(w.x << 16), x1 = __uint_as_float(w.x & 0xffff0000u), x2 = __uint_as_float(w.y << 16), x3 = __uint_as_float(w.y & 0xffff0000u);
        const float x4 = __uint_as_float(w.z << 16), x5 = __uint_as_float(w.z & 0xffff0000u), x6 = __uint_as_float(w.w << 16), x7 = __uint_as_float(w.w & 0xffff0000u);
        ss += x0 * x0 + x1 * x1 + x2 * x2 + x3 * x3 + x4 * x4 + x5 * x5 + x6 * x6 + x7 * x7; }
      for (int o = 32; o >= 1; o >>= 1) ss = fmaxf(ss, __shfl_xor(ss, o));
      if (lane == 0) p.kn2[(size_t)((b * AH + h) * 2 + c) * (S / 64) + j] = ss; } }
  constexpr int SEG = 16, NCG = CC / 8, NU = NCG * (T / SEG);
  for (int u = blockIdx.x * NT + threadIdx.x; u < NU; u += gridDim.x * NT) {
    const int cg = u % NCG, seg = u / NCG, t0 = seg * SEG, s0 = t0 % S, chan = cg * 8;
    float w[5][8], bias[8];
#pragma unroll
    for (int j = 0; j < 5; ++j) { const float4 a = *(const float4*)(p.conv_w + j * CC + chan), c = *(const float4*)(p.conv_w + j * CC + chan + 4);
      w[j][0] = a.x; w[j][1] = a.y; w[j][2] = a.z; w[j][3] = a.w; w[j][4] = c.x; w[j][5] = c.y; w[j][6] = c.z; w[j][7] = c.w; }
    { const float4 a = *(const float4*)(p.conv_b + chan), c = *(const float4*)(p.conv_b + chan + 4);
      bias[0] = a.x; bias[1] = a.y; bias[2] = a.z; bias[3] = a.w; bias[4] = c.x; bias[5] = c.y; bias[6] = c.z; bias[7] = c.w; }
    const bf16_t* base = p.proj + (size_t)t0 * PLD + N_XBC + chan;
    u32x4 rows[SEG + 4];
#pragma unroll
    for (int i = 0; i < SEG + 4; ++i) { const int s = s0 + i - 2; rows[i] = (u32x4){0u, 0u, 0u, 0u}; if (s >= 0 && s < S) rows[i] = *(const u32x4*)(base + (ptrdiff_t)(i - 2) * PLD); }
#pragma unroll
    for (int i = 0; i < SEG; ++i) {
      float o[8];
#pragma unroll
      for (int c = 0; c < 8; ++c) o[c] = bias[c];
#pragma unroll
      for (int j = 0; j < 5; ++j) { const u32x4 rr = rows[i + j];
        o[0] += w[j][0] * __uint_as_float(rr.x << 16); o[1] += w[j][1] * __uint_as_float(rr.x & 0xffff0000u);
        o[2] += w[j][2] * __uint_as_float(rr.y << 16); o[3] += w[j][3] * __uint_as_float(rr.y & 0xffff0000u);
        o[4] += w[j][4] * __uint_as_float(rr.z << 16); o[5] += w[j][5] * __uint_as_float(rr.z & 0xffff0000u);
        o[6] += w[j][6] * __uint_as_float(rr.w << 16); o[7] += w[j][7] * __uint_as_float(rr.w & 0xffff0000u); }
#pragma unroll
      for (int c = 0; c < 8; ++c) o[c] = o[c] * __builtin_amdgcn_rcpf(1.f + __expf(-o[c]));
      u32x4 pk; pk.x = cvtpk(o[0], o[1]); pk.y = cvtpk(o[2], o[3]); pk.z = cvtpk(o[4], o[5]); pk.w = cvtpk(o[6], o[7]);
      *(u32x4*)(p.xc16 + (size_t)(t0 + i) * CC + chan) = pk;
    }
  }
}
template <bool WITH_C, bool BV>
__device__ __forceinline__ void load_chunk(const Params& p, char* lds, int b, int g, int c0) {
  constexpr int NCG = WITH_C ? 96 : 80, NP = NCG * CH / NT;
  int tid = threadIdx.x; asm volatile("" : "+v"(tid));
  const bf16_t* src = p.xc16 + ((size_t)b * S + c0) * CC;
  u32x4 v[NP];
#pragma unroll
  for (int i = 0; i < NP; ++i) { const int idx = tid + NT * i, tok = idx / NCG, cg = idx % NCG;
    const int chan = cg < 64 ? g * 512 + cg * 8 : (cg < 80 ? 1024 + g * 128 + (cg - 64) * 8 : 1280 + g * 128 + (cg - 80) * 8);
    v[i] = *(const u32x4*)(src + (size_t)tok * CC + chan); }
#pragma unroll
  for (int i = 0; i < NP; ++i) { const int idx = tid + NT * i, tok = idx / NCG, cg = idx % NCG;
    if (cg < 64) { const int hl = cg >> 3, c = (hl & 1) * 64 + (cg & 7) * 8; *(u32x4*)(lds + L_XV + (hl >> 1) * 16384 + v_st(tok, c)) = v[i]; }
    else if (cg < 80) { const int n0 = (cg - 64) * 8; if (BV) *(u32x4*)(lds + L_BT + v_st(tok, n0)) = v[i]; else *(u32x4*)(lds + L_BT + AT_KSWZ(tok, n0 * 2)) = v[i]; }
    else { const int n0 = (cg - 80) * 8; *(u32x4*)(lds + L_CT + AT_KSWZ(tok, n0 * 2)) = v[i]; } }
}
__device__ __forceinline__ float wave_incl_prefix(float v, int lane) {
#pragma unroll
  for (int o = 1; o < 64; o <<= 1) { const float t = __int_as_float(__builtin_amdgcn_ds_bpermute(((lane - o) & 63) << 2, __float_as_int(v))); if (lane >= o) v += t; }
  return v;
}
__device__ __forceinline__ float wave_incl_suffix(float v, int lane) {
#pragma unroll
  for (int o = 1; o < 64; o <<= 1) { const float t = __int_as_float(__builtin_amdgcn_ds_bpermute(((lane + o) & 63) << 2, __float_as_int(v))); if (lane + o < 64) v += t; }
  return v;
}
__device__ __forceinline__ float wave_bcast(float v, int src) { return __int_as_float(__builtin_amdgcn_ds_bpermute(src << 2, __float_as_int(v))); }
__device__ __forceinline__ bf16x8 scale_frag(s16x4 lo, s16x4 hi, const float4 w0, const float4 w1) {
  const unsigned a = ((unsigned)(unsigned short)lo[0]) | ((unsigned)(unsigned short)lo[1] << 16), b = ((unsigned)(unsigned short)lo[2]) | ((unsigned)(unsigned short)lo[3] << 16);
  const unsigned c = ((unsigned)(unsigned short)hi[0]) | ((unsigned)(unsigned short)hi[1] << 16), d = ((unsigned)(unsigned short)hi[2]) | ((unsigned)(unsigned short)hi[3] << 16);
  u32x4 r;
  r.x = cvtpk(__uint_as_float(a << 16) * w0.x, __uint_as_float(a & 0xffff0000u) * w0.y);
  r.y = cvtpk(__uint_as_float(b << 16) * w0.z, __uint_as_float(b & 0xffff0000u) * w0.w);
  r.z = cvtpk(__uint_as_float(c << 16) * w1.x, __uint_as_float(c & 0xffff0000u) * w1.y);
  r.w = cvtpk(__uint_as_float(d << 16) * w1.z, __uint_as_float(d & 0xffff0000u) * w1.w);
  return *reinterpret_cast<bf16x8*>(&r);
}
#define SD_PK(L, H) (bf16x8){L[0], L[1], L[2], L[3], H[0], H[1], H[2], H[3]}

__device__ __forceinline__ void pass_a_item(const Params& p, char* lds, char* snap, int b, int g, int dir) {
  int tid = threadIdx.x; asm volatile("" : "+v"(tid));
  const int hl = tid >> 6, lane = tid & 63, r32 = lane & 31, hi = lane >> 5, h = g * 8 + hl;
  const float a = -__expf(dir ? p.a_log_b[h] : p.a_log_f[h]);
  float* wtab = (float*)(lds + L_TAB) + hl * 64;
  const int vbx = (int)(uintptr_t)(lds + L_XV + (hl >> 1) * 16384) + v_rd_base(lane) + (hl & 1) * 1024;
  const int vbb = (int)(uintptr_t)(lds + L_BT) + v_rd_base(lane);
  f32x16 st[4][2];
#pragma unroll
  for (int nb = 0; nb < 4; ++nb)
#pragma unroll
    for (int pb = 0; pb < 2; ++pb) st[nb][pb] = f32x16{};
  for (int ci = 0; ci < NCH; ++ci) {
    const int c = dir ? (NCH - 1 - ci) : ci, c0 = c * CH;
    __syncthreads();
    load_chunk<false, true>(p, lds, b, g, c0);
    const float dtv = p.dt[((size_t)b * S + c0 + lane) * 32 + dir * 16 + h];
    const float adt = a * dtv;
    const float cum = dir ? wave_incl_suffix(adt, lane) : wave_incl_prefix(adt, lane);
    const float total = wave_bcast(cum, dir ? 0 : 63);
    wtab[lane] = __expf(total - cum) * dtv;
    const float dec = __expf(total);
    { char* sp = snap + snap_off(dir, b, h, c);
#pragma unroll
      for (int nb = 0; nb < 4; ++nb)
#pragma unroll
        for (int pb = 0; pb < 2; ++pb)
#pragma unroll
          for (int q = 0; q < 4; ++q) { const f32x16& s = st[nb][pb];
            uint2 v; v.x = cvtpk(s[4 * q + 0], s[4 * q + 1]); v.y = cvtpk(s[4 * q + 2], s[4 * q + 3]);
            *(uint2*)(sp + ((((pb * 8 + nb * 2 + (q >> 1)) * 2 + (q & 1)) * 32 + r32) * 16 + hi * 8)) = v; } }
#pragma unroll
    for (int nb = 0; nb < 4; ++nb)
#pragma unroll
      for (int pb = 0; pb < 2; ++pb)
#pragma unroll
        for (int r = 0; r < 16; ++r) st[nb][pb][r] *= dec;
    __syncthreads();
#pragma unroll
    for (int ks = 0; ks < 4; ++ks) {
      const float4 w0 = *(const float4*)(wtab + ks * 16 + hi * 8), w1 = *(const float4*)(wtab + ks * 16 + hi * 8 + 4);
      bf16x8 xf[2];
      { const s16x4 l0 = tr_read<v_rd_off(0, 0, 0)>(vbx + ks * 4096), h0 = tr_read<v_rd_off(0, 0, 1)>(vbx + ks * 4096), l1 = tr_read<v_rd_off(1, 0, 0)>(vbx + ks * 4096), h1 = tr_read<v_rd_off(1, 0, 1)>(vbx + ks * 4096);
        asm volatile("s_waitcnt lgkmcnt(0)" ::: "memory"); AT_SBAR();
        xf[0] = scale_frag(l0, h0, w0, w1); xf[1] = scale_frag(l1, h1, w0, w1); }
#pragma unroll
      for (int nb = 0; nb < 4; ++nb) {
        s16x4 bl, bh;
        asm volatile("ds_read_b64_tr_b16 %0, %1" : "=&v"(bl) : "v"(vbb + nb * 512 + ks * 4096) : "memory");
        asm volatile("ds_read_b64_tr_b16 %0, %1 offset:2048" : "=&v"(bh) : "v"(vbb + nb * 512 + ks * 4096) : "memory");
        asm volatile("s_waitcnt lgkmcnt(0)" ::: "memory"); AT_SBAR();
        const bf16x8 bfr = SD_PK(bl, bh);
        st[nb][0] = __builtin_amdgcn_mfma_f32_32x32x16_bf16(bfr, xf[0], st[nb][0], 0, 0, 0);
        st[nb][1] = __builtin_amdgcn_mfma_f32_32x32x16_bf16(bfr, xf[1], st[nb][1], 0, 0, 0);
      }
    }
  }
  __syncthreads();
}

__device__ __forceinline__ void pass_b_item(const Params& p, char* lds, const char* snap, int b, int g, int c) {
  int tid = threadIdx.x; asm volatile("" : "+v"(tid));
  const int hl = tid >> 6, lane = tid & 63, r32 = lane & 31, hi = lane >> 5, h = g * 8 + hl, c0 = c * CH;
  float4* tab = (float4*)(lds + L_TAB) + hl * 64;
  float* ssp = (float*)(lds + L_SS);
  const int vbx = (int)(uintptr_t)(lds + L_XV + (hl >> 1) * 16384) + v_rd_base(lane) + (hl & 1) * 1024;
  __syncthreads();
  load_chunk<true, false>(p, lds, b, g, c0);
  { const size_t tok = (size_t)b * S + c0 + lane;
    const float dtf = p.dt[tok * 32 + h], dtb = p.dt[tok * 32 + 16 + h];
    const float af = -__expf(p.a_log_f[h]) * dtf, ab = -__expf(p.a_log_b[h]) * dtb;
    tab[lane] = make_float4(wave_incl_prefix(af, lane) * LOG2E, wave_incl_suffix(ab, lane) * LOG2E, dtf, dtb); }
  __syncthreads();
  const float dsk = p.d_skip[h];
  f32x16 o[2][2];
#pragma unroll
  for (int lb = 0; lb < 2; ++lb) {
    const int l = lb * 32 + r32;
    const float4 tl = tab[l];
    bf16x8 cr[8];
#pragma unroll
    for (int kk = 0; kk < 8; ++kk) cr[kk] = *reinterpret_cast<const bf16x8*>(lds + L_CT + AT_KSWZ(l, (kk * 16 + hi * 8) * 2));
    f32x16 p0 = f32x16{}, p1 = f32x16{};
#pragma unroll
    for (int kk = 0; kk < 8; ++kk) { const int cb = (kk * 16 + hi * 8) * 2;
      const bf16x8 b0 = *reinterpret_cast<const bf16x8*>(lds + L_BT + AT_KSWZ(r32, cb));
      const bf16x8 b1 = *reinterpret_cast<const bf16x8*>(lds + L_BT + AT_KSWZ(32 + r32, cb));
      p0 = __builtin_amdgcn_mfma_f32_32x32x16_bf16(b0, cr[kk], p0, 0, 0, 0);
      p1 = __builtin_amdgcn_mfma_f32_32x32x16_bf16(b1, cr[kk], p1, 0, 0, 0); }
#pragma unroll
    for (int r = 0; r < 16; ++r) {
#pragma unroll
      for (int half = 0; half < 2; ++half) {
        const int s = crow(r, hi) + 32 * half; const float4 ts = tab[s];
        float m = 0.f;
        if (s <= l) m += __builtin_amdgcn_exp2f(tl.x - ts.x) * ts.z;
        if (s >= l) m += __builtin_amdgcn_exp2f(tl.y - ts.y) * ts.w;
        const float add = (s == l) ? dsk : 0.f;
        if (half) p1[r] = p1[r] * m + add; else p0[r] = p0[r] * m + add;
      }
      asm volatile("" ::: "memory");
    }
    bf16x8 pa0, pa1, pa2, pa3;
#define SD_PK4(P, BASE, OUT) do { unsigned a0 = cvtpk(P[BASE + 0], P[BASE + 1]), a1 = cvtpk(P[BASE + 2], P[BASE + 3]);   \
    unsigned b0_ = cvtpk(P[BASE + 4], P[BASE + 5]), b1_ = cvtpk(P[BASE + 6], P[BASE + 7]);                              \
    auto r0 = __builtin_amdgcn_permlane32_swap(a0, b0_, false, false); auto r1 = __builtin_amdgcn_permlane32_swap(a1, b1_, false, false); \
    u32x4 w_ = {r0[0], r1[0], r0[1], r1[1]}; OUT = *reinterpret_cast<bf16x8*>(&w_); } while (0)
    SD_PK4(p0, 0, pa0); SD_PK4(p0, 8, pa1); SD_PK4(p1, 0, pa2); SD_PK4(p1, 8, pa3);
#undef SD_PK4
#pragma unroll
    for (int d = 0; d < 2; ++d) {
      const s16x4 l0 = d ? tr_read<v_rd_off(1, 0, 0)>(vbx) : tr_read<v_rd_off(0, 0, 0)>(vbx), h0 = d ? tr_read<v_rd_off(1, 0, 1)>(vbx) : tr_read<v_rd_off(0, 0, 1)>(vbx);
      const s16x4 l1 = d ? tr_read<v_rd_off(1, 1, 0)>(vbx) : tr_read<v_rd_off(0, 1, 0)>(vbx), h1 = d ? tr_read<v_rd_off(1, 1, 1)>(vbx) : tr_read<v_rd_off(0, 1, 1)>(vbx);
      const s16x4 l2 = d ? tr_read<v_rd_off(1, 2, 0)>(vbx) : tr_read<v_rd_off(0, 2, 0)>(vbx), h2 = d ? tr_read<v_rd_off(1, 2, 1)>(vbx) : tr_read<v_rd_off(0, 2, 1)>(vbx);
      const s16x4 l3 = d ? tr_read<v_rd_off(1, 3, 0)>(vbx) : tr_read<v_rd_off(0, 3, 0)>(vbx), h3 = d ? tr_read<v_rd_off(1, 3, 1)>(vbx) : tr_read<v_rd_off(0, 3, 1)>(vbx);
      asm volatile("s_waitcnt lgkmcnt(0)" ::: "memory"); AT_SBAR();
      f32x16 od = f32x16{};
      od = __builtin_amdgcn_mfma_f32_32x32x16_bf16(pa0, SD_PK(l0, h0), od, 0, 0, 0);
      od = __builtin_amdgcn_mfma_f32_32x32x16_bf16(pa1, SD_PK(l1, h1), od, 0, 0, 0);
      od = __builtin_amdgcn_mfma_f32_32x32x16_bf16(pa2, SD_PK(l2, h2), od, 0, 0, 0);
      od = __builtin_amdgcn_mfma_f32_32x32x16_bf16(pa3, SD_PK(l3, h3), od, 0, 0, 0);
      o[lb][d] = od;
    }
  }
#pragma unroll
  for (int dir = 0; dir < 2; ++dir) {
    if (dir == 0 ? (c == 0) : (c == NCH - 1)) continue;
    const char* sp = snap + snap_off(dir, b, h, c);
#pragma unroll
    for (int d = 0; d < 2; ++d) {
      bf16x8 sf[8];
#pragma unroll
      for (int kk = 0; kk < 8; ++kk) sf[kk] = *reinterpret_cast<const bf16x8*>(sp + ((((d * 8 + kk) * 2 + hi) * 32 + r32) * 16));
#pragma unroll
      for (int lb = 0; lb < 2; ++lb) {
        f32x16 acc = f32x16{};
#pragma unroll
        for (int kk = 0; kk < 8; ++kk) { const bf16x8 cf = *reinterpret_cast<const bf16x8*>(lds + L_CT + AT_KSWZ(lb * 32 + r32, (kk * 16 + hi * 8) * 2));
          acc = __builtin_amdgcn_mfma_f32_32x32x16_bf16(cf, sf[kk], acc, 0, 0, 0); }
#pragma unroll
        for (int r = 0; r < 16; ++r) { const float4 tr = tab[lb * 32 + crow(r, hi)]; o[lb][d][r] += __builtin_amdgcn_exp2f(dir ? tr.y : tr.x) * acc[r]; }
      }
      asm volatile("" ::: "memory");
    }
  }
  asm volatile("" ::: "memory");
  const bf16_t* zp = p.proj + ((size_t)b * S + c0) * PLD + N_Z + h * HD + r32;
#pragma unroll
  for (int lb = 0; lb < 2; ++lb)
#pragma unroll
    for (int r = 0; r < 16; ++r) { const int l = lb * 32 + crow(r, hi); float ss = 0.f;
#pragma unroll
      for (int d = 0; d < 2; ++d) { const float z = bf2f(zp[(size_t)l * PLD + d * 32]); const float y = o[lb][d][r] * z * __builtin_amdgcn_rcpf(1.f + __expf(-z)); o[lb][d][r] = y; ss += y * y; }
      ss += __shfl_xor(ss, 16); ss += __shfl_xor(ss, 8); ss += __shfl_xor(ss, 4); ss += __shfl_xor(ss, 2); ss += __shfl_xor(ss, 1);
      if (r32 == 0) ssp[hl * 64 + l] = ss;
      if ((r & 3) == 3) asm volatile("" ::: "memory"); }
  __syncthreads();
  const float nw0 = p.ssd_norm_w[h * HD + r32], nw1 = p.ssd_norm_w[h * HD + 32 + r32];
  bf16_t* up = p.u + ((size_t)b * S + c0) * D + h * HD + r32;
#pragma unroll
  for (int lb = 0; lb < 2; ++lb)
#pragma unroll
    for (int r = 0; r < 16; ++r) { const int l = lb * 32 + crow(r, hi); float ss = 0.f;
#pragma unroll
      for (int q = 0; q < 8; ++q) ss += ssp[q * 64 + l];
      const float rstd = rsqrtf(ss * (1.f / 512.f) + 1e-5f);
      up[(size_t)l * D] = f2bf(o[lb][0][r] * rstd * nw0); up[(size_t)l * D + 32] = f2bf(o[lb][1][r] * rstd * nw1); }
}
}

__device__ void ph_ssd_a(const Params& p, char* lds, char* snap) {
  for (int item = blockIdx.x; item < NB * 2 * 2; item += gridDim.x) { const int dir = item & 1, g = (item >> 1) & 1, b = item >> 2; sd::pass_a_item(p, lds, snap, b, g, dir); }
}
__device__ void ph_ssd_b(const Params& p, char* lds, const char* snap) {
  for (int item = blockIdx.x; item < NB * 2 * sd::NCH; item += gridDim.x) { const int c = item % sd::NCH, g = (item / sd::NCH) & 1, b = item / (2 * sd::NCH); sd::pass_b_item(p, lds, snap, b, g, c); }
}
__device__ void ph_inproj(const Params& p, LAS unsigned char* lds) {
  pg8::Gemm g{p.xb, p.WinT, D, 0, 0}; pg8::OrderStatic Sd; Sd.init(T, NPROJ, gridDim.x, blockIdx.x);
  EpiProj E{p.proj, p.dt, p.dt_bias_f, p.dt_bias_b};
  pg8::gemm_phase<false, false>(lds, g, Sd, E);
}
__device__ void ph_outproj(const Params& p, LAS unsigned char* lds) {
  pg8::Gemm g{p.u, p.WoutT, D, 0, 0}; pg8::OrderStatic Sd; Sd.init(T, D, gridDim.x, blockIdx.x);
  EpiOut E{p.x, p.h1};
  pg8::gemm_phase<false, false>(lds, g, Sd, E);
}
__device__ __forceinline__ int ld_agent(const int* p) { return __hip_atomic_load(p, __ATOMIC_RELAXED, __HIP_MEMORY_SCOPE_AGENT); }
__device__ __forceinline__ float ld_agent(const float* p) { return __hip_atomic_load(p, __ATOMIC_RELAXED, __HIP_MEMORY_SCOPE_AGENT); }
__device__ void ph_ln_route(const Params& p, char* ldsg, LAS unsigned char* lds) {
  typedef short bf16x8 __attribute__((ext_vector_type(8)));
  LAS int* cntl = (LAS int*)lds;
  int tid = threadIdx.x; asm volatile("" : "+v"(tid));
  const int lane = tid & 63, wv = tid >> 6;
  float* lg = (float*)(ldsg + 1024) + wv * 512;
  float gm[32], bt[32];
#pragma unroll
  for (int g = 0; g < 4; ++g) { const f32x4 a = *(const f32x4*)(p.ln1_g + g * 512 + lane * 8), b = *(const f32x4*)(p.ln1_g + g * 512 + lane * 8 + 4);
    const f32x4 c = *(const f32x4*)(p.ln1_b + g * 512 + lane * 8), d = *(const f32x4*)(p.ln1_b + g * 512 + lane * 8 + 4);
#pragma unroll
    for (int j = 0; j < 4; ++j) { gm[g * 8 + j] = a[j]; gm[g * 8 + 4 + j] = b[j]; bt[g * 8 + j] = c[j]; bt[g * 8 + 4 + j] = d[j]; } }
  const float rbias = p.router_bias[lane];
  for (int tb = blockIdx.x; tb < T / 64; tb += gridDim.x) {
    __syncthreads();
    if (tid < NE) cntl[tid] = 0;
    const int t0 = tb * 64 + wv * 8;
    for (int i = 0; i < 8; ++i) {
      const float* vp = p.h1 + (size_t)(t0 + i) * D; float v[32]; float s = 0.f;
#pragma unroll
      for (int g = 0; g < 4; ++g) { const f32x4 a = *(const f32x4*)(vp + g * 512 + lane * 8), b = *(const f32x4*)(vp + g * 512 + lane * 8 + 4);
#pragma unroll
        for (int j = 0; j < 4; ++j) { v[g * 8 + j] = a[j]; v[g * 8 + 4 + j] = b[j]; s += a[j] + b[j]; } }
      const float mu = wave_sum(s) * (1.f / D); float q = 0.f;
#pragma unroll
      for (int j = 0; j < 32; ++j) { const float d = v[j] - mu; q += d * d; }
      const float rstd = rsqrtf(wave_sum(q) * (1.f / D) + 1e-5f);
#pragma unroll
      for (int g = 0; g < 4; ++g) { float o[8];
#pragma unroll
        for (int j = 0; j < 8; ++j) o[j] = (v[g * 8 + j] - mu) * rstd * gm[g * 8 + j] + bt[g * 8 + j];
        u32x4 w; w.x = cvt_pk_bf16(o[0], o[1]); w.y = cvt_pk_bf16(o[2], o[3]); w.z = cvt_pk_bf16(o[4], o[5]); w.w = cvt_pk_bf16(o[6], o[7]);
        *(u32x4*)(p.h1b + (size_t)(t0 + i) * D + g * 512 + lane * 8) = w;
        uint2 w8; { int a = 0, b = 0; a = __builtin_amdgcn_cvt_pk_fp8_f32(o[0], o[1], a, false); a = __builtin_amdgcn_cvt_pk_fp8_f32(o[2], o[3], a, true); b = __builtin_amdgcn_cvt_pk_fp8_f32(o[4], o[5], b, false); b = __builtin_amdgcn_cvt_pk_fp8_f32(o[6], o[7], b, true); w8.x = (unsigned)a; w8.y = (unsigned)b; }
        *(uint2*)(p.h1q + (size_t)(t0 + i) * D + g * 512 + lane * 8) = w8; }
    }
    __threadfence_block(); asm volatile("s_waitcnt vmcnt(0)" ::: "memory");
    f32x4 acc[4];
#pragma unroll
    for (int nb = 0; nb < 4; ++nb) acc[nb] = (f32x4){0.f, 0.f, 0.f, 0.f};
    const bf16_t* ap = p.h1b + (size_t)(t0 + (lane & 7)) * D + 8 * (lane >> 4);
    const bf16_t* bp = p.WrT + (size_t)(lane & 15) * D + 8 * (lane >> 4);
#pragma unroll 4
    for (int kk = 0; kk < D / 32; ++kk) {
      const bf16x8 a = *(const bf16x8*)(ap + kk * 32);
#pragma unroll
      for (int nb = 0; nb < 4; ++nb) { const bf16x8 b = *(const bf16x8*)(bp + (size_t)nb * 16 * D + kk * 32); acc[nb] = __builtin_amdgcn_mfma_f32_16x16x32_bf16(a, b, acc[nb], 0, 0, 0); }
    }
    if ((lane >> 4) < 2) {
#pragma unroll
      for (int nb = 0; nb < 4; ++nb)
#pragma unroll
        for (int i = 0; i < 4; ++i) lg[(4 * (lane >> 4) + i) * 64 + nb * 16 + (lane & 15)] = acc[nb][i];
    }
    __syncthreads();
    for (int ti = 0; ti < 8; ++ti) {
      const int t = t0 + ti;
      const float sc = 1.f / (1.f + __expf(-lg[ti * 64 + lane]));
      const float bz = sc + rbias;
      int rk = 0;
#pragma unroll
      for (int j = 1; j < 8; ++j) { const float o = __shfl_xor(bz, j); const int oi = lane ^ j; rk += (o > bz || (o == bz && oi < lane)) ? 1 : 0; }
      float gs = rk < 2 ? bz : 0.f;
      gs += __shfl_xor(gs, 1); gs += __shfl_xor(gs, 2); gs += __shfl_xor(gs, 4);
      const int g = lane >> 3; int grk = 0;
#pragma unroll
      for (int j = 1; j < 8; ++j) { const float o = __shfl_xor(gs, j * 8); const int og = g ^ j; grk += (o > gs || (o == gs && og < g)) ? 1 : 0; }
      const bool gsel = grk < 4;
      const float mb = gsel ? bz : -INFINITY;
      int erk = 0;
      for (int j = 1; j < 64; ++j) { const float o = __shfl_xor(mb, j); const int oi = lane ^ j; erk += (o > mb || (o == mb && oi < lane)) ? 1 : 0; }
      const bool sel = gsel && erk < 8;
      const float gsum = wave_sum(sel ? sc : 0.f);
      if (sel) {
        const int lr = __hip_atomic_fetch_add(&cntl[lane], 1, __ATOMIC_RELAXED, __HIP_MEMORY_SCOPE_WORKGROUP);
        p.assign[t * 8 + erk] = lane | (lr << 8); p.gate[t * 8 + erk] = sc / gsum * 2.5f;
      }
    }
    __syncthreads();
    if (tid < NE) p.blkcnt[tb * NE + tid] = cntl[tid];
  }
}
__device__ void ph_place(const Params& p, LAS unsigned char* lds) {
  LAS int* part = (LAS int*)lds;
  LAS int* parta = part + 512;
  LAS int* base = parta + 512;
  LAS int* total = base + 64;
  LAS int* pstart = total + 64;
  const int tid = threadIdx.x, e = tid & 63, pt = tid >> 6;
  for (int tb = blockIdx.x; tb < T / 64; tb += gridDim.x) {
    __syncthreads();
    int slo = 0, sall = 0;
    for (int b = pt * 32; b < pt * 32 + 32; ++b) { const int c = ld_agent(p.blkcnt + b * NE + e); sall += c; slo += (b < tb) ? c : 0; }
    part[pt * 64 + e] = slo; parta[pt * 64 + e] = sall;
    __syncthreads();
    if (tid < 64) {
      int b0 = 0, t0 = 0;
#pragma unroll
      for (int q = 0; q < 8; ++q) { b0 += part[q * 64 + tid]; t0 += parta[q * 64 + tid]; }
      base[tid] = b0; total[tid] = t0;
      const int padded = (t0 + 255) & ~255;
      int incl = padded;
      for (int o = 1; o < 64; o <<= 1) { const int v = __shfl_up(incl, o); if (tid >= o) incl += v; }
      pstart[tid] = incl - padded;
      if (tid == 63) pstart[64] = incl;
    }
    __syncthreads();
    {
      const int t = tb * 64 + (tid >> 3), k = tid & 7;
      const int a = ld_agent(p.assign + t * 8 + k), ee = a & 255, lr = a >> 8;
      const int row = pstart[ee] + base[ee] + lr;
      p.row_tok[row] = t; p.row_gate[row] = ld_agent(p.gate + t * 8 + k); p.pos[t * 8 + k] = row;
      if (tid < 64) { const int srow = pstart[64] + tb * 64 + tid; p.row_tok[srow] = tb * 64 + tid; p.row_gate[srow] = 1.0f; }
    }
    if (tb == blockIdx.x) {
      for (int e2 = blockIdx.x; e2 < NE; e2 += gridDim.x) {
        const int r0 = pstart[e2] + total[e2], r1 = pstart[e2 + 1];
        for (int r = r0 + tid; r < r1; r += NT) { p.row_tok[r] = 0; p.row_gate[r] = 0.f; }
        for (int j = pstart[e2] / 256 + tid; j < r1 / 256; j += NT) p.tile_exp[j] = e2;
      }
      if (blockIdx.x == 0) {
        const int nr = pstart[64] / 256;
        for (int j = tid; j < T / 256; j += NT) p.tile_exp[nr + j] = NE;
        if (tid == 0) { p.meta[0] = nr; p.meta[1] = nr + T / 256; }
      }
    }
  }
}
struct OrderMoE {
  LAS const int* ulist; int n;
  LAS const unsigned* tab; int tstride;
  __device__ __forceinline__ bool next(int i, pg8::Unit& u) const { if (i >= n) return false; u.pm = ulist[i * 4 + 0]; u.pn = ulist[i * 4 + 1]; u.bn = ulist[i * 4 + 2]; u.aux = i; return true; }
  __device__ __forceinline__ unsigned row_off(int i, int row) const { return tab[i * tstride + row]; }
};
template <int TABLES>
__device__ __forceinline__ OrderMoE moe_order(const Params& p, LAS unsigned char* lds, int npn, int tile0, int ntiles, int rowbytes) {
  LAS int* ulist = (LAS int*)(lds + LDS_TAB); LAS unsigned* tab = (LAS unsigned*)(lds + LDS_TAB + 1024);
  const int G = gridDim.x, c = blockIdx.x, mpc = 32 / npn; int n = 0;
  __syncthreads();
  for (int i = 0; i < 60; ++i) {
    int U; if (G == 256) U = ((i * 8 + (c & 7)) * 32 + (c >> 3)); else U = i * G + c;
    const int chunk = U >> 5, w = U & 31, j = chunk * mpc + (w % mpc), pn = w / mpc;
    if (j >= ntiles) break;
    const int tile = tile0 + j, e = ld_agent(p.tile_exp + tile);
    if (threadIdx.x == 0) { ulist[i * 4 + 0] = tile; ulist[i * 4 + 1] = pn; ulist[i * 4 + 2] = e * npn + pn; ulist[i * 4 + 3] = e; }
    if (TABLES == 2) { for (int r = threadIdx.x; r < 256; r += NT) tab[i * 256 + r] = (unsigned)(tile * 256 + r) * (unsigned)rowbytes; }
    if (TABLES == 1) { for (int r = threadIdx.x; r < 256; r += NT) { tab[i * 512 + r] = (unsigned)ld_agent(p.row_tok + tile * 256 + r) * (unsigned)rowbytes; tab[i * 512 + 256 + r] = __float_as_uint(ld_agent(p.row_gate + tile * 256 + r)); } }
    n = i + 1;
  }
  __syncthreads();
  return OrderMoE{ulist, n, tab, TABLES == 2 ? 256 : 512};
}
struct EpiGU {
  static constexpr bool PERM = true;
  unsigned char* H; LAS const unsigned* tab;
  __device__ __forceinline__ void operator()(const f32x4 (&acc)[2][2][4][2], const pg8::Unit& u, int wr, int wc, int fr, int fq) const {
    asm volatile("" : "+v"(fr), "+v"(fq));
    const int col0 = u.pn * 128 + wc * 32 + 8 * fq;
#pragma unroll
    for (int ai = 0; ai < 2; ++ai)
#pragma unroll
      for (int m = 0; m < 4; ++m) { const int r = ai * 128 + wr * 64 + m * 16 + fr; const float gt = __uint_as_float(tab[u.aux * 512 + 256 + r]) * H8S;
        float h[8];
#pragma unroll
        for (int j = 0; j < 4; ++j) { const float g0 = acc[ai][0][m][0][j], g1 = acc[ai][0][m][1][j];
          h[j] = g0 * __builtin_amdgcn_rcpf(1.f + __expf(-g0)) * acc[ai][1][m][0][j] * gt; h[4 + j] = g1 * __builtin_amdgcn_rcpf(1.f + __expf(-g1)) * acc[ai][1][m][1][j] * gt; }
#pragma unroll
        for (int j = 0; j < 8; ++j) h[j] = fminf(fmaxf(h[j], -448.f), 448.f);
        uint2 w; { int a = 0, b = 0; a = __builtin_amdgcn_cvt_pk_fp8_f32(h[0], h[1], a, false); a = __builtin_amdgcn_cvt_pk_fp8_f32(h[2], h[3], a, true); b = __builtin_amdgcn_cvt_pk_fp8_f32(h[4], h[5], b, false); b = __builtin_amdgcn_cvt_pk_fp8_f32(h[6], h[7], b, true); w.x = (unsigned)a; w.y = (unsigned)b; }
        *(uint2*)(H + (size_t)(u.pm * 256 + r) * DE + col0) = w; }
  }
};
__device__ void ph_gateup(const Params& p, LAS unsigned char* lds) {
  const int ntot = ld_agent(p.meta + 1);
  const OrderMoE S = moe_order<1>(p, lds, 4, 0, ntot, D);
  pg8::Gemm g{(const bf16_t*)p.h1q, p.WguT, D / 2, 0x7a7a7a7a  , 0x7f7f7f7f}; EpiGU E{(unsigned char*)p.H, S.tab};
  pg8::gemm_phase<true, true>(lds, g, S, E);
}
struct EpiDown {
  static constexpr bool PERM = true;
  unsigned char* Y;
  __device__ __forceinline__ void operator()(const f32x4 (&acc)[2][2][4][2], const pg8::Unit& u, int wr, int wc, int fr, int fq) const {
    asm volatile("" : "+v"(fr), "+v"(fq));
    const int col0 = u.pn * 256 + wc * 32 + 8 * fq;
#pragma unroll
    for (int ai = 0; ai < 2; ++ai)
#pragma unroll
      for (int m = 0; m < 4; ++m) { unsigned char* rowp = Y + (size_t)(u.pm * 256 + ai * 128 + wr * 64 + m * 16 + fr) * D + col0;
#pragma unroll
        for (int bj = 0; bj < 2; ++bj) { const f32x4 v0 = acc[ai][bj][m][0], v1 = acc[ai][bj][m][1];
          uint2 w; { int a = 0, b = 0; a = __builtin_amdgcn_cvt_pk_fp8_f32(v0[0], v0[1], a, false); a = __builtin_amdgcn_cvt_pk_fp8_f32(v0[2], v0[3], a, true); b = __builtin_amdgcn_cvt_pk_fp8_f32(v1[0], v1[1], b, false); b = __builtin_amdgcn_cvt_pk_fp8_f32(v1[2], v1[3], b, true); w.x = (unsigned)a; w.y = (unsigned)b; }
          *(uint2*)(rowp + bj * 128) = w; } }
  }
};
__device__ void ph_down(const Params& p, LAS unsigned char* lds) {
  const int ntot = ld_agent(p.meta + 1);
  const OrderMoE S = moe_order<2>(p, lds, 8, 0, ntot, DE);
  pg8::Gemm g{p.H, p.WdT, DE / 2, 0x7a7a7a7a  , (int)0x81818181u  }; EpiDown E{(unsigned char*)p.Y};
  pg8::gemm_phase<true, true>(lds, g, S, E);
}
__device__ __forceinline__ void acc_fp8x8(float* v, uint2 w) {
  const auto a = __builtin_amdgcn_cvt_pk_f32_fp8((int)w.x, false), b = __builtin_amdgcn_cvt_pk_f32_fp8((int)w.x, true), c = __builtin_amdgcn_cvt_pk_f32_fp8((int)w.y, false), d = __builtin_amdgcn_cvt_pk_f32_fp8((int)w.y, true);
  v[0] += a[0]; v[1] += a[1]; v[2] += b[0]; v[3] += b[1]; v[4] += c[0]; v[5] += c[1]; v[6] += d[0]; v[7] += d[1];
}
__device__ void ph_combine(const Params& p) {
  const int lane = threadIdx.x & 63, wv = threadIdx.x >> 6;
  const int srow0 = ld_agent(p.meta + 0) * 256;
  const unsigned char* Yb = (const unsigned char*)p.Y;
  for (int row = blockIdx.x * 8 + wv; row < T; row += gridDim.x * 8) {
    float v[32];
#pragma unroll
    for (int j = 0; j < 32; ++j) v[j] = 0.f;
    int yr[8];
#pragma unroll
    for (int k = 0; k < 8; ++k) yr[k] = ld_agent(p.pos + row * 8 + k);
#pragma unroll
    for (int g = 0; g < 4; ++g) acc_fp8x8(v + g * 8, *(const uint2*)(Yb + (size_t)(srow0 + row) * D + g * 512 + lane * 8));
#pragma unroll
    for (int k = 0; k < 8; ++k) {
#pragma unroll
      for (int g = 0; g < 4; ++g) acc_fp8x8(v + g * 8, *(const uint2*)(Yb + (size_t)yr[k] * D + g * 512 + lane * 8)); }
    { const bf16_t* hp = p.h1b + (size_t)row * D;
#pragma unroll
      for (int g = 0; g < 4; ++g) { const u32x4 hb = *(const u32x4*)(hp + g * 512 + lane * 8);
        v[g * 8 + 0] = v[g * 8 + 0] * Y8I + ALPHA * __uint_as_float(hb.x << 16); v[g * 8 + 1] = v[g * 8 + 1] * Y8I + ALPHA * __uint_as_float(hb.x & 0xffff0000u);
        v[g * 8 + 2] = v[g * 8 + 2] * Y8I + ALPHA * __uint_as_float(hb.y << 16); v[g * 8 + 3] = v[g * 8 + 3] * Y8I + ALPHA * __uint_as_float(hb.y & 0xffff0000u);
        v[g * 8 + 4] = v[g * 8 + 4] * Y8I + ALPHA * __uint_as_float(hb.z << 16); v[g * 8 + 5] = v[g * 8 + 5] * Y8I + ALPHA * __uint_as_float(hb.z & 0xffff0000u);
        v[g * 8 + 6] = v[g * 8 + 6] * Y8I + ALPHA * __uint_as_float(hb.w << 16); v[g * 8 + 7] = v[g * 8 + 7] * Y8I + ALPHA * __uint_as_float(hb.w & 0xffff0000u); } }
    float s = 0.f;
#pragma unroll
    for (int j = 0; j < 32; ++j) s += v[j];
    const float mu = wave_sum(s) * (1.f / D); float q = 0.f;
#pragma unroll
    for (int j = 0; j < 32; ++j) { const float d = v[j] - mu; q += d * d; }
    const float rstd = rsqrtf(wave_sum(q) * (1.f / D) + 1e-5f);
    float* op = p.out + (size_t)row * D;
#pragma unroll
    for (int g = 0; g < 4; ++g) { const int c0 = g * 512 + lane * 8; f32x4 a, b;
#pragma unroll
      for (int j = 0; j < 4; ++j) { a[j] = (v[g * 8 + j] - mu) * rstd * p.ln2_g[c0 + j] + p.ln2_b[c0 + j]; b[j] = (v[g * 8 + 4 + j] - mu) * rstd * p.ln2_g[c0 + 4 + j] + p.ln2_b[c0 + 4 + j]; }
      *(f32x4*)(op + c0) = a; *(f32x4*)(op + c0 + 4) = b; }
  }
}

__global__ void __launch_bounds__(NT) k_mega(Params p_arg) {
#if defined(__HIP_DEVICE_COMPILE__)
  extern __shared__ __attribute__((aligned(16))) unsigned char lds_raw[];
  LAS unsigned char* lds = (LAS unsigned char*)lds_raw;
  float* smem = (float*)lds_raw;
#ifndef ONLY
#define ONLY -1
#endif
  typedef const __attribute__((address_space(4))) Params* KP;
  const KP pk = (KP)__builtin_amdgcn_kernarg_segment_ptr();
  volatile LAS unsigned* bst = (volatile LAS unsigned*)(lds + LDS_BYTES - 16);
  if (threadIdx.x == 0) { bst[0] = 0u; bst[1] = 0u; }
  __syncthreads();
  XcdBarrier gbar;
  { KP q_ = pk; asm volatile("" : "+s"(q_)); gbar = xcd_barrier_post(q_->bar, bst); }
#define GSYNC() xcd_barrier(gbar)
#ifndef DUP
#define DUP -1
#endif
#define RUN1(n, pass, call) do { if (ONLY < 0 || ONLY == n) { KP q_ = pk; asm volatile("" : "+s"(q_)); const Params p = *q_; const int dup_pass = pass; (void)dup_pass; call; } } while (0)
#define RUN(n, call) do { RUN1(n, 0, call); if (DUP == n) { GSYNC(); RUN1(n, 1, call); } } while (0)
  RUN(0, ph_convert(p)); GSYNC();
  RUN(1, ph_inproj(p, lds)); GSYNC();
  RUN(2, sd::ph_conv16(p)); GSYNC();
  RUN(3, ph_ssd_a(p, (char*)lds_raw, (char*)p.out)); RUN(4, ph_attn_mfma(p, (char*)lds_raw, p.meta + 8 + dup_pass)); GSYNC();
  RUN(5, ph_ssd_b(p, (char*)lds_raw, (const char*)p.out)); GSYNC();
  RUN(6, ph_outproj(p, lds)); GSYNC();
  RUN(7, ph_ln_route(p, (char*)lds_raw, lds)); GSYNC();
  RUN(10, ph_place(p, lds)); GSYNC();
  RUN(11, ph_gateup(p, lds)); GSYNC();
  RUN(12, ph_down(p, lds)); GSYNC();
  RUN(13, ph_combine(p));
#endif
}
}

extern "C" void kernel_launch(void* const* d_in, const int* in_sizes, int n_in, void* d_out, int out_size, void* d_ws, size_t ws_size, hipStream_t stream) {
  Params p{};
  const float* const* in = (const float* const*)d_in;
  p.x = in[0]; p.w_in = in[1]; p.conv_w = in[2]; p.conv_b = in[3]; p.dt_bias_f = in[4]; p.dt_bias_b = in[5]; p.a_log_f = in[6]; p.a_log_b = in[7];
  p.d_skip = in[8]; p.ssd_norm_w = in[9]; p.lq1 = in[10]; p.lk1 = in[11]; p.lq2 = in[12]; p.lk2 = in[13]; p.attn_norm_w = in[14]; p.w_out = in[15];
  p.ln1_g = in[16]; p.ln1_b = in[17]; p.w_router = in[18]; p.router_bias = in[19]; p.wg_e = in[20]; p.wu_e = in[21]; p.wd_e = in[22];
  p.wg_s = in[23]; p.wu_s = in[24]; p.wd_s = in[25]; p.ln2_g = in[26]; p.ln2_b = in[27];
  p.out = (float*)d_out;
  char* w = (char*)d_ws; size_t o = 0;
  auto take = [&](size_t bytes) { char* r = w + o; o += (bytes + 255) / 256 * 256; return r; };
  char* reg1 = w + o;
  p.xb = (bf16_t*)take((size_t)T * D * 2); p.WinT = (bf16_t*)take((size_t)NPROJ * D * 2); p.WoutT = (bf16_t*)take((size_t)D * D * 2);
  p.WguT = (bf16_t*)take((size_t)(NE + 1) * 1024 * D); p.proj = (bf16_t*)take((size_t)T * PLD * 2); p.u = (bf16_t*)take((size_t)T * D * 2);
  if ((size_t)((w + o) - reg1) < (size_t)MAXROWS * D * 2) take((size_t)MAXROWS * D * 2 - (size_t)((w + o) - reg1));
  const size_t reg1_bytes = (size_t)((w + o) - reg1);
  p.Y = (bf16_t*)reg1;
  if ((size_t)MAXROWS * D * 2 > reg1_bytes) { fprintf(stderr, "kernel_launch: region 1 too small for Y\n"); return; }
  char* reg2 = take((size_t)MAXROWS * DE);
  p.H = (bf16_t*)reg2; p.xc16 = (bf16_t*)reg2;
  p.h1b = (bf16_t*)take((size_t)T * D * 2); p.WdT = (bf16_t*)take((size_t)(NE + 1) * D * DE); p.h1q = (unsigned char*)take((size_t)T * D);
  p.dt = (float*)take((size_t)T * 32 * 4); p.kn2 = (float*)take((size_t)NB * AH * 2 * (S / 64) * 4); p.WrT = (bf16_t*)take((size_t)NE * D * 2); p.gate = (float*)take((size_t)T * 8 * 4);
  p.assign = (int*)take((size_t)T * 8 * 4); p.pos = (int*)take((size_t)T * 8 * 4); p.blkcnt = (int*)take((size_t)(T / 64) * NE * 4);
  p.row_tok = (int*)take((size_t)MAXROWS * 4); p.row_gate = (float*)take((size_t)MAXROWS * 4); p.tile_exp = (int*)take((size_t)MAXTILES * 4);
  p.bar = (unsigned*)take((size_t)XCD_BAR_WORDS * 4 + 256); p.meta = (int*)(p.bar + XCD_BAR_WORDS);
  p.h1 = (float*)d_out;
  if (o > ws_size) { fprintf(stderr, "kernel_launch: ws too small: need %zu have %zu\n", o, ws_size); return; }
  static int grid_blocks = 0;
  if (!grid_blocks) {
    int dev = 0, cus = 0, per_cu = 0;
    hipGetDevice(&dev);
    hipDeviceGetAttribute(&cus, hipDeviceAttributeMultiprocessorCount, dev);
    if (hipFuncSetAttribute((const void*)k_mega, hipFuncAttributeMaxDynamicSharedMemorySize, LDS_BYTES) != hipSuccess) { fprintf(stderr, "kernel_launch: hipFuncSetAttribute failed\n"); return; }
    hipOccupancyMaxActiveBlocksPerMultiprocessor(&per_cu, k_mega, NT, LDS_BYTES);
    if (per_cu < 1) { fprintf(stderr, "kernel_launch: occupancy query says 0 blocks/CU\n"); return; }
    grid_blocks = cus;
  }
  if (hipMemsetAsync(p.bar, 0, (size_t)XCD_BAR_WORDS * 4 + 256, stream) != hipSuccess) { fprintf(stderr, "kernel_launch: memset failed\n"); return; }
  hipLaunchKernelGGL(k_mega, dim3(grid_blocks), dim3(NT), LDS_BYTES, stream, p);
  const hipError_t le = hipPeekAtLastError();
  if (le != hipSuccess) fprintf(stderr, "kernel_launch: launch failed: %s (grid %d)\n", hipGetErrorString(le), grid_blocks);
}
```

```cpp
#include <hip/hip_runtime.h>
#include <cstdio>
#include <cstdint>

namespace {
constexpr int D = 2048, NB = 8, S = 2048, T = NB * S;
constexpr int DSSD = 1024, DATT = 1024, NH = 16, HD = 64, NS = 128, CC = 1536;
constexpr int AH = 8, NE = 64, DE = 512, PW = 5664;
constexpr int O_DT = 2560, O_Q = 2592;
constexpr int N_Z = 0, N_XBC = 1024, N_Q = 2560, N_K = 3584, N_V = 4608, PLD = 5632, NPROJ = 5888;
constexpr float ALPHA = 1.189207115002721f;
constexpr float LAMBDA_INIT = 0.2f;
constexpr float LOG2E = 1.4426950408889634f;
constexpr float QS = 0.125f * LOG2E;
constexpr float W8S = 32.f, H8S = 8.f, Y8S = 32.f, Y8I = 1.f / 32.f;
constexpr int NT = 512;
constexpr int LDS_BYTES = 152 * 1024;
constexpr int LDS_TAB = 128 * 1024;
constexpr int MAXROWS_R = NE * 256 + T * 8;
constexpr int MAXROWS = MAXROWS_R + T;
constexpr int MAXTILES = MAXROWS / 256;

typedef unsigned short bf16_t;
#define LAS __attribute__((address_space(3)))

struct Params {
  const float *x, *w_in, *conv_w, *conv_b, *dt_bias_f, *dt_bias_b, *a_log_f, *a_log_b, *d_skip, *ssd_norm_w;
  const float *lq1, *lk1, *lq2, *lk2, *attn_norm_w, *w_out, *ln1_g, *ln1_b, *w_router, *router_bias;
  const float *wg_e, *wu_e, *wd_e, *wg_s, *wu_s, *wd_s, *ln2_g, *ln2_b;
  float* out;
  bf16_t *xb, *WoutT, *WguT, *WdT, *proj, *u, *h1b, *H, *Y, *xc16, *WrT;
  float *dt, *h1, *gate, *row_gate, *kn2;
  int *assign, *blkcnt, *row_tok, *pos, *tile_exp, *meta;
  unsigned* bar;
  unsigned char* h1q;
  signed char *xq, *WinQ; float *sx, *sw; unsigned* colmax;
};

__device__ __forceinline__ int tid_fresh() { int t = threadIdx.x; asm volatile("" : "+v"(t)); return t; }
__device__ __forceinline__ float silu_f(float x) { return x / (1.f + __expf(-x)); }
__device__ __forceinline__ float softplus_f(float x) { return x > 20.f ? x : __logf(1.f + __expf(x)); }
__device__ __forceinline__ float wave_sum(float v) { for (int o = 32; o >= 1; o >>= 1) v += __shfl_xor(v, o); return v; }
__device__ __forceinline__ float bf2f(bf16_t b) { return __uint_as_float(((unsigned)b) << 16); }
__device__ __forceinline__ bf16_t f2bf(float f) { unsigned u = __float_as_uint(f); u += 0x7FFFu + ((u >> 16) & 1u); return (bf16_t)(u >> 16); }
}

namespace pg8 {
#define PG8_LAS __attribute__((address_space(3)))
typedef unsigned short bf16_t;
typedef short bf16x8 __attribute__((ext_vector_type(8)));
typedef float f32x4 __attribute__((ext_vector_type(4)));
typedef unsigned u32x4 __attribute__((ext_vector_type(4)));
typedef int v8i __attribute__((ext_vector_type(8)));
typedef int v4i __attribute__((ext_vector_type(4)));
constexpr int BM = 256, BK = 64, HALF = 128, HTB = HALF * BK * 2  , STAGE_BYTES = 8 * HTB, NXCD = 8, WGM = 8;

__host__ __device__ __forceinline__ int lds_byte(int r, int c) { const int st = (r >> 4) * 2 + (c >> 5), rr = r & 15, cc = c & 31, ob = rr * 64 + cc * 2; return st * 1024 + (ob ^ (((ob >> 9) & 1) << 5)); }
__host__ __device__ __forceinline__ void stage_rc(int b, int& R, int& C) { const int st = b / 1024, sb = b % 1024, swz = sb ^ (((sb >> 9) & 1) << 5); R = (st >> 1) * 16 + swz / 64; C = (st & 1) * 32 + (swz % 64) / 2; }
__host__ __device__ __forceinline__ int perm32(int rho) { const int n = rho >> 4, i = rho & 15; return 8 * (i >> 2) + 4 * n + (i & 3); }

struct Unit { int pm, pn, bn, aux; };
struct Gemm { const bf16_t* A; const bf16_t* Bt; int K; int sc_w, sc_a; };


__device__ __forceinline__ unsigned cvt_pk_bf16(float lo, float hi) { unsigned r; asm volatile("v_cvt_pk_bf16_f32 %0, %1, %2" : "=v"(r) : "v"(lo), "v"(hi)); return r; }
struct OrderStatic {
    int nM, nN, nwg, G, c;
    __device__ void init(int M, int N, int G_, int c_) { nM = M / BM; nN = N / BM; nwg = nM * nN; G = G_; c = c_; }
    __device__ bool next(int i, Unit& u) const {
        const long L = (long)i * G + c; if (L >= nwg) return false;
        int wgid = (int)L; { const int q = nwg / NXCD, r = nwg % NXCD, xcd = wgid % NXCD, off = wgid / NXCD; wgid = (xcd < r ? xcd * (q + 1) : r * (q + 1) + (xcd - r) * q) + off; }
        const int nig = WGM * nN, gid = wgid / nig, fm = gid * WGM, gsz = (nM - fm) < WGM ? (nM - fm) : WGM;
        u.pm = fm + ((wgid % nig) % gsz); u.pn = (wgid % nig) / gsz; u.bn = u.pn; u.aux = i; return true;
    }
    __device__ __forceinline__ unsigned row_off(int, int) const { return 0u; }
};
template <bool GATHER, bool FP8, class Epi, class Sched, bool I8 = false>
__device__ __forceinline__ void gemm_phase(PG8_LAS unsigned char* lds, const Gemm g, const Sched& S, const Epi& E) {
    int tid = threadIdx.x; asm volatile("" : "+v"(tid));
    const int wid = __builtin_amdgcn_readfirstlane(tid >> 6), lane = tid & 63, wr = wid >> 2, wc = wid & 3, fr = lane & 15, fq = lane >> 4;
    const int K = g.K; int nt = K / BK; asm volatile("" : "+s"(nt));
#define PG8_STAMP() do {} while (0)
    PG8_STAMP();
    unsigned voffA[2], voffB[2];
#pragma unroll
    for (int i = 0; i < 2; ++i) { int R, C; stage_rc(tid * 16 + i * 8192, R, C); const int Rb = Epi::PERM ? ((R & ~31) + perm32(R & 31)) : R;
        voffA[i] = (unsigned)(R * K + C) * 2u; voffB[i] = (unsigned)(Rb * K + C) * 2u; }
    unsigned voffG[2][2] = {{0u, 0u}, {0u, 0u}};
#define PG8_LOADG(uidx) do { if constexpr (GATHER) { _Pragma("unroll") for (int _h = 0; _h < 2; ++_h) _Pragma("unroll") for (int _i = 0; _i < 2; ++_i) { int R_, C_; stage_rc(tid * 16 + _i * 8192, R_, C_); \
        voffG[_h][_i] = S.row_off((uidx), _h * HALF + R_) + (unsigned)C_ * 2u; } } } while (0)
    const size_t kstep = (size_t)(BK * 2);
    const size_t hstep = (size_t)HALF * K * 2;
    const size_t tstep = 2 * hstep;
    const unsigned ldsw = (unsigned)wid * 1024u;
    const int aoff = lds_byte(wr * 64 + fr, fq * 8), boff = lds_byte(wc * 32 + fr, fq * 8);
    const int c8 = (fq >> 1) * 32 + (fq & 1) * 16;
    const int aoff8a = lds_byte(wr * 64 + fr, c8), aoff8b = lds_byte(wr * 64 + fr, c8 + 8), boff8a = lds_byte(wc * 32 + fr, c8), boff8b = lds_byte(wc * 32 + fr, c8 + 8);
#define PG8_SA(b, h) (((b) * 2 + (h)) * HTB)
#define PG8_SB(b, h) ((4 + (b) * 2 + (h)) * HTB)
#define PG8_STAGE(bufoff, gbase, voff) do { _Pragma("unroll") for (int _i = 0; _i < 2; ++_i) \
        __builtin_amdgcn_global_load_lds((const unsigned*)((const char*)(gbase) + (voff)[_i]), (PG8_LAS unsigned*)(lds + (bufoff) + ldsw + _i * 8192), 16, 0, 0); } while (0)
#define PG8_STAGE_A(bufoff, ptr, h) do { if constexpr (GATHER) { PG8_STAGE(bufoff, ptr, voffG[h]); } else { PG8_STAGE(bufoff, (ptr) + (h) * hstep, voffA); } } while (0)
#define PG8_LDA(dst, b, h) do { if constexpr (FP8) { _Pragma("unroll") for (int m = 0; m < 4; ++m) { const u32x4 lo_ = *(const PG8_LAS u32x4*)(lds + PG8_SA(b, h) + aoff8a + m * 2048), hi_ = *(const PG8_LAS u32x4*)(lds + PG8_SA(b, h) + aoff8b + m * 2048); \
        dst##8[m] = (v8i){(int)lo_.x, (int)lo_.y, (int)lo_.z, (int)lo_.w, (int)hi_.x, (int)hi_.y, (int)hi_.z, (int)hi_.w}; } } else { \
        _Pragma("unroll") for (int m = 0; m < 4; ++m) _Pragma("unroll") for (int k = 0; k < 2; ++k) dst[m][k] = *(const PG8_LAS bf16x8*)(lds + PG8_SA(b, h) + aoff + m * 2048 + k * 1024); } } while (0)
#define PG8_LDB(dst, b, h) do { if constexpr (FP8) { _Pragma("unroll") for (int n = 0; n < 2; ++n) { const u32x4 lo_ = *(const PG8_LAS u32x4*)(lds + PG8_SB(b, h) + boff8a + n * 2048), hi_ = *(const PG8_LAS u32x4*)(lds + PG8_SB(b, h) + boff8b + n * 2048); \
        dst##8[n] = (v8i){(int)lo_.x, (int)lo_.y, (int)lo_.z, (int)lo_.w, (int)hi_.x, (int)hi_.y, (int)hi_.z, (int)hi_.w}; } } else { \
        _Pragma("unroll") for (int n = 0; n < 2; ++n) _Pragma("unroll") for (int k = 0; k < 2; ++k) dst[n][k] = *(const PG8_LAS bf16x8*)(lds + PG8_SB(b, h) + boff + n * 2048 + k * 1024); } } while (0)
#define PG8_MMA(ai, bj, At, Bt) do { __builtin_amdgcn_s_setprio(1); if constexpr (FP8) { _Pragma("unroll") for (int m = 0; m < 4; ++m) _Pragma("unroll") for (int n = 0; n < 2; ++n) \
        acc[ai][bj][m][n] = __builtin_amdgcn_mfma_scale_f32_16x16x128_f8f6f4(Bt##8[n], At##8[m], acc[ai][bj][m][n], 0, 0, 0, g.sc_w, 0, g.sc_a); } else { \
        _Pragma("unroll") for (int m = 0; m < 4; ++m) _Pragma("unroll") for (int n = 0; n < 2; ++n) _Pragma("unroll") for (int k = 0; k < 2; ++k) { \
        if constexpr (I8) acc[ai][bj][m][n] = __builtin_bit_cast(f32x4, __builtin_amdgcn_mfma_i32_16x16x64_i8(__builtin_bit_cast(v4i, Bt[n][k]), __builtin_bit_cast(v4i, At[m][k]), __builtin_bit_cast(v4i, acc[ai][bj][m][n]), 0, 0, 0)); \
        else acc[ai][bj][m][n] = __builtin_amdgcn_mfma_f32_16x16x32_bf16(Bt[n][k], At[m][k], acc[ai][bj][m][n], 0, 0, 0); } } __builtin_amdgcn_s_setprio(0); } while (0)
#define PG8_WAIT_V(n) asm volatile("s_waitcnt vmcnt(" #n ")" ::: "memory")
#define PG8_WAIT_L(n) asm volatile("s_waitcnt lgkmcnt(" #n ")" ::: "memory")
#define PG8_BAR __builtin_amdgcn_s_barrier()
#define PG8_SCHED __builtin_amdgcn_sched_barrier(0)
    Unit cur, nxt; int ui = 0;
    if (!S.next(0, cur)) return;
    f32x4 acc[2][2][4][2];
#pragma unroll
    for (int a = 0; a < 2; ++a)
#pragma unroll
        for (int b = 0; b < 2; ++b)
#pragma unroll
            for (int m = 0; m < 4; ++m)
#pragma unroll
                for (int n = 0; n < 2; ++n) acc[a][b][m][n] = (f32x4){0.f, 0.f, 0.f, 0.f};
    bf16x8 At[4][2], B0[2][2], B1[2][2]; v8i At8[4], B08[2], B18[2];
    const char* cA = GATHER ? (const char*)g.A : (const char*)g.A + (size_t)cur.pm * tstep; const char* cB = (const char*)g.Bt + (size_t)cur.bn * tstep;
    PG8_LOADG(0);
    PG8_STAGE(PG8_SB(0, 0), cB, voffB); PG8_STAGE_A(PG8_SA(0, 0), cA, 0); PG8_STAGE(PG8_SB(0, 1), cB + hstep, voffB); PG8_STAGE_A(PG8_SA(0, 1), cA, 1);
    if (wr == 1) PG8_BAR;
    PG8_WAIT_V(4); PG8_BAR;
    PG8_STAGE(PG8_SB(1, 0), cB + kstep, voffB); PG8_STAGE_A(PG8_SA(1, 0), cA + kstep, 0); PG8_STAGE(PG8_SB(1, 1), cB + hstep + kstep, voffB);
    PG8_WAIT_V(6); PG8_BAR;
    PG8_STAMP();
    for (;;) {
        const bool has_next = S.next(ui + 1, nxt);
        const char* nA = has_next ? (GATHER ? (const char*)g.A : (const char*)g.A + (size_t)nxt.pm * tstep) : cA; const char* nB = has_next ? (const char*)g.Bt + (size_t)nxt.bn * tstep : cB;
#pragma unroll 1
        for (int t = 0; t < nt; t += 2) {
            const bool last = (t == nt - 2);
            const char* a1 = cA + (size_t)(t + 1) * kstep;
            const char* a2 = last ? nA : cA + (size_t)(t + 2) * kstep; const char* b2 = last ? nB : cB + (size_t)(t + 2) * kstep;
            const char* a3 = a2 + kstep; const char* b3 = b2 + kstep;
            PG8_LDB(B0, 0, 0); PG8_SCHED; PG8_LDA(At, 0, 0); PG8_STAGE_A(PG8_SA(1, 1), a1, 1);
            PG8_WAIT_L(8); PG8_BAR; PG8_WAIT_L(0); PG8_MMA(0, 0, At, B0); PG8_BAR; PG8_SCHED;
            if (last && has_next) PG8_LOADG(ui + 1);
            PG8_LDB(B1, 0, 1); PG8_STAGE(PG8_SB(0, 0), b2, voffB);
            PG8_BAR; PG8_WAIT_L(0); PG8_MMA(0, 1, At, B1); PG8_BAR;
            PG8_LDA(At, 0, 1); PG8_STAGE_A(PG8_SA(0, 0), a2, 0);
            PG8_BAR; PG8_WAIT_L(0); PG8_MMA(1, 0, At, B0); PG8_BAR; PG8_SCHED;
            PG8_STAGE(PG8_SB(0, 1), b2 + hstep, voffB);
            PG8_WAIT_V(6); PG8_BAR; PG8_MMA(1, 1, At, B1); PG8_BAR;
            PG8_LDB(B0, 1, 0); PG8_SCHED; PG8_LDA(At, 1, 0); PG8_STAGE_A(PG8_SA(0, 1), a2, 1);
            PG8_WAIT_L(8); PG8_BAR; PG8_WAIT_L(0); PG8_MMA(0, 0, At, B0); PG8_BAR; PG8_SCHED;
            PG8_LDB(B1, 1, 1); PG8_STAGE(PG8_SB(1, 0), b3, voffB);
            PG8_BAR; PG8_WAIT_L(0); PG8_MMA(0, 1, At, B1); PG8_BAR;
            PG8_LDA(At, 1, 1); PG8_STAGE_A(PG8_SA(1, 0), a3, 0);
            PG8_BAR; PG8_WAIT_L(0); PG8_MMA(1, 0, At, B0); PG8_BAR; PG8_SCHED;
            PG8_STAGE(PG8_SB(1, 1), b3 + hstep, voffB);
            PG8_WAIT_V(6); PG8_BAR; PG8_MMA(1, 1, At, B1); PG8_BAR;
        }
        PG8_STAMP();
        E(acc, cur, wr, wc, fr, fq);
#ifdef PROBE_EPI2
        if constexpr (GATHER) { asm volatile("" ::: "memory"); E(acc, cur, wr, wc, fr, fq); }
#endif
        PG8_STAMP();
        if (!has_next) break;
#pragma unroll
        for (int a = 0; a < 2; ++a)
#pragma unroll
            for (int b = 0; b < 2; ++b)
#pragma unroll
                for (int m = 0; m < 4; ++m)
#pragma unroll
                    for (int n = 0; n < 2; ++n) acc[a][b][m][n] = (f32x4){0.f, 0.f, 0.f, 0.f};
        cur = nxt; cA = nA; cB = nB; ++ui;
    }
    PG8_WAIT_V(0);
    if (wr == 0) PG8_BAR;
    PG8_BAR;
    PG8_STAMP();
#undef PG8_STAMP
#undef PG8_SA
#undef PG8_SB
#undef PG8_STAGE
#undef PG8_STAGE_A
#undef PG8_LOADG
#undef PG8_LDA
#undef PG8_LDB
#undef PG8_MMA
#undef PG8_WAIT_V
#undef PG8_WAIT_L
#undef PG8_BAR
#undef PG8_SCHED
}
}
namespace {
#define XB_TMO      128
#define XB_XCNT(j)  (256  + 64 * (j))
#define XB_XSUB(j)  (1280 + 64 * (j))
#define XB_XGEN(j)  (2304 + 64 * (j))
#define XB_TOP      3328
#define XB_TOPGEN   3392
#define XCD_BAR_WORDS 3456
#define XB_SPIN_CAP (1u << 18)

__device__ __forceinline__ unsigned xb_ld(unsigned* p)              { return __hip_atomic_load(p, __ATOMIC_RELAXED, __HIP_MEMORY_SCOPE_AGENT); }
__device__ __forceinline__ unsigned xb_add(unsigned* p, unsigned v) { return __hip_atomic_fetch_add(p, v, __ATOMIC_RELAXED, __HIP_MEMORY_SCOPE_AGENT); }
__device__ __forceinline__ unsigned xb_xcc_id() { return (unsigned)__builtin_amdgcn_s_getreg((3 << 11) | 20) & 0xFu; }
#define XB_SPIN(cond, bar) do { unsigned _sp = 0; while (cond) { __builtin_amdgcn_s_sleep(1); \
    if ((++_sp & 255u) == 0u) { if (xb_ld(&(bar)[XB_TMO])) break; if (_sp > XB_SPIN_CAP) { atomicAdd(&(bar)[XB_TMO], 1u); break; } } } } while (0)

struct XcdBarrier {
    unsigned* bar; unsigned x;
    volatile LAS unsigned* st;
};

__device__ __forceinline__ XcdBarrier xcd_barrier_post(unsigned* bar, volatile LAS unsigned* st) {
    XcdBarrier b; b.bar = bar; b.x = xb_xcc_id(); b.st = st;
    if (threadIdx.x == 0) (void)xb_add(&bar[XB_XCNT(b.x)], 1u);
    return b;
}
__device__ __forceinline__ void xcd_barrier_complete(unsigned* bar, unsigned x, unsigned& nloc, unsigned& nx) {
    const unsigned G = gridDim.x * gridDim.y * gridDim.z;
    unsigned sum, cnt, mine, sp = 0u;
    for (;;) {
        sum = 0u; cnt = 0u; mine = 0u;
#pragma unroll
        for (unsigned j = 0; j < 16; ++j) { const unsigned c = xb_ld(&bar[XB_XCNT(j)]); sum += c; cnt += (c > 0u) ? 1u : 0u; mine = (j == x) ? c : mine; }
        if (sum == G) break;
        __builtin_amdgcn_s_sleep(1);
        if ((++sp & 255u) == 0u) { if (xb_ld(&bar[XB_TMO])) break; if (sp > XB_SPIN_CAP) { atomicAdd(&bar[XB_TMO], 1u); break; } }
    }
    nloc = mine > 0u ? mine : 1u; nx = cnt > 0u ? cnt : 1u;
}

__device__ __forceinline__ void xcd_barrier(const XcdBarrier& b) {
    asm volatile("s_waitcnt vmcnt(0)" ::: "memory");
    __syncthreads();
    if (threadIdx.x == 0) {
        unsigned* bar = b.bar;
        __builtin_amdgcn_s_waitcnt(0);
        unsigned nloc = b.st[0], nx = b.st[1];
        if (nloc == 0u) { xcd_barrier_complete(bar, b.x, nloc, nx); b.st[0] = nloc; b.st[1] = nx; }
        const unsigned old = xb_add(&bar[XB_XSUB(b.x)], 1u);
        const unsigned gen = old / nloc;
        if (old + 1u == (gen + 1u) * nloc) {
            __builtin_amdgcn_fence(__ATOMIC_RELEASE, "agent");
            asm volatile("s_waitcnt vmcnt(0)" ::: "memory");
            const unsigned og = xb_add(&bar[XB_TOP], 1u);
            const unsigned tg = og / nx;
            if (og + 1u == (tg + 1u) * nx) xb_add(&bar[XB_TOPGEN], 1u);
            else XB_SPIN(xb_ld(&bar[XB_TOPGEN]) == tg, bar);
            __builtin_amdgcn_fence(__ATOMIC_ACQUIRE, "agent");
            xb_add(&bar[XB_XGEN(b.x)], 1u);
            asm volatile("s_waitcnt vmcnt(0)" ::: "memory");
        } else {
            XB_SPIN(xb_ld(&bar[XB_XGEN(b.x)]) == gen, bar);
            __builtin_amdgcn_fence(__ATOMIC_ACQUIRE, "agent");
            asm volatile("s_waitcnt vmcnt(0)" ::: "memory");
        }
    }
    __syncthreads();
}

}
namespace {
using pg8::f32x4; using pg8::u32x4; using pg8::cvt_pk_bf16;

template <class ARow, class Epi>
__device__ __forceinline__ void gemm_tile(float* smem, int mvalid, int nvalid, int K, ARow arow, const float* Bp, int ldb, Epi epi) {
  float* As = smem;
  float* Bs = smem + 16 * 68;
  const int tid = threadIdx.x, ty = tid >> 5, tx = tid & 31;
  float acc[4][4];
#pragma unroll
  for (int i = 0; i < 4; ++i)
#pragma unroll
    for (int j = 0; j < 4; ++j) acc[i][j] = 0.f;
  const int ak = tid & 15, ar = tid >> 4;
  const float* ap0 = (ar < mvalid) ? arow(ar) : nullptr;
  const float* ap1 = (ar + 32 < mvalid) ? arow(ar + 32) : nullptr;
  const int bn = tid & 127, bk = tid >> 7;
  for (int k0 = 0; k0 < K; k0 += 16) {
    As[ak * 68 + ar] = ap0 ? ap0[k0 + ak] : 0.f;
    As[ak * 68 + ar + 32] = ap1 ? ap1[k0 + ak] : 0.f;
#pragma unroll
    for (int i = 0; i < 4; ++i) { const int kk = bk + 4 * i; Bs[kk * 128 + bn] = (bn < nvalid) ? Bp[(size_t)(k0 + kk) * ldb + bn] : 0.f; }
    __syncthreads();
#pragma unroll
    for (int kk = 0; kk < 16; ++kk) {
      float a[4], b[4];
#pragma unroll
      for (int i = 0; i < 4; ++i) a[i] = As[kk * 68 + ty * 4 + i];
#pragma unroll
      for (int j = 0; j < 4; ++j) b[j] = Bs[kk * 128 + tx * 4 + j];
#pragma unroll
      for (int i = 0; i < 4; ++i)
#pragma unroll
        for (int j = 0; j < 4; ++j) acc[i][j] += a[i] * b[j];
    }
    __syncthreads();
  }
#pragma unroll
  for (int i = 0; i < 4; ++i)
#pragma unroll
    for (int j = 0; j < 4; ++j) { const int r = ty * 4 + i, c = tx * 4 + j; if (r < mvalid && c < nvalid) epi(r, c, acc[i][j]); }
}

template <class RowMap>
__device__ __forceinline__ void cvt_tile(const float* __restrict__ src, int N, int K, int k0, int n0, bf16_t* __restrict__ dst, RowMap rm) {
  const int lane = threadIdx.x & 63, w = threadIdx.x >> 6;
  const int n = n0 + (lane & 15) * 4, kk = k0 + (w * 4 + (lane >> 4)) * 8;
  if (n >= N) return;
  float4 v[8];
#pragma unroll
  for (int j = 0; j < 8; ++j) v[j] = *(const float4*)(src + (size_t)(kk + j) * N + n);
  u32x4 o;
  o.x = cvt_pk_bf16(v[0].x, v[1].x); o.y = cvt_pk_bf16(v[2].x, v[3].x); o.z = cvt_pk_bf16(v[4].x, v[5].x); o.w = cvt_pk_bf16(v[6].x, v[7].x);
  *(u32x4*)(dst + (size_t)rm(n + 0) * K + kk) = o;
  o.x = cvt_pk_bf16(v[0].y, v[1].y); o.y = cvt_pk_bf16(v[2].y, v[3].y); o.z = cvt_pk_bf16(v[4].y, v[5].y); o.w = cvt_pk_bf16(v[6].y, v[7].y);
  *(u32x4*)(dst + (size_t)rm(n + 1) * K + kk) = o;
  o.x = cvt_pk_bf16(v[0].z, v[1].z); o.y = cvt_pk_bf16(v[2].z, v[3].z); o.z = cvt_pk_bf16(v[4].z, v[5].z); o.w = cvt_pk_bf16(v[6].z, v[7].z);
  *(u32x4*)(dst + (size_t)rm(n + 2) * K + kk) = o;
  o.x = cvt_pk_bf16(v[0].w, v[1].w); o.y = cvt_pk_bf16(v[2].w, v[3].w); o.z = cvt_pk_bf16(v[4].w, v[5].w); o.w = cvt_pk_bf16(v[6].w, v[7].w);
  *(u32x4*)(dst + (size_t)rm(n + 3) * K + kk) = o;
}
template <class RowMap>
__device__ __forceinline__ void cvt_job(const float* src, int nmat, int K, int N, bf16_t* dst, size_t dstride, RowMap rm) {
  const int kt = K / 256, ntl = (N + 63) / 64, per = kt * ntl;
  for (int it = blockIdx.x; it < nmat * per; it += gridDim.x) {
    const int m = it / per, r = it % per, k0 = (r / ntl) * 256, n0 = (r % ntl) * 64;
    cvt_tile(src + (size_t)m * K * N, N, K, k0, n0, dst + (size_t)m * dstride, rm);
  }
}
__device__ __forceinline__ unsigned pack4_i8(float a, float b, float c, float d, float inv) {
  const int q0 = __float2int_rn(a * inv), q1 = __float2int_rn(b * inv), q2 = __float2int_rn(c * inv), q3 = __float2int_rn(d * inv);
  return (unsigned)(q0 & 255) | ((unsigned)(q1 & 255) << 8) | ((unsigned)(q2 & 255) << 16) | ((unsigned)(q3 & 255) << 24);
}
__device__ __forceinline__ int win_row(int n) { return n < O_DT ? n : (n < O_Q ? PLD + (n - O_DT) : n - 32); }
__device__ __forceinline__ void ph_convert(const Params& p) {
  const int tidf = tid_fresh(), lane = tidf & 63, wv = tidf >> 6;
  for (int row = blockIdx.x * 8 + wv; row < T; row += gridDim.x * 8) {
    const float* xp = p.x + (size_t)row * D; f32x4 a[4], b[4]; float am = 0.f;
#pragma unroll
    for (int g = 0; g < 4; ++g) { a[g] = __builtin_nontemporal_load((const f32x4*)(xp + g * 512 + lane * 8)); b[g] = __builtin_nontemporal_load((const f32x4*)(xp + g * 512 + lane * 8 + 4));
#pragma unroll
      for (int j = 0; j < 4; ++j) am = fmaxf(am, fmaxf(fabsf(a[g][j]), fabsf(b[g][j]))); }
    for (int o = 32; o >= 1; o >>= 1) am = fmaxf(am, __shfl_xor(am, o));
    const float inv = am > 0.f ? 127.f / am : 0.f;
    if (lane == 0) p.sx[row] = am * (1.f / 127.f);
#pragma unroll
    for (int g = 0; g < 4; ++g) {
      u32x4 o; o.x = cvt_pk_bf16(a[g][0], a[g][1]); o.y = cvt_pk_bf16(a[g][2], a[g][3]); o.z = cvt_pk_bf16(b[g][0], b[g][1]); o.w = cvt_pk_bf16(b[g][2], b[g][3]);
      *(u32x4*)(p.xb + (size_t)row * D + g * 512 + lane * 8) = o;
      *(uint2*)(p.xq + (size_t)row * D + g * 512 + lane * 8) = make_uint2(pack4_i8(a[g][0], a[g][1], a[g][2], a[g][3], inv), pack4_i8(b[g][0], b[g][1], b[g][2], b[g][3], inv)); }
  }
  { constexpr int NTL = (PW + 63) / 64;
    for (int it = blockIdx.x; it < (D / 256) * NTL; it += gridDim.x) {
      const int k0 = (it / NTL) * 256, n = (it % NTL) * 64 + (lane & 15) * 4, kk = k0 + (wv * 4 + (lane >> 4)) * 8;
      float m4[4] = {0.f, 0.f, 0.f, 0.f};
      if (n < PW) {
#pragma unroll
        for (int j = 0; j < 8; ++j) { const float4 v = *(const float4*)(p.w_in + (size_t)(kk + j) * PW + n); m4[0] = fmaxf(m4[0], fabsf(v.x)); m4[1] = fmaxf(m4[1], fabsf(v.y)); m4[2] = fmaxf(m4[2], fabsf(v.z)); m4[3] = fmaxf(m4[3], fabsf(v.w)); } }
#pragma unroll
      for (int c = 0; c < 4; ++c) { m4[c] = fmaxf(m4[c], __shfl_xor(m4[c], 16)); m4[c] = fmaxf(m4[c], __shfl_xor(m4[c], 32)); }
      if (lane < 16 && n < PW) {
#pragma unroll
        for (int c = 0; c < 4; ++c) atomicMax(p.colmax + n + c, __float_as_uint(m4[c])); }
    } }
  cvt_job(p.w_out, 1, D, D, p.WoutT, 0, [](int n) { return n; });
  cvt_job(p.w_router, 1, D, NE, p.WrT, 0, [](int n) { return n; });
}
__device__ __forceinline__ void ph_convert_win(const Params& p) {
  const int tidf = tid_fresh(), lane = tidf & 63, wv = tidf >> 6;
  constexpr int NTL = (PW + 63) / 64;
  for (int it = blockIdx.x; it < (D / 512) * NTL; it += gridDim.x) {
    const int k0 = (it / NTL) * 512, n = (it % NTL) * 64 + (lane & 15) * 4, kk = k0 + (wv * 4 + (lane >> 4)) * 16;
    if (n >= PW) continue;
    float4 v[16];
#pragma unroll
    for (int j = 0; j < 16; ++j) v[j] = *(const float4*)(p.w_in + (size_t)(kk + j) * PW + n);
    float cm[4], inv[4];
#pragma unroll
    for (int c = 0; c < 4; ++c) { cm[c] = __uint_as_float(__hip_atomic_load(p.colmax + n + c, __ATOMIC_RELAXED, __HIP_MEMORY_SCOPE_AGENT)); inv[c] = cm[c] > 0.f ? 127.f / cm[c] : 0.f; }
    u32x4 o;
    o.x = pack4_i8(v[0].x, v[1].x, v[2].x, v[3].x, inv[0]); o.y = pack4_i8(v[4].x, v[5].x, v[6].x, v[7].x, inv[0]); o.z = pack4_i8(v[8].x, v[9].x, v[10].x, v[11].x, inv[0]); o.w = pack4_i8(v[12].x, v[13].x, v[14].x, v[15].x, inv[0]);
    *(u32x4*)(p.WinQ + (size_t)win_row(n + 0) * D + kk) = o;
    o.x = pack4_i8(v[0].y, v[1].y, v[2].y, v[3].y, inv[1]); o.y = pack4_i8(v[4].y, v[5].y, v[6].y, v[7].y, inv[1]); o.z = pack4_i8(v[8].y, v[9].y, v[10].y, v[11].y, inv[1]); o.w = pack4_i8(v[12].y, v[13].y, v[14].y, v[15].y, inv[1]);
    *(u32x4*)(p.WinQ + (size_t)win_row(n + 1) * D + kk) = o;
    o.x = pack4_i8(v[0].z, v[1].z, v[2].z, v[3].z, inv[2]); o.y = pack4_i8(v[4].z, v[5].z, v[6].z, v[7].z, inv[2]); o.z = pack4_i8(v[8].z, v[9].z, v[10].z, v[11].z, inv[2]); o.w = pack4_i8(v[12].z, v[13].z, v[14].z, v[15].z, inv[2]);
    *(u32x4*)(p.WinQ + (size_t)win_row(n + 2) * D + kk) = o;
    o.x = pack4_i8(v[0].w, v[1].w, v[2].w, v[3].w, inv[3]); o.y = pack4_i8(v[4].w, v[5].w, v[6].w, v[7].w, inv[3]); o.z = pack4_i8(v[8].w, v[9].w, v[10].w, v[11].w, inv[3]); o.w = pack4_i8(v[12].w, v[13].w, v[14].w, v[15].w, inv[3]);
    *(u32x4*)(p.WinQ + (size_t)win_row(n + 3) * D + kk) = o;
    if (kk == 0) {
#pragma unroll
      for (int c = 0; c < 4; ++c) p.sw[win_row(n + c)] = cm[c] * (1.f / 127.f); }
  }
  const size_t gtid = (size_t)blockIdx.x * NT + tidf, gsz = (size_t)gridDim.x * NT;
  for (size_t i = gtid; i < (size_t)(NPROJ - PW) * D / 16; i += gsz) *(u32x4*)(p.WinQ + (size_t)PW * D + i * 16) = (u32x4){0u, 0u, 0u, 0u};
  if (gtid < (size_t)(NPROJ - PW)) p.sw[PW + gtid] = 0.f;
}
__device__ __forceinline__ unsigned pk4_fp8(float a, float b, float c, float d) { const float a2 = a * W8S; int w = __float_as_int(a2); w = __builtin_amdgcn_cvt_pk_fp8_f32(a2, b * W8S, w, false); w = __builtin_amdgcn_cvt_pk_fp8_f32(c * W8S, d * W8S, w, true); return (unsigned)w; }
#ifndef CVT_LN
#define CVT_LN 16
#endif
template <class RowMap>
__device__ __forceinline__ void cvt_range8(const float* __restrict__ src, int K, int N, unsigned char* __restrict__ dst, size_t dstride, RowMap rm, int it0, int it1) {
  constexpr int NTF = 3;
  constexpr int LN = CVT_LN, TK = 8 * (64 / LN) * 16, TN = LN * 4;
  const int kt = K / TK, ntl = N / TN, per = kt * ntl;
  int tid = threadIdx.x; asm volatile("" : "+v"(tid));
  const int lane = tid & 63, w = tid >> 6, nl = (lane % LN) * 4, kl = (w * (64 / LN) + lane / LN) * 16;
  for (int it = it0; it < it1; it += NTF) {
    float4 v[NTF][16];
#pragma unroll
    for (int q = 0; q < NTF; ++q) if (it + q < it1) { const int m = (it + q) / per, r = (it + q) % per, kk = (r / ntl) * TK + kl, n = (r % ntl) * TN + nl;
      const float* sp = src + (size_t)m * K * N + (size_t)kk * N + n;
#pragma unroll
      for (int j = 0; j < 16; ++j) { const f32x4 t_ = __builtin_nontemporal_load((const f32x4*)(sp + (size_t)j * N)); v[q][j] = make_float4(t_[0], t_[1], t_[2], t_[3]); } }
#pragma unroll
    for (int q = 0; q < NTF; ++q) if (it + q < it1) { const int m = (it + q) / per, r = (it + q) % per, kk = (r / ntl) * TK + kl, n = (r % ntl) * TN + nl;
      unsigned char* dp = dst + (size_t)m * dstride + kk; u32x4 o;
      o.x = pk4_fp8(v[q][0].x, v[q][1].x, v[q][2].x, v[q][3].x); o.y = pk4_fp8(v[q][4].x, v[q][5].x, v[q][6].x, v[q][7].x); o.z = pk4_fp8(v[q][8].x, v[q][9].x, v[q][10].x, v[q][11].x); o.w = pk4_fp8(v[q][12].x, v[q][13].x, v[q][14].x, v[q][15].x);
      __builtin_nontemporal_store(o, (u32x4*)(dp + (size_t)rm(n + 0) * K));
      o.x = pk4_fp8(v[q][0].y, v[q][1].y, v[q][2].y, v[q][3].y); o.y = pk4_fp8(v[q][4].y, v[q][5].y, v[q][6].y, v[q][7].y); o.z = pk4_fp8(v[q][8].y, v[q][9].y, v[q][10].y, v[q][11].y); o.w = pk4_fp8(v[q][12].y, v[q][13].y, v[q][14].y, v[q][15].y);
      __builtin_nontemporal_store(o, (u32x4*)(dp + (size_t)rm(n + 1) * K));
      o.x = pk4_fp8(v[q][0].z, v[q][1].z, v[q][2].z, v[q][3].z); o.y = pk4_fp8(v[q][4].z, v[q][5].z, v[q][6].z, v[q][7].z); o.z = pk4_fp8(v[q][8].z, v[q][9].z, v[q][10].z, v[q][11].z); o.w = pk4_fp8(v[q][12].z, v[q][13].z, v[q][14].z, v[q][15].z);
      __builtin_nontemporal_store(o, (u32x4*)(dp + (size_t)rm(n + 2) * K));
      o.x = pk4_fp8(v[q][0].w, v[q][1].w, v[q][2].w, v[q][3].w); o.y = pk4_fp8(v[q][4].w, v[q][5].w, v[q][6].w, v[q][7].w); o.z = pk4_fp8(v[q][8].w, v[q][9].w, v[q][10].w, v[q][11].w); o.w = pk4_fp8(v[q][12].w, v[q][13].w, v[q][14].w, v[q][15].w);
      __builtin_nontemporal_store(o, (u32x4*)(dp + (size_t)rm(n + 3) * K)); }
  }
}
constexpr int CVT_ITEMS = 3 * 256 + 3 * 4;
__device__ __forceinline__ void cvt_moe_item(const Params& p, int item) {
  unsigned char* gu = (unsigned char*)p.WguT; unsigned char* dn = (unsigned char*)p.WdT;
  if (item < 256) cvt_range8(p.wg_e, D, DE, gu, (size_t)1024 * D, [](int n) { return (n >> 7) * 256 + (n & 127); }, item * 8, item * 8 + 8);
  else if (item < 512) cvt_range8(p.wu_e, D, DE, gu, (size_t)1024 * D, [](int n) { return (n >> 7) * 256 + 128 + (n & 127); }, (item - 256) * 8, (item - 256) * 8 + 8);
  else if (item < 768) cvt_range8(p.wd_e, DE, D, dn, (size_t)D * DE, [](int n) { return n; }, (item - 512) * 8, (item - 512) * 8 + 8);
  else if (item < 772) cvt_range8(p.wg_s, D, DE, gu + (size_t)NE * 1024 * D, 0, [](int n) { return (n >> 7) * 256 + (n & 127); }, (item - 768) * 8, (item - 768) * 8 + 8);
  else if (item < 776) cvt_range8(p.wu_s, D, DE, gu + (size_t)NE * 1024 * D, 0, [](int n) { return (n >> 7) * 256 + 128 + (n & 127); }, (item - 772) * 8, (item - 772) * 8 + 8);
  else cvt_range8(p.wd_s, DE, D, dn + (size_t)NE * D * DE, 0, [](int n) { return n; }, (item - 776) * 8, (item - 776) * 8 + 8);
}

struct EpiProj {
  static constexpr bool PERM = true;
  bf16_t* proj; float* dt; const float* bias_f; const float* bias_b; const float* sx; const float* sw;
  __device__ __forceinline__ void operator()(const f32x4 (&acc)[2][2][4][2], const pg8::Unit& u, int wr, int wc, int fr, int fq) const {
    asm volatile("" : "+v"(fr), "+v"(fq));
    typedef int v4i_ __attribute__((ext_vector_type(4)));
    const int row0 = u.pm * 256 + wr * 64 + fr;
    float sr[2][4];
#pragma unroll
    for (int ai = 0; ai < 2; ++ai)
#pragma unroll
      for (int m = 0; m < 4; ++m) sr[ai][m] = sx[row0 + ai * 128 + m * 16];
    if (u.pn < 22) {
      const int col0 = u.pn * 256 + wc * 32 + 8 * fq;
      const float sc = (u.pn >= 10 && u.pn < 14) ? QS : 1.0f;
#pragma unroll
      for (int bj = 0; bj < 2; ++bj) { const f32x4 s0 = *(const f32x4*)(sw + col0 + bj * 128) * sc, s1 = *(const f32x4*)(sw + col0 + bj * 128 + 4) * sc;
#pragma unroll
        for (int ai = 0; ai < 2; ++ai)
#pragma unroll
          for (int m = 0; m < 4; ++m) { const float r = sr[ai][m];
            const f32x4 v0 = __builtin_convertvector(__builtin_bit_cast(v4i_, acc[ai][bj][m][0]), f32x4) * s0 * r, v1 = __builtin_convertvector(__builtin_bit_cast(v4i_, acc[ai][bj][m][1]), f32x4) * s1 * r;
            u32x4 w; w.x = cvt_pk_bf16(v0[0], v0[1]); w.y = cvt_pk_bf16(v0[2], v0[3]); w.z = cvt_pk_bf16(v1[0], v1[1]); w.w = cvt_pk_bf16(v1[2], v1[3]);
            *(u32x4*)(proj + (size_t)(row0 + ai * 128 + m * 16) * PLD + col0 + bj * 128) = w; } }
    } else if (wc == 0) {
      const int c0 = 8 * fq;
      float bs[8], sc8[8];
#pragma unroll
      for (int j = 0; j < 8; ++j) { bs[j] = (c0 + j) < 16 ? bias_f[c0 + j] : bias_b[c0 + j - 16]; sc8[j] = sw[PLD + c0 + j]; }
#pragma unroll
      for (int ai = 0; ai < 2; ++ai)
#pragma unroll
        for (int m = 0; m < 4; ++m) { float* rowp = dt + (size_t)(row0 + ai * 128 + m * 16) * 32 + c0; const float r = sr[ai][m];
          const f32x4 v0 = __builtin_convertvector(__builtin_bit_cast(v4i_, acc[ai][0][m][0]), f32x4), v1 = __builtin_convertvector(__builtin_bit_cast(v4i_, acc[ai][0][m][1]), f32x4);
          f32x4 o0, o1;
#pragma unroll
          for (int j = 0; j < 4; ++j) { o0[j] = softplus_f(v0[j] * (r * sc8[j]) + bs[j]); o1[j] = softplus_f(v1[j] * (r * sc8[4 + j]) + bs[4 + j]); }
          *(f32x4*)rowp = o0; *(f32x4*)(rowp + 4) = o1; }
    }
  }
};
struct EpiOut {
  static constexpr bool PERM = true;
  bf16_t* v; size_t doff;
  __device__ __forceinline__ void operator()(const f32x4 (&acc)[2][2][4][2], const pg8::Unit& u, int wr, int wc, int fr, int fq) const {
    asm volatile("" : "+v"(fr), "+v"(fq));
    const int row0 = u.pm * 256 + wr * 64 + fr, col0 = u.pn * 256 + wc * 32 + 8 * fq;
#pragma unroll
    for (int ai = 0; ai < 2; ++ai)
#pragma unroll
      for (int m = 0; m < 4; ++m) { bf16_t* rp = v + (size_t)(row0 + ai * 128 + m * 16) * D + col0;
#pragma unroll
        for (int bj = 0; bj < 2; ++bj) { const u32x4 xb = __builtin_nontemporal_load((const u32x4*)(rp + bj * 128));
          f32x4 x0, x1; x0[0] = __uint_as_float(xb.x << 16); x0[1] = __uint_as_float(xb.x & 0xffff0000u); x0[2] = __uint_as_float(xb.y << 16); x0[3] = __uint_as_float(xb.y & 0xffff0000u);
          x1[0] = __uint_as_float(xb.z << 16); x1[1] = __uint_as_float(xb.z & 0xffff0000u); x1[2] = __uint_as_float(xb.w << 16); x1[3] = __uint_as_float(xb.w & 0xffff0000u);
          const f32x4 v0 = x0 * ALPHA + acc[ai][bj][m][0], v1 = x1 * ALPHA + acc[ai][bj][m][1];
          u32x4 w; w.x = cvt_pk_bf16(v0[0], v0[1]); w.y = cvt_pk_bf16(v0[2], v0[3]); w.z = cvt_pk_bf16(v1[0], v1[1]); w.w = cvt_pk_bf16(v1[2], v1[3]);
          *(u32x4*)(rp + doff + bj * 128) = w; } }
  }
};

namespace at {
using bf16x8 = __attribute__((ext_vector_type(8))) short;
using s16x4  = __attribute__((ext_vector_type(4))) short;
using f32x16 = __attribute__((ext_vector_type(16))) float;
using u32x4  = __attribute__((ext_vector_type(4))) unsigned;
constexpr int KVBLK = 64;
constexpr size_t SHM_V = KVBLK * 128 * 2, SHM_K = KVBLK * 128 * 2;
constexpr float THR2 = 8.0f;
#define AT_KSWZ(row, colB) ((row) * 256 + ((colB) ^ (((row) & 15) << 4)))
#define AT_SBAR() __builtin_amdgcn_sched_barrier(0)
__device__ __forceinline__ int crow(int r, int hi) { return (r & 3) + 8 * (r >> 2) + 4 * hi; }
__device__ __forceinline__ unsigned cvtpk(float lo, float hi) { unsigned r; asm volatile("v_cvt_pk_bf16_f32 %0, %1, %2" : "=v"(r) : "v"(lo), "v"(hi)); return r; }

typedef float f32x2v __attribute__((ext_vector_type(2)));
__device__ __forceinline__ void diagfix(f32x16& p0, f32x16& p1, const f32x16& i0, float dqh, float a) {
#pragma unroll
  for (int r = 0; r < 16; ++r) { const float c = (float)((r & 3) + 8 * (r >> 2));
    p0[r] = fmaf(-a, fabsf(dqh - c), p0[r]) - i0[r]; p1[r] = fmaf(-a, fabsf(dqh - (c + 32.f)), p1[r]) - i0[r]; }
}
__device__ __forceinline__ void softmax_tile(f32x16& p0, f32x16& p1, float dqh, float sa, float& m_reg, float& l_reg, float& alpha, bf16x8& pa0, bf16x8& pa1, bf16x8& pa2, bf16x8& pa3) {
  const float Bt = -sa * dqh, d1 = 32.f * sa;
  float pmax = p0[0], pmax1 = p1[0], mn;
#pragma unroll
  for (int r = 1; r < 16; ++r) pmax = fmaxf(pmax, p0[r]);
#pragma unroll
  for (int r = 1; r < 16; ++r) pmax1 = fmaxf(pmax1, p1[r]);
  pmax = fmaxf(pmax, pmax1 + d1) + Bt;
  { auto rr = __builtin_amdgcn_permlane32_swap(__float_as_uint(pmax), __float_as_uint(pmax), false, false);
    pmax = fmaxf(__uint_as_float(rr[0]), __uint_as_float(rr[1])); }
  if (__builtin_expect(__all(pmax - m_reg <= THR2), 1)) { mn = m_reg; alpha = 1.f; }
  else { mn = fmaxf(m_reg, pmax); alpha = __builtin_amdgcn_exp2f(m_reg - mn); m_reg = mn; }
  const float cs = Bt - mn, cs1 = cs + d1; const f32x2v c2 = {cs, cs}, c21 = {cs1, cs1};
#pragma unroll
  for (int r = 0; r < 16; r += 2) { const f32x2v t = (f32x2v){p0[r], p0[r + 1]} + c2; p0[r] = t[0]; p0[r + 1] = t[1]; }
#pragma unroll
  for (int r = 0; r < 16; r += 2) { const f32x2v t = (f32x2v){p1[r], p1[r + 1]} + c21; p1[r] = t[0]; p1[r + 1] = t[1]; }
#pragma unroll
  for (int r = 0; r < 16; ++r) p0[r] = __builtin_amdgcn_exp2f(p0[r]);
#pragma unroll
  for (int r = 0; r < 16; ++r) p1[r] = __builtin_amdgcn_exp2f(p1[r]);
  f32x2v s2 = {0.f, 0.f};
#pragma unroll
  for (int r = 0; r < 16; r += 2) s2 += (f32x2v){p0[r], p0[r + 1]};
#pragma unroll
  for (int r = 0; r < 16; r += 2) s2 += (f32x2v){p1[r], p1[r + 1]};
  float ps = s2[0] + s2[1];
  { auto rr = __builtin_amdgcn_permlane32_swap(__float_as_uint(ps), __float_as_uint(ps), false, false);
    ps = __uint_as_float(rr[0]) + __uint_as_float(rr[1]); }
  l_reg = l_reg * alpha + ps;
#define AT_PK4(P, BASE, OUT) do { unsigned a0 = cvtpk(P[BASE + 0], P[BASE + 1]), a1 = cvtpk(P[BASE + 2], P[BASE + 3]);   \
    unsigned b0 = cvtpk(P[BASE + 4], P[BASE + 5]), b1 = cvtpk(P[BASE + 6], P[BASE + 7]);                              \
    auto r0 = __builtin_amdgcn_permlane32_swap(a0, b0, false, false); auto r1 = __builtin_amdgcn_permlane32_swap(a1, b1, false, false); \
    u32x4 w = {r0[0], r1[0], r0[1], r1[1]}; OUT = *reinterpret_cast<bf16x8*>(&w); } while (0)
  AT_PK4(p0, 0, pa0); AT_PK4(p0, 8, pa1); AT_PK4(p1, 0, pa2); AT_PK4(p1, 8, pa3);
#undef AT_PK4
}
__device__ __forceinline__ int v_st(int k, int c) { const int kk = (k & ~0xC) | ((k & 4) << 1) | ((k & 8) >> 1); return ((kk >> 3) * 4 + (c >> 5)) * 512 + ((kk & 7) * 32 + (c & 31)) * 2; }
__device__ __forceinline__ int v_rd_base(int lane) { return ((lane & 3) << 3) | (((lane >> 2) & 3) << 6) | (((lane >> 4) & 1) << 5) | (((lane >> 5) & 1) << 8); }
constexpr int v_rd_off(int d0, int ks, int half) { return d0 * 512 + ks * 4096 + half * 2048; }
template <int OFF> __device__ __forceinline__ s16x4 tr_read(int vb) {
  s16x4 r; asm volatile("ds_read_b64_tr_b16 %0, %1 offset:%2" : "=&v"(r) : "v"(vb), "i"(OFF) : "memory"); return r;
}
template <int OFF> __device__ __forceinline__ bf16x8 k_read(int ka) {
  bf16x8 r; asm volatile("ds_read_b128 %0, %1 offset:%2" : "=&v"(r) : "v"(ka), "i"(OFF) : "memory"); return r;
}
#define AT_WAIT(n) asm volatile("s_waitcnt lgkmcnt(" #n ")" ::: "memory")
template <bool QK, bool PV, class H1, class H2>
__device__ __forceinline__ void xphase(f32x16& p0, f32x16& p1, const f32x16& i0, f32x16* o, const int* ka, int kbuf, const bf16x8* qr, int vb, bf16x8 pa0, bf16x8 pa1, bf16x8 pa2, bf16x8 pa3, const H1& hook1, const H2& hook2) {
  bf16x8 kf[8]; s16x4 va[8], vc[8];
#define AT_VREAD(dst, D0) do { dst[0] = tr_read<v_rd_off(D0, 0, 0)>(vb); dst[1] = tr_read<v_rd_off(D0, 0, 1)>(vb); dst[2] = tr_read<v_rd_off(D0, 1, 0)>(vb); dst[3] = tr_read<v_rd_off(D0, 1, 1)>(vb); \
    dst[4] = tr_read<v_rd_off(D0, 2, 0)>(vb); dst[5] = tr_read<v_rd_off(D0, 2, 1)>(vb); dst[6] = tr_read<v_rd_off(D0, 3, 0)>(vb); dst[7] = tr_read<v_rd_off(D0, 3, 1)>(vb); } while (0)
#define AT_PK(L, H) (bf16x8){L[0], L[1], L[2], L[3], H[0], H[1], H[2], H[3]}
#define AT_PVMMA(od, v) do { od = __builtin_amdgcn_mfma_f32_32x32x16_bf16(pa0, AT_PK(v[0], v[1]), od, 0, 0, 0); od = __builtin_amdgcn_mfma_f32_32x32x16_bf16(pa1, AT_PK(v[2], v[3]), od, 0, 0, 0); \
    od = __builtin_amdgcn_mfma_f32_32x32x16_bf16(pa2, AT_PK(v[4], v[5]), od, 0, 0, 0); od = __builtin_amdgcn_mfma_f32_32x32x16_bf16(pa3, AT_PK(v[6], v[7]), od, 0, 0, 0); } while (0)
#define AT_KREAD() do { _Pragma("unroll") for (int d0 = 0; d0 < 4; ++d0) { kf[2 * d0] = k_read<0>(ka[d0] + kbuf); kf[2 * d0 + 1] = k_read<32 * 256>(ka[d0] + kbuf); } } while (0)
#define AT_QKMMA() do { p0 = __builtin_amdgcn_mfma_f32_32x32x16_bf16(kf[0], qr[0], i0, 0, 0, 0); p1 = __builtin_amdgcn_mfma_f32_32x32x16_bf16(kf[1], qr[0], i0, 0, 0, 0); \
    _Pragma("unroll") for (int d0 = 1; d0 < 4; ++d0) { p0 = __builtin_amdgcn_mfma_f32_32x32x16_bf16(kf[2 * d0], qr[d0], p0, 0, 0, 0); p1 = __builtin_amdgcn_mfma_f32_32x32x16_bf16(kf[2 * d0 + 1], qr[d0], p1, 0, 0, 0); } } while (0)
  if constexpr (QK && PV) {
    AT_VREAD(va, 0); AT_KREAD();
    hook1();
    AT_WAIT(8); AT_SBAR(); AT_PVMMA(o[0], va); AT_SBAR();
    AT_VREAD(vc, 1);
    hook2();
    AT_WAIT(8); AT_SBAR(); AT_QKMMA(); AT_SBAR();
    AT_VREAD(va, 2);
    AT_WAIT(8); AT_SBAR(); AT_PVMMA(o[1], vc); AT_SBAR();
    AT_VREAD(vc, 3);
    AT_WAIT(8); AT_SBAR(); AT_PVMMA(o[2], va); AT_SBAR();
    AT_WAIT(0); AT_SBAR(); AT_PVMMA(o[3], vc); AT_SBAR();
  } else if constexpr (QK) {
    AT_KREAD(); hook1(); hook2(); AT_WAIT(0); AT_SBAR(); AT_QKMMA(); AT_SBAR();
  } else {
    AT_VREAD(va, 0);
    AT_VREAD(vc, 1); AT_WAIT(8); AT_SBAR(); AT_PVMMA(o[0], va); AT_SBAR();
    AT_VREAD(va, 2); AT_WAIT(8); AT_SBAR(); AT_PVMMA(o[1], vc); AT_SBAR();
    AT_VREAD(vc, 3); AT_WAIT(8); AT_SBAR(); AT_PVMMA(o[2], va); AT_SBAR();
    AT_WAIT(0); AT_SBAR(); AT_PVMMA(o[3], vc); AT_SBAR();
  }
#undef AT_KREAD
#undef AT_QKMMA
#undef AT_VREAD
#undef AT_PK
#undef AT_PVMMA
}

__device__ __forceinline__ void attn_item(const bf16_t* __restrict__ Qb, const bf16_t* Kh, const bf16_t* Vh, bf16_t* __restrict__ Ub,
                                          int q0, float nsl2, float lam, const float* __restrict__ normw, const float* kn2, char* lds) {
  constexpr int LDK = PLD;
  int tid = threadIdx.x; asm volatile("" : "+v"(tid));
  const int wid = __builtin_amdgcn_readfirstlane(tid >> 6), lane = tid & 63, r32 = lane & 31, hi = lane >> 5, rg = wid >> 1, cmap = wid & 1, cm = cmap * 64, grp = wid >> 2;
  char* V_lds = lds; char* K_lds = lds + 3 * SHM_V;
  float* ws = (float*)(lds + 96 * 1024) + wid * 64; float* li_l = ws; float* al_l = ws + 32;
  float m_reg = -1e30f, l_reg = 0; f32x16 o[4] = {}; bf16x8 qr[4];
  const bf16_t* Qw = Qb + (size_t)(rg * 32 + r32) * LDK + cm + hi * 8;
#pragma unroll
  for (int d0 = 0; d0 < 4; ++d0) qr[d0] = *reinterpret_cast<const bf16x8*>(Qw + d0 * 16);
  int jlo, ntl;
  { float qs = 0.f;
#pragma unroll
    for (int d0 = 0; d0 < 4; ++d0)
#pragma unroll
      for (int e = 0; e < 8; ++e) { const float x = __uint_as_float(((unsigned)(unsigned short)qr[d0][e]) << 16); qs += x * x; }
    qs += __shfl_xor(qs, 32);
    for (int o = 16; o >= 1; o >>= 1) qs = fmaxf(qs, __shfl_xor(qs, o));
    float* qn = (float*)(lds + 99 * 1024);
    __syncthreads();
    if (lane == 0) qn[wid] = qs;
    __syncthreads();
    float q2 = qn[0];
#pragma unroll
    for (int w = 1; w < 8; ++w) q2 = fmaxf(q2, qn[w]);
    const float qnm = sqrtf(q2) * 1.01f;
    const int j = lane & 31;
    float kv = __hip_atomic_load(kn2 + lane, __ATOMIC_RELAXED, __HIP_MEMORY_SCOPE_AGENT);
    kv = fmaxf(kv, __shfl_xor(kv, 32));
    const int dl = q0 - (j * KVBLK + KVBLK - 1), dr = j * KVBLK - (q0 + 127); const int dmin = dl > 0 ? dl : (dr > 0 ? dr : 0);
    const float smax = qnm * sqrtf(kv) * 1.01f;
    const bool keep = -nsl2 * (float)dmin < 2.f * smax + 30.f;
    const unsigned km = (unsigned)__ballot(keep);
    jlo = __builtin_ctz(km); ntl = 32 - __builtin_clz(km) - jlo; }
  Kh += (size_t)jlo * KVBLK * LDK; Vh += (size_t)jlo * KVBLK * LDK;
  const int vb0 = (int)(uintptr_t)V_lds + v_rd_base(lane);
  const float qposh = (float)(q0 - jlo * KVBLK + rg * 32 + r32 - 4 * hi);
  int kso[2], vso[2];
#pragma unroll
  for (int q = 0; q < 2; ++q) {
    const int row = 4 * (wid * 2 + q) + (lane >> 4), c = (lane & 15) ^ (row & 15); kso[q] = row * (LDK * 2) + c * 16;
    const int s = (wid * 2 + q) * 64 + lane, hi5 = s >> 5, kk = ((hi5 >> 2) << 3) | ((s >> 2) & 7), k = (kk & ~0xC) | ((kk & 4) << 1) | ((kk & 8) >> 1), cch = (hi5 & 3) * 4 + (s & 3);
    vso[q] = k * (LDK * 2) + cch * 16; }
  __attribute__((address_space(3))) char* const l3 = (__attribute__((address_space(3))) char*)lds;
#define DMA_K(t, b) do { _Pragma("unroll") for (int q_ = 0; q_ < 2; ++q_) __builtin_amdgcn_global_load_lds((const unsigned*)((const char*)Kh + (size_t)(t) * (KVBLK * LDK * 2) + kso[q_]), \
    (__attribute__((address_space(3))) unsigned*)(l3 + 3 * SHM_V + (b) * SHM_K + (wid * 2 + q_) * 1024), 16, 0, 0); } while (0)
#define DMA_V(t, b) do { _Pragma("unroll") for (int q_ = 0; q_ < 2; ++q_) __builtin_amdgcn_global_load_lds((const unsigned*)((const char*)Vh + (size_t)(t) * (KVBLK * LDK * 2) + vso[q_]), \
    (__attribute__((address_space(3))) unsigned*)(l3 + (b) * SHM_V + (wid * 2 + q_) * 1024), 16, 0, 0); } while (0)
#define BAR() do { asm volatile("" ::: "memory"); __builtin_amdgcn_s_barrier(); asm volatile("" ::: "memory"); } while (0)
#define RESC(a) do { if (__any((a) < 1.f)) { if (hi == 0) al_l[r32] = (a); asm volatile("s_waitcnt lgkmcnt(0)" ::: "memory"); \
    _Pragma("unroll") for (int d = 0; d < 4; ++d) _Pragma("unroll") for (int r = 0; r < 16; ++r) o[d][r] *= al_l[crow(r, hi)]; } } while (0)
  f32x16 p0, p1; float alpha = 1.f; bf16x8 pa0, pa1, pa2, pa3; const int NTL = ntl;
  const float aa = -nsl2; const int tdiag = __builtin_amdgcn_readfirstlane(((q0 + rg * 32) >> 6) - jlo);
  f32x16 i0;
#pragma unroll
  for (int r = 0; r < 16; ++r) i0[r] = aa * (float)((r & 3) + 8 * (r >> 2));
  int ka[4];
#pragma unroll
  for (int d0 = 0; d0 < 4; ++d0) ka[d0] = (int)(uintptr_t)K_lds + AT_KSWZ(r32, (cm + d0 * 16 + hi * 8) * 2);
#define FLIP(t) do { if ((t) == tdiag + 1) { _Pragma("unroll") for (int r = 0; r < 16; ++r) asm volatile("v_xor_b32 %0, 0x80000000, %0" : "+v"(i0[r])); } } while (0)
#define YPHASE(t) do { const float dq = qposh - (float)((t) * KVBLK); if ((t) == tdiag) diagfix(p0, p1, i0, dq, aa); \
    softmax_tile(p0, p1, dq, (t) < tdiag ? aa : ((t) == tdiag ? 0.f : -aa), m_reg, l_reg, alpha, pa0, pa1, pa2, pa3); } while (0)
  DMA_K(0, 0); DMA_V(0, 0); if (1 < NTL) DMA_K(1, 1);
  asm volatile("s_waitcnt vmcnt(0)" ::: "memory"); BAR();
  if (grp == 1) { BAR(); __builtin_amdgcn_s_setprio(1); }
  auto nohook = []() {};
  xphase<true, false>(p0, p1, i0, o, ka, 0, qr, vb0, pa0, pa1, pa2, pa3, [&]() { if (2 < NTL) DMA_K(2, 2); }, [&]() { if (1 < NTL) DMA_V(1, 1); });
#define XWAIT(m) do { if ((m) + 2 < NTL) asm volatile("s_waitcnt vmcnt(4)" ::: "memory"); else asm volatile("s_waitcnt vmcnt(0)" ::: "memory"); } while (0)
  if (grp == 1) XWAIT(0);
  BAR();
  YPHASE(0);
  if (grp == 0) XWAIT(0);
  BAR();
  int b0 = 1;
  for (int j = 1; j < NTL; ++j) {
    const int b1 = b0 == 2 ? 0 : b0 + 1, b2 = b1 == 2 ? 0 : b1 + 1;
    RESC(alpha);
    FLIP(j);
    xphase<true, true>(p0, p1, i0, o, ka, b0 * (int)SHM_K, qr, vb0 + b2 * (int)SHM_V, pa0, pa1, pa2, pa3, [&]() { if (j + 2 < NTL) DMA_K(j + 2, b2); }, [&]() { if (j + 1 < NTL) DMA_V(j + 1, b1); });
    if (grp == 1) XWAIT(j);
    BAR();
    YPHASE(j);
    if (grp == 0) XWAIT(j);
    BAR();
    b0 = b1;
  }
  { const int bl = b0 == 0 ? 2 : b0 - 1;
    RESC(alpha); xphase<false, true>(p0, p1, i0, o, ka, 0, qr, vb0 + bl * (int)SHM_V, pa0, pa1, pa2, pa3, nohook, nohook); }
  BAR();
  if (grp == 0) BAR(); else __builtin_amdgcn_s_setprio(0);
#undef FLIP
#undef XWAIT
#undef YPHASE
#undef DMA_K
#undef DMA_V
#undef BAR
  if (hi == 0) li_l[r32] = l_reg; asm volatile("s_waitcnt lgkmcnt(0)" ::: "memory");
  float rli[16];
#pragma unroll
  for (int r = 0; r < 16; ++r) rli[r] = __builtin_amdgcn_rcpf(li_l[crow(r, hi)]);
#pragma unroll
  for (int d = 0; d < 4; ++d)
#pragma unroll
    for (int r = 0; r < 16; ++r) o[d][r] *= rli[r];
  __syncthreads();
  float* X = (float*)lds + rg * (32 * 128);
  if (cmap == 1) {
#pragma unroll
    for (int d = 0; d < 4; ++d)
#pragma unroll
      for (int r = 0; r < 16; ++r) X[crow(r, hi) * 128 + d * 32 + r32] = o[d][r];
  }
  __syncthreads();
  if (cmap == 0) {
    float ss[16];
#pragma unroll
    for (int r = 0; r < 16; ++r) ss[r] = 0.f;
#pragma unroll
    for (int d = 0; d < 4; ++d)
#pragma unroll
      for (int r = 0; r < 16; ++r) { const float v = o[d][r] - lam * X[crow(r, hi) * 128 + d * 32 + r32]; o[d][r] = v; ss[r] += v * v; }
#pragma unroll
    for (int r = 0; r < 16; ++r) { float s = ss[r]; s += __shfl_xor(s, 16); s += __shfl_xor(s, 8); s += __shfl_xor(s, 4); s += __shfl_xor(s, 2); s += __shfl_xor(s, 1);
      ss[r] = rsqrtf(s * (1.f / 128.f) + 1e-5f) * (1.f - LAMBDA_INIT); }
    float nw[4];
#pragma unroll
    for (int d = 0; d < 4; ++d) nw[d] = normw[d * 32 + r32];
#pragma unroll
    for (int r = 0; r < 16; ++r) { bf16_t* up = Ub + (size_t)(rg * 32 + crow(r, hi)) * D + r32;
#pragma unroll
      for (int d = 0; d < 4; ++d) up[d * 32] = f2bf(o[d][r] * ss[r] * nw[d]); }
  }
  __syncthreads();
#undef RESC
}
}

__device__ __forceinline__ void ph_attn_mfma(const Params& p, char* lds, int* qhead) {
  float lam;
  { float s1 = 0.f, s2 = 0.f; for (int i = 0; i < 64; ++i) { s1 += p.lq1[i] * p.lk1[i]; s2 += p.lq2[i] * p.lk2[i]; } lam = __expf(s1) - __expf(s2) + LAMBDA_INIT; }
  int* qslot = (int*)(lds + 100 * 1024);
  bool more_a = true, more_c = true;
  for (int turn = 0; more_a || more_c; ++turn) {
    const bool do_attn = more_a && (!more_c || (turn & 1) == 0);
    __syncthreads();
    if (threadIdx.x == 0) *qslot = atomicAdd(do_attn ? qhead : qhead + 4, 1);
    __syncthreads();
    const int item = *qslot;
    if (do_attn) {
      if (item >= NB * AH * (S / 128)) { more_a = false; continue; }
      const int qb = item % (S / 128), h = (item / (S / 128)) % AH, b = item / ((S / 128) * AH);
      const float nsl2 = -exp2f(-(float)(h + 1)) * LOG2E;
      const size_t row0 = (size_t)b * S;
      at::attn_item(p.proj + (row0 + qb * 128) * PLD + N_Q + h * 128, p.proj + row0 * PLD + N_K + h * 128, p.proj + row0 * PLD + N_V + h * 128,
                    p.u + (row0 + qb * 128) * D + DSSD + h * 128, qb * 128, nsl2, lam, p.attn_norm_w, p.kn2 + (size_t)(b * AH + h) * 2 * (S / 64), lds);
    } else {
      if (2 * item >= CVT_ITEMS) { more_c = false; continue; }
      cvt_moe_item(p, 2 * item); if (2 * item + 1 < CVT_ITEMS) cvt_moe_item(p, 2 * item + 1);
    }
  }
}
namespace sd {
using at::bf16x8; using at::s16x4; using at::f32x16; using at::u32x4; using at::crow; using at::cvtpk; using at::v_st; using at::v_rd_base; using at::v_rd_off; using at::tr_read;
constexpr int CH = 64, NCH = S / CH;
constexpr int L_BT = 0, L_CT = 16384, L_XV = 32768, L_TAB = 98304, L_SS = 106496;
constexpr size_t SNAP = 16384;
__device__ __forceinline__ size_t snap_off(int dir, int b, int h, int c) { return ((((size_t)dir * NB + b) * NH + h) * NCH + c) * SNAP; }

__device__ __forceinline__ void ph_conv16(const Params& p) {
  { const int tidf = tid_fresh(), lane = tidf & 63, wv = tidf >> 6;
    for (int it = blockIdx.x * 8 + wv; it < NB * AH * 2 * (S / 64); it += gridDim.x * 8) {
      const int j = it % (S / 64), c = (it / (S / 64)) & 1, h = (it / (2 * (S / 64))) % AH, b = it / (2 * (S / 64) * AH);
      const bf16_t* kp = p.proj + ((size_t)b * S + j * 64 + lane) * PLD + N_K + h * 128 + c * 64; float ss = 0.f;
#pragma unroll
      for (int q = 0; q < 8; ++q) { const u32x4 w = *(const u32x4*)(kp + q * 8);
        const float x0 = __uint_as_float(w.x << 16), x1 = __uint_as_float(w.x & 0xffff0000u), x2 = __uint_as_float(w.y << 16), x3 = __uint_as_float(w.y & 0xffff0000u);
        const float x4 = __uint_as_float(w.z << 16), x5 = __uint_as_float(w.z & 0xffff0000u), x6 = __uint_as_float(w.w << 16), x7 = __uint_as_float(w.w & 0xffff0000u);
        ss += x0 * x0 + x1 * x1 + x2 * x2 + x3 * x3 + x4 * x4 + x5 * x5 + x6 * x6 + x7 * x7; }
      for (int o = 32; o >= 1; o >>= 1) ss = fmaxf(ss, __shfl_xor(ss, o));
      if (lane == 0) p.kn2[(size_t)((b * AH + h) * 2 + c) * (S / 64) + j] = ss; } }
  constexpr int SEG = 16, NCG = CC / 8, NU = NCG * (T / SEG);
  for (int u = blockIdx.x * NT + tid_fresh(); u < NU; u += gridDim.x * NT) {
    const int cg = u % NCG, seg = u / NCG, t0 = seg * SEG, s0 = t0 % S, chan = cg * 8;
    float w[5][8], bias[8];
#pragma unroll
    for (int j = 0; j < 5; ++j) { const float4 a = *(const float4*)(p.conv_w + j * CC + chan), c = *(const float4*)(p.conv_w + j * CC + chan + 4);
      w[j][0] = a.x; w[j][1] = a.y; w[j][2] = a.z; w[j][3] = a.w; w[j][4] = c.x; w[j][5] = c.y; w[j][6] = c.z; w[j][7] = c.w; }
    { const float4 a = *(const float4*)(p.conv_b + chan), c = *(const float4*)(p.conv_b + chan + 4);
      bias[0] = a.x; bias[1] = a.y; bias[2] = a.z; bias[3] = a.w; bias[4] = c.x; bias[5] = c.y; bias[6] = c.z; bias[7] = c.w; }
    const bf16_t* base = p.proj + (size_t)t0 * PLD + N_XBC + chan;
    u32x4 rows[SEG + 4];
#pragma unroll
    for (int i = 0; i < SEG + 4; ++i) { const int s = s0 + i - 2; rows[i] = (u32x4){0u, 0u, 0u, 0u}; if (s >= 0 && s < S) rows[i] = *(const u32x4*)(base + (ptrdiff_t)(i - 2) * PLD); }
#pragma unroll
    for (int i = 0; i < SEG; ++i) {
      float o[8];
#pragma unroll
      for (int c = 0; c < 8; ++c) o[c] = bias[c];
#pragma unroll
      for (int j = 0; j < 5; ++j) { const u32x4 rr = rows[i + j];
        o[0] += w[j][0] * __uint_as_float(rr.x << 16); o[1] += w[j][1] * __uint_as_float(rr.x & 0xffff0000u);
        o[2] += w[j][2] * __uint_as_float(rr.y << 16); o[3] += w[j][3] * __uint_as_float(rr.y & 0xffff0000u);
        o[4] += w[j][4] * __uint_as_float(rr.z << 16); o[5] += w[j][5] * __uint_as_float(rr.z & 0xffff0000u);
        o[6] += w[j][6] * __uint_as_float(rr.w << 16); o[7] += w[j][7] * __uint_as_float(rr.w & 0xffff0000u); }
#pragma unroll
      for (int c = 0; c < 8; ++c) o[c] = o[c] * __builtin_amdgcn_rcpf(1.f + __expf(-o[c]));
      u32x4 pk; pk.x = cvtpk(o[0], o[1]); pk.y = cvtpk(o[2], o[3]); pk.z = cvtpk(o[4], o[5]); pk.w = cvtpk(o[6], o[7]);
      *(u32x4*)(p.xc16 + (size_t)(t0 + i) * CC + chan) = pk;
    }
  }
}
template <bool WITH_C, bool BV>
__device__ __forceinline__ void load_chunk(const Params& p, char* lds, int b, int g, int c0) {
  constexpr int NCG = WITH_C ? 96 : 80, NP = NCG * CH / NT;
  int tid = threadIdx.x; asm volatile("" : "+v"(tid));
  const bf16_t* src = p.xc16 + ((size_t)b * S + c0) * CC;
  u32x4 v[NP];
#pragma unroll
  for (int i = 0; i < NP; ++i) { const int idx = tid + NT * i, tok = idx / NCG, cg = idx % NCG;
    const int chan = cg < 64 ? g * 512 + cg * 8 : (cg < 80 ? 1024 + g * 128 + (cg - 64) * 8 : 1280 + g * 128 + (cg - 80) * 8);
    v[i] = *(const u32x4*)(src + (size_t)tok * CC + chan); }
#pragma unroll
  for (int i = 0; i < NP; ++i) { const int idx = tid + NT * i, tok = idx / NCG, cg = idx % NCG;
    if (cg < 64) { const int hl = cg >> 3, c = (hl & 1) * 64 + (cg & 7) * 8; *(u32x4*)(lds + L_XV + (hl >> 1) * 16384 + v_st(tok, c)) = v[i]; }
    else if (cg < 80) { const int n0 = (cg - 64) * 8; if (BV) *(u32x4*)(lds + L_BT + v_st(tok, n0)) = v[i]; else *(u32x4*)(lds + L_BT + AT_KSWZ(tok, n0 * 2)) = v[i]; }
    else { const int n0 = (cg - 80) * 8; *(u32x4*)(lds + L_CT + AT_KSWZ(tok, n0 * 2)) = v[i]; } }
}
__device__ __forceinline__ float wave_incl_prefix(float v, int lane) {
#pragma unroll
  for (int o = 1; o < 64; o <<= 1) { const float t = __int_as_float(__builtin_amdgcn_ds_bpermute(((lane - o) & 63) << 2, __float_as_int(v))); if (lane >= o) v += t; }
  return v;
}
__device__ __forceinline__ float wave_incl_suffix(float v, int lane) {
#pragma unroll
  for (int o = 1; o < 64; o <<= 1) { const float t = __int_as_float(__builtin_amdgcn_ds_bpermute(((lane + o) & 63) << 2, __float_as_int(v))); if (lane + o < 64) v += t; }
  return v;
}
__device__ __forceinline__ float wave_bcast(float v, int src) { return __int_as_float(__builtin_amdgcn_ds_bpermute(src << 2, __float_as_int(v))); }
__device__ __forceinline__ bf16x8 scale_frag(s16x4 lo, s16x4 hi, const float4 w0, const float4 w1) {
  const unsigned a = ((unsigned)(unsigned short)lo[0]) | ((unsigned)(unsigned short)lo[1] << 16), b = ((unsigned)(unsigned short)lo[2]) | ((unsigned)(unsigned short)lo[3] << 16);
  const unsigned c = ((unsigned)(unsigned short)hi[0]) | ((unsigned)(unsigned short)hi[1] << 16), d = ((unsigned)(unsigned short)hi[2]) | ((unsigned)(unsigned short)hi[3] << 16);
  u32x4 r;
  r.x = cvtpk(__uint_as_float(a << 16) * w0.x, __uint_as_float(a & 0xffff0000u) * w0.y);
  r.y = cvtpk(__uint_as_float(b << 16) * w0.z, __uint_as_float(b & 0xffff0000u) * w0.w);
  r.z = cvtpk(__uint_as_float(c << 16) * w1.x, __uint_as_float(c & 0xffff0000u) * w1.y);
  r.w = cvtpk(__uint_as_float(d << 16) * w1.z, __uint_as_float(d & 0xffff0000u) * w1.w);
  return *reinterpret_cast<bf16x8*>(&r);
}
#define SD_PK(L, H) (bf16x8){L[0], L[1], L[2], L[3], H[0], H[1], H[2], H[3]}

__device__ __forceinline__ void pass_a_item(const Params& p, char* lds, char* snap, int b, int g, int dir) {
  int tid = threadIdx.x; asm volatile("" : "+v"(tid));
  const int hl = tid >> 6, lane = tid & 63, r32 = lane & 31, hi = lane >> 5, h = g * 8 + hl;
  const float a = -__expf(dir ? p.a_log_b[h] : p.a_log_f[h]);
  float* wtab = (float*)(lds + L_TAB) + hl * 64;
  const int vbx = (int)(uintptr_t)(lds + L_XV + (hl >> 1) * 16384) + v_rd_base(lane) + (hl & 1) * 1024;
  const int vbb = (int)(uintptr_t)(lds + L_BT) + v_rd_base(lane);
  f32x16 st[4][2];
#pragma unroll
  for (int nb = 0; nb < 4; ++nb)
#pragma unroll
    for (int pb = 0; pb < 2; ++pb) st[nb][pb] = f32x16{};
  for (int ci = 0; ci < NCH; ++ci) {
    const int c = dir ? (NCH - 1 - ci) : ci, c0 = c * CH;
    __syncthreads();
    load_chunk<false, true>(p, lds, b, g, c0);
    const float dtv = p.dt[((size_t)b * S + c0 + lane) * 32 + dir * 16 + h];
    const float adt = a * dtv;
    const float cum = dir ? wave_incl_suffix(adt, lane) : wave_incl_prefix(adt, lane);
    const float total = wave_bcast(cum, dir ? 0 : 63);
    wtab[lane] = __expf(total - cum) * dtv;
    const float dec = __expf(total);
    { char* sp = snap + snap_off(dir, b, h, c);
#pragma unroll
      for (int nb = 0; nb < 4; ++nb)
#pragma unroll
        for (int pb = 0; pb < 2; ++pb)
#pragma unroll
          for (int q = 0; q < 4; ++q) { const f32x16& s = st[nb][pb];
            uint2 v; v.x = cvtpk(s[4 * q + 0], s[4 * q + 1]); v.y = cvtpk(s[4 * q + 2], s[4 * q + 3]);
            *(uint2*)(sp + ((((pb * 8 + nb * 2 + (q >> 1)) * 2 + (q & 1)) * 32 + r32) * 16 + hi * 8)) = v; } }
#pragma unroll
    for (int nb = 0; nb < 4; ++nb)
#pragma unroll
      for (int pb = 0; pb < 2; ++pb)
#pragma unroll
        for (int r = 0; r < 16; ++r) st[nb][pb][r] *= dec;
    __syncthreads();
#pragma unroll
    for (int ks = 0; ks < 4; ++ks) {
      const float4 w0 = *(const float4*)(wtab + ks * 16 + hi * 8), w1 = *(const float4*)(wtab + ks * 16 + hi * 8 + 4);
      bf16x8 xf[2];
      { const s16x4 l0 = tr_read<v_rd_off(0, 0, 0)>(vbx + ks * 4096), h0 = tr_read<v_rd_off(0, 0, 1)>(vbx + ks * 4096), l1 = tr_read<v_rd_off(1, 0, 0)>(vbx + ks * 4096), h1 = tr_read<v_rd_off(1, 0, 1)>(vbx + ks * 4096);
        asm volatile("s_waitcnt lgkmcnt(0)" ::: "memory"); AT_SBAR();
        xf[0] = scale_frag(l0, h0, w0, w1); xf[1] = scale_frag(l1, h1, w0, w1); }
#pragma unroll
      for (int nb = 0; nb < 4; ++nb) {
        s16x4 bl, bh;
        asm volatile("ds_read_b64_tr_b16 %0, %1" : "=&v"(bl) : "v"(vbb + nb * 512 + ks * 4096) : "memory");
        asm volatile("ds_read_b64_tr_b16 %0, %1 offset:2048" : "=&v"(bh) : "v"(vbb + nb * 512 + ks * 4096) : "memory");
        asm volatile("s_waitcnt lgkmcnt(0)" ::: "memory"); AT_SBAR();
        const bf16x8 bfr = SD_PK(bl, bh);
        st[nb][0] = __builtin_amdgcn_mfma_f32_32x32x16_bf16(bfr, xf[0], st[nb][0], 0, 0, 0);
        st[nb][1] = __builtin_amdgcn_mfma_f32_32x32x16_bf16(bfr, xf[1], st[nb][1], 0, 0, 0);
      }
    }
  }
  __syncthreads();
}

__device__ __forceinline__ void pass_b_item(const Params& p, char* lds, const char* snap, int b, int g, int c) {
  int tid = threadIdx.x; asm volatile("" : "+v"(tid));
  const int hl = tid >> 6, lane = tid & 63, r32 = lane & 31, hi = lane >> 5, h = g * 8 + hl, c0 = c * CH;
  float4* tab = (float4*)(lds + L_TAB) + hl * 64;
  float* ssp = (float*)(lds + L_SS);
  const int vbx = (int)(uintptr_t)(lds + L_XV + (hl >> 1) * 16384) + v_rd_base(lane) + (hl & 1) * 1024;
  __syncthreads();
  load_chunk<true, false>(p, lds, b, g, c0);
  { const size_t tok = (size_t)b * S + c0 + lane;
    const float dtf = p.dt[tok * 32 + h], dtb = p.dt[tok * 32 + 16 + h];
    const float af = -__expf(p.a_log_f[h]) * dtf, ab = -__expf(p.a_log_b[h]) * dtb;
    tab[lane] = make_float4(wave_incl_prefix(af, lane) * LOG2E, wave_incl_suffix(ab, lane) * LOG2E, dtf, dtb); }
  __syncthreads();
  const float dsk = p.d_skip[h];
  f32x16 o[2][2];
#pragma unroll
  for (int lb = 0; lb < 2; ++lb) {
    const int l = lb * 32 + r32;
    const float4 tl = tab[l];
    bf16x8 cr[8];
#pragma unroll
    for (int kk = 0; kk < 8; ++kk) cr[kk] = *reinterpret_cast<const bf16x8*>(lds + L_CT + AT_KSWZ(l, (kk * 16 + hi * 8) * 2));
    f32x16 p0 = f32x16{}, p1 = f32x16{};
#pragma unroll
    for (int kk = 0; kk < 8; ++kk) { const int cb = (kk * 16 + hi * 8) * 2;
      const bf16x8 b0 = *reinterpret_cast<const bf16x8*>(lds + L_BT + AT_KSWZ(r32, cb));
      const bf16x8 b1 = *reinterpret_cast<const bf16x8*>(lds + L_BT + AT_KSWZ(32 + r32, cb));
      p0 = __builtin_amdgcn_mfma_f32_32x32x16_bf16(b0, cr[kk], p0, 0, 0, 0);
      p1 = __builtin_amdgcn_mfma_f32_32x32x16_bf16(b1, cr[kk], p1, 0, 0, 0); }
#pragma unroll
    for (int r = 0; r < 16; ++r) {
#pragma unroll
      for (int half = 0; half < 2; ++half) {
        const int s = crow(r, hi) + 32 * half; const float4 ts = tab[s];
        float m = 0.f;
        if (s <= l) m += __builtin_amdgcn_exp2f(tl.x - ts.x) * ts.z;
        if (s >= l) m += __builtin_amdgcn_exp2f(tl.y - ts.y) * ts.w;
        const float add = (s == l) ? dsk : 0.f;
        if (half) p1[r] = p1[r] * m + add; else p0[r] = p0[r] * m + add;
      }
      if ((r & 3) == 3) asm volatile("" ::: "memory");
    }
    bf16x8 pa0, pa1, pa2, pa3;
#define SD_PK4(P, BASE, OUT) do { unsigned a0 = cvtpk(P[BASE + 0], P[BASE + 1]), a1 = cvtpk(P[BASE + 2], P[BASE + 3]);   \
    unsigned b0_ = cvtpk(P[BASE + 4], P[BASE + 5]), b1_ = cvtpk(P[BASE + 6], P[BASE + 7]);                              \
    auto r0 = __builtin_amdgcn_permlane32_swap(a0, b0_, false, false); auto r1 = __builtin_amdgcn_permlane32_swap(a1, b1_, false, false); \
    u32x4 w_ = {r0[0], r1[0], r0[1], r1[1]}; OUT = *reinterpret_cast<bf16x8*>(&w_); } while (0)
    SD_PK4(p0, 0, pa0); SD_PK4(p0, 8, pa1); SD_PK4(p1, 0, pa2); SD_PK4(p1, 8, pa3);
#undef SD_PK4
#pragma unroll
    for (int d = 0; d < 2; ++d) {
      const s16x4 l0 = d ? tr_read<v_rd_off(1, 0, 0)>(vbx) : tr_read<v_rd_off(0, 0, 0)>(vbx), h0 = d ? tr_read<v_rd_off(1, 0, 1)>(vbx) : tr_read<v_rd_off(0, 0, 1)>(vbx);
      const s16x4 l1 = d ? tr_read<v_rd_off(1, 1, 0)>(vbx) : tr_read<v_rd_off(0, 1, 0)>(vbx), h1 = d ? tr_read<v_rd_off(1, 1, 1)>(vbx) : tr_read<v_rd_off(0, 1, 1)>(vbx);
      const s16x4 l2 = d ? tr_read<v_rd_off(1, 2, 0)>(vbx) : tr_read<v_rd_off(0, 2, 0)>(vbx), h2 = d ? tr_read<v_rd_off(1, 2, 1)>(vbx) : tr_read<v_rd_off(0, 2, 1)>(vbx);
      const s16x4 l3 = d ? tr_read<v_rd_off(1, 3, 0)>(vbx) : tr_read<v_rd_off(0, 3, 0)>(vbx), h3 = d ? tr_read<v_rd_off(1, 3, 1)>(vbx) : tr_read<v_rd_off(0, 3, 1)>(vbx);
      asm volatile("s_waitcnt lgkmcnt(0)" ::: "memory"); AT_SBAR();
      f32x16 od = f32x16{};
      od = __builtin_amdgcn_mfma_f32_32x32x16_bf16(pa0, SD_PK(l0, h0), od, 0, 0, 0);
      od = __builtin_amdgcn_mfma_f32_32x32x16_bf16(pa1, SD_PK(l1, h1), od, 0, 0, 0);
      od = __builtin_amdgcn_mfma_f32_32x32x16_bf16(pa2, SD_PK(l2, h2), od, 0, 0, 0);
      od = __builtin_amdgcn_mfma_f32_32x32x16_bf16(pa3, SD_PK(l3, h3), od, 0, 0, 0);
      o[lb][d] = od;
    }
  }
  { const bool has0 = (c != 0), has1 = (c != NCH - 1);
    const char* sp0 = snap + snap_off(0, b, h, c); const char* sp1 = snap + snap_off(1, b, h, c);
    bf16x8 sfa[8], sfb[8];
#define SD_LOADSF(dst, G) do { const char* sp_ = ((G) >> 1) ? sp1 : sp0; if (((G) >> 1) ? has1 : has0) { _Pragma("unroll") for (int kk = 0; kk < 8; ++kk) \
      dst[kk] = *reinterpret_cast<const bf16x8*>(sp_ + ((((((G) & 1) * 8 + kk) * 2 + hi) * 32 + r32) * 16)); } } while (0)
#define SD_USESF(src, G) do { if (((G) >> 1) ? has1 : has0) { _Pragma("unroll") for (int lb = 0; lb < 2; ++lb) { f32x16 acc = f32x16{}; \
      _Pragma("unroll") for (int kk = 0; kk < 8; ++kk) { const bf16x8 cf = *reinterpret_cast<const bf16x8*>(lds + L_CT + AT_KSWZ(lb * 32 + r32, (kk * 16 + hi * 8) * 2)); \
        acc = __builtin_amdgcn_mfma_f32_32x32x16_bf16(cf, src[kk], acc, 0, 0, 0); } \
      _Pragma("unroll") for (int r = 0; r < 16; ++r) { const float4 tr = tab[lb * 32 + crow(r, hi)]; o[lb][(G) & 1][r] += __builtin_amdgcn_exp2f(((G) >> 1) ? tr.y : tr.x) * acc[r]; } } } } while (0)
    SD_LOADSF(sfa, 0);
    SD_LOADSF(sfb, 1); SD_USESF(sfa, 0); asm volatile("" ::: "memory");
    SD_LOADSF(sfa, 2); SD_USESF(sfb, 1); asm volatile("" ::: "memory");
    SD_LOADSF(sfb, 3); SD_USESF(sfa, 2); asm volatile("" ::: "memory");
    SD_USESF(sfb, 3);
#undef SD_LOADSF
#undef SD_USESF
  }
  asm volatile("" ::: "memory");
  const bf16_t* zp = p.proj + ((size_t)b * S + c0) * PLD + N_Z + h * HD + r32;
#pragma unroll
  for (int lb = 0; lb < 2; ++lb)
#pragma unroll
    for (int r = 0; r < 16; ++r) { const int l = lb * 32 + crow(r, hi); float ss = 0.f;
#pragma unroll
      for (int d = 0; d < 2; ++d) { const float z = bf2f(zp[(size_t)l * PLD + d * 32]); const float y = o[lb][d][r] * z * __builtin_amdgcn_rcpf(1.f + __expf(-z)); o[lb][d][r] = y; ss += y * y; }
      ss += __shfl_xor(ss, 16); ss += __shfl_xor(ss, 8); ss += __shfl_xor(ss, 4); ss += __shfl_xor(ss, 2); ss += __shfl_xor(ss, 1);
      if (r32 == 0) ssp[hl * 64 + l] = ss;
      if ((r & 3) == 3) asm volatile("" ::: "memory"); }
  __syncthreads();
  const float nw0 = p.ssd_norm_w[h * HD + r32], nw1 = p.ssd_norm_w[h * HD + 32 + r32];
  bf16_t* up = p.u + ((size_t)b * S + c0) * D + h * HD + r32;
#pragma unroll
  for (int lb = 0; lb < 2; ++lb)
#pragma unroll
    for (int r = 0; r < 16; ++r) { const int l = lb * 32 + crow(r, hi); float ss = 0.f;
#pragma unroll
      for (int q = 0; q < 8; ++q) ss += ssp[q * 64 + l];
      const float rstd = rsqrtf(ss * (1.f / 512.f) + 1e-5f);
      up[(size_t)l * D] = f2bf(o[lb][0][r] * rstd * nw0); up[(size_t)l * D + 32] = f2bf(o[lb][1][r] * rstd * nw1); }
}
}

__device__ __forceinline__ void ph_ssd_a(const Params& p, char* lds, char* snap) {
  for (int item = blockIdx.x; item < NB * 2 * 2; item += gridDim.x) { const int dir = item & 1, g = (item >> 1) & 1, b = item >> 2; sd::pass_a_item(p, lds, snap, b, g, dir); }
}
__device__ __forceinline__ void ph_ssd_b(const Params& p, char* lds, const char* snap) {
  for (int item = blockIdx.x; item < NB * 2 * sd::NCH; item += gridDim.x) { const int c = item % sd::NCH, g = (item / sd::NCH) & 1, b = item / (2 * sd::NCH); sd::pass_b_item(p, lds, snap, b, g, c); }
}
__device__ __forceinline__ void ph_inproj(const Params& p, LAS unsigned char* lds) {
  pg8::Gemm g{(const bf16_t*)p.xq, (const bf16_t*)p.WinQ, D / 2, 0, 0};
  pg8::OrderStatic Sd; Sd.init(T, NPROJ, gridDim.x, blockIdx.x);
  EpiProj E{p.proj, p.dt, p.dt_bias_f, p.dt_bias_b, p.sx, p.sw};
  pg8::gemm_phase<false, false, EpiProj, pg8::OrderStatic, true>(lds, g, Sd, E);
}
__device__ __forceinline__ void ph_outproj(const Params& p, LAS unsigned char* lds) {
  pg8::Gemm g{p.u, p.WoutT, D, 0, 0}; pg8::OrderStatic Sd; Sd.init(T, D, gridDim.x, blockIdx.x);
#ifdef PROBE_OUT2
  { EpiOut E2{p.xb, (size_t)((bf16_t*)p.H - p.xb)}; pg8::gemm_phase<false, false>(lds, g, Sd, E2); }
#endif
  EpiOut E{p.xb, 0};
  pg8::gemm_phase<false, false>(lds, g, Sd, E);
}
__device__ __forceinline__ int ld_agent(const int* p) { return __hip_atomic_load(p, __ATOMIC_RELAXED, __HIP_MEMORY_SCOPE_AGENT); }
__device__ __forceinline__ float ld_agent(const float* p) { return __hip_atomic_load(p, __ATOMIC_RELAXED, __HIP_MEMORY_SCOPE_AGENT); }
__device__ __forceinline__ void ph_ln_route(const Params& p, char* ldsg, LAS unsigned char* lds) {
  typedef short bf16x8 __attribute__((ext_vector_type(8)));
  LAS int* cntl = (LAS int*)lds;
  int tid = threadIdx.x; asm volatile("" : "+v"(tid));
  const int lane = tid & 63, wv = tid >> 6;
  float* lg = (float*)(ldsg + 132 * 1024) + wv * 512;
  const float rbias = p.router_bias[lane];
  for (int tb = blockIdx.x; tb < T / 64; tb += gridDim.x) {
    __syncthreads();
    if (tid < NE) cntl[tid] = 0;
    { float* gl = (float*)(ldsg + 4096); *(f32x4*)(gl + tid * 4) = *(const f32x4*)(p.ln1_g + tid * 4); *(f32x4*)(gl + 2048 + tid * 4) = *(const f32x4*)(p.ln1_b + tid * 4); }
    __syncthreads();
    const int t0 = tb * 64 + wv * 8;
    {
    const float* gl = (const float*)(ldsg + 4096);
#pragma unroll 1
    for (int i0 = 0; i0 < 8; i0 += 4) {
    u32x4 nx[4][4];
#pragma unroll
    for (int r = 0; r < 4; ++r)
#pragma unroll
      for (int g = 0; g < 4; ++g) nx[r][g] = *(const u32x4*)(p.xb + (size_t)(t0 + i0 + r) * D + g * 512 + lane * 8);
#pragma unroll
    for (int ii = 0; ii < 4; ++ii) { const int i = i0 + ii;
      float v[32]; float s = 0.f;
#pragma unroll
      for (int g = 0; g < 4; ++g) { const u32x4 w = nx[ii][g];
        v[g * 8 + 0] = __uint_as_float(w.x << 16); v[g * 8 + 1] = __uint_as_float(w.x & 0xffff0000u); v[g * 8 + 2] = __uint_as_float(w.y << 16); v[g * 8 + 3] = __uint_as_float(w.y & 0xffff0000u);
        v[g * 8 + 4] = __uint_as_float(w.z << 16); v[g * 8 + 5] = __uint_as_float(w.z & 0xffff0000u); v[g * 8 + 6] = __uint_as_float(w.w << 16); v[g * 8 + 7] = __uint_as_float(w.w & 0xffff0000u); }
#pragma unroll
      for (int j = 0; j < 32; ++j) s += v[j];
      const float mu = wave_sum(s) * (1.f / D); float q = 0.f;
#pragma unroll
      for (int j = 0; j < 32; ++j) { const float d = v[j] - mu; q += d * d; }
      const float rstd = rsqrtf(wave_sum(q) * (1.f / D) + 1e-5f);
#pragma unroll
      for (int g = 0; g < 4; ++g) { float o[8];
        const f32x4 ga = *(const f32x4*)(gl + g * 512 + lane * 8), gb = *(const f32x4*)(gl + g * 512 + lane * 8 + 4), ba = *(const f32x4*)(gl + 2048 + g * 512 + lane * 8), bb = *(const f32x4*)(gl + 2048 + g * 512 + lane * 8 + 4);
#pragma unroll
        for (int j = 0; j < 4; ++j) { o[j] = (v[g * 8 + j] - mu) * rstd * ga[j] + ba[j]; o[4 + j] = (v[g * 8 + 4 + j] - mu) * rstd * gb[j] + bb[j]; }
        u32x4 w; w.x = cvt_pk_bf16(o[0], o[1]); w.y = cvt_pk_bf16(o[2], o[3]); w.z = cvt_pk_bf16(o[4], o[5]); w.w = cvt_pk_bf16(o[6], o[7]);
        *(u32x4*)(p.h1b + (size_t)(t0 + i) * D + g * 512 + lane * 8) = w;
        uint2 w8; { int a = __float_as_int(o[0]), b = __float_as_int(o[4]); a = __builtin_amdgcn_cvt_pk_fp8_f32(o[0], o[1], a, false); a = __builtin_amdgcn_cvt_pk_fp8_f32(o[2], o[3], a, true); b = __builtin_amdgcn_cvt_pk_fp8_f32(o[4], o[5], b, false); b = __builtin_amdgcn_cvt_pk_fp8_f32(o[6], o[7], b, true); w8.x = (unsigned)a; w8.y = (unsigned)b; }
        *(uint2*)(p.h1q + (size_t)(t0 + i) * D + g * 512 + lane * 8) = w8; }
      __builtin_amdgcn_sched_barrier(0);
    }
    }
    }
    __threadfence_block(); asm volatile("s_waitcnt vmcnt(0)" ::: "memory"); __syncthreads();
    { f32x4 acc[4][4];
#pragma unroll
      for (int mb = 0; mb < 4; ++mb)
#pragma unroll
        for (int nb = 0; nb < 4; ++nb) acc[mb][nb] = (f32x4){0.f, 0.f, 0.f, 0.f};
      const bf16_t* ap = p.h1b + (size_t)(tb * 64 + (lane & 15)) * D + wv * 256 + 8 * (lane >> 4);
      const bf16_t* bp = p.WrT + (size_t)(lane & 15) * D + wv * 256 + 8 * (lane >> 4);
#pragma unroll 4
      for (int kk = 0; kk < 8; ++kk) {
        bf16x8 a[4], b[4];
#pragma unroll
        for (int q = 0; q < 4; ++q) { a[q] = *(const bf16x8*)(ap + (size_t)q * 16 * D + kk * 32); b[q] = *(const bf16x8*)(bp + (size_t)q * 16 * D + kk * 32); }
#pragma unroll
        for (int mb = 0; mb < 4; ++mb)
#pragma unroll
          for (int nb = 0; nb < 4; ++nb) acc[mb][nb] = __builtin_amdgcn_mfma_f32_16x16x32_bf16(a[mb], b[nb], acc[mb][nb], 0, 0, 0);
      }
      float* red = (float*)(ldsg + 4096) + wv * 4096;
#pragma unroll
      for (int mb = 0; mb < 4; ++mb)
#pragma unroll
        for (int nb = 0; nb < 4; ++nb)
#pragma unroll
          for (int i = 0; i < 4; ++i) red[(mb * 16 + 4 * (lane >> 4) + i) * 64 + nb * 16 + (lane & 15)] = acc[mb][nb][i];
    }
    __syncthreads();
    { const float* red = (const float*)(ldsg + 4096);
#pragma unroll
      for (int ti = 0; ti < 8; ++ti) { float s = 0.f;
#pragma unroll
        for (int w2 = 0; w2 < 8; ++w2) s += red[w2 * 4096 + (wv * 8 + ti) * 64 + lane];
        lg[ti * 64 + lane] = s; } }
    asm volatile("s_waitcnt lgkmcnt(0)" ::: "memory"); __builtin_amdgcn_wave_barrier();
    { float* rb = (float*)(ldsg + 148 * 1024) + wv * 96;
#define WSYNC() do { asm volatile("s_waitcnt lgkmcnt(0)" ::: "memory"); __builtin_amdgcn_wave_barrier(); } while (0)
      for (int ti = 0; ti < 8; ++ti) {
        const int t = t0 + ti;
        const float sc = 1.f / (1.f + __expf(-lg[ti * 64 + lane]));
        const float bz = sc + rbias;
        WSYNC(); rb[lane] = bz; WSYNC();
        const int g = lane >> 3;
        float gv[8]; { const f32x4 a = *(const f32x4*)(rb + g * 8), b = *(const f32x4*)(rb + g * 8 + 4); gv[0] = a[0]; gv[1] = a[1]; gv[2] = a[2]; gv[3] = a[3]; gv[4] = b[0]; gv[5] = b[1]; gv[6] = b[2]; gv[7] = b[3]; }
        float gs = 0.f;
#pragma unroll
        for (int j = 0; j < 8; ++j) { int rk = 0;
#pragma unroll
          for (int k = 0; k < 8; ++k) rk += (gv[k] > gv[j] || (gv[k] == gv[j] && k < j)) ? 1 : 0;
          gs += rk < 2 ? gv[j] : 0.f; }
        if ((lane & 7) == 0) rb[64 + g] = gs;
        WSYNC();
        int grk = 0;
        { const f32x4 a = *(const f32x4*)(rb + 64), b = *(const f32x4*)(rb + 68); const float q[8] = {a[0], a[1], a[2], a[3], b[0], b[1], b[2], b[3]};
#pragma unroll
          for (int k = 0; k < 8; ++k) grk += (q[k] > gs || (q[k] == gs && k < g)) ? 1 : 0; }
        const bool gsel = grk < 4;
        const float mb = gsel ? bz : -INFINITY;
        WSYNC(); rb[lane] = mb; WSYNC();
        int erk = 0;
#pragma unroll
        for (int k4 = 0; k4 < 16; ++k4) { const f32x4 a = *(const f32x4*)(rb + k4 * 4);
#pragma unroll
          for (int k = 0; k < 4; ++k) erk += (a[k] > mb || (a[k] == mb && (k4 * 4 + k) < lane)) ? 1 : 0; }
        const bool sel = gsel && erk < 8;
        if (sel) rb[72 + erk] = sc;
        WSYNC();
        float gsum; { const f32x4 a = *(const f32x4*)(rb + 72), b = *(const f32x4*)(rb + 76); gsum = ((a[0] + a[1]) + (a[2] + a[3])) + ((b[0] + b[1]) + (b[2] + b[3])); }
        if (sel) {
          const int lr = __hip_atomic_fetch_add(&cntl[lane], 1, __ATOMIC_RELAXED, __HIP_MEMORY_SCOPE_WORKGROUP);
          p.assign[t * 8 + erk] = lane | (lr << 8); p.gate[t * 8 + erk] = sc / gsum * 2.5f;
        }
      }
#undef WSYNC
    }
    __syncthreads();
    if (tid < NE) p.blkcnt[tb * NE + tid] = cntl[tid];
  }
}
__device__ __forceinline__ void ph_place(const Params& p, LAS unsigned char* lds) {
  LAS int* part = (LAS int*)lds;
  LAS int* parta = part + 512;
  LAS int* base = parta + 512;
  LAS int* total = base + 64;
  LAS int* pstart = total + 64;
  const int tid = tid_fresh(), e = tid & 63, pt = tid >> 6;
  for (int tb = blockIdx.x; tb < T / 64; tb += gridDim.x) {
    __syncthreads();
    int slo = 0, sall = 0;
    { int cv[32];
#pragma unroll
      for (int i = 0; i < 32; ++i) cv[i] = p.blkcnt[(pt * 32 + i) * NE + e];
#pragma unroll
      for (int i = 0; i < 32; ++i) { sall += cv[i]; slo += (pt * 32 + i < tb) ? cv[i] : 0; } }
    part[pt * 64 + e] = slo; parta[pt * 64 + e] = sall;
    __syncthreads();
    if (tid < 64) {
      int b0 = 0, t0 = 0;
#pragma unroll
      for (int q = 0; q < 8; ++q) { b0 += part[q * 64 + tid]; t0 += parta[q * 64 + tid]; }
      base[tid] = b0; total[tid] = t0;
      const int padded = (t0 + 255) & ~255;
      int incl = padded;
      for (int o = 1; o < 64; o <<= 1) { const int v = __shfl_up(incl, o); if (tid >= o) incl += v; }
      pstart[tid] = incl - padded;
      if (tid == 63) pstart[64] = incl;
    }
    __syncthreads();
    {
      const int t = tb * 64 + (tid >> 3), k = tid & 7;
      const int a = ld_agent(p.assign + t * 8 + k), ee = a & 255, lr = a >> 8;
      const int row = pstart[ee] + base[ee] + lr;
      p.row_tok[row] = t; p.row_gate[row] = ld_agent(p.gate + t * 8 + k); p.pos[t * 8 + k] = row;
      if (tid < 64) { const int srow = pstart[64] + tb * 64 + tid; p.row_tok[srow] = tb * 64 + tid; p.row_gate[srow] = 1.0f; }
    }
    if (tb == blockIdx.x) {
      for (int e2 = blockIdx.x; e2 < NE; e2 += gridDim.x) {
        const int r0 = pstart[e2] + total[e2], r1 = pstart[e2 + 1];
        for (int r = r0 + tid; r < r1; r += NT) { p.row_tok[r] = 0; p.row_gate[r] = 0.f; }
        for (int j = pstart[e2] / 256 + tid; j < r1 / 256; j += NT) p.tile_exp[j] = e2;
      }
      if (blockIdx.x == 0) {
        const int nr = pstart[64] / 256;
        for (int j = tid; j < T / 256; j += NT) p.tile_exp[nr + j] = NE;
        if (tid == 0) { p.meta[0] = nr; p.meta[1] = nr + T / 256; }
      }
    }
  }
}
struct OrderMoE {
  LAS const int* ulist; int n;
  LAS const unsigned* tab; int tstride;
  __device__ __forceinline__ bool next(int i, pg8::Unit& u) const { if (i >= n) return false; u.pm = ulist[i * 4 + 0]; u.pn = ulist[i * 4 + 1]; u.bn = ulist[i * 4 + 2]; u.aux = i; return true; }
  __device__ __forceinline__ unsigned row_off(int i, int row) const { return tab[i * tstride + row]; }
};
template <int TABLES>
__device__ __forceinline__ OrderMoE moe_order(const Params& p, LAS unsigned char* lds, int npn, int tile0, int ntiles, int rowbytes) {
  LAS int* ulist = (LAS int*)(lds + LDS_TAB); LAS unsigned* tab = (LAS unsigned*)(lds + LDS_TAB + 1024);
  const int G = gridDim.x, c = blockIdx.x, mpc = 32 / npn; int n = 0;
  __syncthreads();
  for (int i = 0; i < 60; ++i) {
    int U; if (G == 256) U = ((i * 8 + (c & 7)) * 32 + (c >> 3)); else U = i * G + c;
    const int chunk = U >> 5, w = U & 31, j = chunk * mpc + (w % mpc), pn = w / mpc;
    if (j >= ntiles) break;
    const int tile = tile0 + j, e = ld_agent(p.tile_exp + tile);
    if (threadIdx.x == 0) { ulist[i * 4 + 0] = tile; ulist[i * 4 + 1] = pn; ulist[i * 4 + 2] = e * npn + pn; ulist[i * 4 + 3] = e; }
    if (TABLES == 2) { for (int r = threadIdx.x; r < 256; r += NT) tab[i * 256 + r] = (unsigned)(tile * 256 + r) * (unsigned)rowbytes; }
    if (TABLES == 1) { for (int r = threadIdx.x; r < 256; r += NT) { tab[i * 512 + r] = (unsigned)ld_agent(p.row_tok + tile * 256 + r) * (unsigned)rowbytes; tab[i * 512 + 256 + r] = __float_as_uint(ld_agent(p.row_gate + tile * 256 + r)); } }
    n = i + 1;
  }
  __syncthreads();
  return OrderMoE{ulist, n, tab, TABLES == 2 ? 256 : 512};
}
__device__ __forceinline__ u32x4 pair16(uint2 a, uint2 b) {
  const auto rx = __builtin_amdgcn_permlane16_swap(a.x, b.x, false, false), ry = __builtin_amdgcn_permlane16_swap(a.y, b.y, false, false);
  return (u32x4){rx[0], ry[0], rx[1], ry[1]};
}
__device__ __forceinline__ uint2 pack8_fp8(const float* h) { int a = __float_as_int(h[0]), b = __float_as_int(h[4]);
  a = __builtin_amdgcn_cvt_pk_fp8_f32(h[0], h[1], a, false); a = __builtin_amdgcn_cvt_pk_fp8_f32(h[2], h[3], a, true); b = __builtin_amdgcn_cvt_pk_fp8_f32(h[4], h[5], b, false); b = __builtin_amdgcn_cvt_pk_fp8_f32(h[6], h[7], b, true); return make_uint2((unsigned)a, (unsigned)b); }
struct EpiGU {
  static constexpr bool PERM = true;
  unsigned char* H; LAS const unsigned* tab;
  __device__ __forceinline__ void operator()(const f32x4 (&acc)[2][2][4][2], const pg8::Unit& u, int wr, int wc, int fr, int fq) const {
    asm volatile("" : "+v"(fr), "+v"(fq));
    const int col0 = u.pn * 128 + wc * 32 + 8 * (fq & ~1);
#pragma unroll
    for (int ai = 0; ai < 2; ++ai)
#pragma unroll
      for (int mp = 0; mp < 2; ++mp) { uint2 pk[2];
#pragma unroll
        for (int mm = 0; mm < 2; ++mm) { const int m = 2 * mp + mm; const int r = ai * 128 + wr * 64 + m * 16 + fr; const float gt = __uint_as_float(tab[u.aux * 512 + 256 + r]) * H8S;
          float h[8];
#pragma unroll
          for (int j = 0; j < 4; ++j) { const float g0 = acc[ai][0][m][0][j], g1 = acc[ai][0][m][1][j];
            h[j] = g0 * __builtin_amdgcn_rcpf(1.f + __expf(-g0)) * acc[ai][1][m][0][j] * gt; h[4 + j] = g1 * __builtin_amdgcn_rcpf(1.f + __expf(-g1)) * acc[ai][1][m][1][j] * gt; }
#pragma unroll
          for (int j = 0; j < 8; ++j) h[j] = __builtin_amdgcn_fmed3f(h[j], -448.f, 448.f);
          pk[mm] = pack8_fp8(h); }
        const int rsel = ai * 128 + wr * 64 + (2 * mp + (fq & 1)) * 16 + fr;
        __builtin_nontemporal_store(pair16(pk[0], pk[1]), (u32x4*)(H + (size_t)(u.pm * 256 + rsel) * DE + col0)); }
  }
};
__device__ __forceinline__ void ph_gateup(const Params& p, LAS unsigned char* lds) {
  const int ntot = ld_agent(p.meta + 1);
  const OrderMoE S = moe_order<1>(p, lds, 4, 0, ntot, D);
  pg8::Gemm g{(const bf16_t*)p.h1q, p.WguT, D / 2, 0x7a7a7a7a  , 0x7f7f7f7f}; EpiGU E{(unsigned char*)p.H, S.tab};
  pg8::gemm_phase<true, true>(lds, g, S, E);
}
struct EpiDown {
  static constexpr bool PERM = true;
  unsigned char* Y;
  __device__ __forceinline__ void operator()(const f32x4 (&acc)[2][2][4][2], const pg8::Unit& u, int wr, int wc, int fr, int fq) const {
    asm volatile("" : "+v"(fr), "+v"(fq));
    const int col0 = u.pn * 256 + wc * 32 + 8 * (fq & ~1);
#pragma unroll
    for (int ai = 0; ai < 2; ++ai)
#pragma unroll
      for (int mp = 0; mp < 2; ++mp) { unsigned char* rowp = Y + (size_t)(u.pm * 256 + ai * 128 + wr * 64 + (2 * mp + (fq & 1)) * 16 + fr) * D + col0;
#pragma unroll
        for (int bj = 0; bj < 2; ++bj) { uint2 pk[2];
#pragma unroll
          for (int mm = 0; mm < 2; ++mm) { const f32x4 v0 = acc[ai][bj][2 * mp + mm][0], v1 = acc[ai][bj][2 * mp + mm][1]; float h[8] = {v0[0], v0[1], v0[2], v0[3], v1[0], v1[1], v1[2], v1[3]};
#pragma unroll
            for (int j = 0; j < 8; ++j) h[j] = __builtin_amdgcn_fmed3f(h[j], -448.f, 448.f);
            pk[mm] = pack8_fp8(h); }
          *(u32x4*)(rowp + bj * 128) = pair16(pk[0], pk[1]); } }
  }
};
__device__ __forceinline__ void ph_down(const Params& p, LAS unsigned char* lds) {
  const int ntot = ld_agent(p.meta + 1);
  const OrderMoE S = moe_order<2>(p, lds, 8, 0, ntot, DE);
  pg8::Gemm g{p.H, p.WdT, DE / 2, 0x7a7a7a7a  , (int)0x81818181u  }; EpiDown E{(unsigned char*)p.Y};
  pg8::gemm_phase<true, true>(lds, g, S, E);
}
__device__ __forceinline__ void acc_fp8x8(float* v, uint2 w) {
  const auto a = __builtin_amdgcn_cvt_pk_f32_fp8((int)w.x, false), b = __builtin_amdgcn_cvt_pk_f32_fp8((int)w.x, true), c = __builtin_amdgcn_cvt_pk_f32_fp8((int)w.y, false), d = __builtin_amdgcn_cvt_pk_f32_fp8((int)w.y, true);
  v[0] += a[0]; v[1] += a[1]; v[2] += b[0]; v[3] += b[1]; v[4] += c[0]; v[5] += c[1]; v[6] += d[0]; v[7] += d[1];
}
__device__ __forceinline__ void ph_combine(const Params& p) {
  const int tidf = tid_fresh(), lane = tidf & 63, wv = tidf >> 6;
  const int srow0 = ld_agent(p.meta + 0) * 256;
  const unsigned char* Yb = (const unsigned char*)p.Y;
  for (int row = blockIdx.x * 8 + wv; row < T; row += gridDim.x * 8) {
    float v[32];
#pragma unroll
    for (int j = 0; j < 32; ++j) v[j] = 0.f;
    int yr[8];
#pragma unroll
    for (int k = 0; k < 8; ++k) yr[k] = ld_agent(p.pos + row * 8 + k);
#pragma unroll
    for (int g = 0; g < 4; ++g) acc_fp8x8(v + g * 8, *(const uint2*)(Yb + (size_t)(srow0 + row) * D + g * 512 + lane * 8));
#pragma unroll
    for (int k = 0; k < 8; ++k) {
#pragma unroll
      for (int g = 0; g < 4; ++g) acc_fp8x8(v + g * 8, *(const uint2*)(Yb + (size_t)yr[k] * D + g * 512 + lane * 8)); }
    { const bf16_t* hp = p.h1b + (size_t)row * D;
#pragma unroll
      for (int g = 0; g < 4; ++g) { const u32x4 hb = *(const u32x4*)(hp + g * 512 + lane * 8);
        v[g * 8 + 0] = v[g * 8 + 0] * Y8I + ALPHA * __uint_as_float(hb.x << 16); v[g * 8 + 1] = v[g * 8 + 1] * Y8I + ALPHA * __uint_as_float(hb.x & 0xffff0000u);
        v[g * 8 + 2] = v[g * 8 + 2] * Y8I + ALPHA * __uint_as_float(hb.y << 16); v[g * 8 + 3] = v[g * 8 + 3] * Y8I + ALPHA * __uint_as_float(hb.y & 0xffff0000u);
        v[g * 8 + 4] = v[g * 8 + 4] * Y8I + ALPHA * __uint_as_float(hb.z << 16); v[g * 8 + 5] = v[g * 8 + 5] * Y8I + ALPHA * __uint_as_float(hb.z & 0xffff0000u);
        v[g * 8 + 6] = v[g * 8 + 6] * Y8I + ALPHA * __uint_as_float(hb.w << 16); v[g * 8 + 7] = v[g * 8 + 7] * Y8I + ALPHA * __uint_as_float(hb.w & 0xffff0000u); } }
    float s = 0.f;
#pragma unroll
    for (int j = 0; j < 32; ++j) s += v[j];
    const float mu = wave_sum(s) * (1.f / D); float q = 0.f;
#pragma unroll
    for (int j = 0; j < 32; ++j) { const float d = v[j] - mu; q += d * d; }
    const float rstd = rsqrtf(wave_sum(q) * (1.f / D) + 1e-5f);
    float* op = p.out + (size_t)row * D;
#pragma unroll
    for (int g = 0; g < 4; ++g) { const int c0 = g * 512 + lane * 8; f32x4 a, b;
#pragma unroll
      for (int j = 0; j < 4; ++j) { a[j] = (v[g * 8 + j] - mu) * rstd * p.ln2_g[c0 + j] + p.ln2_b[c0 + j]; b[j] = (v[g * 8 + 4 + j] - mu) * rstd * p.ln2_g[c0 + 4 + j] + p.ln2_b[c0 + 4 + j]; }
      *(f32x4*)(op + c0) = a; *(f32x4*)(op + c0 + 4) = b; }
  }
}

__global__ void __launch_bounds__(NT) k_mega(Params p_arg) {
#if defined(__HIP_DEVICE_COMPILE__)
  extern __shared__ __attribute__((aligned(16))) unsigned char lds_raw[];
  LAS unsigned char* lds = (LAS unsigned char*)lds_raw;
  float* smem = (float*)lds_raw;
#ifndef ONLY
#define ONLY -1
#endif
  typedef const __attribute__((address_space(4))) Params* KP;
  const KP pk = (KP)__builtin_amdgcn_kernarg_segment_ptr();
  volatile LAS unsigned* bst = (volatile LAS unsigned*)(lds + LDS_BYTES - 16);
  if (threadIdx.x == 0) { bst[0] = 0u; bst[1] = 0u; }
  __syncthreads();
  { KP q_ = pk; asm volatile("" : "+s"(q_)); (void)xcd_barrier_post(q_->bar, bst); }
#define GSYNC() do { KP qb_ = pk; asm volatile("" : "+s"(qb_)); XcdBarrier gb_; gb_.bar = qb_->bar; gb_.x = xb_xcc_id(); gb_.st = bst; xcd_barrier(gb_); } while (0)
#ifndef DUP
#define DUP -1
#endif
#define RUN1(n, pass, call) do { if (ONLY < 0 || ONLY == n) { KP q_ = pk; asm volatile("" : "+s"(q_)); const Params p = *q_; const int dup_pass = pass; (void)dup_pass; call; } } while (0)
#define RUN(n, call) do { RUN1(n, 0, call); if (DUP == n) { GSYNC(); RUN1(n, 1, call); } } while (0)
  RUN(0, ph_convert(p)); GSYNC();
  RUN(14, ph_convert_win(p)); GSYNC();
  RUN(1, ph_inproj(p, lds)); GSYNC();
  RUN(2, sd::ph_conv16(p)); GSYNC();
  RUN(3, ph_ssd_a(p, (char*)lds_raw, (char*)p.out)); RUN(4, ph_attn_mfma(p, (char*)lds_raw, p.meta + 8 + dup_pass)); GSYNC();
  RUN(5, ph_ssd_b(p, (char*)lds_raw, (const char*)p.out)); GSYNC();
  RUN(6, ph_outproj(p, lds)); GSYNC();
  RUN(7, ph_ln_route(p, (char*)lds_raw, lds)); GSYNC();
  RUN(10, ph_place(p, lds)); GSYNC();
  RUN(11, ph_gateup(p, lds)); GSYNC();
  RUN(12, ph_down(p, lds)); GSYNC();
  RUN(13, ph_combine(p));
#endif
}
}

extern "C" void kernel_launch(void* const* d_in, const int* in_sizes, int n_in, void* d_out, int out_size, void* d_ws, size_t ws_size, hipStream_t stream) {
  Params p{};
  const float* const* in = (const float* const*)d_in;
  p.x = in[0]; p.w_in = in[1]; p.conv_w = in[2]; p.conv_b = in[3]; p.dt_bias_f = in[4]; p.dt_bias_b = in[5]; p.a_log_f = in[6]; p.a_log_b = in[7];
  p.d_skip = in[8]; p.ssd_norm_w = in[9]; p.lq1 = in[10]; p.lk1 = in[11]; p.lq2 = in[12]; p.lk2 = in[13]; p.attn_norm_w = in[14]; p.w_out = in[15];
  p.ln1_g = in[16]; p.ln1_b = in[17]; p.w_router = in[18]; p.router_bias = in[19]; p.wg_e = in[20]; p.wu_e = in[21]; p.wd_e = in[22];
  p.wg_s = in[23]; p.wu_s = in[24]; p.wd_s = in[25]; p.ln2_g = in[26]; p.ln2_b = in[27];
  p.out = (float*)d_out;
  char* w = (char*)d_ws; size_t o = 0;
  auto take = [&](size_t bytes) { char* r = w + o; o += (bytes + 255) / 256 * 256; return r; };
  char* reg1 = w + o;
  p.xb = (bf16_t*)take((size_t)T * D * 2); p.xq = (signed char*)take((size_t)T * D); p.WinQ = (signed char*)take((size_t)NPROJ * D); p.WoutT = (bf16_t*)take((size_t)D * D * 2);
  p.WguT = (bf16_t*)take((size_t)(NE + 1) * 1024 * D); p.proj = (bf16_t*)take((size_t)T * PLD * 2); p.u = (bf16_t*)take((size_t)T * D * 2);
  if ((size_t)((w + o) - reg1) < (size_t)MAXROWS * D * 2) take((size_t)MAXROWS * D * 2 - (size_t)((w + o) - reg1));
  const size_t reg1_bytes = (size_t)((w + o) - reg1);
  p.Y = (bf16_t*)reg1;
  if ((size_t)MAXROWS * D * 2 > reg1_bytes) { fprintf(stderr, "kernel_launch: region 1 too small for Y\n"); return; }
  char* reg2 = take((size_t)MAXROWS * DE);
  p.H = (bf16_t*)reg2; p.xc16 = (bf16_t*)reg2;
  p.h1b = (bf16_t*)take((size_t)T * D * 2); p.WdT = (bf16_t*)take((size_t)(NE + 1) * D * DE); p.h1q = (unsigned char*)take((size_t)T * D);
  p.dt = (float*)take((size_t)T * 32 * 4); p.kn2 = (float*)take((size_t)NB * AH * 2 * (S / 64) * 4); p.WrT = (bf16_t*)take((size_t)NE * D * 2); p.gate = (float*)take((size_t)T * 8 * 4);
  p.assign = (int*)take((size_t)T * 8 * 4); p.pos = (int*)take((size_t)T * 8 * 4); p.blkcnt = (int*)take((size_t)(T / 64) * NE * 4);
  p.row_tok = (int*)take((size_t)MAXROWS * 4); p.row_gate = (float*)take((size_t)MAXROWS * 4); p.tile_exp = (int*)take((size_t)MAXTILES * 4);
  p.bar = (unsigned*)take((size_t)XCD_BAR_WORDS * 4 + 256 + (size_t)NPROJ * 4); p.meta = (int*)(p.bar + XCD_BAR_WORDS); p.colmax = (unsigned*)(p.meta + 64);
  p.sx = (float*)take((size_t)T * 4); p.sw = (float*)take((size_t)NPROJ * 4);
  p.h1 = (float*)d_out;
  if (o > ws_size) { fprintf(stderr, "kernel_launch: ws too small: need %zu have %zu\n", o, ws_size); return; }
  static int grid_blocks = 0;
  if (!grid_blocks) {
    int dev = 0, cus = 0, per_cu = 0;
    hipGetDevice(&dev);
    hipDeviceGetAttribute(&cus, hipDeviceAttributeMultiprocessorCount, dev);
    if (hipFuncSetAttribute((const void*)k_mega, hipFuncAttributeMaxDynamicSharedMemorySize, LDS_BYTES) != hipSuccess) { fprintf(stderr, "kernel_launch: hipFuncSetAttribute failed\n"); return; }
    hipOccupancyMaxActiveBlocksPerMultiprocessor(&per_cu, k_mega, NT, LDS_BYTES);
    if (per_cu < 1) { fprintf(stderr, "kernel_launch: occupancy query says 0 blocks/CU\n"); return; }
    grid_blocks = cus;
  }
  if (hipMemsetAsync(p.bar, 0, (size_t)XCD_BAR_WORDS * 4 + 256 + (size_t)NPROJ * 4, stream) != hipSuccess) { fprintf(stderr, "kernel_launch: memset failed\n"); return; }
  hipLaunchKernelGGL(k_mega, dim3(grid_blocks), dim3(NT), LDS_BYTES, stream, p);
  const hipError_t le = hipPeekAtLastError();
  if (le != hipSuccess) fprintf(stderr, "kernel_launch: launch failed: %s (grid %d)\n", hipGetErrorString(le), grid_blocks);
}
```

```cpp
#include <hip/hip_runtime.h>
#include <cstdio>
#include <cstdint>

namespace {
constexpr int D = 2048, NB = 8, S = 2048, T = NB * S;
constexpr int DSSD = 1024, DATT = 1024, NH = 16, HD = 64, NS = 128, CC = 1536;
constexpr int AH = 8, NE = 64, DE = 512, PW = 5664;
constexpr int O_DT = 2560, O_Q = 2592;
constexpr int N_Z = 0, N_XBC = 1024, N_Q = 2560, N_K = 3584, N_V = 4608, PLD = 5632, NPROJ = 5888;
constexpr float ALPHA = 1.189207115002721f;
constexpr float LAMBDA_INIT = 0.2f;
constexpr float LOG2E = 1.4426950408889634f;
constexpr float QS = 0.125f * LOG2E;
constexpr float W8S = 32.f, H8S = 8.f, Y8S = 32.f, Y8I = 1.f / 32.f;
constexpr int NT = 512;
constexpr int LDS_BYTES = 152 * 1024;
constexpr int LDS_TAB = 128 * 1024;
constexpr int MAXROWS_R = NE * 256 + T * 8;
constexpr int MAXROWS = MAXROWS_R + T;
constexpr int MAXTILES = MAXROWS / 256;

typedef unsigned short bf16_t;
#define LAS __attribute__((address_space(3)))

struct Params {
  const float *x, *w_in, *conv_w, *conv_b, *dt_bias_f, *dt_bias_b, *a_log_f, *a_log_b, *d_skip, *ssd_norm_w;
  const float *lq1, *lk1, *lq2, *lk2, *attn_norm_w, *w_out, *ln1_g, *ln1_b, *w_router, *router_bias;
  const float *wg_e, *wu_e, *wd_e, *wg_s, *wu_s, *wd_s, *ln2_g, *ln2_b;
  float* out;
  bf16_t *xb, *WoutT, *WguT, *WdT, *proj, *u, *h1b, *H, *Y, *xc16, *WrT;
  float *dt, *h1, *gate, *row_gate, *kn2;
  int *assign, *blkcnt, *row_tok, *pos, *tile_exp, *meta;
  unsigned* bar;
  unsigned char* h1q;
  signed char *xq, *WinQ; float *sx, *sw; unsigned* colmax;
};

__device__ __forceinline__ int tid_fresh() { int t = threadIdx.x; asm volatile("" : "+v"(t)); return t; }
__device__ __forceinline__ float silu_f(float x) { return x / (1.f + __expf(-x)); }
__device__ __forceinline__ float softplus_f(float x) { return x > 20.f ? x : __logf(1.f + __expf(x)); }
__device__ __forceinline__ float wave_sum(float v) { for (int o = 32; o >= 1; o >>= 1) v += __shfl_xor(v, o); return v; }
__device__ __forceinline__ float bf2f(bf16_t b) { return __uint_as_float(((unsigned)b) << 16); }
__device__ __forceinline__ bf16_t f2bf(float f) { unsigned u = __float_as_uint(f); u += 0x7FFFu + ((u >> 16) & 1u); return (bf16_t)(u >> 16); }
}

namespace pg8 {
#define PG8_LAS __attribute__((address_space(3)))
typedef unsigned short bf16_t;
typedef short bf16x8 __attribute__((ext_vector_type(8)));
typedef float f32x4 __attribute__((ext_vector_type(4)));
typedef unsigned u32x4 __attribute__((ext_vector_type(4)));
typedef int v8i __attribute__((ext_vector_type(8)));
typedef int v4i __attribute__((ext_vector_type(4)));
constexpr int BM = 256, BK = 64, HALF = 128, HTB = HALF * BK * 2  , STAGE_BYTES = 8 * HTB, NXCD = 8, WGM = 8;

__host__ __device__ __forceinline__ int lds_byte(int r, int c) { const int st = (r >> 4) * 2 + (c >> 5), rr = r & 15, cc = c & 31, ob = rr * 64 + cc * 2; return st * 1024 + (ob ^ (((ob >> 9) & 1) << 5)); }
__host__ __device__ __forceinline__ void stage_rc(int b, int& R, int& C) { const int st = b / 1024, sb = b % 1024, swz = sb ^ (((sb >> 9) & 1) << 5); R = (st >> 1) * 16 + swz / 64; C = (st & 1) * 32 + (swz % 64) / 2; }
__host__ __device__ __forceinline__ int perm32(int rho) { const int n = rho >> 4, i = rho & 15; return 8 * (i >> 2) + 4 * n + (i & 3); }

struct Unit { int pm, pn, bn, aux; };
struct Gemm { const bf16_t* A; const bf16_t* Bt; int K; int sc_w, sc_a; };


__device__ __forceinline__ unsigned cvt_pk_bf16(float lo, float hi) { unsigned r; asm volatile("v_cvt_pk_bf16_f32 %0, %1, %2" : "=v"(r) : "v"(lo), "v"(hi)); return r; }
struct OrderStatic {
    int nM, nN, nwg, G, c;
    __device__ void init(int M, int N, int G_, int c_) { nM = M / BM; nN = N / BM; nwg = nM * nN; G = G_; c = c_; }
    __device__ bool next(int i, Unit& u) const {
        const long L = (long)i * G + c; if (L >= nwg) return false;
        int wgid = (int)L; { const int q = nwg / NXCD, r = nwg % NXCD, xcd = wgid % NXCD, off = wgid / NXCD; wgid = (xcd < r ? xcd * (q + 1) : r * (q + 1) + (xcd - r) * q) + off; }
        const int nig = WGM * nN, gid = wgid / nig, fm = gid * WGM, gsz = (nM - fm) < WGM ? (nM - fm) : WGM;
        u.pm = fm + ((wgid % nig) % gsz); u.pn = (wgid % nig) / gsz; u.bn = u.pn; u.aux = i; return true;
    }
    __device__ __forceinline__ unsigned row_off(int, int) const { return 0u; }
};
template <bool GATHER, bool FP8, class Epi, class Sched, bool I8 = false>
__device__ __forceinline__ void gemm_phase(PG8_LAS unsigned char* lds, const Gemm g, const Sched& S, const Epi& E) {
    int tid = threadIdx.x; asm volatile("" : "+v"(tid));
    const int wid = __builtin_amdgcn_readfirstlane(tid >> 6), lane = tid & 63, wr = wid >> 2, wc = wid & 3, fr = lane & 15, fq = lane >> 4;
    const int K = g.K; int nt = K / BK; asm volatile("" : "+s"(nt));
#define PG8_STAMP() do {} while (0)
    PG8_STAMP();
    unsigned voffA[2], voffB[2];
#pragma unroll
    for (int i = 0; i < 2; ++i) { int R, C; stage_rc(tid * 16 + i * 8192, R, C); const int Rb = Epi::PERM ? ((R & ~31) + perm32(R & 31)) : R;
        voffA[i] = (unsigned)(R * K + C) * 2u; voffB[i] = (unsigned)(Rb * K + C) * 2u; }
    unsigned voffG[2][2] = {{0u, 0u}, {0u, 0u}};
#define PG8_LOADG(uidx) do { if constexpr (GATHER) { _Pragma("unroll") for (int _h = 0; _h < 2; ++_h) _Pragma("unroll") for (int _i = 0; _i < 2; ++_i) { int R_, C_; stage_rc(tid * 16 + _i * 8192, R_, C_); \
        voffG[_h][_i] = S.row_off((uidx), _h * HALF + R_) + (unsigned)C_ * 2u; } } } while (0)
    const size_t kstep = (size_t)(BK * 2);
    const size_t hstep = (size_t)HALF * K * 2;
    const size_t tstep = 2 * hstep;
    const unsigned ldsw = (unsigned)wid * 1024u;
    const int aoff = lds_byte(wr * 64 + fr, fq * 8), boff = lds_byte(wc * 32 + fr, fq * 8);
    const int c8 = (fq >> 1) * 32 + (fq & 1) * 16;
    const int aoff8a = lds_byte(wr * 64 + fr, c8), aoff8b = lds_byte(wr * 64 + fr, c8 + 8), boff8a = lds_byte(wc * 32 + fr, c8), boff8b = lds_byte(wc * 32 + fr, c8 + 8);
#define PG8_SA(b, h) (((b) * 2 + (h)) * HTB)
#define PG8_SB(b, h) ((4 + (b) * 2 + (h)) * HTB)
#define PG8_STAGE(bufoff, gbase, voff) do { _Pragma("unroll") for (int _i = 0; _i < 2; ++_i) \
        __builtin_amdgcn_global_load_lds((const unsigned*)((const char*)(gbase) + (voff)[_i]), (PG8_LAS unsigned*)(lds + (bufoff) + ldsw + _i * 8192), 16, 0, 0); } while (0)
#define PG8_STAGE_A(bufoff, ptr, h) do { if constexpr (GATHER) { PG8_STAGE(bufoff, ptr, voffG[h]); } else { PG8_STAGE(bufoff, (ptr) + (h) * hstep, voffA); } } while (0)
#define PG8_LDA(dst, b, h) do { if constexpr (FP8) { _Pragma("unroll") for (int m = 0; m < 4; ++m) { const u32x4 lo_ = *(const PG8_LAS u32x4*)(lds + PG8_SA(b, h) + aoff8a + m * 2048), hi_ = *(const PG8_LAS u32x4*)(lds + PG8_SA(b, h) + aoff8b + m * 2048); \
        dst##8[m] = (v8i){(int)lo_.x, (int)lo_.y, (int)lo_.z, (int)lo_.w, (int)hi_.x, (int)hi_.y, (int)hi_.z, (int)hi_.w}; } } else { \
        _Pragma("unroll") for (int m = 0; m < 4; ++m) _Pragma("unroll") for (int k = 0; k < 2; ++k) dst[m][k] = *(const PG8_LAS bf16x8*)(lds + PG8_SA(b, h) + aoff + m * 2048 + k * 1024); } } while (0)
#define PG8_LDB(dst, b, h) do { if constexpr (FP8) { _Pragma("unroll") for (int n = 0; n < 2; ++n) { const u32x4 lo_ = *(const PG8_LAS u32x4*)(lds + PG8_SB(b, h) + boff8a + n * 2048), hi_ = *(const PG8_LAS u32x4*)(lds + PG8_SB(b, h) + boff8b + n * 2048); \
        dst##8[n] = (v8i){(int)lo_.x, (int)lo_.y, (int)lo_.z, (int)lo_.w, (int)hi_.x, (int)hi_.y, (int)hi_.z, (int)hi_.w}; } } else { \
        _Pragma("unroll") for (int n = 0; n < 2; ++n) _Pragma("unroll") for (int k = 0; k < 2; ++k) dst[n][k] = *(const PG8_LAS bf16x8*)(lds + PG8_SB(b, h) + boff + n * 2048 + k * 1024); } } while (0)
#define PG8_MMA(ai, bj, At, Bt) do { __builtin_amdgcn_s_setprio(1); if constexpr (FP8) { _Pragma("unroll") for (int m = 0; m < 4; ++m) _Pragma("unroll") for (int n = 0; n < 2; ++n) \
        acc[ai][bj][m][n] = __builtin_amdgcn_mfma_scale_f32_16x16x128_f8f6f4(Bt##8[n], At##8[m], acc[ai][bj][m][n], 0, 0, 0, g.sc_w, 0, g.sc_a); } else { \
        _Pragma("unroll") for (int m = 0; m < 4; ++m) _Pragma("unroll") for (int n = 0; n < 2; ++n) _Pragma("unroll") for (int k = 0; k < 2; ++k) { \
        if constexpr (I8) acc[ai][bj][m][n] = __builtin_bit_cast(f32x4, __builtin_amdgcn_mfma_i32_16x16x64_i8(__builtin_bit_cast(v4i, Bt[n][k]), __builtin_bit_cast(v4i, At[m][k]), __builtin_bit_cast(v4i, acc[ai][bj][m][n]), 0, 0, 0)); \
        else acc[ai][bj][m][n] = __builtin_amdgcn_mfma_f32_16x16x32_bf16(Bt[n][k], At[m][k], acc[ai][bj][m][n], 0, 0, 0); } } __builtin_amdgcn_s_setprio(0); } while (0)
#define PG8_WAIT_V(n) asm volatile("s_waitcnt vmcnt(" #n ")" ::: "memory")
#define PG8_WAIT_L(n) asm volatile("s_waitcnt lgkmcnt(" #n ")" ::: "memory")
#define PG8_BAR __builtin_amdgcn_s_barrier()
#define PG8_SCHED __builtin_amdgcn_sched_barrier(0)
    Unit cur, nxt; int ui = 0;
    if (!S.next(0, cur)) return;
    f32x4 acc[2][2][4][2];
#pragma unroll
    for (int a = 0; a < 2; ++a)
#pragma unroll
        for (int b = 0; b < 2; ++b)
#pragma unroll
            for (int m = 0; m < 4; ++m)
#pragma unroll
                for (int n = 0; n < 2; ++n) acc[a][b][m][n] = (f32x4){0.f, 0.f, 0.f, 0.f};
    bf16x8 At[4][2], B0[2][2], B1[2][2]; v8i At8[4], B08[2], B18[2];
    const char* cA = GATHER ? (const char*)g.A : (const char*)g.A + (size_t)cur.pm * tstep; const char* cB = (const char*)g.Bt + (size_t)cur.bn * tstep;
    PG8_LOADG(0);
    PG8_STAGE(PG8_SB(0, 0), cB, voffB); PG8_STAGE_A(PG8_SA(0, 0), cA, 0); PG8_STAGE(PG8_SB(0, 1), cB + hstep, voffB); PG8_STAGE_A(PG8_SA(0, 1), cA, 1);
    if (wr == 1) PG8_BAR;
    PG8_WAIT_V(4); PG8_BAR;
    PG8_STAGE(PG8_SB(1, 0), cB + kstep, voffB); PG8_STAGE_A(PG8_SA(1, 0), cA + kstep, 0); PG8_STAGE(PG8_SB(1, 1), cB + hstep + kstep, voffB);
    PG8_WAIT_V(6); PG8_BAR;
    PG8_STAMP();
    for (;;) {
        const bool has_next = S.next(ui + 1, nxt);
        const char* nA = has_next ? (GATHER ? (const char*)g.A : (const char*)g.A + (size_t)nxt.pm * tstep) : cA; const char* nB = has_next ? (const char*)g.Bt + (size_t)nxt.bn * tstep : cB;
#pragma unroll 1
        for (int t = 0; t < nt; t += 2) {
            const bool last = (t == nt - 2);
            const char* a1 = cA + (size_t)(t + 1) * kstep;
            const char* a2 = last ? nA : cA + (size_t)(t + 2) * kstep; const char* b2 = last ? nB : cB + (size_t)(t + 2) * kstep;
            const char* a3 = a2 + kstep; const char* b3 = b2 + kstep;
            PG8_LDB(B0, 0, 0); PG8_SCHED; PG8_LDA(At, 0, 0); PG8_STAGE_A(PG8_SA(1, 1), a1, 1);
            PG8_WAIT_L(8); PG8_BAR; PG8_WAIT_L(0); PG8_MMA(0, 0, At, B0); PG8_BAR; PG8_SCHED;
            if (last && has_next) PG8_LOADG(ui + 1);
            PG8_LDB(B1, 0, 1); PG8_STAGE(PG8_SB(0, 0), b2, voffB);
            PG8_BAR; PG8_WAIT_L(0); PG8_MMA(0, 1, At, B1); PG8_BAR;
            PG8_LDA(At, 0, 1); PG8_STAGE_A(PG8_SA(0, 0), a2, 0);
            PG8_BAR; PG8_WAIT_L(0); PG8_MMA(1, 0, At, B0); PG8_BAR; PG8_SCHED;
            PG8_STAGE(PG8_SB(0, 1), b2 + hstep, voffB);
            PG8_WAIT_V(6); PG8_BAR; PG8_MMA(1, 1, At, B1); PG8_BAR;
            PG8_LDB(B0, 1, 0); PG8_SCHED; PG8_LDA(At, 1, 0); PG8_STAGE_A(PG8_SA(0, 1), a2, 1);
            PG8_WAIT_L(8); PG8_BAR; PG8_WAIT_L(0); PG8_MMA(0, 0, At, B0); PG8_BAR; PG8_SCHED;
            PG8_LDB(B1, 1, 1); PG8_STAGE(PG8_SB(1, 0), b3, voffB);
            PG8_BAR; PG8_WAIT_L(0); PG8_MMA(0, 1, At, B1); PG8_BAR;
            PG8_LDA(At, 1, 1); PG8_STAGE_A(PG8_SA(1, 0), a3, 0);
            PG8_BAR; PG8_WAIT_L(0); PG8_MMA(1, 0, At, B0); PG8_BAR; PG8_SCHED;
            PG8_STAGE(PG8_SB(1, 1), b3 + hstep, voffB);
            PG8_WAIT_V(6); PG8_BAR; PG8_MMA(1, 1, At, B1); PG8_BAR;
        }
        PG8_STAMP();
        E(acc, cur, wr, wc, fr, fq);
#ifdef PROBE_EPI2
        if constexpr (GATHER) { asm volatile("" ::: "memory"); E(acc, cur, wr, wc, fr, fq); }
#endif
        PG8_STAMP();
        if (!has_next) break;
#pragma unroll
        for (int a = 0; a < 2; ++a)
#pragma unroll
            for (int b = 0; b < 2; ++b)
#pragma unroll
                for (int m = 0; m < 4; ++m)
#pragma unroll
                    for (int n = 0; n < 2; ++n) acc[a][b][m][n] = (f32x4){0.f, 0.f, 0.f, 0.f};
        cur = nxt; cA = nA; cB = nB; ++ui;
    }
    PG8_WAIT_V(0);
    if (wr == 0) PG8_BAR;
    PG8_BAR;
    PG8_STAMP();
#undef PG8_STAMP
#undef PG8_SA
#undef PG8_SB
#undef PG8_STAGE
#undef PG8_STAGE_A
#undef PG8_LOADG
#undef PG8_LDA
#undef PG8_LDB
#undef PG8_MMA
#undef PG8_WAIT_V
#undef PG8_WAIT_L
#undef PG8_BAR
#undef PG8_SCHED
}
}
namespace {
#define XB_TMO      128
#define XB_XCNT(j)  (256  + 64 * (j))
#define XB_XSUB(j)  (1280 + 64 * (j))
#define XB_XGEN(j)  (2304 + 64 * (j))
#define XB_TOP      3328
#define XB_TOPGEN   3392
#define XCD_BAR_WORDS 3456
#define XB_SPIN_CAP (1u << 18)

__device__ __forceinline__ unsigned xb_ld(unsigned* p)              { return __hip_atomic_load(p, __ATOMIC_RELAXED, __HIP_MEMORY_SCOPE_AGENT); }
__device__ __forceinline__ unsigned xb_add(unsigned* p, unsigned v) { return __hip_atomic_fetch_add(p, v, __ATOMIC_RELAXED, __HIP_MEMORY_SCOPE_AGENT); }
__device__ __forceinline__ unsigned xb_xcc_id() { return (unsigned)__builtin_amdgcn_s_getreg((3 << 11) | 20) & 0xFu; }
#define XB_SPIN(cond, bar) do { unsigned _sp = 0; while (cond) { __builtin_amdgcn_s_sleep(1); \
    if ((++_sp & 255u) == 0u) { if (xb_ld(&(bar)[XB_TMO])) break; if (_sp > XB_SPIN_CAP) { atomicAdd(&(bar)[XB_TMO], 1u); break; } } } } while (0)

struct XcdBarrier {
    unsigned* bar; unsigned x;
    volatile LAS unsigned* st;
};

__device__ __forceinline__ XcdBarrier xcd_barrier_post(unsigned* bar, volatile LAS unsigned* st) {
    XcdBarrier b; b.bar = bar; b.x = xb_xcc_id(); b.st = st;
    if (threadIdx.x == 0) (void)xb_add(&bar[XB_XCNT(b.x)], 1u);
    return b;
}
__device__ __forceinline__ void xcd_barrier_complete(unsigned* bar, unsigned x, unsigned& nloc, unsigned& nx) {
    const unsigned G = gridDim.x * gridDim.y * gridDim.z;
    unsigned sum, cnt, mine, sp = 0u;
    for (;;) {
        sum = 0u; cnt = 0u; mine = 0u;
#pragma unroll
        for (unsigned j = 0; j < 16; ++j) { const unsigned c = xb_ld(&bar[XB_XCNT(j)]); sum += c; cnt += (c > 0u) ? 1u : 0u; mine = (j == x) ? c : mine; }
        if (sum == G) break;
        __builtin_amdgcn_s_sleep(1);
        if ((++sp & 255u) == 0u) { if (xb_ld(&bar[XB_TMO])) break; if (sp > XB_SPIN_CAP) { atomicAdd(&bar[XB_TMO], 1u); break; } }
    }
    nloc = mine > 0u ? mine : 1u; nx = cnt > 0u ? cnt : 1u;
}

__device__ __forceinline__ void xcd_barrier(const XcdBarrier& b) {
    asm volatile("s_waitcnt vmcnt(0)" ::: "memory");
    __syncthreads();
    if (threadIdx.x == 0) {
        unsigned* bar = b.bar;
        __builtin_amdgcn_s_waitcnt(0);
        unsigned nloc = b.st[0], nx = b.st[1];
        if (nloc == 0u) { xcd_barrier_complete(bar, b.x, nloc, nx); b.st[0] = nloc; b.st[1] = nx; }
        const unsigned old = xb_add(&bar[XB_XSUB(b.x)], 1u);
        const unsigned gen = old / nloc;
        if (old + 1u == (gen + 1u) * nloc) {
            __builtin_amdgcn_fence(__ATOMIC_RELEASE, "agent");
            asm volatile("s_waitcnt vmcnt(0)" ::: "memory");
            const unsigned og = xb_add(&bar[XB_TOP], 1u);
            const unsigned tg = og / nx;
            if (og + 1u == (tg + 1u) * nx) xb_add(&bar[XB_TOPGEN], 1u);
            else XB_SPIN(xb_ld(&bar[XB_TOPGEN]) == tg, bar);
            __builtin_amdgcn_fence(__ATOMIC_ACQUIRE, "agent");
            xb_add(&bar[XB_XGEN(b.x)], 1u);
            asm volatile("s_waitcnt vmcnt(0)" ::: "memory");
        } else {
            XB_SPIN(xb_ld(&bar[XB_XGEN(b.x)]) == gen, bar);
            __builtin_amdgcn_fence(__ATOMIC_ACQUIRE, "agent");
            asm volatile("s_waitcnt vmcnt(0)" ::: "memory");
        }
    }
    __syncthreads();
}

}
namespace {
using pg8::f32x4; using pg8::u32x4; using pg8::cvt_pk_bf16;

template <class ARow, class Epi>
__device__ __forceinline__ void gemm_tile(float* smem, int mvalid, int nvalid, int K, ARow arow, const float* Bp, int ldb, Epi epi) {
  float* As = smem;
  float* Bs = smem + 16 * 68;
  const int tid = threadIdx.x, ty = tid >> 5, tx = tid & 31;
  float acc[4][4];
#pragma unroll
  for (int i = 0; i < 4; ++i)
#pragma unroll
    for (int j = 0; j < 4; ++j) acc[i][j] = 0.f;
  const int ak = tid & 15, ar = tid >> 4;
  const float* ap0 = (ar < mvalid) ? arow(ar) : nullptr;
  const float* ap1 = (ar + 32 < mvalid) ? arow(ar + 32) : nullptr;
  const int bn = tid & 127, bk = tid >> 7;
  for (int k0 = 0; k0 < K; k0 += 16) {
    As[ak * 68 + ar] = ap0 ? ap0[k0 + ak] : 0.f;
    As[ak * 68 + ar + 32] = ap1 ? ap1[k0 + ak] : 0.f;
#pragma unroll
    for (int i = 0; i < 4; ++i) { const int kk = bk + 4 * i; Bs[kk * 128 + bn] = (bn < nvalid) ? Bp[(size_t)(k0 + kk) * ldb + bn] : 0.f; }
    __syncthreads();
#pragma unroll
    for (int kk = 0; kk < 16; ++kk) {
      float a[4], b[4];
#pragma unroll
      for (int i = 0; i < 4; ++i) a[i] = As[kk * 68 + ty * 4 + i];
#pragma unroll
      for (int j = 0; j < 4; ++j) b[j] = Bs[kk * 128 + tx * 4 + j];
#pragma unroll
      for (int i = 0; i < 4; ++i)
#pragma unroll
        for (int j = 0; j < 4; ++j) acc[i][j] += a[i] * b[j];
    }
    __syncthreads();
  }
#pragma unroll
  for (int i = 0; i < 4; ++i)
#pragma unroll
    for (int j = 0; j < 4; ++j) { const int r = ty * 4 + i, c = tx * 4 + j; if (r < mvalid && c < nvalid) epi(r, c, acc[i][j]); }
}

template <class RowMap>
__device__ __forceinline__ void cvt_tile(const float* __restrict__ src, int N, int K, int k0, int n0, bf16_t* __restrict__ dst, RowMap rm) {
  const int lane = threadIdx.x & 63, w = threadIdx.x >> 6;
  const int n = n0 + (lane & 15) * 4, kk = k0 + (w * 4 + (lane >> 4)) * 8;
  if (n >= N) return;
  float4 v[8];
#pragma unroll
  for (int j = 0; j < 8; ++j) v[j] = *(const float4*)(src + (size_t)(kk + j) * N + n);
  u32x4 o;
  o.x = cvt_pk_bf16(v[0].x, v[1].x); o.y = cvt_pk_bf16(v[2].x, v[3].x); o.z = cvt_pk_bf16(v[4].x, v[5].x); o.w = cvt_pk_bf16(v[6].x, v[7].x);
  *(u32x4*)(dst + (size_t)rm(n + 0) * K + kk) = o;
  o.x = cvt_pk_bf16(v[0].y, v[1].y); o.y = cvt_pk_bf16(v[2].y, v[3].y); o.z = cvt_pk_bf16(v[4].y, v[5].y); o.w = cvt_pk_bf16(v[6].y, v[7].y);
  *(u32x4*)(dst + (size_t)rm(n + 1) * K + kk) = o;
  o.x = cvt_pk_bf16(v[0].z, v[1].z); o.y = cvt_pk_bf16(v[2].z, v[3].z); o.z = cvt_pk_bf16(v[4].z, v[5].z); o.w = cvt_pk_bf16(v[6].z, v[7].z);
  *(u32x4*)(dst + (size_t)rm(n + 2) * K + kk) = o;
  o.x = cvt_pk_bf16(v[0].w, v[1].w); o.y = cvt_pk_bf16(v[2].w, v[3].w); o.z = cvt_pk_bf16(v[4].w, v[5].w); o.w = cvt_pk_bf16(v[6].w, v[7].w);
  *(u32x4*)(dst + (size_t)rm(n + 3) * K + kk) = o;
}
template <class RowMap>
__device__ __forceinline__ void cvt_job(const float* src, int nmat, int K, int N, bf16_t* dst, size_t dstride, RowMap rm) {
  const int kt = K / 256, ntl = (N + 63) / 64, per = kt * ntl;
  for (int it = blockIdx.x; it < nmat * per; it += gridDim.x) {
    const int m = it / per, r = it % per, k0 = (r / ntl) * 256, n0 = (r % ntl) * 64;
    cvt_tile(src + (size_t)m * K * N, N, K, k0, n0, dst + (size_t)m * dstride, rm);
  }
}
__device__ __forceinline__ unsigned pack4_i8(float a, float b, float c, float d, float inv) {
  const int q0 = __float2int_rn(a * inv), q1 = __float2int_rn(b * inv), q2 = __float2int_rn(c * inv), q3 = __float2int_rn(d * inv);
  return (unsigned)(q0 & 255) | ((unsigned)(q1 & 255) << 8) | ((unsigned)(q2 & 255) << 16) | ((unsigned)(q3 & 255) << 24);
}
__device__ __forceinline__ int win_row(int n) { return n < O_DT ? n : (n < O_Q ? PLD + (n - O_DT) : n - 32); }
__device__ __forceinline__ void ph_convert(const Params& p) {
  const int tidf = tid_fresh(), lane = tidf & 63, wv = tidf >> 6;
  for (int row = blockIdx.x * 8 + wv; row < T; row += gridDim.x * 8) {
    const float* xp = p.x + (size_t)row * D; f32x4 a[4], b[4]; float am = 0.f;
#pragma unroll
    for (int g = 0; g < 4; ++g) { a[g] = __builtin_nontemporal_load((const f32x4*)(xp + g * 512 + lane * 8)); b[g] = __builtin_nontemporal_load((const f32x4*)(xp + g * 512 + lane * 8 + 4));
#pragma unroll
      for (int j = 0; j < 4; ++j) am = fmaxf(am, fmaxf(fabsf(a[g][j]), fabsf(b[g][j]))); }
    for (int o = 32; o >= 1; o >>= 1) am = fmaxf(am, __shfl_xor(am, o));
    const float inv = am > 0.f ? 127.f / am : 0.f;
    if (lane == 0) p.sx[row] = am * (1.f / 127.f);
#pragma unroll
    for (int g = 0; g < 4; ++g) {
      *(uint2*)(p.xq + (size_t)row * D + g * 512 + lane * 8) = make_uint2(pack4_i8(a[g][0], a[g][1], a[g][2], a[g][3], inv), pack4_i8(b[g][0], b[g][1], b[g][2], b[g][3], inv)); }
  }
  { constexpr int NTL = (PW + 63) / 64;
    for (int it = blockIdx.x; it < (D / 256) * NTL; it += gridDim.x) {
      const int k0 = (it / NTL) * 256, n = (it % NTL) * 64 + (lane & 15) * 4, kk = k0 + (wv * 4 + (lane >> 4)) * 8;
      float m4[4] = {0.f, 0.f, 0.f, 0.f};
      if (n < PW) {
#pragma unroll
        for (int j = 0; j < 8; ++j) { const float4 v = *(const float4*)(p.w_in + (size_t)(kk + j) * PW + n); m4[0] = fmaxf(m4[0], fabsf(v.x)); m4[1] = fmaxf(m4[1], fabsf(v.y)); m4[2] = fmaxf(m4[2], fabsf(v.z)); m4[3] = fmaxf(m4[3], fabsf(v.w)); } }
#pragma unroll
      for (int c = 0; c < 4; ++c) { m4[c] = fmaxf(m4[c], __shfl_xor(m4[c], 16)); m4[c] = fmaxf(m4[c], __shfl_xor(m4[c], 32)); }
      if (lane < 16 && n < PW) {
#pragma unroll
        for (int c = 0; c < 4; ++c) atomicMax(p.colmax + n + c, __float_as_uint(m4[c])); }
    } }
  cvt_job(p.w_out, 1, D, D, p.WoutT, 0, [](int n) { return n; });
  cvt_job(p.w_router, 1, D, NE, p.WrT, 0, [](int n) { return n; });
}
__device__ __forceinline__ void ph_convert_win(const Params& p) {
  const int tidf = tid_fresh(), lane = tidf & 63, wv = tidf >> 6;
  constexpr int NTL = (PW + 63) / 64;
  for (int it = blockIdx.x; it < (D / 512) * NTL; it += gridDim.x) {
    const int k0 = (it / NTL) * 512, n = (it % NTL) * 64 + (lane & 15) * 4, kk = k0 + (wv * 4 + (lane >> 4)) * 16;
    if (n >= PW) continue;
    float4 v[16];
#pragma unroll
    for (int j = 0; j < 16; ++j) v[j] = *(const float4*)(p.w_in + (size_t)(kk + j) * PW + n);
    float cm[4], inv[4];
#pragma unroll
    for (int c = 0; c < 4; ++c) { cm[c] = __uint_as_float(__hip_atomic_load(p.colmax + n + c, __ATOMIC_RELAXED, __HIP_MEMORY_SCOPE_AGENT)); inv[c] = cm[c] > 0.f ? 127.f / cm[c] : 0.f; }
    u32x4 o;
    o.x = pack4_i8(v[0].x, v[1].x, v[2].x, v[3].x, inv[0]); o.y = pack4_i8(v[4].x, v[5].x, v[6].x, v[7].x, inv[0]); o.z = pack4_i8(v[8].x, v[9].x, v[10].x, v[11].x, inv[0]); o.w = pack4_i8(v[12].x, v[13].x, v[14].x, v[15].x, inv[0]);
    *(u32x4*)(p.WinQ + (size_t)win_row(n + 0) * D + kk) = o;
    o.x = pack4_i8(v[0].y, v[1].y, v[2].y, v[3].y, inv[1]); o.y = pack4_i8(v[4].y, v[5].y, v[6].y, v[7].y, inv[1]); o.z = pack4_i8(v[8].y, v[9].y, v[10].y, v[11].y, inv[1]); o.w = pack4_i8(v[12].y, v[13].y, v[14].y, v[15].y, inv[1]);
    *(u32x4*)(p.WinQ + (size_t)win_row(n + 1) * D + kk) = o;
    o.x = pack4_i8(v[0].z, v[1].z, v[2].z, v[3].z, inv[2]); o.y = pack4_i8(v[4].z, v[5].z, v[6].z, v[7].z, inv[2]); o.z = pack4_i8(v[8].z, v[9].z, v[10].z, v[11].z, inv[2]); o.w = pack4_i8(v[12].z, v[13].z, v[14].z, v[15].z, inv[2]);
    *(u32x4*)(p.WinQ + (size_t)win_row(n + 2) * D + kk) = o;
    o.x = pack4_i8(v[0].w, v[1].w, v[2].w, v[3].w, inv[3]); o.y = pack4_i8(v[4].w, v[5].w, v[6].w, v[7].w, inv[3]); o.z = pack4_i8(v[8].w, v[9].w, v[10].w, v[11].w, inv[3]); o.w = pack4_i8(v[12].w, v[13].w, v[14].w, v[15].w, inv[3]);
    *(u32x4*)(p.WinQ + (size_t)win_row(n + 3) * D + kk) = o;
    if (kk == 0) {
#pragma unroll
      for (int c = 0; c < 4; ++c) p.sw[win_row(n + c)] = cm[c] * (1.f / 127.f); }
  }
  const size_t gtid = (size_t)blockIdx.x * NT + tidf, gsz = (size_t)gridDim.x * NT;
  for (size_t i = gtid; i < (size_t)(NPROJ - PW) * D / 16; i += gsz) *(u32x4*)(p.WinQ + (size_t)PW * D + i * 16) = (u32x4){0u, 0u, 0u, 0u};
  if (gtid < (size_t)(NPROJ - PW)) p.sw[PW + gtid] = 0.f;
}
__device__ __forceinline__ unsigned pk4_fp8(float a, float b, float c, float d) { const float a2 = a * W8S; int w = __float_as_int(a2); w = __builtin_amdgcn_cvt_pk_fp8_f32(a2, b * W8S, w, false); w = __builtin_amdgcn_cvt_pk_fp8_f32(c * W8S, d * W8S, w, true); return (unsigned)w; }
#ifndef CVT_LN_GU
#define CVT_LN_GU 8
#endif
template <int LN, class RowMap>
__device__ __forceinline__ void cvt_range8(const float* __restrict__ src, int K, int N, unsigned char* __restrict__ dst, size_t dstride, RowMap rm, int it0, int it1) {
  constexpr int NTF = 3;
  constexpr int TK = 8 * (64 / LN) * 16, TN = LN * 4;
  const int kt = K / TK, ntl = N / TN, per = kt * ntl;
  int tid = threadIdx.x; asm volatile("" : "+v"(tid));
  const int lane = tid & 63, w = tid >> 6, nl = (lane % LN) * 4, kl = (w * (64 / LN) + lane / LN) * 16;
  for (int it = it0; it < it1; it += NTF) {
    float4 v[NTF][16];
#pragma unroll
    for (int q = 0; q < NTF; ++q) if (it + q < it1) { const int m = (it + q) / per, r = (it + q) % per, kk = (r / ntl) * TK + kl, n = (r % ntl) * TN + nl;
      const float* sp = src + (size_t)m * K * N + (size_t)kk * N + n;
#pragma unroll
      for (int j = 0; j < 16; ++j) { const f32x4 t_ = __builtin_nontemporal_load((const f32x4*)(sp + (size_t)j * N)); v[q][j] = make_float4(t_[0], t_[1], t_[2], t_[3]); } }
#pragma unroll
    for (int q = 0; q < NTF; ++q) if (it + q < it1) { const int m = (it + q) / per, r = (it + q) % per, kk = (r / ntl) * TK + kl, n = (r % ntl) * TN + nl;
      unsigned char* dp = dst + (size_t)m * dstride + kk; u32x4 o;
      o.x = pk4_fp8(v[q][0].x, v[q][1].x, v[q][2].x, v[q][3].x); o.y = pk4_fp8(v[q][4].x, v[q][5].x, v[q][6].x, v[q][7].x); o.z = pk4_fp8(v[q][8].x, v[q][9].x, v[q][10].x, v[q][11].x); o.w = pk4_fp8(v[q][12].x, v[q][13].x, v[q][14].x, v[q][15].x);
      __builtin_nontemporal_store(o, (u32x4*)(dp + (size_t)rm(n + 0) * K));
      o.x = pk4_fp8(v[q][0].y, v[q][1].y, v[q][2].y, v[q][3].y); o.y = pk4_fp8(v[q][4].y, v[q][5].y, v[q][6].y, v[q][7].y); o.z = pk4_fp8(v[q][8].y, v[q][9].y, v[q][10].y, v[q][11].y); o.w = pk4_fp8(v[q][12].y, v[q][13].y, v[q][14].y, v[q][15].y);
      __builtin_nontemporal_store(o, (u32x4*)(dp + (size_t)rm(n + 1) * K));
      o.x = pk4_fp8(v[q][0].z, v[q][1].z, v[q][2].z, v[q][3].z); o.y = pk4_fp8(v[q][4].z, v[q][5].z, v[q][6].z, v[q][7].z); o.z = pk4_fp8(v[q][8].z, v[q][9].z, v[q][10].z, v[q][11].z); o.w = pk4_fp8(v[q][12].z, v[q][13].z, v[q][14].z, v[q][15].z);
      __builtin_nontemporal_store(o, (u32x4*)(dp + (size_t)rm(n + 2) * K));
      o.x = pk4_fp8(v[q][0].w, v[q][1].w, v[q][2].w, v[q][3].w); o.y = pk4_fp8(v[q][4].w, v[q][5].w, v[q][6].w, v[q][7].w); o.z = pk4_fp8(v[q][8].w, v[q][9].w, v[q][10].w, v[q][11].w); o.w = pk4_fp8(v[q][12].w, v[q][13].w, v[q][14].w, v[q][15].w);
      __builtin_nontemporal_store(o, (u32x4*)(dp + (size_t)rm(n + 3) * K)); }
  }
}
constexpr int CVT_TPI = 6, CVT_NJ = (NE * 32 + CVT_TPI - 1) / CVT_TPI, CVT_NS = (32 + CVT_TPI - 1) / CVT_TPI;
constexpr int CVT_ITEMS = 3 * CVT_NJ + 3 * CVT_NS;
__device__ __forceinline__ void cvt_moe_item(const Params& p, int item) {
  unsigned char* gu = (unsigned char*)p.WguT; unsigned char* dn = (unsigned char*)p.WdT;
  constexpr int NJ = CVT_NJ, NS = CVT_NS, TE = NE * 32;
#define CVT_RNG(i_, n_) (i_) * CVT_TPI, ((i_) * CVT_TPI + CVT_TPI < (n_) ? (i_) * CVT_TPI + CVT_TPI : (n_))
  if (item < NJ) cvt_range8<CVT_LN_GU>(p.wg_e, D, DE, gu, (size_t)1024 * D, [](int n) { return (n >> 7) * 256 + (n & 127); }, CVT_RNG(item, TE));
  else if (item < 2 * NJ) cvt_range8<CVT_LN_GU>(p.wu_e, D, DE, gu, (size_t)1024 * D, [](int n) { return (n >> 7) * 256 + 128 + (n & 127); }, CVT_RNG(item - NJ, TE));
  else if (item < 3 * NJ) cvt_range8<16>(p.wd_e, DE, D, dn, (size_t)D * DE, [](int n) { return n; }, CVT_RNG(item - 2 * NJ, TE));
  else if (item < 3 * NJ + NS) cvt_range8<CVT_LN_GU>(p.wg_s, D, DE, gu + (size_t)NE * 1024 * D, 0, [](int n) { return (n >> 7) * 256 + (n & 127); }, CVT_RNG(item - 3 * NJ, 32));
  else if (item < 3 * NJ + 2 * NS) cvt_range8<CVT_LN_GU>(p.wu_s, D, DE, gu + (size_t)NE * 1024 * D, 0, [](int n) { return (n >> 7) * 256 + 128 + (n & 127); }, CVT_RNG(item - 3 * NJ - NS, 32));
  else cvt_range8<16>(p.wd_s, DE, D, dn + (size_t)NE * D * DE, 0, [](int n) { return n; }, CVT_RNG(item - 3 * NJ - 2 * NS, 32));
#undef CVT_RNG
}

struct EpiProj {
  static constexpr bool PERM = true;
  bf16_t* proj; float* dt; const float* bias_f; const float* bias_b; const float* sx; const float* sw;
  __device__ __forceinline__ void operator()(const f32x4 (&acc)[2][2][4][2], const pg8::Unit& u, int wr, int wc, int fr, int fq) const {
    asm volatile("" : "+v"(fr), "+v"(fq));
    typedef int v4i_ __attribute__((ext_vector_type(4)));
    const int row0 = u.pm * 256 + wr * 64 + fr;
    float sr[2][4];
#pragma unroll
    for (int ai = 0; ai < 2; ++ai)
#pragma unroll
      for (int m = 0; m < 4; ++m) sr[ai][m] = sx[row0 + ai * 128 + m * 16];
    if (u.pn < 22) {
      const int col0 = u.pn * 256 + wc * 32 + 8 * fq;
      const float sc = (u.pn >= 10 && u.pn < 14) ? QS : 1.0f;
#pragma unroll
      for (int bj = 0; bj < 2; ++bj) { const f32x4 s0 = *(const f32x4*)(sw + col0 + bj * 128) * sc, s1 = *(const f32x4*)(sw + col0 + bj * 128 + 4) * sc;
#pragma unroll
        for (int ai = 0; ai < 2; ++ai)
#pragma unroll
          for (int m = 0; m < 4; ++m) { const float r = sr[ai][m];
            const f32x4 v0 = __builtin_convertvector(__builtin_bit_cast(v4i_, acc[ai][bj][m][0]), f32x4) * s0 * r, v1 = __builtin_convertvector(__builtin_bit_cast(v4i_, acc[ai][bj][m][1]), f32x4) * s1 * r;
            u32x4 w; w.x = cvt_pk_bf16(v0[0], v0[1]); w.y = cvt_pk_bf16(v0[2], v0[3]); w.z = cvt_pk_bf16(v1[0], v1[1]); w.w = cvt_pk_bf16(v1[2], v1[3]);
            *(u32x4*)(proj + (size_t)(row0 + ai * 128 + m * 16) * PLD + col0 + bj * 128) = w; } }
    } else if (wc == 0) {
      const int c0 = 8 * fq;
      float bs[8], sc8[8];
#pragma unroll
      for (int j = 0; j < 8; ++j) { bs[j] = (c0 + j) < 16 ? bias_f[c0 + j] : bias_b[c0 + j - 16]; sc8[j] = sw[PLD + c0 + j]; }
#pragma unroll
      for (int ai = 0; ai < 2; ++ai)
#pragma unroll
        for (int m = 0; m < 4; ++m) { float* rowp = dt + (size_t)(row0 + ai * 128 + m * 16) * 32 + c0; const float r = sr[ai][m];
          const f32x4 v0 = __builtin_convertvector(__builtin_bit_cast(v4i_, acc[ai][0][m][0]), f32x4), v1 = __builtin_convertvector(__builtin_bit_cast(v4i_, acc[ai][0][m][1]), f32x4);
          f32x4 o0, o1;
#pragma unroll
          for (int j = 0; j < 4; ++j) { o0[j] = softplus_f(v0[j] * (r * sc8[j]) + bs[j]); o1[j] = softplus_f(v1[j] * (r * sc8[4 + j]) + bs[4 + j]); }
          *(f32x4*)rowp = o0; *(f32x4*)(rowp + 4) = o1; }
    }
  }
};
struct EpiOut {
  static constexpr bool PERM = true;
  bf16_t* v; size_t doff; const float* x;
  __device__ __forceinline__ void operator()(const f32x4 (&acc)[2][2][4][2], const pg8::Unit& u, int wr, int wc, int fr, int fq) const {
    asm volatile("" : "+v"(fr), "+v"(fq));
    const int row0 = u.pm * 256 + wr * 64 + fr, col0 = u.pn * 256 + wc * 32 + 8 * fq;
#pragma unroll
    for (int ai = 0; ai < 2; ++ai) {
      f32x4 xr0[4][2], xr1[4][2];
#pragma unroll
      for (int m = 0; m < 4; ++m)
#pragma unroll
        for (int bj = 0; bj < 2; ++bj) { const float* xr = x + (size_t)(row0 + ai * 128 + m * 16) * D + col0 + bj * 128;
          xr0[m][bj] = __builtin_nontemporal_load((const f32x4*)xr); xr1[m][bj] = __builtin_nontemporal_load((const f32x4*)(xr + 4)); }
      asm volatile("" ::: "memory");
#pragma unroll
      for (int m = 0; m < 4; ++m) { bf16_t* rp = v + (size_t)(row0 + ai * 128 + m * 16) * D + col0;
#pragma unroll
        for (int bj = 0; bj < 2; ++bj) {
          const f32x4 v0 = xr0[m][bj] * ALPHA + acc[ai][bj][m][0], v1 = xr1[m][bj] * ALPHA + acc[ai][bj][m][1];
          u32x4 w; w.x = cvt_pk_bf16(v0[0], v0[1]); w.y = cvt_pk_bf16(v0[2], v0[3]); w.z = cvt_pk_bf16(v1[0], v1[1]); w.w = cvt_pk_bf16(v1[2], v1[3]);
          *(u32x4*)(rp + doff + bj * 128) = w; } }
    }
  }
};

namespace at {
using bf16x8 = __attribute__((ext_vector_type(8))) short;
using s16x4  = __attribute__((ext_vector_type(4))) short;
using f32x16 = __attribute__((ext_vector_type(16))) float;
using u32x4  = __attribute__((ext_vector_type(4))) unsigned;
constexpr int KVBLK = 64;
constexpr size_t SHM_V = KVBLK * 128 * 2, SHM_K = KVBLK * 128 * 2;
constexpr float THR2 = 8.0f;
#define AT_KSWZ(row, colB) ((row) * 256 + ((colB) ^ (((row) & 15) << 4)))
#define AT_SBAR() __builtin_amdgcn_sched_barrier(0)
__device__ __forceinline__ int crow(int r, int hi) { return (r & 3) + 8 * (r >> 2) + 4 * hi; }
__device__ __forceinline__ unsigned cvtpk(float lo, float hi) { unsigned r; asm volatile("v_cvt_pk_bf16_f32 %0, %1, %2" : "=v"(r) : "v"(lo), "v"(hi)); return r; }

typedef float f32x2v __attribute__((ext_vector_type(2)));
__device__ __forceinline__ void diagfix(f32x16& p0, f32x16& p1, const f32x16& i0, float dqh, float a) {
#pragma unroll
  for (int r = 0; r < 16; ++r) { const float c = (float)((r & 3) + 8 * (r >> 2));
    p0[r] = fmaf(-a, fabsf(dqh - c), p0[r]) - i0[r]; p1[r] = fmaf(-a, fabsf(dqh - (c + 32.f)), p1[r]) - i0[r]; }
}
__device__ __forceinline__ void softmax_tile(f32x16& p0, f32x16& p1, float dqh, float sa, float& m_reg, float& l_reg, float& alpha, bf16x8& pa0, bf16x8& pa1, bf16x8& pa2, bf16x8& pa3) {
  const float Bt = -sa * dqh, d1 = 32.f * sa;
  float pmax = p0[0], pmax1 = p1[0], mn;
#pragma unroll
  for (int r = 1; r < 16; ++r) pmax = fmaxf(pmax, p0[r]);
#pragma unroll
  for (int r = 1; r < 16; ++r) pmax1 = fmaxf(pmax1, p1[r]);
  pmax = fmaxf(pmax, pmax1 + d1) + Bt;
  { auto rr = __builtin_amdgcn_permlane32_swap(__float_as_uint(pmax), __float_as_uint(pmax), false, false);
    pmax = fmaxf(__uint_as_float(rr[0]), __uint_as_float(rr[1])); }
  if (__builtin_expect(__all(pmax - m_reg <= THR2), 1)) { mn = m_reg; alpha = 1.f; }
  else { mn = fmaxf(m_reg, pmax); alpha = __builtin_amdgcn_exp2f(m_reg - mn); m_reg = mn; }
  const float cs = Bt - mn, cs1 = cs + d1; const f32x2v c2 = {cs, cs}, c21 = {cs1, cs1};
#pragma unroll
  for (int r = 0; r < 16; r += 2) { const f32x2v t = (f32x2v){p0[r], p0[r + 1]} + c2; p0[r] = t[0]; p0[r + 1] = t[1]; }
#pragma unroll
  for (int r = 0; r < 16; r += 2) { const f32x2v t = (f32x2v){p1[r], p1[r + 1]} + c21; p1[r] = t[0]; p1[r + 1] = t[1]; }
#pragma unroll
  for (int r = 0; r < 16; ++r) p0[r] = __builtin_amdgcn_exp2f(p0[r]);
#pragma unroll
  for (int r = 0; r < 16; ++r) p1[r] = __builtin_amdgcn_exp2f(p1[r]);
  f32x2v s2 = {0.f, 0.f};
#pragma unroll
  for (int r = 0; r < 16; r += 2) s2 += (f32x2v){p0[r], p0[r + 1]};
#pragma unroll
  for (int r = 0; r < 16; r += 2) s2 += (f32x2v){p1[r], p1[r + 1]};
  float ps = s2[0] + s2[1];
  { auto rr = __builtin_amdgcn_permlane32_swap(__float_as_uint(ps), __float_as_uint(ps), false, false);
    ps = __uint_as_float(rr[0]) + __uint_as_float(rr[1]); }
  l_reg = l_reg * alpha + ps;
#define AT_PK4(P, BASE, OUT) do { unsigned a0 = cvtpk(P[BASE + 0], P[BASE + 1]), a1 = cvtpk(P[BASE + 2], P[BASE + 3]);   \
    unsigned b0 = cvtpk(P[BASE + 4], P[BASE + 5]), b1 = cvtpk(P[BASE + 6], P[BASE + 7]);                              \
    auto r0 = __builtin_amdgcn_permlane32_swap(a0, b0, false, false); auto r1 = __builtin_amdgcn_permlane32_swap(a1, b1, false, false); \
    u32x4 w = {r0[0], r1[0], r0[1], r1[1]}; OUT = *reinterpret_cast<bf16x8*>(&w); } while (0)
  AT_PK4(p0, 0, pa0); AT_PK4(p0, 8, pa1); AT_PK4(p1, 0, pa2); AT_PK4(p1, 8, pa3);
#undef AT_PK4
}
__device__ __forceinline__ int v_st(int k, int c) { const int kk = (k & ~0xC) | ((k & 4) << 1) | ((k & 8) >> 1); return ((kk >> 3) * 4 + (c >> 5)) * 512 + ((kk & 7) * 32 + (c & 31)) * 2; }
__device__ __forceinline__ int v_rd_base(int lane) { return ((lane & 3) << 3) | (((lane >> 2) & 3) << 6) | (((lane >> 4) & 1) << 5) | (((lane >> 5) & 1) << 8); }
constexpr int v_rd_off(int d0, int ks, int half) { return d0 * 512 + ks * 4096 + half * 2048; }
template <int OFF> __device__ __forceinline__ s16x4 tr_read(int vb) {
  s16x4 r; asm volatile("ds_read_b64_tr_b16 %0, %1 offset:%2" : "=&v"(r) : "v"(vb), "i"(OFF) : "memory"); return r;
}
template <int OFF> __device__ __forceinline__ bf16x8 k_read(int ka) {
  bf16x8 r; asm volatile("ds_read_b128 %0, %1 offset:%2" : "=&v"(r) : "v"(ka), "i"(OFF) : "memory"); return r;
}
#define AT_WAIT(n) asm volatile("s_waitcnt lgkmcnt(" #n ")" ::: "memory")
template <bool QK, bool PV, class H1, class H2>
__device__ __forceinline__ void xphase(f32x16& p0, f32x16& p1, const f32x16& i0, f32x16* o, const int* ka, int kbuf, const bf16x8* qr, int vb, bf16x8 pa0, bf16x8 pa1, bf16x8 pa2, bf16x8 pa3, const H1& hook1, const H2& hook2) {
  bf16x8 kf[8]; s16x4 va[8], vc[8];
#define AT_VREAD(dst, D0) do { dst[0] = tr_read<v_rd_off(D0, 0, 0)>(vb); dst[1] = tr_read<v_rd_off(D0, 0, 1)>(vb); dst[2] = tr_read<v_rd_off(D0, 1, 0)>(vb); dst[3] = tr_read<v_rd_off(D0, 1, 1)>(vb); \
    dst[4] = tr_read<v_rd_off(D0, 2, 0)>(vb); dst[5] = tr_read<v_rd_off(D0, 2, 1)>(vb); dst[6] = tr_read<v_rd_off(D0, 3, 0)>(vb); dst[7] = tr_read<v_rd_off(D0, 3, 1)>(vb); } while (0)
#define AT_PK(L, H) (bf16x8){L[0], L[1], L[2], L[3], H[0], H[1], H[2], H[3]}
#define AT_PVMMA(od, v) do { od = __builtin_amdgcn_mfma_f32_32x32x16_bf16(pa0, AT_PK(v[0], v[1]), od, 0, 0, 0); od = __builtin_amdgcn_mfma_f32_32x32x16_bf16(pa1, AT_PK(v[2], v[3]), od, 0, 0, 0); \
    od = __builtin_amdgcn_mfma_f32_32x32x16_bf16(pa2, AT_PK(v[4], v[5]), od, 0, 0, 0); od = __builtin_amdgcn_mfma_f32_32x32x16_bf16(pa3, AT_PK(v[6], v[7]), od, 0, 0, 0); } while (0)
#define AT_KREAD() do { _Pragma("unroll") for (int d0 = 0; d0 < 4; ++d0) { kf[2 * d0] = k_read<0>(ka[d0] + kbuf); kf[2 * d0 + 1] = k_read<32 * 256>(ka[d0] + kbuf); } } while (0)
#define AT_QKMMA() do { p0 = __builtin_amdgcn_mfma_f32_32x32x16_bf16(kf[0], qr[0], i0, 0, 0, 0); p1 = __builtin_amdgcn_mfma_f32_32x32x16_bf16(kf[1], qr[0], i0, 0, 0, 0); \
    _Pragma("unroll") for (int d0 = 1; d0 < 4; ++d0) { p0 = __builtin_amdgcn_mfma_f32_32x32x16_bf16(kf[2 * d0], qr[d0], p0, 0, 0, 0); p1 = __builtin_amdgcn_mfma_f32_32x32x16_bf16(kf[2 * d0 + 1], qr[d0], p1, 0, 0, 0); } } while (0)
  if constexpr (QK && PV) {
    AT_VREAD(va, 0); AT_KREAD();
    hook1();
    AT_WAIT(8); AT_SBAR(); AT_PVMMA(o[0], va); AT_SBAR();
    AT_VREAD(vc, 1);
    hook2();
    AT_WAIT(8); AT_SBAR(); AT_QKMMA(); AT_SBAR();
    AT_VREAD(va, 2);
    AT_WAIT(8); AT_SBAR(); AT_PVMMA(o[1], vc); AT_SBAR();
    AT_VREAD(vc, 3);
    AT_WAIT(8); AT_SBAR(); AT_PVMMA(o[2], va); AT_SBAR();
    AT_WAIT(0); AT_SBAR(); AT_PVMMA(o[3], vc); AT_SBAR();
  } else if constexpr (QK) {
    AT_KREAD(); hook1(); hook2(); AT_WAIT(0); AT_SBAR(); AT_QKMMA(); AT_SBAR();
  } else {
    AT_VREAD(va, 0);
    AT_VREAD(vc, 1); AT_WAIT(8); AT_SBAR(); AT_PVMMA(o[0], va); AT_SBAR();
    AT_VREAD(va, 2); AT_WAIT(8); AT_SBAR(); AT_PVMMA(o[1], vc); AT_SBAR();
    AT_VREAD(vc, 3); AT_WAIT(8); AT_SBAR(); AT_PVMMA(o[2], va); AT_SBAR();
    AT_WAIT(0); AT_SBAR(); AT_PVMMA(o[3], vc); AT_SBAR();
  }
#undef AT_KREAD
#undef AT_QKMMA
#undef AT_VREAD
#undef AT_PK
#undef AT_PVMMA
}

__device__ __forceinline__ void attn_item(const bf16_t* __restrict__ Qb, const bf16_t* Kh, const bf16_t* Vh, bf16_t* __restrict__ Ub,
                                          int q0, float nsl2, float lam, const float* __restrict__ normw, const float* kn2, char* lds) {
  constexpr int LDK = PLD;
  int tid = threadIdx.x; asm volatile("" : "+v"(tid));
  const int wid = __builtin_amdgcn_readfirstlane(tid >> 6), lane = tid & 63, r32 = lane & 31, hi = lane >> 5, rg = wid >> 1, cmap = wid & 1, cm = cmap * 64, grp = wid >> 2;
  char* V_lds = lds; char* K_lds = lds + 3 * SHM_V;
  float* ws = (float*)(lds + 96 * 1024) + wid * 64; float* li_l = ws; float* al_l = ws + 32;
  float m_reg = -1e30f, l_reg = 0; f32x16 o[4] = {}; bf16x8 qr[4];
  const bf16_t* Qw = Qb + (size_t)(rg * 32 + r32) * LDK + cm + hi * 8;
#pragma unroll
  for (int d0 = 0; d0 < 4; ++d0) qr[d0] = *reinterpret_cast<const bf16x8*>(Qw + d0 * 16);
  int jlo, ntl;
  { float qs = 0.f;
#pragma unroll
    for (int d0 = 0; d0 < 4; ++d0)
#pragma unroll
      for (int e = 0; e < 8; ++e) { const float x = __uint_as_float(((unsigned)(unsigned short)qr[d0][e]) << 16); qs += x * x; }
    qs += __shfl_xor(qs, 32);
    for (int o = 16; o >= 1; o >>= 1) qs = fmaxf(qs, __shfl_xor(qs, o));
    float* qn = (float*)(lds + 99 * 1024);
    __syncthreads();
    if (lane == 0) qn[wid] = qs;
    __syncthreads();
    float q2 = qn[0];
#pragma unroll
    for (int w = 1; w < 8; ++w) q2 = fmaxf(q2, qn[w]);
    const float qnm = sqrtf(q2) * 1.01f;
    const int j = lane & 31;
    float kv = __hip_atomic_load(kn2 + lane, __ATOMIC_RELAXED, __HIP_MEMORY_SCOPE_AGENT);
    kv = fmaxf(kv, __shfl_xor(kv, 32));
    const int dl = q0 - (j * KVBLK + KVBLK - 1), dr = j * KVBLK - (q0 + 127); const int dmin = dl > 0 ? dl : (dr > 0 ? dr : 0);
    const float smax = qnm * sqrtf(kv) * 1.01f;
    const bool keep = -nsl2 * (float)dmin < 2.f * smax + 30.f;
    const unsigned km = (unsigned)__ballot(keep);
    jlo = __builtin_ctz(km); ntl = 32 - __builtin_clz(km) - jlo; }
  Kh += (size_t)jlo * KVBLK * LDK; Vh += (size_t)jlo * KVBLK * LDK;
  const int vb0 = (int)(uintptr_t)V_lds + v_rd_base(lane);
  const float qposh = (float)(q0 - jlo * KVBLK + rg * 32 + r32 - 4 * hi);
  int kso[2], vso[2];
#pragma unroll
  for (int q = 0; q < 2; ++q) {
    const int row = 4 * (wid * 2 + q) + (lane >> 4), c = (lane & 15) ^ (row & 15); kso[q] = row * (LDK * 2) + c * 16;
    const int s = (wid * 2 + q) * 64 + lane, hi5 = s >> 5, kk = ((hi5 >> 2) << 3) | ((s >> 2) & 7), k = (kk & ~0xC) | ((kk & 4) << 1) | ((kk & 8) >> 1), cch = (hi5 & 3) * 4 + (s & 3);
    vso[q] = k * (LDK * 2) + cch * 16; }
  __attribute__((address_space(3))) char* const l3 = (__attribute__((address_space(3))) char*)lds;
#define DMA_K(t, b) do { _Pragma("unroll") for (int q_ = 0; q_ < 2; ++q_) __builtin_amdgcn_global_load_lds((const unsigned*)((const char*)Kh + (size_t)(t) * (KVBLK * LDK * 2) + kso[q_]), \
    (__attribute__((address_space(3))) unsigned*)(l3 + 3 * SHM_V + (b) * SHM_K + (wid * 2 + q_) * 1024), 16, 0, 0); } while (0)
#define DMA_V(t, b) do { _Pragma("unroll") for (int q_ = 0; q_ < 2; ++q_) __builtin_amdgcn_global_load_lds((const unsigned*)((const char*)Vh + (size_t)(t) * (KVBLK * LDK * 2) + vso[q_]), \
    (__attribute__((address_space(3))) unsigned*)(l3 + (b) * SHM_V + (wid * 2 + q_) * 1024), 16, 0, 0); } while (0)
#define BAR() do { asm volatile("" ::: "memory"); __builtin_amdgcn_s_barrier(); asm volatile("" ::: "memory"); } while (0)
#define RESC(a) do { if (__any((a) < 1.f)) { if (hi == 0) al_l[r32] = (a); asm volatile("s_waitcnt lgkmcnt(0)" ::: "memory"); \
    _Pragma("unroll") for (int d = 0; d < 4; ++d) _Pragma("unroll") for (int r = 0; r < 16; ++r) o[d][r] *= al_l[crow(r, hi)]; } } while (0)
  f32x16 p0, p1; float alpha = 1.f; bf16x8 pa0, pa1, pa2, pa3; const int NTL = ntl;
  const float aa = -nsl2; const int tdiag = __builtin_amdgcn_readfirstlane(((q0 + rg * 32) >> 6) - jlo);
  f32x16 i0;
#pragma unroll
  for (int r = 0; r < 16; ++r) i0[r] = aa * (float)((r & 3) + 8 * (r >> 2));
  int ka[4];
#pragma unroll
  for (int d0 = 0; d0 < 4; ++d0) ka[d0] = (int)(uintptr_t)K_lds + AT_KSWZ(r32, (cm + d0 * 16 + hi * 8) * 2);
#define FLIP(t) do { if ((t) == tdiag + 1) { _Pragma("unroll") for (int r = 0; r < 16; ++r) asm volatile("v_xor_b32 %0, 0x80000000, %0" : "+v"(i0[r])); } } while (0)
#define YPHASE(t) do { const float dq = qposh - (float)((t) * KVBLK); if ((t) == tdiag) diagfix(p0, p1, i0, dq, aa); \
    softmax_tile(p0, p1, dq, (t) < tdiag ? aa : ((t) == tdiag ? 0.f : -aa), m_reg, l_reg, alpha, pa0, pa1, pa2, pa3); } while (0)
  DMA_K(0, 0); DMA_V(0, 0); if (1 < NTL) DMA_K(1, 1);
  asm volatile("s_waitcnt vmcnt(0)" ::: "memory"); BAR();
  if (grp == 1) { BAR(); __builtin_amdgcn_s_setprio(1); }
  auto nohook = []() {};
  xphase<true, false>(p0, p1, i0, o, ka, 0, qr, vb0, pa0, pa1, pa2, pa3, [&]() { if (2 < NTL) DMA_K(2, 2); }, [&]() { if (1 < NTL) DMA_V(1, 1); });
#define XWAIT(m) do { if ((m) + 2 < NTL) asm volatile("s_waitcnt vmcnt(4)" ::: "memory"); else asm volatile("s_waitcnt vmcnt(0)" ::: "memory"); } while (0)
  if (grp == 1) XWAIT(0);
  BAR();
  YPHASE(0);
  if (grp == 0) XWAIT(0);
  BAR();
  int b0 = 1;
  for (int j = 1; j < NTL; ++j) {
    const int b1 = b0 == 2 ? 0 : b0 + 1, b2 = b1 == 2 ? 0 : b1 + 1;
    RESC(alpha);
    FLIP(j);
    xphase<true, true>(p0, p1, i0, o, ka, b0 * (int)SHM_K, qr, vb0 + b2 * (int)SHM_V, pa0, pa1, pa2, pa3, [&]() { if (j + 2 < NTL) DMA_K(j + 2, b2); }, [&]() { if (j + 1 < NTL) DMA_V(j + 1, b1); });
    if (grp == 1) XWAIT(j);
    BAR();
    YPHASE(j);
    if (grp == 0) XWAIT(j);
    BAR();
    b0 = b1;
  }
  { const int bl = b0 == 0 ? 2 : b0 - 1;
    RESC(alpha); xphase<false, true>(p0, p1, i0, o, ka, 0, qr, vb0 + bl * (int)SHM_V, pa0, pa1, pa2, pa3, nohook, nohook); }
  BAR();
  if (grp == 0) BAR(); else __builtin_amdgcn_s_setprio(0);
#undef FLIP
#undef XWAIT
#undef YPHASE
#undef DMA_K
#undef DMA_V
#undef BAR
  if (hi == 0) li_l[r32] = l_reg; asm volatile("s_waitcnt lgkmcnt(0)" ::: "memory");
  float rli[16];
#pragma unroll
  for (int r = 0; r < 16; ++r) rli[r] = __builtin_amdgcn_rcpf(li_l[crow(r, hi)]);
#pragma unroll
  for (int d = 0; d < 4; ++d)
#pragma unroll
    for (int r = 0; r < 16; ++r) o[d][r] *= rli[r];
  __syncthreads();
  float* X = (float*)lds + rg * (32 * 128);
  if (cmap == 1) {
#pragma unroll
    for (int d = 0; d < 4; ++d)
#pragma unroll
      for (int r = 0; r < 16; ++r) X[crow(r, hi) * 128 + d * 32 + r32] = o[d][r];
  }
  __syncthreads();
  if (cmap == 0) {
    float ss[16];
#pragma unroll
    for (int r = 0; r < 16; ++r) ss[r] = 0.f;
#pragma unroll
    for (int d = 0; d < 4; ++d)
#pragma unroll
      for (int r = 0; r < 16; ++r) { const float v = o[d][r] - lam * X[crow(r, hi) * 128 + d * 32 + r32]; o[d][r] = v; ss[r] += v * v; }
#pragma unroll
    for (int r = 0; r < 16; ++r) { float s = ss[r]; s += __shfl_xor(s, 16); s += __shfl_xor(s, 8); s += __shfl_xor(s, 4); s += __shfl_xor(s, 2); s += __shfl_xor(s, 1);
      ss[r] = rsqrtf(s * (1.f / 128.f) + 1e-5f) * (1.f - LAMBDA_INIT); }
    float nw[4];
#pragma unroll
    for (int d = 0; d < 4; ++d) nw[d] = normw[d * 32 + r32];
#pragma unroll
    for (int r = 0; r < 16; ++r) { bf16_t* up = Ub + (size_t)(rg * 32 + crow(r, hi)) * D + r32;
#pragma unroll
      for (int d = 0; d < 4; ++d) up[d * 32] = f2bf(o[d][r] * ss[r] * nw[d]); }
  }
  __syncthreads();
#undef RESC
}
}

__device__ __forceinline__ void ph_attn_mfma(const Params& p, char* lds, int* qhead) {
  float lam;
  { float s1 = 0.f, s2 = 0.f; for (int i = 0; i < 64; ++i) { s1 += p.lq1[i] * p.lk1[i]; s2 += p.lq2[i] * p.lk2[i]; } lam = __expf(s1) - __expf(s2) + LAMBDA_INIT; }
  int* qslot = (int*)(lds + 100 * 1024);
  bool more_a = true, more_c = true;
  for (int turn = 0; more_a || more_c; ++turn) {
    const bool do_attn = more_a && (!more_c || (turn & 1) == 0);
    __syncthreads();
    if (threadIdx.x == 0) *qslot = atomicAdd(do_attn ? qhead : qhead + 4, 1);
    __syncthreads();
    const int item = *qslot;
    if (do_attn) {
      if (item >= NB * AH * (S / 128)) { more_a = false; continue; }
      const int qb = item % (S / 128), h = (item / (S / 128)) % AH, b = item / ((S / 128) * AH);
      const float nsl2 = -exp2f(-(float)(h + 1)) * LOG2E;
      const size_t row0 = (size_t)b * S;
      at::attn_item(p.proj + (row0 + qb * 128) * PLD + N_Q + h * 128, p.proj + row0 * PLD + N_K + h * 128, p.proj + row0 * PLD + N_V + h * 128,
                    p.u + (row0 + qb * 128) * D + DSSD + h * 128, qb * 128, nsl2, lam, p.attn_norm_w, p.kn2 + (size_t)(b * AH + h) * 2 * (S / 64), lds);
    } else {
      if (item >= CVT_ITEMS) { more_c = false; continue; }
      cvt_moe_item(p, item);
    }
  }
}
namespace sd {
using at::bf16x8; using at::s16x4; using at::f32x16; using at::u32x4; using at::crow; using at::cvtpk; using at::v_st; using at::v_rd_base; using at::v_rd_off; using at::tr_read;
constexpr int CH = 64, NCH = S / CH;
constexpr int L_BT = 0, L_CT = 16384, L_XV = 32768, L_TAB = 98304, L_SS = 106496;
constexpr size_t SNAP = 16384;
__device__ __forceinline__ size_t snap_off(int dir, int b, int h, int c) { return ((((size_t)dir * NB + b) * NH + h) * NCH + c) * SNAP; }

__device__ __forceinline__ void ph_conv16(const Params& p) {
  { const int tidf = tid_fresh(), lane = tidf & 63, wv = tidf >> 6;
    for (int it = blockIdx.x * 8 + wv; it < NB * AH * 2 * (S / 64); it += gridDim.x * 8) {
      const int j = it % (S / 64), c = (it / (S / 64)) & 1, h = (it / (2 * (S / 64))) % AH, b = it / (2 * (S / 64) * AH);
      const bf16_t* kp = p.proj + ((size_t)b * S + j * 64 + lane) * PLD + N_K + h * 128 + c * 64; float ss = 0.f;
#pragma unroll
      for (int q = 0; q < 8; ++q) { const u32x4 w = *(const u32x4*)(kp + q * 8);
        const float x0 = __uint_as_float(w.x << 16), x1 = __uint_as_float(w.x & 0xffff0000u), x2 = __uint_as_float(w.y << 16), x3 = __uint_as_float(w.y & 0xffff0000u);
        const float x4 = __uint_as_float(w.z << 16), x5 = __uint_as_float(w.z & 0xffff0000u), x6 = __uint_as_float(w.w << 16), x7 = __uint_as_float(w.w & 0xffff0000u);
        ss += x0 * x0 + x1 * x1 + x2 * x2 + x3 * x3 + x4 * x4 + x5 * x5 + x6 * x6 + x7 * x7; }
      for (int o = 32; o >= 1; o >>= 1) ss = fmaxf(ss, __shfl_xor(ss, o));
      if (lane == 0) p.kn2[(size_t)((b * AH + h) * 2 + c) * (S / 64) + j] = ss; } }
  constexpr int SEG = 16, NCG = CC / 8, NU = NCG * (T / SEG);
  int bx_ = blockIdx.x; asm volatile("" : "+s"(bx_));
  for (int u = bx_ * NT + tid_fresh(); u < NU; u += gridDim.x * NT) {
    const int cg = u % NCG, seg = u / NCG, t0 = seg * SEG, s0 = t0 % S, chan = cg * 8;
    float w[5][8], bias[8];
#pragma unroll
    for (int j = 0; j < 5; ++j) { const float4 a = *(const float4*)(p.conv_w + j * CC + chan), c = *(const float4*)(p.conv_w + j * CC + chan + 4);
      w[j][0] = a.x; w[j][1] = a.y; w[j][2] = a.z; w[j][3] = a.w; w[j][4] = c.x; w[j][5] = c.y; w[j][6] = c.z; w[j][7] = c.w; }
    { const float4 a = *(const float4*)(p.conv_b + chan), c = *(const float4*)(p.conv_b + chan + 4);
      bias[0] = a.x; bias[1] = a.y; bias[2] = a.z; bias[3] = a.w; bias[4] = c.x; bias[5] = c.y; bias[6] = c.z; bias[7] = c.w; }
    const bf16_t* base = p.proj + (size_t)t0 * PLD + N_XBC + chan;
    u32x4 rows[SEG + 4];
#pragma unroll
    for (int i = 0; i < SEG + 4; ++i) { const int s = s0 + i - 2; rows[i] = (u32x4){0u, 0u, 0u, 0u}; if (s >= 0 && s < S) rows[i] = *(const u32x4*)(base + (ptrdiff_t)(i - 2) * PLD); }
#pragma unroll
    for (int i = 0; i < SEG; ++i) {
      float o[8];
#pragma unroll
      for (int c = 0; c < 8; ++c) o[c] = bias[c];
#pragma unroll
      for (int j = 0; j < 5; ++j) { const u32x4 rr = rows[i + j];
        o[0] += w[j][0] * __uint_as_float(rr.x << 16); o[1] += w[j][1] * __uint_as_float(rr.x & 0xffff0000u);
        o[2] += w[j][2] * __uint_as_float(rr.y << 16); o[3] += w[j][3] * __uint_as_float(rr.y & 0xffff0000u);
        o[4] += w[j][4] * __uint_as_float(rr.z << 16); o[5] += w[j][5] * __uint_as_float(rr.z & 0xffff0000u);
        o[6] += w[j][6] * __uint_as_float(rr.w << 16); o[7] += w[j][7] * __uint_as_float(rr.w & 0xffff0000u); }
#pragma unroll
      for (int c = 0; c < 8; ++c) o[c] = o[c] * __builtin_amdgcn_rcpf(1.f + __expf(-o[c]));
      u32x4 pk; pk.x = cvtpk(o[0], o[1]); pk.y = cvtpk(o[2], o[3]); pk.z = cvtpk(o[4], o[5]); pk.w = cvtpk(o[6], o[7]);
      *(u32x4*)(p.xc16 + (size_t)(t0 + i) * CC + chan) = pk;
    }
  }
}
template <bool WITH_C, bool BV>
__device__ __forceinline__ void load_chunk(const Params& p, char* lds, int b, int g, int c0) {
  constexpr int NCG = WITH_C ? 96 : 80, NP = NCG * CH / NT;
  int tid = threadIdx.x; asm volatile("" : "+v"(tid));
  const bf16_t* src = p.xc16 + ((size_t)b * S + c0) * CC;
  u32x4 v[NP];
#pragma unroll
  for (int i = 0; i < NP; ++i) { const int idx = tid + NT * i, tok = idx / NCG, cg = idx % NCG;
    const int chan = cg < 64 ? g * 512 + cg * 8 : (cg < 80 ? 1024 + g * 128 + (cg - 64) * 8 : 1280 + g * 128 + (cg - 80) * 8);
    v[i] = *(const u32x4*)(src + (size_t)tok * CC + chan); }
#pragma unroll
  for (int i = 0; i < NP; ++i) { const int idx = tid + NT * i, tok = idx / NCG, cg = idx % NCG;
    if (cg < 64) { const int hl = cg >> 3, c = (hl & 1) * 64 + (cg & 7) * 8; *(u32x4*)(lds + L_XV + (hl >> 1) * 16384 + v_st(tok, c)) = v[i]; }
    else if (cg < 80) { const int n0 = (cg - 64) * 8; if (BV) *(u32x4*)(lds + L_BT + v_st(tok, n0)) = v[i]; else *(u32x4*)(lds + L_BT + AT_KSWZ(tok, n0 * 2)) = v[i]; }
    else { const int n0 = (cg - 80) * 8; *(u32x4*)(lds + L_CT + AT_KSWZ(tok, n0 * 2)) = v[i]; } }
}
__device__ __forceinline__ float wave_incl_prefix(float v, int lane) {
#pragma unroll
  for (int o = 1; o < 64; o <<= 1) { const float t = __int_as_float(__builtin_amdgcn_ds_bpermute(((lane - o) & 63) << 2, __float_as_int(v))); if (lane >= o) v += t; }
  return v;
}
__device__ __forceinline__ float wave_incl_suffix(float v, int lane) {
#pragma unroll
  for (int o = 1; o < 64; o <<= 1) { const float t = __int_as_float(__builtin_amdgcn_ds_bpermute(((lane + o) & 63) << 2, __float_as_int(v))); if (lane + o < 64) v += t; }
  return v;
}
__device__ __forceinline__ float wave_bcast(float v, int src) { return __int_as_float(__builtin_amdgcn_ds_bpermute(src << 2, __float_as_int(v))); }
__device__ __forceinline__ bf16x8 scale_frag(s16x4 lo, s16x4 hi, const float4 w0, const float4 w1) {
  const unsigned a = ((unsigned)(unsigned short)lo[0]) | ((unsigned)(unsigned short)lo[1] << 16), b = ((unsigned)(unsigned short)lo[2]) | ((unsigned)(unsigned short)lo[3] << 16);
  const unsigned c = ((unsigned)(unsigned short)hi[0]) | ((unsigned)(unsigned short)hi[1] << 16), d = ((unsigned)(unsigned short)hi[2]) | ((unsigned)(unsigned short)hi[3] << 16);
  u32x4 r;
  r.x = cvtpk(__uint_as_float(a << 16) * w0.x, __uint_as_float(a & 0xffff0000u) * w0.y);
  r.y = cvtpk(__uint_as_float(b << 16) * w0.z, __uint_as_float(b & 0xffff0000u) * w0.w);
  r.z = cvtpk(__uint_as_float(c << 16) * w1.x, __uint_as_float(c & 0xffff0000u) * w1.y);
  r.w = cvtpk(__uint_as_float(d << 16) * w1.z, __uint_as_float(d & 0xffff0000u) * w1.w);
  return *reinterpret_cast<bf16x8*>(&r);
}
#define SD_PK(L, H) (bf16x8){L[0], L[1], L[2], L[3], H[0], H[1], H[2], H[3]}

__device__ __forceinline__ void pass_a_item(const Params& p, char* lds, char* snap, int b, int g, int dir) {
  int tid = threadIdx.x; asm volatile("" : "+v"(tid));
  const int hl = tid >> 6, lane = tid & 63, r32 = lane & 31, hi = lane >> 5, h = g * 8 + hl;
  const float a = -__expf(dir ? p.a_log_b[h] : p.a_log_f[h]);
  float* wtab = (float*)(lds + L_TAB) + hl * 64;
  const int vbx = (int)(uintptr_t)(lds + L_XV + (hl >> 1) * 16384) + v_rd_base(lane) + (hl & 1) * 1024;
  const int vbb = (int)(uintptr_t)(lds + L_BT) + v_rd_base(lane);
  f32x16 st[4][2];
#pragma unroll
  for (int nb = 0; nb < 4; ++nb)
#pragma unroll
    for (int pb = 0; pb < 2; ++pb) st[nb][pb] = f32x16{};
  for (int ci = 0; ci < NCH; ++ci) {
    const int c = dir ? (NCH - 1 - ci) : ci, c0 = c * CH;
    __syncthreads();
    const float dtv = p.dt[((size_t)b * S + c0 + lane) * 32 + dir * 16 + h];
    load_chunk<false, true>(p, lds, b, g, c0);
    const float adt = a * dtv;
    const float cum = dir ? wave_incl_suffix(adt, lane) : wave_incl_prefix(adt, lane);
    const float total = wave_bcast(cum, dir ? 0 : 63);
    wtab[lane] = __expf(total - cum) * dtv;
    const float dec = __expf(total);
    { char* sp = snap + snap_off(dir, b, h, c);
#pragma unroll
      for (int nb = 0; nb < 4; ++nb)
#pragma unroll
        for (int pb = 0; pb < 2; ++pb)
#pragma unroll
          for (int q = 0; q < 4; ++q) { const f32x16& s = st[nb][pb];
            uint2 v; v.x = cvtpk(s[4 * q + 0], s[4 * q + 1]); v.y = cvtpk(s[4 * q + 2], s[4 * q + 3]);
            *(uint2*)(sp + ((((pb * 8 + nb * 2 + (q >> 1)) * 2 + (q & 1)) * 32 + r32) * 16 + hi * 8)) = v; } }
#pragma unroll
    for (int nb = 0; nb < 4; ++nb)
#pragma unroll
      for (int pb = 0; pb < 2; ++pb)
#pragma unroll
        for (int r = 0; r < 16; ++r) st[nb][pb][r] *= dec;
    __syncthreads();
#pragma unroll
    for (int ks = 0; ks < 4; ++ks) {
      const float4 w0 = *(const float4*)(wtab + ks * 16 + hi * 8), w1 = *(const float4*)(wtab + ks * 16 + hi * 8 + 4);
      bf16x8 xf[2];
      const s16x4 l0 = tr_read<v_rd_off(0, 0, 0)>(vbx + ks * 4096), h0 = tr_read<v_rd_off(0, 0, 1)>(vbx + ks * 4096), l1 = tr_read<v_rd_off(1, 0, 0)>(vbx + ks * 4096), h1 = tr_read<v_rd_off(1, 0, 1)>(vbx + ks * 4096);
      s16x4 bl[4], bh[4];
#pragma unroll
      for (int nb = 0; nb < 4; ++nb) {
        asm volatile("ds_read_b64_tr_b16 %0, %1" : "=&v"(bl[nb]) : "v"(vbb + nb * 512 + ks * 4096) : "memory");
        asm volatile("ds_read_b64_tr_b16 %0, %1 offset:2048" : "=&v"(bh[nb]) : "v"(vbb + nb * 512 + ks * 4096) : "memory"); }
      asm volatile("s_waitcnt lgkmcnt(0)" ::: "memory"); AT_SBAR();
      xf[0] = scale_frag(l0, h0, w0, w1); xf[1] = scale_frag(l1, h1, w0, w1);
#pragma unroll
      for (int nb = 0; nb < 4; ++nb) {
        const bf16x8 bfr = SD_PK(bl[nb], bh[nb]);
        st[nb][0] = __builtin_amdgcn_mfma_f32_32x32x16_bf16(bfr, xf[0], st[nb][0], 0, 0, 0);
        st[nb][1] = __builtin_amdgcn_mfma_f32_32x32x16_bf16(bfr, xf[1], st[nb][1], 0, 0, 0);
      }
    }
  }
  __syncthreads();
}

__device__ __forceinline__ void pass_b_item(const Params& p, char* lds, const char* snap, int b, int g, int c) {
  int tid = threadIdx.x; asm volatile("" : "+v"(tid));
  const int hl = tid >> 6, lane = tid & 63, r32 = lane & 31, hi = lane >> 5, h = g * 8 + hl, c0 = c * CH;
  float4* tab = (float4*)(lds + L_TAB) + hl * 64;
  float* ssp = (float*)(lds + L_SS);
  const int vbx = (int)(uintptr_t)(lds + L_XV + (hl >> 1) * 16384) + v_rd_base(lane) + (hl & 1) * 1024;
  __syncthreads();
  const size_t tok_ = (size_t)b * S + c0 + lane;
  const float dtf = p.dt[tok_ * 32 + h], dtb = p.dt[tok_ * 32 + 16 + h];
  load_chunk<true, false>(p, lds, b, g, c0);
  {
    const float af = -__expf(p.a_log_f[h]) * dtf, ab = -__expf(p.a_log_b[h]) * dtb;
    tab[lane] = make_float4(wave_incl_prefix(af, lane) * LOG2E, wave_incl_suffix(ab, lane) * LOG2E, dtf, dtb); }
  __syncthreads();
  const float dsk = p.d_skip[h];
  f32x16 o[2][2];
  const bool has0 = (c != 0), has1 = (c != NCH - 1);
  const char* sp0 = snap + snap_off(0, b, h, c); const char* sp1 = snap + snap_off(1, b, h, c);
  bf16x8 sfa[8], sfb[8];
#define SD_LOADSF(dst, G) do { const char* sp_ = ((G) >> 1) ? sp1 : sp0; if (((G) >> 1) ? has1 : has0) { _Pragma("unroll") for (int kk = 0; kk < 8; ++kk) \
      dst[kk] = *reinterpret_cast<const bf16x8*>(sp_ + ((((((G) & 1) * 8 + kk) * 2 + hi) * 32 + r32) * 16)); } } while (0)
  SD_LOADSF(sfa, 0);
#pragma unroll
  for (int lb = 0; lb < 2; ++lb) {
    const int l = lb * 32 + r32;
    const float4 tl = tab[l];
    bf16x8 cr[8];
#pragma unroll
    for (int kk = 0; kk < 8; ++kk) cr[kk] = *reinterpret_cast<const bf16x8*>(lds + L_CT + AT_KSWZ(l, (kk * 16 + hi * 8) * 2));
    f32x16 p0 = f32x16{}, p1 = f32x16{};
#pragma unroll
    for (int kk = 0; kk < 8; ++kk) { const int cb = (kk * 16 + hi * 8) * 2;
      const bf16x8 b0 = *reinterpret_cast<const bf16x8*>(lds + L_BT + AT_KSWZ(r32, cb));
      const bf16x8 b1 = *reinterpret_cast<const bf16x8*>(lds + L_BT + AT_KSWZ(32 + r32, cb));
      p0 = __builtin_amdgcn_mfma_f32_32x32x16_bf16(b0, cr[kk], p0, 0, 0, 0);
      p1 = __builtin_amdgcn_mfma_f32_32x32x16_bf16(b1, cr[kk], p1, 0, 0, 0); }
#pragma unroll
    for (int r = 0; r < 16; ++r) {
#pragma unroll
      for (int half = 0; half < 2; ++half) {
        const int s = crow(r, hi) + 32 * half; const float4 ts = tab[s];
        float m, add = 0.f;
        if (half == lb) {
          m = 0.f;
          if (s <= l) m += __builtin_amdgcn_exp2f(tl.x - ts.x) * ts.z;
          if (s >= l) m += __builtin_amdgcn_exp2f(tl.y - ts.y) * ts.w;
          add = (s == l) ? dsk : 0.f;
        } else if (half < lb) m = __builtin_amdgcn_exp2f(tl.x - ts.x) * ts.z;
        else m = __builtin_amdgcn_exp2f(tl.y - ts.y) * ts.w;
        if (half) p1[r] = p1[r] * m + add; else p0[r] = p0[r] * m + add;
      }
      if ((r & 3) == 3) asm volatile("" ::: "memory");
    }
    bf16x8 pa0, pa1, pa2, pa3;
#define SD_PK4(P, BASE, OUT) do { unsigned a0 = cvtpk(P[BASE + 0], P[BASE + 1]), a1 = cvtpk(P[BASE + 2], P[BASE + 3]);   \
    unsigned b0_ = cvtpk(P[BASE + 4], P[BASE + 5]), b1_ = cvtpk(P[BASE + 6], P[BASE + 7]);                              \
    auto r0 = __builtin_amdgcn_permlane32_swap(a0, b0_, false, false); auto r1 = __builtin_amdgcn_permlane32_swap(a1, b1_, false, false); \
    u32x4 w_ = {r0[0], r1[0], r0[1], r1[1]}; OUT = *reinterpret_cast<bf16x8*>(&w_); } while (0)
    SD_PK4(p0, 0, pa0); SD_PK4(p0, 8, pa1); SD_PK4(p1, 0, pa2); SD_PK4(p1, 8, pa3);
#undef SD_PK4
#pragma unroll
    for (int d = 0; d < 2; ++d) {
      const s16x4 l0 = d ? tr_read<v_rd_off(1, 0, 0)>(vbx) : tr_read<v_rd_off(0, 0, 0)>(vbx), h0 = d ? tr_read<v_rd_off(1, 0, 1)>(vbx) : tr_read<v_rd_off(0, 0, 1)>(vbx);
      const s16x4 l1 = d ? tr_read<v_rd_off(1, 1, 0)>(vbx) : tr_read<v_rd_off(0, 1, 0)>(vbx), h1 = d ? tr_read<v_rd_off(1, 1, 1)>(vbx) : tr_read<v_rd_off(0, 1, 1)>(vbx);
      const s16x4 l2 = d ? tr_read<v_rd_off(1, 2, 0)>(vbx) : tr_read<v_rd_off(0, 2, 0)>(vbx), h2 = d ? tr_read<v_rd_off(1, 2, 1)>(vbx) : tr_read<v_rd_off(0, 2, 1)>(vbx);
      const s16x4 l3 = d ? tr_read<v_rd_off(1, 3, 0)>(vbx) : tr_read<v_rd_off(0, 3, 0)>(vbx), h3 = d ? tr_read<v_rd_off(1, 3, 1)>(vbx) : tr_read<v_rd_off(0, 3, 1)>(vbx);
      asm volatile("s_waitcnt lgkmcnt(0)" ::: "memory"); AT_SBAR();
      f32x16 od = f32x16{};
      od = __builtin_amdgcn_mfma_f32_32x32x16_bf16(pa0, SD_PK(l0, h0), od, 0, 0, 0);
      od = __builtin_amdgcn_mfma_f32_32x32x16_bf16(pa1, SD_PK(l1, h1), od, 0, 0, 0);
      od = __builtin_amdgcn_mfma_f32_32x32x16_bf16(pa2, SD_PK(l2, h2), od, 0, 0, 0);
      od = __builtin_amdgcn_mfma_f32_32x32x16_bf16(pa3, SD_PK(l3, h3), od, 0, 0, 0);
      o[lb][d] = od;
    }
  }
  {
#define SD_USESF(src, G) do { if (((G) >> 1) ? has1 : has0) { _Pragma("unroll") for (int lb = 0; lb < 2; ++lb) { f32x16 acc = f32x16{}; \
      _Pragma("unroll") for (int kk = 0; kk < 8; ++kk) { const bf16x8 cf = *reinterpret_cast<const bf16x8*>(lds + L_CT + AT_KSWZ(lb * 32 + r32, (kk * 16 + hi * 8) * 2)); \
        acc = __builtin_amdgcn_mfma_f32_32x32x16_bf16(cf, src[kk], acc, 0, 0, 0); } \
      _Pragma("unroll") for (int r = 0; r < 16; ++r) { const float4 tr = tab[lb * 32 + crow(r, hi)]; o[lb][(G) & 1][r] += __builtin_amdgcn_exp2f(((G) >> 1) ? tr.y : tr.x) * acc[r]; } } } } while (0)
    SD_LOADSF(sfb, 1); SD_USESF(sfa, 0); asm volatile("" ::: "memory");
    SD_LOADSF(sfa, 2); SD_USESF(sfb, 1); asm volatile("" ::: "memory");
    SD_LOADSF(sfb, 3); SD_USESF(sfa, 2); asm volatile("" ::: "memory");
    SD_USESF(sfb, 3);
#undef SD_LOADSF
#undef SD_USESF
  }
  asm volatile("" ::: "memory");
  const bf16_t* zp = p.proj + ((size_t)b * S + c0) * PLD + N_Z + h * HD + r32;
  bf16_t zz[2][16][2];
#pragma unroll
  for (int lb = 0; lb < 2; ++lb)
#pragma unroll
    for (int r = 0; r < 16; ++r) { const int l = lb * 32 + crow(r, hi);
#pragma unroll
      for (int d = 0; d < 2; ++d) zz[lb][r][d] = zp[(size_t)l * PLD + d * 32]; }
  asm volatile("" ::: "memory");
#pragma unroll
  for (int lb = 0; lb < 2; ++lb)
#pragma unroll
    for (int r = 0; r < 16; ++r) { const int l = lb * 32 + crow(r, hi); float ss = 0.f;
#pragma unroll
      for (int d = 0; d < 2; ++d) { const float z = bf2f(zz[lb][r][d]); const float y = o[lb][d][r] * z * __builtin_amdgcn_rcpf(1.f + __expf(-z)); o[lb][d][r] = y; ss += y * y; }
      ss += __shfl_xor(ss, 16); ss += __shfl_xor(ss, 8); ss += __shfl_xor(ss, 4); ss += __shfl_xor(ss, 2); ss += __shfl_xor(ss, 1);
      if (r32 == 0) ssp[hl * 64 + l] = ss; }
  __syncthreads();
  const float nw0 = p.ssd_norm_w[h * HD + r32], nw1 = p.ssd_norm_w[h * HD + 32 + r32];
  bf16_t* up = p.u + ((size_t)b * S + c0) * D + h * HD + r32;
#pragma unroll
  for (int lb = 0; lb < 2; ++lb)
#pragma unroll
    for (int r = 0; r < 16; ++r) { const int l = lb * 32 + crow(r, hi); float ss = 0.f;
#pragma unroll
      for (int q = 0; q < 8; ++q) ss += ssp[q * 64 + l];
      const float rstd = rsqrtf(ss * (1.f / 512.f) + 1e-5f);
      up[(size_t)l * D] = f2bf(o[lb][0][r] * rstd * nw0); up[(size_t)l * D + 32] = f2bf(o[lb][1][r] * rstd * nw1); }
}
}

__device__ __forceinline__ void ph_ssd_a(const Params& p, char* lds, char* snap) {
  for (int item = blockIdx.x; item < NB * 2 * 2; item += gridDim.x) { const int dir = item & 1, g = (item >> 1) & 1, b = item >> 2; sd::pass_a_item(p, lds, snap, b, g, dir); }
}
__device__ __forceinline__ void ph_ssd_b(const Params& p, char* lds, const char* snap) {
  for (int item = blockIdx.x; item < NB * 2 * sd::NCH; item += gridDim.x) { const int c = item % sd::NCH, g = (item / sd::NCH) & 1, b = item / (2 * sd::NCH); sd::pass_b_item(p, lds, snap, b, g, c); }
}
__device__ __forceinline__ void ph_inproj(const Params& p, LAS unsigned char* lds) {
  pg8::Gemm g{(const bf16_t*)p.xq, (const bf16_t*)p.WinQ, D / 2, 0, 0};
  pg8::OrderStatic Sd; Sd.init(T, NPROJ, gridDim.x, blockIdx.x);
  EpiProj E{p.proj, p.dt, p.dt_bias_f, p.dt_bias_b, p.sx, p.sw};
  pg8::gemm_phase<false, false, EpiProj, pg8::OrderStatic, true>(lds, g, Sd, E);
}
__device__ __forceinline__ void ph_outproj(const Params& p, LAS unsigned char* lds) {
  pg8::Gemm g{p.u, p.WoutT, D, 0, 0}; pg8::OrderStatic Sd; Sd.init(T, D, gridDim.x, blockIdx.x);
#ifdef PROBE_OUT2
  { EpiOut E2{p.xb, (size_t)((bf16_t*)p.H - p.xb), p.x}; pg8::gemm_phase<false, false>(lds, g, Sd, E2); }
#endif
  EpiOut E{p.xb, 0, p.x};
  pg8::gemm_phase<false, false>(lds, g, Sd, E);
}
__device__ __forceinline__ int ld_agent(const int* p) { return __hip_atomic_load(p, __ATOMIC_RELAXED, __HIP_MEMORY_SCOPE_AGENT); }
__device__ __forceinline__ float ld_agent(const float* p) { return __hip_atomic_load(p, __ATOMIC_RELAXED, __HIP_MEMORY_SCOPE_AGENT); }
__device__ __forceinline__ void ph_ln_route(const Params& p, char* ldsg, LAS unsigned char* lds) {
  typedef short bf16x8 __attribute__((ext_vector_type(8)));
  LAS int* cntl = (LAS int*)lds;
  int tid = threadIdx.x; asm volatile("" : "+v"(tid));
  const int lane = tid & 63, wv = tid >> 6;
  float* lg = (float*)(ldsg + 132 * 1024) + wv * 512;
  const float rbias = p.router_bias[lane];
  for (int tb = blockIdx.x; tb < T / 64; tb += gridDim.x) {
    __syncthreads();
    if (tid < NE) cntl[tid] = 0;
    { float* gl = (float*)(ldsg + 4096); *(f32x4*)(gl + tid * 4) = *(const f32x4*)(p.ln1_g + tid * 4); *(f32x4*)(gl + 2048 + tid * 4) = *(const f32x4*)(p.ln1_b + tid * 4); }
    __syncthreads();
    const int t0 = tb * 64 + wv * 8;
    {
    const float* gl = (const float*)(ldsg + 4096);
#pragma unroll 1
    for (int i0 = 0; i0 < 8; i0 += 4) {
    u32x4 nx[4][4];
#pragma unroll
    for (int r = 0; r < 4; ++r)
#pragma unroll
      for (int g = 0; g < 4; ++g) nx[r][g] = *(const u32x4*)(p.xb + (size_t)(t0 + i0 + r) * D + g * 512 + lane * 8);
#pragma unroll
    for (int ii = 0; ii < 4; ++ii) { const int i = i0 + ii;
      float v[32]; float s = 0.f;
#pragma unroll
      for (int g = 0; g < 4; ++g) { const u32x4 w = nx[ii][g];
        v[g * 8 + 0] = __uint_as_float(w.x << 16); v[g * 8 + 1] = __uint_as_float(w.x & 0xffff0000u); v[g * 8 + 2] = __uint_as_float(w.y << 16); v[g * 8 + 3] = __uint_as_float(w.y & 0xffff0000u);
        v[g * 8 + 4] = __uint_as_float(w.z << 16); v[g * 8 + 5] = __uint_as_float(w.z & 0xffff0000u); v[g * 8 + 6] = __uint_as_float(w.w << 16); v[g * 8 + 7] = __uint_as_float(w.w & 0xffff0000u); }
#pragma unroll
      for (int j = 0; j < 32; ++j) s += v[j];
      const float mu = wave_sum(s) * (1.f / D); float q = 0.f;
#pragma unroll
      for (int j = 0; j < 32; ++j) { const float d = v[j] - mu; q += d * d; }
      const float rstd = rsqrtf(wave_sum(q) * (1.f / D) + 1e-5f), nmr = -mu * rstd;
#pragma unroll
      for (int g = 0; g < 4; ++g) { float o[8];
        const f32x4 ga = *(const f32x4*)(gl + g * 512 + lane * 8), gb = *(const f32x4*)(gl + g * 512 + lane * 8 + 4), ba = *(const f32x4*)(gl + 2048 + g * 512 + lane * 8), bb = *(const f32x4*)(gl + 2048 + g * 512 + lane * 8 + 4);
#pragma unroll
        for (int j = 0; j < 4; ++j) { o[j] = fmaf(fmaf(v[g * 8 + j], rstd, nmr), ga[j], ba[j]); o[4 + j] = fmaf(fmaf(v[g * 8 + 4 + j], rstd, nmr), gb[j], bb[j]); }
        u32x4 w; w.x = cvt_pk_bf16(o[0], o[1]); w.y = cvt_pk_bf16(o[2], o[3]); w.z = cvt_pk_bf16(o[4], o[5]); w.w = cvt_pk_bf16(o[6], o[7]);
        *(u32x4*)(p.h1b + (size_t)(t0 + i) * D + g * 512 + lane * 8) = w;
        uint2 w8; { int a = __float_as_int(o[0]), b = __float_as_int(o[4]); a = __builtin_amdgcn_cvt_pk_fp8_f32(o[0], o[1], a, false); a = __builtin_amdgcn_cvt_pk_fp8_f32(o[2], o[3], a, true); b = __builtin_amdgcn_cvt_pk_fp8_f32(o[4], o[5], b, false); b = __builtin_amdgcn_cvt_pk_fp8_f32(o[6], o[7], b, true); w8.x = (unsigned)a; w8.y = (unsigned)b; }
        *(uint2*)(p.h1q + (size_t)(t0 + i) * D + g * 512 + lane * 8) = w8; }
      __builtin_amdgcn_sched_barrier(0);
    }
    }
    }
    __threadfence_block(); asm volatile("s_waitcnt vmcnt(0)" ::: "memory"); __syncthreads();
    { f32x4 acc[4][4];
#pragma unroll
      for (int mb = 0; mb < 4; ++mb)
#pragma unroll
        for (int nb = 0; nb < 4; ++nb) acc[mb][nb] = (f32x4){0.f, 0.f, 0.f, 0.f};
      const bf16_t* ap = p.h1b + (size_t)(tb * 64 + (lane & 15)) * D + wv * 256 + 8 * (lane >> 4);
      const bf16_t* bp = p.WrT + (size_t)(lane & 15) * D + wv * 256 + 8 * (lane >> 4);
#pragma unroll 4
      for (int kk = 0; kk < 8; ++kk) {
        bf16x8 a[4], b[4];
#pragma unroll
        for (int q = 0; q < 4; ++q) { a[q] = *(const bf16x8*)(ap + (size_t)q * 16 * D + kk * 32); b[q] = *(const bf16x8*)(bp + (size_t)q * 16 * D + kk * 32); }
#pragma unroll
        for (int mb = 0; mb < 4; ++mb)
#pragma unroll
          for (int nb = 0; nb < 4; ++nb) acc[mb][nb] = __builtin_amdgcn_mfma_f32_16x16x32_bf16(a[mb], b[nb], acc[mb][nb], 0, 0, 0);
      }
      float* red = (float*)(ldsg + 4096) + wv * 4096;
#pragma unroll
      for (int mb = 0; mb < 4; ++mb)
#pragma unroll
        for (int nb = 0; nb < 4; ++nb)
#pragma unroll
          for (int i = 0; i < 4; ++i) red[(mb * 16 + 4 * (lane >> 4) + i) * 64 + nb * 16 + (lane & 15)] = acc[mb][nb][i];
    }
    __syncthreads();
    { const float* red = (const float*)(ldsg + 4096);
#pragma unroll
      for (int ti = 0; ti < 8; ++ti) { float s = 0.f;
#pragma unroll
        for (int w2 = 0; w2 < 8; ++w2) s += red[w2 * 4096 + (wv * 8 + ti) * 64 + lane];
        lg[ti * 64 + lane] = s; } }
    asm volatile("s_waitcnt lgkmcnt(0)" ::: "memory"); __builtin_amdgcn_wave_barrier();
    { float* rb = (float*)(ldsg + 148 * 1024) + wv * 96;
#define WSYNC() do { asm volatile("s_waitcnt lgkmcnt(0)" ::: "memory"); __builtin_amdgcn_wave_barrier(); } while (0)
      for (int ti = 0; ti < 8; ++ti) {
        const int t = t0 + ti;
        const float sc = 1.f / (1.f + __expf(-lg[ti * 64 + lane]));
        const float bz = sc + rbias;
        WSYNC(); rb[lane] = bz; WSYNC();
        const int g = lane >> 3;
        float gv[8]; { const f32x4 a = *(const f32x4*)(rb + g * 8), b = *(const f32x4*)(rb + g * 8 + 4); gv[0] = a[0]; gv[1] = a[1]; gv[2] = a[2]; gv[3] = a[3]; gv[4] = b[0]; gv[5] = b[1]; gv[6] = b[2]; gv[7] = b[3]; }
        float m1 = fmaxf(gv[0], gv[1]), m2 = fminf(gv[0], gv[1]);
#pragma unroll
        for (int j = 2; j < 8; ++j) { m2 = fmaxf(m2, fminf(m1, gv[j])); m1 = fmaxf(m1, gv[j]); }
        const float gs = m1 + m2;
        if ((lane & 7) == 0) rb[64 + g] = gs;
        WSYNC();
        int grk = 0;
        { const f32x4 a = *(const f32x4*)(rb + 64), b = *(const f32x4*)(rb + 68); const float q[8] = {a[0], a[1], a[2], a[3], b[0], b[1], b[2], b[3]};
#pragma unroll
          for (int k = 0; k < 8; ++k) grk += (q[k] > gs || (q[k] == gs && k < g)) ? 1 : 0; }
        const bool gsel = grk < 4;
        const unsigned long long gmask = __ballot(gsel);
        const float mb = gsel ? bz : -INFINITY;
        WSYNC(); rb[lane] = mb; WSYNC();
        int erk = 0;
#pragma unroll
        for (int k4 = 0; k4 < 16; ++k4) { if (!((gmask >> (k4 * 4)) & 1ull)) continue;
          const f32x4 a = *(const f32x4*)(rb + k4 * 4);
#pragma unroll
          for (int k = 0; k < 4; ++k) erk += (a[k] > mb || (a[k] == mb && (k4 * 4 + k) < lane)) ? 1 : 0; }
        const bool sel = gsel && erk < 8;
        if (sel) rb[72 + erk] = sc;
        WSYNC();
        float gsum; { const f32x4 a = *(const f32x4*)(rb + 72), b = *(const f32x4*)(rb + 76); gsum = ((a[0] + a[1]) + (a[2] + a[3])) + ((b[0] + b[1]) + (b[2] + b[3])); }
        if (sel) {
          const int lr = __hip_atomic_fetch_add(&cntl[lane], 1, __ATOMIC_RELAXED, __HIP_MEMORY_SCOPE_WORKGROUP);
          p.assign[t * 8 + erk] = lane | (lr << 8); p.gate[t * 8 + erk] = sc / gsum * 2.5f;
        }
      }
#undef WSYNC
    }
    __syncthreads();
    if (tid < NE) p.blkcnt[tb * NE + tid] = cntl[tid];
  }
}
__device__ __forceinline__ void ph_place(const Params& p, LAS unsigned char* lds) {
  LAS int* part = (LAS int*)lds;
  LAS int* parta = part + 512;
  LAS int* base = parta + 512;
  LAS int* total = base + 64;
  LAS int* pstart = total + 64;
  const int tid = tid_fresh(), e = tid & 63, pt = tid >> 6;
  for (int tb = blockIdx.x; tb < T / 64; tb += gridDim.x) {
    __syncthreads();
    int slo = 0, sall = 0;
    { int cv[32];
#pragma unroll
      for (int i = 0; i < 32; ++i) cv[i] = p.blkcnt[(pt * 32 + i) * NE + e];
#pragma unroll
      for (int i = 0; i < 32; ++i) { sall += cv[i]; slo += (pt * 32 + i < tb) ? cv[i] : 0; } }
    part[pt * 64 + e] = slo; parta[pt * 64 + e] = sall;
    __syncthreads();
    if (tid < 64) {
      int b0 = 0, t0 = 0;
#pragma unroll
      for (int q = 0; q < 8; ++q) { b0 += part[q * 64 + tid]; t0 += parta[q * 64 + tid]; }
      base[tid] = b0; total[tid] = t0;
      const int padded = (t0 + 255) & ~255;
      int incl = padded;
      for (int o = 1; o < 64; o <<= 1) { const int v = __shfl_up(incl, o); if (tid >= o) incl += v; }
      pstart[tid] = incl - padded;
      if (tid == 63) pstart[64] = incl;
    }
    __syncthreads();
    {
      const int t = tb * 64 + (tid >> 3), k = tid & 7;
      const int a = ld_agent(p.assign + t * 8 + k), ee = a & 255, lr = a >> 8;
      const int row = pstart[ee] + base[ee] + lr;
      p.row_tok[row] = t; p.row_gate[row] = ld_agent(p.gate + t * 8 + k); p.pos[t * 8 + k] = row;
      if (tid < 64) { const int srow = pstart[64] + tb * 64 + tid; p.row_tok[srow] = tb * 64 + tid; p.row_gate[srow] = 1.0f; }
    }
    if (tb == blockIdx.x) {
      for (int e2 = blockIdx.x; e2 < NE; e2 += gridDim.x) {
        const int r0 = pstart[e2] + total[e2], r1 = pstart[e2 + 1];
        for (int r = r0 + tid; r < r1; r += NT) { p.row_tok[r] = 0; p.row_gate[r] = 0.f; }
        for (int j = pstart[e2] / 256 + tid; j < r1 / 256; j += NT) p.tile_exp[j] = e2;
      }
      if (blockIdx.x == 0) {
        const int nr = pstart[64] / 256;
        for (int j = tid; j < T / 256; j += NT) p.tile_exp[nr + j] = NE;
        if (tid == 0) { p.meta[0] = nr; p.meta[1] = nr + T / 256; }
      }
    }
  }
}
struct OrderMoE {
  LAS const int* ulist; int n;
  LAS const unsigned* tab; int tstride;
  __device__ __forceinline__ bool next(int i, pg8::Unit& u) const { if (i >= n) return false; u.pm = ulist[i * 4 + 0]; u.pn = ulist[i * 4 + 1]; u.bn = ulist[i * 4 + 2]; u.aux = i; return true; }
  __device__ __forceinline__ unsigned row_off(int i, int row) const { return tab[i * tstride + row]; }
};
template <int TABLES>
__device__ __forceinline__ OrderMoE moe_order(const Params& p, LAS unsigned char* lds, int npn, int tile0, int ntiles, int rowbytes) {
  LAS int* ulist = (LAS int*)(lds + LDS_TAB); LAS unsigned* tab = (LAS unsigned*)(lds + LDS_TAB + 1024);
  const int G = gridDim.x, c = blockIdx.x, mpc = 32 / npn; int n = 0;
  auto unit_of = [&](int i, int& tile, int& pn) -> bool {
    int U; if (G == 256) U = ((i * 8 + (c & 7)) * 32 + (c >> 3)); else U = i * G + c;
    const int chunk = U >> 5, w = U & 31, j = chunk * mpc + (w % mpc); pn = w / mpc; tile = tile0 + j; return j < ntiles; };
  __syncthreads();
  for (int i = 0; i < 60; ++i) { int tile, pn; if (!unit_of(i, tile, pn)) break; n = i + 1; }
  if ((int)threadIdx.x < n) { int tile, pn; unit_of(threadIdx.x, tile, pn); const int e = p.tile_exp[tile];
    ulist[threadIdx.x * 4 + 0] = tile; ulist[threadIdx.x * 4 + 1] = pn; ulist[threadIdx.x * 4 + 2] = e * npn + pn; ulist[threadIdx.x * 4 + 3] = e; }
  if (TABLES == 2) { for (int idx = threadIdx.x; idx < n * 256; idx += NT) { const int i = idx >> 8, r = idx & 255; int tile, pn; unit_of(i, tile, pn); tab[i * 256 + r] = (unsigned)(tile * 256 + r) * (unsigned)rowbytes; } }
  if (TABLES == 1) {
#pragma unroll 4
    for (int idx = threadIdx.x; idx < n * 256; idx += NT) { const int i = idx >> 8, r = idx & 255; int tile, pn; unit_of(i, tile, pn);
      tab[i * 512 + r] = (unsigned)p.row_tok[tile * 256 + r] * (unsigned)rowbytes; tab[i * 512 + 256 + r] = __float_as_uint(p.row_gate[tile * 256 + r]); } }
  __syncthreads();
  return OrderMoE{ulist, n, tab, TABLES == 2 ? 256 : 512};
}
__device__ __forceinline__ u32x4 pair16(uint2 a, uint2 b) {
  const auto rx = __builtin_amdgcn_permlane16_swap(a.x, b.x, false, false), ry = __builtin_amdgcn_permlane16_swap(a.y, b.y, false, false);
  return (u32x4){rx[0], ry[0], rx[1], ry[1]};
}
__device__ __forceinline__ uint2 pack8_fp8(const float* h) { int a = __float_as_int(h[0]), b = __float_as_int(h[4]);
  a = __builtin_amdgcn_cvt_pk_fp8_f32(h[0], h[1], a, false); a = __builtin_amdgcn_cvt_pk_fp8_f32(h[2], h[3], a, true); b = __builtin_amdgcn_cvt_pk_fp8_f32(h[4], h[5], b, false); b = __builtin_amdgcn_cvt_pk_fp8_f32(h[6], h[7], b, true); return make_uint2((unsigned)a, (unsigned)b); }
struct EpiGU {
  static constexpr bool PERM = true;
  unsigned char* H; LAS const unsigned* tab;
  __device__ __forceinline__ void operator()(const f32x4 (&acc)[2][2][4][2], const pg8::Unit& u, int wr, int wc, int fr, int fq) const {
    asm volatile("" : "+v"(fr), "+v"(fq));
    const int col0 = u.pn * 128 + wc * 32 + 8 * (fq & ~1);
#pragma unroll
    for (int ai = 0; ai < 2; ++ai)
#pragma unroll
      for (int mp = 0; mp < 2; ++mp) { uint2 pk[2];
#pragma unroll
        for (int mm = 0; mm < 2; ++mm) { const int m = 2 * mp + mm; const int r = ai * 128 + wr * 64 + m * 16 + fr; const float gt = __uint_as_float(tab[u.aux * 512 + 256 + r]) * H8S;
          float h[8];
#pragma unroll
          for (int j = 0; j < 4; ++j) { const float g0 = acc[ai][0][m][0][j], g1 = acc[ai][0][m][1][j];
            h[j] = g0 * __builtin_amdgcn_rcpf(1.f + __expf(-g0)) * acc[ai][1][m][0][j] * gt; h[4 + j] = g1 * __builtin_amdgcn_rcpf(1.f + __expf(-g1)) * acc[ai][1][m][1][j] * gt; }
#pragma unroll
          for (int j = 0; j < 8; ++j) h[j] = __builtin_amdgcn_fmed3f(h[j], -448.f, 448.f);
          pk[mm] = pack8_fp8(h); }
        const int rsel = ai * 128 + wr * 64 + (2 * mp + (fq & 1)) * 16 + fr;
        __builtin_nontemporal_store(pair16(pk[0], pk[1]), (u32x4*)(H + (size_t)(u.pm * 256 + rsel) * DE + col0)); }
  }
};
__device__ __forceinline__ void ph_gateup(const Params& p, LAS unsigned char* lds) {
  const int ntot = ld_agent(p.meta + 1);
  const OrderMoE S = moe_order<1>(p, lds, 4, 0, ntot, D);
  pg8::Gemm g{(const bf16_t*)p.h1q, p.WguT, D / 2, 0x7a7a7a7a  , 0x7f7f7f7f}; EpiGU E{(unsigned char*)p.H, S.tab};
  pg8::gemm_phase<true, true>(lds, g, S, E);
}
struct EpiDown {
  static constexpr bool PERM = true;
  unsigned char* Y;
  __device__ __forceinline__ void operator()(const f32x4 (&acc)[2][2][4][2], const pg8::Unit& u, int wr, int wc, int fr, int fq) const {
    asm volatile("" : "+v"(fr), "+v"(fq));
    const int col0 = u.pn * 256 + wc * 32 + 8 * (fq & ~1);
#pragma unroll
    for (int ai = 0; ai < 2; ++ai)
#pragma unroll
      for (int mp = 0; mp < 2; ++mp) { unsigned char* rowp = Y + (size_t)(u.pm * 256 + ai * 128 + wr * 64 + (2 * mp + (fq & 1)) * 16 + fr) * D + col0;
#pragma unroll
        for (int bj = 0; bj < 2; ++bj) { uint2 pk[2];
#pragma unroll
          for (int mm = 0; mm < 2; ++mm) { const f32x4 v0 = acc[ai][bj][2 * mp + mm][0], v1 = acc[ai][bj][2 * mp + mm][1]; float h[8] = {v0[0], v0[1], v0[2], v0[3], v1[0], v1[1], v1[2], v1[3]};
#pragma unroll
            for (int j = 0; j < 8; ++j) h[j] = __builtin_amdgcn_fmed3f(h[j], -448.f, 448.f);
            pk[mm] = pack8_fp8(h); }
          *(u32x4*)(rowp + bj * 128) = pair16(pk[0], pk[1]); } }
  }
};
__device__ __forceinline__ void ph_down(const Params& p, LAS unsigned char* lds) {
  const int ntot = ld_agent(p.meta + 1);
  const OrderMoE S = moe_order<2>(p, lds, 8, 0, ntot, DE);
  pg8::Gemm g{p.H, p.WdT, DE / 2, 0x7a7a7a7a  , (int)0x81818181u  }; EpiDown E{(unsigned char*)p.Y};
  pg8::gemm_phase<true, true>(lds, g, S, E);
}
__device__ __forceinline__ void acc_fp8x8(float* v, uint2 w) {
  const auto a = __builtin_amdgcn_cvt_pk_f32_fp8((int)w.x, false), b = __builtin_amdgcn_cvt_pk_f32_fp8((int)w.x, true), c = __builtin_amdgcn_cvt_pk_f32_fp8((int)w.y, false), d = __builtin_amdgcn_cvt_pk_f32_fp8((int)w.y, true);
  v[0] += a[0]; v[1] += a[1]; v[2] += b[0]; v[3] += b[1]; v[4] += c[0]; v[5] += c[1]; v[6] += d[0]; v[7] += d[1];
}
__device__ __forceinline__ void ph_combine(const Params& p) {
  const int tidf = tid_fresh(), lane = tidf & 63, wv = tidf >> 6;
  const int srow0 = ld_agent(p.meta + 0) * 256;
  const unsigned char* Yb = (const unsigned char*)p.Y;
  f32x4 g2[4][2], b2[4][2];
#pragma unroll
  for (int g = 0; g < 4; ++g) { const int c0 = g * 512 + lane * 8;
    g2[g][0] = *(const f32x4*)(p.ln2_g + c0); g2[g][1] = *(const f32x4*)(p.ln2_g + c0 + 4); b2[g][0] = *(const f32x4*)(p.ln2_b + c0); b2[g][1] = *(const f32x4*)(p.ln2_b + c0 + 4); }
  for (int row = blockIdx.x * 8 + wv; row < T; row += gridDim.x * 8) {
    float v[32];
#pragma unroll
    for (int j = 0; j < 32; ++j) v[j] = 0.f;
    int yr[8];
#pragma unroll
    for (int k = 0; k < 8; ++k) yr[k] = ld_agent(p.pos + row * 8 + k);
#pragma unroll
    for (int g = 0; g < 4; ++g) acc_fp8x8(v + g * 8, *(const uint2*)(Yb + (size_t)(srow0 + row) * D + g * 512 + lane * 8));
#pragma unroll
    for (int k = 0; k < 8; ++k) {
#pragma unroll
      for (int g = 0; g < 4; ++g) acc_fp8x8(v + g * 8, *(const uint2*)(Yb + (size_t)yr[k] * D + g * 512 + lane * 8)); }
    { const bf16_t* hp = p.h1b + (size_t)row * D;
#pragma unroll
      for (int g = 0; g < 4; ++g) { const u32x4 hb = *(const u32x4*)(hp + g * 512 + lane * 8);
        v[g * 8 + 0] = v[g * 8 + 0] * Y8I + ALPHA * __uint_as_float(hb.x << 16); v[g * 8 + 1] = v[g * 8 + 1] * Y8I + ALPHA * __uint_as_float(hb.x & 0xffff0000u);
        v[g * 8 + 2] = v[g * 8 + 2] * Y8I + ALPHA * __uint_as_float(hb.y << 16); v[g * 8 + 3] = v[g * 8 + 3] * Y8I + ALPHA * __uint_as_float(hb.y & 0xffff0000u);
        v[g * 8 + 4] = v[g * 8 + 4] * Y8I + ALPHA * __uint_as_float(hb.z << 16); v[g * 8 + 5] = v[g * 8 + 5] * Y8I + ALPHA * __uint_as_float(hb.z & 0xffff0000u);
        v[g * 8 + 6] = v[g * 8 + 6] * Y8I + ALPHA * __uint_as_float(hb.w << 16); v[g * 8 + 7] = v[g * 8 + 7] * Y8I + ALPHA * __uint_as_float(hb.w & 0xffff0000u); } }
    float s = 0.f;
#pragma unroll
    for (int j = 0; j < 32; ++j) s += v[j];
    const float mu = wave_sum(s) * (1.f / D); float q = 0.f;
#pragma unroll
    for (int j = 0; j < 32; ++j) { const float d = v[j] - mu; q += d * d; }
    const float rstd = rsqrtf(wave_sum(q) * (1.f / D) + 1e-5f);
    float* op = p.out + (size_t)row * D;
#pragma unroll
    for (int g = 0; g < 4; ++g) { const int c0 = g * 512 + lane * 8; f32x4 a, b;
#pragma unroll
      for (int j = 0; j < 4; ++j) { a[j] = (v[g * 8 + j] - mu) * rstd * g2[g][0][j] + b2[g][0][j]; b[j] = (v[g * 8 + 4 + j] - mu) * rstd * g2[g][1][j] + b2[g][1][j]; }
      *(f32x4*)(op + c0) = a; *(f32x4*)(op + c0 + 4) = b; }
  }
}

__global__ void __launch_bounds__(NT) k_mega(Params p_arg) {
#if defined(__HIP_DEVICE_COMPILE__)
  extern __shared__ __attribute__((aligned(16))) unsigned char lds_raw[];
  LAS unsigned char* lds = (LAS unsigned char*)lds_raw;
  float* smem = (float*)lds_raw;
#ifndef ONLY
#define ONLY -1
#endif
  typedef const __attribute__((address_space(4))) Params* KP;
  const KP pk = (KP)__builtin_amdgcn_kernarg_segment_ptr();
  volatile LAS unsigned* bst = (volatile LAS unsigned*)(lds + LDS_BYTES - 16);
  if (threadIdx.x == 0) { bst[0] = 0u; bst[1] = 0u; }
  __syncthreads();
  { KP q_ = pk; asm volatile("" : "+s"(q_)); (void)xcd_barrier_post(q_->bar, bst); }
#define GSYNC() do { KP qb_ = pk; asm volatile("" : "+s"(qb_)); XcdBarrier gb_; gb_.bar = qb_->bar; gb_.x = xb_xcc_id(); gb_.st = bst; xcd_barrier(gb_); } while (0)
#ifndef DUP
#define DUP -1
#endif
#define RUN1(n, pass, call) do { if (ONLY < 0 || ONLY == n) { KP q_ = pk; asm volatile("" : "+s"(q_)); const Params p = *q_; const int dup_pass = pass; (void)dup_pass; call; } } while (0)
#define RUN(n, call) do { RUN1(n, 0, call); if (DUP == n) { GSYNC(); RUN1(n, 1, call); } } while (0)
  RUN(0, ph_convert(p)); GSYNC();
  RUN(14, ph_convert_win(p)); GSYNC();
  RUN(1, ph_inproj(p, lds)); GSYNC();
  RUN(2, sd::ph_conv16(p)); GSYNC();
  RUN(3, ph_ssd_a(p, (char*)lds_raw, (char*)p.out)); RUN(4, ph_attn_mfma(p, (char*)lds_raw, p.meta + 8 + dup_pass)); GSYNC();
  RUN(5, ph_ssd_b(p, (char*)lds_raw, (const char*)p.out)); GSYNC();
  RUN(6, ph_outproj(p, lds)); GSYNC();
  RUN(7, ph_ln_route(p, (char*)lds_raw, lds)); GSYNC();
  RUN(10, ph_place(p, lds)); GSYNC();
  RUN(11, ph_gateup(p, lds)); GSYNC();
  RUN(12, ph_down(p, lds)); GSYNC();
  RUN(13, ph_combine(p));
#endif
}
}

extern "C" void kernel_launch(void* const* d_in, const int* in_sizes, int n_in, void* d_out, int out_size, void* d_ws, size_t ws_size, hipStream_t stream) {
  Params p{};
  const float* const* in = (const float* const*)d_in;
  p.x = in[0]; p.w_in = in[1]; p.conv_w = in[2]; p.conv_b = in[3]; p.dt_bias_f = in[4]; p.dt_bias_b = in[5]; p.a_log_f = in[6]; p.a_log_b = in[7];
  p.d_skip = in[8]; p.ssd_norm_w = in[9]; p.lq1 = in[10]; p.lk1 = in[11]; p.lq2 = in[12]; p.lk2 = in[13]; p.attn_norm_w = in[14]; p.w_out = in[15];
  p.ln1_g = in[16]; p.ln1_b = in[17]; p.w_router = in[18]; p.router_bias = in[19]; p.wg_e = in[20]; p.wu_e = in[21]; p.wd_e = in[22];
  p.wg_s = in[23]; p.wu_s = in[24]; p.wd_s = in[25]; p.ln2_g = in[26]; p.ln2_b = in[27];
  p.out = (float*)d_out;
  char* w = (char*)d_ws; size_t o = 0;
  auto take = [&](size_t bytes) { char* r = w + o; o += (bytes + 255) / 256 * 256; return r; };
  char* reg1 = w + o;
  p.xb = (bf16_t*)take((size_t)T * D * 2); p.xq = (signed char*)take((size_t)T * D); p.WinQ = (signed char*)take((size_t)NPROJ * D); p.WoutT = (bf16_t*)take((size_t)D * D * 2);
  p.WguT = (bf16_t*)take((size_t)(NE + 1) * 1024 * D); p.proj = (bf16_t*)take((size_t)T * PLD * 2); p.u = (bf16_t*)take((size_t)T * D * 2);
  if ((size_t)((w + o) - reg1) < (size_t)MAXROWS * D * 2) take((size_t)MAXROWS * D * 2 - (size_t)((w + o) - reg1));
  const size_t reg1_bytes = (size_t)((w + o) - reg1);
  p.Y = (bf16_t*)reg1;
  if ((size_t)MAXROWS * D * 2 > reg1_bytes) { fprintf(stderr, "kernel_launch: region 1 too small for Y\n"); return; }
  char* reg2 = take((size_t)MAXROWS * DE);
  p.H = (bf16_t*)reg2; p.xc16 = (bf16_t*)reg2;
  p.h1b = (bf16_t*)take((size_t)T * D * 2); p.WdT = (bf16_t*)take((size_t)(NE + 1) * D * DE); p.h1q = (unsigned char*)take((size_t)T * D);
  p.dt = (float*)take((size_t)T * 32 * 4); p.kn2 = (float*)take((size_t)NB * AH * 2 * (S / 64) * 4); p.WrT = (bf16_t*)take((size_t)NE * D * 2); p.gate = (float*)take((size_t)T * 8 * 4);
  p.assign = (int*)take((size_t)T * 8 * 4); p.pos = (int*)take((size_t)T * 8 * 4); p.blkcnt = (int*)take((size_t)(T / 64) * NE * 4);
  p.row_tok = (int*)take((size_t)MAXROWS * 4); p.row_gate = (float*)take((size_t)MAXROWS * 4); p.tile_exp = (int*)take((size_t)MAXTILES * 4);
  p.bar = (unsigned*)take((size_t)XCD_BAR_WORDS * 4 + 256 + (size_t)NPROJ * 4); p.meta = (int*)(p.bar + XCD_BAR_WORDS); p.colmax = (unsigned*)(p.meta + 64);
  p.sx = (float*)take((size_t)T * 4); p.sw = (float*)take((size_t)NPROJ * 4);
  p.h1 = (float*)d_out;
  if (o > ws_size) { fprintf(stderr, "kernel_launch: ws too small: need %zu have %zu\n", o, ws_size); return; }
  static int grid_blocks = 0;
  if (!grid_blocks) {
    int dev = 0, cus = 0, per_cu = 0;
    hipGetDevice(&dev);
    hipDeviceGetAttribute(&cus, hipDeviceAttributeMultiprocessorCount, dev);
    if (hipFuncSetAttribute((const void*)k_mega, hipFuncAttributeMaxDynamicSharedMemorySize, LDS_BYTES) != hipSuccess) { fprintf(stderr, "kernel_launch: hipFuncSetAttribute failed\n"); return; }
    hipOccupancyMaxActiveBlocksPerMultiprocessor(&per_cu, k_mega, NT, LDS_BYTES);
    if (per_cu < 1) { fprintf(stderr, "kernel_launch: occupancy query says 0 blocks/CU\n"); return; }
    grid_blocks = cus;
  }
  if (hipMemsetAsync(p.bar, 0, (size_t)XCD_BAR_WORDS * 4 + 256 + (size_t)NPROJ * 4, stream) != hipSuccess) { fprintf(stderr, "kernel_launch: memset failed\n"); return; }
  hipLaunchKernelGGL(k_mega, dim3(grid_blocks), dim3(NT), LDS_BYTES, stream, p);
  const hipError_t le = hipPeekAtLastError();
  if (le != hipSuccess) fprintf(stderr, "kernel_launch: launch failed: %s (grid %d)\n", hipGetErrorString(le), grid_blocks);
}
```
